# Optimizing an MI355X kernel written in HIP

```python
import math
import jax, jax.numpy as jnp
from jax import lax
import numpy as np

D_MODEL = 1024
BATCH = 4
SEQ = 8192
DEPTH = 1

CHUNK = 64
N_MEM = 256
EPS = 1e-6
SB_HEADS = 8
SB_HEAD_DIM = 64
SB_WIDTH = SB_HEADS * SB_HEAD_DIM
SB_Q_BLOCK = 128
GDN_HEADS = 4
GDN_HEAD_DIM = 128
GDN_WIDTH = GDN_HEADS * GDN_HEAD_DIM
CONV_WIDTH = 4
X_HEADS = 4
X_HEAD_DIM = D_MODEL // X_HEADS
PEER_HEADS = 8
PEER_KEYS = 128
PEER_EXPERTS = PEER_KEYS * PEER_KEYS
PEER_TOPK = 16
PEER_QDIM = 256
PEER_TOKEN_BLOCK = 128
IN_SPLIT_SIZES = (SB_WIDTH, SB_WIDTH, SB_WIDTH, GDN_WIDTH, GDN_WIDTH, GDN_WIDTH, GDN_WIDTH,
                  GDN_HEADS, GDN_HEADS, D_MODEL, D_MODEL)
IN_COLS = 3 * SB_WIDTH + 4 * GDN_WIDTH + 2 * GDN_HEADS + 2 * D_MODEL

kernel_name = "hybrid_stickbreak_gdn_peer_block"


def rmsnorm(x, g):
    xf = x.astype(jnp.float32)
    y = xf * lax.rsqrt(jnp.mean(xf * xf, axis=-1, keepdims=True) + EPS)
    return (y * g.astype(jnp.float32)).astype(x.dtype)


def l2norm(x):
    xf = x.astype(jnp.float32)
    return xf * lax.rsqrt(jnp.sum(xf * xf, axis=-1, keepdims=True) + EPS)


def causal_dwconv(x, w):
    K = w.shape[0]
    S = x.shape[1]
    xp = jnp.pad(x, ((0, 0), (K - 1, 0), (0, 0)))
    return sum(xp[:, j:j + S] * w[j] for j in range(K))


def stick_breaking_attention(q, k, v):
    S, d = q.shape[2], q.shape[3]
    scale = d ** -0.5
    outs = []
    for i in range(S // SB_Q_BLOCK):
        q0 = i * SB_Q_BLOCK
        kv_len = q0 + SB_Q_BLOCK
        qb = q[:, :, q0:kv_len]
        kb = k[:, :, :kv_len]
        vb = v[:, :, :kv_len]
        z = jnp.einsum('bhqd,bhkd->bhqk', qb, kb).astype(jnp.float32) * scale
        qpos = q0 + jnp.arange(SB_Q_BLOCK)[:, None]
        kpos = jnp.arange(kv_len)[None, :]
        mask = kpos < qpos
        log_keep = jnp.where(mask, jax.nn.log_sigmoid(-z), 0.0)
        after = lax.cumsum(log_keep, axis=3, reverse=True) - log_keep
        a = jnp.where(mask, jnp.exp(jax.nn.log_sigmoid(z) + after), 0.0)
        outs.append(jnp.einsum('bhqk,bhkd->bhqd', a.astype(v.dtype), vb))
    return jnp.concatenate(outs, axis=2)


def gated_delta_rule(q, k, v, beta, g):
    B, S, H, dk = q.shape
    dv = v.shape[-1]
    N, C = S // CHUNK, CHUNK
    f32 = jnp.float32

    def chunk4(t):
        return jnp.moveaxis(t.astype(f32).reshape(B, N, C, H, t.shape[-1]), 3, 1)

    def chunk3(t):
        return jnp.moveaxis(t.astype(f32).reshape(B, N, C, H), 3, 1)

    q = chunk4(q) * (dk ** -0.5)
    k = chunk4(k)
    v = chunk4(v)
    beta = chunk3(beta)
    gc = jnp.cumsum(chunk3(g), axis=-1)
    idx = jnp.arange(C)
    incl = idx[:, None] >= idx[None, :]
    strict = idx[:, None] > idx[None, :]
    decay = jnp.exp(jnp.where(incl, gc[..., :, None] - gc[..., None, :], -jnp.inf))
    kb = k * beta[..., None]
    vb = v * beta[..., None]
    a = jnp.where(strict, jnp.einsum('bhncd,bhnmd->bhncm', kb, k) * decay, 0.0)
    eye = jnp.eye(C, dtype=f32)
    rhs = jnp.concatenate([vb, kb * jnp.exp(gc)[..., None]], axis=-1)
    sol = lax.linalg.triangular_solve(a + eye, rhs, left_side=True, lower=True, unit_diagonal=True)
    u = sol[..., :dv]
    w = sol[..., dv:]
    qk = jnp.einsum('bhncd,bhnmd->bhncm', q, k) * decay
    q_dec = q * jnp.exp(gc)[..., None]
    k_dec = k * jnp.exp(gc[..., -1:] - gc)[..., None]
    chunk_decay = jnp.exp(gc[..., -1])
    xs = tuple(jnp.moveaxis(t, 2, 0) for t in (q_dec, k_dec, u, w, qk, chunk_decay))

    def step(state, inp):
        qd, kd, u_n, w_n, qk_n, cd = inp
        v_new = u_n - jnp.einsum('bhcd,bhde->bhce', w_n, state)
        o = jnp.einsum('bhcd,bhde->bhce', qd, state) + jnp.einsum('bhcm,bhme->bhce', qk_n, v_new)
        state = state * cd[..., None, None] + jnp.einsum('bhcd,bhce->bhde', kd, v_new)
        return state, o

    state0 = jnp.zeros((B, H, dk, dv), f32)
    _, o = lax.scan(step, state0, xs)
    return jnp.transpose(o, (1, 0, 3, 2, 4)).reshape(B, S, H, dv)


def token_mixer(xn, w_in, gdn_conv, gdn_a_log, gdn_dt_bias, gdn_norm_g, w_sb_up, w_gdn_up, w_mix_out):
    B, S, _ = xn.shape
    proj = xn @ w_in
    offs = [int(o) for o in np.cumsum(IN_SPLIT_SIZES)[:-1]]
    (sb_q, sb_k, sb_v, g_q, g_k, g_v, g_z, g_b, g_a, gate_sb, gate_gdn) = jnp.split(proj, offs, axis=-1)

    def heads_sb(t):
        return t.reshape(B, S, SB_HEADS, SB_HEAD_DIM).transpose(0, 2, 1, 3)
    o_sb = stick_breaking_attention(heads_sb(sb_q), heads_sb(sb_k), heads_sb(sb_v))
    o_sb = o_sb.transpose(0, 2, 1, 3).reshape(B, S, SB_WIDTH)

    qkv = jax.nn.silu(causal_dwconv(jnp.concatenate([g_q, g_k, g_v], axis=-1), gdn_conv))
    cq, ck, cv = jnp.split(qkv, 3, axis=-1)
    cq = l2norm(cq.reshape(B, S, GDN_HEADS, GDN_HEAD_DIM))
    ck = l2norm(ck.reshape(B, S, GDN_HEADS, GDN_HEAD_DIM))
    cv = cv.reshape(B, S, GDN_HEADS, GDN_HEAD_DIM)
    beta = jax.nn.sigmoid(g_b.astype(jnp.float32))
    g = -jnp.exp(gdn_a_log.astype(jnp.float32)) * jax.nn.softplus(g_a.astype(jnp.float32) + gdn_dt_bias.astype(jnp.float32))
    o_g = gated_delta_rule(cq, ck, cv, beta, g).astype(xn.dtype)
    o_g = rmsnorm(o_g, gdn_norm_g) * jax.nn.silu(g_z.reshape(B, S, GDN_HEADS, GDN_HEAD_DIM))
    o_g = o_g.reshape(B, S, GDN_WIDTH)

    merged = jax.nn.sigmoid(gate_sb) * (o_sb @ w_sb_up) + jax.nn.sigmoid(gate_gdn) * (o_g @ w_gdn_up)
    return merged @ w_mix_out


def memory_cross_attention(hn, mn, w_cq, w_ckv, w_co):
    B, S, _ = hn.shape
    M = mn.shape[1]
    q = (hn @ w_cq).reshape(B, S, X_HEADS, X_HEAD_DIM)
    k, v = jnp.split(mn @ w_ckv, 2, axis=-1)
    k = k.reshape(B, M, X_HEADS, X_HEAD_DIM)
    v = v.reshape(B, M, X_HEADS, X_HEAD_DIM)
    s = jnp.einsum('bshd,bmhd->bhsm', q, k).astype(jnp.float32) * (X_HEAD_DIM ** -0.5)
    p = jax.nn.softmax(s, axis=-1).astype(v.dtype)
    o = jnp.einsum('bhsm,bmhd->bshd', p, v).reshape(B, S, D_MODEL)
    return o @ w_co


def peer(xn, w_pq, subkeys, peer_u, peer_v):
    B, S, D = xn.shape
    T = B * S
    xt = xn.reshape(T, D)
    q = (xt @ w_pq).reshape(T, PEER_HEADS, 2, PEER_QDIM // 2)
    s = jnp.einsum('thpd,hpnd->thpn', q, subkeys).astype(jnp.float32)
    top_s, top_i = lax.top_k(s, PEER_TOPK)
    cand_s = top_s[:, :, 0, :, None] + top_s[:, :, 1, None, :]
    cand_i = top_i[:, :, 0, :, None] * PEER_KEYS + top_i[:, :, 1, None, :]
    kk = PEER_TOPK * PEER_TOPK
    best_s, best_pos = lax.top_k(cand_s.reshape(T, PEER_HEADS, kk), PEER_TOPK)
    expert = jnp.take_along_axis(cand_i.reshape(T, PEER_HEADS, kk), best_pos, axis=-1)
    gate = jax.nn.softmax(best_s, axis=-1).astype(xn.dtype)
    nb = T // PEER_TOKEN_BLOCK

    def block(args):
        xb, eb, gb = args
        act = jax.nn.gelu(jnp.einsum('thkd,td->thk', peer_u[eb], xb), approximate=False) * gb
        return jnp.einsum('thk,thkd->td', act, peer_v[eb])

    out = lax.map(block, (xt.reshape(nb, PEER_TOKEN_BLOCK, D),
                          expert.reshape(nb, PEER_TOKEN_BLOCK, PEER_HEADS, PEER_TOPK),
                          gate.reshape(nb, PEER_TOKEN_BLOCK, PEER_HEADS, PEER_TOPK)))
    return out.reshape(B, S, D)


def setup_inputs(seed: int = 0) -> dict:
    key = jax.random.key(seed)
    ks = jax.random.split(key, 24)
    f32 = jnp.float32

    def nrm(k, shape, scale):
        return jax.random.normal(k, shape, f32) * scale

    def gain(k, shape):
        return 1.0 + 0.02 * jax.random.normal(k, shape, f32)

    L, D = DEPTH, D_MODEL
    a_log = jnp.log(jax.random.uniform(ks[5], (L, GDN_HEADS), f32, 1.0, 16.0))
    dt = jnp.exp(jax.random.uniform(ks[6], (L, GDN_HEADS), f32, math.log(1e-3), math.log(1e-1)))
    dt_bias = dt + jnp.log(-jnp.expm1(-dt))
    return {
        "x": nrm(ks[0], (BATCH, SEQ, D), 1.0),
        "mem": nrm(ks[1], (BATCH, N_MEM, D), 1.0),
        "g_mix": gain(ks[2], (L, D)),
        "w_in": nrm(ks[3], (L, D, IN_COLS), D ** -0.5),
        "gdn_conv": nrm(ks[4], (L, CONV_WIDTH, 3 * GDN_WIDTH), CONV_WIDTH ** -0.5),
        "gdn_a_log": a_log,
        "gdn_dt_bias": dt_bias,
        "gdn_norm_g": gain(ks[7], (L, GDN_HEAD_DIM)),
        "w_sb_up": nrm(ks[8], (L, SB_WIDTH, D), SB_WIDTH ** -0.5),
        "w_gdn_up": nrm(ks[9], (L, GDN_WIDTH, D), GDN_WIDTH ** -0.5),
        "w_mix_out": nrm(ks[10], (L, D, D), D ** -0.5),
        "g_cross": gain(ks[11], (L, D)),
        "g_mem": gain(ks[12], (L, D)),
        "w_cq": nrm(ks[13], (L, D, D), D ** -0.5),
        "w_ckv": nrm(ks[14], (L, D, 2 * D), D ** -0.5),
        "w_co": nrm(ks[15], (L, D, D), D ** -0.5),
        "g_peer": gain(ks[16], (L, D)),
        "w_pq": nrm(ks[17], (L, D, PEER_HEADS * PEER_QDIM), D ** -0.5),
        "peer_subkeys": nrm(ks[18], (L, PEER_HEADS, 2, PEER_KEYS, PEER_QDIM // 2), (PEER_QDIM // 2) ** -0.5),
        "peer_u": nrm(ks[19], (L, PEER_EXPERTS, D), D ** -0.5),
        "peer_v": nrm(ks[20], (L, PEER_EXPERTS, D), PEER_HEADS ** -0.5),
        "g_final": gain(ks[21], (D,)),
    }


def reference(x, mem, g_mix, w_in, gdn_conv, gdn_a_log, gdn_dt_bias, gdn_norm_g, w_sb_up, w_gdn_up,
              w_mix_out, g_cross, g_mem, w_cq, w_ckv, w_co, g_peer, w_pq, peer_subkeys, peer_u, peer_v,
              g_final):
    for l in range(DEPTH):
        x = x + token_mixer(rmsnorm(x, g_mix[l]), w_in[l], gdn_conv[l], gdn_a_log[l], gdn_dt_bias[l],
                            gdn_norm_g[l], w_sb_up[l], w_gdn_up[l], w_mix_out[l])
        x = x + memory_cross_attention(rmsnorm(x, g_cross[l]), rmsnorm(mem, g_mem[l]),
                                       w_cq[l], w_ckv[l], w_co[l])
        x = x + peer(rmsnorm(x, g_peer[l]), w_pq[l], peer_subkeys[l], peer_u[l], peer_v[l])
    return rmsnorm(x, g_final)
```

```cpp
#include <hip/hip_runtime.h>
#include <stdint.h>
#include <cstdio>

typedef unsigned short bf16_t;
__device__ __forceinline__ float bf2f(bf16_t v) { return __uint_as_float(((unsigned)v) << 16); }
__device__ __forceinline__ bf16_t f2bf(float f) { unsigned u = __float_as_uint(f); return (bf16_t)((u + 0x7fffu + ((u >> 16) & 1u)) >> 16); }

constexpr int T = 32768, D = 1024, SEQ = 8192, NB = 4;
constexpr int IN_COLS = 5640;
constexpr float EPS = 1e-6f;
constexpr size_t MiB = 1u << 20;

__device__ __forceinline__ float wave_sum(float v) {
#pragma unroll
    for (int o = 1; o < 64; o <<= 1) v += __shfl_xor(v, o);
    return v;
}
__device__ __forceinline__ float sigmoidf_(float x) { return 1.f / (1.f + __expf(-x)); }
__device__ __forceinline__ float softplusf_(float x) { return fmaxf(x, 0.f) + log1pf(__expf(-fabsf(x))); }

__global__ void __launch_bounds__(256) k_rows(const float* in, int nrows, const float* gain, bf16_t* outb, float* rstd_out) {
    const int row = blockIdx.x * 4 + (threadIdx.x >> 6), lane = threadIdx.x & 63;
    if (row >= nrows) return;
    const float4* p = (const float4*)(in + (size_t)row * D);
    float4 v[4]; float s = 0.f;
#pragma unroll
    for (int j = 0; j < 4; ++j) { v[j] = p[lane + 64 * j]; s += v[j].x * v[j].x + v[j].y * v[j].y + v[j].z * v[j].z + v[j].w * v[j].w; }
    s = wave_sum(s);
    const float rstd = rsqrtf(s * (1.f / D) + EPS);
    if (rstd_out && lane == 0) rstd_out[row] = rstd;
    if (outb) {
#pragma unroll
        for (int j = 0; j < 4; ++j) {
            const int c = (lane + 64 * j) * 4;
            float4 o = v[j];
            if (gain) { const float4 g = *(const float4*)(gain + c); o.x *= rstd * g.x; o.y *= rstd * g.y; o.z *= rstd * g.z; o.w *= rstd * g.w; }
            bf16_t* q = outb + (size_t)row * D + c;
            q[0] = f2bf(o.x); q[1] = f2bf(o.y); q[2] = f2bf(o.z); q[3] = f2bf(o.w);
        }
    }
}

template <class Epi>
__global__ void __launch_bounds__(256) k_gemm_naive(const bf16_t* A, int lda, const float* W, int ldw, const float* gain, int M, int N, int K, Epi epi) {
    __shared__ float As[16][65];
    __shared__ float Bs[16][65];
    const int tx = threadIdx.x & 15, ty = threadIdx.x >> 4;
    const int row0 = blockIdx.y * 64, col0 = blockIdx.x * 64;
    float acc[4][4];
#pragma unroll
    for (int i = 0; i < 4; ++i)
#pragma unroll
        for (int j = 0; j < 4; ++j) acc[i][j] = 0.f;
    for (int k0 = 0; k0 < K; k0 += 16) {
#pragma unroll
        for (int i = 0; i < 4; ++i) { const int idx = threadIdx.x + i * 256; const int r = idx >> 4, kk = idx & 15; As[kk][r] = bf2f(A[(size_t)(row0 + r) * lda + k0 + kk]); }
#pragma unroll
        for (int i = 0; i < 4; ++i) { const int idx = threadIdx.x + i * 256; const int kk = idx >> 6, c = idx & 63;
            float w = (col0 + c < N) ? W[(size_t)(k0 + kk) * ldw + col0 + c] : 0.f; if (gain) w *= gain[k0 + kk]; Bs[kk][c] = w; }
        __syncthreads();
#pragma unroll
        for (int kk = 0; kk < 16; ++kk) {
            float a[4], b[4];
#pragma unroll
            for (int i = 0; i < 4; ++i) { a[i] = As[kk][ty * 4 + i]; b[i] = Bs[kk][tx * 4 + i]; }
#pragma unroll
            for (int i = 0; i < 4; ++i)
#pragma unroll
                for (int j = 0; j < 4; ++j) acc[i][j] += a[i] * b[j];
        }
        __syncthreads();
    }
#pragma unroll
    for (int i = 0; i < 4; ++i)
#pragma unroll
        for (int j = 0; j < 4; ++j) { const int r = row0 + ty * 4 + i, c = col0 + tx * 4 + j; if (c < N) epi(r, c, acc[i][j]); }
}

struct EpiProj {
    const float* rstd; bf16_t *SBQ, *SBK, *SBV, *GQKV, *GZ, *GSB, *GGDN; float *GB, *GA;
    __device__ void operator()(int r, int c, float v) const {
        v *= rstd[r];
        if (c < 512) SBQ[(size_t)r * 512 + c] = f2bf(v);
        else if (c < 1024) SBK[(size_t)r * 512 + c - 512] = f2bf(v);
        else if (c < 1536) SBV[(size_t)r * 512 + c - 1024] = f2bf(v);
        else if (c < 3072) GQKV[(size_t)r * 1536 + c - 1536] = f2bf(v);
        else if (c < 3584) GZ[(size_t)r * 512 + c - 3072] = f2bf(v);
        else if (c < 3588) GB[(size_t)r * 4 + c - 3584] = v;
        else if (c < 3592) GA[(size_t)r * 4 + c - 3588] = v;
        else if (c < 4616) GSB[(size_t)r * 1024 + c - 3592] = f2bf(v);
        else GGDN[(size_t)r * 1024 + c - 4616] = f2bf(v);
    }
};
struct EpiKV { bf16_t *KC, *VC;
    __device__ void operator()(int r, int c, float v) const { if (c < 1024) KC[(size_t)r * 1024 + c] = f2bf(v); else VC[(size_t)r * 1024 + c - 1024] = f2bf(v); } };
struct EpiMerge { const bf16_t* gate; bf16_t* M; int add;
    __device__ void operator()(int r, int c, float v) const { const size_t i = (size_t)r * 1024 + c; float o = sigmoidf_(bf2f(gate[i])) * v; if (add) o += bf2f(M[i]); M[i] = f2bf(o); } };
struct EpiRes { const float* xin; float* xout;
    __device__ void operator()(int r, int c, float v) const { const size_t i = (size_t)r * 1024 + c; xout[i] = xin[i] + v; } };
struct EpiScale { const float* rstd; bf16_t* O; int ldo;
    __device__ void operator()(int r, int c, float v) const { O[(size_t)r * ldo + c] = f2bf(v * rstd[r]); } };

__global__ void __launch_bounds__(64) k_sb_naive(const bf16_t* SBQ, const bf16_t* SBK, const bf16_t* SBV, bf16_t* OSB) {
    const int gid = blockIdx.x * 64 + threadIdx.x;
    const int t = gid & 8191, h = (gid >> 13) & 7, b = gid >> 16;
    const size_t rowq = (size_t)(b * SEQ + t) * 512 + h * 64;
    float q[64], o[64];
#pragma unroll
    for (int d = 0; d < 64; ++d) { q[d] = bf2f(SBQ[rowq + d]) * 0.125f; o[d] = 0.f; }
    float carry = 0.f;
    for (int s = t - 1; s >= 0; --s) {
        const size_t rk = (size_t)(b * SEQ + s) * 512 + h * 64;
        float z = 0.f;
#pragma unroll
        for (int d = 0; d < 64; ++d) z += q[d] * bf2f(SBK[rk + d]);
        const float sp = softplusf_(z);
        const float a = __expf(z - sp + carry);
#pragma unroll
        for (int d = 0; d < 64; ++d) o[d] += a * bf2f(SBV[rk + d]);
        carry -= sp;
        if (carry < -104.f) break;
    }
#pragma unroll
    for (int d = 0; d < 64; ++d) OSB[rowq + d] = f2bf(o[d]);
}

__global__ void __launch_bounds__(128) k_gdn_prep(const bf16_t* GQKV, const float* conv, bf16_t* CQ, bf16_t* CK, bf16_t* CV) {
    __shared__ float red[2][2];
    const int t = blockIdx.x >> 2, h = blockIdx.x & 3, d = threadIdx.x;
    const int tl = t & (SEQ - 1);
    float y[3];
#pragma unroll
    for (int part = 0; part < 3; ++part) {
        const int ch = part * 512 + h * 128 + d;
        float acc = 0.f;
#pragma unroll
        for (int j = 0; j < 4; ++j) { const int dt = j - 3; if (tl + dt >= 0) acc += bf2f(GQKV[(size_t)(t + dt) * 1536 + ch]) * conv[j * 1536 + ch]; }
        y[part] = acc / (1.f + __expf(-acc));
    }
    float sq = wave_sum(y[0] * y[0]), sk = wave_sum(y[1] * y[1]);
    if ((threadIdx.x & 63) == 0) { red[threadIdx.x >> 6][0] = sq; red[threadIdx.x >> 6][1] = sk; }
    __syncthreads();
    sq = red[0][0] + red[1][0]; sk = red[0][1] + red[1][1];
    const size_t o = (size_t)t * 512 + h * 128 + d;
    CQ[o] = f2bf(y[0] * rsqrtf(sq + EPS)); CK[o] = f2bf(y[1] * rsqrtf(sk + EPS)); CV[o] = f2bf(y[2]);
}
__global__ void __launch_bounds__(64) k_gdn_scan(const bf16_t* CQ, const bf16_t* CK, const bf16_t* CV, const float* GB, const float* GA,
                                                  const float* a_log, const float* dt_bias, float* OGRAW) {
    const int sl = blockIdx.x & 7, h = (blockIdx.x >> 3) & 3, b = blockIdx.x >> 5;
    const int lane = threadIdx.x, rg = lane >> 4, e = lane & 15;
    float S[32];
#pragma unroll
    for (int i = 0; i < 32; ++i) S[i] = 0.f;
    const float na = -__expf(a_log[h]), dtb = dt_bias[h];
    const size_t base = (size_t)b * SEQ;
    uint4 kn[4], qn[4];
    {
        const uint4* pk = (const uint4*)(CK + base * 512 + h * 128 + rg * 32);
        const uint4* pq = (const uint4*)(CQ + base * 512 + h * 128 + rg * 32);
#pragma unroll
        for (int i = 0; i < 4; ++i) { kn[i] = pk[i]; qn[i] = pq[i]; }
    }
    for (int t = 0; t < SEQ; ++t) {
        const size_t tg = base + t;
        uint4 kc[4], qc[4];
#pragma unroll
        for (int i = 0; i < 4; ++i) { kc[i] = kn[i]; qc[i] = qn[i]; }
        if (t + 1 < SEQ) {
            const uint4* pk = (const uint4*)(CK + (tg + 1) * 512 + h * 128 + rg * 32);
            const uint4* pq = (const uint4*)(CQ + (tg + 1) * 512 + h * 128 + rg * 32);
#pragma unroll
            for (int i = 0; i < 4; ++i) { kn[i] = pk[i]; qn[i] = pq[i]; }
        }
        const float v = bf2f(CV[tg * 512 + h * 128 + sl * 16 + e]);
        const float beta = sigmoidf_(GB[tg * 4 + h]);
        const float alpha = __expf(na * softplusf_(GA[tg * 4 + h] + dtb));
        float kk[32], qq[32];
#pragma unroll
        for (int i = 0; i < 4; ++i) {
            const unsigned w[4] = {kc[i].x, kc[i].y, kc[i].z, kc[i].w}, u[4] = {qc[i].x, qc[i].y, qc[i].z, qc[i].w};
#pragma unroll
            for (int j = 0; j < 4; ++j) { kk[i * 8 + 2 * j] = __uint_as_float(w[j] << 16); kk[i * 8 + 2 * j + 1] = __uint_as_float(w[j] & 0xffff0000u);
                                         qq[i * 8 + 2 * j] = __uint_as_float(u[j] << 16); qq[i * 8 + 2 * j + 1] = __uint_as_float(u[j] & 0xffff0000u); }
        }
        float ks = 0.f;
#pragma unroll
        for (int i = 0; i < 32; ++i) { S[i] *= alpha; ks += kk[i] * S[i]; }
        ks += __shfl_xor(ks, 16); ks += __shfl_xor(ks, 32);
        const float vn = beta * (v - ks);
        float o = 0.f;
#pragma unroll
        for (int i = 0; i < 32; ++i) { S[i] += kk[i] * vn; o += qq[i] * S[i]; }
        o += __shfl_xor(o, 16); o += __shfl_xor(o, 32);
        if (rg == 0) OGRAW[tg * 512 + h * 128 + sl * 16 + e] = o * 0.08838834764831845f;
    }
}
__global__ void __launch_bounds__(128) k_gdn_finish(const float* OGRAW, const bf16_t* GZ, const float* gn, bf16_t* OG) {
    __shared__ float red[2];
    const int t = blockIdx.x >> 2, h = blockIdx.x & 3, d = threadIdx.x;
    const size_t i = (size_t)t * 512 + h * 128 + d;
    const float o = OGRAW[i];
    const float s = wave_sum(o * o);
    if ((threadIdx.x & 63) == 0) red[threadIdx.x >> 6] = s;
    __syncthreads();
    const float ms = (red[0] + red[1]) * (1.f / 128.f);
    const float z = bf2f(GZ[i]);
    OG[i] = f2bf(o * rsqrtf(ms + EPS) * gn[d] * (z / (1.f + __expf(-z))));
}

__global__ void __launch_bounds__(256) k_cross_naive(const bf16_t* QC, const bf16_t* KC, const bf16_t* VC, bf16_t* OC) {
    __shared__ float qs[4][256];
    __shared__ float ps[4][256];
    const int t = blockIdx.x, h = threadIdx.x >> 6, lane = threadIdx.x & 63, b = t / SEQ;
    for (int j = 0; j < 4; ++j) qs[h][lane + 64 * j] = bf2f(QC[(size_t)t * 1024 + h * 256 + lane + 64 * j]);
    __syncthreads();
    float sc[4]; float mx = -1e30f;
#pragma unroll
    for (int j = 0; j < 4; ++j) {
        const int m = lane + 64 * j;
        const bf16_t* kr = KC + (size_t)(b * 256 + m) * 1024 + h * 256;
        float s = 0.f;
        for (int d = 0; d < 256; ++d) s += qs[h][d] * bf2f(kr[d]);
        sc[j] = s * 0.0625f; mx = fmaxf(mx, sc[j]);
    }
#pragma unroll
    for (int o = 1; o < 64; o <<= 1) mx = fmaxf(mx, __shfl_xor(mx, o));
    float l = 0.f;
#pragma unroll
    for (int j = 0; j < 4; ++j) { sc[j] = __expf(sc[j] - mx); l += sc[j]; }
    l = wave_sum(l);
    const float il = 1.f / l;
#pragma unroll
    for (int j = 0; j < 4; ++j) ps[h][lane + 64 * j] = sc[j] * il;
    __syncthreads();
    float o[4] = {0.f, 0.f, 0.f, 0.f};
    for (int m = 0; m < 256; ++m) {
        const float p = ps[h][m];
        const bf16_t* vr = VC + (size_t)(b * 256 + m) * 1024 + h * 256 + lane * 4;
#pragma unroll
        for (int j = 0; j < 4; ++j) o[j] += p * bf2f(vr[j]);
    }
#pragma unroll
    for (int j = 0; j < 4; ++j) OC[(size_t)t * 1024 + h * 256 + lane * 4 + j] = f2bf(o[j]);
}

__global__ void __launch_bounds__(256) k_peer_route(const bf16_t* PQ, const float* subkeys, int* EIDX, float* EGATE) {
    __shared__ float q[2048];
    __shared__ float sc[2048];
    __shared__ float tops[16][16];
    __shared__ int topi[16][16];
    const int t = blockIdx.x, tid = threadIdx.x, w = tid >> 6, lane = tid & 63;
    for (int i = tid; i < 2048; i += 256) q[i] = bf2f(PQ[(size_t)t * 2048 + i]);
    __syncthreads();
    for (int i = tid; i < 2048; i += 256) {
        const int hp = i >> 7;
        const float* sk = subkeys + (size_t)i * 128;
        float s = 0.f;
        for (int d = 0; d < 128; ++d) s += q[hp * 128 + d] * sk[d];
        sc[i] = s;
    }
    __syncthreads();
    for (int g = w * 4; g < w * 4 + 4; ++g) {
        float v0 = sc[g * 128 + lane], v1 = sc[g * 128 + lane + 64];
        for (int r = 0; r < 16; ++r) {
            float bv; int bi;
            if (v0 >= v1) { bv = v0; bi = lane; } else { bv = v1; bi = lane + 64; }
#pragma unroll
            for (int o = 1; o < 64; o <<= 1) { const float ov = __shfl_xor(bv, o); const int oi = __shfl_xor(bi, o); if (ov > bv || (ov == bv && oi < bi)) { bv = ov; bi = oi; } }
            if (lane == 0) { tops[g][r] = bv; topi[g][r] = bi; }
            if (bi == lane) v0 = -INFINITY; if (bi == lane + 64) v1 = -INFINITY;
        }
    }
    __syncthreads();
    for (int hh = w * 2; hh < w * 2 + 2; ++hh) {
        float cv[4];
#pragma unroll
        for (int c = 0; c < 4; ++c) { const int pos = lane * 4 + c; cv[c] = tops[hh * 2][pos >> 4] + tops[hh * 2 + 1][pos & 15]; }
        float bs[16]; int bp[16];
#pragma unroll
        for (int r = 0; r < 16; ++r) {
            float bv = cv[0]; int bi = lane * 4;
#pragma unroll
            for (int c = 1; c < 4; ++c) if (cv[c] > bv) { bv = cv[c]; bi = lane * 4 + c; }
#pragma unroll
            for (int o = 1; o < 64; o <<= 1) { const float ov = __shfl_xor(bv, o); const int oi = __shfl_xor(bi, o); if (ov > bv || (ov == bv && oi < bi)) { bv = ov; bi = oi; } }
            bs[r] = bv; bp[r] = bi;
#pragma unroll
            for (int c = 0; c < 4; ++c) if (bi == lane * 4 + c) cv[c] = -INFINITY;
        }
        float l = 0.f; const float bmax = bs[0];
#pragma unroll
        for (int r = 0; r < 16; ++r) { bs[r] = __expf(bs[r] - bmax); l += bs[r]; }
        if (lane < 16) {
            float g = 0.f; int pos = 0;
#pragma unroll
            for (int r = 0; r < 16; ++r) if (r == lane) { g = bs[r] / l; pos = bp[r]; }
            EIDX[(size_t)t * 128 + hh * 16 + lane] = topi[hh * 2][pos >> 4] * 128 + topi[hh * 2 + 1][pos & 15];
            EGATE[(size_t)t * 128 + hh * 16 + lane] = g;
        }
    }
}

__global__ void __launch_bounds__(256) k_peer_final(const float* X2, const float* rstd2, const float* g_peer, const int* EIDX, const float* EGATE,
                                                     const float* U, const float* V, const float* g_final, float* out) {
    __shared__ float acts[4][128];
    const int t = blockIdx.x * 4 + (threadIdx.x >> 6), w = threadIdx.x >> 6, lane = threadIdx.x & 63;
    const float4* xr = (const float4*)(X2 + (size_t)t * D);
    float4 x[4], xn[4];
    const float rs = rstd2[t];
#pragma unroll
    for (int j = 0; j < 4; ++j) { x[j] = xr[lane + 64 * j]; const float4 g = ((const float4*)g_peer)[lane + 64 * j];
        xn[j].x = x[j].x * rs * g.x; xn[j].y = x[j].y * rs * g.y; xn[j].z = x[j].z * rs * g.z; xn[j].w = x[j].w * rs * g.w; }
    for (int k = 0; k < 128; ++k) {
        const int e = EIDX[(size_t)t * 128 + k];
        const float4* ur = (const float4*)(U + (size_t)e * D);
        float s = 0.f;
#pragma unroll
        for (int j = 0; j < 4; ++j) { const float4 u = ur[lane + 64 * j]; s += u.x * xn[j].x + u.y * xn[j].y + u.z * xn[j].z + u.w * xn[j].w; }
        s = wave_sum(s);
        const float a = 0.5f * s * (1.f + erff(s * 0.70710678118654752f)) * EGATE[(size_t)t * 128 + k];
        if (lane == 0) acts[w][k] = a;
    }
    __syncthreads();
    for (int k = 0; k < 128; ++k) {
        const int e = EIDX[(size_t)t * 128 + k];
        const float a = acts[w][k];
        const float4* vr = (const float4*)(V + (size_t)e * D);
#pragma unroll
        for (int j = 0; j < 4; ++j) { const float4 v = vr[lane + 64 * j]; x[j].x += a * v.x; x[j].y += a * v.y; x[j].z += a * v.z; x[j].w += a * v.w; }
    }
    float s = 0.f;
#pragma unroll
    for (int j = 0; j < 4; ++j) s += x[j].x * x[j].x + x[j].y * x[j].y + x[j].z * x[j].z + x[j].w * x[j].w;
    s = wave_sum(s);
    const float r3 = rsqrtf(s * (1.f / D) + EPS);
    float4* orow = (float4*)(out + (size_t)t * D);
#pragma unroll
    for (int j = 0; j < 4; ++j) { const float4 g = ((const float4*)g_final)[lane + 64 * j];
        float4 o; o.x = x[j].x * r3 * g.x; o.y = x[j].y * r3 * g.y; o.z = x[j].z * r3 * g.z; o.w = x[j].w * r3 * g.w; orow[lane + 64 * j] = o; }
}

extern "C" void kernel_launch(void* const* d_in, const int* in_sizes, int n_in, void* d_out, int out_size, void* d_ws, size_t ws_size, hipStream_t stream) {
    if (n_in != 22 || ws_size < 512 * MiB) { fprintf(stderr, "kernel_launch: unexpected n_in %d / ws %zu\n", n_in, ws_size); return; }
    const float* x = (const float*)d_in[0]; const float* mem = (const float*)d_in[1]; const float* g_mix = (const float*)d_in[2]; const float* w_in = (const float*)d_in[3];
    const float* gdn_conv = (const float*)d_in[4]; const float* a_log = (const float*)d_in[5]; const float* dt_bias = (const float*)d_in[6]; const float* gdn_norm_g = (const float*)d_in[7];
    const float* w_sb_up = (const float*)d_in[8]; const float* w_gdn_up = (const float*)d_in[9]; const float* w_mix_out = (const float*)d_in[10]; const float* g_cross = (const float*)d_in[11];
    const float* g_mem = (const float*)d_in[12]; const float* w_cq = (const float*)d_in[13]; const float* w_ckv = (const float*)d_in[14]; const float* w_co = (const float*)d_in[15];
    const float* g_peer = (const float*)d_in[16]; const float* w_pq = (const float*)d_in[17]; const float* subkeys = (const float*)d_in[18]; const float* peer_u = (const float*)d_in[19];
    const float* peer_v = (const float*)d_in[20]; const float* g_final = (const float*)d_in[21];
    float* out = (float*)d_out; char* ws = (char*)d_ws; char* ob = (char*)d_out;
    float* rstd0 = (float*)(ws + 94 * MiB); float* rstd1 = rstd0 + T; float* rstd2 = rstd1 + T;
    float* GB = (float*)(ws + 95 * MiB); float* GA = GB + T * 4;
    bf16_t* MN = (bf16_t*)(ws + 96 * MiB); bf16_t* KC = (bf16_t*)(ws + 98 * MiB); bf16_t* VC = (bf16_t*)(ws + 100 * MiB);
    bf16_t* XB = (bf16_t*)(ws + 104 * MiB);
    bf16_t* CQ = (bf16_t*)(ws + 104 * MiB); bf16_t* CK = (bf16_t*)(ws + 136 * MiB); bf16_t* CV = (bf16_t*)(ws + 424 * MiB);
    bf16_t* MERGED = (bf16_t*)(ws + 104 * MiB); bf16_t* X2B = (bf16_t*)(ws + 104 * MiB);
    bf16_t* GQKV = (bf16_t*)(ws + 168 * MiB);
    float* OGRAW = (float*)(ws + 168 * MiB); bf16_t* OG = (bf16_t*)(ws + 232 * MiB); bf16_t* X1B = (bf16_t*)(ws + 168 * MiB); bf16_t* PQ = (bf16_t*)(ws + 168 * MiB);
    bf16_t* GZ = (bf16_t*)(ws + 264 * MiB);
    bf16_t* GSB = (bf16_t*)(ws + 296 * MiB); bf16_t* GGDN = (bf16_t*)(ws + 360 * MiB);
    bf16_t* QC = (bf16_t*)(ws + 296 * MiB); bf16_t* OC = (bf16_t*)(ws + 360 * MiB);
    int* EIDX = (int*)(ws + 296 * MiB); float* EGATE = (float*)(ws + 312 * MiB);
    bf16_t* SBQ = (bf16_t*)ob; bf16_t* SBK = (bf16_t*)(ob + 32 * MiB); bf16_t* SBV = (bf16_t*)(ob + 64 * MiB); bf16_t* OSB = (bf16_t*)(ob + 96 * MiB);

    k_rows<<<T / 4, 256, 0, stream>>>(x, T, nullptr, XB, rstd0);
    k_rows<<<1024 / 4, 256, 0, stream>>>(mem, 1024, g_mem, MN, nullptr);
    { EpiProj e{rstd0, SBQ, SBK, SBV, GQKV, GZ, GSB, GGDN, GB, GA};
      k_gemm_naive<EpiProj><<<dim3((IN_COLS + 63) / 64, T / 64), 256, 0, stream>>>(XB, D, w_in, IN_COLS, g_mix, T, IN_COLS, D, e); }
    { EpiKV e{KC, VC}; k_gemm_naive<EpiKV><<<dim3(2048 / 64, 1024 / 64), 256, 0, stream>>>(MN, D, w_ckv, 2048, nullptr, 1024, 2048, D, e); }
    k_sb_naive<<<T * 8 / 64, 64, 0, stream>>>(SBQ, SBK, SBV, OSB);
    k_gdn_prep<<<T * 4, 128, 0, stream>>>(GQKV, gdn_conv, CQ, CK, CV);
    k_gdn_scan<<<128, 64, 0, stream>>>(CQ, CK, CV, GB, GA, a_log, dt_bias, OGRAW);
    k_gdn_finish<<<T * 4, 128, 0, stream>>>(OGRAW, GZ, gdn_norm_g, OG);
    { EpiMerge e{GSB, MERGED, 0}; k_gemm_naive<EpiMerge><<<dim3(1024 / 64, T / 64), 256, 0, stream>>>(OSB, 512, w_sb_up, 1024, nullptr, T, 1024, 512, e); }
    { EpiMerge e{GGDN, MERGED, 1}; k_gemm_naive<EpiMerge><<<dim3(1024 / 64, T / 64), 256, 0, stream>>>(OG, 512, w_gdn_up, 1024, nullptr, T, 1024, 512, e); }
    { EpiRes e{x, out}; k_gemm_naive<EpiRes><<<dim3(1024 / 64, T / 64), 256, 0, stream>>>(MERGED, 1024, w_mix_out, 1024, nullptr, T, 1024, 1024, e); }
    k_rows<<<T / 4, 256, 0, stream>>>(out, T, nullptr, X1B, rstd1);
    { EpiScale e{rstd1, QC, 1024}; k_gemm_naive<EpiScale><<<dim3(1024 / 64, T / 64), 256, 0, stream>>>(X1B, 1024, w_cq, 1024, g_cross, T, 1024, 1024, e); }
    k_cross_naive<<<T, 256, 0, stream>>>(QC, KC, VC, OC);
    { EpiRes e{out, out}; k_gemm_naive<EpiRes><<<dim3(1024 / 64, T / 64), 256, 0, stream>>>(OC, 1024, w_co, 1024, nullptr, T, 1024, 1024, e); }
    k_rows<<<T / 4, 256, 0, stream>>>(out, T, nullptr, X2B, rstd2);
    { EpiScale e{rstd2, PQ, 2048}; k_gemm_naive<EpiScale><<<dim3(2048 / 64, T / 64), 256, 0, stream>>>(X2B, 1024, w_pq, 2048, g_peer, T, 2048, 1024, e); }
    k_peer_route<<<T, 256, 0, stream>>>(PQ, subkeys, EIDX, EGATE);
    k_peer_final<<<T / 4, 256, 0, stream>>>(out, rstd2, g_peer, EIDX, EGATE, peer_u, peer_v, g_final, out);
}
```

```cpp
#include <hip/hip_runtime.h>
#include <stdint.h>
#include <cstdio>

typedef unsigned short bf16_t;
__device__ __forceinline__ float bf2f(bf16_t v) { return __uint_as_float(((unsigned)v) << 16); }
__device__ __forceinline__ bf16_t f2bf(float f) { unsigned u = __float_as_uint(f); return (bf16_t)((u + 0x7fffu + ((u >> 16) & 1u)) >> 16); }

constexpr int T = 32768, D = 1024, SEQ = 8192, NB = 4;
constexpr int IN_COLS = 5640, NPROJ = 5632;
constexpr float EPS = 1e-6f;
constexpr size_t MiB = 1u << 20;

__device__ __forceinline__ float wave_sum(float v) {
#pragma unroll
    for (int o = 1; o < 64; o <<= 1) v += __shfl_xor(v, o);
    return v;
}
__device__ __forceinline__ float sigmoidf_(float x) { return 1.f / (1.f + __expf(-x)); }
__device__ __forceinline__ float softplusf_(float x) { return fmaxf(x, 0.f) + log1pf(__expf(-fabsf(x))); }

namespace pg8 {
#define PG8_LAS __attribute__((address_space(3)))
typedef unsigned short bf16_t;
typedef short bf16x8 __attribute__((ext_vector_type(8)));
typedef float f32x4 __attribute__((ext_vector_type(4)));
typedef unsigned u32x4 __attribute__((ext_vector_type(4)));
constexpr int BM = 256, BK = 64, HALF = 128, HTB = HALF * BK * 2  , STAGE_BYTES = 8 * HTB, NXCD = 8, WGM = 8;

__host__ __device__ __forceinline__ int lds_byte(int r, int c) { const int st = (r >> 4) * 2 + (c >> 5), rr = r & 15, cc = c & 31, ob = rr * 64 + cc * 2; return st * 1024 + (ob ^ (((ob >> 9) & 1) << 5)); }
__host__ __device__ __forceinline__ void stage_rc(int b, int& R, int& C) { const int st = b / 1024, sb = b % 1024, swz = sb ^ (((sb >> 9) & 1) << 5); R = (st >> 1) * 16 + swz / 64; C = (st & 1) * 32 + (swz % 64) / 2; }
__host__ __device__ __forceinline__ int perm32(int rho) { const int n = rho >> 4, i = rho & 15; return 8 * (i >> 2) + 4 * n + (i & 3); }

struct Unit { int pm, pn; };
struct Gemm { const bf16_t* A; const bf16_t* Bt; int M, N, K; };

struct StaticOrder {
    int nM, nN, nwg, G, c;
    __host__ __device__ __forceinline__ void init(int M, int N, int G_, int c_) { nM = M / BM; nN = N / BM; nwg = nM * nN; G = G_; c = c_; }
    __host__ __device__ __forceinline__ bool next(int i, Unit& u) const {
        const long L = (long)i * G + c; if (L >= nwg) return false;
        int wgid = (int)L; { const int q = nwg / NXCD, r = nwg % NXCD, xcd = wgid % NXCD, off = wgid / NXCD; wgid = (xcd < r ? xcd * (q + 1) : r * (q + 1) + (xcd - r) * q) + off; }
        const int nig = WGM * nN, gid = wgid / nig, fm = gid * WGM, gsz = (nM - fm) < WGM ? (nM - fm) : WGM;
        u.pm = fm + ((wgid % nig) % gsz); u.pn = (wgid % nig) / gsz; return true;
    }
    __device__ __forceinline__ void a_ready(const Unit&) const {}
    __device__ __forceinline__ void done(const Unit&) const {}
};

__device__ __forceinline__ unsigned cvt_pk_bf16(float lo, float hi) { unsigned r; asm volatile("v_cvt_pk_bf16_f32 %0, %1, %2" : "=v"(r) : "v"(lo), "v"(hi)); return r; }
typedef float f32x2 __attribute__((ext_vector_type(2)));
__device__ __forceinline__ float bfl(unsigned w) { return __uint_as_float(w << 16); }
__device__ __forceinline__ float bfh(unsigned w) { return __uint_as_float(w & 0xffff0000u); }
struct EpiProj {
    static constexpr bool PERM = true, AFTER_DRAIN = false;
    const float* rstd; bf16_t *SBQ, *SBK, *SBV, *GQKV, *GZ, *GSB, *GGDN;
    __device__ __forceinline__ void operator()(const f32x4 (&acc)[2][2][4][2], const Unit& u, int wr, int wc, int fr, int fq) const {
        const int pn = u.pn; bf16_t* base; int ld, coff;
        if (pn < 2) { base = SBQ; ld = 512; coff = pn * 256; } else if (pn < 4) { base = SBK; ld = 512; coff = (pn - 2) * 256; } else if (pn < 6) { base = SBV; ld = 512; coff = (pn - 4) * 256; }
        else if (pn < 12) { base = GQKV; ld = 1536; coff = (pn - 6) * 256; } else if (pn < 14) { base = GZ; ld = 512; coff = (pn - 12) * 256; }
        else if (pn < 18) { base = GSB; ld = 1024; coff = (pn - 14) * 256; } else { base = GGDN; ld = 1024; coff = (pn - 18) * 256; }
        const int row0 = u.pm * BM + wr * 64 + fr, col0 = coff + wc * 32 + 8 * fq;
#pragma unroll
        for (int ai = 0; ai < 2; ++ai)
#pragma unroll
            for (int m = 0; m < 4; ++m) { const int row = row0 + ai * HALF + m * 16; const float rs = rstd[row]; bf16_t* rowp = base + (size_t)row * ld + col0;
#pragma unroll
                for (int bj = 0; bj < 2; ++bj) { const f32x4 v0 = acc[ai][bj][m][0] * rs, v1 = acc[ai][bj][m][1] * rs;
                    u32x4 w; w.x = cvt_pk_bf16(v0[0], v0[1]); w.y = cvt_pk_bf16(v0[2], v0[3]); w.z = cvt_pk_bf16(v1[0], v1[1]); w.w = cvt_pk_bf16(v1[2], v1[3]);
                    *(u32x4*)(rowp + bj * HALF) = w; } }
    }
};
struct EpiSplit {
    static constexpr bool PERM = true, AFTER_DRAIN = false;
    bf16_t *O0, *O1; int ldc, split_tiles;
    __device__ __forceinline__ void operator()(const f32x4 (&acc)[2][2][4][2], const Unit& u, int wr, int wc, int fr, int fq) const {
        bf16_t* base = u.pn < split_tiles ? O0 : O1; const int coff = (u.pn < split_tiles ? u.pn : u.pn - split_tiles) * 256;
        const int row0 = u.pm * BM + wr * 64 + fr, col0 = coff + wc * 32 + 8 * fq;
#pragma unroll
        for (int ai = 0; ai < 2; ++ai)
#pragma unroll
            for (int m = 0; m < 4; ++m) { bf16_t* rowp = base + (size_t)(row0 + ai * HALF + m * 16) * ldc + col0;
#pragma unroll
                for (int bj = 0; bj < 2; ++bj) { const f32x4 v0 = acc[ai][bj][m][0], v1 = acc[ai][bj][m][1];
                    u32x4 w; w.x = cvt_pk_bf16(v0[0], v0[1]); w.y = cvt_pk_bf16(v0[2], v0[3]); w.z = cvt_pk_bf16(v1[0], v1[1]); w.w = cvt_pk_bf16(v1[2], v1[3]);
                    *(u32x4*)(rowp + bj * HALF) = w; } }
    }
};
template <bool ADD> struct EpiMerge {
    static constexpr bool PERM = true, AFTER_DRAIN = false;
    const bf16_t* gate; bf16_t* M;
    __device__ __forceinline__ void operator()(const f32x4 (&acc)[2][2][4][2], const Unit& u, int wr, int wc, int fr, int fq) const {
        const int row0 = u.pm * BM + wr * 64 + fr, col0 = u.pn * BM + wc * 32 + 8 * fq;
#pragma unroll
        for (int ai = 0; ai < 2; ++ai)
#pragma unroll
            for (int m = 0; m < 4; ++m) { const size_t ro = (size_t)(row0 + ai * HALF + m * 16) * 1024 + col0;
#pragma unroll
                for (int bj = 0; bj < 2; ++bj) { const size_t o = ro + bj * HALF; const u32x4 g = *(const u32x4*)(gate + o);
                    float gv[8] = {bfl(g.x), bfh(g.x), bfl(g.y), bfh(g.y), bfl(g.z), bfh(g.z), bfl(g.w), bfh(g.w)};
                    float pv[8] = {0.f, 0.f, 0.f, 0.f, 0.f, 0.f, 0.f, 0.f};
                    if (ADD) { const u32x4 p = *(const u32x4*)(M + o); pv[0] = bfl(p.x); pv[1] = bfh(p.x); pv[2] = bfl(p.y); pv[3] = bfh(p.y); pv[4] = bfl(p.z); pv[5] = bfh(p.z); pv[6] = bfl(p.w); pv[7] = bfh(p.w); }
                    float r[8];
#pragma unroll
                    for (int j = 0; j < 8; ++j) { const float a = j < 4 ? acc[ai][bj][m][0][j] : acc[ai][bj][m][1][j - 4]; r[j] = pv[j] + a * __builtin_amdgcn_rcpf(1.f + __expf(-gv[j])); }
                    u32x4 w; w.x = cvt_pk_bf16(r[0], r[1]); w.y = cvt_pk_bf16(r[2], r[3]); w.z = cvt_pk_bf16(r[4], r[5]); w.w = cvt_pk_bf16(r[6], r[7]);
                    *(u32x4*)(M + o) = w; } }
    }
};
template <bool IN_F32> struct EpiRes {
    static constexpr bool PERM = true, AFTER_DRAIN = false;
    const float* xin_f; const bf16_t* xin_b; bf16_t* xb; float* SS;
    __device__ __forceinline__ void operator()(const f32x4 (&acc)[2][2][4][2], const Unit& u, int wr, int wc, int fr, int fq) const {
        const int row0 = u.pm * BM + wr * 64 + fr, col0 = u.pn * BM + wc * 32 + 8 * fq;
#pragma unroll
        for (int ai = 0; ai < 2; ++ai)
#pragma unroll
            for (int m = 0; m < 4; ++m) { const int row = row0 + ai * HALF + m * 16; const size_t ro = (size_t)row * 1024 + col0; float s = 0.f;
#pragma unroll
                for (int bj = 0; bj < 2; ++bj) { const size_t o = ro + bj * HALF; f32x4 v0, v1;
                    if (IN_F32) { v0 = *(const f32x4*)(xin_f + o); v1 = *(const f32x4*)(xin_f + o + 4); }
                    else { const u32x4 p = *(const u32x4*)(xin_b + o); v0 = (f32x4){bfl(p.x), bfh(p.x), bfl(p.y), bfh(p.y)}; v1 = (f32x4){bfl(p.z), bfh(p.z), bfl(p.w), bfh(p.w)}; }
                    v0 += acc[ai][bj][m][0]; v1 += acc[ai][bj][m][1];
                    u32x4 w; w.x = cvt_pk_bf16(v0[0], v0[1]); w.y = cvt_pk_bf16(v0[2], v0[3]); w.z = cvt_pk_bf16(v1[0], v1[1]); w.w = cvt_pk_bf16(v1[2], v1[3]);
                    *(u32x4*)(xb + o) = w;
                    const float r0 = bfl(w.x), r1 = bfh(w.x), r2 = bfl(w.y), r3 = bfh(w.y), r4 = bfl(w.z), r5 = bfh(w.z), r6 = bfl(w.w), r7 = bfh(w.w);
                    s += (r0 * r0 + r1 * r1) + (r2 * r2 + r3 * r3) + (r4 * r4 + r5 * r5) + (r6 * r6 + r7 * r7); }
                s += __shfl_xor(s, 16); s += __shfl_xor(s, 32);
                if (fq == 0) SS[(size_t)row * 16 + u.pn * 4 + wc] = s; }
    }
};
struct EpiScale {
    static constexpr bool PERM = true, AFTER_DRAIN = false;
    const float* SS; bf16_t* O; int ldc; float* rstd_out;
    __device__ __forceinline__ void operator()(const f32x4 (&acc)[2][2][4][2], const Unit& u, int wr, int wc, int fr, int fq) const {
        const int row0 = u.pm * BM + wr * 64 + fr, col0 = u.pn * BM + wc * 32 + 8 * fq;
#pragma unroll
        for (int ai = 0; ai < 2; ++ai)
#pragma unroll
            for (int m = 0; m < 4; ++m) { const int row = row0 + ai * HALF + m * 16; const f32x4* sp = (const f32x4*)(SS + (size_t)row * 16);
                const f32x4 a = sp[0] + sp[1] + sp[2] + sp[3]; const float rs = rsqrtf(((a[0] + a[1]) + (a[2] + a[3])) * (1.f / 1024.f) + 1e-6f);
                if (rstd_out && u.pn == 0 && wc == 0 && fq == 0) rstd_out[row] = rs;
                bf16_t* rowp = O + (size_t)row * ldc + col0;
#pragma unroll
                for (int bj = 0; bj < 2; ++bj) { const f32x4 v0 = acc[ai][bj][m][0] * rs, v1 = acc[ai][bj][m][1] * rs;
                    u32x4 w; w.x = cvt_pk_bf16(v0[0], v0[1]); w.y = cvt_pk_bf16(v0[2], v0[3]); w.z = cvt_pk_bf16(v1[0], v1[1]); w.w = cvt_pk_bf16(v1[2], v1[3]);
                    *(u32x4*)(rowp + bj * HALF) = w; } }
    }
};
template <class Epi, class Sched, bool ALIGN_EPI = false, bool SP2 = false>
__device__ __forceinline__ void gemm_phase(PG8_LAS unsigned char* lds, const Gemm g, const Sched& S, const Epi& E) {
    const int tid = threadIdx.x, wid = __builtin_amdgcn_readfirstlane(tid >> 6), lane = tid & 63, wr = wid >> 2, wc = wid & 3, fr = lane & 15, fq = lane >> 4;
    const int K = g.K, nt = K / BK;
    unsigned voffA[2], voffB[2];
#pragma unroll
    for (int i = 0; i < 2; ++i) { int R, C; stage_rc(tid * 16 + i * 8192, R, C); const int Rb = Epi::PERM ? ((R & ~31) + perm32(R & 31)) : R;
        voffA[i] = (unsigned)(R * K + C) * 2u; voffB[i] = (unsigned)(Rb * K + C) * 2u; }
    const size_t kstep = (size_t)(BK * 2);
    const size_t hstep = (size_t)HALF * K * 2;
    const size_t tstep = 2 * hstep;
    const unsigned ldsw = (unsigned)wid * 1024u;
    const int aoff = lds_byte(wr * 64 + fr, fq * 8), boff = lds_byte(wc * 32 + fr, fq * 8);
#define PG8_SA(b, h) (((b) * 2 + (h)) * HTB)
#define PG8_SB(b, h) ((4 + (b) * 2 + (h)) * HTB)
#define PG8_STAGE(bufoff, gbase, voff) do { _Pragma("unroll") for (int _i = 0; _i < 2; ++_i) \
        __builtin_amdgcn_global_load_lds((const unsigned*)((const char*)(gbase) + (voff)[_i]), (PG8_LAS unsigned*)(lds + (bufoff) + ldsw + _i * 8192), 16, 0, 0); } while (0)
#define PG8_LDA(dst, b, h) do { _Pragma("unroll") for (int m = 0; m < 4; ++m) _Pragma("unroll") for (int k = 0; k < 2; ++k) dst[m][k] = *(const PG8_LAS bf16x8*)(lds + PG8_SA(b, h) + aoff + m * 2048 + k * 1024); } while (0)
#define PG8_LDB(dst, b, h) do { _Pragma("unroll") for (int n = 0; n < 2; ++n) _Pragma("unroll") for (int k = 0; k < 2; ++k) dst[n][k] = *(const PG8_LAS bf16x8*)(lds + PG8_SB(b, h) + boff + n * 2048 + k * 1024); } while (0)
#define PG8_MMA(ai, bj, At, Bt) do { __builtin_amdgcn_s_setprio(1); _Pragma("unroll") for (int m = 0; m < 4; ++m) _Pragma("unroll") for (int n = 0; n < 2; ++n) _Pragma("unroll") for (int k = 0; k < 2; ++k) \
        acc[ai][bj][m][n] = __builtin_amdgcn_mfma_f32_16x16x32_bf16(Bt[n][k], At[m][k], acc[ai][bj][m][n], 0, 0, 0); __builtin_amdgcn_s_setprio(0); } while (0)
#define PG8_WAIT_V(n) asm volatile("s_waitcnt vmcnt(" #n ")" ::: "memory")
#define PG8_WAIT_L(n) asm volatile("s_waitcnt lgkmcnt(" #n ")" ::: "memory")
#define PG8_BAR __builtin_amdgcn_s_barrier()
#define PG8_SCHED __builtin_amdgcn_sched_barrier(0)
    Unit cur, nxt; int ui = 0;
    if (!S.next(0, cur)) return;
    f32x4 acc[2][2][4][2];
#pragma unroll
    for (int a = 0; a < 2; ++a)
#pragma unroll
        for (int b = 0; b < 2; ++b)
#pragma unroll
            for (int m = 0; m < 4; ++m)
#pragma unroll
                for (int n = 0; n < 2; ++n) acc[a][b][m][n] = (f32x4){0.f, 0.f, 0.f, 0.f};
    bf16x8 At[4][2], B0[2][2], B1[2][2];
    const char* cA = (const char*)g.A + (size_t)cur.pm * tstep; const char* cB = (const char*)g.Bt + (size_t)cur.pn * tstep;
    S.a_ready(cur);
    if constexpr (SP2) {
        PG8_STAGE(PG8_SB(0, 0), cB, voffB); PG8_STAGE(PG8_SB(0, 1), cB + hstep, voffB); PG8_STAGE(PG8_SA(0, 0), cA, voffA); PG8_STAGE(PG8_SA(0, 1), cA + hstep, voffA);
        if (wr == 1) PG8_BAR;
        PG8_WAIT_V(2); PG8_BAR;
        PG8_STAGE(PG8_SB(1, 0), cB + kstep, voffB); PG8_STAGE(PG8_SA(1, 0), cA + kstep, voffA); PG8_STAGE(PG8_SB(1, 1), cB + hstep + kstep, voffB);
        PG8_WAIT_V(6); PG8_BAR;
    } else {
        PG8_STAGE(PG8_SB(0, 0), cB, voffB); PG8_STAGE(PG8_SA(0, 0), cA, voffA); PG8_STAGE(PG8_SB(0, 1), cB + hstep, voffB); PG8_STAGE(PG8_SA(0, 1), cA + hstep, voffA);
        if (wr == 1) PG8_BAR;
        PG8_WAIT_V(4); PG8_BAR;
        PG8_STAGE(PG8_SB(1, 0), cB + kstep, voffB); PG8_STAGE(PG8_SA(1, 0), cA + kstep, voffA); PG8_STAGE(PG8_SB(1, 1), cB + hstep + kstep, voffB);
        PG8_WAIT_V(6); PG8_BAR;
    }
    for (;;) {
        const bool has_next = S.next(ui + 1, nxt);
        const char* nA = has_next ? (const char*)g.A + (size_t)nxt.pm * tstep : cA; const char* nB = has_next ? (const char*)g.Bt + (size_t)nxt.pn * tstep : cB;
        for (int t = 0; t < nt; t += 2) {
            const bool last = (t == nt - 2);
            const char* a1 = cA + (size_t)(t + 1) * kstep;
            const char* a2 = last ? nA : cA + (size_t)(t + 2) * kstep; const char* b2 = last ? nB : cB + (size_t)(t + 2) * kstep;
            const char* a3 = a2 + kstep; const char* b3 = b2 + kstep;
            if (last && has_next) S.a_ready(nxt);
            if constexpr (SP2) {
            PG8_LDB(B0, 0, 0); PG8_LDB(B1, 0, 1); PG8_SCHED; PG8_LDA(At, 0, 0); PG8_STAGE(PG8_SA(1, 1), a1 + hstep, voffA);
            PG8_WAIT_V(8); PG8_WAIT_L(0); PG8_BAR; PG8_MMA(0, 0, At, B0); PG8_MMA(0, 1, At, B1); PG8_BAR; PG8_SCHED;
            PG8_LDA(At, 0, 1); PG8_STAGE(PG8_SB(0, 0), b2, voffB); PG8_STAGE(PG8_SB(0, 1), b2 + hstep, voffB); PG8_STAGE(PG8_SA(0, 0), a2, voffA);
            PG8_WAIT_V(8); PG8_WAIT_L(0); PG8_BAR; PG8_MMA(1, 0, At, B0); PG8_MMA(1, 1, At, B1); PG8_BAR; PG8_SCHED;
            PG8_LDB(B0, 1, 0); PG8_LDB(B1, 1, 1); PG8_SCHED; PG8_LDA(At, 1, 0); PG8_STAGE(PG8_SA(0, 1), a2 + hstep, voffA);
            PG8_WAIT_V(8); PG8_WAIT_L(0); PG8_BAR; PG8_MMA(0, 0, At, B0); PG8_MMA(0, 1, At, B1); PG8_BAR; PG8_SCHED;
            PG8_LDA(At, 1, 1); PG8_STAGE(PG8_SB(1, 0), b3, voffB); PG8_STAGE(PG8_SB(1, 1), b3 + hstep, voffB); PG8_STAGE(PG8_SA(1, 0), a3, voffA);
            PG8_WAIT_V(8); PG8_WAIT_L(0); PG8_BAR; PG8_MMA(1, 0, At, B0); PG8_MMA(1, 1, At, B1); PG8_BAR; PG8_SCHED;
            } else {
            PG8_LDB(B0, 0, 0); PG8_SCHED; PG8_LDA(At, 0, 0); PG8_STAGE(PG8_SA(1, 1), a1 + hstep, voffA);
            PG8_WAIT_L(8); PG8_BAR; PG8_WAIT_L(0); PG8_MMA(0, 0, At, B0); PG8_BAR; PG8_SCHED;
            PG8_LDB(B1, 0, 1); PG8_STAGE(PG8_SB(0, 0), b2, voffB);
            PG8_BAR; PG8_WAIT_L(0); PG8_MMA(0, 1, At, B1); PG8_BAR;
            PG8_LDA(At, 0, 1); PG8_STAGE(PG8_SA(0, 0), a2, voffA);
            PG8_BAR; PG8_WAIT_L(0); PG8_MMA(1, 0, At, B0); PG8_BAR; PG8_SCHED;
            PG8_STAGE(PG8_SB(0, 1), b2 + hstep, voffB);
            PG8_WAIT_V(6); PG8_BAR; PG8_MMA(1, 1, At, B1); PG8_BAR;
            PG8_LDB(B0, 1, 0); PG8_SCHED; PG8_LDA(At, 1, 0); PG8_STAGE(PG8_SA(0, 1), a2 + hstep, voffA);
            PG8_WAIT_L(8); PG8_BAR; PG8_WAIT_L(0); PG8_MMA(0, 0, At, B0); PG8_BAR; PG8_SCHED;
            PG8_LDB(B1, 1, 1); PG8_STAGE(PG8_SB(1, 0), b3, voffB);
            PG8_BAR; PG8_WAIT_L(0); PG8_MMA(0, 1, At, B1); PG8_BAR;
            PG8_LDA(At, 1, 1); PG8_STAGE(PG8_SA(1, 0), a3, voffA);
            PG8_BAR; PG8_WAIT_L(0); PG8_MMA(1, 0, At, B0); PG8_BAR; PG8_SCHED;
            PG8_STAGE(PG8_SB(1, 1), b3 + hstep, voffB);
            PG8_WAIT_V(6); PG8_BAR; PG8_MMA(1, 1, At, B1); PG8_BAR;
            }
        }
        if constexpr (ALIGN_EPI) { if (wr == 0) PG8_BAR; }
        if constexpr (!Epi::AFTER_DRAIN) { E(acc, cur, wr, wc, fr, fq); S.done(cur); }
        if (!has_next) break;
#pragma unroll
        for (int a = 0; a < 2; ++a)
#pragma unroll
            for (int b = 0; b < 2; ++b)
#pragma unroll
                for (int m = 0; m < 4; ++m)
#pragma unroll
                    for (int n = 0; n < 2; ++n) acc[a][b][m][n] = (f32x4){0.f, 0.f, 0.f, 0.f};
        cur = nxt; cA = nA; cB = nB; ++ui;
        if constexpr (ALIGN_EPI) { if (wr == 1) PG8_BAR; }
    }
    PG8_WAIT_V(0);
    if constexpr (!ALIGN_EPI) { if (wr == 0) PG8_BAR; }
    PG8_BAR;
    if constexpr (Epi::AFTER_DRAIN) { E.fused(acc, cur, wr, wc, fr, fq, lds, wid, lane); S.done(cur); }
#undef PG8_SA
#undef PG8_SB
#undef PG8_STAGE
#undef PG8_LDA
#undef PG8_LDB
#undef PG8_MMA
#undef PG8_WAIT_V
#undef PG8_WAIT_L
#undef PG8_BAR
#undef PG8_SCHED
}
}
#define GAS __attribute__((address_space(1)))
#define LAS __attribute__((address_space(3)))
typedef unsigned short bf16;
typedef unsigned v4u __attribute__((ext_vector_type(4)));
typedef float f32x4 __attribute__((ext_vector_type(4)));
typedef short bf16x8 __attribute__((ext_vector_type(8)));
typedef GAS unsigned gu32;
typedef GAS unsigned long long gu64;
#define RLX_AGENT __ATOMIC_RELAXED, __HIP_MEMORY_SCOPE_AGENT
#define LDS_WAIT() asm volatile("s_waitcnt lgkmcnt(0)" ::: "memory")
#define VM_WAIT() asm volatile("s_waitcnt vmcnt(0)" ::: "memory")
__device__ __forceinline__ unsigned long long rt() { return __builtin_amdgcn_s_memrealtime(); }
__device__ __forceinline__ unsigned pk2(float lo, float hi) { return (unsigned)f2bf(lo) | ((unsigned)f2bf(hi) << 16); }

#define XB_TMO      128
#define XB_XCNT(j)  (256  + 64 * (j))
#define XB_XSUB(j)  (1280 + 64 * (j))
#define XB_XGEN(j)  (2304 + 64 * (j))
#define XB_TOP      3328
#define XB_TOPGEN   3392
#define XCD_BAR_WORDS 3456
#define XB_SPIN_CAP (1u << 18)

__device__ __forceinline__ unsigned xb_ld(unsigned* p)              { return __hip_atomic_load(p, __ATOMIC_RELAXED, __HIP_MEMORY_SCOPE_AGENT); }
__device__ __forceinline__ unsigned xb_add(unsigned* p, unsigned v) { return __hip_atomic_fetch_add(p, v, __ATOMIC_RELAXED, __HIP_MEMORY_SCOPE_AGENT); }
__device__ __forceinline__ unsigned xb_xcc_id() { return (unsigned)__builtin_amdgcn_s_getreg((3 << 11) | 20) & 0xFu; }
#define XB_SPIN(cond, bar) do { unsigned _sp = 0; while (cond) { __builtin_amdgcn_s_sleep(1); \
    if ((++_sp & 255u) == 0u) { if (xb_ld(&(bar)[XB_TMO])) break; if (_sp > XB_SPIN_CAP) { atomicAdd(&(bar)[XB_TMO], 1u); break; } } } } while (0)

struct XcdBarrier {
    unsigned* bar; unsigned x;
    volatile LAS unsigned* st;
};

__device__ __forceinline__ XcdBarrier xcd_barrier_post(unsigned* bar, volatile LAS unsigned* st) {
    XcdBarrier b; b.bar = bar; b.x = xb_xcc_id(); b.st = st;
    if (threadIdx.x == 0) (void)xb_add(&bar[XB_XCNT(b.x)], 1u);
    return b;
}
__device__ __forceinline__ void xcd_barrier_complete(unsigned* bar, unsigned x, unsigned& nloc, unsigned& nx) {
    const unsigned G = gridDim.x * gridDim.y * gridDim.z;
    unsigned sum, cnt, mine, sp = 0u;
    for (;;) {
        sum = 0u; cnt = 0u; mine = 0u;
#pragma unroll
        for (unsigned j = 0; j < 16; ++j) { const unsigned c = xb_ld(&bar[XB_XCNT(j)]); sum += c; cnt += (c > 0u) ? 1u : 0u; mine = (j == x) ? c : mine; }
        if (sum == G) break;
        __builtin_amdgcn_s_sleep(1);
        if ((++sp & 255u) == 0u) { if (xb_ld(&bar[XB_TMO])) break; if (sp > XB_SPIN_CAP) { atomicAdd(&bar[XB_TMO], 1u); break; } }
    }
    nloc = mine > 0u ? mine : 1u; nx = cnt > 0u ? cnt : 1u;
}

__device__ __forceinline__ void xcd_barrier(const XcdBarrier& b) {
    asm volatile("s_waitcnt vmcnt(0)" ::: "memory");
    __syncthreads();
    if (threadIdx.x == 0) {
        unsigned* bar = b.bar;
        __builtin_amdgcn_s_waitcnt(0);
        unsigned nloc = b.st[0], nx = b.st[1];
        if (nloc == 0u) { xcd_barrier_complete(bar, b.x, nloc, nx); b.st[0] = nloc; b.st[1] = nx; }
        const unsigned old = xb_add(&bar[XB_XSUB(b.x)], 1u);
        const unsigned gen = old / nloc;
        if (old + 1u == (gen + 1u) * nloc) {
            __builtin_amdgcn_fence(__ATOMIC_RELEASE, "agent");
            asm volatile("s_waitcnt vmcnt(0)" ::: "memory");
            const unsigned og = xb_add(&bar[XB_TOP], 1u);
            const unsigned tg = og / nx;
            if (og + 1u == (tg + 1u) * nx) xb_add(&bar[XB_TOPGEN], 1u);
            else XB_SPIN(xb_ld(&bar[XB_TOPGEN]) == tg, bar);
            __builtin_amdgcn_fence(__ATOMIC_ACQUIRE, "agent");
            xb_add(&bar[XB_XGEN(b.x)], 1u);
            asm volatile("s_waitcnt vmcnt(0)" ::: "memory");
        } else {
            XB_SPIN(xb_ld(&bar[XB_XGEN(b.x)]) == gen, bar);
            __builtin_amdgcn_fence(__ATOMIC_ACQUIRE, "agent");
            asm volatile("s_waitcnt vmcnt(0)" ::: "memory");
        }
    }
    __syncthreads();
}
constexpr size_t KiB = 1024;
constexpr size_t WS_CTL = 0, CTL_ZERO_BYTES = 1 * MiB;
constexpr size_t WS_WIN = 1 * MiB, WS_WSB = 12 * MiB, WS_WGDN = 13 * MiB, WS_WMIX = 14 * MiB, WS_WCQ = 16 * MiB, WS_WCO = 18 * MiB, WS_WCKV = 20 * MiB, WS_WPQ = 24 * MiB, WS_SKB = 28 * MiB, WS_U16 = 30 * MiB, WS_V16 = 62 * MiB;
constexpr size_t WS_RSTD0 = 94 * MiB, WS_RSTD2 = 94 * MiB + 256 * KiB, WS_CD = 94 * MiB + 384 * KiB, WS_GB = 94 * MiB + 512 * KiB;
constexpr size_t WS_MN = 96 * MiB, WS_KC = 98 * MiB, WS_VC = 100 * MiB, WS_SS = 102 * MiB;
constexpr size_t WS_A0 = 104 * MiB;
constexpr size_t WS_NW = 104 * MiB, WS_QD = 136 * MiB;
constexpr size_t WS_A1 = 168 * MiB;
constexpr size_t WS_ORAW = 168 * MiB, WS_OSS = 200 * MiB, WS_OG = 232 * MiB;
constexpr size_t WS_GZ = 264 * MiB;
constexpr size_t WS_GSB = 296 * MiB, WS_GGDN = 360 * MiB;
constexpr size_t WS_KDT = 424 * MiB, WS_QK = 456 * MiB, WS_UT = 472 * MiB;
constexpr size_t WS_U8 = 30 * MiB, WS_V8 = 46 * MiB, WS_SUV = 62 * MiB;
constexpr size_t WS_PART = 344 * MiB;
constexpr size_t WS_END = 512 * MiB;
constexpr int CW_SUB = 12288;
constexpr int CW_BAR = 4096;

constexpr int NWAVES = 8;
constexpr int RING_BYTES = 131072, LDSCTL_OFF = RING_BYTES, MISC_OFF = LDSCTL_OFF + 320, LDS_BYTES = 147456;

struct Args {
    const float *x, *mem, *g_mix, *w_in, *gdn_conv, *a_log, *dt_bias, *gdn_norm_g, *w_sb_up, *w_gdn_up, *w_mix_out, *g_cross, *g_mem, *w_cq, *w_ckv, *w_co, *g_peer, *w_pq, *subkeys, *peer_u, *peer_v, *g_final;
    float* out; unsigned char* ws; int ph_lo, ph_hi, bar_region, pad;
};

struct Frame {
    LAS unsigned char* lds; int tid, lane, wave, vcu, G;
};


typedef short bf16x8_t __attribute__((ext_vector_type(8)));
typedef float f32x16_t __attribute__((ext_vector_type(16)));
typedef short v4i16_t __attribute__((ext_vector_type(4)));
typedef float f32x2v_t __attribute__((ext_vector_type(2))); typedef __bf16 bf16x2v_t __attribute__((ext_vector_type(2)));
__device__ __forceinline__ unsigned cvtpk(float lo, float hi) { f32x2v_t v = {lo, hi}; bf16x2v_t b = __builtin_convertvector(v, bf16x2v_t); return __builtin_bit_cast(unsigned, b); }
__device__ __forceinline__ v4i16_t lds_tr16(LAS unsigned char* p) { return __builtin_amdgcn_ds_read_tr16_b64_v4i16((LAS v4i16_t*)p); }

__device__ __forceinline__ void sb_phase(LAS unsigned char* wlds  , const bf16_t* SBQ, const bf16_t* SBK, const bf16_t* SBV, bf16_t* OSB, int gw, int ngw, int lane) {
    const int q = lane & 31, hi = lane >> 5;
    bf16x8_t Mf[2];
#pragma unroll
    for (int s = 0; s < 2; ++s)
#pragma unroll
        for (int j = 0; j < 8; ++j) { const int k = 16 * s + 8 * (j >> 2) + 4 * hi + (j & 3); Mf[s][j] = (k > q) ? (short)0x3F80 : (short)0; }
    const int vrow = lane >> 3, vch = lane & 7;
    const int g4 = lane >> 4, qq = (lane >> 2) & 3, p4 = lane & 3;
    LAS unsigned char* trb = wlds + (4 * (g4 >> 1) + qq) * 192 + ((g4 & 1) * 16 + 4 * p4) * 2;
    for (int item = gw; item < 32 * 256; item += ngw) {
        const int bh = item >> 8, qt = item & 255, b = bh >> 3, h = bh & 7;
        const size_t base = (size_t)b * SEQ;
        const bf16_t* Qp = SBQ + (base + qt * 32 + q) * 512 + h * 64 + 8 * hi;
        bf16x8_t Qf[4];
#pragma unroll
        for (int ks = 0; ks < 4; ++ks) Qf[ks] = *(const bf16x8_t*)(Qp + 16 * ks);
        f32x16_t o0 = {}, o1 = {};
        float carry = 0.f;
        bf16x8_t Kn[4]; v4u vn[4];
        {   const bf16_t* Kp = SBK + (base + qt * 32 + q) * 512 + h * 64 + 8 * hi;
#pragma unroll
            for (int ks = 0; ks < 4; ++ks) Kn[ks] = *(const bf16x8_t*)(Kp + 16 * ks);
#pragma unroll
            for (int i = 0; i < 4; ++i) vn[i] = *(const v4u*)(SBV + (base + qt * 32 + vrow + 8 * i) * 512 + h * 64 + vch * 8); }
        for (int kb = qt; kb >= 0; --kb) {
            bf16x8_t Kf[4]; v4u vv[4];
#pragma unroll
            for (int ks = 0; ks < 4; ++ks) Kf[ks] = Kn[ks];
#pragma unroll
            for (int i = 0; i < 4; ++i) vv[i] = vn[i];
            {   const int kn = kb > 0 ? kb - 1 : 0;
                const bf16_t* Kp = SBK + (base + kn * 32 + q) * 512 + h * 64 + 8 * hi;
#pragma unroll
                for (int ks = 0; ks < 4; ++ks) Kn[ks] = *(const bf16x8_t*)(Kp + 16 * ks);
#pragma unroll
                for (int i = 0; i < 4; ++i) vn[i] = *(const v4u*)(SBV + (base + kn * 32 + vrow + 8 * i) * 512 + h * 64 + vch * 8); }
            f32x16_t st = {};
#pragma unroll
            for (int ks = 0; ks < 4; ++ks) st = __builtin_amdgcn_mfma_f32_32x32x16_bf16(Kf[ks], Qf[ks], st, 0, 0, 0);
#pragma unroll
            for (int i = 0; i < 4; ++i) *(LAS v4u*)(wlds + (vrow + 8 * i) * 192 + vch * 16) = vv[i];
            const bool diag = (kb == qt);
            float z[16], lk[16];
#pragma unroll
            for (int r = 0; r < 16; ++r) {
                const int key = (r & 3) + 8 * (r >> 2) + 4 * hi;
                z[r] = st[r] * 0.125f;
                const float sp = fmaxf(z[r], 0.f) + __logf(1.f + __expf(-fabsf(z[r])));
                const bool valid = !diag || key < q;
                lk[r] = valid ? -sp : 0.f;
                z[r] = valid ? z[r] - sp : -INFINITY;
            }
            bf16x8_t lh[2], ll[2];
#pragma unroll
            for (int s = 0; s < 2; ++s) {
                unsigned wh[4], wl[4];
#pragma unroll
                for (int jj = 0; jj < 4; ++jj) { const float a = lk[8 * s + 2 * jj], c = lk[8 * s + 2 * jj + 1]; wh[jj] = cvtpk(a, c);
                    wl[jj] = cvtpk(a - __uint_as_float(wh[jj] << 16), c - __uint_as_float(wh[jj] & 0xffff0000u)); }
                lh[s] = __builtin_bit_cast(bf16x8_t, (v4u){wh[0], wh[1], wh[2], wh[3]}); ll[s] = __builtin_bit_cast(bf16x8_t, (v4u){wl[0], wl[1], wl[2], wl[3]});
            }
            f32x16_t af;
#pragma unroll
            for (int r = 0; r < 16; ++r) af[r] = carry;
            af = __builtin_amdgcn_mfma_f32_32x32x16_bf16(Mf[0], lh[0], af, 0, 0, 0);
            af = __builtin_amdgcn_mfma_f32_32x32x16_bf16(Mf[1], lh[1], af, 0, 0, 0);
            af = __builtin_amdgcn_mfma_f32_32x32x16_bf16(Mf[0], ll[0], af, 0, 0, 0);
            af = __builtin_amdgcn_mfma_f32_32x32x16_bf16(Mf[1], ll[1], af, 0, 0, 0);
            float tot = af[0] + lk[0];
            tot = __shfl(tot, q);
            float pr[16];
#pragma unroll
            for (int r = 0; r < 16; ++r) pr[r] = __expf(z[r] + af[r]);
            bf16x8_t pa[2];
#pragma unroll
            for (int s = 0; s < 2; ++s) pa[s] = __builtin_bit_cast(bf16x8_t, (v4u){cvtpk(pr[8 * s], pr[8 * s + 1]), cvtpk(pr[8 * s + 2], pr[8 * s + 3]), cvtpk(pr[8 * s + 4], pr[8 * s + 5]), cvtpk(pr[8 * s + 6], pr[8 * s + 7])});
            asm volatile("s_waitcnt lgkmcnt(0)" ::: "memory");
#pragma unroll
            for (int s = 0; s < 2; ++s) {
                const v4i16_t a0 = lds_tr16(trb + (16 * s) * 192), a1 = lds_tr16(trb + (16 * s + 8) * 192);
                const v4i16_t c0 = lds_tr16(trb + (16 * s) * 192 + 64), c1 = lds_tr16(trb + (16 * s + 8) * 192 + 64);
                const bf16x8_t vb0 = {a0[0], a0[1], a0[2], a0[3], a1[0], a1[1], a1[2], a1[3]}, vb1 = {c0[0], c0[1], c0[2], c0[3], c1[0], c1[1], c1[2], c1[3]};
                o0 = __builtin_amdgcn_mfma_f32_32x32x16_bf16(pa[s], vb0, o0, 0, 0, 0);
                o1 = __builtin_amdgcn_mfma_f32_32x32x16_bf16(pa[s], vb1, o1, 0, 0, 0);
            }
            carry = tot;
            if (__all(carry < -104.f)) break;
        }
        bf16_t* Op = OSB + (base + qt * 32) * 512 + h * 64 + q;
#pragma unroll
        for (int r = 0; r < 16; ++r) { const int row = (r & 3) + 8 * (r >> 2) + 4 * hi; Op[(size_t)row * 512] = f2bf(o0[r]); Op[(size_t)row * 512 + 32] = f2bf(o1[r]); }
    }
}
typedef float f32x4_t __attribute__((ext_vector_type(4)));
typedef unsigned v2u __attribute__((ext_vector_type(2)));
__device__ __forceinline__ float bflo(unsigned w) { return __uint_as_float(w << 16); }
__device__ __forceinline__ float bfhi(unsigned w) { return __uint_as_float(w & 0xffff0000u); }
__device__ __forceinline__ int frag_off(int r, int k0, int KS) { return (((r >> 4) * KS + (k0 >> 5)) << 9) + (((r & 15) + 16 * ((k0 & 15) >> 2)) << 3) + (((k0 & 31) >> 4) << 2); }

constexpr int GP_KS = 0, GP_QS = 17408, GP_VS = 34816, GP_AS = 52224, GP_WT = 69632, GP_GC = 87040, GP_BETA = 87296, GP_EGC = 87552, GP_CW = 88064, GP_TS = 94208;
constexpr int GROW = 136;

#define LDS_BARRIER() do { asm volatile("s_waitcnt lgkmcnt(0)" ::: "memory"); __builtin_amdgcn_s_barrier(); asm volatile("" ::: "memory"); } while (0)
struct GdnBufs { bf16_t *NW, *QD, *KDT, *QK, *UT; float* CD; bf16_t* ORAW; float* OSS; };

__device__ __forceinline__ void gdn_prep_phase(Frame& F, const Args& a, const bf16_t* GQKV, const float* GB, const float* GA, const GdnBufs& Gb) {
    LAS unsigned char* L = F.lds;
    LAS bf16_t* KS = (LAS bf16_t*)(L + GP_KS); LAS bf16_t* QS = (LAS bf16_t*)(L + GP_QS); LAS bf16_t* VS = (LAS bf16_t*)(L + GP_VS); LAS bf16_t* WT = (LAS bf16_t*)(L + GP_WT);
    LAS float* AS = (LAS float*)(L + GP_AS); LAS float* GC = (LAS float*)(L + GP_GC); LAS float* BETA = (LAS float*)(L + GP_BETA); LAS float* EGC = (LAS float*)(L + GP_EGC); LAS float* CW = (LAS float*)(L + GP_CW); LAS float* TS = (LAS float*)(L + GP_TS);
    const int tid = F.tid, lane = F.lane, wave = F.wave;
    const int per = (2048 + F.G - 1) / F.G;
    int hcur = -1;
    for (int ii = 0; ii < per; ++ii) {
        const int item = F.vcu * per + ii; if (item >= 2048) break;
        const int bh = item >> 7, n = item & 127, b = bh >> 2, h = bh & 3;
        const size_t t0 = (size_t)b * SEQ + n * 64;
        if (h != hcur) { hcur = h; for (int i = tid; i < 1536; i += NWAVES * 64) { const int j = i / 384, cc = i % 384; CW[i] = a.gdn_conv[j * 1536 + (cc >> 7) * 512 + h * 128 + (cc & 127)]; } }
        unsigned pf = 0u;
        if (ii + 1 < per && item + 1 < 2048 && tid < 384) {
            const int r = tid / 6, q6 = tid % 6; const int item2 = item + 1, bh2 = item2 >> 7, n2 = item2 & 127;
            pf = *(const unsigned*)(GQKV + ((size_t)(bh2 >> 2) * SEQ + n2 * 64 + r) * 1536 + (q6 >> 1) * 512 + (bh2 & 3) * 128 + (q6 & 1) * 64);
        }
        if (wave == 0) {
            const size_t t = t0 + lane;
            float g = -__expf(a.a_log[h]) * softplusf_(GA[t * 4 + h] + a.dt_bias[h]);
#pragma unroll
            for (int o = 1; o < 64; o <<= 1) { const float up = __shfl_up(g, o); if (lane >= o) g += up; }
            GC[lane] = g; BETA[lane] = sigmoidf_(GB[t * 4 + h]); EGC[lane] = __expf(g);
            if (lane == 63) Gb.CD[item] = __expf(g);
        }
        LDS_BARRIER();
        {
            const int c = tid >> 3, d0 = (tid & 7) * 16;
#pragma unroll
            for (int part = 0; part < 3; ++part) {
                float acc[16];
#pragma unroll
                for (int i = 0; i < 16; ++i) acc[i] = 0.f;
#pragma unroll
                for (int j = 0; j < 4; ++j) {
                    if (n * 64 + c - 3 + j >= 0) {
                        const bf16_t* src = GQKV + (t0 + c - 3 + j) * 1536 + part * 512 + h * 128 + d0;
                        const v4u r0 = *(const v4u*)src, r1 = *(const v4u*)(src + 8);
                        const unsigned rw[8] = {r0.x, r0.y, r0.z, r0.w, r1.x, r1.y, r1.z, r1.w};
                        const LAS float* cw = CW + j * 384 + part * 128 + d0;
#pragma unroll
                        for (int i = 0; i < 8; ++i) { acc[2 * i] += bflo(rw[i]) * cw[2 * i]; acc[2 * i + 1] += bfhi(rw[i]) * cw[2 * i + 1]; }
                    }
                }
                float ss = 0.f;
#pragma unroll
                for (int i = 0; i < 16; ++i) { acc[i] = acc[i] / (1.f + __expf(-acc[i])); ss += acc[i] * acc[i]; }
                if (part < 2) { ss += __shfl_xor(ss, 1); ss += __shfl_xor(ss, 2); ss += __shfl_xor(ss, 4); const float inv = rsqrtf(ss + EPS);
#pragma unroll
                    for (int i = 0; i < 16; ++i) acc[i] *= inv; }
                LAS bf16_t* dst = (part == 0 ? QS : part == 1 ? KS : VS) + c * GROW + d0;
                v4u w0, w1; w0.x = cvtpk(acc[0], acc[1]); w0.y = cvtpk(acc[2], acc[3]); w0.z = cvtpk(acc[4], acc[5]); w0.w = cvtpk(acc[6], acc[7]);
                w1.x = cvtpk(acc[8], acc[9]); w1.y = cvtpk(acc[10], acc[11]); w1.z = cvtpk(acc[12], acc[13]); w1.w = cvtpk(acc[14], acc[15]);
                *(LAS v4u*)dst = w0; *(LAS v4u*)(dst + 8) = w1;
            }
        }
        LDS_BARRIER();
        {
            const int fr = lane & 15, g = lane >> 4;
            for (int task = wave; task < 26; task += NWAVES) {
                const bool isKK = task < 10; int ct, mt;
                if (isKK) { ct = task >= 6 ? 3 : task >= 3 ? 2 : task >= 1 ? 1 : 0; mt = task - ct * (ct + 1) / 2; } else { ct = (task - 10) >> 2; mt = (task - 10) & 3; }
                f32x4_t acc = {0.f, 0.f, 0.f, 0.f};
                if (mt <= ct) {
                    const LAS bf16_t* Ap = KS + (mt * 16 + fr) * GROW + 8 * g; const LAS bf16_t* Bp = (isKK ? KS : QS) + (ct * 16 + fr) * GROW + 8 * g;
#pragma unroll
                    for (int ks = 0; ks < 4; ++ks) acc = __builtin_amdgcn_mfma_f32_16x16x32_bf16(*(const LAS bf16x8_t*)(Ap + 32 * ks), *(const LAS bf16x8_t*)(Bp + 32 * ks), acc, 0, 0, 0);
                }
                const int c = ct * 16 + fr, m0 = mt * 16 + 4 * g; const float gcc = GC[c];
                float v[4];
#pragma unroll
                for (int r = 0; r < 4; ++r) { const int m = m0 + r; const float dec = __expf(fminf(gcc - GC[m], 0.f)); v[r] = acc[r] * dec; }
                if (isKK) { const float bc = BETA[c];
                    f32x4_t o;
#pragma unroll
                    for (int r = 0; r < 4; ++r) o[r] = (c > m0 + r) ? v[r] * bc : 0.f;
                    *(LAS f32x4_t*)(AS + c * 68 + m0) = o;
                } else {
#pragma unroll
                    for (int r = 0; r < 4; ++r) v[r] = (c >= m0 + r) ? v[r] * 0.08838834764831845f : 0.f;
                    v2u w; w.x = cvtpk(v[0], v[1]); w.y = cvtpk(v[2], v[3]);
                    *(v2u*)(Gb.QK + (size_t)item * 4096 + (ct * 2 + (mt >> 1)) * 512 + lane * 8 + (mt & 1) * 4) = w;
                }
            }
        }
        LDS_BARRIER();
        if (wave == 0) {
            const int q4 = lane >> 4, c = lane & 15; const LAS float* Ab = AS + (16 * q4) * 68 + 16 * q4;
            float t[16];
#pragma unroll
            for (int r = 0; r < 16; ++r) { float s = (r == c) ? 1.f : 0.f;
#pragma unroll
                for (int j4 = 0; j4 < (r + 3) / 4; ++j4) { const f32x4_t av = *(const LAS f32x4_t*)(Ab + r * 68 + 4 * j4);
#pragma unroll
                    for (int i = 0; i < 4; ++i) if (4 * j4 + i < r) s -= av[i] * t[4 * j4 + i]; }
                t[r] = s; TS[(q4 * 16 + r) * 20 + c] = (r == c) ? 0.f : s; }
        }
        LDS_BARRIER();
        {
            const int fr = lane & 15, g = lane >> 4;
#pragma unroll
            for (int cc = 0; cc < 2; ++cc) {
                const int ct2 = wave * 2 + cc; const bool isW = ct2 >= 8; const int col = (ct2 & 7) * 16 + fr;
                const LAS bf16_t* src = (isW ? KS : VS) + col;
                unsigned xb[4][2];
#pragma unroll
                for (int i = 0; i < 4; ++i) {
                    f32x4_t y;
#pragma unroll
                    for (int r = 0; r < 4; ++r) { const int row = 16 * i + 4 * g + r; float v = bf2f(src[row * GROW]) * BETA[row]; if (isW) v *= EGC[row]; y[r] = v; }
#pragma unroll
                    for (int j = 0; j < i; j += 2) {
                        const LAS float* ap = AS + (16 * i + fr) * 68 + 16 * j + 4 * g;
                        const f32x4_t a0 = *(const LAS f32x4_t*)ap; f32x4_t a1 = {0.f, 0.f, 0.f, 0.f}; if (j + 1 < i) a1 = *(const LAS f32x4_t*)(ap + 16);
                        const bf16x8_t af = __builtin_bit_cast(bf16x8_t, (v4u){cvtpk(-a0[0], -a0[1]), cvtpk(-a0[2], -a0[3]), cvtpk(-a1[0], -a1[1]), cvtpk(-a1[2], -a1[3])});
                        const bf16x8_t bfr = __builtin_bit_cast(bf16x8_t, (v4u){xb[j][0], xb[j][1], (j + 1 < i) ? xb[j + 1][0] : 0u, (j + 1 < i) ? xb[j + 1][1] : 0u});
                        y = __builtin_amdgcn_mfma_f32_16x16x32_bf16(af, bfr, y, 0, 0, 0);
                    }
                    const f32x4_t tv = *(const LAS f32x4_t*)(TS + (i * 16 + fr) * 20 + 4 * g);
                    const bf16x8_t tf = __builtin_bit_cast(bf16x8_t, (v4u){cvtpk(tv[0], tv[1]), cvtpk(tv[2], tv[3]), 0u, 0u});
                    const bf16x8_t yf = __builtin_bit_cast(bf16x8_t, (v4u){cvtpk(y[0], y[1]), cvtpk(y[2], y[3]), 0u, 0u});
                    const f32x4_t x = __builtin_amdgcn_mfma_f32_16x16x32_bf16(tf, yf, y, 0, 0, 0);
                    xb[i][0] = cvtpk(x[0], x[1]); xb[i][1] = cvtpk(x[2], x[3]);
                    if (!isW) { *(v2u*)(Gb.UT + (size_t)item * 8192 + col * 64 + 16 * i + 4 * g) = (v2u){xb[i][0], xb[i][1]}; }
                    else {
#pragma unroll
                        for (int r = 0; r < 4; ++r) WT[(16 * i + 4 * g + r) * GROW + col] = f2bf(-x[r]); }
                }
            }
        }
        {
            const float glast = GC[63];
#pragma unroll
            for (int i = 0; i < 4; ++i) { const int p = tid + 512 * i, c = p >> 5, d0 = (p & 31) * 4; const v2u r = *(const LAS v2u*)(QS + c * GROW + d0); const float sc = EGC[c] * 0.08838834764831845f;
                v2u w; w.x = cvtpk(bflo(r.x) * sc, bfhi(r.x) * sc); w.y = cvtpk(bflo(r.y) * sc, bfhi(r.y) * sc);
                *(v2u*)(Gb.QD + (size_t)item * 8192 + frag_off(c, d0, 4)) = w; }
#pragma unroll
            for (int i = 0; i < 4; ++i) { const int p = tid + 512 * i, d = p >> 4, c0 = (p & 15) * 4; float v[4];
#pragma unroll
                for (int r = 0; r < 4; ++r) v[r] = bf2f(KS[(c0 + r) * GROW + d]) * __expf(glast - GC[c0 + r]);
                v2u w; w.x = cvtpk(v[0], v[1]); w.y = cvtpk(v[2], v[3]);
                *(v2u*)(Gb.KDT + (size_t)item * 8192 + frag_off(d, c0, 2)) = w; }
        }
        LDS_BARRIER();
#pragma unroll
        for (int i = 0; i < 4; ++i) { const int p = tid + 512 * i, c = p >> 5, d0 = (p & 31) * 4; const v2u r = *(const LAS v2u*)(WT + c * GROW + d0);
            *(v2u*)(Gb.NW + (size_t)item * 8192 + frag_off(c, d0, 4)) = r; }
        asm volatile("" :: "v"(pf));
        LDS_BARRIER();
    }
}

__device__ __forceinline__ void gdn_scan_unit(Frame& F, int s, const GdnBufs& Gb) {
    const int bh = s >> 2, half = s & 3, h = bh & 3, b = bh >> 2;
    const int tid = F.tid, lane = F.lane, wave = F.wave, fr = lane & 15, g = lane >> 4;
    LAS unsigned char* L = F.lds;
    const size_t tb = (size_t)b * SEQ;
    const int item0 = bh * 128;
    const int lt = tid - 256;
#define GDN_SRC(it, i) ((i) < 4 ? (const v4u*)(Gb.NW + (size_t)(it) * 8192) + lt + 256 * (i) : (i) < 8 ? (const v4u*)(Gb.QD + (size_t)(it) * 8192) + lt + 256 * ((i) - 4) : \
                        (i) < 12 ? (const v4u*)(Gb.KDT + (size_t)(it) * 8192) + lt + 256 * ((i) - 8) : (i) < 14 ? (const v4u*)(Gb.QK + (size_t)(it) * 4096) + lt + 256 * ((i) - 12) : \
                        (const v4u*)(Gb.UT + (size_t)(it) * 8192 + half * 2048) + lt + 256 * ((i) - 14))
#define GDN_LOADR(R, it) do { _Pragma("unroll") for (int i_ = 0; i_ < 15; ++i_) R[i_] = *GDN_SRC(it, i_); } while (0)
#define GDN_STORER(R, bufp) do { _Pragma("unroll") for (int i_ = 0; i_ < 15; ++i_) *(LAS v4u*)((bufp) + (i_ * 256 + lt) * 16) = R[i_]; } while (0)
    LAS float* CDL = (LAS float*)(L + 131072 + 1024);
    LAS bf16_t* OTB = (LAS bf16_t*)(L + 131072 + 2048);
#define GDN_OSTORE(step) do { if (wave < 6 && (step) < 128) { const LAS bf16_t* ot_ = OTB + ((wave - 4) * 2 + ((step) & 1)) * 1024; \
        const v4u o0_ = *(const LAS v4u*)(ot_ + lane * 16), o1_ = *(const LAS v4u*)(ot_ + lane * 16 + 8); \
        bf16_t* dst_ = Gb.ORAW + (tb + (size_t)(step) * 64 + lane) * 512 + h * 128 + half * 32 + (wave - 4) * 16; *(v4u*)dst_ = o0_; *(v4u*)(dst_ + 8) = o1_; } } while (0)
    if (wave >= 4) {
        if (wave == 4) { CDL[lane] = Gb.CD[item0 + lane]; CDL[64 + lane] = Gb.CD[item0 + 64 + lane]; }
        v4u r0[15], r1[15], r2[15];
        GDN_LOADR(r0, item0); GDN_LOADR(r1, item0 + 1); GDN_LOADR(r2, item0 + 2);
        GDN_STORER(r0, L);
        LDS_BARRIER();
#define GDN_CL(k) (item0 + ((k) < 127 ? (k) : 127))
        for (int n = 0; n < 129; n += 3) {
            GDN_LOADR(r0, GDN_CL(n + 3)); GDN_STORER(r1, L + ((n + 1) & 1) * 65536); LDS_BARRIER(); GDN_OSTORE(n);
            GDN_LOADR(r1, GDN_CL(n + 4)); GDN_STORER(r2, L + ((n + 2) & 1) * 65536); LDS_BARRIER(); GDN_OSTORE(n + 1);
            GDN_LOADR(r2, GDN_CL(n + 5)); GDN_STORER(r0, L + ((n + 3) & 1) * 65536); LDS_BARRIER(); GDN_OSTORE(n + 2);
        }
#undef GDN_CL
    } else if (wave >= 2) {
        for (int n = 0; n < 130; ++n) LDS_BARRIER();
    } else {
        LDS_BARRIER();
        f32x4_t S[8];
#pragma unroll
        for (int i = 0; i < 8; ++i) S[i] = (f32x4_t){0.f, 0.f, 0.f, 0.f};
        for (int n = 0; n < 128; ++n) {
            LAS unsigned char* B = L + (n & 1) * 65536;
            const float cd = CDL[n];
            bf16x8_t sb[4];
#pragma unroll
            for (int ks = 0; ks < 4; ++ks) sb[ks] = __builtin_bit_cast(bf16x8_t, (v4u){cvtpk(S[2 * ks][0], S[2 * ks][1]), cvtpk(S[2 * ks][2], S[2 * ks][3]), cvtpk(S[2 * ks + 1][0], S[2 * ks + 1][1]), cvtpk(S[2 * ks + 1][2], S[2 * ks + 1][3])});
#define GDN_SB() __builtin_amdgcn_sched_barrier(0)
            const LAS unsigned char* Bl = B + lane * 16;
            v2u u8[4]; bf16x8_t fa[16], fb[16];
#pragma unroll
            for (int rt = 0; rt < 4; ++rt) u8[rt] = *(const LAS v2u*)(B + 57344 + ((wave * 16 + fr) * 64 + 16 * rt + 4 * g) * 2);
#pragma unroll
            for (int i = 0; i < 16; ++i) fa[i] = *(const LAS bf16x8_t*)(Bl + ((i & 3) * 4 + (i >> 2)) * 1024);
            GDN_SB();
#pragma unroll
            for (int i = 0; i < 16; ++i) fb[i] = *(const LAS bf16x8_t*)(Bl + 16384 + ((i & 3) * 4 + (i >> 2)) * 1024);
            GDN_SB();
            f32x4_t va[4], oa[4];
#pragma unroll
            for (int rt = 0; rt < 4; ++rt) { va[rt] = (f32x4_t){bflo(u8[rt].x), bfhi(u8[rt].x), bflo(u8[rt].y), bfhi(u8[rt].y)}; oa[rt] = (f32x4_t){0.f, 0.f, 0.f, 0.f}; }
#pragma unroll
            for (int i = 0; i < 16; ++i) va[i & 3] = __builtin_amdgcn_mfma_f32_16x16x32_bf16(fa[i], sb[i >> 2], va[i & 3], 0, 0, 0);
            GDN_SB();
#pragma unroll
            for (int i = 0; i < 8; ++i) fa[i] = *(const LAS bf16x8_t*)(Bl + 49152 + ((i & 3) * 2 + (i >> 2)) * 1024);
#pragma unroll
            for (int i = 0; i < 8; ++i) fa[8 + i] = *(const LAS bf16x8_t*)(Bl + 32768 + ((i & 3) * 2 + (i >> 2)) * 1024);
            GDN_SB();
#pragma unroll
            for (int i = 0; i < 16; ++i) oa[i & 3] = __builtin_amdgcn_mfma_f32_16x16x32_bf16(fb[i], sb[i >> 2], oa[i & 3], 0, 0, 0);
            bf16x8_t vb[2];
#pragma unroll
            for (int k2 = 0; k2 < 2; ++k2) vb[k2] = __builtin_bit_cast(bf16x8_t, (v4u){cvtpk(va[2 * k2][0], va[2 * k2][1]), cvtpk(va[2 * k2][2], va[2 * k2][3]), cvtpk(va[2 * k2 + 1][0], va[2 * k2 + 1][1]), cvtpk(va[2 * k2 + 1][2], va[2 * k2 + 1][3])});
#pragma unroll
            for (int dt = 0; dt < 8; ++dt) S[dt] = S[dt] * cd;
            GDN_SB();
#pragma unroll
            for (int i = 0; i < 8; ++i) fb[i] = *(const LAS bf16x8_t*)(Bl + 32768 + 8192 + ((i & 3) * 2 + (i >> 2)) * 1024);
            GDN_SB();
#pragma unroll
            for (int i = 0; i < 8; ++i) oa[i & 3] = __builtin_amdgcn_mfma_f32_16x16x32_bf16(fa[i], vb[i >> 2], oa[i & 3], 0, 0, 0);
#pragma unroll
            for (int i = 0; i < 8; ++i) S[i & 3] = __builtin_amdgcn_mfma_f32_16x16x32_bf16(fa[8 + i], vb[i >> 2], S[i & 3], 0, 0, 0);
            GDN_SB();
#pragma unroll
            for (int i = 0; i < 8; ++i) S[4 + (i & 3)] = __builtin_amdgcn_mfma_f32_16x16x32_bf16(fb[i], vb[i >> 2], S[4 + (i & 3)], 0, 0, 0);
            GDN_SB();
#undef GDN_SB
            { LAS bf16_t* OT = OTB + (wave * 2 + (n & 1)) * 1024;
#pragma unroll
              for (int rt = 0; rt < 4; ++rt)
#pragma unroll
                for (int r = 0; r < 4; ++r) OT[(16 * rt + 4 * g + r) * 16 + fr] = f2bf(oa[rt][r]); }
            LDS_BARRIER();
        }
        LDS_BARRIER();
    }
#undef GDN_SRC
#undef GDN_LOADR
#undef GDN_OSTORE
#undef GDN_STORER
}

__device__ __forceinline__ void gdn_finish_phase(Frame& F, const Args& a, const GdnBufs& Gb, const bf16_t* GZ, bf16_t* OG) {
    const int gt = F.vcu * NWAVES * 64 + F.tid, ngt = F.G * NWAVES * 64;
    for (int p = gt; p < T * 64; p += ngt) {
        const size_t t = (size_t)(p >> 6); const int col = (p & 63) * 8, e0 = col & 127;
        const v4u o = *(const v4u*)(Gb.ORAW + t * 512 + col), z = *(const v4u*)(GZ + t * 512 + col);
        const unsigned ow[4] = {o.x, o.y, o.z, o.w}, zw[4] = {z.x, z.y, z.z, z.w};
        float ss = 0.f;
#pragma unroll
        for (int i = 0; i < 4; ++i) { const float a0 = bflo(ow[i]), a1 = bfhi(ow[i]); ss += a0 * a0 + a1 * a1; }
        ss += __shfl_xor(ss, 1); ss += __shfl_xor(ss, 2); ss += __shfl_xor(ss, 4); ss += __shfl_xor(ss, 8);
        const float rinv = rsqrtf(ss * (1.f / 128.f) + EPS);
        const f32x4_t g0 = *(const f32x4_t*)(a.gdn_norm_g + e0), g1 = *(const f32x4_t*)(a.gdn_norm_g + e0 + 4);
        const float gg[8] = {g0[0], g0[1], g0[2], g0[3], g1[0], g1[1], g1[2], g1[3]};
        unsigned r[4];
#pragma unroll
        for (int i = 0; i < 4; ++i) { const float z0 = bflo(zw[i]), z1 = bfhi(zw[i]);
            r[i] = cvtpk(bflo(ow[i]) * rinv * gg[2 * i] * (z0 / (1.f + __expf(-z0))), bfhi(ow[i]) * rinv * gg[2 * i + 1] * (z1 / (1.f + __expf(-z1)))); }
        *(v4u*)(OG + t * 512 + col) = (v4u){r[0], r[1], r[2], r[3]};
    }
}
typedef float f32x2_t __attribute__((ext_vector_type(2)));
__device__ __forceinline__ float gelu_erf(float v) { return 0.5f * v * (1.f + erff(v * 0.70710678118654752f)); }
constexpr int PEER_CH = 16;
constexpr int CW_PEERU = 8192, CW_PEERV = 8192 + 1024;

#define PEER_U_COMPUTE(W, TOK) do { const size_t t_ = (TOK); const float rs = rstd2[t_]; \
        const v4u xr0 = *(const v4u*)(X2B + t_ * 1024 + 128 * x + 16 * j), xr1 = *(const v4u*)(X2B + t_ * 1024 + 128 * x + 16 * j + 8); \
        const unsigned xw[8] = {xr0.x, xr0.y, xr0.z, xr0.w, xr1.x, xr1.y, xr1.z, xr1.w}; f32x2_t xf[8]; \
        _Pragma("unroll") for (int q = 0; q < 8; ++q) { xf[q].x = bflo(xw[q]) * rs * gp[q >> 1][(q & 1) * 2]; xf[q].y = bfhi(xw[q]) * rs * gp[q >> 1][(q & 1) * 2 + 1]; } \
        float p[16]; \
        _Pragma("unroll") for (int i = 0; i < 16; ++i) { const unsigned ww[4] = {W[i].x, W[i].y, W[i].z, W[i].w}; f32x2_t acc = {0.f, 0.f}; \
            _Pragma("unroll") for (int q = 0; q < 4; ++q) { acc = __builtin_elementwise_fma(__builtin_amdgcn_cvt_pk_f32_fp8(ww[q], false), xf[2 * q], acc); acc = __builtin_elementwise_fma(__builtin_amdgcn_cvt_pk_f32_fp8(ww[q], true), xf[2 * q + 1], acc); } \
            p[i] = acc.x + acc.y; } \
        _Pragma("unroll") for (int off = 4; off >= 1; off >>= 1) { const bool up = (j & off) != 0; \
            _Pragma("unroll") for (int i = 0; i < 2 * off; ++i) { const float lo = p[i], hi = p[i + 2 * off]; const float send = up ? lo : hi, keep = up ? hi : lo; p[i] = keep + __shfl_xor(send, off); } } \
        bf16_t* dst = PART + ((size_t)x * T + t_) * 128 + 16 * j + g; dst[0] = f2bf(p[0]); dst[8] = f2bf(p[1]); } while (0)
__device__ __forceinline__ void peer_u_phase(Frame& F, const Args& a, gu32* ctl, const bf16_t* X2B, const float* rstd2, const int* EIDX, const unsigned char* U8, bf16_t* PART) {
    const int lane = F.lane, g = lane >> 3, j = lane & 7;
    const int x0 = (int)(xb_xcc_id() & 7u);
    for (int s = 0; s < 8; ++s) {
        const int x = (x0 + s) & 7;
        f32x4_t gp[4];
#pragma unroll
        for (int q = 0; q < 4; ++q) gp[q] = *(const f32x4_t*)(a.g_peer + 128 * x + 16 * j + 4 * q);
        const unsigned char* Ux = U8 + (size_t)x * 16384 * 128 + 16 * j;
        for (;;) {
            int c = 0; if (lane == 0) c = (int)__hip_atomic_fetch_add(ctl + CW_PEERU + 64 * x, 1u, __ATOMIC_RELAXED, __HIP_MEMORY_SCOPE_AGENT);
            c = __builtin_amdgcn_readfirstlane(c);
            if (c >= T / PEER_CH) break;
            const size_t tc = (size_t)c * PEER_CH, tl = tc + PEER_CH - 1;
            int en[16]; v4u wa[16], wb[16];
            { const int e0_ = EIDX[(tc) * 128 + lane], e1_ = EIDX[(tc) * 128 + 64 + lane];
#pragma unroll
              for (int i = 0; i < 16; ++i) en[i] = __shfl(i < 8 ? e0_ : e1_, 8 * (i & 7) + g); }
#pragma unroll
            for (int i = 0; i < 16; ++i) wa[i] = *(const v4u*)(Ux + (size_t)en[i] * 128);
            { const int e0_ = EIDX[((tc + 1)) * 128 + lane], e1_ = EIDX[((tc + 1)) * 128 + 64 + lane];
#pragma unroll
              for (int i = 0; i < 16; ++i) en[i] = __shfl(i < 8 ? e0_ : e1_, 8 * (i & 7) + g); }
            for (int tt = 0; tt < PEER_CH; tt += 2) {
                const size_t t = tc + tt, t2 = (t + 2 < tl) ? t + 2 : tl, t3 = (t + 3 < tl) ? t + 3 : tl;
#pragma unroll
                for (int i = 0; i < 16; ++i) wb[i] = *(const v4u*)(Ux + (size_t)en[i] * 128);
                { const int e0_ = EIDX[(t2) * 128 + lane], e1_ = EIDX[(t2) * 128 + 64 + lane];
#pragma unroll
              for (int i = 0; i < 16; ++i) en[i] = __shfl(i < 8 ? e0_ : e1_, 8 * (i & 7) + g); }
                PEER_U_COMPUTE(wa, t);
#pragma unroll
                for (int i = 0; i < 16; ++i) wa[i] = *(const v4u*)(Ux + (size_t)en[i] * 128);
                { const int e0_ = EIDX[(t3) * 128 + lane], e1_ = EIDX[(t3) * 128 + 64 + lane];
#pragma unroll
              for (int i = 0; i < 16; ++i) en[i] = __shfl(i < 8 ? e0_ : e1_, 8 * (i & 7) + g); }
                PEER_U_COMPUTE(wb, t + 1);
            }
        }
    }
}
__device__ __forceinline__ void peer_combine_phase(Frame& F, const bf16_t* PART, const int* EIDX, const float* EGATE, const float* SU, const float* SV, float* ACTS) {
    const int gt = F.vcu * NWAVES * 64 + F.tid, ngt = F.G * NWAVES * 64;
    for (int p = gt; p < T * 32; p += ngt) {
        f32x4_t s = {0.f, 0.f, 0.f, 0.f};
#pragma unroll
        for (int x = 0; x < 8; ++x) { const v2u w = *(const v2u*)(PART + (size_t)x * T * 128 + (size_t)p * 4); s += (f32x4_t){bflo(w.x), bfhi(w.x), bflo(w.y), bfhi(w.y)}; }
        const int4 e = *(const int4*)(EIDX + (size_t)p * 4); const f32x4_t gt4 = *(const f32x4_t*)(EGATE + (size_t)p * 4);
        *(f32x4_t*)(ACTS + (size_t)p * 4) = (f32x4_t){gelu_erf(s[0] * SU[e.x]) * gt4[0] * SV[e.x], gelu_erf(s[1] * SU[e.y]) * gt4[1] * SV[e.y], gelu_erf(s[2] * SU[e.z]) * gt4[2] * SV[e.z], gelu_erf(s[3] * SU[e.w]) * gt4[3] * SV[e.w]};
    }
}
#define PEER_V_COMPUTE(W, TOK) do { const size_t t_ = (TOK); float av[16]; \
        { const float a0_ = ACTS[t_ * 128 + lane], a1_ = ACTS[t_ * 128 + 64 + lane]; _Pragma("unroll") for (int i = 0; i < 16; ++i) av[i] = __shfl(i < 8 ? a0_ : a1_, 8 * (i & 7) + g); } \
        const size_t oo_ = t_ * 1024 + 128 * x + 16 * j + 2 * g; const unsigned xw_ = *(const unsigned*)(X2B + oo_); const f32x2_t xv = {bflo(xw_), bfhi(xw_)}; \
        f32x2_t o2[8]; _Pragma("unroll") for (int q = 0; q < 8; ++q) o2[q] = (f32x2_t){0.f, 0.f}; \
        _Pragma("unroll") for (int i = 0; i < 16; ++i) { const unsigned ww[4] = {W[i].x, W[i].y, W[i].z, W[i].w}; const f32x2_t a2 = {av[i], av[i]}; \
            _Pragma("unroll") for (int q = 0; q < 4; ++q) { o2[2 * q] = __builtin_elementwise_fma(__builtin_amdgcn_cvt_pk_f32_fp8(ww[q], false), a2, o2[2 * q]); o2[2 * q + 1] = __builtin_elementwise_fma(__builtin_amdgcn_cvt_pk_f32_fp8(ww[q], true), a2, o2[2 * q + 1]); } } \
        float o[16]; _Pragma("unroll") for (int q = 0; q < 8; ++q) { o[2 * q] = o2[q].x; o[2 * q + 1] = o2[q].y; } \
        _Pragma("unroll") for (int off = 4; off >= 1; off >>= 1) { const bool up = (g & off) != 0; \
            _Pragma("unroll") for (int i = 0; i < 2 * off; ++i) { const float lo = o[i], hi = o[i + 2 * off]; const float send = up ? lo : hi, keep = up ? hi : lo; o[i] = keep + __shfl_xor(send, 8 * off); } } \
        const unsigned rw_ = cvtpk(xv.x + o[0], xv.y + o[1]); *(unsigned*)(X3B + oo_) = rw_; const float r0 = bflo(rw_), r1 = bfhi(rw_); \
        const float ss = wave_sum(r0 * r0 + r1 * r1); if (lane == 0) SS3[t_ * 8 + x] = ss; } while (0)
__device__ __forceinline__ void peer_v_phase(Frame& F, gu32* ctl, const int* EIDX, const float* ACTS, const unsigned char* V8, const bf16_t* X2B, bf16_t* X3B, float* SS3) {
    const int lane = F.lane, g = lane >> 3, j = lane & 7;
    const int x0 = (int)(xb_xcc_id() & 7u);
    for (int s = 0; s < 8; ++s) {
        const int x = (x0 + s) & 7;
        const unsigned char* Vx = V8 + (size_t)x * 16384 * 128 + 16 * j;
        for (;;) {
            int c = 0; if (lane == 0) c = (int)__hip_atomic_fetch_add(ctl + CW_PEERV + 64 * x, 1u, __ATOMIC_RELAXED, __HIP_MEMORY_SCOPE_AGENT);
            c = __builtin_amdgcn_readfirstlane(c);
            if (c >= T / PEER_CH) break;
            const size_t tc = (size_t)c * PEER_CH, tl = tc + PEER_CH - 1;
            int en[16]; v4u wa[16], wb[16];
            { const int e0_ = EIDX[(tc) * 128 + lane], e1_ = EIDX[(tc) * 128 + 64 + lane];
#pragma unroll
              for (int i = 0; i < 16; ++i) en[i] = __shfl(i < 8 ? e0_ : e1_, 8 * (i & 7) + g); }
#pragma unroll
            for (int i = 0; i < 16; ++i) wa[i] = *(const v4u*)(Vx + (size_t)en[i] * 128);
            { const int e0_ = EIDX[((tc + 1)) * 128 + lane], e1_ = EIDX[((tc + 1)) * 128 + 64 + lane];
#pragma unroll
              for (int i = 0; i < 16; ++i) en[i] = __shfl(i < 8 ? e0_ : e1_, 8 * (i & 7) + g); }
            for (int tt = 0; tt < PEER_CH; tt += 2) {
                const size_t t = tc + tt, t2 = (t + 2 < tl) ? t + 2 : tl, t3 = (t + 3 < tl) ? t + 3 : tl;
#pragma unroll
                for (int i = 0; i < 16; ++i) wb[i] = *(const v4u*)(Vx + (size_t)en[i] * 128);
                { const int e0_ = EIDX[(t2) * 128 + lane], e1_ = EIDX[(t2) * 128 + 64 + lane];
#pragma unroll
              for (int i = 0; i < 16; ++i) en[i] = __shfl(i < 8 ? e0_ : e1_, 8 * (i & 7) + g); }
                PEER_V_COMPUTE(wa, t);
#pragma unroll
                for (int i = 0; i < 16; ++i) wa[i] = *(const v4u*)(Vx + (size_t)en[i] * 128);
                { const int e0_ = EIDX[(t3) * 128 + lane], e1_ = EIDX[(t3) * 128 + 64 + lane];
#pragma unroll
              for (int i = 0; i < 16; ++i) en[i] = __shfl(i < 8 ? e0_ : e1_, 8 * (i & 7) + g); }
                PEER_V_COMPUTE(wb, t + 1);
            }
        }
    }
}
__device__ __forceinline__ void peer_norm_phase(Frame& F, const Args& a, const float* SS3, const bf16_t* X3B, float* out) {
    const int gt = F.vcu * NWAVES * 64 + F.tid, ngt = F.G * NWAVES * 64;
    for (int p = gt; p < T * 128; p += ngt) {
        const size_t t = (size_t)(p >> 7); const int c = (p & 127) * 8;
        const f32x4_t s0 = *(const f32x4_t*)(SS3 + t * 8), s1 = *(const f32x4_t*)(SS3 + t * 8 + 4);
        const float r3 = rsqrtf(((s0[0] + s0[1]) + (s0[2] + s0[3]) + (s1[0] + s1[1]) + (s1[2] + s1[3])) * (1.f / D) + EPS);
        const v4u w = *(const v4u*)(X3B + t * 1024 + c);
        const f32x4_t g0 = *(const f32x4_t*)(a.g_final + c), g1 = *(const f32x4_t*)(a.g_final + c + 4);
        *(f32x4_t*)(out + t * 1024 + c) = (f32x4_t){bflo(w.x), bfhi(w.x), bflo(w.y), bfhi(w.y)} * g0 * r3;
        *(f32x4_t*)(out + t * 1024 + c + 4) = (f32x4_t){bflo(w.z), bfhi(w.z), bflo(w.w), bfhi(w.w)} * g1 * r3;
    }
}
#ifndef TOPK_HD
#define TOPK_HD __device__ __forceinline__
#endif
TOPK_HD void ce_desc(unsigned& a, unsigned& b) { const unsigned hi = a > b ? a : b, lo = a > b ? b : a; a = hi; b = lo; }
TOPK_HD void sort16_desc(unsigned (&v)[16]) {
#pragma unroll
    for (int k = 2; k <= 16; k <<= 1)
#pragma unroll
        for (int j = k >> 1; j >= 1; j >>= 1)
#pragma unroll
            for (int i = 0; i < 16; ++i) { const int l = i ^ j; if (l > i) { if ((i & k) == 0) ce_desc(v[i], v[l]); else ce_desc(v[l], v[i]); } }
}
TOPK_HD void bitonic_merge16_desc(unsigned (&v)[16]) {
#pragma unroll
    for (int j = 8; j >= 1; j >>= 1)
#pragma unroll
        for (int i = 0; i < 16; ++i) { const int l = i ^ j; if (l > i) ce_desc(v[i], v[l]); }
}
TOPK_HD void top16_merge(unsigned (&a)[16], const unsigned (&b)[16]) {
#pragma unroll
    for (int i = 0; i < 16; ++i) a[i] = a[i] > b[15 - i] ? a[i] : b[15 - i];
    bitonic_merge16_desc(a);
}
TOPK_HD unsigned f2ord(float f) { const unsigned u = __builtin_bit_cast(unsigned, f); return (u & 0x80000000u) ? ~u : (u | 0x80000000u); }
TOPK_HD float ord2f(unsigned o) { const unsigned u = (o & 0x80000000u) ? (o & 0x7fffffffu) : ~o; return __builtin_bit_cast(float, u); }

__device__ __forceinline__ void peer_route_task(Frame& F, const bf16_t* PQ, const bf16_t* SK16, int* EIDX, float* EGATE, int tt, int h) {
    constexpr int CI[50] = {0,0,0,0,0,0,0,0,0,0,0,0,0,0,0,0,1,1,1,1,1,1,1,1,2,2,2,2,2,3,3,3,3,4,4,4,5,5,6,6,7,7,8,9,10,11,12,13,14,15};
    constexpr int CJ[50] = {0,1,2,3,4,5,6,7,8,9,10,11,12,13,14,15,0,1,2,3,4,5,6,7,0,1,2,3,4,0,1,2,3,0,1,2,0,1,0,1,0,1,0,0,0,0,0,0,0,0};
    int lane = F.lane; asm volatile("" : "+v"(lane));
    const int t = lane & 31, hi = lane >> 5;
    LAS unsigned* wl = (LAS unsigned*)(F.lds + F.wave * 16384) + lane * 33;
    {
        const size_t row = (size_t)tt * 32 + t;
        unsigned L[2][16];
#pragma unroll
        for (int p = 0; p < 2; ++p) {
            const int hp = h * 2 + p;
            bf16x8_t Bf[8], An[8];
#pragma unroll
            for (int ks = 0; ks < 8; ++ks) Bf[ks] = *(const bf16x8_t*)(PQ + row * 2048 + hp * 128 + 16 * ks + 8 * hi);
            const bf16_t* Abase = SK16 + ((size_t)(hp * 128 + t)) * 128 + 8 * hi;
#pragma unroll
            for (int ks = 0; ks < 8; ++ks) An[ks] = *(const bf16x8_t*)(Abase + 16 * ks);
#pragma unroll
            for (int i = 0; i < 16; ++i) L[p][i] = 0u;
#pragma unroll 1
            for (int nt = 0; nt < 4; ++nt) {
                bf16x8_t Ac[8];
#pragma unroll
                for (int ks = 0; ks < 8; ++ks) Ac[ks] = An[ks];
                const int nn = nt < 3 ? nt + 1 : 3;
#pragma unroll
                for (int ks = 0; ks < 8; ++ks) An[ks] = *(const bf16x8_t*)(Abase + (size_t)nn * 32 * 128 + 16 * ks);
                f32x16_t acc = {};
#pragma unroll
                for (int ks = 0; ks < 8; ++ks) acc = __builtin_amdgcn_mfma_f32_32x32x16_bf16(Ac[ks], Bf[ks], acc, 0, 0, 0);
                unsigned k[16];
#pragma unroll
                for (int r = 0; r < 16; ++r) { const int n = 32 * nt + (r & 3) + 8 * (r >> 2) + 4 * hi; k[r] = (f2ord(acc[r]) & ~127u) | (unsigned)(127 - n); }
                sort16_desc(k);
                top16_merge(L[p], k);
            }
            unsigned pb[16];
#pragma unroll
            for (int i = 0; i < 16; ++i) pb[i] = __shfl_xor(L[p][i], 32);
            top16_merge(L[p], pb);
        }
        float sa[16], sb[16];
#pragma unroll
        for (int i = 0; i < 16; ++i) { sa[i] = ord2f(L[0][i] & ~127u); sb[i] = ord2f(L[1][i] & ~127u); wl[i] = 127u - (L[0][i] & 127u); wl[16 + i] = 127u - (L[1][i] & 127u); }
        unsigned c0[16], c1[16];
#pragma unroll
        for (int s = 0; s < 32; ++s) {
            unsigned key = 0u;
            if (s < 25) { const float v = hi ? sa[CI[25 + s]] + sb[CJ[25 + s]] : sa[CI[s]] + sb[CJ[s]]; const int pos = hi ? CI[25 + s] * 16 + CJ[25 + s] : CI[s] * 16 + CJ[s];
                key = (f2ord(v) & ~255u) | (unsigned)(255 - pos); }
            if (s < 16) c0[s] = key; else c1[s - 16] = key;
        }
        sort16_desc(c0); sort16_desc(c1); top16_merge(c0, c1);
        unsigned pb[16];
#pragma unroll
        for (int i = 0; i < 16; ++i) pb[i] = __shfl_xor(c0[i], 32);
        top16_merge(c0, pb);
        float e[16]; const float m = ord2f(c0[0] & ~255u); float l = 0.f;
#pragma unroll
        for (int r = 0; r < 16; ++r) { e[r] = __expf(ord2f(c0[r] & ~255u) - m); l += e[r]; }
        const float il = 1.f / l;
        int ex[8]; float gt[8];
#pragma unroll
        for (int q = 0; q < 8; ++q) { const unsigned kk = hi ? c0[8 + q] : c0[q]; const int pos = 255 - (int)(kk & 255u); ex[q] = (int)(wl[pos >> 4] * 128u + wl[16 + (pos & 15)]); gt[q] = (hi ? e[8 + q] : e[q]) * il; }
        int* ep = EIDX + row * 128 + h * 16 + hi * 8; float* gp = EGATE + row * 128 + h * 16 + hi * 8;
        *(int4*)ep = make_int4(ex[0], ex[1], ex[2], ex[3]); *(int4*)(ep + 4) = make_int4(ex[4], ex[5], ex[6], ex[7]);
        *(f32x4_t*)gp = (f32x4_t){gt[0], gt[1], gt[2], gt[3]}; *(f32x4_t*)(gp + 4) = (f32x4_t){gt[4], gt[5], gt[6], gt[7]};
    }
}
__device__ __forceinline__ void cross_item(Frame& F, const bf16_t* QC, const bf16_t* KC, const bf16_t* VC, bf16_t* OC, int bh, int qb) {
    int tid = F.tid; asm volatile("" : "+v"(tid));
    const int lane = tid & 63, wave = F.wave, q = lane & 31, hi = lane >> 5;
    LAS unsigned char* L = F.lds;
    const int g4 = lane >> 4, qq = (lane >> 2) & 3, p4 = lane & 3;
    {
        const int b = bh >> 2, h = bh & 3;
#pragma unroll
        for (int i = 0; i < 16; ++i) { const int cid = tid + 512 * i, r = cid >> 5, c = cid & 31;
            *(LAS v4u*)(L + r * 512 + ((c ^ (r & 15)) << 4)) = *(const v4u*)(KC + (size_t)(b * 256 + r) * 1024 + h * 256 + c * 8); }
        const size_t qrow0 = (size_t)b * SEQ + qb * 256 + wave * 32;
        const bf16_t* Qp = QC + (qrow0 + q) * 1024 + h * 256 + 8 * hi;
        __syncthreads();
        f32x16_t st[8];
#pragma unroll
        for (int kt = 0; kt < 8; ++kt) st[kt] = (f32x16_t){};
#pragma unroll 2
        for (int ks = 0; ks < 16; ++ks) { const bf16x8_t qf = *(const bf16x8_t*)(Qp + 16 * ks);
#pragma unroll
            for (int kt = 0; kt < 8; ++kt) { const int row = 32 * kt + q;
                st[kt] = __builtin_amdgcn_mfma_f32_32x32x16_bf16(*(const LAS bf16x8_t*)(L + row * 512 + (((2 * ks + hi) ^ (row & 15)) << 4)), qf, st[kt], 0, 0, 0); } }
        float m = -INFINITY;
#pragma unroll
        for (int kt = 0; kt < 8; ++kt)
#pragma unroll
            for (int r = 0; r < 16; ++r) { st[kt][r] *= 0.0625f; m = fmaxf(m, st[kt][r]); }
        m = fmaxf(m, __shfl_xor(m, 32));
        float l = 0.f;
#pragma unroll
        for (int kt = 0; kt < 8; ++kt)
#pragma unroll
            for (int r = 0; r < 16; ++r) { st[kt][r] = __expf(st[kt][r] - m); l += st[kt][r]; }
        l += __shfl_xor(l, 32);
        const float il = 1.f / l;
        bf16x8_t pa[8][2];
#pragma unroll
        for (int kt = 0; kt < 8; ++kt)
#pragma unroll
            for (int s = 0; s < 2; ++s) pa[kt][s] = __builtin_bit_cast(bf16x8_t, (v4u){cvtpk(st[kt][8 * s] * il, st[kt][8 * s + 1] * il), cvtpk(st[kt][8 * s + 2] * il, st[kt][8 * s + 3] * il),
                                                                                        cvtpk(st[kt][8 * s + 4] * il, st[kt][8 * s + 5] * il), cvtpk(st[kt][8 * s + 6] * il, st[kt][8 * s + 7] * il)});
        __syncthreads();
#pragma unroll
        for (int i = 0; i < 16; ++i) { const int cid = tid + 512 * i, r = cid >> 5, c = cid & 31;
            *(LAS v4u*)(L + r * 512 + ((c ^ (4 * (r & 3))) << 4)) = *(const v4u*)(VC + (size_t)(b * 256 + r) * 1024 + h * 256 + c * 8); }
        __syncthreads();
        bf16_t* Op = OC + qrow0 * 1024 + h * 256 + q;
#pragma unroll 1
        for (int dt = 0; dt < 8; ++dt) {
            f32x16_t o = {};
            LAS unsigned char* vb = L + (4 * (g4 >> 1) + qq) * 512 + (((dt * 64) ^ (qq << 6)) + (g4 & 1) * 32 + p4 * 8);
#pragma unroll
            for (int kt = 0; kt < 8; ++kt)
#pragma unroll
                for (int s = 0; s < 2; ++s) { const v4i16_t a0 = lds_tr16(vb + (32 * kt + 16 * s) * 512), a1 = lds_tr16(vb + (32 * kt + 16 * s + 8) * 512);
                    const bf16x8_t vf = {a0[0], a0[1], a0[2], a0[3], a1[0], a1[1], a1[2], a1[3]};
                    o = __builtin_amdgcn_mfma_f32_32x32x16_bf16(pa[kt][s], vf, o, 0, 0, 0); }
#pragma unroll
            for (int r = 0; r < 16; ++r) { const int row = (r & 3) + 8 * (r >> 2) + 4 * hi; Op[(size_t)row * 1024 + dt * 32] = f2bf(o[r]); }
        }
        __syncthreads();
    }
}
template <bool REMAP>
__device__ __forceinline__ void transpose_tile(const float* W, int K, int N, const float* gain, bf16_t* WT, LAS float* tile, int item, int tid) {
    const int nblk = (N + 255) / 256, kb = item / nblk, nb = item % nblk, k0 = 64 * kb, n0 = 256 * nb;
    const int c4 = (tid & 63) * 4, kr = tid >> 6;
    f32x4 v[8];
#pragma unroll
    for (int i = 0; i < 8; ++i) { const int k = kr + 8 * i; v[i] = (n0 + c4 < N) ? *(const GAS f32x4*)(W + (size_t)(k0 + k) * N + n0 + c4) : (f32x4){0.f, 0.f, 0.f, 0.f}; }
#pragma unroll
    for (int i = 0; i < 8; ++i) { const int k = kr + 8 * i; LAS float* d = tile + k * 257 + c4; d[0] = v[i].x; d[1] = v[i].y; d[2] = v[i].z; d[3] = v[i].w; }
    __syncthreads();
#pragma unroll
    for (int i = 0; i < 4; ++i) { const int p = tid + 512 * i, n = p >> 3, c = p & 7; const LAS float* sp = tile + (8 * c) * 257 + n;
        float g[8];
#pragma unroll
        for (int q = 0; q < 8; ++q) g[q] = gain ? gain[k0 + 8 * c + q] : 1.f;
        v4u o; o.x = pk2(sp[0 * 257] * g[0], sp[1 * 257] * g[1]); o.y = pk2(sp[2 * 257] * g[2], sp[3 * 257] * g[3]); o.z = pk2(sp[4 * 257] * g[4], sp[5 * 257] * g[5]); o.w = pk2(sp[6 * 257] * g[6], sp[7 * 257] * g[7]);
        int ng = n0 + n; bool ok = ng < N;
        if (REMAP) { if (ng >= 3584 && ng < 3592) ok = false; else if (ng >= 3592) ng -= 8; }
        if (ok) *(GAS v4u*)(WT + (size_t)ng * K + k0 + 8 * c) = o; }
    __syncthreads();
}

__device__ __forceinline__ void p0_prologue(Frame& F, const Args& a) {
    unsigned char* ws = a.ws;
    LAS float* tile = (LAS float*)F.lds;
    const int gw = F.vcu * NWAVES + F.wave, NGW = F.G * NWAVES;
    constexpr int I_IN = 16 * 23;
    for (int it = F.vcu; it < I_IN; it += F.G) transpose_tile<true>(a.w_in, 1024, IN_COLS, a.g_mix, (bf16_t*)(ws + WS_WIN), tile, it, F.tid);
    __syncthreads();
    LAS float* wsm = (LAS float*)F.lds;
    for (int i = F.tid; i < 8192; i += NWAVES * 64) { const int j = i >> 10, k = i & 1023; wsm[i] = a.w_in[(size_t)k * IN_COLS + 3584 + j] * a.g_mix[k]; }
    __syncthreads();
    bf16_t* XB = (bf16_t*)(ws + WS_A0); float* rstd0 = (float*)(ws + WS_RSTD0); float* GB = (float*)(ws + WS_GB); float* GA = GB + T * 4;
    for (int row0 = gw * 4; row0 < T; row0 += NGW * 4) {
        f32x4 v[4][4];
#pragma unroll
        for (int r = 0; r < 4; ++r)
#pragma unroll
            for (int j = 0; j < 4; ++j) v[r][j] = *((const GAS f32x4*)(a.x + (size_t)(row0 + r) * D) + F.lane + 64 * j);
#pragma unroll
        for (int r = 0; r < 4; ++r) { const int row = row0 + r; float s = 0.f;
#pragma unroll
            for (int j = 0; j < 4; ++j) s += (v[r][j].x * v[r][j].x + v[r][j].y * v[r][j].y) + (v[r][j].z * v[r][j].z + v[r][j].w * v[r][j].w);
            const float rstd = rsqrtf(wave_sum(s) * (1.f / D) + EPS);
            GAS unsigned long long* o8 = (GAS unsigned long long*)(XB + (size_t)row * D) + F.lane;
#pragma unroll
            for (int j = 0; j < 4; ++j) o8[64 * j] = (unsigned long long)pk2(v[r][j].x, v[r][j].y) | ((unsigned long long)pk2(v[r][j].z, v[r][j].w) << 32);
            float dj[8];
#pragma unroll
            for (int jj = 0; jj < 8; ++jj) { float d = 0.f;
#pragma unroll
                for (int j = 0; j < 4; ++j) { const f32x4 w = *(const LAS f32x4*)(wsm + jj * 1024 + (F.lane + 64 * j) * 4); d += (v[r][j].x * w.x + v[r][j].y * w.y) + (v[r][j].z * w.z + v[r][j].w * w.w); }
                dj[jj] = d; }
#pragma unroll
            for (int off = 4; off >= 1; off >>= 1) { const bool up = (F.lane & off) != 0;
#pragma unroll
                for (int i = 0; i < off; ++i) { const float lo = dj[i], hi = dj[i + off]; const float send = up ? lo : hi, keep = up ? hi : lo; dj[i] = keep + __shfl_xor(send, off); } }
            float d0 = dj[0]; d0 += __shfl_xor(d0, 8); d0 += __shfl_xor(d0, 16); d0 += __shfl_xor(d0, 32);
            if (F.lane == 0) rstd0[row] = rstd;
            if (F.lane < 4) GB[(size_t)row * 4 + F.lane] = d0 * rstd; else if (F.lane < 8) GA[(size_t)row * 4 + F.lane - 4] = d0 * rstd; }
    }
}
__device__ __forceinline__ void late_prologue(Frame& F, const Args& a, int wgi, int nwg) {
    unsigned char* ws = a.ws;
    LAS float* tile = (LAS float*)F.lds;
    const int gw = wgi * NWAVES + F.wave, NGW = nwg * NWAVES;
    constexpr int I_S = 8 * 4, I_M = 16 * 4, I_L = 16 * 8;
    constexpr int NITEMS = 2 * I_S + 3 * I_M + 2 * I_L;
    for (int it = wgi; it < NITEMS; it += nwg) {
        int r = it;
        if (r < I_S) { transpose_tile<false>(a.w_sb_up, 512, 1024, nullptr, (bf16_t*)(ws + WS_WSB), tile, r, F.tid); continue; } r -= I_S;
        if (r < I_S) { transpose_tile<false>(a.w_gdn_up, 512, 1024, nullptr, (bf16_t*)(ws + WS_WGDN), tile, r, F.tid); continue; } r -= I_S;
        if (r < I_M) { transpose_tile<false>(a.w_mix_out, 1024, 1024, nullptr, (bf16_t*)(ws + WS_WMIX), tile, r, F.tid); continue; } r -= I_M;
        if (r < I_M) { transpose_tile<false>(a.w_cq, 1024, 1024, a.g_cross, (bf16_t*)(ws + WS_WCQ), tile, r, F.tid); continue; } r -= I_M;
        if (r < I_M) { transpose_tile<false>(a.w_co, 1024, 1024, nullptr, (bf16_t*)(ws + WS_WCO), tile, r, F.tid); continue; } r -= I_M;
        if (r < I_L) { transpose_tile<false>(a.w_ckv, 1024, 2048, nullptr, (bf16_t*)(ws + WS_WCKV), tile, r, F.tid); continue; } r -= I_L;
        transpose_tile<false>(a.w_pq, 1024, 2048, a.g_peer, (bf16_t*)(ws + WS_WPQ), tile, r, F.tid);
    }
    __syncthreads();
    {
        float* SUV = (float*)(ws + WS_SUV);
        for (int row0 = gw * 4; row0 < 2 * 16384; row0 += NGW * 4) {
            f32x4 v[4][4];
#pragma unroll
            for (int r = 0; r < 4; ++r) { const int row = row0 + r, tb = row >> 14, e = row & 16383; const float* src = (tb ? a.peer_v : a.peer_u) + (size_t)e * 1024 + 16 * F.lane;
#pragma unroll
                for (int q = 0; q < 4; ++q) v[r][q] = *(const GAS f32x4*)(src + 4 * q); }
#pragma unroll
            for (int r = 0; r < 4; ++r) { const int row = row0 + r, tb = row >> 14, e = row & 16383; float am = 0.f;
#pragma unroll
                for (int q = 0; q < 4; ++q) am = fmaxf(am, fmaxf(fmaxf(fabsf(v[r][q].x), fabsf(v[r][q].y)), fmaxf(fabsf(v[r][q].z), fabsf(v[r][q].w))));
#pragma unroll
                for (int o = 1; o < 64; o <<= 1) am = fmaxf(am, __shfl_xor(am, o));
                int ex = 0; if (am > 0.f) (void)frexpf(am, &ex);
                const float sc = ldexpf(1.f, 8 - ex), inv = ldexpf(1.f, ex - 8);
                v4u o; int rr;
                rr = __builtin_amdgcn_cvt_pk_fp8_f32(v[r][0].x * sc, v[r][0].y * sc, 0, false); rr = __builtin_amdgcn_cvt_pk_fp8_f32(v[r][0].z * sc, v[r][0].w * sc, rr, true); o.x = (unsigned)rr;
                rr = __builtin_amdgcn_cvt_pk_fp8_f32(v[r][1].x * sc, v[r][1].y * sc, 0, false); rr = __builtin_amdgcn_cvt_pk_fp8_f32(v[r][1].z * sc, v[r][1].w * sc, rr, true); o.y = (unsigned)rr;
                rr = __builtin_amdgcn_cvt_pk_fp8_f32(v[r][2].x * sc, v[r][2].y * sc, 0, false); rr = __builtin_amdgcn_cvt_pk_fp8_f32(v[r][2].z * sc, v[r][2].w * sc, rr, true); o.z = (unsigned)rr;
                rr = __builtin_amdgcn_cvt_pk_fp8_f32(v[r][3].x * sc, v[r][3].y * sc, 0, false); rr = __builtin_amdgcn_cvt_pk_fp8_f32(v[r][3].z * sc, v[r][3].w * sc, rr, true); o.w = (unsigned)rr;
                *(GAS v4u*)(ws + (tb ? WS_V8 : WS_U8) + ((size_t)(F.lane >> 3) * 16384 + e) * 128 + 16 * (F.lane & 7)) = o;
                if (F.lane == 0) SUV[row] = inv; }
        }
    }
    {
        const int gt = gw * 64 + F.lane, ngt = NGW * 64;
        for (int p = gt; p < 262144 / 8; p += ngt) { const float* src = a.subkeys + (size_t)p * 8; const f32x4 v0 = *(const GAS f32x4*)src, v1 = *(const GAS f32x4*)(src + 4);
            v4u o; o.x = pk2(v0.x, v0.y); o.y = pk2(v0.z, v0.w); o.z = pk2(v1.x, v1.y); o.w = pk2(v1.z, v1.w); *(GAS v4u*)((bf16_t*)(ws + WS_SKB) + (size_t)p * 8) = o; }
    }
    bf16_t* MN = (bf16_t*)(ws + WS_MN);
    for (int row = gw; row < 1024; row += NGW) {
        const GAS f32x4* xr = (const GAS f32x4*)(a.mem + (size_t)row * D) + F.lane;
        f32x4 v[4]; float s = 0.f;
#pragma unroll
        for (int j = 0; j < 4; ++j) { v[j] = xr[64 * j]; s += (v[j].x * v[j].x + v[j].y * v[j].y) + (v[j].z * v[j].z + v[j].w * v[j].w); }
        const float rstd = rsqrtf(wave_sum(s) * (1.f / D) + EPS);
        GAS unsigned long long* o8 = (GAS unsigned long long*)(MN + (size_t)row * D) + F.lane;
#pragma unroll
        for (int j = 0; j < 4; ++j) { const f32x4 g = *((const f32x4*)a.g_mem + F.lane + 64 * j); const f32x4 o = v[j] * g * rstd;
            o8[64 * j] = (unsigned long long)pk2(o.x, o.y) | ((unsigned long long)pk2(o.z, o.w) << 32); }
    }
}
__device__ __forceinline__ void sub_barrier(gu32* cnt, unsigned n, gu32* tmo) {
    asm volatile("s_waitcnt vmcnt(0)" ::: "memory");
    __syncthreads();
    if (threadIdx.x == 0) {
        __builtin_amdgcn_fence(__ATOMIC_RELEASE, "agent");
        asm volatile("s_waitcnt vmcnt(0)" ::: "memory");
        __hip_atomic_fetch_add(cnt, 1u, __ATOMIC_RELAXED, __HIP_MEMORY_SCOPE_AGENT);
        unsigned sp = 0;
        while (__hip_atomic_load(cnt, __ATOMIC_RELAXED, __HIP_MEMORY_SCOPE_AGENT) < n) { __builtin_amdgcn_s_sleep(2); if (++sp > (1u << 22)) { __hip_atomic_store(tmo, 1u, __ATOMIC_RELAXED, __HIP_MEMORY_SCOPE_AGENT); break; } }
        __builtin_amdgcn_fence(__ATOMIC_ACQUIRE, "agent");
        asm volatile("s_waitcnt vmcnt(0)" ::: "memory");
    }
    __syncthreads();
}

__global__ void __launch_bounds__(NWAVES * 64, 2) mk_fwd(Args args) {
    extern __shared__ __attribute__((aligned(16))) unsigned char lds_raw[];
    Frame F;
    F.lds = (LAS unsigned char*)lds_raw;
    F.tid = threadIdx.x; F.lane = F.tid & 63; F.wave = __builtin_amdgcn_readfirstlane(F.tid >> 6);
    F.G = gridDim.x; { const int bx = blockIdx.x; F.vcu = (F.G % 8 == 0) ? (bx % 8) * (F.G / 8) + bx / 8 : bx; }
    unsigned char* ws = args.ws;
    gu32* ctl = (gu32*)(ws + WS_CTL);
    volatile LAS unsigned* MISC = (volatile LAS unsigned*)(F.lds + MISC_OFF);
    for (int u = F.tid; u < (LDS_BYTES - LDSCTL_OFF) / 4; u += NWAVES * 64) ((LAS unsigned*)(F.lds + LDSCTL_OFF))[u] = 0u;
    __syncthreads();
    XcdBarrier bar = xcd_barrier_post((unsigned*)(ctl + CW_BAR) + args.bar_region * XCD_BAR_WORDS, MISC + 8);
    const int lo = args.ph_lo, hi = args.ph_hi;
#define IN(k) (lo <= (k) && (k) < hi)
#define SEAM(k) do { if (IN(k) && IN((k) + 1)) xcd_barrier(bar); } while (0)
    bf16_t* A0 = (bf16_t*)(ws + WS_A0); bf16_t* A1 = (bf16_t*)(ws + WS_A1);
    bf16_t* MG = (bf16_t*)args.out;
    bf16_t* SBQ = (bf16_t*)args.out; bf16_t* SBK = SBQ + (size_t)T * 512; bf16_t* SBV = SBK + (size_t)T * 512; bf16_t* OSB = SBV + (size_t)T * 512;

    GdnBufs Gb{(bf16_t*)(ws + WS_NW), (bf16_t*)(ws + WS_QD), (bf16_t*)(ws + WS_KDT), (bf16_t*)(ws + WS_QK), (bf16_t*)(ws + WS_UT), (float*)(ws + WS_CD), (bf16_t*)(ws + WS_ORAW), (float*)(ws + WS_OSS)};
    if (IN(0)) { p0_prologue(F, args);}
    SEAM(0);
    if (IN(1)) {
        { pg8::Gemm g{A0, (const bf16_t*)(ws + WS_WIN), T, NPROJ, 1024}; pg8::StaticOrder S; S.init(T, NPROJ, F.G, (int)blockIdx.x);
          pg8::EpiProj E{(const float*)(ws + WS_RSTD0), SBQ, SBK, SBV, A1, (bf16_t*)(ws + WS_GZ), (bf16_t*)(ws + WS_GSB), (bf16_t*)(ws + WS_GGDN)};
          pg8::gemm_phase<pg8::EpiProj, pg8::StaticOrder, true, true>(F.lds, g, S, E); }
    }
    SEAM(1);
    if (IN(2)) { gdn_prep_phase(F, args, A1, (const float*)(ws + WS_GB), (const float*)(ws + WS_GB) + T * 4, Gb); }
    SEAM(2);
    if (IN(3)) {
        const int nscan = F.G > 64 ? 64 : F.G, sb0 = F.G > 64 ? 64 : 0;
        if ((int)blockIdx.x < nscan) for (int s0 = blockIdx.x; s0 < 64; s0 += nscan) { const int s = (nscan == 64) ? ((s0 & 7) + 8 * (s0 >> 5)) * 4 + ((s0 >> 3) & 3) : s0; gdn_scan_unit(F, s, Gb); __syncthreads(); }
        if ((int)blockIdx.x >= sb0) { late_prologue(F, args, (int)blockIdx.x - sb0, F.G - sb0); __syncthreads(); }
        if ((int)blockIdx.x >= sb0) sb_phase(F.lds + F.wave * 8192, SBQ, SBK, SBV, OSB, ((int)blockIdx.x - sb0) * NWAVES + F.wave, (F.G - sb0) * NWAVES, F.lane);
        __syncthreads();
        if (sb0 > 0 && (int)blockIdx.x >= sb0) {
            sub_barrier(ctl + CW_SUB, (unsigned)(F.G - sb0), ctl + CW_SUB + 64);
            pg8::Gemm g{OSB, (const bf16_t*)(ws + WS_WSB), T, 1024, 512}; pg8::StaticOrder S; S.init(T, 1024, F.G - sb0, (int)blockIdx.x - sb0);
            pg8::EpiMerge<false> E{(const bf16_t*)(ws + WS_GSB), MG};
            pg8::gemm_phase<pg8::EpiMerge<false>, pg8::StaticOrder, true, true>(F.lds, g, S, E);
        }
    }
    SEAM(3);
    if (IN(4)) {
        { pg8::Gemm g{(const bf16_t*)(ws + WS_MN), (const bf16_t*)(ws + WS_WCKV), 1024, 2048, 1024}; pg8::StaticOrder S; S.init(1024, 2048, F.G, (int)blockIdx.x);
          pg8::EpiSplit E{(bf16_t*)(ws + WS_KC), (bf16_t*)(ws + WS_VC), 1024, 4};
          pg8::gemm_phase<pg8::EpiSplit, pg8::StaticOrder, true, true>(F.lds, g, S, E); }
        gdn_finish_phase(F, args, Gb, (const bf16_t*)(ws + WS_GZ), (bf16_t*)(ws + WS_OG)); }
    SEAM(4);
    if (IN(5)) {
        if (!(F.G > 64)) { pg8::Gemm g{OSB, (const bf16_t*)(ws + WS_WSB), T, 1024, 512}; pg8::StaticOrder S; S.init(T, 1024, F.G, (int)blockIdx.x);
          pg8::EpiMerge<false> E{(const bf16_t*)(ws + WS_GSB), MG};
          pg8::gemm_phase<pg8::EpiMerge<false>, pg8::StaticOrder, true, true>(F.lds, g, S, E);
          xcd_barrier(bar); }
        { pg8::Gemm g{(const bf16_t*)(ws + WS_OG), (const bf16_t*)(ws + WS_WGDN), T, 1024, 512}; pg8::StaticOrder S; S.init(T, 1024, F.G, (int)blockIdx.x);
          pg8::EpiMerge<true> E{(const bf16_t*)(ws + WS_GGDN), MG};
          pg8::gemm_phase<pg8::EpiMerge<true>, pg8::StaticOrder, true, true>(F.lds, g, S, E); }
    }
    SEAM(5);
    if (IN(6)) {
        pg8::Gemm g{MG, (const bf16_t*)(ws + WS_WMIX), T, 1024, 1024}; pg8::StaticOrder S; S.init(T, 1024, F.G, (int)blockIdx.x);
        pg8::EpiRes<true> E{args.x, nullptr, A1, (float*)(ws + WS_SS)};
        pg8::gemm_phase<pg8::EpiRes<true>, pg8::StaticOrder, true, true>(F.lds, g, S, E);
    }
    SEAM(6);
    if (IN(7)) {
        pg8::Gemm g{A1, (const bf16_t*)(ws + WS_WCQ), T, 1024, 1024}; pg8::StaticOrder S; S.init(T, 1024, F.G, (int)blockIdx.x);
        pg8::EpiScale E{(const float*)(ws + WS_SS), (bf16_t*)(ws + WS_GSB), 1024, nullptr};
        pg8::gemm_phase<pg8::EpiScale, pg8::StaticOrder, true, true>(F.lds, g, S, E);
        asm volatile("s_waitcnt vmcnt(0)" ::: "memory"); __syncthreads();
        pg8::StaticOrder S2; S2.init(T, 1024, F.G, (int)blockIdx.x); pg8::Unit u;
        for (int i = 0; S2.next(i, u); ++i) cross_item(F, (const bf16_t*)(ws + WS_GSB), (const bf16_t*)(ws + WS_KC), (const bf16_t*)(ws + WS_VC), (bf16_t*)(ws + WS_GGDN), (u.pm >> 5) * 4 + u.pn, u.pm & 31);
    }
    SEAM(7);
    if (IN(9)) {
        pg8::Gemm g{(const bf16_t*)(ws + WS_GGDN), (const bf16_t*)(ws + WS_WCO), T, 1024, 1024}; pg8::StaticOrder S; S.init(T, 1024, F.G, (int)blockIdx.x);
        pg8::EpiRes<false> E{nullptr, A1, A0, (float*)(ws + WS_SS)};
        pg8::gemm_phase<pg8::EpiRes<false>, pg8::StaticOrder, true, true>(F.lds, g, S, E);
    }
    SEAM(9);
    if (IN(10)) {
        pg8::Gemm g{A0, (const bf16_t*)(ws + WS_WPQ), T, 2048, 1024}; pg8::StaticOrder S; S.init(T, 2048, F.G, (int)blockIdx.x);
        pg8::EpiScale E{(const float*)(ws + WS_SS), A1, 2048, (float*)(ws + WS_RSTD2)};
        pg8::gemm_phase<pg8::EpiScale, pg8::StaticOrder, true, true>(F.lds, g, S, E);
        asm volatile("s_waitcnt vmcnt(0)" ::: "memory"); __syncthreads();
        pg8::StaticOrder S2; S2.init(T, 2048, F.G, (int)blockIdx.x); pg8::Unit u;
        for (int i = 0; S2.next(i, u); ++i) peer_route_task(F, A1, (const bf16_t*)(ws + WS_SKB), (int*)(ws + 296 * MiB), (float*)(ws + 312 * MiB), u.pm * 8 + F.wave, u.pn);
        __syncthreads();
    }
    SEAM(10);
    if (IN(12)) { peer_u_phase(F, args, ctl, A0, (const float*)(ws + WS_RSTD2), (const int*)(ws + 296 * MiB), (const unsigned char*)(ws + WS_U8), (bf16_t*)(ws + WS_PART)); }
    SEAM(12);
    if (IN(13)) { peer_combine_phase(F, (const bf16_t*)(ws + WS_PART), (const int*)(ws + 296 * MiB), (const float*)(ws + 312 * MiB), (const float*)(ws + WS_SUV), (const float*)(ws + WS_SUV) + 16384, (float*)(ws + 328 * MiB)); }
    SEAM(13);
    if (IN(14)) { peer_v_phase(F, ctl, (const int*)(ws + 296 * MiB), (const float*)(ws + 328 * MiB), (const unsigned char*)(ws + WS_V8), A0, A1, (float*)(ws + WS_SS)); }
    SEAM(14);
    if (IN(15)) { peer_norm_phase(F, args, (const float*)(ws + WS_SS), A1, args.out); }
#undef IN
#undef SEAM
}
extern "C" void kernel_launch(void* const* d_in, const int* in_sizes, int n_in, void* d_out, int out_size, void* d_ws, size_t ws_size, hipStream_t stream) {
    static int grid = 0;
    if (grid == 0) {
        if (n_in != 22 || ws_size < WS_END || out_size != T * D) { fprintf(stderr, "kernel_launch: unexpected n_in %d / ws %zu / out %d\n", n_in, ws_size, out_size); grid = -1; return; }
        int dev = 0, cus = 0, per_cu = 0;
        if (hipGetDevice(&dev) != hipSuccess || hipDeviceGetAttribute(&cus, hipDeviceAttributeMultiprocessorCount, dev) != hipSuccess) { grid = -1; return; }
        if (hipFuncSetAttribute((const void*)mk_fwd, hipFuncAttributeMaxDynamicSharedMemorySize, LDS_BYTES) != hipSuccess) { fprintf(stderr, "kernel_launch: hipFuncSetAttribute failed\n"); grid = -1; return; }
        if (hipOccupancyMaxActiveBlocksPerMultiprocessor(&per_cu, (const void*)mk_fwd, NWAVES * 64, LDS_BYTES) != hipSuccess || per_cu < 1) { fprintf(stderr, "kernel_launch: occupancy query says %d\n", per_cu); per_cu = 1; }
        (void)hipGetLastError();
        grid = cus;
    }
    if (grid < 0) return;
    hipMemsetAsync((char*)d_ws + WS_CTL, 0, CTL_ZERO_BYTES, stream);
    Args a{};
    const float** ap = (const float**)&a;
    for (int i = 0; i < 22; ++i) ap[i] = (const float*)d_in[i];
    a.out = (float*)d_out; a.ws = (unsigned char*)d_ws;
    char* ws = (char*)d_ws; float* out = (float*)d_out;
    float* rstd2 = (float*)(ws + WS_RSTD2);
    bf16_t* KC = (bf16_t*)(ws + WS_KC); bf16_t* VC = (bf16_t*)(ws + WS_VC);
    bf16_t* PQ = (bf16_t*)(ws + WS_A1); bf16_t* QC = (bf16_t*)(ws + WS_GSB); bf16_t* OC = (bf16_t*)(ws + WS_GGDN);
    int* EIDX = (int*)(ws + 296 * MiB); float* EGATE = (float*)(ws + 312 * MiB);
#define MK(lo, hi, reg) do { a.ph_lo = (lo); a.ph_hi = (hi); a.bar_region = (reg); hipLaunchKernelGGL(mk_fwd, dim3(grid), dim3(NWAVES * 64), LDS_BYTES, stream, a); } while (0)
    MK(0, 16, 0);
#undef MK
}
```

```cpp
#include <hip/hip_runtime.h>
#include <stdint.h>
#include <cstdio>

typedef unsigned short bf16_t;
__device__ __forceinline__ float bf2f(bf16_t v) { return __uint_as_float(((unsigned)v) << 16); }
__device__ __forceinline__ bf16_t f2bf(float f) { unsigned u = __float_as_uint(f); return (bf16_t)((u + 0x7fffu + ((u >> 16) & 1u)) >> 16); }

constexpr int T = 32768, D = 1024, SEQ = 8192, NB = 4;
constexpr int IN_COLS = 5640, NPROJ = 5632;
constexpr float EPS = 1e-6f;
constexpr size_t MiB = 1u << 20;

__device__ __forceinline__ float wave_sum(float v) {
#pragma unroll
    for (int o = 1; o < 64; o <<= 1) v += __shfl_xor(v, o);
    return v;
}
__device__ __forceinline__ float sigmoidf_(float x) { return 1.f / (1.f + __expf(-x)); }
__device__ __forceinline__ float softplusf_(float x) { return fmaxf(x, 0.f) + log1pf(__expf(-fabsf(x))); }

namespace pg8 {
#define PG8_LAS __attribute__((address_space(3)))
typedef unsigned short bf16_t;
typedef short bf16x8 __attribute__((ext_vector_type(8)));
typedef float f32x4 __attribute__((ext_vector_type(4)));
typedef unsigned u32x4 __attribute__((ext_vector_type(4)));
constexpr int BM = 256, BK = 64, HALF = 128, HTB = HALF * BK * 2  , STAGE_BYTES = 8 * HTB, NXCD = 8, WGM = 8;

__host__ __device__ __forceinline__ int lds_byte(int r, int c) { const int st = (r >> 4) * 2 + (c >> 5), rr = r & 15, cc = c & 31, ob = rr * 64 + cc * 2; return st * 1024 + (ob ^ (((ob >> 9) & 1) << 5)); }
__host__ __device__ __forceinline__ void stage_rc(int b, int& R, int& C) { const int st = b / 1024, sb = b % 1024, swz = sb ^ (((sb >> 9) & 1) << 5); R = (st >> 1) * 16 + swz / 64; C = (st & 1) * 32 + (swz % 64) / 2; }
__host__ __device__ __forceinline__ int perm32(int rho) { const int n = rho >> 4, i = rho & 15; return 8 * (i >> 2) + 4 * n + (i & 3); }

struct Unit { int pm, pn; };
struct Gemm { const bf16_t* A; const bf16_t* Bt; int M, N, K; };

struct StaticOrder {
    int nM, nN, nwg, G, c;
    __host__ __device__ __forceinline__ void init(int M, int N, int G_, int c_) { nM = M / BM; nN = N / BM; nwg = nM * nN; G = G_; c = c_; }
    __host__ __device__ __forceinline__ bool next(int i, Unit& u) const {
        const long L = (long)i * G + c; if (L >= nwg) return false;
        int wgid = (int)L; { const int q = nwg / NXCD, r = nwg % NXCD, xcd = wgid % NXCD, off = wgid / NXCD; wgid = (xcd < r ? xcd * (q + 1) : r * (q + 1) + (xcd - r) * q) + off; }
        const int nig = WGM * nN, gid = wgid / nig, fm = gid * WGM, gsz = (nM - fm) < WGM ? (nM - fm) : WGM;
        u.pm = fm + ((wgid % nig) % gsz); u.pn = (wgid % nig) / gsz; return true;
    }
    __device__ __forceinline__ void a_ready(const Unit&) const {}
    __device__ __forceinline__ void done(const Unit&) const {}
};

__device__ __forceinline__ unsigned cvt_pk_bf16(float lo, float hi) { unsigned r; asm volatile("v_cvt_pk_bf16_f32 %0, %1, %2" : "=v"(r) : "v"(lo), "v"(hi)); return r; }
typedef float f32x2 __attribute__((ext_vector_type(2)));
__device__ __forceinline__ float bfl(unsigned w) { return __uint_as_float(w << 16); }
__device__ __forceinline__ float bfh(unsigned w) { return __uint_as_float(w & 0xffff0000u); }
constexpr int EPI_STAGE_OFF = 131072 + 1024;
__device__ __forceinline__ void stage_store16x64(int wid, int fr, int fq, u32x4 w0, u32x4 w1, bf16_t* rowbase  , size_t ld) {
    PG8_LAS unsigned char* sl = (PG8_LAS unsigned char*)(EPI_STAGE_OFF + wid * 2048);
    *(PG8_LAS u32x4*)(sl + fr * 128 + ((fq ^ (fr & 7)) << 4)) = w0;
    *(PG8_LAS u32x4*)(sl + fr * 128 + (((4 + fq) ^ (fr & 7)) << 4)) = w1;
    const int lane = fr + 16 * fq, r0 = lane >> 3, c = lane & 7;
    const u32x4 a = *(const PG8_LAS u32x4*)(sl + r0 * 128 + ((c ^ r0) << 4));
    const u32x4 b = *(const PG8_LAS u32x4*)(sl + (r0 + 8) * 128 + ((c ^ r0) << 4));
    *(u32x4*)(rowbase + (size_t)r0 * ld + c * 8) = a;
    *(u32x4*)(rowbase + (size_t)(r0 + 8) * ld + c * 8) = b;
}
__device__ __forceinline__ u32x4 pack8(const f32x4& v0, const f32x4& v1) { u32x4 w; w.x = cvt_pk_bf16(v0[0], v0[1]); w.y = cvt_pk_bf16(v0[2], v0[3]); w.z = cvt_pk_bf16(v1[0], v1[1]); w.w = cvt_pk_bf16(v1[2], v1[3]); return w; }

struct EpiProj {
    static constexpr bool PERM = true, AFTER_DRAIN = false, COL64 = true;
    const float* rstd; bf16_t *SBQ, *SBK, *SBV, *GQKV, *GZ, *GSB, *GGDN;
    __device__ __forceinline__ void operator()(const f32x4 (&acc)[2][2][4][2], const Unit& u, int wr, int wc, int fr_in, int fq_in) const {
        int lane_ = fr_in + 16 * fq_in; asm volatile("" : "+v"(lane_));
        const int fr = lane_ & 15, fq = lane_ >> 4;
        const int pn = u.pn; bf16_t* base; int ld, coff;
        if (pn < 2) { base = SBQ; ld = 512; coff = pn * 256; } else if (pn < 4) { base = SBK; ld = 512; coff = (pn - 2) * 256; } else if (pn < 6) { base = SBV; ld = 512; coff = (pn - 4) * 256; }
        else if (pn < 12) { base = GQKV; ld = 1536; coff = (pn - 6) * 256; } else if (pn < 14) { base = GZ; ld = 512; coff = (pn - 12) * 256; }
        else if (pn < 18) { base = GSB; ld = 1024; coff = (pn - 14) * 256; } else { base = GGDN; ld = 1024; coff = (pn - 18) * 256; }
        const int row0 = u.pm * BM + wr * 64, wid = wr * 4 + wc;
        float rsv[2][4];
#pragma unroll
        for (int ai = 0; ai < 2; ++ai)
#pragma unroll
            for (int m = 0; m < 4; ++m) rsv[ai][m] = rstd[row0 + ai * HALF + m * 16 + fr];
#pragma unroll
        for (int ai = 0; ai < 2; ++ai)
#pragma unroll
            for (int m = 0; m < 4; ++m) { const int rg = row0 + ai * HALF + m * 16; const float rs = rsv[ai][m];
                stage_store16x64(wid, fr, fq, pack8(acc[ai][0][m][0] * rs, acc[ai][0][m][1] * rs), pack8(acc[ai][1][m][0] * rs, acc[ai][1][m][1] * rs), base + (size_t)rg * ld + coff + wc * 64, ld); }
    }
};
struct EpiSplit {
    static constexpr bool PERM = true, AFTER_DRAIN = false, COL64 = true;
    bf16_t *O0, *O1; int ldc, split_tiles;
    __device__ __forceinline__ void operator()(const f32x4 (&acc)[2][2][4][2], const Unit& u, int wr, int wc, int fr_in, int fq_in) const {
        int lane_ = fr_in + 16 * fq_in; asm volatile("" : "+v"(lane_));
        const int fr = lane_ & 15, fq = lane_ >> 4;
        bf16_t* base = u.pn < split_tiles ? O0 : O1; const int coff = (u.pn < split_tiles ? u.pn : u.pn - split_tiles) * 256;
        const int row0 = u.pm * BM + wr * 64, wid = wr * 4 + wc;
#pragma unroll
        for (int ai = 0; ai < 2; ++ai)
#pragma unroll
            for (int m = 0; m < 4; ++m) { const int rg = row0 + ai * HALF + m * 16;
                stage_store16x64(wid, fr, fq, pack8(acc[ai][0][m][0], acc[ai][0][m][1]), pack8(acc[ai][1][m][0], acc[ai][1][m][1]), base + (size_t)rg * ldc + coff + wc * 64, ldc); }
    }
};
template <bool ADD> struct EpiMerge {
    static constexpr bool PERM = true, AFTER_DRAIN = false, COL64 = true;
    const bf16_t* gate; bf16_t* M;
    __device__ __forceinline__ void operator()(const f32x4 (&acc)[2][2][4][2], const Unit& u, int wr, int wc, int fr_in, int fq_in) const {
        int lane_ = fr_in + 16 * fq_in; asm volatile("" : "+v"(lane_));
        const int fr = lane_ & 15, fq = lane_ >> 4;
        const int row0 = u.pm * BM + wr * 64, col0 = u.pn * BM + wc * 64, wid = wr * 4 + wc;
#pragma unroll
        for (int ab = 0; ab < 4; ++ab) { const int ai = ab >> 1, mb = (ab & 1) * 2;
            u32x4 gl[4][2], pl[4][2];
#pragma unroll
            for (int m = mb; m < mb + 2; ++m)
#pragma unroll
                for (int bj = 0; bj < 2; ++bj) { const size_t o = (size_t)(row0 + ai * HALF + m * 16 + fr) * 1024 + col0 + 8 * fq + bj * 32; gl[m][bj] = *(const u32x4*)(gate + o); if (ADD) pl[m][bj] = *(const u32x4*)(M + o); }
#pragma unroll
            for (int m = mb; m < mb + 2; ++m) { const int rg = row0 + ai * HALF + m * 16;
                u32x4 wv[2];
#pragma unroll
                for (int bj = 0; bj < 2; ++bj) { const u32x4 g = gl[m][bj];
                    float gv[8] = {bfl(g.x), bfh(g.x), bfl(g.y), bfh(g.y), bfl(g.z), bfh(g.z), bfl(g.w), bfh(g.w)};
                    float pv[8] = {0.f, 0.f, 0.f, 0.f, 0.f, 0.f, 0.f, 0.f};
                    if (ADD) { const u32x4 p = pl[m][bj]; pv[0] = bfl(p.x); pv[1] = bfh(p.x); pv[2] = bfl(p.y); pv[3] = bfh(p.y); pv[4] = bfl(p.z); pv[5] = bfh(p.z); pv[6] = bfl(p.w); pv[7] = bfh(p.w); }
                    float r[8];
#pragma unroll
                    for (int j = 0; j < 8; ++j) { const float a = j < 4 ? acc[ai][bj][m][0][j] : acc[ai][bj][m][1][j - 4]; r[j] = pv[j] + a * __builtin_amdgcn_rcpf(1.f + __expf(-gv[j])); }
                    wv[bj].x = cvt_pk_bf16(r[0], r[1]); wv[bj].y = cvt_pk_bf16(r[2], r[3]); wv[bj].z = cvt_pk_bf16(r[4], r[5]); wv[bj].w = cvt_pk_bf16(r[6], r[7]); }
                stage_store16x64(wid, fr, fq, wv[0], wv[1], M + (size_t)rg * 1024 + col0, 1024); }
        }
    }
};
template <bool IN_F32> struct EpiRes {
    static constexpr bool PERM = true, AFTER_DRAIN = false, COL64 = true;
    const float* xin_f; const bf16_t* xin_b; bf16_t* xb; float* SS;
    __device__ __forceinline__ void operator()(const f32x4 (&acc)[2][2][4][2], const Unit& u, int wr, int wc, int fr_in, int fq_in) const {
        int lane_ = fr_in + 16 * fq_in; asm volatile("" : "+v"(lane_));
        const int fr = lane_ & 15, fq = lane_ >> 4;
        const int row0 = u.pm * BM + wr * 64, col0 = u.pn * BM + wc * 64, wid = wr * 4 + wc;
#pragma unroll
        for (int ab = 0; ab < 4; ++ab) { const int ai = ab >> 1, mb = (ab & 1) * 2;
            f32x4 xl[4][2][2];
#pragma unroll
            for (int m = mb; m < mb + 2; ++m)
#pragma unroll
                for (int bj = 0; bj < 2; ++bj) { const size_t o = (size_t)(row0 + ai * HALF + m * 16 + fr) * 1024 + col0 + 8 * fq + bj * 32;
                    if (IN_F32) { xl[m][bj][0] = *(const f32x4*)(xin_f + o); xl[m][bj][1] = *(const f32x4*)(xin_f + o + 4); }
                    else { const u32x4 p = *(const u32x4*)(xin_b + o); xl[m][bj][0] = (f32x4){bfl(p.x), bfh(p.x), bfl(p.y), bfh(p.y)}; xl[m][bj][1] = (f32x4){bfl(p.z), bfh(p.z), bfl(p.w), bfh(p.w)}; } }
            float sv[4];
#pragma unroll
            for (int m = mb; m < mb + 2; ++m) { const int rg = row0 + ai * HALF + m * 16; float s = 0.f;
                u32x4 wv[2];
#pragma unroll
                for (int bj = 0; bj < 2; ++bj) { const u32x4 w = pack8(xl[m][bj][0] + acc[ai][bj][m][0], xl[m][bj][1] + acc[ai][bj][m][1]); wv[bj] = w;
                    const float r0 = bfl(w.x), r1 = bfh(w.x), r2 = bfl(w.y), r3 = bfh(w.y), r4 = bfl(w.z), r5 = bfh(w.z), r6 = bfl(w.w), r7 = bfh(w.w);
                    s += (r0 * r0 + r1 * r1) + (r2 * r2 + r3 * r3) + (r4 * r4 + r5 * r5) + (r6 * r6 + r7 * r7); }
                stage_store16x64(wid, fr, fq, wv[0], wv[1], xb + (size_t)rg * 1024 + col0, 1024);
                s += __shfl_xor(s, 16); s += __shfl_xor(s, 32); sv[m] = s; }
#pragma unroll
            for (int m = mb; m < mb + 2; ++m) if (fq == 0) SS[(size_t)(row0 + ai * HALF + m * 16 + fr) * 16 + u.pn * 4 + wc] = sv[m];
        }
    }
};
struct EpiScale {
    static constexpr bool PERM = true, AFTER_DRAIN = false, COL64 = true;
    const float* rstd; bf16_t* O; int ldc;
    __device__ __forceinline__ void operator()(const f32x4 (&acc)[2][2][4][2], const Unit& u, int wr, int wc, int fr_in, int fq_in) const {
        int lane_ = fr_in + 16 * fq_in; asm volatile("" : "+v"(lane_));
        const int fr = lane_ & 15, fq = lane_ >> 4;
        const int row0 = u.pm * BM + wr * 64, col0 = u.pn * BM + wc * 64, wid = wr * 4 + wc;
        float rsv[2][4];
#pragma unroll
        for (int ai = 0; ai < 2; ++ai)
#pragma unroll
            for (int m = 0; m < 4; ++m) rsv[ai][m] = rstd[row0 + ai * HALF + m * 16 + fr];
#pragma unroll
        for (int ai = 0; ai < 2; ++ai)
#pragma unroll
            for (int m = 0; m < 4; ++m) { const int rg = row0 + ai * HALF + m * 16; const float rs = rsv[ai][m];
                stage_store16x64(wid, fr, fq, pack8(acc[ai][0][m][0] * rs, acc[ai][0][m][1] * rs), pack8(acc[ai][1][m][0] * rs, acc[ai][1][m][1] * rs), O + (size_t)rg * ldc + col0, ldc); }
    }
};
template <class Epi, class Sched, bool ALIGN_EPI = false, bool SP2 = false>
__device__ __forceinline__ void gemm_phase(PG8_LAS unsigned char* lds, const Gemm g, const Sched& S, const Epi& E) {
    const int tid = threadIdx.x, wid = __builtin_amdgcn_readfirstlane(tid >> 6), lane = tid & 63, wr = wid >> 2, wc = wid & 3, fr = lane & 15, fq = lane >> 4;
    const int K = g.K, nt = K / BK;
    unsigned voffA[2], voffB[2];
#pragma unroll
    for (int i = 0; i < 2; ++i) { int R, C; stage_rc(tid * 16 + i * 8192, R, C); const int Rb = Epi::PERM ? ((Epi::COL64 ? 2 * (R & ~31) : (R & ~31)) + perm32(R & 31)) : R;
        voffA[i] = (unsigned)(R * K + C) * 2u; voffB[i] = (unsigned)(Rb * K + C) * 2u; }
    const size_t kstep = (size_t)(BK * 2);
    const size_t hstep = (size_t)HALF * K * 2;
    const size_t bhstep = Epi::COL64 ? (size_t)32 * K * 2 : hstep;
    const size_t tstep = 2 * hstep;
    const unsigned ldsw = (unsigned)wid * 1024u;
    const int aoff = lds_byte(wr * 64 + fr, fq * 8), boff = lds_byte(wc * 32 + fr, fq * 8);
#define PG8_SA(b, h) (((b) * 2 + (h)) * HTB)
#define PG8_SB(b, h) ((4 + (b) * 2 + (h)) * HTB)
#define PG8_STAGE(bufoff, gbase, voff) do { _Pragma("unroll") for (int _i = 0; _i < 2; ++_i) \
        __builtin_amdgcn_global_load_lds((const unsigned*)((const char*)(gbase) + (voff)[_i]), (PG8_LAS unsigned*)(lds + (bufoff) + ldsw + _i * 8192), 16, 0, 0); } while (0)
#define PG8_LDA(dst, b, h) do { _Pragma("unroll") for (int m = 0; m < 4; ++m) _Pragma("unroll") for (int k = 0; k < 2; ++k) dst[m][k] = *(const PG8_LAS bf16x8*)(lds + PG8_SA(b, h) + aoff + m * 2048 + k * 1024); } while (0)
#define PG8_LDB(dst, b, h) do { _Pragma("unroll") for (int n = 0; n < 2; ++n) _Pragma("unroll") for (int k = 0; k < 2; ++k) dst[n][k] = *(const PG8_LAS bf16x8*)(lds + PG8_SB(b, h) + boff + n * 2048 + k * 1024); } while (0)
#define PG8_MMA(ai, bj, At, Bt) do { __builtin_amdgcn_s_setprio(1); _Pragma("unroll") for (int m = 0; m < 4; ++m) _Pragma("unroll") for (int n = 0; n < 2; ++n) _Pragma("unroll") for (int k = 0; k < 2; ++k) \
        acc[ai][bj][m][n] = __builtin_amdgcn_mfma_f32_16x16x32_bf16(Bt[n][k], At[m][k], acc[ai][bj][m][n], 0, 0, 0); __builtin_amdgcn_s_setprio(0); } while (0)
#define PG8_WAIT_V(n) asm volatile("s_waitcnt vmcnt(" #n ")" ::: "memory")
#define PG8_WAIT_L(n) asm volatile("s_waitcnt lgkmcnt(" #n ")" ::: "memory")
#define PG8_BAR __builtin_amdgcn_s_barrier()
#define PG8_SCHED __builtin_amdgcn_sched_barrier(0)
    Unit cur, nxt; int ui = 0;
    if (!S.next(0, cur)) return;
    f32x4 acc[2][2][4][2];
#pragma unroll
    for (int a = 0; a < 2; ++a)
#pragma unroll
        for (int b = 0; b < 2; ++b)
#pragma unroll
            for (int m = 0; m < 4; ++m)
#pragma unroll
                for (int n = 0; n < 2; ++n) acc[a][b][m][n] = (f32x4){0.f, 0.f, 0.f, 0.f};
    bf16x8 At[4][2], B0[2][2], B1[2][2];
    const char* cA = (const char*)g.A + (size_t)cur.pm * tstep; const char* cB = (const char*)g.Bt + (size_t)cur.pn * tstep;
    S.a_ready(cur);
    if constexpr (SP2) {
        PG8_STAGE(PG8_SB(0, 0), cB, voffB); PG8_STAGE(PG8_SB(0, 1), cB + bhstep, voffB); PG8_STAGE(PG8_SA(0, 0), cA, voffA); PG8_STAGE(PG8_SA(0, 1), cA + hstep, voffA);
        if (wr == 1) PG8_BAR;
        PG8_WAIT_V(2); PG8_BAR;
        PG8_STAGE(PG8_SB(1, 0), cB + kstep, voffB); PG8_STAGE(PG8_SA(1, 0), cA + kstep, voffA); PG8_STAGE(PG8_SB(1, 1), cB + bhstep + kstep, voffB);
        PG8_WAIT_V(6); PG8_BAR;
    } else {
        PG8_STAGE(PG8_SB(0, 0), cB, voffB); PG8_STAGE(PG8_SA(0, 0), cA, voffA); PG8_STAGE(PG8_SB(0, 1), cB + bhstep, voffB); PG8_STAGE(PG8_SA(0, 1), cA + hstep, voffA);
        if (wr == 1) PG8_BAR;
        PG8_WAIT_V(4); PG8_BAR;
        PG8_STAGE(PG8_SB(1, 0), cB + kstep, voffB); PG8_STAGE(PG8_SA(1, 0), cA + kstep, voffA); PG8_STAGE(PG8_SB(1, 1), cB + bhstep + kstep, voffB);
        PG8_WAIT_V(6); PG8_BAR;
    }
    for (;;) {
        const bool has_next = S.next(ui + 1, nxt);
        const char* nA = has_next ? (const char*)g.A + (size_t)nxt.pm * tstep : cA; const char* nB = has_next ? (const char*)g.Bt + (size_t)nxt.pn * tstep : cB;
        for (int t = 0; t < nt; t += 2) {
            const bool last = (t == nt - 2);
            const char* a1 = cA + (size_t)(t + 1) * kstep;
            const char* a2 = last ? nA : cA + (size_t)(t + 2) * kstep; const char* b2 = last ? nB : cB + (size_t)(t + 2) * kstep;
            const char* a3 = a2 + kstep; const char* b3 = b2 + kstep;
            if (last && has_next) S.a_ready(nxt);
            if constexpr (SP2) {
            PG8_LDB(B0, 0, 0); PG8_LDB(B1, 0, 1); PG8_SCHED; PG8_LDA(At, 0, 0); PG8_STAGE(PG8_SA(1, 1), a1 + hstep, voffA);
            PG8_WAIT_V(8); PG8_WAIT_L(0); PG8_BAR; PG8_MMA(0, 0, At, B0); PG8_MMA(0, 1, At, B1); PG8_BAR; PG8_SCHED;
            PG8_LDA(At, 0, 1); PG8_STAGE(PG8_SB(0, 0), b2, voffB); PG8_STAGE(PG8_SB(0, 1), b2 + bhstep, voffB); PG8_STAGE(PG8_SA(0, 0), a2, voffA);
            PG8_WAIT_V(8); PG8_WAIT_L(0); PG8_BAR; PG8_MMA(1, 0, At, B0); PG8_MMA(1, 1, At, B1); PG8_BAR; PG8_SCHED;
            PG8_LDB(B0, 1, 0); PG8_LDB(B1, 1, 1); PG8_SCHED; PG8_LDA(At, 1, 0); PG8_STAGE(PG8_SA(0, 1), a2 + hstep, voffA);
            PG8_WAIT_V(8); PG8_WAIT_L(0); PG8_BAR; PG8_MMA(0, 0, At, B0); PG8_MMA(0, 1, At, B1); PG8_BAR; PG8_SCHED;
            PG8_LDA(At, 1, 1); PG8_STAGE(PG8_SB(1, 0), b3, voffB); PG8_STAGE(PG8_SB(1, 1), b3 + bhstep, voffB); PG8_STAGE(PG8_SA(1, 0), a3, voffA);
            PG8_WAIT_V(8); PG8_WAIT_L(0); PG8_BAR; PG8_MMA(1, 0, At, B0); PG8_MMA(1, 1, At, B1); PG8_BAR; PG8_SCHED;
            } else {
            PG8_LDB(B0, 0, 0); PG8_SCHED; PG8_LDA(At, 0, 0); PG8_STAGE(PG8_SA(1, 1), a1 + hstep, voffA);
            PG8_WAIT_L(8); PG8_BAR; PG8_WAIT_L(0); PG8_MMA(0, 0, At, B0); PG8_BAR; PG8_SCHED;
            PG8_LDB(B1, 0, 1); PG8_STAGE(PG8_SB(0, 0), b2, voffB);
            PG8_BAR; PG8_WAIT_L(0); PG8_MMA(0, 1, At, B1); PG8_BAR;
            PG8_LDA(At, 0, 1); PG8_STAGE(PG8_SA(0, 0), a2, voffA);
            PG8_BAR; PG8_WAIT_L(0); PG8_MMA(1, 0, At, B0); PG8_BAR; PG8_SCHED;
            PG8_STAGE(PG8_SB(0, 1), b2 + bhstep, voffB);
            PG8_WAIT_V(6); PG8_BAR; PG8_MMA(1, 1, At, B1); PG8_BAR;
            PG8_LDB(B0, 1, 0); PG8_SCHED; PG8_LDA(At, 1, 0); PG8_STAGE(PG8_SA(0, 1), a2 + hstep, voffA);
            PG8_WAIT_L(8); PG8_BAR; PG8_WAIT_L(0); PG8_MMA(0, 0, At, B0); PG8_BAR; PG8_SCHED;
            PG8_LDB(B1, 1, 1); PG8_STAGE(PG8_SB(1, 0), b3, voffB);
            PG8_BAR; PG8_WAIT_L(0); PG8_MMA(0, 1, At, B1); PG8_BAR;
            PG8_LDA(At, 1, 1); PG8_STAGE(PG8_SA(1, 0), a3, voffA);
            PG8_BAR; PG8_WAIT_L(0); PG8_MMA(1, 0, At, B0); PG8_BAR; PG8_SCHED;
            PG8_STAGE(PG8_SB(1, 1), b3 + bhstep, voffB);
            PG8_WAIT_V(6); PG8_BAR; PG8_MMA(1, 1, At, B1); PG8_BAR;
            }
        }
        if constexpr (ALIGN_EPI) { if (wr == 0) PG8_BAR; }
        if constexpr (!Epi::AFTER_DRAIN) { E(acc, cur, wr, wc, fr, fq); S.done(cur); }
        if (!has_next) break;
#pragma unroll
        for (int a = 0; a < 2; ++a)
#pragma unroll
            for (int b = 0; b < 2; ++b)
#pragma unroll
                for (int m = 0; m < 4; ++m)
#pragma unroll
                    for (int n = 0; n < 2; ++n) acc[a][b][m][n] = (f32x4){0.f, 0.f, 0.f, 0.f};
        cur = nxt; cA = nA; cB = nB; ++ui;
        if constexpr (ALIGN_EPI) { if (wr == 1) PG8_BAR; }
    }
    PG8_WAIT_V(0);
    if constexpr (!ALIGN_EPI) { if (wr == 0) PG8_BAR; }
    PG8_BAR;
    if constexpr (Epi::AFTER_DRAIN) { E.fused(acc, cur, wr, wc, fr, fq, lds, wid, lane); S.done(cur); }
#undef PG8_SA
#undef PG8_SB
#undef PG8_STAGE
#undef PG8_LDA
#undef PG8_LDB
#undef PG8_MMA
#undef PG8_WAIT_V
#undef PG8_WAIT_L
#undef PG8_BAR
#undef PG8_SCHED
}
}
#define GAS __attribute__((address_space(1)))
#define LAS __attribute__((address_space(3)))
typedef unsigned short bf16;
typedef unsigned v4u __attribute__((ext_vector_type(4)));
typedef float f32x4 __attribute__((ext_vector_type(4)));
typedef short bf16x8 __attribute__((ext_vector_type(8)));
typedef GAS unsigned gu32;
typedef GAS unsigned long long gu64;
#define RLX_AGENT __ATOMIC_RELAXED, __HIP_MEMORY_SCOPE_AGENT
#define LDS_WAIT() asm volatile("s_waitcnt lgkmcnt(0)" ::: "memory")
#define VM_WAIT() asm volatile("s_waitcnt vmcnt(0)" ::: "memory")
__device__ __forceinline__ unsigned long long rt() { return __builtin_amdgcn_s_memrealtime(); }
__device__ __forceinline__ unsigned pk2(float lo, float hi) { return (unsigned)f2bf(lo) | ((unsigned)f2bf(hi) << 16); }

#define XB_TMO      128
#define XB_XCNT(j)  (256  + 64 * (j))
#define XB_XSUB(j)  (1280 + 64 * (j))
#define XB_XGEN(j)  (2304 + 64 * (j))
#define XB_TOP      3328
#define XB_TOPGEN   3392
#define XCD_BAR_WORDS 3456
#define XB_SPIN_CAP (1u << 18)

__device__ __forceinline__ unsigned xb_ld(unsigned* p)              { return __hip_atomic_load(p, __ATOMIC_RELAXED, __HIP_MEMORY_SCOPE_AGENT); }
__device__ __forceinline__ unsigned xb_add(unsigned* p, unsigned v) { return __hip_atomic_fetch_add(p, v, __ATOMIC_RELAXED, __HIP_MEMORY_SCOPE_AGENT); }
__device__ __forceinline__ unsigned xb_xcc_id() { return (unsigned)__builtin_amdgcn_s_getreg((3 << 11) | 20) & 0xFu; }
#define XB_SPIN(cond, bar) do { unsigned _sp = 0; while (cond) { __builtin_amdgcn_s_sleep(1); \
    if ((++_sp & 255u) == 0u) { if (xb_ld(&(bar)[XB_TMO])) break; if (_sp > XB_SPIN_CAP) { atomicAdd(&(bar)[XB_TMO], 1u); break; } } } } while (0)

struct XcdBarrier {
    unsigned* bar; unsigned x;
    volatile LAS unsigned* st;
};

__device__ __forceinline__ XcdBarrier xcd_barrier_post(unsigned* bar, volatile LAS unsigned* st) {
    XcdBarrier b; b.bar = bar; b.x = xb_xcc_id(); b.st = st;
    if (threadIdx.x == 0) (void)xb_add(&bar[XB_XCNT(b.x)], 1u);
    return b;
}
__device__ __forceinline__ void xcd_barrier_complete(unsigned* bar, unsigned x, unsigned& nloc, unsigned& nx) {
    const unsigned G = gridDim.x * gridDim.y * gridDim.z;
    unsigned sum, cnt, mine, sp = 0u;
    for (;;) {
        sum = 0u; cnt = 0u; mine = 0u;
#pragma unroll
        for (unsigned j = 0; j < 16; ++j) { const unsigned c = xb_ld(&bar[XB_XCNT(j)]); sum += c; cnt += (c > 0u) ? 1u : 0u; mine = (j == x) ? c : mine; }
        if (sum == G) break;
        __builtin_amdgcn_s_sleep(1);
        if ((++sp & 255u) == 0u) { if (xb_ld(&bar[XB_TMO])) break; if (sp > XB_SPIN_CAP) { atomicAdd(&bar[XB_TMO], 1u); break; } }
    }
    nloc = mine > 0u ? mine : 1u; nx = cnt > 0u ? cnt : 1u;
}

__device__ __forceinline__ void xcd_barrier(const XcdBarrier& b) {
    asm volatile("s_waitcnt vmcnt(0)" ::: "memory");
    __syncthreads();
    if (threadIdx.x == 0) {
        unsigned* bar = b.bar;
        __builtin_amdgcn_s_waitcnt(0);
        unsigned nloc = b.st[0], nx = b.st[1];
        if (nloc == 0u) { xcd_barrier_complete(bar, b.x, nloc, nx); b.st[0] = nloc; b.st[1] = nx; }
        const unsigned old = xb_add(&bar[XB_XSUB(b.x)], 1u);
        const unsigned gen = old / nloc;
        if (old + 1u == (gen + 1u) * nloc) {
            __builtin_amdgcn_fence(__ATOMIC_RELEASE, "agent");
            asm volatile("s_waitcnt vmcnt(0)" ::: "memory");
            const unsigned og = xb_add(&bar[XB_TOP], 1u);
            const unsigned tg = og / nx;
            if (og + 1u == (tg + 1u) * nx) xb_add(&bar[XB_TOPGEN], 1u);
            else XB_SPIN(xb_ld(&bar[XB_TOPGEN]) == tg, bar);
            __builtin_amdgcn_fence(__ATOMIC_ACQUIRE, "agent");
            xb_add(&bar[XB_XGEN(b.x)], 1u);
            asm volatile("s_waitcnt vmcnt(0)" ::: "memory");
        } else {
            XB_SPIN(xb_ld(&bar[XB_XGEN(b.x)]) == gen, bar);
            __builtin_amdgcn_fence(__ATOMIC_ACQUIRE, "agent");
            asm volatile("s_waitcnt vmcnt(0)" ::: "memory");
        }
    }
    __syncthreads();
}
constexpr size_t KiB = 1024;
constexpr size_t WS_CTL = 0, CTL_ZERO_BYTES = 1 * MiB;
constexpr size_t WS_WIN = 1 * MiB, WS_WSB = 12 * MiB, WS_WGDN = 13 * MiB, WS_WMIX = 14 * MiB, WS_WCQ = 16 * MiB, WS_WCO = 18 * MiB, WS_WCKV = 20 * MiB, WS_WPQ = 24 * MiB, WS_SKB = 28 * MiB, WS_U16 = 30 * MiB, WS_V16 = 62 * MiB;
constexpr size_t WS_RSTD0 = 94 * MiB, WS_RSTD2 = 94 * MiB + 256 * KiB, WS_CD = 94 * MiB + 384 * KiB, WS_GB = 94 * MiB + 512 * KiB;
constexpr size_t WS_MN = 96 * MiB, WS_KC = 98 * MiB, WS_VC = 100 * MiB, WS_SS = 102 * MiB;
constexpr size_t WS_A0 = 104 * MiB;
constexpr size_t WS_NW = 104 * MiB, WS_QD = 136 * MiB;
constexpr size_t WS_A1 = 168 * MiB;
constexpr size_t WS_ORAW = 168 * MiB, WS_OSS = 200 * MiB, WS_OG = 232 * MiB;
constexpr size_t WS_GZ = 264 * MiB;
constexpr size_t WS_GSB = 296 * MiB, WS_GGDN = 360 * MiB;
constexpr size_t WS_KDT = 424 * MiB, WS_QK = 456 * MiB, WS_UT = 472 * MiB;
constexpr size_t WS_U8 = 30 * MiB, WS_V8 = 46 * MiB, WS_SUV = 62 * MiB;
constexpr size_t WS_PART = 344 * MiB;
constexpr size_t WS_END = 512 * MiB;
constexpr int CW_SUB = 12288;
constexpr int CW_BAR = 4096;

constexpr int NWAVES = 8;
constexpr int RING_BYTES = 131072, LDSCTL_OFF = RING_BYTES, MISC_OFF = LDSCTL_OFF + 320, LDS_BYTES = 149504;

struct Args {
    const float *x, *mem, *g_mix, *w_in, *gdn_conv, *a_log, *dt_bias, *gdn_norm_g, *w_sb_up, *w_gdn_up, *w_mix_out, *g_cross, *g_mem, *w_cq, *w_ckv, *w_co, *g_peer, *w_pq, *subkeys, *peer_u, *peer_v, *g_final;
    float* out; unsigned char* ws; int ph_lo, ph_hi, bar_region, pad;
};

struct Frame {
    LAS unsigned char* lds; int tid, lane, wave, vcu, G;
};


typedef short bf16x8_t __attribute__((ext_vector_type(8)));
typedef float f32x16_t __attribute__((ext_vector_type(16)));
typedef short v4i16_t __attribute__((ext_vector_type(4)));
typedef float f32x2v_t __attribute__((ext_vector_type(2))); typedef __bf16 bf16x2v_t __attribute__((ext_vector_type(2)));
__device__ __forceinline__ unsigned cvtpk(float lo, float hi) { f32x2v_t v = {lo, hi}; bf16x2v_t b = __builtin_convertvector(v, bf16x2v_t); return __builtin_bit_cast(unsigned, b); }
__device__ __forceinline__ v4i16_t lds_tr16(LAS unsigned char* p) { return __builtin_amdgcn_ds_read_tr16_b64_v4i16((LAS v4i16_t*)p); }

__device__ __forceinline__ void sb_phase(LAS unsigned char* wlds  , const bf16_t* SBQ, const bf16_t* SBK, const bf16_t* SBV, bf16_t* OSB, int gw, int ngw, int lane) {
    const int q = lane & 31, hi = lane >> 5;
    bf16x8_t Mf[2];
#pragma unroll
    for (int s = 0; s < 2; ++s)
#pragma unroll
        for (int j = 0; j < 8; ++j) { const int k = 16 * s + 8 * (j >> 2) + 4 * hi + (j & 3); Mf[s][j] = (k > q) ? (short)0x3F80 : (short)0; }
    const int vrow = lane >> 3, vch = lane & 7;
    const int g4 = lane >> 4, qq = (lane >> 2) & 3, p4 = lane & 3;
    LAS unsigned char* trb = wlds + (4 * (g4 >> 1) + qq) * 192 + ((g4 & 1) * 16 + 4 * p4) * 2;
    for (int item = gw; item < 32 * 256; item += ngw) {
        const int bh = item >> 8, qt = item & 255, b = bh >> 3, h = bh & 7;
        const size_t base = (size_t)b * SEQ;
        const bf16_t* Qp = SBQ + (base + qt * 32 + q) * 512 + h * 64 + 8 * hi;
        bf16x8_t Qf[4];
#pragma unroll
        for (int ks = 0; ks < 4; ++ks) Qf[ks] = *(const bf16x8_t*)(Qp + 16 * ks);
        f32x16_t o0 = {}, o1 = {};
        float carry = 0.f;
        bf16x8_t Kn[4]; v4u vn[4];
        {   const bf16_t* Kp = SBK + (base + qt * 32 + q) * 512 + h * 64 + 8 * hi;
#pragma unroll
            for (int ks = 0; ks < 4; ++ks) Kn[ks] = *(const bf16x8_t*)(Kp + 16 * ks);
#pragma unroll
            for (int i = 0; i < 4; ++i) vn[i] = *(const v4u*)(SBV + (base + qt * 32 + vrow + 8 * i) * 512 + h * 64 + vch * 8); }
        for (int kb = qt; kb >= 0; --kb) {
            bf16x8_t Kf[4]; v4u vv[4];
#pragma unroll
            for (int ks = 0; ks < 4; ++ks) Kf[ks] = Kn[ks];
#pragma unroll
            for (int i = 0; i < 4; ++i) vv[i] = vn[i];
            {   const int kn = kb > 0 ? kb - 1 : 0;
                const bf16_t* Kp = SBK + (base + kn * 32 + q) * 512 + h * 64 + 8 * hi;
#pragma unroll
                for (int ks = 0; ks < 4; ++ks) Kn[ks] = *(const bf16x8_t*)(Kp + 16 * ks);
#pragma unroll
                for (int i = 0; i < 4; ++i) vn[i] = *(const v4u*)(SBV + (base + kn * 32 + vrow + 8 * i) * 512 + h * 64 + vch * 8); }
            f32x16_t st = {};
#pragma unroll
            for (int ks = 0; ks < 4; ++ks) st = __builtin_amdgcn_mfma_f32_32x32x16_bf16(Kf[ks], Qf[ks], st, 0, 0, 0);
#pragma unroll
            for (int i = 0; i < 4; ++i) *(LAS v4u*)(wlds + (vrow + 8 * i) * 192 + vch * 16) = vv[i];
            const bool diag = (kb == qt);
            float z[16], lk[16];
#pragma unroll
            for (int r = 0; r < 16; ++r) {
                const int key = (r & 3) + 8 * (r >> 2) + 4 * hi;
                z[r] = st[r] * 0.125f;
                const float sp = fmaxf(z[r], 0.f) + __logf(1.f + __expf(-fabsf(z[r])));
                const bool valid = !diag || key < q;
                lk[r] = valid ? -sp : 0.f;
                z[r] = valid ? z[r] - sp : -INFINITY;
            }
            bf16x8_t lh[2], ll[2];
#pragma unroll
            for (int s = 0; s < 2; ++s) {
                unsigned wh[4], wl[4];
#pragma unroll
                for (int jj = 0; jj < 4; ++jj) { const float a = lk[8 * s + 2 * jj], c = lk[8 * s + 2 * jj + 1]; wh[jj] = cvtpk(a, c);
                    wl[jj] = cvtpk(a - __uint_as_float(wh[jj] << 16), c - __uint_as_float(wh[jj] & 0xffff0000u)); }
                lh[s] = __builtin_bit_cast(bf16x8_t, (v4u){wh[0], wh[1], wh[2], wh[3]}); ll[s] = __builtin_bit_cast(bf16x8_t, (v4u){wl[0], wl[1], wl[2], wl[3]});
            }
            f32x16_t af;
#pragma unroll
            for (int r = 0; r < 16; ++r) af[r] = carry;
            af = __builtin_amdgcn_mfma_f32_32x32x16_bf16(Mf[0], lh[0], af, 0, 0, 0);
            af = __builtin_amdgcn_mfma_f32_32x32x16_bf16(Mf[1], lh[1], af, 0, 0, 0);
            af = __builtin_amdgcn_mfma_f32_32x32x16_bf16(Mf[0], ll[0], af, 0, 0, 0);
            af = __builtin_amdgcn_mfma_f32_32x32x16_bf16(Mf[1], ll[1], af, 0, 0, 0);
            float tot = af[0] + lk[0];
            tot = __shfl(tot, q);
            float pr[16];
#pragma unroll
            for (int r = 0; r < 16; ++r) pr[r] = __expf(z[r] + af[r]);
            bf16x8_t pa[2];
#pragma unroll
            for (int s = 0; s < 2; ++s) pa[s] = __builtin_bit_cast(bf16x8_t, (v4u){cvtpk(pr[8 * s], pr[8 * s + 1]), cvtpk(pr[8 * s + 2], pr[8 * s + 3]), cvtpk(pr[8 * s + 4], pr[8 * s + 5]), cvtpk(pr[8 * s + 6], pr[8 * s + 7])});
            asm volatile("s_waitcnt lgkmcnt(0)" ::: "memory");
#pragma unroll
            for (int s = 0; s < 2; ++s) {
                const v4i16_t a0 = lds_tr16(trb + (16 * s) * 192), a1 = lds_tr16(trb + (16 * s + 8) * 192);
                const v4i16_t c0 = lds_tr16(trb + (16 * s) * 192 + 64), c1 = lds_tr16(trb + (16 * s + 8) * 192 + 64);
                const bf16x8_t vb0 = {a0[0], a0[1], a0[2], a0[3], a1[0], a1[1], a1[2], a1[3]}, vb1 = {c0[0], c0[1], c0[2], c0[3], c1[0], c1[1], c1[2], c1[3]};
                o0 = __builtin_amdgcn_mfma_f32_32x32x16_bf16(pa[s], vb0, o0, 0, 0, 0);
                o1 = __builtin_amdgcn_mfma_f32_32x32x16_bf16(pa[s], vb1, o1, 0, 0, 0);
            }
            carry = tot;
            if (__all(carry < -104.f)) break;
        }
        bf16_t* Op = OSB + (base + qt * 32) * 512 + h * 64 + q;
#pragma unroll
        for (int r = 0; r < 16; ++r) { const int row = (r & 3) + 8 * (r >> 2) + 4 * hi; Op[(size_t)row * 512] = f2bf(o0[r]); Op[(size_t)row * 512 + 32] = f2bf(o1[r]); }
    }
}
typedef float f32x4_t __attribute__((ext_vector_type(4)));
typedef unsigned v2u __attribute__((ext_vector_type(2)));
__device__ __forceinline__ float bflo(unsigned w) { return __uint_as_float(w << 16); }
__device__ __forceinline__ float bfhi(unsigned w) { return __uint_as_float(w & 0xffff0000u); }
__device__ __forceinline__ int frag_off(int r, int k0, int KS) { return (((r >> 4) * KS + (k0 >> 5)) << 9) + (((r & 15) + 16 * ((k0 & 15) >> 2)) << 3) + (((k0 & 31) >> 4) << 2); }

constexpr int GP_KS = 0, GP_QS = 17408, GP_VS = 34816, GP_AS = 52224, GP_WT = 69632, GP_GC = 87040, GP_BETA = 87296, GP_EGC = 87552, GP_CW = 88064, GP_TS = 94208;
constexpr int GROW = 136;

#define LDS_BARRIER() do { asm volatile("s_waitcnt lgkmcnt(0)" ::: "memory"); __builtin_amdgcn_s_barrier(); asm volatile("" ::: "memory"); } while (0)
struct GdnBufs { bf16_t *NW, *QD, *KDT, *QK, *UT; float* CD; bf16_t* ORAW; float* OSS; };

__device__ __forceinline__ void gdn_prep_phase(Frame& F, const Args& a, const bf16_t* GQKV, const float* GB, const float* GA, const GdnBufs& Gb) {
    LAS unsigned char* L = F.lds;
    LAS bf16_t* KS = (LAS bf16_t*)(L + GP_KS); LAS bf16_t* QS = (LAS bf16_t*)(L + GP_QS); LAS bf16_t* VS = (LAS bf16_t*)(L + GP_VS); LAS bf16_t* WT = (LAS bf16_t*)(L + GP_WT);
    LAS float* AS = (LAS float*)(L + GP_AS); LAS float* GC = (LAS float*)(L + GP_GC); LAS float* BETA = (LAS float*)(L + GP_BETA); LAS float* EGC = (LAS float*)(L + GP_EGC); LAS float* CW = (LAS float*)(L + GP_CW); LAS float* TS = (LAS float*)(L + GP_TS);
    const int tid = F.tid, lane = F.lane, wave = F.wave;
    const int per = (2048 + F.G - 1) / F.G;
    int hcur = -1;
    for (int ii = 0; ii < per; ++ii) {
        const int item = F.vcu * per + ii; if (item >= 2048) break;
        const int bh = item >> 7, n = item & 127, b = bh >> 2, h = bh & 3;
        const size_t t0 = (size_t)b * SEQ + n * 64;
        if (h != hcur) { hcur = h; for (int i = tid; i < 1536; i += NWAVES * 64) { const int j = i / 384, cc = i % 384; CW[i] = a.gdn_conv[j * 1536 + (cc >> 7) * 512 + h * 128 + (cc & 127)]; } }
        unsigned pf = 0u;
        if (ii + 1 < per && item + 1 < 2048 && tid < 384) {
            const int r = tid / 6, q6 = tid % 6; const int item2 = item + 1, bh2 = item2 >> 7, n2 = item2 & 127;
            pf = *(const unsigned*)(GQKV + ((size_t)(bh2 >> 2) * SEQ + n2 * 64 + r) * 1536 + (q6 >> 1) * 512 + (bh2 & 3) * 128 + (q6 & 1) * 64);
        }
        if (wave == 0) {
            const size_t t = t0 + lane;
            float g = -__expf(a.a_log[h]) * softplusf_(GA[t * 4 + h] + a.dt_bias[h]);
#pragma unroll
            for (int o = 1; o < 64; o <<= 1) { const float up = __shfl_up(g, o); if (lane >= o) g += up; }
            GC[lane] = g; BETA[lane] = sigmoidf_(GB[t * 4 + h]); EGC[lane] = __expf(g);
            if (lane == 63) Gb.CD[item] = __expf(g);
        }
        LDS_BARRIER();
        {
            const int c = tid >> 3, d0 = (tid & 7) * 16;
#pragma unroll
            for (int part = 0; part < 3; ++part) {
                float acc[16];
#pragma unroll
                for (int i = 0; i < 16; ++i) acc[i] = 0.f;
#pragma unroll
                for (int j = 0; j < 4; ++j) {
                    if (n * 64 + c - 3 + j >= 0) {
                        const bf16_t* src = GQKV + (t0 + c - 3 + j) * 1536 + part * 512 + h * 128 + d0;
                        const v4u r0 = *(const v4u*)src, r1 = *(const v4u*)(src + 8);
                        const unsigned rw[8] = {r0.x, r0.y, r0.z, r0.w, r1.x, r1.y, r1.z, r1.w};
                        const LAS float* cw = CW + j * 384 + part * 128 + d0;
#pragma unroll
                        for (int i = 0; i < 8; ++i) { acc[2 * i] += bflo(rw[i]) * cw[2 * i]; acc[2 * i + 1] += bfhi(rw[i]) * cw[2 * i + 1]; }
                    }
                }
                float ss = 0.f;
#pragma unroll
                for (int i = 0; i < 16; ++i) { acc[i] = acc[i] / (1.f + __expf(-acc[i])); ss += acc[i] * acc[i]; }
                if (part < 2) { ss += __shfl_xor(ss, 1); ss += __shfl_xor(ss, 2); ss += __shfl_xor(ss, 4); const float inv = rsqrtf(ss + EPS);
#pragma unroll
                    for (int i = 0; i < 16; ++i) acc[i] *= inv; }
                LAS bf16_t* dst = (part == 0 ? QS : part == 1 ? KS : VS) + c * GROW + d0;
                v4u w0, w1; w0.x = cvtpk(acc[0], acc[1]); w0.y = cvtpk(acc[2], acc[3]); w0.z = cvtpk(acc[4], acc[5]); w0.w = cvtpk(acc[6], acc[7]);
                w1.x = cvtpk(acc[8], acc[9]); w1.y = cvtpk(acc[10], acc[11]); w1.z = cvtpk(acc[12], acc[13]); w1.w = cvtpk(acc[14], acc[15]);
                *(LAS v4u*)dst = w0; *(LAS v4u*)(dst + 8) = w1;
            }
        }
        LDS_BARRIER();
        {
            const int fr = lane & 15, g = lane >> 4;
            for (int task = wave; task < 26; task += NWAVES) {
                const bool isKK = task < 10; int ct, mt;
                if (isKK) { ct = task >= 6 ? 3 : task >= 3 ? 2 : task >= 1 ? 1 : 0; mt = task - ct * (ct + 1) / 2; } else { ct = (task - 10) >> 2; mt = (task - 10) & 3; }
                f32x4_t acc = {0.f, 0.f, 0.f, 0.f};
                if (mt <= ct) {
                    const LAS bf16_t* Ap = KS + (mt * 16 + fr) * GROW + 8 * g; const LAS bf16_t* Bp = (isKK ? KS : QS) + (ct * 16 + fr) * GROW + 8 * g;
#pragma unroll
                    for (int ks = 0; ks < 4; ++ks) acc = __builtin_amdgcn_mfma_f32_16x16x32_bf16(*(const LAS bf16x8_t*)(Ap + 32 * ks), *(const LAS bf16x8_t*)(Bp + 32 * ks), acc, 0, 0, 0);
                }
                const int c = ct * 16 + fr, m0 = mt * 16 + 4 * g; const float gcc = GC[c];
                float v[4];
#pragma unroll
                for (int r = 0; r < 4; ++r) { const int m = m0 + r; const float dec = __expf(fminf(gcc - GC[m], 0.f)); v[r] = acc[r] * dec; }
                if (isKK) { const float bc = BETA[c];
                    f32x4_t o;
#pragma unroll
                    for (int r = 0; r < 4; ++r) o[r] = (c > m0 + r) ? v[r] * bc : 0.f;
                    *(LAS f32x4_t*)(AS + c * 68 + m0) = o;
                } else {
#pragma unroll
                    for (int r = 0; r < 4; ++r) v[r] = (c >= m0 + r) ? v[r] * 0.08838834764831845f : 0.f;
                    v2u w; w.x = cvtpk(v[0], v[1]); w.y = cvtpk(v[2], v[3]);
                    *(v2u*)(Gb.QK + (size_t)item * 4096 + (ct * 2 + (mt >> 1)) * 512 + lane * 8 + (mt & 1) * 4) = w;
                }
            }
        }
        LDS_BARRIER();
        if (wave == 0) {
            const int q4 = lane >> 4, c = lane & 15; const LAS float* Ab = AS + (16 * q4) * 68 + 16 * q4;
            float t[16];
#pragma unroll
            for (int r = 0; r < 16; ++r) { float s = (r == c) ? 1.f : 0.f;
#pragma unroll
                for (int j4 = 0; j4 < (r + 3) / 4; ++j4) { const f32x4_t av = *(const LAS f32x4_t*)(Ab + r * 68 + 4 * j4);
#pragma unroll
                    for (int i = 0; i < 4; ++i) if (4 * j4 + i < r) s -= av[i] * t[4 * j4 + i]; }
                t[r] = s; TS[(q4 * 16 + r) * 20 + c] = (r == c) ? 0.f : s; }
        }
        LDS_BARRIER();
        {
            const int fr = lane & 15, g = lane >> 4;
#pragma unroll
            for (int cc = 0; cc < 2; ++cc) {
                const int ct2 = wave * 2 + cc; const bool isW = ct2 >= 8; const int col = (ct2 & 7) * 16 + fr;
                const LAS bf16_t* src = (isW ? KS : VS) + col;
                unsigned xb[4][2];
#pragma unroll
                for (int i = 0; i < 4; ++i) {
                    f32x4_t y;
#pragma unroll
                    for (int r = 0; r < 4; ++r) { const int row = 16 * i + 4 * g + r; float v = bf2f(src[row * GROW]) * BETA[row]; if (isW) v *= EGC[row]; y[r] = v; }
#pragma unroll
                    for (int j = 0; j < i; j += 2) {
                        const LAS float* ap = AS + (16 * i + fr) * 68 + 16 * j + 4 * g;
                        const f32x4_t a0 = *(const LAS f32x4_t*)ap; f32x4_t a1 = {0.f, 0.f, 0.f, 0.f}; if (j + 1 < i) a1 = *(const LAS f32x4_t*)(ap + 16);
                        const bf16x8_t af = __builtin_bit_cast(bf16x8_t, (v4u){cvtpk(-a0[0], -a0[1]), cvtpk(-a0[2], -a0[3]), cvtpk(-a1[0], -a1[1]), cvtpk(-a1[2], -a1[3])});
                        const bf16x8_t bfr = __builtin_bit_cast(bf16x8_t, (v4u){xb[j][0], xb[j][1], (j + 1 < i) ? xb[j + 1][0] : 0u, (j + 1 < i) ? xb[j + 1][1] : 0u});
                        y = __builtin_amdgcn_mfma_f32_16x16x32_bf16(af, bfr, y, 0, 0, 0);
                    }
                    const f32x4_t tv = *(const LAS f32x4_t*)(TS + (i * 16 + fr) * 20 + 4 * g);
                    const bf16x8_t tf = __builtin_bit_cast(bf16x8_t, (v4u){cvtpk(tv[0], tv[1]), cvtpk(tv[2], tv[3]), 0u, 0u});
                    const bf16x8_t yf = __builtin_bit_cast(bf16x8_t, (v4u){cvtpk(y[0], y[1]), cvtpk(y[2], y[3]), 0u, 0u});
                    const f32x4_t x = __builtin_amdgcn_mfma_f32_16x16x32_bf16(tf, yf, y, 0, 0, 0);
                    xb[i][0] = cvtpk(x[0], x[1]); xb[i][1] = cvtpk(x[2], x[3]);
                    if (!isW) { *(v2u*)(Gb.UT + (size_t)item * 8192 + col * 64 + 16 * i + 4 * g) = (v2u){xb[i][0], xb[i][1]}; }
                    else {
#pragma unroll
                        for (int r = 0; r < 4; ++r) WT[(16 * i + 4 * g + r) * GROW + col] = f2bf(-x[r]); }
                }
            }
        }
        {
            const float glast = GC[63];
#pragma unroll
            for (int i = 0; i < 4; ++i) { const int p = tid + 512 * i, c = p >> 5, d0 = (p & 31) * 4; const v2u r = *(const LAS v2u*)(QS + c * GROW + d0); const float sc = EGC[c] * 0.08838834764831845f;
                v2u w; w.x = cvtpk(bflo(r.x) * sc, bfhi(r.x) * sc); w.y = cvtpk(bflo(r.y) * sc, bfhi(r.y) * sc);
                *(v2u*)(Gb.QD + (size_t)item * 8192 + frag_off(c, d0, 4)) = w; }
#pragma unroll
            for (int i = 0; i < 4; ++i) { const int p = tid + 512 * i, d = p >> 4, c0 = (p & 15) * 4; float v[4];
#pragma unroll
                for (int r = 0; r < 4; ++r) v[r] = bf2f(KS[(c0 + r) * GROW + d]) * __expf(glast - GC[c0 + r]);
                v2u w; w.x = cvtpk(v[0], v[1]); w.y = cvtpk(v[2], v[3]);
                *(v2u*)(Gb.KDT + (size_t)item * 8192 + frag_off(d, c0, 2)) = w; }
        }
        LDS_BARRIER();
#pragma unroll
        for (int i = 0; i < 4; ++i) { const int p = tid + 512 * i, c = p >> 5, d0 = (p & 31) * 4; const v2u r = *(const LAS v2u*)(WT + c * GROW + d0);
            *(v2u*)(Gb.NW + (size_t)item * 8192 + frag_off(c, d0, 4)) = r; }
        asm volatile("" :: "v"(pf));
        LDS_BARRIER();
    }
}

__device__ __forceinline__ void gdn_scan_unit(Frame& F, int s, const GdnBufs& Gb) {
    const int bh = s >> 2, half = s & 3, h = bh & 3, b = bh >> 2;
    const int tid = F.tid, lane = F.lane, wave = F.wave, fr = lane & 15, g = lane >> 4;
    LAS unsigned char* L = F.lds;
    const size_t tb = (size_t)b * SEQ;
    const int item0 = bh * 128;
    const int lt = tid - 256;
#define GDN_SRC(it, i) ((i) < 4 ? (const v4u*)(Gb.NW + (size_t)(it) * 8192) + lt + 256 * (i) : (i) < 8 ? (const v4u*)(Gb.QD + (size_t)(it) * 8192) + lt + 256 * ((i) - 4) : \
                        (i) < 12 ? (const v4u*)(Gb.KDT + (size_t)(it) * 8192) + lt + 256 * ((i) - 8) : (i) < 14 ? (const v4u*)(Gb.QK + (size_t)(it) * 4096) + lt + 256 * ((i) - 12) : \
                        (const v4u*)(Gb.UT + (size_t)(it) * 8192 + half * 2048) + lt + 256 * ((i) - 14))
#define GDN_LOADR(R, it) do { _Pragma("unroll") for (int i_ = 0; i_ < 15; ++i_) R[i_] = *GDN_SRC(it, i_); } while (0)
#define GDN_STORER(R, bufp) do { _Pragma("unroll") for (int i_ = 0; i_ < 15; ++i_) *(LAS v4u*)((bufp) + (i_ * 256 + lt) * 16) = R[i_]; } while (0)
    LAS float* CDL = (LAS float*)(L + 131072 + 1024);
    LAS bf16_t* OTB = (LAS bf16_t*)(L + 131072 + 2048);
#define GDN_OSTORE(step) do { if (wave < 6 && (step) < 128) { const LAS bf16_t* ot_ = OTB + ((wave - 4) * 2 + ((step) & 1)) * 1024; \
        const v4u o0_ = *(const LAS v4u*)(ot_ + lane * 16), o1_ = *(const LAS v4u*)(ot_ + lane * 16 + 8); \
        bf16_t* dst_ = Gb.ORAW + (tb + (size_t)(step) * 64 + lane) * 512 + h * 128 + half * 32 + (wave - 4) * 16; *(v4u*)dst_ = o0_; *(v4u*)(dst_ + 8) = o1_; } } while (0)
    if (wave >= 4) {
        if (wave == 4) { CDL[lane] = Gb.CD[item0 + lane]; CDL[64 + lane] = Gb.CD[item0 + 64 + lane]; }
        v4u r0[15], r1[15], r2[15];
        GDN_LOADR(r0, item0); GDN_LOADR(r1, item0 + 1); GDN_LOADR(r2, item0 + 2);
        GDN_STORER(r0, L);
        LDS_BARRIER();
#define GDN_CL(k) (item0 + ((k) < 127 ? (k) : 127))
        for (int n = 0; n < 129; n += 3) {
            GDN_LOADR(r0, GDN_CL(n + 3)); GDN_STORER(r1, L + ((n + 1) & 1) * 65536); LDS_BARRIER(); GDN_OSTORE(n);
            GDN_LOADR(r1, GDN_CL(n + 4)); GDN_STORER(r2, L + ((n + 2) & 1) * 65536); LDS_BARRIER(); GDN_OSTORE(n + 1);
            GDN_LOADR(r2, GDN_CL(n + 5)); GDN_STORER(r0, L + ((n + 3) & 1) * 65536); LDS_BARRIER(); GDN_OSTORE(n + 2);
        }
#undef GDN_CL
    } else if (wave >= 2) {
        for (int n = 0; n < 130; ++n) LDS_BARRIER();
    } else {
        LDS_BARRIER();
        f32x4_t S[8];
#pragma unroll
        for (int i = 0; i < 8; ++i) S[i] = (f32x4_t){0.f, 0.f, 0.f, 0.f};
        for (int n = 0; n < 128; ++n) {
            LAS unsigned char* B = L + (n & 1) * 65536;
            const float cd = CDL[n];
            bf16x8_t sb[4];
#pragma unroll
            for (int ks = 0; ks < 4; ++ks) sb[ks] = __builtin_bit_cast(bf16x8_t, (v4u){cvtpk(S[2 * ks][0], S[2 * ks][1]), cvtpk(S[2 * ks][2], S[2 * ks][3]), cvtpk(S[2 * ks + 1][0], S[2 * ks + 1][1]), cvtpk(S[2 * ks + 1][2], S[2 * ks + 1][3])});
#define GDN_SB() __builtin_amdgcn_sched_barrier(0)
            const LAS unsigned char* Bl = B + lane * 16;
            v2u u8[4]; bf16x8_t fa[16], fb[16];
#pragma unroll
            for (int rt = 0; rt < 4; ++rt) u8[rt] = *(const LAS v2u*)(B + 57344 + ((wave * 16 + fr) * 64 + 16 * rt + 4 * g) * 2);
#pragma unroll
            for (int i = 0; i < 16; ++i) fa[i] = *(const LAS bf16x8_t*)(Bl + ((i & 3) * 4 + (i >> 2)) * 1024);
            GDN_SB();
#pragma unroll
            for (int i = 0; i < 16; ++i) fb[i] = *(const LAS bf16x8_t*)(Bl + 16384 + ((i & 3) * 4 + (i >> 2)) * 1024);
            GDN_SB();
            f32x4_t va[4], oa[4];
#pragma unroll
            for (int rt = 0; rt < 4; ++rt) { va[rt] = (f32x4_t){bflo(u8[rt].x), bfhi(u8[rt].x), bflo(u8[rt].y), bfhi(u8[rt].y)}; oa[rt] = (f32x4_t){0.f, 0.f, 0.f, 0.f}; }
#pragma unroll
            for (int i = 0; i < 16; ++i) va[i & 3] = __builtin_amdgcn_mfma_f32_16x16x32_bf16(fa[i], sb[i >> 2], va[i & 3], 0, 0, 0);
            GDN_SB();
#pragma unroll
            for (int i = 0; i < 8; ++i) fa[i] = *(const LAS bf16x8_t*)(Bl + 49152 + ((i & 3) * 2 + (i >> 2)) * 1024);
#pragma unroll
            for (int i = 0; i < 8; ++i) fa[8 + i] = *(const LAS bf16x8_t*)(Bl + 32768 + ((i & 3) * 2 + (i >> 2)) * 1024);
            GDN_SB();
#pragma unroll
            for (int i = 0; i < 16; ++i) oa[i & 3] = __builtin_amdgcn_mfma_f32_16x16x32_bf16(fb[i], sb[i >> 2], oa[i & 3], 0, 0, 0);
            bf16x8_t vb[2];
#pragma unroll
            for (int k2 = 0; k2 < 2; ++k2) vb[k2] = __builtin_bit_cast(bf16x8_t, (v4u){cvtpk(va[2 * k2][0], va[2 * k2][1]), cvtpk(va[2 * k2][2], va[2 * k2][3]), cvtpk(va[2 * k2 + 1][0], va[2 * k2 + 1][1]), cvtpk(va[2 * k2 + 1][2], va[2 * k2 + 1][3])});
#pragma unroll
            for (int dt = 0; dt < 8; ++dt) S[dt] = S[dt] * cd;
            GDN_SB();
#pragma unroll
            for (int i = 0; i < 8; ++i) fb[i] = *(const LAS bf16x8_t*)(Bl + 32768 + 8192 + ((i & 3) * 2 + (i >> 2)) * 1024);
            GDN_SB();
#pragma unroll
            for (int i = 0; i < 8; ++i) oa[i & 3] = __builtin_amdgcn_mfma_f32_16x16x32_bf16(fa[i], vb[i >> 2], oa[i & 3], 0, 0, 0);
#pragma unroll
            for (int i = 0; i < 8; ++i) S[i & 3] = __builtin_amdgcn_mfma_f32_16x16x32_bf16(fa[8 + i], vb[i >> 2], S[i & 3], 0, 0, 0);
            GDN_SB();
#pragma unroll
            for (int i = 0; i < 8; ++i) S[4 + (i & 3)] = __builtin_amdgcn_mfma_f32_16x16x32_bf16(fb[i], vb[i >> 2], S[4 + (i & 3)], 0, 0, 0);
            GDN_SB();
#undef GDN_SB
            { LAS bf16_t* OT = OTB + (wave * 2 + (n & 1)) * 1024;
#pragma unroll
              for (int rt = 0; rt < 4; ++rt)
#pragma unroll
                for (int r = 0; r < 4; ++r) OT[(16 * rt + 4 * g + r) * 16 + fr] = f2bf(oa[rt][r]); }
            LDS_BARRIER();
        }
        LDS_BARRIER();
    }
#undef GDN_SRC
#undef GDN_LOADR
#undef GDN_OSTORE
#undef GDN_STORER
}

__device__ __forceinline__ void gdn_finish_phase(Frame& F, const Args& a, const GdnBufs& Gb, const bf16_t* GZ, bf16_t* OG) {
    const int gt = F.vcu * NWAVES * 64 + F.tid, ngt = F.G * NWAVES * 64;
    for (int p = gt; p < T * 64; p += ngt) {
        const size_t t = (size_t)(p >> 6); const int col = (p & 63) * 8, e0 = col & 127;
        const v4u o = *(const v4u*)(Gb.ORAW + t * 512 + col), z = *(const v4u*)(GZ + t * 512 + col);
        const unsigned ow[4] = {o.x, o.y, o.z, o.w}, zw[4] = {z.x, z.y, z.z, z.w};
        float ss = 0.f;
#pragma unroll
        for (int i = 0; i < 4; ++i) { const float a0 = bflo(ow[i]), a1 = bfhi(ow[i]); ss += a0 * a0 + a1 * a1; }
        ss += __shfl_xor(ss, 1); ss += __shfl_xor(ss, 2); ss += __shfl_xor(ss, 4); ss += __shfl_xor(ss, 8);
        const float rinv = rsqrtf(ss * (1.f / 128.f) + EPS);
        const f32x4_t g0 = *(const f32x4_t*)(a.gdn_norm_g + e0), g1 = *(const f32x4_t*)(a.gdn_norm_g + e0 + 4);
        const float gg[8] = {g0[0], g0[1], g0[2], g0[3], g1[0], g1[1], g1[2], g1[3]};
        unsigned r[4];
#pragma unroll
        for (int i = 0; i < 4; ++i) { const float z0 = bflo(zw[i]), z1 = bfhi(zw[i]);
            r[i] = cvtpk(bflo(ow[i]) * rinv * gg[2 * i] * (z0 / (1.f + __expf(-z0))), bfhi(ow[i]) * rinv * gg[2 * i + 1] * (z1 / (1.f + __expf(-z1)))); }
        *(v4u*)(OG + t * 512 + col) = (v4u){r[0], r[1], r[2], r[3]};
    }
}
typedef float f32x2_t __attribute__((ext_vector_type(2)));
__device__ __forceinline__ float gelu_erf(float v) { return 0.5f * v * (1.f + erff(v * 0.70710678118654752f)); }
constexpr int PEER_CH = 16;
constexpr int CW_PEERU = 8192, CW_PEERV = 8192 + 1024;

#define PEER_U_COMPUTE(W, TOK) do { const size_t t_ = (TOK); const float rs = rstd2[t_]; \
        const v4u xr0 = *(const v4u*)(X2B + t_ * 1024 + 128 * x + 16 * j), xr1 = *(const v4u*)(X2B + t_ * 1024 + 128 * x + 16 * j + 8); \
        const unsigned xw[8] = {xr0.x, xr0.y, xr0.z, xr0.w, xr1.x, xr1.y, xr1.z, xr1.w}; f32x2_t xf[8]; \
        _Pragma("unroll") for (int q = 0; q < 8; ++q) { xf[q].x = bflo(xw[q]) * rs * gp[q >> 1][(q & 1) * 2]; xf[q].y = bfhi(xw[q]) * rs * gp[q >> 1][(q & 1) * 2 + 1]; } \
        float p[16]; \
        _Pragma("unroll") for (int i = 0; i < 16; ++i) { const unsigned ww[4] = {W[i].x, W[i].y, W[i].z, W[i].w}; f32x2_t acc = {0.f, 0.f}; \
            _Pragma("unroll") for (int q = 0; q < 4; ++q) { acc = __builtin_elementwise_fma(__builtin_amdgcn_cvt_pk_f32_fp8(ww[q], false), xf[2 * q], acc); acc = __builtin_elementwise_fma(__builtin_amdgcn_cvt_pk_f32_fp8(ww[q], true), xf[2 * q + 1], acc); } \
            p[i] = acc.x + acc.y; } \
        _Pragma("unroll") for (int off = 4; off >= 1; off >>= 1) { const bool up = (j & off) != 0; \
            _Pragma("unroll") for (int i = 0; i < 2 * off; ++i) { const float lo = p[i], hi = p[i + 2 * off]; const float send = up ? lo : hi, keep = up ? hi : lo; p[i] = keep + __shfl_xor(send, off); } } \
        bf16_t* dst = PART + ((size_t)x * T + t_) * 128 + 16 * j + g; dst[0] = f2bf(p[0]); dst[8] = f2bf(p[1]); } while (0)
__device__ __forceinline__ void peer_u_phase(Frame& F, const Args& a, gu32* ctl, const bf16_t* X2B, const float* rstd2, const int* EIDX, const unsigned char* U8, bf16_t* PART) {
    const int lane = F.lane, g = lane >> 3, j = lane & 7;
    const int x0 = (int)(xb_xcc_id() & 7u);
    for (int s = 0; s < 8; ++s) {
        const int x = (x0 + s) & 7;
        f32x4_t gp[4];
#pragma unroll
        for (int q = 0; q < 4; ++q) gp[q] = *(const f32x4_t*)(a.g_peer + 128 * x + 16 * j + 4 * q);
        const unsigned char* Ux = U8 + (size_t)x * 16384 * 128 + 16 * j;
        for (;;) {
            int c = 0; if (lane == 0) c = (int)__hip_atomic_fetch_add(ctl + CW_PEERU + 64 * x, 1u, __ATOMIC_RELAXED, __HIP_MEMORY_SCOPE_AGENT);
            c = __builtin_amdgcn_readfirstlane(c);
            if (c >= T / PEER_CH) break;
            const size_t tc = (size_t)c * PEER_CH, tl = tc + PEER_CH - 1;
            int en[16]; v4u wa[16], wb[16];
            { const int e0_ = EIDX[(tc) * 128 + lane], e1_ = EIDX[(tc) * 128 + 64 + lane];
#pragma unroll
              for (int i = 0; i < 16; ++i) en[i] = __shfl(i < 8 ? e0_ : e1_, 8 * (i & 7) + g); }
#pragma unroll
            for (int i = 0; i < 16; ++i) wa[i] = *(const v4u*)(Ux + (size_t)en[i] * 128);
            { const int e0_ = EIDX[((tc + 1)) * 128 + lane], e1_ = EIDX[((tc + 1)) * 128 + 64 + lane];
#pragma unroll
              for (int i = 0; i < 16; ++i) en[i] = __shfl(i < 8 ? e0_ : e1_, 8 * (i & 7) + g); }
            for (int tt = 0; tt < PEER_CH; tt += 2) {
                const size_t t = tc + tt, t2 = (t + 2 < tl) ? t + 2 : tl, t3 = (t + 3 < tl) ? t + 3 : tl;
#pragma unroll
                for (int i = 0; i < 16; ++i) wb[i] = *(const v4u*)(Ux + (size_t)en[i] * 128);
                { const int e0_ = EIDX[(t2) * 128 + lane], e1_ = EIDX[(t2) * 128 + 64 + lane];
#pragma unroll
              for (int i = 0; i < 16; ++i) en[i] = __shfl(i < 8 ? e0_ : e1_, 8 * (i & 7) + g); }
                PEER_U_COMPUTE(wa, t);
#pragma unroll
                for (int i = 0; i < 16; ++i) wa[i] = *(const v4u*)(Ux + (size_t)en[i] * 128);
                { const int e0_ = EIDX[(t3) * 128 + lane], e1_ = EIDX[(t3) * 128 + 64 + lane];
#pragma unroll
              for (int i = 0; i < 16; ++i) en[i] = __shfl(i < 8 ? e0_ : e1_, 8 * (i & 7) + g); }
                PEER_U_COMPUTE(wb, t + 1);
            }
        }
    }
}
__device__ __forceinline__ void peer_combine_phase(Frame& F, const bf16_t* PART, const int* EIDX, const float* EGATE, const float* SU, const float* SV, float* ACTS) {
    const int gt = F.vcu * NWAVES * 64 + F.tid, ngt = F.G * NWAVES * 64;
    for (int p = gt; p < T * 32; p += ngt) {
        f32x4_t s = {0.f, 0.f, 0.f, 0.f};
#pragma unroll
        for (int x = 0; x < 8; ++x) { const v2u w = *(const v2u*)(PART + (size_t)x * T * 128 + (size_t)p * 4); s += (f32x4_t){bflo(w.x), bfhi(w.x), bflo(w.y), bfhi(w.y)}; }
        const int4 e = *(const int4*)(EIDX + (size_t)p * 4); const f32x4_t gt4 = *(const f32x4_t*)(EGATE + (size_t)p * 4);
        *(f32x4_t*)(ACTS + (size_t)p * 4) = (f32x4_t){gelu_erf(s[0] * SU[e.x]) * gt4[0] * SV[e.x], gelu_erf(s[1] * SU[e.y]) * gt4[1] * SV[e.y], gelu_erf(s[2] * SU[e.z]) * gt4[2] * SV[e.z], gelu_erf(s[3] * SU[e.w]) * gt4[3] * SV[e.w]};
    }
}
#define PEER_V_COMPUTE(W, TOK) do { const size_t t_ = (TOK); float av[16]; \
        { const float a0_ = ACTS[t_ * 128 + lane], a1_ = ACTS[t_ * 128 + 64 + lane]; _Pragma("unroll") for (int i = 0; i < 16; ++i) av[i] = __shfl(i < 8 ? a0_ : a1_, 8 * (i & 7) + g); } \
        const size_t oo_ = t_ * 1024 + 128 * x + 16 * j + 2 * g; const unsigned xw_ = *(const unsigned*)(X2B + oo_); const f32x2_t xv = {bflo(xw_), bfhi(xw_)}; \
        f32x2_t o2[8]; _Pragma("unroll") for (int q = 0; q < 8; ++q) o2[q] = (f32x2_t){0.f, 0.f}; \
        _Pragma("unroll") for (int i = 0; i < 16; ++i) { const unsigned ww[4] = {W[i].x, W[i].y, W[i].z, W[i].w}; const f32x2_t a2 = {av[i], av[i]}; \
            _Pragma("unroll") for (int q = 0; q < 4; ++q) { o2[2 * q] = __builtin_elementwise_fma(__builtin_amdgcn_cvt_pk_f32_fp8(ww[q], false), a2, o2[2 * q]); o2[2 * q + 1] = __builtin_elementwise_fma(__builtin_amdgcn_cvt_pk_f32_fp8(ww[q], true), a2, o2[2 * q + 1]); } } \
        float o[16]; _Pragma("unroll") for (int q = 0; q < 8; ++q) { o[2 * q] = o2[q].x; o[2 * q + 1] = o2[q].y; } \
        _Pragma("unroll") for (int off = 4; off >= 1; off >>= 1) { const bool up = (g & off) != 0; \
            _Pragma("unroll") for (int i = 0; i < 2 * off; ++i) { const float lo = o[i], hi = o[i + 2 * off]; const float send = up ? lo : hi, keep = up ? hi : lo; o[i] = keep + __shfl_xor(send, 8 * off); } } \
        const unsigned rw_ = cvtpk(xv.x + o[0], xv.y + o[1]); *(unsigned*)(X3B + oo_) = rw_; const float r0 = bflo(rw_), r1 = bfhi(rw_); \
        const float ss = wave_sum(r0 * r0 + r1 * r1); if (lane == 0) SS3[t_ * 8 + x] = ss; } while (0)
__device__ __forceinline__ void peer_v_phase(Frame& F, gu32* ctl, const int* EIDX, const float* ACTS, const unsigned char* V8, const bf16_t* X2B, bf16_t* X3B, float* SS3) {
    const int lane = F.lane, g = lane >> 3, j = lane & 7;
    const int x0 = (int)(xb_xcc_id() & 7u);
    for (int s = 0; s < 8; ++s) {
        const int x = (x0 + s) & 7;
        const unsigned char* Vx = V8 + (size_t)x * 16384 * 128 + 16 * j;
        for (;;) {
            int c = 0; if (lane == 0) c = (int)__hip_atomic_fetch_add(ctl + CW_PEERV + 64 * x, 1u, __ATOMIC_RELAXED, __HIP_MEMORY_SCOPE_AGENT);
            c = __builtin_amdgcn_readfirstlane(c);
            if (c >= T / PEER_CH) break;
            const size_t tc = (size_t)c * PEER_CH, tl = tc + PEER_CH - 1;
            int en[16]; v4u wa[16], wb[16];
            { const int e0_ = EIDX[(tc) * 128 + lane], e1_ = EIDX[(tc) * 128 + 64 + lane];
#pragma unroll
              for (int i = 0; i < 16; ++i) en[i] = __shfl(i < 8 ? e0_ : e1_, 8 * (i & 7) + g); }
#pragma unroll
            for (int i = 0; i < 16; ++i) wa[i] = *(const v4u*)(Vx + (size_t)en[i] * 128);
            { const int e0_ = EIDX[((tc + 1)) * 128 + lane], e1_ = EIDX[((tc + 1)) * 128 + 64 + lane];
#pragma unroll
              for (int i = 0; i < 16; ++i) en[i] = __shfl(i < 8 ? e0_ : e1_, 8 * (i & 7) + g); }
            for (int tt = 0; tt < PEER_CH; tt += 2) {
                const size_t t = tc + tt, t2 = (t + 2 < tl) ? t + 2 : tl, t3 = (t + 3 < tl) ? t + 3 : tl;
#pragma unroll
                for (int i = 0; i < 16; ++i) wb[i] = *(const v4u*)(Vx + (size_t)en[i] * 128);
                { const int e0_ = EIDX[(t2) * 128 + lane], e1_ = EIDX[(t2) * 128 + 64 + lane];
#pragma unroll
              for (int i = 0; i < 16; ++i) en[i] = __shfl(i < 8 ? e0_ : e1_, 8 * (i & 7) + g); }
                PEER_V_COMPUTE(wa, t);
#pragma unroll
                for (int i = 0; i < 16; ++i) wa[i] = *(const v4u*)(Vx + (size_t)en[i] * 128);
                { const int e0_ = EIDX[(t3) * 128 + lane], e1_ = EIDX[(t3) * 128 + 64 + lane];
#pragma unroll
              for (int i = 0; i < 16; ++i) en[i] = __shfl(i < 8 ? e0_ : e1_, 8 * (i & 7) + g); }
                PEER_V_COMPUTE(wb, t + 1);
            }
        }
    }
}
__device__ __forceinline__ void peer_norm_phase(Frame& F, const Args& a, const float* SS3, const bf16_t* X3B, float* out) {
    const int gt = F.vcu * NWAVES * 64 + F.tid, ngt = F.G * NWAVES * 64;
    for (int p = gt; p < T * 128; p += ngt) {
        const size_t t = (size_t)(p >> 7); const int c = (p & 127) * 8;
        const f32x4_t s0 = *(const f32x4_t*)(SS3 + t * 8), s1 = *(const f32x4_t*)(SS3 + t * 8 + 4);
        const float r3 = rsqrtf(((s0[0] + s0[1]) + (s0[2] + s0[3]) + (s1[0] + s1[1]) + (s1[2] + s1[3])) * (1.f / D) + EPS);
        const v4u w = *(const v4u*)(X3B + t * 1024 + c);
        const f32x4_t g0 = *(const f32x4_t*)(a.g_final + c), g1 = *(const f32x4_t*)(a.g_final + c + 4);
        *(f32x4_t*)(out + t * 1024 + c) = (f32x4_t){bflo(w.x), bfhi(w.x), bflo(w.y), bfhi(w.y)} * g0 * r3;
        *(f32x4_t*)(out + t * 1024 + c + 4) = (f32x4_t){bflo(w.z), bfhi(w.z), bflo(w.w), bfhi(w.w)} * g1 * r3;
    }
}
#ifndef TOPK_HD
#define TOPK_HD __device__ __forceinline__
#endif
TOPK_HD void ce_desc(unsigned& a, unsigned& b) { const unsigned hi = a > b ? a : b, lo = a > b ? b : a; a = hi; b = lo; }
TOPK_HD void sort16_desc(unsigned (&v)[16]) {
#pragma unroll
    for (int k = 2; k <= 16; k <<= 1)
#pragma unroll
        for (int j = k >> 1; j >= 1; j >>= 1)
#pragma unroll
            for (int i = 0; i < 16; ++i) { const int l = i ^ j; if (l > i) { if ((i & k) == 0) ce_desc(v[i], v[l]); else ce_desc(v[l], v[i]); } }
}
TOPK_HD void bitonic_merge16_desc(unsigned (&v)[16]) {
#pragma unroll
    for (int j = 8; j >= 1; j >>= 1)
#pragma unroll
        for (int i = 0; i < 16; ++i) { const int l = i ^ j; if (l > i) ce_desc(v[i], v[l]); }
}
TOPK_HD void top16_merge(unsigned (&a)[16], const unsigned (&b)[16]) {
#pragma unroll
    for (int i = 0; i < 16; ++i) a[i] = a[i] > b[15 - i] ? a[i] : b[15 - i];
    bitonic_merge16_desc(a);
}
TOPK_HD unsigned f2ord(float f) { const unsigned u = __builtin_bit_cast(unsigned, f); return (u & 0x80000000u) ? ~u : (u | 0x80000000u); }
TOPK_HD float ord2f(unsigned o) { const unsigned u = (o & 0x80000000u) ? (o & 0x7fffffffu) : ~o; return __builtin_bit_cast(float, u); }

__device__ __forceinline__ void peer_route_task(Frame& F, const bf16_t* PQ, const bf16_t* SK16, int* EIDX, float* EGATE, int tt, int h) {
    constexpr int CI[50] = {0,0,0,0,0,0,0,0,0,0,0,0,0,0,0,0,1,1,1,1,1,1,1,1,2,2,2,2,2,3,3,3,3,4,4,4,5,5,6,6,7,7,8,9,10,11,12,13,14,15};
    constexpr int CJ[50] = {0,1,2,3,4,5,6,7,8,9,10,11,12,13,14,15,0,1,2,3,4,5,6,7,0,1,2,3,4,0,1,2,3,0,1,2,0,1,0,1,0,1,0,0,0,0,0,0,0,0};
    int lane = F.lane; asm volatile("" : "+v"(lane));
    const int t = lane & 31, hi = lane >> 5;
    LAS unsigned* wl = (LAS unsigned*)(F.lds + F.wave * 16384) + lane * 33;
    {
        const size_t row = (size_t)tt * 32 + t;
        unsigned L[2][16];
#pragma unroll
        for (int p = 0; p < 2; ++p) {
            const int hp = h * 2 + p;
            bf16x8_t Bf[8], An[8];
#pragma unroll
            for (int ks = 0; ks < 8; ++ks) Bf[ks] = *(const bf16x8_t*)(PQ + row * 2048 + hp * 128 + 16 * ks + 8 * hi);
            const bf16_t* Abase = SK16 + ((size_t)(hp * 128 + t)) * 128 + 8 * hi;
#pragma unroll
            for (int ks = 0; ks < 8; ++ks) An[ks] = *(const bf16x8_t*)(Abase + 16 * ks);
#pragma unroll
            for (int i = 0; i < 16; ++i) L[p][i] = 0u;
#pragma unroll 1
            for (int nt = 0; nt < 4; ++nt) {
                bf16x8_t Ac[8];
#pragma unroll
                for (int ks = 0; ks < 8; ++ks) Ac[ks] = An[ks];
                const int nn = nt < 3 ? nt + 1 : 3;
#pragma unroll
                for (int ks = 0; ks < 8; ++ks) An[ks] = *(const bf16x8_t*)(Abase + (size_t)nn * 32 * 128 + 16 * ks);
                f32x16_t acc = {};
#pragma unroll
                for (int ks = 0; ks < 8; ++ks) acc = __builtin_amdgcn_mfma_f32_32x32x16_bf16(Ac[ks], Bf[ks], acc, 0, 0, 0);
                unsigned k[16];
#pragma unroll
                for (int r = 0; r < 16; ++r) { const int n = 32 * nt + (r & 3) + 8 * (r >> 2) + 4 * hi; k[r] = (f2ord(acc[r]) & ~127u) | (unsigned)(127 - n); }
                sort16_desc(k);
                top16_merge(L[p], k);
            }
            unsigned pb[16];
#pragma unroll
            for (int i = 0; i < 16; ++i) pb[i] = __shfl_xor(L[p][i], 32);
            top16_merge(L[p], pb);
        }
        float sa[16], sb[16];
#pragma unroll
        for (int i = 0; i < 16; ++i) { sa[i] = ord2f(L[0][i] & ~127u); sb[i] = ord2f(L[1][i] & ~127u); wl[i] = 127u - (L[0][i] & 127u); wl[16 + i] = 127u - (L[1][i] & 127u); }
        unsigned c0[16], c1[16];
#pragma unroll
        for (int s = 0; s < 32; ++s) {
            unsigned key = 0u;
            if (s < 25) { const float v = hi ? sa[CI[25 + s]] + sb[CJ[25 + s]] : sa[CI[s]] + sb[CJ[s]]; const int pos = hi ? CI[25 + s] * 16 + CJ[25 + s] : CI[s] * 16 + CJ[s];
                key = (f2ord(v) & ~255u) | (unsigned)(255 - pos); }
            if (s < 16) c0[s] = key; else c1[s - 16] = key;
        }
        sort16_desc(c0); sort16_desc(c1); top16_merge(c0, c1);
        unsigned pb[16];
#pragma unroll
        for (int i = 0; i < 16; ++i) pb[i] = __shfl_xor(c0[i], 32);
        top16_merge(c0, pb);
        float e[16]; const float m = ord2f(c0[0] & ~255u); float l = 0.f;
#pragma unroll
        for (int r = 0; r < 16; ++r) { e[r] = __expf(ord2f(c0[r] & ~255u) - m); l += e[r]; }
        const float il = 1.f / l;
        int ex[8]; float gt[8];
#pragma unroll
        for (int q = 0; q < 8; ++q) { const unsigned kk = hi ? c0[8 + q] : c0[q]; const int pos = 255 - (int)(kk & 255u); ex[q] = (int)(wl[pos >> 4] * 128u + wl[16 + (pos & 15)]); gt[q] = (hi ? e[8 + q] : e[q]) * il; }
        int* ep = EIDX + row * 128 + h * 16 + hi * 8; float* gp = EGATE + row * 128 + h * 16 + hi * 8;
        *(int4*)ep = make_int4(ex[0], ex[1], ex[2], ex[3]); *(int4*)(ep + 4) = make_int4(ex[4], ex[5], ex[6], ex[7]);
        *(f32x4_t*)gp = (f32x4_t){gt[0], gt[1], gt[2], gt[3]}; *(f32x4_t*)(gp + 4) = (f32x4_t){gt[4], gt[5], gt[6], gt[7]};
    }
}
__device__ __forceinline__ void cross_item(Frame& F, const bf16_t* QC, const bf16_t* KC, const bf16_t* VC, bf16_t* OC, int bh, int qb) {
    int tid = F.tid; asm volatile("" : "+v"(tid));
    const int lane = tid & 63, wave = F.wave, q = lane & 31, hi = lane >> 5;
    LAS unsigned char* L = F.lds;
    const int g4 = lane >> 4, qq = (lane >> 2) & 3, p4 = lane & 3;
    {
        const int b = bh >> 2, h = bh & 3;
#pragma unroll
        for (int i = 0; i < 16; ++i) { const int cid = tid + 512 * i, r = cid >> 5, c = cid & 31;
            *(LAS v4u*)(L + r * 512 + ((c ^ (r & 15)) << 4)) = *(const v4u*)(KC + (size_t)(b * 256 + r) * 1024 + h * 256 + c * 8); }
        const size_t qrow0 = (size_t)b * SEQ + qb * 256 + wave * 32;
        const bf16_t* Qp = QC + (qrow0 + q) * 1024 + h * 256 + 8 * hi;
        __syncthreads();
        f32x16_t st[8];
#pragma unroll
        for (int kt = 0; kt < 8; ++kt) st[kt] = (f32x16_t){};
#pragma unroll 2
        for (int ks = 0; ks < 16; ++ks) { const bf16x8_t qf = *(const bf16x8_t*)(Qp + 16 * ks);
#pragma unroll
            for (int kt = 0; kt < 8; ++kt) { const int row = 32 * kt + q;
                st[kt] = __builtin_amdgcn_mfma_f32_32x32x16_bf16(*(const LAS bf16x8_t*)(L + row * 512 + (((2 * ks + hi) ^ (row & 15)) << 4)), qf, st[kt], 0, 0, 0); } }
        float m = -INFINITY;
#pragma unroll
        for (int kt = 0; kt < 8; ++kt)
#pragma unroll
            for (int r = 0; r < 16; ++r) { st[kt][r] *= 0.0625f; m = fmaxf(m, st[kt][r]); }
        m = fmaxf(m, __shfl_xor(m, 32));
        float l = 0.f;
#pragma unroll
        for (int kt = 0; kt < 8; ++kt)
#pragma unroll
            for (int r = 0; r < 16; ++r) { st[kt][r] = __expf(st[kt][r] - m); l += st[kt][r]; }
        l += __shfl_xor(l, 32);
        const float il = 1.f / l;
        bf16x8_t pa[8][2];
#pragma unroll
        for (int kt = 0; kt < 8; ++kt)
#pragma unroll
            for (int s = 0; s < 2; ++s) pa[kt][s] = __builtin_bit_cast(bf16x8_t, (v4u){cvtpk(st[kt][8 * s] * il, st[kt][8 * s + 1] * il), cvtpk(st[kt][8 * s + 2] * il, st[kt][8 * s + 3] * il),
                                                                                        cvtpk(st[kt][8 * s + 4] * il, st[kt][8 * s + 5] * il), cvtpk(st[kt][8 * s + 6] * il, st[kt][8 * s + 7] * il)});
        __syncthreads();
#pragma unroll
        for (int i = 0; i < 16; ++i) { const int cid = tid + 512 * i, r = cid >> 5, c = cid & 31;
            *(LAS v4u*)(L + r * 512 + ((c ^ (4 * (r & 3))) << 4)) = *(const v4u*)(VC + (size_t)(b * 256 + r) * 1024 + h * 256 + c * 8); }
        __syncthreads();
        bf16_t* Op = OC + qrow0 * 1024 + h * 256 + q;
#pragma unroll 1
        for (int dt = 0; dt < 8; ++dt) {
            f32x16_t o = {};
            LAS unsigned char* vb = L + (4 * (g4 >> 1) + qq) * 512 + (((dt * 64) ^ (qq << 6)) + (g4 & 1) * 32 + p4 * 8);
#pragma unroll
            for (int kt = 0; kt < 8; ++kt)
#pragma unroll
                for (int s = 0; s < 2; ++s) { const v4i16_t a0 = lds_tr16(vb + (32 * kt + 16 * s) * 512), a1 = lds_tr16(vb + (32 * kt + 16 * s + 8) * 512);
                    const bf16x8_t vf = {a0[0], a0[1], a0[2], a0[3], a1[0], a1[1], a1[2], a1[3]};
                    o = __builtin_amdgcn_mfma_f32_32x32x16_bf16(pa[kt][s], vf, o, 0, 0, 0); }
#pragma unroll
            for (int r = 0; r < 16; ++r) { const int row = (r & 3) + 8 * (r >> 2) + 4 * hi; Op[(size_t)row * 1024 + dt * 32] = f2bf(o[r]); }
        }
        __syncthreads();
    }
}
template <bool REMAP>
__device__ __forceinline__ void transpose_tile(const float* W, int K, int N, const float* gain, bf16_t* WT, LAS float* tile, int item, int tid) {
    const int nblk = (N + 255) / 256, kb = item / nblk, nb = item % nblk, k0 = 64 * kb, n0 = 256 * nb;
    const int c4 = (tid & 63) * 4, kr = tid >> 6;
    f32x4 v[8];
#pragma unroll
    for (int i = 0; i < 8; ++i) { const int k = kr + 8 * i; v[i] = (n0 + c4 < N) ? *(const GAS f32x4*)(W + (size_t)(k0 + k) * N + n0 + c4) : (f32x4){0.f, 0.f, 0.f, 0.f}; }
#pragma unroll
    for (int i = 0; i < 8; ++i) { const int k = kr + 8 * i; LAS float* d = tile + k * 257 + c4; d[0] = v[i].x; d[1] = v[i].y; d[2] = v[i].z; d[3] = v[i].w; }
    __syncthreads();
#pragma unroll
    for (int i = 0; i < 4; ++i) { const int p = tid + 512 * i, n = p >> 3, c = p & 7; const LAS float* sp = tile + (8 * c) * 257 + n;
        float g[8];
#pragma unroll
        for (int q = 0; q < 8; ++q) g[q] = gain ? gain[k0 + 8 * c + q] : 1.f;
        v4u o; o.x = pk2(sp[0 * 257] * g[0], sp[1 * 257] * g[1]); o.y = pk2(sp[2 * 257] * g[2], sp[3 * 257] * g[3]); o.z = pk2(sp[4 * 257] * g[4], sp[5 * 257] * g[5]); o.w = pk2(sp[6 * 257] * g[6], sp[7 * 257] * g[7]);
        int ng = n0 + n; bool ok = ng < N;
        if (REMAP) { if (ng >= 3584 && ng < 3592) ok = false; else if (ng >= 3592) ng -= 8; }
        if (ok) *(GAS v4u*)(WT + (size_t)ng * K + k0 + 8 * c) = o; }
    __syncthreads();
}

__device__ __forceinline__ void p0_prologue(Frame& F, const Args& a) {
    unsigned char* ws = a.ws;
    LAS float* tile = (LAS float*)F.lds;
    const int gw = F.vcu * NWAVES + F.wave, NGW = F.G * NWAVES;
    constexpr int I_IN = 16 * 23;
    for (int it = F.vcu; it < I_IN; it += F.G) transpose_tile<true>(a.w_in, 1024, IN_COLS, a.g_mix, (bf16_t*)(ws + WS_WIN), tile, it, F.tid);
    __syncthreads();
    LAS float* wsm = (LAS float*)F.lds;
    for (int i = F.tid; i < 8192; i += NWAVES * 64) { const int j = i >> 10, k = i & 1023; wsm[i] = a.w_in[(size_t)k * IN_COLS + 3584 + j] * a.g_mix[k]; }
    __syncthreads();
    bf16_t* XB = (bf16_t*)(ws + WS_A0); float* rstd0 = (float*)(ws + WS_RSTD0); float* GB = (float*)(ws + WS_GB); float* GA = GB + T * 4;
    for (int row0 = gw * 4; row0 < T; row0 += NGW * 4) {
        f32x4 v[4][4];
#pragma unroll
        for (int r = 0; r < 4; ++r)
#pragma unroll
            for (int j = 0; j < 4; ++j) v[r][j] = *((const GAS f32x4*)(a.x + (size_t)(row0 + r) * D) + F.lane + 64 * j);
#pragma unroll
        for (int r = 0; r < 4; ++r) { const int row = row0 + r; float s = 0.f;
#pragma unroll
            for (int j = 0; j < 4; ++j) s += (v[r][j].x * v[r][j].x + v[r][j].y * v[r][j].y) + (v[r][j].z * v[r][j].z + v[r][j].w * v[r][j].w);
            const float rstd = rsqrtf(wave_sum(s) * (1.f / D) + EPS);
            GAS unsigned long long* o8 = (GAS unsigned long long*)(XB + (size_t)row * D) + F.lane;
#pragma unroll
            for (int j = 0; j < 4; ++j) o8[64 * j] = (unsigned long long)pk2(v[r][j].x, v[r][j].y) | ((unsigned long long)pk2(v[r][j].z, v[r][j].w) << 32);
            float dj[8];
#pragma unroll
            for (int jj = 0; jj < 8; ++jj) { float d = 0.f;
#pragma unroll
                for (int j = 0; j < 4; ++j) { const f32x4 w = *(const LAS f32x4*)(wsm + jj * 1024 + (F.lane + 64 * j) * 4); d += (v[r][j].x * w.x + v[r][j].y * w.y) + (v[r][j].z * w.z + v[r][j].w * w.w); }
                dj[jj] = d; }
#pragma unroll
            for (int off = 4; off >= 1; off >>= 1) { const bool up = (F.lane & off) != 0;
#pragma unroll
                for (int i = 0; i < off; ++i) { const float lo = dj[i], hi = dj[i + off]; const float send = up ? lo : hi, keep = up ? hi : lo; dj[i] = keep + __shfl_xor(send, off); } }
            float d0 = dj[0]; d0 += __shfl_xor(d0, 8); d0 += __shfl_xor(d0, 16); d0 += __shfl_xor(d0, 32);
            if (F.lane == 0) rstd0[row] = rstd;
            if (F.lane < 4) GB[(size_t)row * 4 + F.lane] = d0 * rstd; else if (F.lane < 8) GA[(size_t)row * 4 + F.lane - 4] = d0 * rstd; }
    }
}
__device__ __forceinline__ void late_prologue(Frame& F, const Args& a, int wgi, int nwg) {
    unsigned char* ws = a.ws;
    LAS float* tile = (LAS float*)F.lds;
    const int gw = wgi * NWAVES + F.wave, NGW = nwg * NWAVES;
    constexpr int I_S = 8 * 4, I_M = 16 * 4, I_L = 16 * 8;
    constexpr int NITEMS = 2 * I_S + 3 * I_M + 2 * I_L;
    for (int it = wgi; it < NITEMS; it += nwg) {
        int r = it;
        if (r < I_S) { transpose_tile<false>(a.w_sb_up, 512, 1024, nullptr, (bf16_t*)(ws + WS_WSB), tile, r, F.tid); continue; } r -= I_S;
        if (r < I_S) { transpose_tile<false>(a.w_gdn_up, 512, 1024, nullptr, (bf16_t*)(ws + WS_WGDN), tile, r, F.tid); continue; } r -= I_S;
        if (r < I_M) { transpose_tile<false>(a.w_mix_out, 1024, 1024, nullptr, (bf16_t*)(ws + WS_WMIX), tile, r, F.tid); continue; } r -= I_M;
        if (r < I_M) { transpose_tile<false>(a.w_cq, 1024, 1024, a.g_cross, (bf16_t*)(ws + WS_WCQ), tile, r, F.tid); continue; } r -= I_M;
        if (r < I_M) { transpose_tile<false>(a.w_co, 1024, 1024, nullptr, (bf16_t*)(ws + WS_WCO), tile, r, F.tid); continue; } r -= I_M;
        if (r < I_L) { transpose_tile<false>(a.w_ckv, 1024, 2048, nullptr, (bf16_t*)(ws + WS_WCKV), tile, r, F.tid); continue; } r -= I_L;
        transpose_tile<false>(a.w_pq, 1024, 2048, a.g_peer, (bf16_t*)(ws + WS_WPQ), tile, r, F.tid);
    }
    __syncthreads();
    {
        float* SUV = (float*)(ws + WS_SUV);
        for (int row0 = gw * 4; row0 < 2 * 16384; row0 += NGW * 4) {
            f32x4 v[4][4];
#pragma unroll
            for (int r = 0; r < 4; ++r) { const int row = row0 + r, tb = row >> 14, e = row & 16383; const float* src = (tb ? a.peer_v : a.peer_u) + (size_t)e * 1024 + 16 * F.lane;
#pragma unroll
                for (int q = 0; q < 4; ++q) v[r][q] = *(const GAS f32x4*)(src + 4 * q); }
#pragma unroll
            for (int r = 0; r < 4; ++r) { const int row = row0 + r, tb = row >> 14, e = row & 16383; float am = 0.f;
#pragma unroll
                for (int q = 0; q < 4; ++q) am = fmaxf(am, fmaxf(fmaxf(fabsf(v[r][q].x), fabsf(v[r][q].y)), fmaxf(fabsf(v[r][q].z), fabsf(v[r][q].w))));
#pragma unroll
                for (int o = 1; o < 64; o <<= 1) am = fmaxf(am, __shfl_xor(am, o));
                int ex = 0; if (am > 0.f) (void)frexpf(am, &ex);
                const float sc = ldexpf(1.f, 8 - ex), inv = ldexpf(1.f, ex - 8);
                v4u o; int rr;
                rr = __builtin_amdgcn_cvt_pk_fp8_f32(v[r][0].x * sc, v[r][0].y * sc, 0, false); rr = __builtin_amdgcn_cvt_pk_fp8_f32(v[r][0].z * sc, v[r][0].w * sc, rr, true); o.x = (unsigned)rr;
                rr = __builtin_amdgcn_cvt_pk_fp8_f32(v[r][1].x * sc, v[r][1].y * sc, 0, false); rr = __builtin_amdgcn_cvt_pk_fp8_f32(v[r][1].z * sc, v[r][1].w * sc, rr, true); o.y = (unsigned)rr;
                rr = __builtin_amdgcn_cvt_pk_fp8_f32(v[r][2].x * sc, v[r][2].y * sc, 0, false); rr = __builtin_amdgcn_cvt_pk_fp8_f32(v[r][2].z * sc, v[r][2].w * sc, rr, true); o.z = (unsigned)rr;
                rr = __builtin_amdgcn_cvt_pk_fp8_f32(v[r][3].x * sc, v[r][3].y * sc, 0, false); rr = __builtin_amdgcn_cvt_pk_fp8_f32(v[r][3].z * sc, v[r][3].w * sc, rr, true); o.w = (unsigned)rr;
                *(GAS v4u*)(ws + (tb ? WS_V8 : WS_U8) + ((size_t)(F.lane >> 3) * 16384 + e) * 128 + 16 * (F.lane & 7)) = o;
                if (F.lane == 0) SUV[row] = inv; }
        }
    }
    {
        const int gt = gw * 64 + F.lane, ngt = NGW * 64;
        for (int p = gt; p < 262144 / 8; p += ngt) { const float* src = a.subkeys + (size_t)p * 8; const f32x4 v0 = *(const GAS f32x4*)src, v1 = *(const GAS f32x4*)(src + 4);
            v4u o; o.x = pk2(v0.x, v0.y); o.y = pk2(v0.z, v0.w); o.z = pk2(v1.x, v1.y); o.w = pk2(v1.z, v1.w); *(GAS v4u*)((bf16_t*)(ws + WS_SKB) + (size_t)p * 8) = o; }
    }
    bf16_t* MN = (bf16_t*)(ws + WS_MN);
    for (int row = gw; row < 1024; row += NGW) {
        const GAS f32x4* xr = (const GAS f32x4*)(a.mem + (size_t)row * D) + F.lane;
        f32x4 v[4]; float s = 0.f;
#pragma unroll
        for (int j = 0; j < 4; ++j) { v[j] = xr[64 * j]; s += (v[j].x * v[j].x + v[j].y * v[j].y) + (v[j].z * v[j].z + v[j].w * v[j].w); }
        const float rstd = rsqrtf(wave_sum(s) * (1.f / D) + EPS);
        GAS unsigned long long* o8 = (GAS unsigned long long*)(MN + (size_t)row * D) + F.lane;
#pragma unroll
        for (int j = 0; j < 4; ++j) { const f32x4 g = *((const f32x4*)a.g_mem + F.lane + 64 * j); const f32x4 o = v[j] * g * rstd;
            o8[64 * j] = (unsigned long long)pk2(o.x, o.y) | ((unsigned long long)pk2(o.z, o.w) << 32); }
    }
}
__device__ __forceinline__ void rstd_rows_for_units(Frame& F, int N, const float* SS, float* rstd) {
    pg8::StaticOrder S2; S2.init(T, N, F.G, (int)blockIdx.x); pg8::Unit u;
    for (int i = 0; S2.next(i, u); ++i) if (F.tid < 256) { const int row = u.pm * 256 + F.tid; const f32x4* sp = (const f32x4*)(SS + (size_t)row * 16);
        const f32x4 a = (sp[0] + sp[1]) + (sp[2] + sp[3]); rstd[row] = rsqrtf(((a.x + a.y) + (a.z + a.w)) * (1.f / 1024.f) + EPS); }
    asm volatile("s_waitcnt vmcnt(0)" ::: "memory"); __syncthreads();
}

__device__ __forceinline__ void sub_barrier(gu32* cnt, unsigned n, gu32* tmo) {
    asm volatile("s_waitcnt vmcnt(0)" ::: "memory");
    __syncthreads();
    if (threadIdx.x == 0) {
        __builtin_amdgcn_fence(__ATOMIC_RELEASE, "agent");
        asm volatile("s_waitcnt vmcnt(0)" ::: "memory");
        __hip_atomic_fetch_add(cnt, 1u, __ATOMIC_RELAXED, __HIP_MEMORY_SCOPE_AGENT);
        unsigned sp = 0;
        while (__hip_atomic_load(cnt, __ATOMIC_RELAXED, __HIP_MEMORY_SCOPE_AGENT) < n) { __builtin_amdgcn_s_sleep(2); if (++sp > (1u << 22)) { __hip_atomic_store(tmo, 1u, __ATOMIC_RELAXED, __HIP_MEMORY_SCOPE_AGENT); break; } }
        __builtin_amdgcn_fence(__ATOMIC_ACQUIRE, "agent");
        asm volatile("s_waitcnt vmcnt(0)" ::: "memory");
    }
    __syncthreads();
}

__global__ void __launch_bounds__(NWAVES * 64, 2) mk_fwd(Args args) {
    extern __shared__ __attribute__((aligned(16))) unsigned char lds_raw[];
    Frame F;
    F.lds = (LAS unsigned char*)lds_raw;
    F.tid = threadIdx.x; F.lane = F.tid & 63; F.wave = __builtin_amdgcn_readfirstlane(F.tid >> 6);
    F.G = gridDim.x; { const int bx = blockIdx.x; F.vcu = (F.G % 8 == 0) ? (bx % 8) * (F.G / 8) + bx / 8 : bx; }
    unsigned char* ws = args.ws;
    gu32* ctl = (gu32*)(ws + WS_CTL);
    volatile LAS unsigned* MISC = (volatile LAS unsigned*)(F.lds + MISC_OFF);
    for (int u = F.tid; u < (LDS_BYTES - LDSCTL_OFF) / 4; u += NWAVES * 64) ((LAS unsigned*)(F.lds + LDSCTL_OFF))[u] = 0u;
    __syncthreads();
    XcdBarrier bar = xcd_barrier_post((unsigned*)(ctl + CW_BAR) + args.bar_region * XCD_BAR_WORDS, MISC + 8);
    const int lo = args.ph_lo, hi = args.ph_hi;
#define IN(k) (lo <= (k) && (k) < hi)
#define SEAM(k) do { if (IN(k) && IN((k) + 1)) xcd_barrier(bar); } while (0)
    bf16_t* A0 = (bf16_t*)(ws + WS_A0); bf16_t* A1 = (bf16_t*)(ws + WS_A1);
    bf16_t* MG = (bf16_t*)args.out;
    bf16_t* SBQ = (bf16_t*)args.out; bf16_t* SBK = SBQ + (size_t)T * 512; bf16_t* SBV = SBK + (size_t)T * 512; bf16_t* OSB = SBV + (size_t)T * 512;

    GdnBufs Gb{(bf16_t*)(ws + WS_NW), (bf16_t*)(ws + WS_QD), (bf16_t*)(ws + WS_KDT), (bf16_t*)(ws + WS_QK), (bf16_t*)(ws + WS_UT), (float*)(ws + WS_CD), (bf16_t*)(ws + WS_ORAW), (float*)(ws + WS_OSS)};
    if (IN(0)) { p0_prologue(F, args);}
    SEAM(0);
    if (IN(1)) {
        { pg8::Gemm g{A0, (const bf16_t*)(ws + WS_WIN), T, NPROJ, 1024}; pg8::StaticOrder S; S.init(T, NPROJ, F.G, (int)blockIdx.x);
          pg8::EpiProj E{(const float*)(ws + WS_RSTD0), SBQ, SBK, SBV, A1, (bf16_t*)(ws + WS_GZ), (bf16_t*)(ws + WS_GSB), (bf16_t*)(ws + WS_GGDN)};
          pg8::gemm_phase<pg8::EpiProj, pg8::StaticOrder, true, true>(F.lds, g, S, E); }
    }
    SEAM(1);
    if (IN(2)) { gdn_prep_phase(F, args, A1, (const float*)(ws + WS_GB), (const float*)(ws + WS_GB) + T * 4, Gb); }
    SEAM(2);
    if (IN(3)) {
        const int nscan = F.G > 64 ? 64 : F.G, sb0 = F.G > 64 ? 64 : 0;
        if ((int)blockIdx.x < nscan) for (int s0 = blockIdx.x; s0 < 64; s0 += nscan) { const int s = (nscan == 64) ? ((s0 & 7) + 8 * (s0 >> 5)) * 4 + ((s0 >> 3) & 3) : s0; gdn_scan_unit(F, s, Gb); __syncthreads(); }
        if ((int)blockIdx.x >= sb0) { late_prologue(F, args, (int)blockIdx.x - sb0, F.G - sb0); __syncthreads(); }
        if ((int)blockIdx.x >= sb0) sb_phase(F.lds + F.wave * 8192, SBQ, SBK, SBV, OSB, ((int)blockIdx.x - sb0) * NWAVES + F.wave, (F.G - sb0) * NWAVES, F.lane);
        __syncthreads();
        if (sb0 > 0 && (int)blockIdx.x >= sb0) {
            sub_barrier(ctl + CW_SUB, (unsigned)(F.G - sb0), ctl + CW_SUB + 64);
            pg8::Gemm g{OSB, (const bf16_t*)(ws + WS_WSB), T, 1024, 512}; pg8::StaticOrder S; S.init(T, 1024, F.G - sb0, (int)blockIdx.x - sb0);
            pg8::EpiMerge<false> E{(const bf16_t*)(ws + WS_GSB), MG};
            pg8::gemm_phase<pg8::EpiMerge<false>, pg8::StaticOrder, true, true>(F.lds, g, S, E);
        }
    }
    SEAM(3);
    if (IN(4)) {
        { pg8::Gemm g{(const bf16_t*)(ws + WS_MN), (const bf16_t*)(ws + WS_WCKV), 1024, 2048, 1024}; pg8::StaticOrder S; S.init(1024, 2048, F.G, (int)blockIdx.x);
          pg8::EpiSplit E{(bf16_t*)(ws + WS_KC), (bf16_t*)(ws + WS_VC), 1024, 4};
          pg8::gemm_phase<pg8::EpiSplit, pg8::StaticOrder, true, true>(F.lds, g, S, E); }
        gdn_finish_phase(F, args, Gb, (const bf16_t*)(ws + WS_GZ), (bf16_t*)(ws + WS_OG)); }
    SEAM(4);
    if (IN(5)) {
        if (!(F.G > 64)) { pg8::Gemm g{OSB, (const bf16_t*)(ws + WS_WSB), T, 1024, 512}; pg8::StaticOrder S; S.init(T, 1024, F.G, (int)blockIdx.x);
          pg8::EpiMerge<false> E{(const bf16_t*)(ws + WS_GSB), MG};
          pg8::gemm_phase<pg8::EpiMerge<false>, pg8::StaticOrder, true, true>(F.lds, g, S, E);
          xcd_barrier(bar); }
        { pg8::Gemm g{(const bf16_t*)(ws + WS_OG), (const bf16_t*)(ws + WS_WGDN), T, 1024, 512}; pg8::StaticOrder S; S.init(T, 1024, F.G, (int)blockIdx.x);
          pg8::EpiMerge<true> E{(const bf16_t*)(ws + WS_GGDN), MG};
          pg8::gemm_phase<pg8::EpiMerge<true>, pg8::StaticOrder, true, true>(F.lds, g, S, E); }
    }
    SEAM(5);
    if (IN(6)) {
        pg8::Gemm g{MG, (const bf16_t*)(ws + WS_WMIX), T, 1024, 1024}; pg8::StaticOrder S; S.init(T, 1024, F.G, (int)blockIdx.x);
        pg8::EpiRes<true> E{args.x, nullptr, A1, (float*)(ws + WS_SS)};
        pg8::gemm_phase<pg8::EpiRes<true>, pg8::StaticOrder, true, true>(F.lds, g, S, E);
    }
    SEAM(6);
    if (IN(7)) {
        rstd_rows_for_units(F, 1024, (const float*)(ws + WS_SS), (float*)(ws + WS_RSTD0));
        pg8::Gemm g{A1, (const bf16_t*)(ws + WS_WCQ), T, 1024, 1024}; pg8::StaticOrder S; S.init(T, 1024, F.G, (int)blockIdx.x);
        pg8::EpiScale E{(const float*)(ws + WS_RSTD0), (bf16_t*)(ws + WS_GSB), 1024};
        pg8::gemm_phase<pg8::EpiScale, pg8::StaticOrder, true, true>(F.lds, g, S, E);
        asm volatile("s_waitcnt vmcnt(0)" ::: "memory"); __syncthreads();
        pg8::StaticOrder S2; S2.init(T, 1024, F.G, (int)blockIdx.x); pg8::Unit u;
        for (int i = 0; S2.next(i, u); ++i) cross_item(F, (const bf16_t*)(ws + WS_GSB), (const bf16_t*)(ws + WS_KC), (const bf16_t*)(ws + WS_VC), (bf16_t*)(ws + WS_GGDN), (u.pm >> 5) * 4 + u.pn, u.pm & 31);
    }
    SEAM(7);
    if (IN(9)) {
        pg8::Gemm g{(const bf16_t*)(ws + WS_GGDN), (const bf16_t*)(ws + WS_WCO), T, 1024, 1024}; pg8::StaticOrder S; S.init(T, 1024, F.G, (int)blockIdx.x);
        pg8::EpiRes<false> E{nullptr, A1, A0, (float*)(ws + WS_SS)};
        pg8::gemm_phase<pg8::EpiRes<false>, pg8::StaticOrder, true, true>(F.lds, g, S, E);
    }
    SEAM(9);
    if (IN(10)) {
        rstd_rows_for_units(F, 2048, (const float*)(ws + WS_SS), (float*)(ws + WS_RSTD2));
        pg8::Gemm g{A0, (const bf16_t*)(ws + WS_WPQ), T, 2048, 1024}; pg8::StaticOrder S; S.init(T, 2048, F.G, (int)blockIdx.x);
        pg8::EpiScale E{(const float*)(ws + WS_RSTD2), A1, 2048};
        pg8::gemm_phase<pg8::EpiScale, pg8::StaticOrder, true, true>(F.lds, g, S, E);
        asm volatile("s_waitcnt vmcnt(0)" ::: "memory"); __syncthreads();
        pg8::StaticOrder S2; S2.init(T, 2048, F.G, (int)blockIdx.x); pg8::Unit u;
        for (int i = 0; S2.next(i, u); ++i) peer_route_task(F, A1, (const bf16_t*)(ws + WS_SKB), (int*)(ws + 296 * MiB), (float*)(ws + 312 * MiB), u.pm * 8 + F.wave, u.pn);
        __syncthreads();
    }
    SEAM(10);
    if (IN(12)) { peer_u_phase(F, args, ctl, A0, (const float*)(ws + WS_RSTD2), (const int*)(ws + 296 * MiB), (const unsigned char*)(ws + WS_U8), (bf16_t*)(ws + WS_PART)); }
    SEAM(12);
    if (IN(13)) { peer_combine_phase(F, (const bf16_t*)(ws + WS_PART), (const int*)(ws + 296 * MiB), (const float*)(ws + 312 * MiB), (const float*)(ws + WS_SUV), (const float*)(ws + WS_SUV) + 16384, (float*)(ws + 328 * MiB)); }
    SEAM(13);
    if (IN(14)) { peer_v_phase(F, ctl, (const int*)(ws + 296 * MiB), (const float*)(ws + 328 * MiB), (const unsigned char*)(ws + WS_V8), A0, A1, (float*)(ws + WS_SS)); }
    SEAM(14);
    if (IN(15)) { peer_norm_phase(F, args, (const float*)(ws + WS_SS), A1, args.out); }
#undef IN
#undef SEAM
}
extern "C" void kernel_launch(void* const* d_in, const int* in_sizes, int n_in, void* d_out, int out_size, void* d_ws, size_t ws_size, hipStream_t stream) {
    static int grid = 0;
    if (grid == 0) {
        if (n_in != 22 || ws_size < WS_END || out_size != T * D) { fprintf(stderr, "kernel_launch: unexpected n_in %d / ws %zu / out %d\n", n_in, ws_size, out_size); grid = -1; return; }
        int dev = 0, cus = 0, per_cu = 0;
        if (hipGetDevice(&dev) != hipSuccess || hipDeviceGetAttribute(&cus, hipDeviceAttributeMultiprocessorCount, dev) != hipSuccess) { grid = -1; return; }
        if (hipFuncSetAttribute((const void*)mk_fwd, hipFuncAttributeMaxDynamicSharedMemorySize, LDS_BYTES) != hipSuccess) { fprintf(stderr, "kernel_launch: hipFuncSetAttribute failed\n"); grid = -1; return; }
        if (hipOccupancyMaxActiveBlocksPerMultiprocessor(&per_cu, (const void*)mk_fwd, NWAVES * 64, LDS_BYTES) != hipSuccess || per_cu < 1) { fprintf(stderr, "kernel_launch: occupancy query says %d\n", per_cu); per_cu = 1; }
        (void)hipGetLastError();
        grid = cus;
    }
    if (grid < 0) return;
    hipMemsetAsync((char*)d_ws + WS_CTL, 0, CTL_ZERO_BYTES, stream);
    Args a{};
    const float** ap = (const float**)&a;
    for (int i = 0; i < 22; ++i) ap[i] = (const float*)d_in[i];
    a.out = (float*)d_out; a.ws = (unsigned char*)d_ws;
    char* ws = (char*)d_ws; float* out = (float*)d_out;
    float* rstd2 = (float*)(ws + WS_RSTD2);
    bf16_t* KC = (bf16_t*)(ws + WS_KC); bf16_t* VC = (bf16_t*)(ws + WS_VC);
    bf16_t* PQ = (bf16_t*)(ws + WS_A1); bf16_t* QC = (bf16_t*)(ws + WS_GSB); bf16_t* OC = (bf16_t*)(ws + WS_GGDN);
    int* EIDX = (int*)(ws + 296 * MiB); float* EGATE = (float*)(ws + 312 * MiB);
#define MK(lo, hi, reg) do { a.ph_lo = (lo); a.ph_hi = (hi); a.bar_region = (reg); hipLaunchKernelGGL(mk_fwd, dim3(grid), dim3(NWAVES * 64), LDS_BYTES, stream, a); } while (0)
    MK(0, 16, 0);
#undef MK
}
```

```cpp
#include <hip/hip_runtime.h>
#include <stdint.h>
#include <cstdio>

typedef unsigned short bf16_t;
__device__ __forceinline__ float bf2f(bf16_t v) { return __uint_as_float(((unsigned)v) << 16); }
__device__ __forceinline__ bf16_t f2bf(float f) { unsigned u = __float_as_uint(f); return (bf16_t)((u + 0x7fffu + ((u >> 16) & 1u)) >> 16); }

constexpr int T = 32768, D = 1024, SEQ = 8192, NB = 4;
constexpr int IN_COLS = 5640, NPROJ = 5632;
constexpr float EPS = 1e-6f;
constexpr size_t MiB = 1u << 20;

__device__ __forceinline__ float wave_sum(float v) {
#pragma unroll
    for (int o = 1; o < 64; o <<= 1) v += __shfl_xor(v, o);
    return v;
}
__device__ __forceinline__ float sigmoidf_(float x) { return 1.f / (1.f + __expf(-x)); }
__device__ __forceinline__ float softplusf_(float x) { return fmaxf(x, 0.f) + log1pf(__expf(-fabsf(x))); }

namespace pg8 {
#define PG8_LAS __attribute__((address_space(3)))
typedef unsigned short bf16_t;
typedef short bf16x8 __attribute__((ext_vector_type(8)));
typedef float f32x4 __attribute__((ext_vector_type(4)));
typedef unsigned u32x4 __attribute__((ext_vector_type(4)));
constexpr int BM = 256, BK = 64, HALF = 128, HTB = HALF * BK * 2  , STAGE_BYTES = 8 * HTB, NXCD = 8, WGM = 8;

__host__ __device__ __forceinline__ int lds_byte(int r, int c) { const int st = (r >> 4) * 2 + (c >> 5), rr = r & 15, cc = c & 31, ob = rr * 64 + cc * 2; return st * 1024 + (ob ^ (((ob >> 9) & 1) << 5)); }
__host__ __device__ __forceinline__ void stage_rc(int b, int& R, int& C) { const int st = b / 1024, sb = b % 1024, swz = sb ^ (((sb >> 9) & 1) << 5); R = (st >> 1) * 16 + swz / 64; C = (st & 1) * 32 + (swz % 64) / 2; }
__host__ __device__ __forceinline__ int perm32(int rho) { const int n = rho >> 4, i = rho & 15; return 8 * (i >> 2) + 4 * n + (i & 3); }

struct Unit { int pm, pn; };
struct Gemm { const bf16_t* A; const bf16_t* Bt; int M, N, K; };

struct StaticOrder {
    int nM, nN, nwg, G, c;
    __host__ __device__ __forceinline__ void init(int M, int N, int G_, int c_) { nM = M / BM; nN = N / BM; nwg = nM * nN; G = G_; c = c_; }
    __host__ __device__ __forceinline__ bool next(int i, Unit& u) const {
        const long L = (long)i * G + c; if (L >= nwg) return false;
        int wgid = (int)L; { const int q = nwg / NXCD, r = nwg % NXCD, xcd = wgid % NXCD, off = wgid / NXCD; wgid = (xcd < r ? xcd * (q + 1) : r * (q + 1) + (xcd - r) * q) + off; }
        const int nig = WGM * nN, gid = wgid / nig, fm = gid * WGM, gsz = (nM - fm) < WGM ? (nM - fm) : WGM;
        u.pm = fm + ((wgid % nig) % gsz); u.pn = (wgid % nig) / gsz; return true;
    }
    __device__ __forceinline__ void a_ready(const Unit&) const {}
    __device__ __forceinline__ void done(const Unit&) const {}
};

__device__ __forceinline__ unsigned cvt_pk_bf16(float lo, float hi) { unsigned r; asm volatile("v_cvt_pk_bf16_f32 %0, %1, %2" : "=v"(r) : "v"(lo), "v"(hi)); return r; }
typedef float f32x2 __attribute__((ext_vector_type(2)));
__device__ __forceinline__ float bfl(unsigned w) { return __uint_as_float(w << 16); }
__device__ __forceinline__ float bfh(unsigned w) { return __uint_as_float(w & 0xffff0000u); }
constexpr int EPI_STAGE_OFF = 131072 + 1024;
__device__ __forceinline__ void stage_store16x64(int wid, int fr, int fq, u32x4 w0, u32x4 w1, bf16_t* rowbase  , size_t ld) {
    PG8_LAS unsigned char* sl = (PG8_LAS unsigned char*)(EPI_STAGE_OFF + wid * 2048);
    *(PG8_LAS u32x4*)(sl + fr * 128 + ((fq ^ (fr & 7)) << 4)) = w0;
    *(PG8_LAS u32x4*)(sl + fr * 128 + (((4 + fq) ^ (fr & 7)) << 4)) = w1;
    const int lane = fr + 16 * fq, r0 = lane >> 3, c = lane & 7;
    const u32x4 a = *(const PG8_LAS u32x4*)(sl + r0 * 128 + ((c ^ r0) << 4));
    const u32x4 b = *(const PG8_LAS u32x4*)(sl + (r0 + 8) * 128 + ((c ^ r0) << 4));
    *(u32x4*)(rowbase + (size_t)r0 * ld + c * 8) = a;
    *(u32x4*)(rowbase + (size_t)(r0 + 8) * ld + c * 8) = b;
}
__device__ __forceinline__ u32x4 pack8(const f32x4& v0, const f32x4& v1) { u32x4 w; w.x = cvt_pk_bf16(v0[0], v0[1]); w.y = cvt_pk_bf16(v0[2], v0[3]); w.z = cvt_pk_bf16(v1[0], v1[1]); w.w = cvt_pk_bf16(v1[2], v1[3]); return w; }

struct EpiProj {
    static constexpr bool PERM = true, AFTER_DRAIN = false, COL64 = true;
    const float* rstd; bf16_t *SBQ, *SBK, *SBV, *GQKV, *GZ, *GSB, *GGDN;
    __device__ __forceinline__ void operator()(const f32x4 (&acc)[2][2][4][2], const Unit& u, int wr, int wc, int fr_in, int fq_in) const {
        int lane_ = fr_in + 16 * fq_in; asm volatile("" : "+v"(lane_));
        const int fr = lane_ & 15, fq = lane_ >> 4;
        const int pn = u.pn; bf16_t* base; int ld, coff;
        if (pn < 2) { base = SBQ; ld = 512; coff = pn * 256; } else if (pn < 4) { base = SBK; ld = 512; coff = (pn - 2) * 256; } else if (pn < 6) { base = SBV; ld = 512; coff = (pn - 4) * 256; }
        else if (pn < 12) { base = GQKV; ld = 1536; coff = (pn - 6) * 256; } else if (pn < 14) { base = GZ; ld = 512; coff = (pn - 12) * 256; }
        else if (pn < 18) { base = GSB; ld = 1024; coff = (pn - 14) * 256; } else { base = GGDN; ld = 1024; coff = (pn - 18) * 256; }
        const int row0 = u.pm * BM + wr * 64, wid = wr * 4 + wc;
        float rsv[2][4];
#pragma unroll
        for (int ai = 0; ai < 2; ++ai)
#pragma unroll
            for (int m = 0; m < 4; ++m) rsv[ai][m] = rstd[row0 + ai * HALF + m * 16 + fr];
#pragma unroll
        for (int ai = 0; ai < 2; ++ai)
#pragma unroll
            for (int m = 0; m < 4; ++m) { const int rg = row0 + ai * HALF + m * 16; const float rs = rsv[ai][m];
                stage_store16x64(wid, fr, fq, pack8(acc[ai][0][m][0] * rs, acc[ai][0][m][1] * rs), pack8(acc[ai][1][m][0] * rs, acc[ai][1][m][1] * rs), base + (size_t)rg * ld + coff + wc * 64, ld); }
    }
};
struct EpiSplit {
    static constexpr bool PERM = true, AFTER_DRAIN = false, COL64 = true;
    bf16_t *O0, *O1; int ldc, split_tiles;
    __device__ __forceinline__ void operator()(const f32x4 (&acc)[2][2][4][2], const Unit& u, int wr, int wc, int fr_in, int fq_in) const {
        int lane_ = fr_in + 16 * fq_in; asm volatile("" : "+v"(lane_));
        const int fr = lane_ & 15, fq = lane_ >> 4;
        bf16_t* base = u.pn < split_tiles ? O0 : O1; const int coff = (u.pn < split_tiles ? u.pn : u.pn - split_tiles) * 256;
        const int row0 = u.pm * BM + wr * 64, wid = wr * 4 + wc;
#pragma unroll
        for (int ai = 0; ai < 2; ++ai)
#pragma unroll
            for (int m = 0; m < 4; ++m) { const int rg = row0 + ai * HALF + m * 16;
                stage_store16x64(wid, fr, fq, pack8(acc[ai][0][m][0], acc[ai][0][m][1]), pack8(acc[ai][1][m][0], acc[ai][1][m][1]), base + (size_t)rg * ldc + coff + wc * 64, ldc); }
    }
};
template <bool ADD> struct EpiMerge {
    static constexpr bool PERM = true, AFTER_DRAIN = false, COL64 = true;
    const bf16_t* gate; bf16_t* M;
    __device__ __forceinline__ void operator()(const f32x4 (&acc)[2][2][4][2], const Unit& u, int wr, int wc, int fr_in, int fq_in) const {
        int lane_ = fr_in + 16 * fq_in; asm volatile("" : "+v"(lane_));
        const int fr = lane_ & 15, fq = lane_ >> 4;
        const int row0 = u.pm * BM + wr * 64, col0 = u.pn * BM + wc * 64, wid = wr * 4 + wc;
#pragma unroll
        for (int ab = 0; ab < 4; ++ab) { const int ai = ab >> 1, mb = (ab & 1) * 2;
            u32x4 gl[4][2], pl[4][2];
#pragma unroll
            for (int m = mb; m < mb + 2; ++m)
#pragma unroll
                for (int bj = 0; bj < 2; ++bj) { const size_t o = (size_t)(row0 + ai * HALF + m * 16 + fr) * 1024 + col0 + 8 * fq + bj * 32; gl[m][bj] = *(const u32x4*)(gate + o); if (ADD) pl[m][bj] = *(const u32x4*)(M + o); }
#pragma unroll
            for (int m = mb; m < mb + 2; ++m) { const int rg = row0 + ai * HALF + m * 16;
                u32x4 wv[2];
#pragma unroll
                for (int bj = 0; bj < 2; ++bj) { const u32x4 g = gl[m][bj];
                    float gv[8] = {bfl(g.x), bfh(g.x), bfl(g.y), bfh(g.y), bfl(g.z), bfh(g.z), bfl(g.w), bfh(g.w)};
                    float pv[8] = {0.f, 0.f, 0.f, 0.f, 0.f, 0.f, 0.f, 0.f};
                    if (ADD) { const u32x4 p = pl[m][bj]; pv[0] = bfl(p.x); pv[1] = bfh(p.x); pv[2] = bfl(p.y); pv[3] = bfh(p.y); pv[4] = bfl(p.z); pv[5] = bfh(p.z); pv[6] = bfl(p.w); pv[7] = bfh(p.w); }
                    float r[8];
#pragma unroll
                    for (int j = 0; j < 8; ++j) { const float a = j < 4 ? acc[ai][bj][m][0][j] : acc[ai][bj][m][1][j - 4]; r[j] = pv[j] + a * __builtin_amdgcn_rcpf(1.f + __expf(-gv[j])); }
                    wv[bj].x = cvt_pk_bf16(r[0], r[1]); wv[bj].y = cvt_pk_bf16(r[2], r[3]); wv[bj].z = cvt_pk_bf16(r[4], r[5]); wv[bj].w = cvt_pk_bf16(r[6], r[7]); }
                stage_store16x64(wid, fr, fq, wv[0], wv[1], M + (size_t)rg * 1024 + col0, 1024); }
        }
    }
};
template <bool IN_F32> struct EpiRes {
    static constexpr bool PERM = true, AFTER_DRAIN = false, COL64 = true;
    const float* xin_f; const bf16_t* xin_b; bf16_t* xb; float* SS;
    __device__ __forceinline__ void operator()(const f32x4 (&acc)[2][2][4][2], const Unit& u, int wr, int wc, int fr_in, int fq_in) const {
        int lane_ = fr_in + 16 * fq_in; asm volatile("" : "+v"(lane_));
        const int fr = lane_ & 15, fq = lane_ >> 4;
        const int row0 = u.pm * BM + wr * 64, col0 = u.pn * BM + wc * 64, wid = wr * 4 + wc;
#pragma unroll
        for (int ab = 0; ab < 4; ++ab) { const int ai = ab >> 1, mb = (ab & 1) * 2;
            f32x4 xl[4][2][2];
#pragma unroll
            for (int m = mb; m < mb + 2; ++m)
#pragma unroll
                for (int bj = 0; bj < 2; ++bj) { const size_t o = (size_t)(row0 + ai * HALF + m * 16 + fr) * 1024 + col0 + 8 * fq + bj * 32;
                    if (IN_F32) { xl[m][bj][0] = *(const f32x4*)(xin_f + o); xl[m][bj][1] = *(const f32x4*)(xin_f + o + 4); }
                    else { const u32x4 p = *(const u32x4*)(xin_b + o); xl[m][bj][0] = (f32x4){bfl(p.x), bfh(p.x), bfl(p.y), bfh(p.y)}; xl[m][bj][1] = (f32x4){bfl(p.z), bfh(p.z), bfl(p.w), bfh(p.w)}; } }
            float sv[4];
#pragma unroll
            for (int m = mb; m < mb + 2; ++m) { const int rg = row0 + ai * HALF + m * 16; float s = 0.f;
                u32x4 wv[2];
#pragma unroll
                for (int bj = 0; bj < 2; ++bj) { const u32x4 w = pack8(xl[m][bj][0] + acc[ai][bj][m][0], xl[m][bj][1] + acc[ai][bj][m][1]); wv[bj] = w;
                    const float r0 = bfl(w.x), r1 = bfh(w.x), r2 = bfl(w.y), r3 = bfh(w.y), r4 = bfl(w.z), r5 = bfh(w.z), r6 = bfl(w.w), r7 = bfh(w.w);
                    s += (r0 * r0 + r1 * r1) + (r2 * r2 + r3 * r3) + (r4 * r4 + r5 * r5) + (r6 * r6 + r7 * r7); }
                stage_store16x64(wid, fr, fq, wv[0], wv[1], xb + (size_t)rg * 1024 + col0, 1024);
                s += __shfl_xor(s, 16); s += __shfl_xor(s, 32); sv[m] = s; }
#pragma unroll
            for (int m = mb; m < mb + 2; ++m) if (fq == 0) SS[(size_t)(row0 + ai * HALF + m * 16 + fr) * 16 + u.pn * 4 + wc] = sv[m];
        }
    }
};
struct EpiScale {
    static constexpr bool PERM = true, AFTER_DRAIN = false, COL64 = true;
    const float* rstd; bf16_t* O; int ldc;
    __device__ __forceinline__ void operator()(const f32x4 (&acc)[2][2][4][2], const Unit& u, int wr, int wc, int fr_in, int fq_in) const {
        int lane_ = fr_in + 16 * fq_in; asm volatile("" : "+v"(lane_));
        const int fr = lane_ & 15, fq = lane_ >> 4;
        const int row0 = u.pm * BM + wr * 64, col0 = u.pn * BM + wc * 64, wid = wr * 4 + wc;
        float rsv[2][4];
#pragma unroll
        for (int ai = 0; ai < 2; ++ai)
#pragma unroll
            for (int m = 0; m < 4; ++m) rsv[ai][m] = rstd[row0 + ai * HALF + m * 16 + fr];
#pragma unroll
        for (int ai = 0; ai < 2; ++ai)
#pragma unroll
            for (int m = 0; m < 4; ++m) { const int rg = row0 + ai * HALF + m * 16; const float rs = rsv[ai][m];
                stage_store16x64(wid, fr, fq, pack8(acc[ai][0][m][0] * rs, acc[ai][0][m][1] * rs), pack8(acc[ai][1][m][0] * rs, acc[ai][1][m][1] * rs), O + (size_t)rg * ldc + col0, ldc); }
    }
};
template <class Epi, class Sched, bool ALIGN_EPI = false, bool SP2 = false>
__device__ __forceinline__ void gemm_phase(PG8_LAS unsigned char* lds, const Gemm g, const Sched& S, const Epi& E) {
    const int tid = threadIdx.x, wid = __builtin_amdgcn_readfirstlane(tid >> 6), lane = tid & 63, wr = wid >> 2, wc = wid & 3, fr = lane & 15, fq = lane >> 4;
    const int K = g.K, nt = K / BK;
    unsigned voffA[2], voffB[2];
#pragma unroll
    for (int i = 0; i < 2; ++i) { int R, C; stage_rc(tid * 16 + i * 8192, R, C); const int Rb = Epi::PERM ? ((Epi::COL64 ? 2 * (R & ~31) : (R & ~31)) + perm32(R & 31)) : R;
        voffA[i] = (unsigned)(R * K + C) * 2u; voffB[i] = (unsigned)(Rb * K + C) * 2u; }
    const size_t kstep = (size_t)(BK * 2);
    const size_t hstep = (size_t)HALF * K * 2;
    const size_t bhstep = Epi::COL64 ? (size_t)32 * K * 2 : hstep;
    const size_t tstep = 2 * hstep;
    const unsigned ldsw = (unsigned)wid * 1024u;
    const int aoff = lds_byte(wr * 64 + fr, fq * 8), boff = lds_byte(wc * 32 + fr, fq * 8);
#define PG8_SA(b, h) (((b) * 2 + (h)) * HTB)
#define PG8_SB(b, h) ((4 + (b) * 2 + (h)) * HTB)
#define PG8_STAGE(bufoff, gbase, voff) do { _Pragma("unroll") for (int _i = 0; _i < 2; ++_i) \
        __builtin_amdgcn_global_load_lds((const unsigned*)((const char*)(gbase) + (voff)[_i]), (PG8_LAS unsigned*)(lds + (bufoff) + ldsw + _i * 8192), 16, 0, 0); } while (0)
#define PG8_LDA(dst, b, h) do { _Pragma("unroll") for (int m = 0; m < 4; ++m) _Pragma("unroll") for (int k = 0; k < 2; ++k) dst[m][k] = *(const PG8_LAS bf16x8*)(lds + PG8_SA(b, h) + aoff + m * 2048 + k * 1024); } while (0)
#define PG8_LDB(dst, b, h) do { _Pragma("unroll") for (int n = 0; n < 2; ++n) _Pragma("unroll") for (int k = 0; k < 2; ++k) dst[n][k] = *(const PG8_LAS bf16x8*)(lds + PG8_SB(b, h) + boff + n * 2048 + k * 1024); } while (0)
#define PG8_MMA(ai, bj, At, Bt) do { __builtin_amdgcn_s_setprio(1); _Pragma("unroll") for (int m = 0; m < 4; ++m) _Pragma("unroll") for (int n = 0; n < 2; ++n) _Pragma("unroll") for (int k = 0; k < 2; ++k) \
        acc[ai][bj][m][n] = __builtin_amdgcn_mfma_f32_16x16x32_bf16(Bt[n][k], At[m][k], acc[ai][bj][m][n], 0, 0, 0); __builtin_amdgcn_s_setprio(0); } while (0)
#define PG8_WAIT_V(n) asm volatile("s_waitcnt vmcnt(" #n ")" ::: "memory")
#define PG8_WAIT_L(n) asm volatile("s_waitcnt lgkmcnt(" #n ")" ::: "memory")
#define PG8_BAR __builtin_amdgcn_s_barrier()
#define PG8_SCHED __builtin_amdgcn_sched_barrier(0)
    Unit cur, nxt; int ui = 0;
    if (!S.next(0, cur)) return;
    f32x4 acc[2][2][4][2];
#pragma unroll
    for (int a = 0; a < 2; ++a)
#pragma unroll
        for (int b = 0; b < 2; ++b)
#pragma unroll
            for (int m = 0; m < 4; ++m)
#pragma unroll
                for (int n = 0; n < 2; ++n) acc[a][b][m][n] = (f32x4){0.f, 0.f, 0.f, 0.f};
    bf16x8 At[4][2], B0[2][2], B1[2][2];
    const char* cA = (const char*)g.A + (size_t)cur.pm * tstep; const char* cB = (const char*)g.Bt + (size_t)cur.pn * tstep;
    S.a_ready(cur);
    if constexpr (SP2) {
        PG8_STAGE(PG8_SB(0, 0), cB, voffB); PG8_STAGE(PG8_SB(0, 1), cB + bhstep, voffB); PG8_STAGE(PG8_SA(0, 0), cA, voffA); PG8_STAGE(PG8_SA(0, 1), cA + hstep, voffA);
        if (wr == 1) PG8_BAR;
        PG8_WAIT_V(2); PG8_BAR;
        PG8_STAGE(PG8_SB(1, 0), cB + kstep, voffB); PG8_STAGE(PG8_SA(1, 0), cA + kstep, voffA); PG8_STAGE(PG8_SB(1, 1), cB + bhstep + kstep, voffB);
        PG8_WAIT_V(6); PG8_BAR;
    } else {
        PG8_STAGE(PG8_SB(0, 0), cB, voffB); PG8_STAGE(PG8_SA(0, 0), cA, voffA); PG8_STAGE(PG8_SB(0, 1), cB + bhstep, voffB); PG8_STAGE(PG8_SA(0, 1), cA + hstep, voffA);
        if (wr == 1) PG8_BAR;
        PG8_WAIT_V(4); PG8_BAR;
        PG8_STAGE(PG8_SB(1, 0), cB + kstep, voffB); PG8_STAGE(PG8_SA(1, 0), cA + kstep, voffA); PG8_STAGE(PG8_SB(1, 1), cB + bhstep + kstep, voffB);
        PG8_WAIT_V(6); PG8_BAR;
    }
    for (;;) {
        const bool has_next = S.next(ui + 1, nxt);
        const char* nA = has_next ? (const char*)g.A + (size_t)nxt.pm * tstep : cA; const char* nB = has_next ? (const char*)g.Bt + (size_t)nxt.pn * tstep : cB;
        for (int t = 0; t < nt; t += 2) {
            const bool last = (t == nt - 2);
            const char* a1 = cA + (size_t)(t + 1) * kstep;
            const char* a2 = last ? nA : cA + (size_t)(t + 2) * kstep; const char* b2 = last ? nB : cB + (size_t)(t + 2) * kstep;
            const char* a3 = a2 + kstep; const char* b3 = b2 + kstep;
            if (last && has_next) S.a_ready(nxt);
            if constexpr (SP2) {
            PG8_LDB(B0, 0, 0); PG8_LDB(B1, 0, 1); PG8_SCHED; PG8_LDA(At, 0, 0); PG8_STAGE(PG8_SA(1, 1), a1 + hstep, voffA);
            PG8_WAIT_V(8); PG8_WAIT_L(0); PG8_BAR; PG8_MMA(0, 0, At, B0); PG8_MMA(0, 1, At, B1); PG8_BAR; PG8_SCHED;
            PG8_LDA(At, 0, 1); PG8_STAGE(PG8_SB(0, 0), b2, voffB); PG8_STAGE(PG8_SB(0, 1), b2 + bhstep, voffB); PG8_STAGE(PG8_SA(0, 0), a2, voffA);
            PG8_WAIT_V(8); PG8_WAIT_L(0); PG8_BAR; PG8_MMA(1, 0, At, B0); PG8_MMA(1, 1, At, B1); PG8_BAR; PG8_SCHED;
            PG8_LDB(B0, 1, 0); PG8_LDB(B1, 1, 1); PG8_SCHED; PG8_LDA(At, 1, 0); PG8_STAGE(PG8_SA(0, 1), a2 + hstep, voffA);
            PG8_WAIT_V(8); PG8_WAIT_L(0); PG8_BAR; PG8_MMA(0, 0, At, B0); PG8_MMA(0, 1, At, B1); PG8_BAR; PG8_SCHED;
            PG8_LDA(At, 1, 1); PG8_STAGE(PG8_SB(1, 0), b3, voffB); PG8_STAGE(PG8_SB(1, 1), b3 + bhstep, voffB); PG8_STAGE(PG8_SA(1, 0), a3, voffA);
            PG8_WAIT_V(8); PG8_WAIT_L(0); PG8_BAR; PG8_MMA(1, 0, At, B0); PG8_MMA(1, 1, At, B1); PG8_BAR; PG8_SCHED;
            } else {
            PG8_LDB(B0, 0, 0); PG8_SCHED; PG8_LDA(At, 0, 0); PG8_STAGE(PG8_SA(1, 1), a1 + hstep, voffA);
            PG8_WAIT_L(8); PG8_BAR; PG8_WAIT_L(0); PG8_MMA(0, 0, At, B0); PG8_BAR; PG8_SCHED;
            PG8_LDB(B1, 0, 1); PG8_STAGE(PG8_SB(0, 0), b2, voffB);
            PG8_BAR; PG8_WAIT_L(0); PG8_MMA(0, 1, At, B1); PG8_BAR;
            PG8_LDA(At, 0, 1); PG8_STAGE(PG8_SA(0, 0), a2, voffA);
            PG8_BAR; PG8_WAIT_L(0); PG8_MMA(1, 0, At, B0); PG8_BAR; PG8_SCHED;
            PG8_STAGE(PG8_SB(0, 1), b2 + bhstep, voffB);
            PG8_WAIT_V(6); PG8_BAR; PG8_MMA(1, 1, At, B1); PG8_BAR;
            PG8_LDB(B0, 1, 0); PG8_SCHED; PG8_LDA(At, 1, 0); PG8_STAGE(PG8_SA(0, 1), a2 + hstep, voffA);
            PG8_WAIT_L(8); PG8_BAR; PG8_WAIT_L(0); PG8_MMA(0, 0, At, B0); PG8_BAR; PG8_SCHED;
            PG8_LDB(B1, 1, 1); PG8_STAGE(PG8_SB(1, 0), b3, voffB);
            PG8_BAR; PG8_WAIT_L(0); PG8_MMA(0, 1, At, B1); PG8_BAR;
            PG8_LDA(At, 1, 1); PG8_STAGE(PG8_SA(1, 0), a3, voffA);
            PG8_BAR; PG8_WAIT_L(0); PG8_MMA(1, 0, At, B0); PG8_BAR; PG8_SCHED;
            PG8_STAGE(PG8_SB(1, 1), b3 + bhstep, voffB);
            PG8_WAIT_V(6); PG8_BAR; PG8_MMA(1, 1, At, B1); PG8_BAR;
            }
        }
        if constexpr (ALIGN_EPI) { if (wr == 0) PG8_BAR; }
        if constexpr (!Epi::AFTER_DRAIN) { E(acc, cur, wr, wc, fr, fq); S.done(cur); }
        if (!has_next) break;
#pragma unroll
        for (int a = 0; a < 2; ++a)
#pragma unroll
            for (int b = 0; b < 2; ++b)
#pragma unroll
                for (int m = 0; m < 4; ++m)
#pragma unroll
                    for (int n = 0; n < 2; ++n) acc[a][b][m][n] = (f32x4){0.f, 0.f, 0.f, 0.f};
        cur = nxt; cA = nA; cB = nB; ++ui;
        if constexpr (ALIGN_EPI) { if (wr == 1) PG8_BAR; }
    }
    PG8_WAIT_V(0);
    if constexpr (!ALIGN_EPI) { if (wr == 0) PG8_BAR; }
    PG8_BAR;
    if constexpr (Epi::AFTER_DRAIN) { E.fused(acc, cur, wr, wc, fr, fq, lds, wid, lane); S.done(cur); }
#undef PG8_SA
#undef PG8_SB
#undef PG8_STAGE
#undef PG8_LDA
#undef PG8_LDB
#undef PG8_MMA
#undef PG8_WAIT_V
#undef PG8_WAIT_L
#undef PG8_BAR
#undef PG8_SCHED
}
}
#define GAS __attribute__((address_space(1)))
#define LAS __attribute__((address_space(3)))
typedef unsigned short bf16;
typedef unsigned v4u __attribute__((ext_vector_type(4)));
typedef float f32x4 __attribute__((ext_vector_type(4)));
typedef short bf16x8 __attribute__((ext_vector_type(8)));
typedef GAS unsigned gu32;
typedef GAS unsigned long long gu64;
#define RLX_AGENT __ATOMIC_RELAXED, __HIP_MEMORY_SCOPE_AGENT
#define LDS_WAIT() asm volatile("s_waitcnt lgkmcnt(0)" ::: "memory")
#define VM_WAIT() asm volatile("s_waitcnt vmcnt(0)" ::: "memory")
__device__ __forceinline__ unsigned long long rt() { return __builtin_amdgcn_s_memrealtime(); }
__device__ __forceinline__ unsigned pk2(float lo, float hi) { return (unsigned)f2bf(lo) | ((unsigned)f2bf(hi) << 16); }

#define XB_TMO      128
#define XB_XCNT(j)  (256  + 64 * (j))
#define XB_XSUB(j)  (1280 + 64 * (j))
#define XB_XGEN(j)  (2304 + 64 * (j))
#define XB_TOP      3328
#define XB_TOPGEN   3392
#define XCD_BAR_WORDS 3456
#define XB_SPIN_CAP (1u << 18)

__device__ __forceinline__ unsigned xb_ld(unsigned* p)              { return __hip_atomic_load(p, __ATOMIC_RELAXED, __HIP_MEMORY_SCOPE_AGENT); }
__device__ __forceinline__ unsigned xb_add(unsigned* p, unsigned v) { return __hip_atomic_fetch_add(p, v, __ATOMIC_RELAXED, __HIP_MEMORY_SCOPE_AGENT); }
__device__ __forceinline__ unsigned xb_xcc_id() { return (unsigned)__builtin_amdgcn_s_getreg((3 << 11) | 20) & 0xFu; }
#define XB_SPIN(cond, bar) do { unsigned _sp = 0; while (cond) { __builtin_amdgcn_s_sleep(1); \
    if ((++_sp & 255u) == 0u) { if (xb_ld(&(bar)[XB_TMO])) break; if (_sp > XB_SPIN_CAP) { atomicAdd(&(bar)[XB_TMO], 1u); break; } } } } while (0)

struct XcdBarrier {
    unsigned* bar; unsigned x;
    volatile LAS unsigned* st;
};

__device__ __forceinline__ XcdBarrier xcd_barrier_post(unsigned* bar, volatile LAS unsigned* st) {
    XcdBarrier b; b.bar = bar; b.x = xb_xcc_id(); b.st = st;
    if (threadIdx.x == 0) (void)xb_add(&bar[XB_XCNT(b.x)], 1u);
    return b;
}
__device__ __forceinline__ void xcd_barrier_complete(unsigned* bar, unsigned x, unsigned& nloc, unsigned& nx) {
    const unsigned G = gridDim.x * gridDim.y * gridDim.z;
    unsigned sum, cnt, mine, sp = 0u;
    for (;;) {
        sum = 0u; cnt = 0u; mine = 0u;
#pragma unroll
        for (unsigned j = 0; j < 16; ++j) { const unsigned c = xb_ld(&bar[XB_XCNT(j)]); sum += c; cnt += (c > 0u) ? 1u : 0u; mine = (j == x) ? c : mine; }
        if (sum == G) break;
        __builtin_amdgcn_s_sleep(1);
        if ((++sp & 255u) == 0u) { if (xb_ld(&bar[XB_TMO])) break; if (sp > XB_SPIN_CAP) { atomicAdd(&bar[XB_TMO], 1u); break; } }
    }
    nloc = mine > 0u ? mine : 1u; nx = cnt > 0u ? cnt : 1u;
}

__device__ __forceinline__ void xcd_barrier(const XcdBarrier& b) {
    asm volatile("s_waitcnt vmcnt(0)" ::: "memory");
    __syncthreads();
    if (threadIdx.x == 0) {
        unsigned* bar = b.bar;
        __builtin_amdgcn_s_waitcnt(0);
        unsigned nloc = b.st[0], nx = b.st[1];
        if (nloc == 0u) { xcd_barrier_complete(bar, b.x, nloc, nx); b.st[0] = nloc; b.st[1] = nx; }
        const unsigned old = xb_add(&bar[XB_XSUB(b.x)], 1u);
        const unsigned gen = old / nloc;
        if (old + 1u == (gen + 1u) * nloc) {
            __builtin_amdgcn_fence(__ATOMIC_RELEASE, "agent");
            asm volatile("s_waitcnt vmcnt(0)" ::: "memory");
            const unsigned og = xb_add(&bar[XB_TOP], 1u);
            const unsigned tg = og / nx;
            if (og + 1u == (tg + 1u) * nx) xb_add(&bar[XB_TOPGEN], 1u);
            else XB_SPIN(xb_ld(&bar[XB_TOPGEN]) == tg, bar);
            __builtin_amdgcn_fence(__ATOMIC_ACQUIRE, "agent");
            xb_add(&bar[XB_XGEN(b.x)], 1u);
            asm volatile("s_waitcnt vmcnt(0)" ::: "memory");
        } else {
            XB_SPIN(xb_ld(&bar[XB_XGEN(b.x)]) == gen, bar);
            __builtin_amdgcn_fence(__ATOMIC_ACQUIRE, "agent");
            asm volatile("s_waitcnt vmcnt(0)" ::: "memory");
        }
    }
    __syncthreads();
}
constexpr size_t KiB = 1024;
constexpr size_t WS_CTL = 0, CTL_ZERO_BYTES = 1 * MiB;
constexpr size_t WS_WIN = 1 * MiB, WS_WSB = 12 * MiB, WS_WGDN = 13 * MiB, WS_WMIX = 14 * MiB, WS_WCQ = 16 * MiB, WS_WCO = 18 * MiB, WS_WCKV = 20 * MiB, WS_WPQ = 24 * MiB, WS_SKB = 28 * MiB, WS_U16 = 30 * MiB, WS_V16 = 62 * MiB;
constexpr size_t WS_RSTD0 = 94 * MiB, WS_RSTD2 = 94 * MiB + 256 * KiB, WS_CD = 94 * MiB + 384 * KiB, WS_GB = 94 * MiB + 512 * KiB;
constexpr size_t WS_MN = 96 * MiB, WS_KC = 98 * MiB, WS_VC = 100 * MiB, WS_SS = 102 * MiB;
constexpr size_t WS_A0 = 104 * MiB;
constexpr size_t WS_NW = 104 * MiB, WS_QD = 136 * MiB;
constexpr size_t WS_A1 = 168 * MiB;
constexpr size_t WS_ORAW = 168 * MiB, WS_OSS = 200 * MiB, WS_OG = 232 * MiB;
constexpr size_t WS_GZ = 264 * MiB;
constexpr size_t WS_GSB = 296 * MiB, WS_GGDN = 360 * MiB;
constexpr size_t WS_KDT = 424 * MiB, WS_QK = 456 * MiB, WS_UT = 472 * MiB;
constexpr size_t WS_U8 = 30 * MiB, WS_V8 = 46 * MiB, WS_SUV = 62 * MiB;
constexpr size_t WS_PART = 344 * MiB;
constexpr size_t WS_END = 512 * MiB;
constexpr int CW_SUB = 12288;
constexpr int CW_BAR = 4096;

constexpr int NWAVES = 8;
constexpr int RING_BYTES = 131072, LDSCTL_OFF = RING_BYTES, MISC_OFF = LDSCTL_OFF + 320, LDS_BYTES = 149504;

struct Args {
    const float *x, *mem, *g_mix, *w_in, *gdn_conv, *a_log, *dt_bias, *gdn_norm_g, *w_sb_up, *w_gdn_up, *w_mix_out, *g_cross, *g_mem, *w_cq, *w_ckv, *w_co, *g_peer, *w_pq, *subkeys, *peer_u, *peer_v, *g_final;
    float* out; unsigned char* ws; int ph_lo, ph_hi, bar_region, pad;
};

struct Frame {
    LAS unsigned char* lds; int tid, lane, wave, vcu, G;
};


typedef short bf16x8_t __attribute__((ext_vector_type(8)));
typedef float f32x16_t __attribute__((ext_vector_type(16)));
typedef short v4i16_t __attribute__((ext_vector_type(4)));
typedef float f32x2v_t __attribute__((ext_vector_type(2))); typedef __bf16 bf16x2v_t __attribute__((ext_vector_type(2)));
__device__ __forceinline__ unsigned cvtpk(float lo, float hi) { f32x2v_t v = {lo, hi}; bf16x2v_t b = __builtin_convertvector(v, bf16x2v_t); return __builtin_bit_cast(unsigned, b); }
__device__ __forceinline__ v4i16_t lds_tr16(LAS unsigned char* p) { return __builtin_amdgcn_ds_read_tr16_b64_v4i16((LAS v4i16_t*)p); }

__device__ __forceinline__ void sb_phase(LAS unsigned char* wlds  , const bf16_t* SBQ, const bf16_t* SBK, const bf16_t* SBV, bf16_t* OSB, int gw, int ngw, int lane) {
    const int q = lane & 31, hi = lane >> 5;
    bf16x8_t Mf[2];
#pragma unroll
    for (int s = 0; s < 2; ++s)
#pragma unroll
        for (int j = 0; j < 8; ++j) { const int k = 16 * s + 8 * (j >> 2) + 4 * hi + (j & 3); Mf[s][j] = (k > q) ? (short)0x3F80 : (short)0; }
    const int vrow = lane >> 3, vch = lane & 7;
    const int g4 = lane >> 4, qq = (lane >> 2) & 3, p4 = lane & 3;
    LAS unsigned char* trb = wlds + (4 * (g4 >> 1) + qq) * 192 + ((g4 & 1) * 16 + 4 * p4) * 2;
    for (int item = gw; item < 32 * 256; item += ngw) {
        const int bh = item >> 8, qt = item & 255, b = bh >> 3, h = bh & 7;
        const size_t base = (size_t)b * SEQ;
        const bf16_t* Qp = SBQ + (base + qt * 32 + q) * 512 + h * 64 + 8 * hi;
        bf16x8_t Qf[4];
#pragma unroll
        for (int ks = 0; ks < 4; ++ks) Qf[ks] = *(const bf16x8_t*)(Qp + 16 * ks);
        f32x16_t o0 = {}, o1 = {};
        float carry = 0.f;
        bf16x8_t Kn[4]; v4u vn[4];
        {   const bf16_t* Kp = SBK + (base + qt * 32 + q) * 512 + h * 64 + 8 * hi;
#pragma unroll
            for (int ks = 0; ks < 4; ++ks) Kn[ks] = *(const bf16x8_t*)(Kp + 16 * ks);
#pragma unroll
            for (int i = 0; i < 4; ++i) vn[i] = *(const v4u*)(SBV + (base + qt * 32 + vrow + 8 * i) * 512 + h * 64 + vch * 8); }
        for (int kb = qt; kb >= 0; --kb) {
            bf16x8_t Kf[4]; v4u vv[4];
#pragma unroll
            for (int ks = 0; ks < 4; ++ks) Kf[ks] = Kn[ks];
#pragma unroll
            for (int i = 0; i < 4; ++i) vv[i] = vn[i];
            {   const int kn = kb > 0 ? kb - 1 : 0;
                const bf16_t* Kp = SBK + (base + kn * 32 + q) * 512 + h * 64 + 8 * hi;
#pragma unroll
                for (int ks = 0; ks < 4; ++ks) Kn[ks] = *(const bf16x8_t*)(Kp + 16 * ks);
#pragma unroll
                for (int i = 0; i < 4; ++i) vn[i] = *(const v4u*)(SBV + (base + kn * 32 + vrow + 8 * i) * 512 + h * 64 + vch * 8); }
            f32x16_t st = {};
#pragma unroll
            for (int ks = 0; ks < 4; ++ks) st = __builtin_amdgcn_mfma_f32_32x32x16_bf16(Kf[ks], Qf[ks], st, 0, 0, 0);
#pragma unroll
            for (int i = 0; i < 4; ++i) *(LAS v4u*)(wlds + (vrow + 8 * i) * 192 + vch * 16) = vv[i];
            const bool diag = (kb == qt);
            float z[16], lk[16];
#pragma unroll
            for (int r = 0; r < 16; ++r) {
                const int key = (r & 3) + 8 * (r >> 2) + 4 * hi;
                z[r] = st[r] * 0.125f;
                const float sp = fmaxf(z[r], 0.f) + __logf(1.f + __expf(-fabsf(z[r])));
                const bool valid = !diag || key < q;
                lk[r] = valid ? -sp : 0.f;
                z[r] = valid ? z[r] - sp : -INFINITY;
            }
            bf16x8_t lh[2], ll[2];
#pragma unroll
            for (int s = 0; s < 2; ++s) {
                unsigned wh[4], wl[4];
#pragma unroll
                for (int jj = 0; jj < 4; ++jj) { const float a = lk[8 * s + 2 * jj], c = lk[8 * s + 2 * jj + 1]; wh[jj] = cvtpk(a, c);
                    wl[jj] = cvtpk(a - __uint_as_float(wh[jj] << 16), c - __uint_as_float(wh[jj] & 0xffff0000u)); }
                lh[s] = __builtin_bit_cast(bf16x8_t, (v4u){wh[0], wh[1], wh[2], wh[3]}); ll[s] = __builtin_bit_cast(bf16x8_t, (v4u){wl[0], wl[1], wl[2], wl[3]});
            }
            f32x16_t af;
#pragma unroll
            for (int r = 0; r < 16; ++r) af[r] = carry;
            af = __builtin_amdgcn_mfma_f32_32x32x16_bf16(Mf[0], lh[0], af, 0, 0, 0);
            af = __builtin_amdgcn_mfma_f32_32x32x16_bf16(Mf[1], lh[1], af, 0, 0, 0);
            af = __builtin_amdgcn_mfma_f32_32x32x16_bf16(Mf[0], ll[0], af, 0, 0, 0);
            af = __builtin_amdgcn_mfma_f32_32x32x16_bf16(Mf[1], ll[1], af, 0, 0, 0);
            float tot = af[0] + lk[0];
            tot = __shfl(tot, q);
            float pr[16];
#pragma unroll
            for (int r = 0; r < 16; ++r) pr[r] = __expf(z[r] + af[r]);
            bf16x8_t pa[2];
#pragma unroll
            for (int s = 0; s < 2; ++s) pa[s] = __builtin_bit_cast(bf16x8_t, (v4u){cvtpk(pr[8 * s], pr[8 * s + 1]), cvtpk(pr[8 * s + 2], pr[8 * s + 3]), cvtpk(pr[8 * s + 4], pr[8 * s + 5]), cvtpk(pr[8 * s + 6], pr[8 * s + 7])});
            asm volatile("s_waitcnt lgkmcnt(0)" ::: "memory");
#pragma unroll
            for (int s = 0; s < 2; ++s) {
                const v4i16_t a0 = lds_tr16(trb + (16 * s) * 192), a1 = lds_tr16(trb + (16 * s + 8) * 192);
                const v4i16_t c0 = lds_tr16(trb + (16 * s) * 192 + 64), c1 = lds_tr16(trb + (16 * s + 8) * 192 + 64);
                const bf16x8_t vb0 = {a0[0], a0[1], a0[2], a0[3], a1[0], a1[1], a1[2], a1[3]}, vb1 = {c0[0], c0[1], c0[2], c0[3], c1[0], c1[1], c1[2], c1[3]};
                o0 = __builtin_amdgcn_mfma_f32_32x32x16_bf16(pa[s], vb0, o0, 0, 0, 0);
                o1 = __builtin_amdgcn_mfma_f32_32x32x16_bf16(pa[s], vb1, o1, 0, 0, 0);
            }
            carry = tot;
            if (__all(carry < -104.f)) break;
        }
        bf16_t* Op = OSB + (base + qt * 32) * 512 + h * 64 + q;
#pragma unroll
        for (int r = 0; r < 16; ++r) { const int row = (r & 3) + 8 * (r >> 2) + 4 * hi; Op[(size_t)row * 512] = f2bf(o0[r]); Op[(size_t)row * 512 + 32] = f2bf(o1[r]); }
    }
}
typedef float f32x4_t __attribute__((ext_vector_type(4)));
typedef unsigned v2u __attribute__((ext_vector_type(2)));
__device__ __forceinline__ float bflo(unsigned w) { return __uint_as_float(w << 16); }
__device__ __forceinline__ float bfhi(unsigned w) { return __uint_as_float(w & 0xffff0000u); }
__device__ __forceinline__ int frag_off(int r, int k0, int KS) { return (((r >> 4) * KS + (k0 >> 5)) << 9) + (((r & 15) + 16 * ((k0 & 15) >> 2)) << 3) + (((k0 & 31) >> 4) << 2); }

constexpr int GP_KS = 0, GP_QS = 17408, GP_VS = 34816, GP_AS = 52224, GP_WT = 69632, GP_GC = 87040, GP_BETA = 87296, GP_EGC = 87552, GP_CW = 88064, GP_TS = 94208;
constexpr int GROW = 136;

#define LDS_BARRIER() do { asm volatile("s_waitcnt lgkmcnt(0)" ::: "memory"); __builtin_amdgcn_s_barrier(); asm volatile("" ::: "memory"); } while (0)
struct GdnBufs { bf16_t *NW, *QD, *KDT, *QK, *UT; float* CD; bf16_t* ORAW; float* OSS; };

__device__ __forceinline__ void gdn_prep_phase(Frame& F, const Args& a, const bf16_t* GQKV, const float* GB, const float* GA, const GdnBufs& Gb) {
    LAS unsigned char* L = F.lds;
    LAS bf16_t* KS = (LAS bf16_t*)(L + GP_KS); LAS bf16_t* QS = (LAS bf16_t*)(L + GP_QS); LAS bf16_t* VS = (LAS bf16_t*)(L + GP_VS); LAS bf16_t* WT = (LAS bf16_t*)(L + GP_WT);
    LAS float* AS = (LAS float*)(L + GP_AS); LAS float* GC = (LAS float*)(L + GP_GC); LAS float* BETA = (LAS float*)(L + GP_BETA); LAS float* EGC = (LAS float*)(L + GP_EGC); LAS float* CW = (LAS float*)(L + GP_CW); LAS float* TS = (LAS float*)(L + GP_TS);
    const int tid = F.tid, lane = F.lane, wave = F.wave;
    const int per = (2048 + F.G - 1) / F.G;
    int hcur = -1;
    for (int ii = 0; ii < per; ++ii) {
        const int item = F.vcu * per + ii; if (item >= 2048) break;
        const int bh = item >> 7, n = item & 127, b = bh >> 2, h = bh & 3;
        const size_t t0 = (size_t)b * SEQ + n * 64;
        if (h != hcur) { hcur = h; for (int i = tid; i < 1536; i += NWAVES * 64) { const int j = i / 384, cc = i % 384; CW[i] = a.gdn_conv[j * 1536 + (cc >> 7) * 512 + h * 128 + (cc & 127)]; } }
        unsigned pf = 0u;
        if (ii + 1 < per && item + 1 < 2048 && tid < 384) {
            const int r = tid / 6, q6 = tid % 6; const int item2 = item + 1, bh2 = item2 >> 7, n2 = item2 & 127;
            pf = *(const unsigned*)(GQKV + ((size_t)(bh2 >> 2) * SEQ + n2 * 64 + r) * 1536 + (q6 >> 1) * 512 + (bh2 & 3) * 128 + (q6 & 1) * 64);
        }
        if (wave == 0) {
            const size_t t = t0 + lane;
            float g = -__expf(a.a_log[h]) * softplusf_(GA[t * 4 + h] + a.dt_bias[h]);
#pragma unroll
            for (int o = 1; o < 64; o <<= 1) { const float up = __shfl_up(g, o); if (lane >= o) g += up; }
            GC[lane] = g; BETA[lane] = sigmoidf_(GB[t * 4 + h]); EGC[lane] = __expf(g);
            if (lane == 63) Gb.CD[item] = __expf(g);
        }
        LDS_BARRIER();
        {
            const int c = tid >> 3, d0 = (tid & 7) * 16;
#pragma unroll
            for (int part = 0; part < 3; ++part) {
                float acc[16];
#pragma unroll
                for (int i = 0; i < 16; ++i) acc[i] = 0.f;
#pragma unroll
                for (int j = 0; j < 4; ++j) {
                    if (n * 64 + c - 3 + j >= 0) {
                        const bf16_t* src = GQKV + (t0 + c - 3 + j) * 1536 + part * 512 + h * 128 + d0;
                        const v4u r0 = *(const v4u*)src, r1 = *(const v4u*)(src + 8);
                        const unsigned rw[8] = {r0.x, r0.y, r0.z, r0.w, r1.x, r1.y, r1.z, r1.w};
                        const LAS float* cw = CW + j * 384 + part * 128 + d0;
#pragma unroll
                        for (int i = 0; i < 8; ++i) { acc[2 * i] += bflo(rw[i]) * cw[2 * i]; acc[2 * i + 1] += bfhi(rw[i]) * cw[2 * i + 1]; }
                    }
                }
                float ss = 0.f;
#pragma unroll
                for (int i = 0; i < 16; ++i) { acc[i] = acc[i] / (1.f + __expf(-acc[i])); ss += acc[i] * acc[i]; }
                if (part < 2) { ss += __shfl_xor(ss, 1); ss += __shfl_xor(ss, 2); ss += __shfl_xor(ss, 4); const float inv = rsqrtf(ss + EPS);
#pragma unroll
                    for (int i = 0; i < 16; ++i) acc[i] *= inv; }
                LAS bf16_t* dst = (part == 0 ? QS : part == 1 ? KS : VS) + c * GROW + d0;
                v4u w0, w1; w0.x = cvtpk(acc[0], acc[1]); w0.y = cvtpk(acc[2], acc[3]); w0.z = cvtpk(acc[4], acc[5]); w0.w = cvtpk(acc[6], acc[7]);
                w1.x = cvtpk(acc[8], acc[9]); w1.y = cvtpk(acc[10], acc[11]); w1.z = cvtpk(acc[12], acc[13]); w1.w = cvtpk(acc[14], acc[15]);
                *(LAS v4u*)dst = w0; *(LAS v4u*)(dst + 8) = w1;
            }
        }
        LDS_BARRIER();
        {
            const int fr = lane & 15, g = lane >> 4;
            for (int task = wave; task < 26; task += NWAVES) {
                const bool isKK = task < 10; int ct, mt;
                if (isKK) { ct = task >= 6 ? 3 : task >= 3 ? 2 : task >= 1 ? 1 : 0; mt = task - ct * (ct + 1) / 2; } else { ct = (task - 10) >> 2; mt = (task - 10) & 3; }
                f32x4_t acc = {0.f, 0.f, 0.f, 0.f};
                if (mt <= ct) {
                    const LAS bf16_t* Ap = KS + (mt * 16 + fr) * GROW + 8 * g; const LAS bf16_t* Bp = (isKK ? KS : QS) + (ct * 16 + fr) * GROW + 8 * g;
#pragma unroll
                    for (int ks = 0; ks < 4; ++ks) acc = __builtin_amdgcn_mfma_f32_16x16x32_bf16(*(const LAS bf16x8_t*)(Ap + 32 * ks), *(const LAS bf16x8_t*)(Bp + 32 * ks), acc, 0, 0, 0);
                }
                const int c = ct * 16 + fr, m0 = mt * 16 + 4 * g; const float gcc = GC[c];
                float v[4];
#pragma unroll
                for (int r = 0; r < 4; ++r) { const int m = m0 + r; const float dec = __expf(fminf(gcc - GC[m], 0.f)); v[r] = acc[r] * dec; }
                if (isKK) { const float bc = BETA[c];
                    f32x4_t o;
#pragma unroll
                    for (int r = 0; r < 4; ++r) o[r] = (c > m0 + r) ? v[r] * bc : 0.f;
                    *(LAS f32x4_t*)(AS + c * 68 + m0) = o;
                } else {
#pragma unroll
                    for (int r = 0; r < 4; ++r) v[r] = (c >= m0 + r) ? v[r] * 0.08838834764831845f : 0.f;
                    v2u w; w.x = cvtpk(v[0], v[1]); w.y = cvtpk(v[2], v[3]);
                    *(v2u*)(Gb.QK + (size_t)item * 4096 + (ct * 2 + (mt >> 1)) * 512 + lane * 8 + (mt & 1) * 4) = w;
                }
            }
        }
        LDS_BARRIER();
        if (wave == 0) {
            const int q4 = lane >> 4, c = lane & 15; const LAS float* Ab = AS + (16 * q4) * 68 + 16 * q4;
            float t[16];
#pragma unroll
            for (int r = 0; r < 16; ++r) { float s = (r == c) ? 1.f : 0.f;
#pragma unroll
                for (int j4 = 0; j4 < (r + 3) / 4; ++j4) { const f32x4_t av = *(const LAS f32x4_t*)(Ab + r * 68 + 4 * j4);
#pragma unroll
                    for (int i = 0; i < 4; ++i) if (4 * j4 + i < r) s -= av[i] * t[4 * j4 + i]; }
                t[r] = s; TS[(q4 * 16 + r) * 20 + c] = (r == c) ? 0.f : s; }
        }
        LDS_BARRIER();
        {
            const int fr = lane & 15, g = lane >> 4;
#pragma unroll
            for (int cc = 0; cc < 2; ++cc) {
                const int ct2 = wave * 2 + cc; const bool isW = ct2 >= 8; const int col = (ct2 & 7) * 16 + fr;
                const LAS bf16_t* src = (isW ? KS : VS) + col;
                unsigned xb[4][2];
#pragma unroll
                for (int i = 0; i < 4; ++i) {
                    f32x4_t y;
#pragma unroll
                    for (int r = 0; r < 4; ++r) { const int row = 16 * i + 4 * g + r; float v = bf2f(src[row * GROW]) * BETA[row]; if (isW) v *= EGC[row]; y[r] = v; }
#pragma unroll
                    for (int j = 0; j < i; j += 2) {
                        const LAS float* ap = AS + (16 * i + fr) * 68 + 16 * j + 4 * g;
                        const f32x4_t a0 = *(const LAS f32x4_t*)ap; f32x4_t a1 = {0.f, 0.f, 0.f, 0.f}; if (j + 1 < i) a1 = *(const LAS f32x4_t*)(ap + 16);
                        const bf16x8_t af = __builtin_bit_cast(bf16x8_t, (v4u){cvtpk(-a0[0], -a0[1]), cvtpk(-a0[2], -a0[3]), cvtpk(-a1[0], -a1[1]), cvtpk(-a1[2], -a1[3])});
                        const bf16x8_t bfr = __builtin_bit_cast(bf16x8_t, (v4u){xb[j][0], xb[j][1], (j + 1 < i) ? xb[j + 1][0] : 0u, (j + 1 < i) ? xb[j + 1][1] : 0u});
                        y = __builtin_amdgcn_mfma_f32_16x16x32_bf16(af, bfr, y, 0, 0, 0);
                    }
                    const f32x4_t tv = *(const LAS f32x4_t*)(TS + (i * 16 + fr) * 20 + 4 * g);
                    const bf16x8_t tf = __builtin_bit_cast(bf16x8_t, (v4u){cvtpk(tv[0], tv[1]), cvtpk(tv[2], tv[3]), 0u, 0u});
                    const bf16x8_t yf = __builtin_bit_cast(bf16x8_t, (v4u){cvtpk(y[0], y[1]), cvtpk(y[2], y[3]), 0u, 0u});
                    const f32x4_t x = __builtin_amdgcn_mfma_f32_16x16x32_bf16(tf, yf, y, 0, 0, 0);
                    xb[i][0] = cvtpk(x[0], x[1]); xb[i][1] = cvtpk(x[2], x[3]);
                    if (!isW) { *(v2u*)(Gb.UT + (size_t)item * 8192 + col * 64 + 16 * i + 4 * g) = (v2u){xb[i][0], xb[i][1]}; }
                    else {
#pragma unroll
                        for (int r = 0; r < 4; ++r) WT[(16 * i + 4 * g + r) * GROW + col] = f2bf(-x[r]); }
                }
            }
        }
        {
            const float glast = GC[63];
#pragma unroll
            for (int i = 0; i < 4; ++i) { const int p = tid + 512 * i, c = p >> 5, d0 = (p & 31) * 4; const v2u r = *(const LAS v2u*)(QS + c * GROW + d0); const float sc = EGC[c] * 0.08838834764831845f;
                v2u w; w.x = cvtpk(bflo(r.x) * sc, bfhi(r.x) * sc); w.y = cvtpk(bflo(r.y) * sc, bfhi(r.y) * sc);
                *(v2u*)(Gb.QD + (size_t)item * 8192 + frag_off(c, d0, 4)) = w; }
#pragma unroll
            for (int i = 0; i < 4; ++i) { const int p = tid + 512 * i, d = p >> 4, c0 = (p & 15) * 4; float v[4];
#pragma unroll
                for (int r = 0; r < 4; ++r) v[r] = bf2f(KS[(c0 + r) * GROW + d]) * __expf(glast - GC[c0 + r]);
                v2u w; w.x = cvtpk(v[0], v[1]); w.y = cvtpk(v[2], v[3]);
                *(v2u*)(Gb.KDT + (size_t)item * 8192 + frag_off(d, c0, 2)) = w; }
        }
        LDS_BARRIER();
#pragma unroll
        for (int i = 0; i < 4; ++i) { const int p = tid + 512 * i, c = p >> 5, d0 = (p & 31) * 4; const v2u r = *(const LAS v2u*)(WT + c * GROW + d0);
            *(v2u*)(Gb.NW + (size_t)item * 8192 + frag_off(c, d0, 4)) = r; }
        asm volatile("" :: "v"(pf));
        LDS_BARRIER();
    }
}

__device__ __forceinline__ void gdn_scan_unit(Frame& F, int s, const GdnBufs& Gb) {
    const int bh = s >> 2, half = s & 3, h = bh & 3, b = bh >> 2;
    const int tid = F.tid, lane = F.lane, wave = F.wave, fr = lane & 15, g = lane >> 4;
    LAS unsigned char* L = F.lds;
    const size_t tb = (size_t)b * SEQ;
    const int item0 = bh * 128;
    const int lt = tid - 256;
#define GDN_SRC(it, i) ((i) < 4 ? (const v4u*)(Gb.NW + (size_t)(it) * 8192) + lt + 256 * (i) : (i) < 8 ? (const v4u*)(Gb.QD + (size_t)(it) * 8192) + lt + 256 * ((i) - 4) : \
                        (i) < 12 ? (const v4u*)(Gb.KDT + (size_t)(it) * 8192) + lt + 256 * ((i) - 8) : (i) < 14 ? (const v4u*)(Gb.QK + (size_t)(it) * 4096) + lt + 256 * ((i) - 12) : \
                        (const v4u*)(Gb.UT + (size_t)(it) * 8192 + half * 2048) + lt + 256 * ((i) - 14))
#define GDN_LOADR(R, it) do { _Pragma("unroll") for (int i_ = 0; i_ < 15; ++i_) R[i_] = *GDN_SRC(it, i_); } while (0)
#define GDN_STORER(R, bufp) do { _Pragma("unroll") for (int i_ = 0; i_ < 15; ++i_) *(LAS v4u*)((bufp) + (i_ * 256 + lt) * 16) = R[i_]; } while (0)
    LAS float* CDL = (LAS float*)(L + 131072 + 1024);
    LAS bf16_t* OTB = (LAS bf16_t*)(L + 131072 + 2048);
#define GDN_OSTORE(step) do { if (wave < 6 && (step) < 128) { const LAS bf16_t* ot_ = OTB + ((wave - 4) * 2 + ((step) & 1)) * 1024; \
        const v4u o0_ = *(const LAS v4u*)(ot_ + lane * 16), o1_ = *(const LAS v4u*)(ot_ + lane * 16 + 8); \
        bf16_t* dst_ = Gb.ORAW + (tb + (size_t)(step) * 64 + lane) * 512 + h * 128 + half * 32 + (wave - 4) * 16; *(v4u*)dst_ = o0_; *(v4u*)(dst_ + 8) = o1_; } } while (0)
    if (wave >= 4) {
        if (wave == 4) { CDL[lane] = Gb.CD[item0 + lane]; CDL[64 + lane] = Gb.CD[item0 + 64 + lane]; }
        v4u r0[15], r1[15], r2[15];
        GDN_LOADR(r0, item0); GDN_LOADR(r1, item0 + 1); GDN_LOADR(r2, item0 + 2);
        GDN_STORER(r0, L);
        LDS_BARRIER();
#define GDN_CL(k) (item0 + ((k) < 127 ? (k) : 127))
        for (int n = 0; n < 129; n += 3) {
            GDN_LOADR(r0, GDN_CL(n + 3)); GDN_STORER(r1, L + ((n + 1) & 1) * 65536); LDS_BARRIER(); GDN_OSTORE(n);
            GDN_LOADR(r1, GDN_CL(n + 4)); GDN_STORER(r2, L + ((n + 2) & 1) * 65536); LDS_BARRIER(); GDN_OSTORE(n + 1);
            GDN_LOADR(r2, GDN_CL(n + 5)); GDN_STORER(r0, L + ((n + 3) & 1) * 65536); LDS_BARRIER(); GDN_OSTORE(n + 2);
        }
#undef GDN_CL
    } else if (wave >= 2) {
        for (int n = 0; n < 130; ++n) LDS_BARRIER();
    } else {
        LDS_BARRIER();
        f32x4_t S[8];
#pragma unroll
        for (int i = 0; i < 8; ++i) S[i] = (f32x4_t){0.f, 0.f, 0.f, 0.f};
        for (int n = 0; n < 128; ++n) {
            LAS unsigned char* B = L + (n & 1) * 65536;
            const float cd = CDL[n];
            bf16x8_t sb[4];
#pragma unroll
            for (int ks = 0; ks < 4; ++ks) sb[ks] = __builtin_bit_cast(bf16x8_t, (v4u){cvtpk(S[2 * ks][0], S[2 * ks][1]), cvtpk(S[2 * ks][2], S[2 * ks][3]), cvtpk(S[2 * ks + 1][0], S[2 * ks + 1][1]), cvtpk(S[2 * ks + 1][2], S[2 * ks + 1][3])});
#define GDN_SB() __builtin_amdgcn_sched_barrier(0)
            const LAS unsigned char* Bl = B + lane * 16;
            v2u u8[4]; bf16x8_t fa[16], fb[16];
#pragma unroll
            for (int rt = 0; rt < 4; ++rt) u8[rt] = *(const LAS v2u*)(B + 57344 + ((wave * 16 + fr) * 64 + 16 * rt + 4 * g) * 2);
#pragma unroll
            for (int i = 0; i < 16; ++i) fa[i] = *(const LAS bf16x8_t*)(Bl + ((i & 3) * 4 + (i >> 2)) * 1024);
            GDN_SB();
#pragma unroll
            for (int i = 0; i < 16; ++i) fb[i] = *(const LAS bf16x8_t*)(Bl + 16384 + ((i & 3) * 4 + (i >> 2)) * 1024);
            GDN_SB();
            f32x4_t va[4], oa[4];
#pragma unroll
            for (int rt = 0; rt < 4; ++rt) { va[rt] = (f32x4_t){bflo(u8[rt].x), bfhi(u8[rt].x), bflo(u8[rt].y), bfhi(u8[rt].y)}; oa[rt] = (f32x4_t){0.f, 0.f, 0.f, 0.f}; }
#pragma unroll
            for (int i = 0; i < 16; ++i) va[i & 3] = __builtin_amdgcn_mfma_f32_16x16x32_bf16(fa[i], sb[i >> 2], va[i & 3], 0, 0, 0);
            GDN_SB();
#pragma unroll
            for (int i = 0; i < 8; ++i) fa[i] = *(const LAS bf16x8_t*)(Bl + 49152 + ((i & 3) * 2 + (i >> 2)) * 1024);
#pragma unroll
            for (int i = 0; i < 8; ++i) fa[8 + i] = *(const LAS bf16x8_t*)(Bl + 32768 + ((i & 3) * 2 + (i >> 2)) * 1024);
            GDN_SB();
#pragma unroll
            for (int i = 0; i < 16; ++i) oa[i & 3] = __builtin_amdgcn_mfma_f32_16x16x32_bf16(fb[i], sb[i >> 2], oa[i & 3], 0, 0, 0);
            bf16x8_t vb[2];
#pragma unroll
            for (int k2 = 0; k2 < 2; ++k2) vb[k2] = __builtin_bit_cast(bf16x8_t, (v4u){cvtpk(va[2 * k2][0], va[2 * k2][1]), cvtpk(va[2 * k2][2], va[2 * k2][3]), cvtpk(va[2 * k2 + 1][0], va[2 * k2 + 1][1]), cvtpk(va[2 * k2 + 1][2], va[2 * k2 + 1][3])});
#pragma unroll
            for (int dt = 0; dt < 8; ++dt) S[dt] = S[dt] * cd;
            GDN_SB();
#pragma unroll
            for (int i = 0; i < 8; ++i) fb[i] = *(const LAS bf16x8_t*)(Bl + 32768 + 8192 + ((i & 3) * 2 + (i >> 2)) * 1024);
            GDN_SB();
#pragma unroll
            for (int i = 0; i < 8; ++i) oa[i & 3] = __builtin_amdgcn_mfma_f32_16x16x32_bf16(fa[i], vb[i >> 2], oa[i & 3], 0, 0, 0);
#pragma unroll
            for (int i = 0; i < 8; ++i) S[i & 3] = __builtin_amdgcn_mfma_f32_16x16x32_bf16(fa[8 + i], vb[i >> 2], S[i & 3], 0, 0, 0);
            GDN_SB();
#pragma unroll
            for (int i = 0; i < 8; ++i) S[4 + (i & 3)] = __builtin_amdgcn_mfma_f32_16x16x32_bf16(fb[i], vb[i >> 2], S[4 + (i & 3)], 0, 0, 0);
            GDN_SB();
#undef GDN_SB
            { LAS bf16_t* OT = OTB + (wave * 2 + (n & 1)) * 1024;
#pragma unroll
              for (int rt = 0; rt < 4; ++rt)
#pragma unroll
                for (int r = 0; r < 4; ++r) OT[(16 * rt + 4 * g + r) * 16 + fr] = f2bf(oa[rt][r]); }
            LDS_BARRIER();
        }
        LDS_BARRIER();
    }
#undef GDN_SRC
#undef GDN_LOADR
#undef GDN_OSTORE
#undef GDN_STORER
}

__device__ __forceinline__ void gdn_finish_phase(Frame& F, const Args& a, const GdnBufs& Gb, const bf16_t* GZ, bf16_t* OG) {
    const int gt = F.vcu * NWAVES * 64 + F.tid, ngt = F.G * NWAVES * 64;
    for (int p = gt; p < T * 64; p += ngt) {
        const size_t t = (size_t)(p >> 6); const int col = (p & 63) * 8, e0 = col & 127;
        const v4u o = *(const v4u*)(Gb.ORAW + t * 512 + col), z = *(const v4u*)(GZ + t * 512 + col);
        const unsigned ow[4] = {o.x, o.y, o.z, o.w}, zw[4] = {z.x, z.y, z.z, z.w};
        float ss = 0.f;
#pragma unroll
        for (int i = 0; i < 4; ++i) { const float a0 = bflo(ow[i]), a1 = bfhi(ow[i]); ss += a0 * a0 + a1 * a1; }
        ss += __shfl_xor(ss, 1); ss += __shfl_xor(ss, 2); ss += __shfl_xor(ss, 4); ss += __shfl_xor(ss, 8);
        const float rinv = rsqrtf(ss * (1.f / 128.f) + EPS);
        const f32x4_t g0 = *(const f32x4_t*)(a.gdn_norm_g + e0), g1 = *(const f32x4_t*)(a.gdn_norm_g + e0 + 4);
        const float gg[8] = {g0[0], g0[1], g0[2], g0[3], g1[0], g1[1], g1[2], g1[3]};
        unsigned r[4];
#pragma unroll
        for (int i = 0; i < 4; ++i) { const float z0 = bflo(zw[i]), z1 = bfhi(zw[i]);
            r[i] = cvtpk(bflo(ow[i]) * rinv * gg[2 * i] * (z0 / (1.f + __expf(-z0))), bfhi(ow[i]) * rinv * gg[2 * i + 1] * (z1 / (1.f + __expf(-z1)))); }
        *(v4u*)(OG + t * 512 + col) = (v4u){r[0], r[1], r[2], r[3]};
    }
}
typedef float f32x2_t __attribute__((ext_vector_type(2)));
__device__ __forceinline__ float gelu_erf(float v) { return 0.5f * v * (1.f + erff(v * 0.70710678118654752f)); }
constexpr int PEER_CH = 16;
constexpr int CW_PEERU = 8192, CW_PEERV = 8192 + 1024;

#define PEER_SHUF(EN, R0, R1) do { _Pragma("unroll") for (int i = 0; i < 16; ++i) EN[i] = __shfl(i < 8 ? (R0) : (R1), 8 * (i & 7) + g); } while (0)
#define PEER_U_COMPUTE(W, TOK, XR0, XR1, RS) do { const size_t t_ = (TOK); const float rs = (RS); \
        const unsigned xw[8] = {XR0.x, XR0.y, XR0.z, XR0.w, XR1.x, XR1.y, XR1.z, XR1.w}; f32x2_t xf[8]; \
        _Pragma("unroll") for (int q = 0; q < 8; ++q) { xf[q].x = bflo(xw[q]) * rs * gp[q >> 1][(q & 1) * 2]; xf[q].y = bfhi(xw[q]) * rs * gp[q >> 1][(q & 1) * 2 + 1]; } \
        float p[16]; \
        _Pragma("unroll") for (int i = 0; i < 16; ++i) { const unsigned ww[4] = {W[i].x, W[i].y, W[i].z, W[i].w}; f32x2_t acc = {0.f, 0.f}; \
            _Pragma("unroll") for (int q = 0; q < 4; ++q) { acc = __builtin_elementwise_fma(__builtin_amdgcn_cvt_pk_f32_fp8(ww[q], false), xf[2 * q], acc); acc = __builtin_elementwise_fma(__builtin_amdgcn_cvt_pk_f32_fp8(ww[q], true), xf[2 * q + 1], acc); } \
            p[i] = acc.x + acc.y; } \
        _Pragma("unroll") for (int off = 4; off >= 1; off >>= 1) { const bool up = (j & off) != 0; \
            _Pragma("unroll") for (int i = 0; i < 2 * off; ++i) { const float lo = p[i], hi = p[i + 2 * off]; const float send = up ? lo : hi, keep = up ? hi : lo; p[i] = keep + __shfl_xor(send, off); } } \
        bf16_t* dst = PART + ((size_t)x * T + t_) * 128 + 16 * j + g; dst[0] = f2bf(p[0]); dst[8] = f2bf(p[1]); } while (0)
__device__ __forceinline__ void peer_u_phase(Frame& F, const Args& a, gu32* ctl, const bf16_t* X2B, const float* rstd2, const int* EIDX, const unsigned char* U8, bf16_t* PART) {
    const int lane = F.lane, g = lane >> 3, j = lane & 7;
    const int x0 = (int)(xb_xcc_id() & 7u);
    for (int s = 0; s < 8; ++s) {
        const int x = (x0 + s) & 7;
        f32x4_t gp[4];
#pragma unroll
        for (int q = 0; q < 4; ++q) gp[q] = *(const f32x4_t*)(a.g_peer + 128 * x + 16 * j + 4 * q);
        const unsigned char* Ux = U8 + (size_t)x * 16384 * 128 + 16 * j;
        const bf16_t* Xx = X2B + 128 * x + 16 * j;
        for (;;) {
            int c = 0; if (lane == 0) c = (int)__hip_atomic_fetch_add(ctl + CW_PEERU + 64 * x, 1u, __ATOMIC_RELAXED, __HIP_MEMORY_SCOPE_AGENT);
            c = __builtin_amdgcn_readfirstlane(c);
            if (c >= T / PEER_CH) break;
            const size_t tc = (size_t)c * PEER_CH, tl = tc + PEER_CH - 1;
            int en[16]; v4u wa[16], wb[16];
            int er0 = EIDX[tc * 128 + lane], er1 = EIDX[tc * 128 + 64 + lane];
            v4u xa0 = *(const v4u*)(Xx + tc * 1024), xa1 = *(const v4u*)(Xx + tc * 1024 + 8), xb0, xb1; float rsa = rstd2[tc], rsb;
            PEER_SHUF(en, er0, er1);
#pragma unroll
            for (int i = 0; i < 16; ++i) wa[i] = *(const v4u*)(Ux + (size_t)en[i] * 128);
            er0 = EIDX[(tc + 1) * 128 + lane]; er1 = EIDX[(tc + 1) * 128 + 64 + lane];
            for (int tt = 0; tt < PEER_CH; tt += 2) {
                const size_t t = tc + tt, t2 = (t + 2 < tl) ? t + 2 : tl, t3 = (t + 3 < tl) ? t + 3 : tl;
                PEER_SHUF(en, er0, er1);
#pragma unroll
                for (int i = 0; i < 16; ++i) wb[i] = *(const v4u*)(Ux + (size_t)en[i] * 128);
                er0 = EIDX[t2 * 128 + lane]; er1 = EIDX[t2 * 128 + 64 + lane];
                xb0 = *(const v4u*)(Xx + (t + 1) * 1024); xb1 = *(const v4u*)(Xx + (t + 1) * 1024 + 8); rsb = rstd2[t + 1];
                PEER_U_COMPUTE(wa, t, xa0, xa1, rsa);
                PEER_SHUF(en, er0, er1);
#pragma unroll
                for (int i = 0; i < 16; ++i) wa[i] = *(const v4u*)(Ux + (size_t)en[i] * 128);
                er0 = EIDX[t3 * 128 + lane]; er1 = EIDX[t3 * 128 + 64 + lane];
                xa0 = *(const v4u*)(Xx + t2 * 1024); xa1 = *(const v4u*)(Xx + t2 * 1024 + 8); rsa = rstd2[t2];
                PEER_U_COMPUTE(wb, t + 1, xb0, xb1, rsb);
            }
        }
    }
}
__device__ __forceinline__ void peer_combine_phase(Frame& F, const bf16_t* PART, const int* EIDX, const float* EGATE, const float* SU, const float* SV, float* ACTS) {
    const int gt = F.vcu * NWAVES * 64 + F.tid, ngt = F.G * NWAVES * 64;
    for (int p = gt; p < T * 32; p += ngt) {
        f32x4_t s = {0.f, 0.f, 0.f, 0.f};
#pragma unroll
        for (int x = 0; x < 8; ++x) { const v2u w = *(const v2u*)(PART + (size_t)x * T * 128 + (size_t)p * 4); s += (f32x4_t){bflo(w.x), bfhi(w.x), bflo(w.y), bfhi(w.y)}; }
        const int4 e = *(const int4*)(EIDX + (size_t)p * 4); const f32x4_t gt4 = *(const f32x4_t*)(EGATE + (size_t)p * 4);
        *(f32x4_t*)(ACTS + (size_t)p * 4) = (f32x4_t){gelu_erf(s[0] * SU[e.x]) * gt4[0] * SV[e.x], gelu_erf(s[1] * SU[e.y]) * gt4[1] * SV[e.y], gelu_erf(s[2] * SU[e.z]) * gt4[2] * SV[e.z], gelu_erf(s[3] * SU[e.w]) * gt4[3] * SV[e.w]};
    }
}
#define PEER_V_COMPUTE(W, TOK, A0R, A1R, XWR) do { const size_t t_ = (TOK); float av[16]; \
        _Pragma("unroll") for (int i = 0; i < 16; ++i) av[i] = __shfl(i < 8 ? (A0R) : (A1R), 8 * (i & 7) + g); \
        const size_t oo_ = t_ * 1024 + 128 * x + 16 * j + 2 * g; const unsigned xw_ = (XWR); const f32x2_t xv = {bflo(xw_), bfhi(xw_)}; \
        f32x2_t o2[8]; _Pragma("unroll") for (int q = 0; q < 8; ++q) o2[q] = (f32x2_t){0.f, 0.f}; \
        _Pragma("unroll") for (int i = 0; i < 16; ++i) { const unsigned ww[4] = {W[i].x, W[i].y, W[i].z, W[i].w}; const f32x2_t a2 = {av[i], av[i]}; \
            _Pragma("unroll") for (int q = 0; q < 4; ++q) { o2[2 * q] = __builtin_elementwise_fma(__builtin_amdgcn_cvt_pk_f32_fp8(ww[q], false), a2, o2[2 * q]); o2[2 * q + 1] = __builtin_elementwise_fma(__builtin_amdgcn_cvt_pk_f32_fp8(ww[q], true), a2, o2[2 * q + 1]); } } \
        float o[16]; _Pragma("unroll") for (int q = 0; q < 8; ++q) { o[2 * q] = o2[q].x; o[2 * q + 1] = o2[q].y; } \
        _Pragma("unroll") for (int off = 4; off >= 1; off >>= 1) { const bool up = (g & off) != 0; \
            _Pragma("unroll") for (int i = 0; i < 2 * off; ++i) { const float lo = o[i], hi = o[i + 2 * off]; const float send = up ? lo : hi, keep = up ? hi : lo; o[i] = keep + __shfl_xor(send, 8 * off); } } \
        const unsigned rw_ = cvtpk(xv.x + o[0], xv.y + o[1]); *(unsigned*)(X3B + oo_) = rw_; const float r0 = bflo(rw_), r1 = bfhi(rw_); \
        const float ss = wave_sum(r0 * r0 + r1 * r1); if (lane == 0) SS3[t_ * 8 + x] = ss; } while (0)
__device__ __forceinline__ void peer_v_phase(Frame& F, gu32* ctl, const int* EIDX, const float* ACTS, const unsigned char* V8, const bf16_t* X2B, bf16_t* X3B, float* SS3) {
    const int lane = F.lane, g = lane >> 3, j = lane & 7;
    const int x0 = (int)(xb_xcc_id() & 7u);
    for (int s = 0; s < 8; ++s) {
        const int x = (x0 + s) & 7;
        const unsigned char* Vx = V8 + (size_t)x * 16384 * 128 + 16 * j;
        const bf16_t* Xx = X2B + 128 * x + 16 * j + 2 * g;
        for (;;) {
            int c = 0; if (lane == 0) c = (int)__hip_atomic_fetch_add(ctl + CW_PEERV + 64 * x, 1u, __ATOMIC_RELAXED, __HIP_MEMORY_SCOPE_AGENT);
            c = __builtin_amdgcn_readfirstlane(c);
            if (c >= T / PEER_CH) break;
            const size_t tc = (size_t)c * PEER_CH, tl = tc + PEER_CH - 1;
            int en[16]; v4u wa[16], wb[16];
            int er0 = EIDX[tc * 128 + lane], er1 = EIDX[tc * 128 + 64 + lane];
            float aa0 = ACTS[tc * 128 + lane], aa1 = ACTS[tc * 128 + 64 + lane], ab0, ab1; unsigned xwa = *(const unsigned*)(Xx + tc * 1024), xwb;
            PEER_SHUF(en, er0, er1);
#pragma unroll
            for (int i = 0; i < 16; ++i) wa[i] = *(const v4u*)(Vx + (size_t)en[i] * 128);
            er0 = EIDX[(tc + 1) * 128 + lane]; er1 = EIDX[(tc + 1) * 128 + 64 + lane];
            for (int tt = 0; tt < PEER_CH; tt += 2) {
                const size_t t = tc + tt, t2 = (t + 2 < tl) ? t + 2 : tl, t3 = (t + 3 < tl) ? t + 3 : tl;
                PEER_SHUF(en, er0, er1);
#pragma unroll
                for (int i = 0; i < 16; ++i) wb[i] = *(const v4u*)(Vx + (size_t)en[i] * 128);
                er0 = EIDX[t2 * 128 + lane]; er1 = EIDX[t2 * 128 + 64 + lane];
                ab0 = ACTS[(t + 1) * 128 + lane]; ab1 = ACTS[(t + 1) * 128 + 64 + lane]; xwb = *(const unsigned*)(Xx + (t + 1) * 1024);
                PEER_V_COMPUTE(wa, t, aa0, aa1, xwa);
                PEER_SHUF(en, er0, er1);
#pragma unroll
                for (int i = 0; i < 16; ++i) wa[i] = *(const v4u*)(Vx + (size_t)en[i] * 128);
                er0 = EIDX[t3 * 128 + lane]; er1 = EIDX[t3 * 128 + 64 + lane];
                aa0 = ACTS[t2 * 128 + lane]; aa1 = ACTS[t2 * 128 + 64 + lane]; xwa = *(const unsigned*)(Xx + t2 * 1024);
                PEER_V_COMPUTE(wb, t + 1, ab0, ab1, xwb);
            }
        }
    }
}
__device__ __forceinline__ void peer_norm_phase(Frame& F, const Args& a, const float* SS3, const bf16_t* X3B, float* out) {
    const int gt = F.vcu * NWAVES * 64 + F.tid, ngt = F.G * NWAVES * 64;
    for (int p = gt; p < T * 128; p += ngt) {
        const size_t t = (size_t)(p >> 7); const int c = (p & 127) * 8;
        const f32x4_t s0 = *(const f32x4_t*)(SS3 + t * 8), s1 = *(const f32x4_t*)(SS3 + t * 8 + 4);
        const float r3 = rsqrtf(((s0[0] + s0[1]) + (s0[2] + s0[3]) + (s1[0] + s1[1]) + (s1[2] + s1[3])) * (1.f / D) + EPS);
        const v4u w = *(const v4u*)(X3B + t * 1024 + c);
        const f32x4_t g0 = *(const f32x4_t*)(a.g_final + c), g1 = *(const f32x4_t*)(a.g_final + c + 4);
        *(f32x4_t*)(out + t * 1024 + c) = (f32x4_t){bflo(w.x), bfhi(w.x), bflo(w.y), bfhi(w.y)} * g0 * r3;
        *(f32x4_t*)(out + t * 1024 + c + 4) = (f32x4_t){bflo(w.z), bfhi(w.z), bflo(w.w), bfhi(w.w)} * g1 * r3;
    }
}
#ifndef TOPK_HD
#define TOPK_HD __device__ __forceinline__
#endif
TOPK_HD void ce_desc(unsigned& a, unsigned& b) { const unsigned hi = a > b ? a : b, lo = a > b ? b : a; a = hi; b = lo; }
TOPK_HD void sort16_desc(unsigned (&v)[16]) {
#pragma unroll
    for (int k = 2; k <= 16; k <<= 1)
#pragma unroll
        for (int j = k >> 1; j >= 1; j >>= 1)
#pragma unroll
            for (int i = 0; i < 16; ++i) { const int l = i ^ j; if (l > i) { if ((i & k) == 0) ce_desc(v[i], v[l]); else ce_desc(v[l], v[i]); } }
}
TOPK_HD void bitonic_merge16_desc(unsigned (&v)[16]) {
#pragma unroll
    for (int j = 8; j >= 1; j >>= 1)
#pragma unroll
        for (int i = 0; i < 16; ++i) { const int l = i ^ j; if (l > i) ce_desc(v[i], v[l]); }
}
TOPK_HD void top16_merge(unsigned (&a)[16], const unsigned (&b)[16]) {
#pragma unroll
    for (int i = 0; i < 16; ++i) a[i] = a[i] > b[15 - i] ? a[i] : b[15 - i];
    bitonic_merge16_desc(a);
}
TOPK_HD unsigned f2ord(float f) { const unsigned u = __builtin_bit_cast(unsigned, f); return (u & 0x80000000u) ? ~u : (u | 0x80000000u); }
TOPK_HD float ord2f(unsigned o) { const unsigned u = (o & 0x80000000u) ? (o & 0x7fffffffu) : ~o; return __builtin_bit_cast(float, u); }

__device__ __forceinline__ void peer_route_task(Frame& F, const bf16_t* PQ, const bf16_t* SK16, int* EIDX, float* EGATE, int tt, int h) {
    constexpr int CI[50] = {0,0,0,0,0,0,0,0,0,0,0,0,0,0,0,0,1,1,1,1,1,1,1,1,2,2,2,2,2,3,3,3,3,4,4,4,5,5,6,6,7,7,8,9,10,11,12,13,14,15};
    constexpr int CJ[50] = {0,1,2,3,4,5,6,7,8,9,10,11,12,13,14,15,0,1,2,3,4,5,6,7,0,1,2,3,4,0,1,2,3,0,1,2,0,1,0,1,0,1,0,0,0,0,0,0,0,0};
    int lane = F.lane; asm volatile("" : "+v"(lane));
    const int t = lane & 31, hi = lane >> 5;
    LAS unsigned* wl = (LAS unsigned*)(F.lds + F.wave * 16384) + lane * 33;
    {
        const size_t row = (size_t)tt * 32 + t;
        unsigned L[2][16];
#pragma unroll
        for (int p = 0; p < 2; ++p) {
            const int hp = h * 2 + p;
            bf16x8_t Bf[8], An[8];
#pragma unroll
            for (int ks = 0; ks < 8; ++ks) Bf[ks] = *(const bf16x8_t*)(PQ + row * 2048 + hp * 128 + 16 * ks + 8 * hi);
            const bf16_t* Abase = SK16 + ((size_t)(hp * 128 + t)) * 128 + 8 * hi;
#pragma unroll
            for (int ks = 0; ks < 8; ++ks) An[ks] = *(const bf16x8_t*)(Abase + 16 * ks);
#pragma unroll
            for (int i = 0; i < 16; ++i) L[p][i] = 0u;
#pragma unroll 1
            for (int nt = 0; nt < 4; ++nt) {
                bf16x8_t Ac[8];
#pragma unroll
                for (int ks = 0; ks < 8; ++ks) Ac[ks] = An[ks];
                const int nn = nt < 3 ? nt + 1 : 3;
#pragma unroll
                for (int ks = 0; ks < 8; ++ks) An[ks] = *(const bf16x8_t*)(Abase + (size_t)nn * 32 * 128 + 16 * ks);
                f32x16_t acc = {};
#pragma unroll
                for (int ks = 0; ks < 8; ++ks) acc = __builtin_amdgcn_mfma_f32_32x32x16_bf16(Ac[ks], Bf[ks], acc, 0, 0, 0);
                unsigned k[16];
#pragma unroll
                for (int r = 0; r < 16; ++r) { const int n = 32 * nt + (r & 3) + 8 * (r >> 2) + 4 * hi; k[r] = (f2ord(acc[r]) & ~127u) | (unsigned)(127 - n); }
                sort16_desc(k);
                top16_merge(L[p], k);
            }
            unsigned pb[16];
#pragma unroll
            for (int i = 0; i < 16; ++i) pb[i] = __shfl_xor(L[p][i], 32);
            top16_merge(L[p], pb);
        }
        float sa[16], sb[16];
#pragma unroll
        for (int i = 0; i < 16; ++i) { sa[i] = ord2f(L[0][i] & ~127u); sb[i] = ord2f(L[1][i] & ~127u); wl[i] = 127u - (L[0][i] & 127u); wl[16 + i] = 127u - (L[1][i] & 127u); }
        unsigned c0[16], c1[16];
#pragma unroll
        for (int s = 0; s < 32; ++s) {
            unsigned key = 0u;
            if (s < 25) { const float v = hi ? sa[CI[25 + s]] + sb[CJ[25 + s]] : sa[CI[s]] + sb[CJ[s]]; const int pos = hi ? CI[25 + s] * 16 + CJ[25 + s] : CI[s] * 16 + CJ[s];
                key = (f2ord(v) & ~255u) | (unsigned)(255 - pos); }
            if (s < 16) c0[s] = key; else c1[s - 16] = key;
        }
        sort16_desc(c0); sort16_desc(c1); top16_merge(c0, c1);
        unsigned pb[16];
#pragma unroll
        for (int i = 0; i < 16; ++i) pb[i] = __shfl_xor(c0[i], 32);
        top16_merge(c0, pb);
        float e[16]; const float m = ord2f(c0[0] & ~255u); float l = 0.f;
#pragma unroll
        for (int r = 0; r < 16; ++r) { e[r] = __expf(ord2f(c0[r] & ~255u) - m); l += e[r]; }
        const float il = 1.f / l;
        int ex[8]; float gt[8];
#pragma unroll
        for (int q = 0; q < 8; ++q) { const unsigned kk = hi ? c0[8 + q] : c0[q]; const int pos = 255 - (int)(kk & 255u); ex[q] = (int)(wl[pos >> 4] * 128u + wl[16 + (pos & 15)]); gt[q] = (hi ? e[8 + q] : e[q]) * il; }
        int* ep = EIDX + row * 128 + h * 16 + hi * 8; float* gp = EGATE + row * 128 + h * 16 + hi * 8;
        *(int4*)ep = make_int4(ex[0], ex[1], ex[2], ex[3]); *(int4*)(ep + 4) = make_int4(ex[4], ex[5], ex[6], ex[7]);
        *(f32x4_t*)gp = (f32x4_t){gt[0], gt[1], gt[2], gt[3]}; *(f32x4_t*)(gp + 4) = (f32x4_t){gt[4], gt[5], gt[6], gt[7]};
    }
}
__device__ __forceinline__ void cross_item(Frame& F, const bf16_t* QC, const bf16_t* KC, const bf16_t* VC, bf16_t* OC, int bh, int qb) {
    int tid = F.tid; asm volatile("" : "+v"(tid));
    const int lane = tid & 63, wave = F.wave, q = lane & 31, hi = lane >> 5;
    LAS unsigned char* L = F.lds;
    const int g4 = lane >> 4, qq = (lane >> 2) & 3, p4 = lane & 3;
    {
        const int b = bh >> 2, h = bh & 3;
#pragma unroll
        for (int i = 0; i < 16; ++i) { const int cid = tid + 512 * i, r = cid >> 5, c = cid & 31;
            *(LAS v4u*)(L + r * 512 + ((c ^ (r & 15)) << 4)) = *(const v4u*)(KC + (size_t)(b * 256 + r) * 1024 + h * 256 + c * 8); }
        const size_t qrow0 = (size_t)b * SEQ + qb * 256 + wave * 32;
        const bf16_t* Qp = QC + (qrow0 + q) * 1024 + h * 256 + 8 * hi;
        __syncthreads();
        f32x16_t st[8];
#pragma unroll
        for (int kt = 0; kt < 8; ++kt) st[kt] = (f32x16_t){};
#pragma unroll 2
        for (int ks = 0; ks < 16; ++ks) { const bf16x8_t qf = *(const bf16x8_t*)(Qp + 16 * ks);
#pragma unroll
            for (int kt = 0; kt < 8; ++kt) { const int row = 32 * kt + q;
                st[kt] = __builtin_amdgcn_mfma_f32_32x32x16_bf16(*(const LAS bf16x8_t*)(L + row * 512 + (((2 * ks + hi) ^ (row & 15)) << 4)), qf, st[kt], 0, 0, 0); } }
        float m = -INFINITY;
#pragma unroll
        for (int kt = 0; kt < 8; ++kt)
#pragma unroll
            for (int r = 0; r < 16; ++r) { st[kt][r] *= 0.0625f; m = fmaxf(m, st[kt][r]); }
        m = fmaxf(m, __shfl_xor(m, 32));
        float l = 0.f;
#pragma unroll
        for (int kt = 0; kt < 8; ++kt)
#pragma unroll
            for (int r = 0; r < 16; ++r) { st[kt][r] = __expf(st[kt][r] - m); l += st[kt][r]; }
        l += __shfl_xor(l, 32);
        const float il = 1.f / l;
        bf16x8_t pa[8][2];
#pragma unroll
        for (int kt = 0; kt < 8; ++kt)
#pragma unroll
            for (int s = 0; s < 2; ++s) pa[kt][s] = __builtin_bit_cast(bf16x8_t, (v4u){cvtpk(st[kt][8 * s] * il, st[kt][8 * s + 1] * il), cvtpk(st[kt][8 * s + 2] * il, st[kt][8 * s + 3] * il),
                                                                                        cvtpk(st[kt][8 * s + 4] * il, st[kt][8 * s + 5] * il), cvtpk(st[kt][8 * s + 6] * il, st[kt][8 * s + 7] * il)});
        __syncthreads();
#pragma unroll
        for (int i = 0; i < 16; ++i) { const int cid = tid + 512 * i, r = cid >> 5, c = cid & 31;
            *(LAS v4u*)(L + r * 512 + ((c ^ (4 * (r & 3))) << 4)) = *(const v4u*)(VC + (size_t)(b * 256 + r) * 1024 + h * 256 + c * 8); }
        __syncthreads();
        bf16_t* Op = OC + qrow0 * 1024 + h * 256 + q;
#pragma unroll 1
        for (int dt = 0; dt < 8; ++dt) {
            f32x16_t o = {};
            LAS unsigned char* vb = L + (4 * (g4 >> 1) + qq) * 512 + (((dt * 64) ^ (qq << 6)) + (g4 & 1) * 32 + p4 * 8);
#pragma unroll
            for (int kt = 0; kt < 8; ++kt)
#pragma unroll
                for (int s = 0; s < 2; ++s) { const v4i16_t a0 = lds_tr16(vb + (32 * kt + 16 * s) * 512), a1 = lds_tr16(vb + (32 * kt + 16 * s + 8) * 512);
                    const bf16x8_t vf = {a0[0], a0[1], a0[2], a0[3], a1[0], a1[1], a1[2], a1[3]};
                    o = __builtin_amdgcn_mfma_f32_32x32x16_bf16(pa[kt][s], vf, o, 0, 0, 0); }
#pragma unroll
            for (int r = 0; r < 16; ++r) { const int row = (r & 3) + 8 * (r >> 2) + 4 * hi; Op[(size_t)row * 1024 + dt * 32] = f2bf(o[r]); }
        }
        __syncthreads();
    }
}
template <bool REMAP>
__device__ __forceinline__ void transpose_tile(const float* W, int K, int N, const float* gain, bf16_t* WT, LAS float* tile, int item, int tid) {
    const int nblk = (N + 255) / 256, kb = item / nblk, nb = item % nblk, k0 = 64 * kb, n0 = 256 * nb;
    const int c4 = (tid & 63) * 4, kr = tid >> 6;
    f32x4 v[8];
#pragma unroll
    for (int i = 0; i < 8; ++i) { const int k = kr + 8 * i; v[i] = (n0 + c4 < N) ? *(const GAS f32x4*)(W + (size_t)(k0 + k) * N + n0 + c4) : (f32x4){0.f, 0.f, 0.f, 0.f}; }
#pragma unroll
    for (int i = 0; i < 8; ++i) { const int k = kr + 8 * i; LAS float* d = tile + k * 257 + c4; d[0] = v[i].x; d[1] = v[i].y; d[2] = v[i].z; d[3] = v[i].w; }
    __syncthreads();
#pragma unroll
    for (int i = 0; i < 4; ++i) { const int p = tid + 512 * i, n = p >> 3, c = p & 7; const LAS float* sp = tile + (8 * c) * 257 + n;
        float g[8];
#pragma unroll
        for (int q = 0; q < 8; ++q) g[q] = gain ? gain[k0 + 8 * c + q] : 1.f;
        v4u o; o.x = pk2(sp[0 * 257] * g[0], sp[1 * 257] * g[1]); o.y = pk2(sp[2 * 257] * g[2], sp[3 * 257] * g[3]); o.z = pk2(sp[4 * 257] * g[4], sp[5 * 257] * g[5]); o.w = pk2(sp[6 * 257] * g[6], sp[7 * 257] * g[7]);
        int ng = n0 + n; bool ok = ng < N;
        if (REMAP) { if (ng >= 3584 && ng < 3592) ok = false; else if (ng >= 3592) ng -= 8; }
        if (ok) *(GAS v4u*)(WT + (size_t)ng * K + k0 + 8 * c) = o; }
    __syncthreads();
}

__device__ __forceinline__ void p0_prologue(Frame& F, const Args& a) {
    unsigned char* ws = a.ws;
    LAS float* tile = (LAS float*)F.lds;
    const int gw = F.vcu * NWAVES + F.wave, NGW = F.G * NWAVES;
    constexpr int I_IN = 16 * 23;
    for (int it = F.vcu; it < I_IN; it += F.G) transpose_tile<true>(a.w_in, 1024, IN_COLS, a.g_mix, (bf16_t*)(ws + WS_WIN), tile, it, F.tid);
    __syncthreads();
    LAS float* wsm = (LAS float*)F.lds;
    for (int i = F.tid; i < 8192; i += NWAVES * 64) { const int j = i >> 10, k = i & 1023; wsm[i] = a.w_in[(size_t)k * IN_COLS + 3584 + j] * a.g_mix[k]; }
    __syncthreads();
    bf16_t* XB = (bf16_t*)(ws + WS_A0); float* rstd0 = (float*)(ws + WS_RSTD0); float* GB = (float*)(ws + WS_GB); float* GA = GB + T * 4;
    for (int row0 = gw * 4; row0 < T; row0 += NGW * 4) {
        f32x4 v[4][4];
#pragma unroll
        for (int r = 0; r < 4; ++r)
#pragma unroll
            for (int j = 0; j < 4; ++j) v[r][j] = *((const GAS f32x4*)(a.x + (size_t)(row0 + r) * D) + F.lane + 64 * j);
#pragma unroll
        for (int r = 0; r < 4; ++r) { const int row = row0 + r; float s = 0.f;
#pragma unroll
            for (int j = 0; j < 4; ++j) s += (v[r][j].x * v[r][j].x + v[r][j].y * v[r][j].y) + (v[r][j].z * v[r][j].z + v[r][j].w * v[r][j].w);
            const float rstd = rsqrtf(wave_sum(s) * (1.f / D) + EPS);
            GAS unsigned long long* o8 = (GAS unsigned long long*)(XB + (size_t)row * D) + F.lane;
#pragma unroll
            for (int j = 0; j < 4; ++j) o8[64 * j] = (unsigned long long)pk2(v[r][j].x, v[r][j].y) | ((unsigned long long)pk2(v[r][j].z, v[r][j].w) << 32);
            float dj[8];
#pragma unroll
            for (int jj = 0; jj < 8; ++jj) { float d = 0.f;
#pragma unroll
                for (int j = 0; j < 4; ++j) { const f32x4 w = *(const LAS f32x4*)(wsm + jj * 1024 + (F.lane + 64 * j) * 4); d += (v[r][j].x * w.x + v[r][j].y * w.y) + (v[r][j].z * w.z + v[r][j].w * w.w); }
                dj[jj] = d; }
#pragma unroll
            for (int off = 4; off >= 1; off >>= 1) { const bool up = (F.lane & off) != 0;
#pragma unroll
                for (int i = 0; i < off; ++i) { const float lo = dj[i], hi = dj[i + off]; const float send = up ? lo : hi, keep = up ? hi : lo; dj[i] = keep + __shfl_xor(send, off); } }
            float d0 = dj[0]; d0 += __shfl_xor(d0, 8); d0 += __shfl_xor(d0, 16); d0 += __shfl_xor(d0, 32);
            if (F.lane == 0) rstd0[row] = rstd;
            if (F.lane < 4) GB[(size_t)row * 4 + F.lane] = d0 * rstd; else if (F.lane < 8) GA[(size_t)row * 4 + F.lane - 4] = d0 * rstd; }
    }
}
__device__ __forceinline__ void late_prologue(Frame& F, const Args& a, int wgi, int nwg) {
    unsigned char* ws = a.ws;
    LAS float* tile = (LAS float*)F.lds;
    const int gw = wgi * NWAVES + F.wave, NGW = nwg * NWAVES;
    constexpr int I_S = 8 * 4, I_M = 16 * 4, I_L = 16 * 8;
    constexpr int NITEMS = 2 * I_S + 3 * I_M + 2 * I_L;
    for (int it = wgi; it < NITEMS; it += nwg) {
        int r = it;
        if (r < I_S) { transpose_tile<false>(a.w_sb_up, 512, 1024, nullptr, (bf16_t*)(ws + WS_WSB), tile, r, F.tid); continue; } r -= I_S;
        if (r < I_S) { transpose_tile<false>(a.w_gdn_up, 512, 1024, nullptr, (bf16_t*)(ws + WS_WGDN), tile, r, F.tid); continue; } r -= I_S;
        if (r < I_M) { transpose_tile<false>(a.w_mix_out, 1024, 1024, nullptr, (bf16_t*)(ws + WS_WMIX), tile, r, F.tid); continue; } r -= I_M;
        if (r < I_M) { transpose_tile<false>(a.w_cq, 1024, 1024, a.g_cross, (bf16_t*)(ws + WS_WCQ), tile, r, F.tid); continue; } r -= I_M;
        if (r < I_M) { transpose_tile<false>(a.w_co, 1024, 1024, nullptr, (bf16_t*)(ws + WS_WCO), tile, r, F.tid); continue; } r -= I_M;
        if (r < I_L) { transpose_tile<false>(a.w_ckv, 1024, 2048, nullptr, (bf16_t*)(ws + WS_WCKV), tile, r, F.tid); continue; } r -= I_L;
        transpose_tile<false>(a.w_pq, 1024, 2048, a.g_peer, (bf16_t*)(ws + WS_WPQ), tile, r, F.tid);
    }
    __syncthreads();
    {
        float* SUV = (float*)(ws + WS_SUV);
        for (int row0 = gw * 4; row0 < 2 * 16384; row0 += NGW * 4) {
            f32x4 v[4][4];
#pragma unroll
            for (int r = 0; r < 4; ++r) { const int row = row0 + r, tb = row >> 14, e = row & 16383; const float* src = (tb ? a.peer_v : a.peer_u) + (size_t)e * 1024 + 16 * F.lane;
#pragma unroll
                for (int q = 0; q < 4; ++q) v[r][q] = *(const GAS f32x4*)(src + 4 * q); }
#pragma unroll
            for (int r = 0; r < 4; ++r) { const int row = row0 + r, tb = row >> 14, e = row & 16383; float am = 0.f;
#pragma unroll
                for (int q = 0; q < 4; ++q) am = fmaxf(am, fmaxf(fmaxf(fabsf(v[r][q].x), fabsf(v[r][q].y)), fmaxf(fabsf(v[r][q].z), fabsf(v[r][q].w))));
#pragma unroll
                for (int o = 1; o < 64; o <<= 1) am = fmaxf(am, __shfl_xor(am, o));
                int ex = 0; if (am > 0.f) (void)frexpf(am, &ex);
                const float sc = ldexpf(1.f, 8 - ex), inv = ldexpf(1.f, ex - 8);
                v4u o; int rr;
                rr = __builtin_amdgcn_cvt_pk_fp8_f32(v[r][0].x * sc, v[r][0].y * sc, 0, false); rr = __builtin_amdgcn_cvt_pk_fp8_f32(v[r][0].z * sc, v[r][0].w * sc, rr, true); o.x = (unsigned)rr;
                rr = __builtin_amdgcn_cvt_pk_fp8_f32(v[r][1].x * sc, v[r][1].y * sc, 0, false); rr = __builtin_amdgcn_cvt_pk_fp8_f32(v[r][1].z * sc, v[r][1].w * sc, rr, true); o.y = (unsigned)rr;
                rr = __builtin_amdgcn_cvt_pk_fp8_f32(v[r][2].x * sc, v[r][2].y * sc, 0, false); rr = __builtin_amdgcn_cvt_pk_fp8_f32(v[r][2].z * sc, v[r][2].w * sc, rr, true); o.z = (unsigned)rr;
                rr = __builtin_amdgcn_cvt_pk_fp8_f32(v[r][3].x * sc, v[r][3].y * sc, 0, false); rr = __builtin_amdgcn_cvt_pk_fp8_f32(v[r][3].z * sc, v[r][3].w * sc, rr, true); o.w = (unsigned)rr;
                *(GAS v4u*)(ws + (tb ? WS_V8 : WS_U8) + ((size_t)(F.lane >> 3) * 16384 + e) * 128 + 16 * (F.lane & 7)) = o;
                if (F.lane == 0) SUV[row] = inv; }
        }
    }
    {
        const int gt = gw * 64 + F.lane, ngt = NGW * 64;
        for (int p = gt; p < 262144 / 8; p += ngt) { const float* src = a.subkeys + (size_t)p * 8; const f32x4 v0 = *(const GAS f32x4*)src, v1 = *(const GAS f32x4*)(src + 4);
            v4u o; o.x = pk2(v0.x, v0.y); o.y = pk2(v0.z, v0.w); o.z = pk2(v1.x, v1.y); o.w = pk2(v1.z, v1.w); *(GAS v4u*)((bf16_t*)(ws + WS_SKB) + (size_t)p * 8) = o; }
    }
    bf16_t* MN = (bf16_t*)(ws + WS_MN);
    for (int row = gw; row < 1024; row += NGW) {
        const GAS f32x4* xr = (const GAS f32x4*)(a.mem + (size_t)row * D) + F.lane;
        f32x4 v[4]; float s = 0.f;
#pragma unroll
        for (int j = 0; j < 4; ++j) { v[j] = xr[64 * j]; s += (v[j].x * v[j].x + v[j].y * v[j].y) + (v[j].z * v[j].z + v[j].w * v[j].w); }
        const float rstd = rsqrtf(wave_sum(s) * (1.f / D) + EPS);
        GAS unsigned long long* o8 = (GAS unsigned long long*)(MN + (size_t)row * D) + F.lane;
#pragma unroll
        for (int j = 0; j < 4; ++j) { const f32x4 g = *((const f32x4*)a.g_mem + F.lane + 64 * j); const f32x4 o = v[j] * g * rstd;
            o8[64 * j] = (unsigned long long)pk2(o.x, o.y) | ((unsigned long long)pk2(o.z, o.w) << 32); }
    }
}
__device__ __forceinline__ void rstd_rows_for_units(Frame& F, int N, const float* SS, float* rstd) {
    pg8::StaticOrder S2; S2.init(T, N, F.G, (int)blockIdx.x); pg8::Unit u;
    for (int i = 0; S2.next(i, u); ++i) if (F.tid < 256) { const int row = u.pm * 256 + F.tid; const f32x4* sp = (const f32x4*)(SS + (size_t)row * 16);
        const f32x4 a = (sp[0] + sp[1]) + (sp[2] + sp[3]); rstd[row] = rsqrtf(((a.x + a.y) + (a.z + a.w)) * (1.f / 1024.f) + EPS); }
    asm volatile("s_waitcnt vmcnt(0)" ::: "memory"); __syncthreads();
}

__device__ __forceinline__ void sub_barrier(gu32* cnt, unsigned n, gu32* tmo) {
    asm volatile("s_waitcnt vmcnt(0)" ::: "memory");
    __syncthreads();
    if (threadIdx.x == 0) {
        __builtin_amdgcn_fence(__ATOMIC_RELEASE, "agent");
        asm volatile("s_waitcnt vmcnt(0)" ::: "memory");
        __hip_atomic_fetch_add(cnt, 1u, __ATOMIC_RELAXED, __HIP_MEMORY_SCOPE_AGENT);
        unsigned sp = 0;
        while (__hip_atomic_load(cnt, __ATOMIC_RELAXED, __HIP_MEMORY_SCOPE_AGENT) < n) { __builtin_amdgcn_s_sleep(2); if (++sp > (1u << 22)) { __hip_atomic_store(tmo, 1u, __ATOMIC_RELAXED, __HIP_MEMORY_SCOPE_AGENT); break; } }
        __builtin_amdgcn_fence(__ATOMIC_ACQUIRE, "agent");
        asm volatile("s_waitcnt vmcnt(0)" ::: "memory");
    }
    __syncthreads();
}

__global__ void __launch_bounds__(NWAVES * 64, 2) mk_fwd(Args args) {
    extern __shared__ __attribute__((aligned(16))) unsigned char lds_raw[];
    Frame F;
    F.lds = (LAS unsigned char*)lds_raw;
    F.tid = threadIdx.x; F.lane = F.tid & 63; F.wave = __builtin_amdgcn_readfirstlane(F.tid >> 6);
    F.G = gridDim.x; { const int bx = blockIdx.x; F.vcu = (F.G % 8 == 0) ? (bx % 8) * (F.G / 8) + bx / 8 : bx; }
    unsigned char* ws = args.ws;
    gu32* ctl = (gu32*)(ws + WS_CTL);
    volatile LAS unsigned* MISC = (volatile LAS unsigned*)(F.lds + MISC_OFF);
    for (int u = F.tid; u < (LDS_BYTES - LDSCTL_OFF) / 4; u += NWAVES * 64) ((LAS unsigned*)(F.lds + LDSCTL_OFF))[u] = 0u;
    __syncthreads();
    XcdBarrier bar = xcd_barrier_post((unsigned*)(ctl + CW_BAR) + args.bar_region * XCD_BAR_WORDS, MISC + 8);
    const int lo = args.ph_lo, hi = args.ph_hi;
#define IN(k) (lo <= (k) && (k) < hi)
#define SEAM(k) do { if (IN(k) && IN((k) + 1)) xcd_barrier(bar); } while (0)
    bf16_t* A0 = (bf16_t*)(ws + WS_A0); bf16_t* A1 = (bf16_t*)(ws + WS_A1);
    bf16_t* MG = (bf16_t*)args.out;
    bf16_t* SBQ = (bf16_t*)args.out; bf16_t* SBK = SBQ + (size_t)T * 512; bf16_t* SBV = SBK + (size_t)T * 512; bf16_t* OSB = SBV + (size_t)T * 512;

    GdnBufs Gb{(bf16_t*)(ws + WS_NW), (bf16_t*)(ws + WS_QD), (bf16_t*)(ws + WS_KDT), (bf16_t*)(ws + WS_QK), (bf16_t*)(ws + WS_UT), (float*)(ws + WS_CD), (bf16_t*)(ws + WS_ORAW), (float*)(ws + WS_OSS)};
    if (IN(0)) { p0_prologue(F, args);}
    SEAM(0);
    if (IN(1)) {
        { pg8::Gemm g{A0, (const bf16_t*)(ws + WS_WIN), T, NPROJ, 1024}; pg8::StaticOrder S; S.init(T, NPROJ, F.G, (int)blockIdx.x);
          pg8::EpiProj E{(const float*)(ws + WS_RSTD0), SBQ, SBK, SBV, A1, (bf16_t*)(ws + WS_GZ), (bf16_t*)(ws + WS_GSB), (bf16_t*)(ws + WS_GGDN)};
          pg8::gemm_phase<pg8::EpiProj, pg8::StaticOrder, true, true>(F.lds, g, S, E); }
    }
    SEAM(1);
    if (IN(2)) { gdn_prep_phase(F, args, A1, (const float*)(ws + WS_GB), (const float*)(ws + WS_GB) + T * 4, Gb); }
    SEAM(2);
    if (IN(3)) {
        const int nscan = F.G > 64 ? 64 : F.G, sb0 = F.G > 64 ? 64 : 0;
        if ((int)blockIdx.x < nscan) for (int s0 = blockIdx.x; s0 < 64; s0 += nscan) { const int s = (nscan == 64) ? ((s0 & 7) + 8 * (s0 >> 5)) * 4 + ((s0 >> 3) & 3) : s0; gdn_scan_unit(F, s, Gb); __syncthreads(); }
        if ((int)blockIdx.x >= sb0) { late_prologue(F, args, (int)blockIdx.x - sb0, F.G - sb0); __syncthreads(); }
        if ((int)blockIdx.x >= sb0) sb_phase(F.lds + F.wave * 8192, SBQ, SBK, SBV, OSB, ((int)blockIdx.x - sb0) * NWAVES + F.wave, (F.G - sb0) * NWAVES, F.lane);
        __syncthreads();
        if (sb0 > 0 && (int)blockIdx.x >= sb0) {
            sub_barrier(ctl + CW_SUB, (unsigned)(F.G - sb0), ctl + CW_SUB + 64);
            pg8::Gemm g{OSB, (const bf16_t*)(ws + WS_WSB), T, 1024, 512}; pg8::StaticOrder S; S.init(T, 1024, F.G - sb0, (int)blockIdx.x - sb0);
            pg8::EpiMerge<false> E{(const bf16_t*)(ws + WS_GSB), MG};
            pg8::gemm_phase<pg8::EpiMerge<false>, pg8::StaticOrder, true, true>(F.lds, g, S, E);
        }
    }
    SEAM(3);
    if (IN(4)) {
        { pg8::Gemm g{(const bf16_t*)(ws + WS_MN), (const bf16_t*)(ws + WS_WCKV), 1024, 2048, 1024}; pg8::StaticOrder S; S.init(1024, 2048, F.G, (int)blockIdx.x);
          pg8::EpiSplit E{(bf16_t*)(ws + WS_KC), (bf16_t*)(ws + WS_VC), 1024, 4};
          pg8::gemm_phase<pg8::EpiSplit, pg8::StaticOrder, true, true>(F.lds, g, S, E); }
        gdn_finish_phase(F, args, Gb, (const bf16_t*)(ws + WS_GZ), (bf16_t*)(ws + WS_OG)); }
    SEAM(4);
    if (IN(5)) {
        if (!(F.G > 64)) { pg8::Gemm g{OSB, (const bf16_t*)(ws + WS_WSB), T, 1024, 512}; pg8::StaticOrder S; S.init(T, 1024, F.G, (int)blockIdx.x);
          pg8::EpiMerge<false> E{(const bf16_t*)(ws + WS_GSB), MG};
          pg8::gemm_phase<pg8::EpiMerge<false>, pg8::StaticOrder, true, true>(F.lds, g, S, E);
          xcd_barrier(bar); }
        { pg8::Gemm g{(const bf16_t*)(ws + WS_OG), (const bf16_t*)(ws + WS_WGDN), T, 1024, 512}; pg8::StaticOrder S; S.init(T, 1024, F.G, (int)blockIdx.x);
          pg8::EpiMerge<true> E{(const bf16_t*)(ws + WS_GGDN), MG};
          pg8::gemm_phase<pg8::EpiMerge<true>, pg8::StaticOrder, true, true>(F.lds, g, S, E); }
    }
    SEAM(5);
    if (IN(6)) {
        pg8::Gemm g{MG, (const bf16_t*)(ws + WS_WMIX), T, 1024, 1024}; pg8::StaticOrder S; S.init(T, 1024, F.G, (int)blockIdx.x);
        pg8::EpiRes<true> E{args.x, nullptr, A1, (float*)(ws + WS_SS)};
        pg8::gemm_phase<pg8::EpiRes<true>, pg8::StaticOrder, true, true>(F.lds, g, S, E);
    }
    SEAM(6);
    if (IN(7)) {
        rstd_rows_for_units(F, 1024, (const float*)(ws + WS_SS), (float*)(ws + WS_RSTD0));
        pg8::Gemm g{A1, (const bf16_t*)(ws + WS_WCQ), T, 1024, 1024}; pg8::StaticOrder S; S.init(T, 1024, F.G, (int)blockIdx.x);
        pg8::EpiScale E{(const float*)(ws + WS_RSTD0), (bf16_t*)(ws + WS_GSB), 1024};
        pg8::gemm_phase<pg8::EpiScale, pg8::StaticOrder, true, true>(F.lds, g, S, E);
        asm volatile("s_waitcnt vmcnt(0)" ::: "memory"); __syncthreads();
        pg8::StaticOrder S2; S2.init(T, 1024, F.G, (int)blockIdx.x); pg8::Unit u;
        for (int i = 0; S2.next(i, u); ++i) cross_item(F, (const bf16_t*)(ws + WS_GSB), (const bf16_t*)(ws + WS_KC), (const bf16_t*)(ws + WS_VC), (bf16_t*)(ws + WS_GGDN), (u.pm >> 5) * 4 + u.pn, u.pm & 31);
    }
    SEAM(7);
    if (IN(9)) {
        pg8::Gemm g{(const bf16_t*)(ws + WS_GGDN), (const bf16_t*)(ws + WS_WCO), T, 1024, 1024}; pg8::StaticOrder S; S.init(T, 1024, F.G, (int)blockIdx.x);
        pg8::EpiRes<false> E{nullptr, A1, A0, (float*)(ws + WS_SS)};
        pg8::gemm_phase<pg8::EpiRes<false>, pg8::StaticOrder, true, true>(F.lds, g, S, E);
    }
    SEAM(9);
    if (IN(10)) {
        rstd_rows_for_units(F, 2048, (const float*)(ws + WS_SS), (float*)(ws + WS_RSTD2));
        pg8::Gemm g{A0, (const bf16_t*)(ws + WS_WPQ), T, 2048, 1024}; pg8::StaticOrder S; S.init(T, 2048, F.G, (int)blockIdx.x);
        pg8::EpiScale E{(const float*)(ws + WS_RSTD2), A1, 2048};
        pg8::gemm_phase<pg8::EpiScale, pg8::StaticOrder, true, true>(F.lds, g, S, E);
        asm volatile("s_waitcnt vmcnt(0)" ::: "memory"); __syncthreads();
        pg8::StaticOrder S2; S2.init(T, 2048, F.G, (int)blockIdx.x); pg8::Unit u;
        for (int i = 0; S2.next(i, u); ++i) peer_route_task(F, A1, (const bf16_t*)(ws + WS_SKB), (int*)(ws + 296 * MiB), (float*)(ws + 312 * MiB), u.pm * 8 + F.wave, u.pn);
        __syncthreads();
    }
    SEAM(10);
    if (IN(12)) { peer_u_phase(F, args, ctl, A0, (const float*)(ws + WS_RSTD2), (const int*)(ws + 296 * MiB), (const unsigned char*)(ws + WS_U8), (bf16_t*)(ws + WS_PART)); }
    SEAM(12);
    if (IN(13)) { peer_combine_phase(F, (const bf16_t*)(ws + WS_PART), (const int*)(ws + 296 * MiB), (const float*)(ws + 312 * MiB), (const float*)(ws + WS_SUV), (const float*)(ws + WS_SUV) + 16384, (float*)(ws + 328 * MiB)); }
    SEAM(13);
    if (IN(14)) { peer_v_phase(F, ctl, (const int*)(ws + 296 * MiB), (const float*)(ws + 328 * MiB), (const unsigned char*)(ws + WS_V8), A0, A1, (float*)(ws + WS_SS)); }
    SEAM(14);
    if (IN(15)) { peer_norm_phase(F, args, (const float*)(ws + WS_SS), A1, args.out); }
#undef IN
#undef SEAM
}
extern "C" void kernel_launch(void* const* d_in, const int* in_sizes, int n_in, void* d_out, int out_size, void* d_ws, size_t ws_size, hipStream_t stream) {
    static int grid = 0;
    if (grid == 0) {
        if (n_in != 22 || ws_size < WS_END || out_size != T * D) { fprintf(stderr, "kernel_launch: unexpected n_in %d / ws %zu / out %d\n", n_in, ws_size, out_size); grid = -1; return; }
        int dev = 0, cus = 0, per_cu = 0;
        if (hipGetDevice(&dev) != hipSuccess || hipDeviceGetAttribute(&cus, hipDeviceAttributeMultiprocessorCount, dev) != hipSuccess) { grid = -1; return; }
        if (hipFuncSetAttribute((const void*)mk_fwd, hipFuncAttributeMaxDynamicSharedMemorySize, LDS_BYTES) != hipSuccess) { fprintf(stderr, "kernel_launch: hipFuncSetAttribute failed\n"); grid = -1; return; }
        if (hipOccupancyMaxActiveBlocksPerMultiprocessor(&per_cu, (const void*)mk_fwd, NWAVES * 64, LDS_BYTES) != hipSuccess || per_cu < 1) { fprintf(stderr, "kernel_launch: occupancy query says %d\n", per_cu); per_cu = 1; }
        (void)hipGetLastError();
        grid = cus;
    }
    if (grid < 0) return;
    hipMemsetAsync((char*)d_ws + WS_CTL, 0, CTL_ZERO_BYTES, stream);
    Args a{};
    const float** ap = (const float**)&a;
    for (int i = 0; i < 22; ++i) ap[i] = (const float*)d_in[i];
    a.out = (float*)d_out; a.ws = (unsigned char*)d_ws;
    char* ws = (char*)d_ws; float* out = (float*)d_out;
    float* rstd2 = (float*)(ws + WS_RSTD2);
    bf16_t* KC = (bf16_t*)(ws + WS_KC); bf16_t* VC = (bf16_t*)(ws + WS_VC);
    bf16_t* PQ = (bf16_t*)(ws + WS_A1); bf16_t* QC = (bf16_t*)(ws + WS_GSB); bf16_t* OC = (bf16_t*)(ws + WS_GGDN);
    int* EIDX = (int*)(ws + 296 * MiB); float* EGATE = (float*)(ws + 312 * MiB);
#define MK(lo, hi, reg) do { a.ph_lo = (lo); a.ph_hi = (hi); a.bar_region = (reg); hipLaunchKernelGGL(mk_fwd, dim3(grid), dim3(NWAVES * 64), LDS_BYTES, stream, a); } while (0)
    MK(0, 16, 0);
#undef MK
}
```

```cpp
#include <hip/hip_runtime.h>
#include <stdint.h>
#include <cstdio>

typedef unsigned short bf16_t;
__device__ __forceinline__ float bf2f(bf16_t v) { return __uint_as_float(((unsigned)v) << 16); }
__device__ __forceinline__ bf16_t f2bf(float f) { unsigned u = __float_as_uint(f); return (bf16_t)((u + 0x7fffu + ((u >> 16) & 1u)) >> 16); }

constexpr int T = 32768, D = 1024, SEQ = 8192, NB = 4;
constexpr int IN_COLS = 5640, NPROJ = 5632;
constexpr float EPS = 1e-6f;
constexpr size_t MiB = 1u << 20;

__device__ __forceinline__ float wave_sum(float v) {
#pragma unroll
    for (int o = 1; o < 64; o <<= 1) v += __shfl_xor(v, o);
    return v;
}
__device__ __forceinline__ float sigmoidf_(float x) { return 1.f / (1.f + __expf(-x)); }
__device__ __forceinline__ float softplusf_(float x) { return fmaxf(x, 0.f) + log1pf(__expf(-fabsf(x))); }

namespace pg8 {
#define PG8_LAS __attribute__((address_space(3)))
typedef unsigned short bf16_t;
typedef short bf16x8 __attribute__((ext_vector_type(8)));
typedef float f32x4 __attribute__((ext_vector_type(4)));
typedef unsigned u32x4 __attribute__((ext_vector_type(4)));
constexpr int BM = 256, BK = 64, HALF = 128, HTB = HALF * BK * 2  , STAGE_BYTES = 8 * HTB, NXCD = 8, WGM = 8;

__host__ __device__ __forceinline__ int lds_byte(int r, int c) { const int st = (r >> 4) * 2 + (c >> 5), rr = r & 15, cc = c & 31, ob = rr * 64 + cc * 2; return st * 1024 + (ob ^ (((ob >> 9) & 1) << 5)); }
__host__ __device__ __forceinline__ void stage_rc(int b, int& R, int& C) { const int st = b / 1024, sb = b % 1024, swz = sb ^ (((sb >> 9) & 1) << 5); R = (st >> 1) * 16 + swz / 64; C = (st & 1) * 32 + (swz % 64) / 2; }
__host__ __device__ __forceinline__ int perm32(int rho) { const int n = rho >> 4, i = rho & 15; return 8 * (i >> 2) + 4 * n + (i & 3); }

struct Unit { int pm, pn; };
struct Gemm { const bf16_t* A; const bf16_t* Bt; int M, N, K; };

struct StaticOrder {
    int nM, nN, nwg, G, c;
    __host__ __device__ __forceinline__ void init(int M, int N, int G_, int c_) { nM = M / BM; nN = N / BM; nwg = nM * nN; G = G_; c = c_; }
    __host__ __device__ __forceinline__ bool next(int i, Unit& u) const {
        const long L = (long)i * G + c; if (L >= nwg) return false;
        int wgid = (int)L; { const int q = nwg / NXCD, r = nwg % NXCD, xcd = wgid % NXCD, off = wgid / NXCD; wgid = (xcd < r ? xcd * (q + 1) : r * (q + 1) + (xcd - r) * q) + off; }
        const int nig = WGM * nN, gid = wgid / nig, fm = gid * WGM, gsz = (nM - fm) < WGM ? (nM - fm) : WGM;
        u.pm = fm + ((wgid % nig) % gsz); u.pn = (wgid % nig) / gsz; return true;
    }
    __device__ __forceinline__ void a_ready(const Unit&) const {}
    __device__ __forceinline__ void done(const Unit&) const {}
};

__device__ __forceinline__ unsigned cvt_pk_bf16(float lo, float hi) { unsigned r; asm volatile("v_cvt_pk_bf16_f32 %0, %1, %2" : "=v"(r) : "v"(lo), "v"(hi)); return r; }
typedef float f32x2 __attribute__((ext_vector_type(2)));
__device__ __forceinline__ float bfl(unsigned w) { return __uint_as_float(w << 16); }
__device__ __forceinline__ float bfh(unsigned w) { return __uint_as_float(w & 0xffff0000u); }
constexpr int EPI_STAGE_OFF = 131072 + 1024;
__device__ __forceinline__ void stage_store16x64(int wid, int fr, int fq, u32x4 w0, u32x4 w1, bf16_t* rowbase  , size_t ld) {
    PG8_LAS unsigned char* sl = (PG8_LAS unsigned char*)(EPI_STAGE_OFF + wid * 2048);
    *(PG8_LAS u32x4*)(sl + fr * 128 + ((fq ^ (fr & 7)) << 4)) = w0;
    *(PG8_LAS u32x4*)(sl + fr * 128 + (((4 + fq) ^ (fr & 7)) << 4)) = w1;
    const int lane = fr + 16 * fq, r0 = lane >> 3, c = lane & 7;
    const u32x4 a = *(const PG8_LAS u32x4*)(sl + r0 * 128 + ((c ^ r0) << 4));
    const u32x4 b = *(const PG8_LAS u32x4*)(sl + (r0 + 8) * 128 + ((c ^ r0) << 4));
    *(u32x4*)(rowbase + (size_t)r0 * ld + c * 8) = a;
    *(u32x4*)(rowbase + (size_t)(r0 + 8) * ld + c * 8) = b;
}
__device__ __forceinline__ u32x4 pack8(const f32x4& v0, const f32x4& v1) { u32x4 w; w.x = cvt_pk_bf16(v0[0], v0[1]); w.y = cvt_pk_bf16(v0[2], v0[3]); w.z = cvt_pk_bf16(v1[0], v1[1]); w.w = cvt_pk_bf16(v1[2], v1[3]); return w; }

struct EpiProj {
    static constexpr bool PERM = true, AFTER_DRAIN = false, COL64 = true;
    const float* rstd; bf16_t *SBQ, *SBK, *SBV, *GQKV, *GZ, *GSB, *GGDN;
    __device__ __forceinline__ void operator()(const f32x4 (&acc)[2][2][4][2], const Unit& u, int wr, int wc, int fr_in, int fq_in) const {
        int lane_ = fr_in + 16 * fq_in; asm volatile("" : "+v"(lane_));
        const int fr = lane_ & 15, fq = lane_ >> 4;
        const int pn = u.pn; bf16_t* base; int ld, coff;
        if (pn < 2) { base = SBQ; ld = 512; coff = pn * 256; } else if (pn < 4) { base = SBK; ld = 512; coff = (pn - 2) * 256; } else if (pn < 6) { base = SBV; ld = 512; coff = (pn - 4) * 256; }
        else if (pn < 12) { base = GQKV; ld = 1536; coff = (pn - 6) * 256; } else if (pn < 14) { base = GZ; ld = 512; coff = (pn - 12) * 256; }
        else if (pn < 18) { base = GSB; ld = 1024; coff = (pn - 14) * 256; } else { base = GGDN; ld = 1024; coff = (pn - 18) * 256; }
        const int row0 = u.pm * BM + wr * 64, wid = wr * 4 + wc;
        float rsv[2][4];
#pragma unroll
        for (int ai = 0; ai < 2; ++ai)
#pragma unroll
            for (int m = 0; m < 4; ++m) rsv[ai][m] = rstd[row0 + ai * HALF + m * 16 + fr];
#pragma unroll
        for (int ai = 0; ai < 2; ++ai)
#pragma unroll
            for (int m = 0; m < 4; ++m) { const int rg = row0 + ai * HALF + m * 16; const float rs = rsv[ai][m];
                stage_store16x64(wid, fr, fq, pack8(acc[ai][0][m][0] * rs, acc[ai][0][m][1] * rs), pack8(acc[ai][1][m][0] * rs, acc[ai][1][m][1] * rs), base + (size_t)rg * ld + coff + wc * 64, ld); }
    }
};
struct EpiSplit {
    static constexpr bool PERM = true, AFTER_DRAIN = false, COL64 = true;
    bf16_t *O0, *O1; int ldc, split_tiles;
    __device__ __forceinline__ void operator()(const f32x4 (&acc)[2][2][4][2], const Unit& u, int wr, int wc, int fr_in, int fq_in) const {
        int lane_ = fr_in + 16 * fq_in; asm volatile("" : "+v"(lane_));
        const int fr = lane_ & 15, fq = lane_ >> 4;
        bf16_t* base = u.pn < split_tiles ? O0 : O1; const int coff = (u.pn < split_tiles ? u.pn : u.pn - split_tiles) * 256;
        const int row0 = u.pm * BM + wr * 64, wid = wr * 4 + wc;
#pragma unroll
        for (int ai = 0; ai < 2; ++ai)
#pragma unroll
            for (int m = 0; m < 4; ++m) { const int rg = row0 + ai * HALF + m * 16;
                stage_store16x64(wid, fr, fq, pack8(acc[ai][0][m][0], acc[ai][0][m][1]), pack8(acc[ai][1][m][0], acc[ai][1][m][1]), base + (size_t)rg * ldc + coff + wc * 64, ldc); }
    }
};
template <bool ADD> struct EpiMerge {
    static constexpr bool PERM = true, AFTER_DRAIN = false, COL64 = true;
    const bf16_t* gate; bf16_t* M;
    __device__ __forceinline__ void operator()(const f32x4 (&acc)[2][2][4][2], const Unit& u, int wr, int wc, int fr_in, int fq_in) const {
        int lane_ = fr_in + 16 * fq_in; asm volatile("" : "+v"(lane_));
        const int fr = lane_ & 15, fq = lane_ >> 4;
        const int row0 = u.pm * BM + wr * 64, col0 = u.pn * BM + wc * 64, wid = wr * 4 + wc;
#pragma unroll
        for (int ab = 0; ab < 4; ++ab) { const int ai = ab >> 1, mb = (ab & 1) * 2;
            u32x4 gl[4][2], pl[4][2];
#pragma unroll
            for (int m = mb; m < mb + 2; ++m)
#pragma unroll
                for (int bj = 0; bj < 2; ++bj) { const size_t o = (size_t)(row0 + ai * HALF + m * 16 + fr) * 1024 + col0 + 8 * fq + bj * 32; gl[m][bj] = *(const u32x4*)(gate + o); if (ADD) pl[m][bj] = *(const u32x4*)(M + o); }
#pragma unroll
            for (int m = mb; m < mb + 2; ++m) { const int rg = row0 + ai * HALF + m * 16;
                u32x4 wv[2];
#pragma unroll
                for (int bj = 0; bj < 2; ++bj) { const u32x4 g = gl[m][bj];
                    float gv[8] = {bfl(g.x), bfh(g.x), bfl(g.y), bfh(g.y), bfl(g.z), bfh(g.z), bfl(g.w), bfh(g.w)};
                    float pv[8] = {0.f, 0.f, 0.f, 0.f, 0.f, 0.f, 0.f, 0.f};
                    if (ADD) { const u32x4 p = pl[m][bj]; pv[0] = bfl(p.x); pv[1] = bfh(p.x); pv[2] = bfl(p.y); pv[3] = bfh(p.y); pv[4] = bfl(p.z); pv[5] = bfh(p.z); pv[6] = bfl(p.w); pv[7] = bfh(p.w); }
                    float r[8];
#pragma unroll
                    for (int j = 0; j < 8; ++j) { const float a = j < 4 ? acc[ai][bj][m][0][j] : acc[ai][bj][m][1][j - 4]; r[j] = pv[j] + a * __builtin_amdgcn_rcpf(1.f + __expf(-gv[j])); }
                    wv[bj].x = cvt_pk_bf16(r[0], r[1]); wv[bj].y = cvt_pk_bf16(r[2], r[3]); wv[bj].z = cvt_pk_bf16(r[4], r[5]); wv[bj].w = cvt_pk_bf16(r[6], r[7]); }
                stage_store16x64(wid, fr, fq, wv[0], wv[1], M + (size_t)rg * 1024 + col0, 1024); }
        }
    }
};
template <bool IN_F32> struct EpiRes {
    static constexpr bool PERM = true, AFTER_DRAIN = false, COL64 = true;
    const float* xin_f; const bf16_t* xin_b; bf16_t* xb; float* SS;
    __device__ __forceinline__ void operator()(const f32x4 (&acc)[2][2][4][2], const Unit& u, int wr, int wc, int fr_in, int fq_in) const {
        int lane_ = fr_in + 16 * fq_in; asm volatile("" : "+v"(lane_));
        const int fr = lane_ & 15, fq = lane_ >> 4;
        const int row0 = u.pm * BM + wr * 64, col0 = u.pn * BM + wc * 64, wid = wr * 4 + wc;
#pragma unroll
        for (int ab = 0; ab < 4; ++ab) { const int ai = ab >> 1, mb = (ab & 1) * 2;
            f32x4 xl[4][2][2];
#pragma unroll
            for (int m = mb; m < mb + 2; ++m)
#pragma unroll
                for (int bj = 0; bj < 2; ++bj) { const size_t o = (size_t)(row0 + ai * HALF + m * 16 + fr) * 1024 + col0 + 8 * fq + bj * 32;
                    if (IN_F32) { xl[m][bj][0] = *(const f32x4*)(xin_f + o); xl[m][bj][1] = *(const f32x4*)(xin_f + o + 4); }
                    else { const u32x4 p = *(const u32x4*)(xin_b + o); xl[m][bj][0] = (f32x4){bfl(p.x), bfh(p.x), bfl(p.y), bfh(p.y)}; xl[m][bj][1] = (f32x4){bfl(p.z), bfh(p.z), bfl(p.w), bfh(p.w)}; } }
            float sv[4];
#pragma unroll
            for (int m = mb; m < mb + 2; ++m) { const int rg = row0 + ai * HALF + m * 16; float s = 0.f;
                u32x4 wv[2];
#pragma unroll
                for (int bj = 0; bj < 2; ++bj) { const u32x4 w = pack8(xl[m][bj][0] + acc[ai][bj][m][0], xl[m][bj][1] + acc[ai][bj][m][1]); wv[bj] = w;
                    const float r0 = bfl(w.x), r1 = bfh(w.x), r2 = bfl(w.y), r3 = bfh(w.y), r4 = bfl(w.z), r5 = bfh(w.z), r6 = bfl(w.w), r7 = bfh(w.w);
                    s += (r0 * r0 + r1 * r1) + (r2 * r2 + r3 * r3) + (r4 * r4 + r5 * r5) + (r6 * r6 + r7 * r7); }
                stage_store16x64(wid, fr, fq, wv[0], wv[1], xb + (size_t)rg * 1024 + col0, 1024);
                s += __shfl_xor(s, 16); s += __shfl_xor(s, 32); sv[m] = s; }
#pragma unroll
            for (int m = mb; m < mb + 2; ++m) if (fq == 0) SS[(size_t)(row0 + ai * HALF + m * 16 + fr) * 16 + u.pn * 4 + wc] = sv[m];
        }
    }
};
struct EpiScale {
    static constexpr bool PERM = true, AFTER_DRAIN = false, COL64 = true;
    const float* rstd; bf16_t* O; int ldc;
    __device__ __forceinline__ void operator()(const f32x4 (&acc)[2][2][4][2], const Unit& u, int wr, int wc, int fr_in, int fq_in) const {
        int lane_ = fr_in + 16 * fq_in; asm volatile("" : "+v"(lane_));
        const int fr = lane_ & 15, fq = lane_ >> 4;
        const int row0 = u.pm * BM + wr * 64, col0 = u.pn * BM + wc * 64, wid = wr * 4 + wc;
        float rsv[2][4];
#pragma unroll
        for (int ai = 0; ai < 2; ++ai)
#pragma unroll
            for (int m = 0; m < 4; ++m) rsv[ai][m] = rstd[row0 + ai * HALF + m * 16 + fr];
#pragma unroll
        for (int ai = 0; ai < 2; ++ai)
#pragma unroll
            for (int m = 0; m < 4; ++m) { const int rg = row0 + ai * HALF + m * 16; const float rs = rsv[ai][m];
                stage_store16x64(wid, fr, fq, pack8(acc[ai][0][m][0] * rs, acc[ai][0][m][1] * rs), pack8(acc[ai][1][m][0] * rs, acc[ai][1][m][1] * rs), O + (size_t)rg * ldc + col0, ldc); }
    }
};
template <class Epi, class Sched, bool ALIGN_EPI = false, bool SP2 = false>
__device__ __forceinline__ void gemm_phase(PG8_LAS unsigned char* lds, const Gemm g, const Sched& S, const Epi& E) {
    const int tid = threadIdx.x, wid = __builtin_amdgcn_readfirstlane(tid >> 6), lane = tid & 63, wr = wid >> 2, wc = wid & 3, fr = lane & 15, fq = lane >> 4;
    const int K = g.K, nt = K / BK;
    unsigned voffA[2], voffB[2];
#pragma unroll
    for (int i = 0; i < 2; ++i) { int R, C; stage_rc(tid * 16 + i * 8192, R, C); const int Rb = Epi::PERM ? ((Epi::COL64 ? 2 * (R & ~31) : (R & ~31)) + perm32(R & 31)) : R;
        voffA[i] = (unsigned)(R * K + C) * 2u; voffB[i] = (unsigned)(Rb * K + C) * 2u; }
    const size_t kstep = (size_t)(BK * 2);
    const size_t hstep = (size_t)HALF * K * 2;
    const size_t bhstep = Epi::COL64 ? (size_t)32 * K * 2 : hstep;
    const size_t tstep = 2 * hstep;
    const unsigned ldsw = (unsigned)wid * 1024u;
    const int aoff = lds_byte(wr * 64 + fr, fq * 8), boff = lds_byte(wc * 32 + fr, fq * 8);
#define PG8_SA(b, h) (((b) * 2 + (h)) * HTB)
#define PG8_SB(b, h) ((4 + (b) * 2 + (h)) * HTB)
#define PG8_STAGE(bufoff, gbase, voff) do { _Pragma("unroll") for (int _i = 0; _i < 2; ++_i) \
        __builtin_amdgcn_global_load_lds((const unsigned*)((const char*)(gbase) + (voff)[_i]), (PG8_LAS unsigned*)(lds + (bufoff) + ldsw + _i * 8192), 16, 0, 0); } while (0)
#define PG8_LDA(dst, b, h) do { _Pragma("unroll") for (int m = 0; m < 4; ++m) _Pragma("unroll") for (int k = 0; k < 2; ++k) dst[m][k] = *(const PG8_LAS bf16x8*)(lds + PG8_SA(b, h) + aoff + m * 2048 + k * 1024); } while (0)
#define PG8_LDB(dst, b, h) do { _Pragma("unroll") for (int n = 0; n < 2; ++n) _Pragma("unroll") for (int k = 0; k < 2; ++k) dst[n][k] = *(const PG8_LAS bf16x8*)(lds + PG8_SB(b, h) + boff + n * 2048 + k * 1024); } while (0)
#define PG8_MMA(ai, bj, At, Bt) do { __builtin_amdgcn_s_setprio(1); _Pragma("unroll") for (int m = 0; m < 4; ++m) _Pragma("unroll") for (int n = 0; n < 2; ++n) _Pragma("unroll") for (int k = 0; k < 2; ++k) \
        acc[ai][bj][m][n] = __builtin_amdgcn_mfma_f32_16x16x32_bf16(Bt[n][k], At[m][k], acc[ai][bj][m][n], 0, 0, 0); __builtin_amdgcn_s_setprio(0); } while (0)
#define PG8_WAIT_V(n) asm volatile("s_waitcnt vmcnt(" #n ")" ::: "memory")
#define PG8_WAIT_L(n) asm volatile("s_waitcnt lgkmcnt(" #n ")" ::: "memory")
#define PG8_BAR __builtin_amdgcn_s_barrier()
#define PG8_SCHED __builtin_amdgcn_sched_barrier(0)
    Unit cur, nxt; int ui = 0;
    if (!S.next(0, cur)) return;
    f32x4 acc[2][2][4][2];
#pragma unroll
    for (int a = 0; a < 2; ++a)
#pragma unroll
        for (int b = 0; b < 2; ++b)
#pragma unroll
            for (int m = 0; m < 4; ++m)
#pragma unroll
                for (int n = 0; n < 2; ++n) acc[a][b][m][n] = (f32x4){0.f, 0.f, 0.f, 0.f};
    bf16x8 At[4][2], B0[2][2], B1[2][2];
    const char* cA = (const char*)g.A + (size_t)cur.pm * tstep; const char* cB = (const char*)g.Bt + (size_t)cur.pn * tstep;
    S.a_ready(cur);
    if constexpr (SP2) {
        PG8_STAGE(PG8_SB(0, 0), cB, voffB); PG8_STAGE(PG8_SB(0, 1), cB + bhstep, voffB); PG8_STAGE(PG8_SA(0, 0), cA, voffA); PG8_STAGE(PG8_SA(0, 1), cA + hstep, voffA);
        if (wr == 1) PG8_BAR;
        PG8_WAIT_V(2); PG8_BAR;
        PG8_STAGE(PG8_SB(1, 0), cB + kstep, voffB); PG8_STAGE(PG8_SA(1, 0), cA + kstep, voffA); PG8_STAGE(PG8_SB(1, 1), cB + bhstep + kstep, voffB);
        PG8_WAIT_V(6); PG8_BAR;
    } else {
        PG8_STAGE(PG8_SB(0, 0), cB, voffB); PG8_STAGE(PG8_SA(0, 0), cA, voffA); PG8_STAGE(PG8_SB(0, 1), cB + bhstep, voffB); PG8_STAGE(PG8_SA(0, 1), cA + hstep, voffA);
        if (wr == 1) PG8_BAR;
        PG8_WAIT_V(4); PG8_BAR;
        PG8_STAGE(PG8_SB(1, 0), cB + kstep, voffB); PG8_STAGE(PG8_SA(1, 0), cA + kstep, voffA); PG8_STAGE(PG8_SB(1, 1), cB + bhstep + kstep, voffB);
        PG8_WAIT_V(6); PG8_BAR;
    }
    for (;;) {
        const bool has_next = S.next(ui + 1, nxt);
        const char* nA = has_next ? (const char*)g.A + (size_t)nxt.pm * tstep : cA; const char* nB = has_next ? (const char*)g.Bt + (size_t)nxt.pn * tstep : cB;
        for (int t = 0; t < nt; t += 2) {
            const bool last = (t == nt - 2);
            const char* a1 = cA + (size_t)(t + 1) * kstep;
            const char* a2 = last ? nA : cA + (size_t)(t + 2) * kstep; const char* b2 = last ? nB : cB + (size_t)(t + 2) * kstep;
            const char* a3 = a2 + kstep; const char* b3 = b2 + kstep;
            if (last && has_next) S.a_ready(nxt);
            if constexpr (SP2) {
            PG8_LDB(B0, 0, 0); PG8_LDB(B1, 0, 1); PG8_SCHED; PG8_LDA(At, 0, 0); PG8_STAGE(PG8_SA(1, 1), a1 + hstep, voffA);
            PG8_WAIT_V(8); PG8_WAIT_L(0); PG8_BAR; PG8_MMA(0, 0, At, B0); PG8_MMA(0, 1, At, B1); PG8_BAR; PG8_SCHED;
            PG8_LDA(At, 0, 1); PG8_STAGE(PG8_SB(0, 0), b2, voffB); PG8_STAGE(PG8_SB(0, 1), b2 + bhstep, voffB); PG8_STAGE(PG8_SA(0, 0), a2, voffA);
            PG8_WAIT_V(8); PG8_WAIT_L(0); PG8_BAR; PG8_MMA(1, 0, At, B0); PG8_MMA(1, 1, At, B1); PG8_BAR; PG8_SCHED;
            PG8_LDB(B0, 1, 0); PG8_LDB(B1, 1, 1); PG8_SCHED; PG8_LDA(At, 1, 0); PG8_STAGE(PG8_SA(0, 1), a2 + hstep, voffA);
            PG8_WAIT_V(8); PG8_WAIT_L(0); PG8_BAR; PG8_MMA(0, 0, At, B0); PG8_MMA(0, 1, At, B1); PG8_BAR; PG8_SCHED;
            PG8_LDA(At, 1, 1); PG8_STAGE(PG8_SB(1, 0), b3, voffB); PG8_STAGE(PG8_SB(1, 1), b3 + bhstep, voffB); PG8_STAGE(PG8_SA(1, 0), a3, voffA);
            PG8_WAIT_V(8); PG8_WAIT_L(0); PG8_BAR; PG8_MMA(1, 0, At, B0); PG8_MMA(1, 1, At, B1); PG8_BAR; PG8_SCHED;
            } else {
            PG8_LDB(B0, 0, 0); PG8_SCHED; PG8_LDA(At, 0, 0); PG8_STAGE(PG8_SA(1, 1), a1 + hstep, voffA);
            PG8_WAIT_L(8); PG8_BAR; PG8_WAIT_L(0); PG8_MMA(0, 0, At, B0); PG8_BAR; PG8_SCHED;
            PG8_LDB(B1, 0, 1); PG8_STAGE(PG8_SB(0, 0), b2, voffB);
            PG8_BAR; PG8_WAIT_L(0); PG8_MMA(0, 1, At, B1); PG8_BAR;
            PG8_LDA(At, 0, 1); PG8_STAGE(PG8_SA(0, 0), a2, voffA);
            PG8_BAR; PG8_WAIT_L(0); PG8_MMA(1, 0, At, B0); PG8_BAR; PG8_SCHED;
            PG8_STAGE(PG8_SB(0, 1), b2 + bhstep, voffB);
            PG8_WAIT_V(6); PG8_BAR; PG8_MMA(1, 1, At, B1); PG8_BAR;
            PG8_LDB(B0, 1, 0); PG8_SCHED; PG8_LDA(At, 1, 0); PG8_STAGE(PG8_SA(0, 1), a2 + hstep, voffA);
            PG8_WAIT_L(8); PG8_BAR; PG8_WAIT_L(0); PG8_MMA(0, 0, At, B0); PG8_BAR; PG8_SCHED;
            PG8_LDB(B1, 1, 1); PG8_STAGE(PG8_SB(1, 0), b3, voffB);
            PG8_BAR; PG8_WAIT_L(0); PG8_MMA(0, 1, At, B1); PG8_BAR;
            PG8_LDA(At, 1, 1); PG8_STAGE(PG8_SA(1, 0), a3, voffA);
            PG8_BAR; PG8_WAIT_L(0); PG8_MMA(1, 0, At, B0); PG8_BAR; PG8_SCHED;
            PG8_STAGE(PG8_SB(1, 1), b3 + bhstep, voffB);
            PG8_WAIT_V(6); PG8_BAR; PG8_MMA(1, 1, At, B1); PG8_BAR;
            }
        }
        if constexpr (ALIGN_EPI) { if (wr == 0) PG8_BAR; }
        if constexpr (!Epi::AFTER_DRAIN) { E(acc, cur, wr, wc, fr, fq); S.done(cur); }
        if (!has_next) break;
#pragma unroll
        for (int a = 0; a < 2; ++a)
#pragma unroll
            for (int b = 0; b < 2; ++b)
#pragma unroll
                for (int m = 0; m < 4; ++m)
#pragma unroll
                    for (int n = 0; n < 2; ++n) acc[a][b][m][n] = (f32x4){0.f, 0.f, 0.f, 0.f};
        cur = nxt; cA = nA; cB = nB; ++ui;
        if constexpr (ALIGN_EPI) { if (wr == 1) PG8_BAR; }
    }
    PG8_WAIT_V(0);
    if constexpr (!ALIGN_EPI) { if (wr == 0) PG8_BAR; }
    PG8_BAR;
    if constexpr (Epi::AFTER_DRAIN) { E.fused(acc, cur, wr, wc, fr, fq, lds, wid, lane); S.done(cur); }
#undef PG8_SA
#undef PG8_SB
#undef PG8_STAGE
#undef PG8_LDA
#undef PG8_LDB
#undef PG8_MMA
#undef PG8_WAIT_V
#undef PG8_WAIT_L
#undef PG8_BAR
#undef PG8_SCHED
}
}
#define GAS __attribute__((address_space(1)))
#define LAS __attribute__((address_space(3)))
typedef unsigned short bf16;
typedef unsigned v4u __attribute__((ext_vector_type(4)));
typedef float f32x4 __attribute__((ext_vector_type(4)));
typedef short bf16x8 __attribute__((ext_vector_type(8)));
typedef GAS unsigned gu32;
typedef GAS unsigned long long gu64;
#define RLX_AGENT __ATOMIC_RELAXED, __HIP_MEMORY_SCOPE_AGENT
#define LDS_WAIT() asm volatile("s_waitcnt lgkmcnt(0)" ::: "memory")
#define VM_WAIT() asm volatile("s_waitcnt vmcnt(0)" ::: "memory")
__device__ __forceinline__ unsigned long long rt() { return __builtin_amdgcn_s_memrealtime(); }
__device__ __forceinline__ unsigned pk2(float lo, float hi) { return (unsigned)f2bf(lo) | ((unsigned)f2bf(hi) << 16); }

#define XB_TMO      128
#define XB_XCNT(j)  (256  + 64 * (j))
#define XB_XSUB(j)  (1280 + 64 * (j))
#define XB_XGEN(j)  (2304 + 64 * (j))
#define XB_TOP      3328
#define XB_TOPGEN   3392
#define XCD_BAR_WORDS 3456
#define XB_SPIN_CAP (1u << 18)

__device__ __forceinline__ unsigned xb_ld(unsigned* p)              { return __hip_atomic_load(p, __ATOMIC_RELAXED, __HIP_MEMORY_SCOPE_AGENT); }
__device__ __forceinline__ unsigned xb_add(unsigned* p, unsigned v) { return __hip_atomic_fetch_add(p, v, __ATOMIC_RELAXED, __HIP_MEMORY_SCOPE_AGENT); }
__device__ __forceinline__ unsigned xb_xcc_id() { return (unsigned)__builtin_amdgcn_s_getreg((3 << 11) | 20) & 0xFu; }
#define XB_SPIN(cond, bar) do { unsigned _sp = 0; while (cond) { __builtin_amdgcn_s_sleep(1); \
    if ((++_sp & 255u) == 0u) { if (xb_ld(&(bar)[XB_TMO])) break; if (_sp > XB_SPIN_CAP) { atomicAdd(&(bar)[XB_TMO], 1u); break; } } } } while (0)

struct XcdBarrier {
    unsigned* bar; unsigned x;
    volatile LAS unsigned* st;
};

__device__ __forceinline__ XcdBarrier xcd_barrier_post(unsigned* bar, volatile LAS unsigned* st) {
    XcdBarrier b; b.bar = bar; b.x = xb_xcc_id(); b.st = st;
    if (threadIdx.x == 0) (void)xb_add(&bar[XB_XCNT(b.x)], 1u);
    return b;
}
__device__ __forceinline__ void xcd_barrier_complete(unsigned* bar, unsigned x, unsigned& nloc, unsigned& nx) {
    const unsigned G = gridDim.x * gridDim.y * gridDim.z;
    unsigned sum, cnt, mine, sp = 0u;
    for (;;) {
        sum = 0u; cnt = 0u; mine = 0u;
#pragma unroll
        for (unsigned j = 0; j < 16; ++j) { const unsigned c = xb_ld(&bar[XB_XCNT(j)]); sum += c; cnt += (c > 0u) ? 1u : 0u; mine = (j == x) ? c : mine; }
        if (sum == G) break;
        __builtin_amdgcn_s_sleep(1);
        if ((++sp & 255u) == 0u) { if (xb_ld(&bar[XB_TMO])) break; if (sp > XB_SPIN_CAP) { atomicAdd(&bar[XB_TMO], 1u); break; } }
    }
    nloc = mine > 0u ? mine : 1u; nx = cnt > 0u ? cnt : 1u;
}

__device__ __forceinline__ void xcd_barrier(const XcdBarrier& b) {
    asm volatile("s_waitcnt vmcnt(0)" ::: "memory");
    __syncthreads();
    if (threadIdx.x == 0) {
        unsigned* bar = b.bar;
        __builtin_amdgcn_s_waitcnt(0);
        unsigned nloc = b.st[0], nx = b.st[1];
        if (nloc == 0u) { xcd_barrier_complete(bar, b.x, nloc, nx); b.st[0] = nloc; b.st[1] = nx; }
        const unsigned old = xb_add(&bar[XB_XSUB(b.x)], 1u);
        const unsigned gen = old / nloc;
        if (old + 1u == (gen + 1u) * nloc) {
            __builtin_amdgcn_fence(__ATOMIC_RELEASE, "agent");
            asm volatile("s_waitcnt vmcnt(0)" ::: "memory");
            const unsigned og = xb_add(&bar[XB_TOP], 1u);
            const unsigned tg = og / nx;
            if (og + 1u == (tg + 1u) * nx) xb_add(&bar[XB_TOPGEN], 1u);
            else XB_SPIN(xb_ld(&bar[XB_TOPGEN]) == tg, bar);
            __builtin_amdgcn_fence(__ATOMIC_ACQUIRE, "agent");
            xb_add(&bar[XB_XGEN(b.x)], 1u);
            asm volatile("s_waitcnt vmcnt(0)" ::: "memory");
        } else {
            XB_SPIN(xb_ld(&bar[XB_XGEN(b.x)]) == gen, bar);
            __builtin_amdgcn_fence(__ATOMIC_ACQUIRE, "agent");
            asm volatile("s_waitcnt vmcnt(0)" ::: "memory");
        }
    }
    __syncthreads();
}
constexpr size_t KiB = 1024;
constexpr size_t WS_CTL = 0, CTL_ZERO_BYTES = 1 * MiB;
constexpr size_t WS_WIN = 1 * MiB, WS_WSB = 12 * MiB, WS_WGDN = 13 * MiB, WS_WMIX = 14 * MiB, WS_WCQ = 16 * MiB, WS_WCO = 18 * MiB, WS_WCKV = 20 * MiB, WS_WPQ = 24 * MiB, WS_SKB = 28 * MiB, WS_U16 = 30 * MiB, WS_V16 = 62 * MiB;
constexpr size_t WS_RSTD0 = 94 * MiB, WS_RSTD2 = 94 * MiB + 256 * KiB, WS_CD = 94 * MiB + 384 * KiB, WS_GB = 94 * MiB + 512 * KiB;
constexpr size_t WS_MN = 96 * MiB, WS_KC = 98 * MiB, WS_VC = 100 * MiB, WS_SS = 102 * MiB;
constexpr size_t WS_A0 = 104 * MiB;
constexpr size_t WS_NW = 104 * MiB, WS_QD = 136 * MiB;
constexpr size_t WS_A1 = 168 * MiB;
constexpr size_t WS_ORAW = 168 * MiB, WS_OSS = 200 * MiB, WS_OG = 232 * MiB;
constexpr size_t WS_GZ = 264 * MiB;
constexpr size_t WS_GSB = 296 * MiB, WS_GGDN = 360 * MiB;
constexpr size_t WS_KDT = 424 * MiB, WS_QK = 456 * MiB, WS_UT = 472 * MiB;
constexpr size_t WS_U8 = 30 * MiB, WS_V8 = 46 * MiB, WS_SUV = 62 * MiB;
constexpr size_t WS_PART = 344 * MiB;
constexpr size_t WS_END = 512 * MiB;
constexpr int CW_SUB = 12288;
constexpr int CW_BAR = 4096;

constexpr int NWAVES = 8;
constexpr int RING_BYTES = 131072, LDSCTL_OFF = RING_BYTES, MISC_OFF = LDSCTL_OFF + 320, LDS_BYTES = 149504;

struct Args {
    const float *x, *mem, *g_mix, *w_in, *gdn_conv, *a_log, *dt_bias, *gdn_norm_g, *w_sb_up, *w_gdn_up, *w_mix_out, *g_cross, *g_mem, *w_cq, *w_ckv, *w_co, *g_peer, *w_pq, *subkeys, *peer_u, *peer_v, *g_final;
    float* out; unsigned char* ws; int ph_lo, ph_hi, bar_region, pad;
};

struct Frame {
    LAS unsigned char* lds; int tid, lane, wave, vcu, G;
};


typedef short bf16x8_t __attribute__((ext_vector_type(8)));
typedef float f32x16_t __attribute__((ext_vector_type(16)));
typedef short v4i16_t __attribute__((ext_vector_type(4)));
typedef float f32x2v_t __attribute__((ext_vector_type(2))); typedef __bf16 bf16x2v_t __attribute__((ext_vector_type(2)));
__device__ __forceinline__ unsigned cvtpk(float lo, float hi) { f32x2v_t v = {lo, hi}; bf16x2v_t b = __builtin_convertvector(v, bf16x2v_t); return __builtin_bit_cast(unsigned, b); }
__device__ __forceinline__ v4i16_t lds_tr16(LAS unsigned char* p) { return __builtin_amdgcn_ds_read_tr16_b64_v4i16((LAS v4i16_t*)p); }

__device__ __forceinline__ void sb_phase(LAS unsigned char* wlds  , const bf16_t* SBQ, const bf16_t* SBK, const bf16_t* SBV, bf16_t* OSB, int gw, int ngw, int lane) {
    const int q = lane & 31, hi = lane >> 5;
    bf16x8_t Mf[2];
#pragma unroll
    for (int s = 0; s < 2; ++s)
#pragma unroll
        for (int j = 0; j < 8; ++j) { const int k = 16 * s + 8 * (j >> 2) + 4 * hi + (j & 3); Mf[s][j] = (k > q) ? (short)0x3F80 : (short)0; }
    const int vrow = lane >> 3, vch = lane & 7;
    const int g4 = lane >> 4, qq = (lane >> 2) & 3, p4 = lane & 3;
    LAS unsigned char* trb = wlds + (4 * (g4 >> 1) + qq) * 192 + ((g4 & 1) * 16 + 4 * p4) * 2;
    for (int item = gw; item < 32 * 256; item += ngw) {
        const int bh = item >> 8, qt = item & 255, b = bh >> 3, h = bh & 7;
        const size_t base = (size_t)b * SEQ;
        const bf16_t* Qp = SBQ + (base + qt * 32 + q) * 512 + h * 64 + 8 * hi;
        bf16x8_t Qf[4];
#pragma unroll
        for (int ks = 0; ks < 4; ++ks) Qf[ks] = *(const bf16x8_t*)(Qp + 16 * ks);
        f32x16_t o0 = {}, o1 = {};
        float carry = 0.f;
        bf16x8_t Kn[4]; v4u vn[4];
        {   const bf16_t* Kp = SBK + (base + qt * 32 + q) * 512 + h * 64 + 8 * hi;
#pragma unroll
            for (int ks = 0; ks < 4; ++ks) Kn[ks] = *(const bf16x8_t*)(Kp + 16 * ks);
#pragma unroll
            for (int i = 0; i < 4; ++i) vn[i] = *(const v4u*)(SBV + (base + qt * 32 + vrow + 8 * i) * 512 + h * 64 + vch * 8); }
        for (int kb = qt; kb >= 0; --kb) {
            bf16x8_t Kf[4]; v4u vv[4];
#pragma unroll
            for (int ks = 0; ks < 4; ++ks) Kf[ks] = Kn[ks];
#pragma unroll
            for (int i = 0; i < 4; ++i) vv[i] = vn[i];
            {   const int kn = kb > 0 ? kb - 1 : 0;
                const bf16_t* Kp = SBK + (base + kn * 32 + q) * 512 + h * 64 + 8 * hi;
#pragma unroll
                for (int ks = 0; ks < 4; ++ks) Kn[ks] = *(const bf16x8_t*)(Kp + 16 * ks);
#pragma unroll
                for (int i = 0; i < 4; ++i) vn[i] = *(const v4u*)(SBV + (base + kn * 32 + vrow + 8 * i) * 512 + h * 64 + vch * 8); }
            f32x16_t st = {};
#pragma unroll
            for (int ks = 0; ks < 4; ++ks) st = __builtin_amdgcn_mfma_f32_32x32x16_bf16(Kf[ks], Qf[ks], st, 0, 0, 0);
#pragma unroll
            for (int i = 0; i < 4; ++i) *(LAS v4u*)(wlds + (vrow + 8 * i) * 192 + vch * 16) = vv[i];
            const bool diag = (kb == qt);
            float z[16], lk[16];
#pragma unroll
            for (int r = 0; r < 16; ++r) {
                const int key = (r & 3) + 8 * (r >> 2) + 4 * hi;
                z[r] = st[r] * 0.125f;
                const float sp = fmaxf(z[r], 0.f) + __logf(1.f + __expf(-fabsf(z[r])));
                const bool valid = !diag || key < q;
                lk[r] = valid ? -sp : 0.f;
                z[r] = valid ? z[r] - sp : -INFINITY;
            }
            bf16x8_t lh[2], ll[2];
#pragma unroll
            for (int s = 0; s < 2; ++s) {
                unsigned wh[4], wl[4];
#pragma unroll
                for (int jj = 0; jj < 4; ++jj) { const float a = lk[8 * s + 2 * jj], c = lk[8 * s + 2 * jj + 1]; wh[jj] = cvtpk(a, c);
                    wl[jj] = cvtpk(a - __uint_as_float(wh[jj] << 16), c - __uint_as_float(wh[jj] & 0xffff0000u)); }
                lh[s] = __builtin_bit_cast(bf16x8_t, (v4u){wh[0], wh[1], wh[2], wh[3]}); ll[s] = __builtin_bit_cast(bf16x8_t, (v4u){wl[0], wl[1], wl[2], wl[3]});
            }
            f32x16_t af;
#pragma unroll
            for (int r = 0; r < 16; ++r) af[r] = carry;
            af = __builtin_amdgcn_mfma_f32_32x32x16_bf16(Mf[0], lh[0], af, 0, 0, 0);
            af = __builtin_amdgcn_mfma_f32_32x32x16_bf16(Mf[1], lh[1], af, 0, 0, 0);
            af = __builtin_amdgcn_mfma_f32_32x32x16_bf16(Mf[0], ll[0], af, 0, 0, 0);
            af = __builtin_amdgcn_mfma_f32_32x32x16_bf16(Mf[1], ll[1], af, 0, 0, 0);
            float tot = af[0] + lk[0];
            tot = __shfl(tot, q);
            float pr[16];
#pragma unroll
            for (int r = 0; r < 16; ++r) pr[r] = __expf(z[r] + af[r]);
            bf16x8_t pa[2];
#pragma unroll
            for (int s = 0; s < 2; ++s) pa[s] = __builtin_bit_cast(bf16x8_t, (v4u){cvtpk(pr[8 * s], pr[8 * s + 1]), cvtpk(pr[8 * s + 2], pr[8 * s + 3]), cvtpk(pr[8 * s + 4], pr[8 * s + 5]), cvtpk(pr[8 * s + 6], pr[8 * s + 7])});
            asm volatile("s_waitcnt lgkmcnt(0)" ::: "memory");
#pragma unroll
            for (int s = 0; s < 2; ++s) {
                const v4i16_t a0 = lds_tr16(trb + (16 * s) * 192), a1 = lds_tr16(trb + (16 * s + 8) * 192);
                const v4i16_t c0 = lds_tr16(trb + (16 * s) * 192 + 64), c1 = lds_tr16(trb + (16 * s + 8) * 192 + 64);
                const bf16x8_t vb0 = {a0[0], a0[1], a0[2], a0[3], a1[0], a1[1], a1[2], a1[3]}, vb1 = {c0[0], c0[1], c0[2], c0[3], c1[0], c1[1], c1[2], c1[3]};
                o0 = __builtin_amdgcn_mfma_f32_32x32x16_bf16(pa[s], vb0, o0, 0, 0, 0);
                o1 = __builtin_amdgcn_mfma_f32_32x32x16_bf16(pa[s], vb1, o1, 0, 0, 0);
            }
            carry = tot;
            if (__all(carry < -104.f)) break;
        }
        bf16_t* Op = OSB + (base + qt * 32) * 512 + h * 64 + q;
#pragma unroll
        for (int r = 0; r < 16; ++r) { const int row = (r & 3) + 8 * (r >> 2) + 4 * hi; Op[(size_t)row * 512] = f2bf(o0[r]); Op[(size_t)row * 512 + 32] = f2bf(o1[r]); }
    }
}
typedef float f32x4_t __attribute__((ext_vector_type(4)));
typedef unsigned v2u __attribute__((ext_vector_type(2)));
__device__ __forceinline__ float bflo(unsigned w) { return __uint_as_float(w << 16); }
__device__ __forceinline__ float bfhi(unsigned w) { return __uint_as_float(w & 0xffff0000u); }
__device__ __forceinline__ int frag_off(int r, int k0, int KS) { return (((r >> 4) * KS + (k0 >> 5)) << 9) + (((r & 15) + 16 * ((k0 & 15) >> 2)) << 3) + (((k0 & 31) >> 4) << 2); }

constexpr int GP_KS = 0, GP_QS = 17408, GP_VS = 34816, GP_AS = 52224, GP_WT = 69632, GP_GC = 87040, GP_BETA = 87296, GP_EGC = 87552, GP_CW = 88064, GP_TS = 94208;
constexpr int GROW = 136;

#define LDS_BARRIER() do { asm volatile("s_waitcnt lgkmcnt(0)" ::: "memory"); __builtin_amdgcn_s_barrier(); asm volatile("" ::: "memory"); } while (0)
struct GdnBufs { bf16_t *NW, *QD, *KDT, *QK, *UT; float* CD; bf16_t* ORAW; float* OSS; };

__device__ __forceinline__ void gdn_prep_phase(Frame& F, const Args& a, const bf16_t* GQKV, const float* GB, const float* GA, const GdnBufs& Gb) {
    LAS unsigned char* L = F.lds;
    LAS bf16_t* KS = (LAS bf16_t*)(L + GP_KS); LAS bf16_t* QS = (LAS bf16_t*)(L + GP_QS); LAS bf16_t* VS = (LAS bf16_t*)(L + GP_VS); LAS bf16_t* WT = (LAS bf16_t*)(L + GP_WT);
    LAS float* AS = (LAS float*)(L + GP_AS); LAS float* GC = (LAS float*)(L + GP_GC); LAS float* BETA = (LAS float*)(L + GP_BETA); LAS float* EGC = (LAS float*)(L + GP_EGC); LAS float* CW = (LAS float*)(L + GP_CW); LAS float* TS = (LAS float*)(L + GP_TS);
    const int tid = F.tid, lane = F.lane, wave = F.wave;
    const int per = (2048 + F.G - 1) / F.G;
    int hcur = -1;
    for (int ii = 0; ii < per; ++ii) {
        const int item = F.vcu * per + ii; if (item >= 2048) break;
        const int bh = item >> 7, n = item & 127, b = bh >> 2, h = bh & 3;
        const size_t t0 = (size_t)b * SEQ + n * 64;
        if (h != hcur) { hcur = h; for (int i = tid; i < 1536; i += NWAVES * 64) { const int j = i / 384, cc = i % 384; CW[i] = a.gdn_conv[j * 1536 + (cc >> 7) * 512 + h * 128 + (cc & 127)]; } }
        unsigned pf = 0u;
        if (ii + 1 < per && item + 1 < 2048 && tid < 384) {
            const int r = tid / 6, q6 = tid % 6; const int item2 = item + 1, bh2 = item2 >> 7, n2 = item2 & 127;
            pf = *(const unsigned*)(GQKV + ((size_t)(bh2 >> 2) * SEQ + n2 * 64 + r) * 1536 + (q6 >> 1) * 512 + (bh2 & 3) * 128 + (q6 & 1) * 64);
        }
        if (wave == 0) {
            const size_t t = t0 + lane;
            float g = -__expf(a.a_log[h]) * softplusf_(GA[t * 4 + h] + a.dt_bias[h]);
#pragma unroll
            for (int o = 1; o < 64; o <<= 1) { const float up = __shfl_up(g, o); if (lane >= o) g += up; }
            GC[lane] = g; BETA[lane] = sigmoidf_(GB[t * 4 + h]); EGC[lane] = __expf(g);
            if (lane == 63) Gb.CD[item] = __expf(g);
        }
        LDS_BARRIER();
        {
            const int c = tid >> 3, d0 = (tid & 7) * 16;
#pragma unroll
            for (int part = 0; part < 3; ++part) {
                float acc[16];
#pragma unroll
                for (int i = 0; i < 16; ++i) acc[i] = 0.f;
#pragma unroll
                for (int j = 0; j < 4; ++j) {
                    if (n * 64 + c - 3 + j >= 0) {
                        const bf16_t* src = GQKV + (t0 + c - 3 + j) * 1536 + part * 512 + h * 128 + d0;
                        const v4u r0 = *(const v4u*)src, r1 = *(const v4u*)(src + 8);
                        const unsigned rw[8] = {r0.x, r0.y, r0.z, r0.w, r1.x, r1.y, r1.z, r1.w};
                        const LAS float* cw = CW + j * 384 + part * 128 + d0;
#pragma unroll
                        for (int i = 0; i < 8; ++i) { acc[2 * i] += bflo(rw[i]) * cw[2 * i]; acc[2 * i + 1] += bfhi(rw[i]) * cw[2 * i + 1]; }
                    }
                }
                float ss = 0.f;
#pragma unroll
                for (int i = 0; i < 16; ++i) { acc[i] = acc[i] / (1.f + __expf(-acc[i])); ss += acc[i] * acc[i]; }
                if (part < 2) { ss += __shfl_xor(ss, 1); ss += __shfl_xor(ss, 2); ss += __shfl_xor(ss, 4); const float inv = rsqrtf(ss + EPS);
#pragma unroll
                    for (int i = 0; i < 16; ++i) acc[i] *= inv; }
                LAS bf16_t* dst = (part == 0 ? QS : part == 1 ? KS : VS) + c * GROW + d0;
                v4u w0, w1; w0.x = cvtpk(acc[0], acc[1]); w0.y = cvtpk(acc[2], acc[3]); w0.z = cvtpk(acc[4], acc[5]); w0.w = cvtpk(acc[6], acc[7]);
                w1.x = cvtpk(acc[8], acc[9]); w1.y = cvtpk(acc[10], acc[11]); w1.z = cvtpk(acc[12], acc[13]); w1.w = cvtpk(acc[14], acc[15]);
                *(LAS v4u*)dst = w0; *(LAS v4u*)(dst + 8) = w1;
            }
        }
        LDS_BARRIER();
        {
            const int fr = lane & 15, g = lane >> 4;
            for (int task = wave; task < 26; task += NWAVES) {
                const bool isKK = task < 10; int ct, mt;
                if (isKK) { ct = task >= 6 ? 3 : task >= 3 ? 2 : task >= 1 ? 1 : 0; mt = task - ct * (ct + 1) / 2; } else { ct = (task - 10) >> 2; mt = (task - 10) & 3; }
                f32x4_t acc = {0.f, 0.f, 0.f, 0.f};
                if (mt <= ct) {
                    const LAS bf16_t* Ap = KS + (mt * 16 + fr) * GROW + 8 * g; const LAS bf16_t* Bp = (isKK ? KS : QS) + (ct * 16 + fr) * GROW + 8 * g;
#pragma unroll
                    for (int ks = 0; ks < 4; ++ks) acc = __builtin_amdgcn_mfma_f32_16x16x32_bf16(*(const LAS bf16x8_t*)(Ap + 32 * ks), *(const LAS bf16x8_t*)(Bp + 32 * ks), acc, 0, 0, 0);
                }
                const int c = ct * 16 + fr, m0 = mt * 16 + 4 * g; const float gcc = GC[c];
                float v[4];
#pragma unroll
                for (int r = 0; r < 4; ++r) { const int m = m0 + r; const float dec = __expf(fminf(gcc - GC[m], 0.f)); v[r] = acc[r] * dec; }
                if (isKK) { const float bc = BETA[c];
                    f32x4_t o;
#pragma unroll
                    for (int r = 0; r < 4; ++r) o[r] = (c > m0 + r) ? v[r] * bc : 0.f;
                    *(LAS f32x4_t*)(AS + c * 68 + m0) = o;
                } else {
#pragma unroll
                    for (int r = 0; r < 4; ++r) v[r] = (c >= m0 + r) ? v[r] * 0.08838834764831845f : 0.f;
                    v2u w; w.x = cvtpk(v[0], v[1]); w.y = cvtpk(v[2], v[3]);
                    *(v2u*)(Gb.QK + (size_t)item * 4096 + (ct * 2 + (mt >> 1)) * 512 + lane * 8 + (mt & 1) * 4) = w;
                }
            }
        }
        LDS_BARRIER();
        if (wave == 0) {
            const int q4 = lane >> 4, c = lane & 15; const LAS float* Ab = AS + (16 * q4) * 68 + 16 * q4;
            float t[16];
#pragma unroll
            for (int r = 0; r < 16; ++r) { float s = (r == c) ? 1.f : 0.f;
#pragma unroll
                for (int j4 = 0; j4 < (r + 3) / 4; ++j4) { const f32x4_t av = *(const LAS f32x4_t*)(Ab + r * 68 + 4 * j4);
#pragma unroll
                    for (int i = 0; i < 4; ++i) if (4 * j4 + i < r) s -= av[i] * t[4 * j4 + i]; }
                t[r] = s; TS[(q4 * 16 + r) * 20 + c] = (r == c) ? 0.f : s; }
        }
        LDS_BARRIER();
        {
            const int fr = lane & 15, g = lane >> 4;
#pragma unroll
            for (int cc = 0; cc < 2; ++cc) {
                const int ct2 = wave * 2 + cc; const bool isW = ct2 >= 8; const int col = (ct2 & 7) * 16 + fr;
                const LAS bf16_t* src = (isW ? KS : VS) + col;
                unsigned xb[4][2];
#pragma unroll
                for (int i = 0; i < 4; ++i) {
                    f32x4_t y;
#pragma unroll
                    for (int r = 0; r < 4; ++r) { const int row = 16 * i + 4 * g + r; float v = bf2f(src[row * GROW]) * BETA[row]; if (isW) v *= EGC[row]; y[r] = v; }
#pragma unroll
                    for (int j = 0; j < i; j += 2) {
                        const LAS float* ap = AS + (16 * i + fr) * 68 + 16 * j + 4 * g;
                        const f32x4_t a0 = *(const LAS f32x4_t*)ap; f32x4_t a1 = {0.f, 0.f, 0.f, 0.f}; if (j + 1 < i) a1 = *(const LAS f32x4_t*)(ap + 16);
                        const bf16x8_t af = __builtin_bit_cast(bf16x8_t, (v4u){cvtpk(-a0[0], -a0[1]), cvtpk(-a0[2], -a0[3]), cvtpk(-a1[0], -a1[1]), cvtpk(-a1[2], -a1[3])});
                        const bf16x8_t bfr = __builtin_bit_cast(bf16x8_t, (v4u){xb[j][0], xb[j][1], (j + 1 < i) ? xb[j + 1][0] : 0u, (j + 1 < i) ? xb[j + 1][1] : 0u});
                        y = __builtin_amdgcn_mfma_f32_16x16x32_bf16(af, bfr, y, 0, 0, 0);
                    }
                    const f32x4_t tv = *(const LAS f32x4_t*)(TS + (i * 16 + fr) * 20 + 4 * g);
                    const bf16x8_t tf = __builtin_bit_cast(bf16x8_t, (v4u){cvtpk(tv[0], tv[1]), cvtpk(tv[2], tv[3]), 0u, 0u});
                    const bf16x8_t yf = __builtin_bit_cast(bf16x8_t, (v4u){cvtpk(y[0], y[1]), cvtpk(y[2], y[3]), 0u, 0u});
                    const f32x4_t x = __builtin_amdgcn_mfma_f32_16x16x32_bf16(tf, yf, y, 0, 0, 0);
                    xb[i][0] = cvtpk(x[0], x[1]); xb[i][1] = cvtpk(x[2], x[3]);
                    if (!isW) { *(v2u*)(Gb.UT + (size_t)item * 8192 + col * 64 + 16 * i + 4 * g) = (v2u){xb[i][0], xb[i][1]}; }
                    else {
#pragma unroll
                        for (int r = 0; r < 4; ++r) WT[(16 * i + 4 * g + r) * GROW + col] = f2bf(-x[r]); }
                }
            }
        }
        {
            const float glast = GC[63];
#pragma unroll
            for (int i = 0; i < 4; ++i) { const int p = tid + 512 * i, c = p >> 5, d0 = (p & 31) * 4; const v2u r = *(const LAS v2u*)(QS + c * GROW + d0); const float sc = EGC[c] * 0.08838834764831845f;
                v2u w; w.x = cvtpk(bflo(r.x) * sc, bfhi(r.x) * sc); w.y = cvtpk(bflo(r.y) * sc, bfhi(r.y) * sc);
                *(v2u*)(Gb.QD + (size_t)item * 8192 + frag_off(c, d0, 4)) = w; }
#pragma unroll
            for (int i = 0; i < 4; ++i) { const int p = tid + 512 * i, d = p >> 4, c0 = (p & 15) * 4; float v[4];
#pragma unroll
                for (int r = 0; r < 4; ++r) v[r] = bf2f(KS[(c0 + r) * GROW + d]) * __expf(glast - GC[c0 + r]);
                v2u w; w.x = cvtpk(v[0], v[1]); w.y = cvtpk(v[2], v[3]);
                *(v2u*)(Gb.KDT + (size_t)item * 8192 + frag_off(d, c0, 2)) = w; }
        }
        LDS_BARRIER();
#pragma unroll
        for (int i = 0; i < 4; ++i) { const int p = tid + 512 * i, c = p >> 5, d0 = (p & 31) * 4; const v2u r = *(const LAS v2u*)(WT + c * GROW + d0);
            *(v2u*)(Gb.NW + (size_t)item * 8192 + frag_off(c, d0, 4)) = r; }
        asm volatile("" :: "v"(pf));
        LDS_BARRIER();
    }
}

__device__ __forceinline__ void gdn_scan_unit(Frame& F, int s, const GdnBufs& Gb) {
    const int bh = s >> 2, half = s & 3, h = bh & 3, b = bh >> 2;
    const int tid = F.tid, lane = F.lane, wave = F.wave, fr = lane & 15, g = lane >> 4;
    LAS unsigned char* L = F.lds;
    const size_t tb = (size_t)b * SEQ;
    const int item0 = bh * 128;
    const int lt = tid - 256;
#define GDN_SRC(it, i) ((i) < 4 ? (const v4u*)(Gb.NW + (size_t)(it) * 8192) + lt + 256 * (i) : (i) < 8 ? (const v4u*)(Gb.QD + (size_t)(it) * 8192) + lt + 256 * ((i) - 4) : \
                        (i) < 12 ? (const v4u*)(Gb.KDT + (size_t)(it) * 8192) + lt + 256 * ((i) - 8) : (i) < 14 ? (const v4u*)(Gb.QK + (size_t)(it) * 4096) + lt + 256 * ((i) - 12) : \
                        (const v4u*)(Gb.UT + (size_t)(it) * 8192 + half * 2048) + lt + 256 * ((i) - 14))
#define GDN_LOADR(R, it) do { _Pragma("unroll") for (int i_ = 0; i_ < 15; ++i_) R[i_] = *GDN_SRC(it, i_); } while (0)
#define GDN_STORER(R, bufp) do { _Pragma("unroll") for (int i_ = 0; i_ < 15; ++i_) *(LAS v4u*)((bufp) + (i_ * 256 + lt) * 16) = R[i_]; } while (0)
    LAS float* CDL = (LAS float*)(L + 131072 + 1024);
    LAS bf16_t* OTB = (LAS bf16_t*)(L + 131072 + 2048);
#define GDN_OSTORE(step) do { if (wave < 6 && (step) < 128) { const LAS bf16_t* ot_ = OTB + ((wave - 4) * 2 + ((step) & 1)) * 1024; \
        const v4u o0_ = *(const LAS v4u*)(ot_ + lane * 16), o1_ = *(const LAS v4u*)(ot_ + lane * 16 + 8); \
        bf16_t* dst_ = Gb.ORAW + (tb + (size_t)(step) * 64 + lane) * 512 + h * 128 + half * 32 + (wave - 4) * 16; *(v4u*)dst_ = o0_; *(v4u*)(dst_ + 8) = o1_; } } while (0)
    if (wave >= 4) {
        if (wave == 4) { CDL[lane] = Gb.CD[item0 + lane]; CDL[64 + lane] = Gb.CD[item0 + 64 + lane]; }
        v4u r0[15], r1[15], r2[15];
        GDN_LOADR(r0, item0); GDN_LOADR(r1, item0 + 1); GDN_LOADR(r2, item0 + 2);
        GDN_STORER(r0, L);
        LDS_BARRIER();
#define GDN_CL(k) (item0 + ((k) < 127 ? (k) : 127))
        for (int n = 0; n < 129; n += 3) {
            GDN_LOADR(r0, GDN_CL(n + 3)); GDN_STORER(r1, L + ((n + 1) & 1) * 65536); LDS_BARRIER(); GDN_OSTORE(n);
            GDN_LOADR(r1, GDN_CL(n + 4)); GDN_STORER(r2, L + ((n + 2) & 1) * 65536); LDS_BARRIER(); GDN_OSTORE(n + 1);
            GDN_LOADR(r2, GDN_CL(n + 5)); GDN_STORER(r0, L + ((n + 3) & 1) * 65536); LDS_BARRIER(); GDN_OSTORE(n + 2);
        }
#undef GDN_CL
    } else if (wave >= 2) {
        for (int n = 0; n < 130; ++n) LDS_BARRIER();
    } else {
        LDS_BARRIER();
        f32x4_t S[8];
#pragma unroll
        for (int i = 0; i < 8; ++i) S[i] = (f32x4_t){0.f, 0.f, 0.f, 0.f};
        for (int n = 0; n < 128; ++n) {
            LAS unsigned char* B = L + (n & 1) * 65536;
            const float cd = CDL[n];
            bf16x8_t sb[4];
#pragma unroll
            for (int ks = 0; ks < 4; ++ks) sb[ks] = __builtin_bit_cast(bf16x8_t, (v4u){cvtpk(S[2 * ks][0], S[2 * ks][1]), cvtpk(S[2 * ks][2], S[2 * ks][3]), cvtpk(S[2 * ks + 1][0], S[2 * ks + 1][1]), cvtpk(S[2 * ks + 1][2], S[2 * ks + 1][3])});
#define GDN_SB() __builtin_amdgcn_sched_barrier(0)
            const LAS unsigned char* Bl = B + lane * 16;
            v2u u8[4]; bf16x8_t fa[16], fb[16];
#pragma unroll
            for (int rt = 0; rt < 4; ++rt) u8[rt] = *(const LAS v2u*)(B + 57344 + ((wave * 16 + fr) * 64 + 16 * rt + 4 * g) * 2);
#pragma unroll
            for (int i = 0; i < 16; ++i) fa[i] = *(const LAS bf16x8_t*)(Bl + ((i & 3) * 4 + (i >> 2)) * 1024);
            GDN_SB();
#pragma unroll
            for (int i = 0; i < 16; ++i) fb[i] = *(const LAS bf16x8_t*)(Bl + 16384 + ((i & 3) * 4 + (i >> 2)) * 1024);
            GDN_SB();
            f32x4_t va[4], oa[4];
#pragma unroll
            for (int rt = 0; rt < 4; ++rt) { va[rt] = (f32x4_t){bflo(u8[rt].x), bfhi(u8[rt].x), bflo(u8[rt].y), bfhi(u8[rt].y)}; oa[rt] = (f32x4_t){0.f, 0.f, 0.f, 0.f}; }
#pragma unroll
            for (int i = 0; i < 16; ++i) va[i & 3] = __builtin_amdgcn_mfma_f32_16x16x32_bf16(fa[i], sb[i >> 2], va[i & 3], 0, 0, 0);
            GDN_SB();
#pragma unroll
            for (int i = 0; i < 8; ++i) fa[i] = *(const LAS bf16x8_t*)(Bl + 49152 + ((i & 3) * 2 + (i >> 2)) * 1024);
#pragma unroll
            for (int i = 0; i < 8; ++i) fa[8 + i] = *(const LAS bf16x8_t*)(Bl + 32768 + ((i & 3) * 2 + (i >> 2)) * 1024);
            GDN_SB();
#pragma unroll
            for (int i = 0; i < 16; ++i) oa[i & 3] = __builtin_amdgcn_mfma_f32_16x16x32_bf16(fb[i], sb[i >> 2], oa[i & 3], 0, 0, 0);
            bf16x8_t vb[2];
#pragma unroll
            for (int k2 = 0; k2 < 2; ++k2) vb[k2] = __builtin_bit_cast(bf16x8_t, (v4u){cvtpk(va[2 * k2][0], va[2 * k2][1]), cvtpk(va[2 * k2][2], va[2 * k2][3]), cvtpk(va[2 * k2 + 1][0], va[2 * k2 + 1][1]), cvtpk(va[2 * k2 + 1][2], va[2 * k2 + 1][3])});
#pragma unroll
            for (int dt = 0; dt < 8; ++dt) S[dt] = S[dt] * cd;
            GDN_SB();
#pragma unroll
            for (int i = 0; i < 8; ++i) fb[i] = *(const LAS bf16x8_t*)(Bl + 32768 + 8192 + ((i & 3) * 2 + (i >> 2)) * 1024);
            GDN_SB();
#pragma unroll
            for (int i = 0; i < 8; ++i) oa[i & 3] = __builtin_amdgcn_mfma_f32_16x16x32_bf16(fa[i], vb[i >> 2], oa[i & 3], 0, 0, 0);
#pragma unroll
            for (int i = 0; i < 8; ++i) S[i & 3] = __builtin_amdgcn_mfma_f32_16x16x32_bf16(fa[8 + i], vb[i >> 2], S[i & 3], 0, 0, 0);
            GDN_SB();
#pragma unroll
            for (int i = 0; i < 8; ++i) S[4 + (i & 3)] = __builtin_amdgcn_mfma_f32_16x16x32_bf16(fb[i], vb[i >> 2], S[4 + (i & 3)], 0, 0, 0);
            GDN_SB();
#undef GDN_SB
            { LAS bf16_t* OT = OTB + (wave * 2 + (n & 1)) * 1024;
#pragma unroll
              for (int rt = 0; rt < 4; ++rt)
#pragma unroll
                for (int r = 0; r < 4; ++r) OT[(16 * rt + 4 * g + r) * 16 + fr] = f2bf(oa[rt][r]); }
            LDS_BARRIER();
        }
        LDS_BARRIER();
    }
#undef GDN_SRC
#undef GDN_LOADR
#undef GDN_OSTORE
#undef GDN_STORER
}

__device__ __forceinline__ void gdn_finish_phase(Frame& F, const Args& a, const GdnBufs& Gb, const bf16_t* GZ, bf16_t* OG) {
    const int gt = F.vcu * NWAVES * 64 + F.tid, ngt = F.G * NWAVES * 64;
    for (int p = gt; p < T * 64; p += ngt) {
        const size_t t = (size_t)(p >> 6); const int col = (p & 63) * 8, e0 = col & 127;
        const v4u o = *(const v4u*)(Gb.ORAW + t * 512 + col), z = *(const v4u*)(GZ + t * 512 + col);
        const unsigned ow[4] = {o.x, o.y, o.z, o.w}, zw[4] = {z.x, z.y, z.z, z.w};
        float ss = 0.f;
#pragma unroll
        for (int i = 0; i < 4; ++i) { const float a0 = bflo(ow[i]), a1 = bfhi(ow[i]); ss += a0 * a0 + a1 * a1; }
        ss += __shfl_xor(ss, 1); ss += __shfl_xor(ss, 2); ss += __shfl_xor(ss, 4); ss += __shfl_xor(ss, 8);
        const float rinv = rsqrtf(ss * (1.f / 128.f) + EPS);
        const f32x4_t g0 = *(const f32x4_t*)(a.gdn_norm_g + e0), g1 = *(const f32x4_t*)(a.gdn_norm_g + e0 + 4);
        const float gg[8] = {g0[0], g0[1], g0[2], g0[3], g1[0], g1[1], g1[2], g1[3]};
        unsigned r[4];
#pragma unroll
        for (int i = 0; i < 4; ++i) { const float z0 = bflo(zw[i]), z1 = bfhi(zw[i]);
            r[i] = cvtpk(bflo(ow[i]) * rinv * gg[2 * i] * (z0 / (1.f + __expf(-z0))), bfhi(ow[i]) * rinv * gg[2 * i + 1] * (z1 / (1.f + __expf(-z1)))); }
        *(v4u*)(OG + t * 512 + col) = (v4u){r[0], r[1], r[2], r[3]};
    }
}
typedef float f32x2_t __attribute__((ext_vector_type(2)));
__device__ __forceinline__ float gelu_erf(float v) { return 0.5f * v * (1.f + erff(v * 0.70710678118654752f)); }
constexpr int PEER_CH = 16;
constexpr int CW_PEERU = 8192, CW_PEERV = 8192 + 1024;

#define PEER_SHUF(EN, R0, R1) do { _Pragma("unroll") for (int i = 0; i < 16; ++i) EN[i] = __shfl(i < 8 ? (R0) : (R1), 8 * (i & 7) + g); } while (0)
#define PEER_U_COMPUTE(W, TOK, XR0, XR1, RS) do { const size_t t_ = (TOK); const float rs = (RS); \
        const unsigned xw[8] = {XR0.x, XR0.y, XR0.z, XR0.w, XR1.x, XR1.y, XR1.z, XR1.w}; f32x2_t xf[8]; \
        _Pragma("unroll") for (int q = 0; q < 8; ++q) { xf[q].x = bflo(xw[q]) * rs * gp[q >> 1][(q & 1) * 2]; xf[q].y = bfhi(xw[q]) * rs * gp[q >> 1][(q & 1) * 2 + 1]; } \
        float p[16]; \
        _Pragma("unroll") for (int i = 0; i < 16; ++i) { const unsigned ww[4] = {W[i].x, W[i].y, W[i].z, W[i].w}; f32x2_t acc = {0.f, 0.f}; \
            _Pragma("unroll") for (int q = 0; q < 4; ++q) { acc = __builtin_elementwise_fma(__builtin_amdgcn_cvt_pk_f32_fp8(ww[q], false), xf[2 * q], acc); acc = __builtin_elementwise_fma(__builtin_amdgcn_cvt_pk_f32_fp8(ww[q], true), xf[2 * q + 1], acc); } \
            p[i] = acc.x + acc.y; } \
        _Pragma("unroll") for (int off = 4; off >= 1; off >>= 1) { const bool up = (j & off) != 0; \
            _Pragma("unroll") for (int i = 0; i < 2 * off; ++i) { const float lo = p[i], hi = p[i + 2 * off]; const float send = up ? lo : hi, keep = up ? hi : lo; p[i] = keep + __shfl_xor(send, off); } } \
        bf16_t* dst = PART + ((size_t)x * T + t_) * 128 + 16 * j + g; dst[0] = f2bf(p[0]); dst[8] = f2bf(p[1]); } while (0)
__device__ __forceinline__ void peer_u_phase(Frame& F, const Args& a, gu32* ctl, const bf16_t* X2B, const float* rstd2, const int* EIDX, const unsigned char* U8, bf16_t* PART) {
    const int lane = F.lane, g = lane >> 3, j = lane & 7;
    const int x0 = (int)(xb_xcc_id() & 7u);
    for (int s = 0; s < 8; ++s) {
        const int x = (x0 + s) & 7;
        f32x4_t gp[4];
#pragma unroll
        for (int q = 0; q < 4; ++q) gp[q] = *(const f32x4_t*)(a.g_peer + 128 * x + 16 * j + 4 * q);
        const unsigned char* Ux = U8 + (size_t)x * 16384 * 128 + 16 * j;
        const bf16_t* Xx = X2B + 128 * x + 16 * j;
        for (;;) {
            int c = 0; if (lane == 0) c = (int)__hip_atomic_fetch_add(ctl + CW_PEERU + 64 * x, 1u, __ATOMIC_RELAXED, __HIP_MEMORY_SCOPE_AGENT);
            c = __builtin_amdgcn_readfirstlane(c);
            if (c >= T / PEER_CH) break;
            const size_t tc = (size_t)c * PEER_CH, tl = tc + PEER_CH - 1;
            int en[16]; v4u wa[16], wb[16];
            int er0 = EIDX[tc * 128 + lane], er1 = EIDX[tc * 128 + 64 + lane];
            v4u xa0 = *(const v4u*)(Xx + tc * 1024), xa1 = *(const v4u*)(Xx + tc * 1024 + 8), xb0, xb1; float rsa = rstd2[tc], rsb;
            PEER_SHUF(en, er0, er1);
#pragma unroll
            for (int i = 0; i < 16; ++i) wa[i] = *(const v4u*)(Ux + (size_t)en[i] * 128);
            er0 = EIDX[(tc + 1) * 128 + lane]; er1 = EIDX[(tc + 1) * 128 + 64 + lane];
            for (int tt = 0; tt < PEER_CH; tt += 2) {
                const size_t t = tc + tt, t2 = (t + 2 < tl) ? t + 2 : tl, t3 = (t + 3 < tl) ? t + 3 : tl;
                PEER_SHUF(en, er0, er1);
#pragma unroll
                for (int i = 0; i < 16; ++i) wb[i] = *(const v4u*)(Ux + (size_t)en[i] * 128);
                er0 = EIDX[t2 * 128 + lane]; er1 = EIDX[t2 * 128 + 64 + lane];
                xb0 = *(const v4u*)(Xx + (t + 1) * 1024); xb1 = *(const v4u*)(Xx + (t + 1) * 1024 + 8); rsb = rstd2[t + 1];
                PEER_U_COMPUTE(wa, t, xa0, xa1, rsa);
                PEER_SHUF(en, er0, er1);
#pragma unroll
                for (int i = 0; i < 16; ++i) wa[i] = *(const v4u*)(Ux + (size_t)en[i] * 128);
                er0 = EIDX[t3 * 128 + lane]; er1 = EIDX[t3 * 128 + 64 + lane];
                xa0 = *(const v4u*)(Xx + t2 * 1024); xa1 = *(const v4u*)(Xx + t2 * 1024 + 8); rsa = rstd2[t2];
                PEER_U_COMPUTE(wb, t + 1, xb0, xb1, rsb);
            }
        }
    }
}
__device__ __forceinline__ void peer_combine_phase(Frame& F, const bf16_t* PART, const int* EIDX, const float* EGATE, const float* SU, const float* SV, float* ACTS) {
    const int gt = F.vcu * NWAVES * 64 + F.tid, ngt = F.G * NWAVES * 64;
    for (int p = gt; p < T * 32; p += ngt) {
        f32x4_t s = {0.f, 0.f, 0.f, 0.f};
#pragma unroll
        for (int x = 0; x < 8; ++x) { const v2u w = *(const v2u*)(PART + (size_t)x * T * 128 + (size_t)p * 4); s += (f32x4_t){bflo(w.x), bfhi(w.x), bflo(w.y), bfhi(w.y)}; }
        const int4 e = *(const int4*)(EIDX + (size_t)p * 4); const f32x4_t gt4 = *(const f32x4_t*)(EGATE + (size_t)p * 4);
        *(f32x4_t*)(ACTS + (size_t)p * 4) = (f32x4_t){gelu_erf(s[0] * SU[e.x]) * gt4[0] * SV[e.x], gelu_erf(s[1] * SU[e.y]) * gt4[1] * SV[e.y], gelu_erf(s[2] * SU[e.z]) * gt4[2] * SV[e.z], gelu_erf(s[3] * SU[e.w]) * gt4[3] * SV[e.w]};
    }
}
#define PEER_V_COMPUTE(W, TOK, A0R, A1R, XWR) do { const size_t t_ = (TOK); float av[16]; \
        _Pragma("unroll") for (int i = 0; i < 16; ++i) av[i] = __shfl(i < 8 ? (A0R) : (A1R), 8 * (i & 7) + g); \
        const size_t oo_ = t_ * 1024 + 128 * x + 16 * j + 2 * g; const unsigned xw_ = (XWR); const f32x2_t xv = {bflo(xw_), bfhi(xw_)}; \
        f32x2_t o2[8]; _Pragma("unroll") for (int q = 0; q < 8; ++q) o2[q] = (f32x2_t){0.f, 0.f}; \
        _Pragma("unroll") for (int i = 0; i < 16; ++i) { const unsigned ww[4] = {W[i].x, W[i].y, W[i].z, W[i].w}; const f32x2_t a2 = {av[i], av[i]}; \
            _Pragma("unroll") for (int q = 0; q < 4; ++q) { o2[2 * q] = __builtin_elementwise_fma(__builtin_amdgcn_cvt_pk_f32_fp8(ww[q], false), a2, o2[2 * q]); o2[2 * q + 1] = __builtin_elementwise_fma(__builtin_amdgcn_cvt_pk_f32_fp8(ww[q], true), a2, o2[2 * q + 1]); } } \
        float o[16]; _Pragma("unroll") for (int q = 0; q < 8; ++q) { o[2 * q] = o2[q].x; o[2 * q + 1] = o2[q].y; } \
        _Pragma("unroll") for (int off = 4; off >= 1; off >>= 1) { const bool up = (g & off) != 0; \
            _Pragma("unroll") for (int i = 0; i < 2 * off; ++i) { const float lo = o[i], hi = o[i + 2 * off]; const float send = up ? lo : hi, keep = up ? hi : lo; o[i] = keep + __shfl_xor(send, 8 * off); } } \
        const unsigned rw_ = cvtpk(xv.x + o[0], xv.y + o[1]); *(unsigned*)(X3B + oo_) = rw_; const float r0 = bflo(rw_), r1 = bfhi(rw_); \
        const float ss = wave_sum(r0 * r0 + r1 * r1); if (lane == 0) SS3[t_ * 8 + x] = ss; } while (0)
__device__ __forceinline__ void peer_v_phase(Frame& F, gu32* ctl, const int* EIDX, const float* ACTS, const unsigned char* V8, const bf16_t* X2B, bf16_t* X3B, float* SS3) {
    const int lane = F.lane, g = lane >> 3, j = lane & 7;
    const int x0 = (int)(xb_xcc_id() & 7u);
    for (int s = 0; s < 8; ++s) {
        const int x = (x0 + s) & 7;
        const unsigned char* Vx = V8 + (size_t)x * 16384 * 128 + 16 * j;
        const bf16_t* Xx = X2B + 128 * x + 16 * j + 2 * g;
        for (;;) {
            int c = 0; if (lane == 0) c = (int)__hip_atomic_fetch_add(ctl + CW_PEERV + 64 * x, 1u, __ATOMIC_RELAXED, __HIP_MEMORY_SCOPE_AGENT);
            c = __builtin_amdgcn_readfirstlane(c);
            if (c >= T / PEER_CH) break;
            const size_t tc = (size_t)c * PEER_CH, tl = tc + PEER_CH - 1;
            int en[16]; v4u wa[16], wb[16];
            int er0 = EIDX[tc * 128 + lane], er1 = EIDX[tc * 128 + 64 + lane];
            float aa0 = ACTS[tc * 128 + lane], aa1 = ACTS[tc * 128 + 64 + lane], ab0, ab1; unsigned xwa = *(const unsigned*)(Xx + tc * 1024), xwb;
            PEER_SHUF(en, er0, er1);
#pragma unroll
            for (int i = 0; i < 16; ++i) wa[i] = *(const v4u*)(Vx + (size_t)en[i] * 128);
            er0 = EIDX[(tc + 1) * 128 + lane]; er1 = EIDX[(tc + 1) * 128 + 64 + lane];
            for (int tt = 0; tt < PEER_CH; tt += 2) {
                const size_t t = tc + tt, t2 = (t + 2 < tl) ? t + 2 : tl, t3 = (t + 3 < tl) ? t + 3 : tl;
                PEER_SHUF(en, er0, er1);
#pragma unroll
                for (int i = 0; i < 16; ++i) wb[i] = *(const v4u*)(Vx + (size_t)en[i] * 128);
                er0 = EIDX[t2 * 128 + lane]; er1 = EIDX[t2 * 128 + 64 + lane];
                ab0 = ACTS[(t + 1) * 128 + lane]; ab1 = ACTS[(t + 1) * 128 + 64 + lane]; xwb = *(const unsigned*)(Xx + (t + 1) * 1024);
                PEER_V_COMPUTE(wa, t, aa0, aa1, xwa);
                PEER_SHUF(en, er0, er1);
#pragma unroll
                for (int i = 0; i < 16; ++i) wa[i] = *(const v4u*)(Vx + (size_t)en[i] * 128);
                er0 = EIDX[t3 * 128 + lane]; er1 = EIDX[t3 * 128 + 64 + lane];
                aa0 = ACTS[t2 * 128 + lane]; aa1 = ACTS[t2 * 128 + 64 + lane]; xwa = *(const unsigned*)(Xx + t2 * 1024);
                PEER_V_COMPUTE(wb, t + 1, ab0, ab1, xwb);
            }
        }
    }
}
__device__ __forceinline__ void peer_norm_phase(Frame& F, const Args& a, const float* SS3, const bf16_t* X3B, float* out) {
    const int gt = F.vcu * NWAVES * 64 + F.tid, ngt = F.G * NWAVES * 64;
    for (int p = gt; p < T * 128; p += ngt) {
        const size_t t = (size_t)(p >> 7); const int c = (p & 127) * 8;
        const f32x4_t s0 = *(const f32x4_t*)(SS3 + t * 8), s1 = *(const f32x4_t*)(SS3 + t * 8 + 4);
        const float r3 = rsqrtf(((s0[0] + s0[1]) + (s0[2] + s0[3]) + (s1[0] + s1[1]) + (s1[2] + s1[3])) * (1.f / D) + EPS);
        const v4u w = *(const v4u*)(X3B + t * 1024 + c);
        const f32x4_t g0 = *(const f32x4_t*)(a.g_final + c), g1 = *(const f32x4_t*)(a.g_final + c + 4);
        *(f32x4_t*)(out + t * 1024 + c) = (f32x4_t){bflo(w.x), bfhi(w.x), bflo(w.y), bfhi(w.y)} * g0 * r3;
        *(f32x4_t*)(out + t * 1024 + c + 4) = (f32x4_t){bflo(w.z), bfhi(w.z), bflo(w.w), bfhi(w.w)} * g1 * r3;
    }
}
#ifndef TOPK_HD
#define TOPK_HD __device__ __forceinline__
#endif
TOPK_HD void ce_desc(unsigned& a, unsigned& b) { const unsigned hi = a > b ? a : b, lo = a > b ? b : a; a = hi; b = lo; }
TOPK_HD void sort16_desc(unsigned (&v)[16]) {
#pragma unroll
    for (int k = 2; k <= 16; k <<= 1)
#pragma unroll
        for (int j = k >> 1; j >= 1; j >>= 1)
#pragma unroll
            for (int i = 0; i < 16; ++i) { const int l = i ^ j; if (l > i) { if ((i & k) == 0) ce_desc(v[i], v[l]); else ce_desc(v[l], v[i]); } }
}
TOPK_HD void bitonic_merge16_desc(unsigned (&v)[16]) {
#pragma unroll
    for (int j = 8; j >= 1; j >>= 1)
#pragma unroll
        for (int i = 0; i < 16; ++i) { const int l = i ^ j; if (l > i) ce_desc(v[i], v[l]); }
}
TOPK_HD void top16_merge(unsigned (&a)[16], const unsigned (&b)[16]) {
#pragma unroll
    for (int i = 0; i < 16; ++i) a[i] = a[i] > b[15 - i] ? a[i] : b[15 - i];
    bitonic_merge16_desc(a);
}
TOPK_HD unsigned f2ord(float f) { const unsigned u = __builtin_bit_cast(unsigned, f); return (u & 0x80000000u) ? ~u : (u | 0x80000000u); }
TOPK_HD float ord2f(unsigned o) { const unsigned u = (o & 0x80000000u) ? (o & 0x7fffffffu) : ~o; return __builtin_bit_cast(float, u); }

__device__ __forceinline__ void peer_route_task(Frame& F, const bf16_t* PQ, const bf16_t* SK16, int* EIDX, float* EGATE, int tt, int h) {
    constexpr int CI[50] = {0,0,0,0,0,0,0,0,0,0,0,0,0,0,0,0,1,1,1,1,1,1,1,1,2,2,2,2,2,3,3,3,3,4,4,4,5,5,6,6,7,7,8,9,10,11,12,13,14,15};
    constexpr int CJ[50] = {0,1,2,3,4,5,6,7,8,9,10,11,12,13,14,15,0,1,2,3,4,5,6,7,0,1,2,3,4,0,1,2,3,0,1,2,0,1,0,1,0,1,0,0,0,0,0,0,0,0};
    int lane = F.lane; asm volatile("" : "+v"(lane));
    const int t = lane & 31, hi = lane >> 5;
    LAS unsigned* wl = (LAS unsigned*)(F.lds + F.wave * 16384) + lane * 33;
    {
        const size_t row = (size_t)tt * 32 + t;
        unsigned L[2][16];
#pragma unroll
        for (int p = 0; p < 2; ++p) {
            const int hp = h * 2 + p;
            bf16x8_t Bf[8], An[8];
#pragma unroll
            for (int ks = 0; ks < 8; ++ks) Bf[ks] = *(const bf16x8_t*)(PQ + row * 2048 + hp * 128 + 16 * ks + 8 * hi);
            const bf16_t* Abase = SK16 + ((size_t)(hp * 128 + t)) * 128 + 8 * hi;
#pragma unroll
            for (int ks = 0; ks < 8; ++ks) An[ks] = *(const bf16x8_t*)(Abase + 16 * ks);
#pragma unroll
            for (int i = 0; i < 16; ++i) L[p][i] = 0u;
#pragma unroll 1
            for (int nt = 0; nt < 4; ++nt) {
                bf16x8_t Ac[8];
#pragma unroll
                for (int ks = 0; ks < 8; ++ks) Ac[ks] = An[ks];
                const int nn = nt < 3 ? nt + 1 : 3;
#pragma unroll
                for (int ks = 0; ks < 8; ++ks) An[ks] = *(const bf16x8_t*)(Abase + (size_t)nn * 32 * 128 + 16 * ks);
                f32x16_t acc = {};
#pragma unroll
                for (int ks = 0; ks < 8; ++ks) acc = __builtin_amdgcn_mfma_f32_32x32x16_bf16(Ac[ks], Bf[ks], acc, 0, 0, 0);
                unsigned k[16];
#pragma unroll
                for (int r = 0; r < 16; ++r) { const int n = 32 * nt + (r & 3) + 8 * (r >> 2) + 4 * hi; k[r] = (f2ord(acc[r]) & ~127u) | (unsigned)(127 - n); }
                sort16_desc(k);
                top16_merge(L[p], k);
            }
            unsigned pb[16];
#pragma unroll
            for (int i = 0; i < 16; ++i) pb[i] = __shfl_xor(L[p][i], 32);
            top16_merge(L[p], pb);
        }
        float sa[16], sb[16];
#pragma unroll
        for (int i = 0; i < 16; ++i) { sa[i] = ord2f(L[0][i] & ~127u); sb[i] = ord2f(L[1][i] & ~127u); wl[i] = 127u - (L[0][i] & 127u); wl[16 + i] = 127u - (L[1][i] & 127u); }
        unsigned c0[16], c1[16];
#pragma unroll
        for (int s = 0; s < 32; ++s) {
            unsigned key = 0u;
            if (s < 25) { const float v = hi ? sa[CI[25 + s]] + sb[CJ[25 + s]] : sa[CI[s]] + sb[CJ[s]]; const int pos = hi ? CI[25 + s] * 16 + CJ[25 + s] : CI[s] * 16 + CJ[s];
                key = (f2ord(v) & ~255u) | (unsigned)(255 - pos); }
            if (s < 16) c0[s] = key; else c1[s - 16] = key;
        }
        sort16_desc(c0); sort16_desc(c1); top16_merge(c0, c1);
        unsigned pb[16];
#pragma unroll
        for (int i = 0; i < 16; ++i) pb[i] = __shfl_xor(c0[i], 32);
        top16_merge(c0, pb);
        float e[16]; const float m = ord2f(c0[0] & ~255u); float l = 0.f;
#pragma unroll
        for (int r = 0; r < 16; ++r) { e[r] = __expf(ord2f(c0[r] & ~255u) - m); l += e[r]; }
        const float il = 1.f / l;
        int ex[8]; float gt[8];
#pragma unroll
        for (int q = 0; q < 8; ++q) { const unsigned kk = hi ? c0[8 + q] : c0[q]; const int pos = 255 - (int)(kk & 255u); ex[q] = (int)(wl[pos >> 4] * 128u + wl[16 + (pos & 15)]); gt[q] = (hi ? e[8 + q] : e[q]) * il; }
        int* ep = EIDX + row * 128 + h * 16 + hi * 8; float* gp = EGATE + row * 128 + h * 16 + hi * 8;
        *(int4*)ep = make_int4(ex[0], ex[1], ex[2], ex[3]); *(int4*)(ep + 4) = make_int4(ex[4], ex[5], ex[6], ex[7]);
        *(f32x4_t*)gp = (f32x4_t){gt[0], gt[1], gt[2], gt[3]}; *(f32x4_t*)(gp + 4) = (f32x4_t){gt[4], gt[5], gt[6], gt[7]};
    }
}
__device__ __forceinline__ void cross_item(Frame& F, const bf16_t* QC, const bf16_t* KC, const bf16_t* VC, bf16_t* OC, int bh, int qb) {
    int tid = F.tid; asm volatile("" : "+v"(tid));
    const int lane = tid & 63, wave = F.wave, q = lane & 31, hi = lane >> 5;
    LAS unsigned char* L = F.lds;
    const int g4 = lane >> 4, qq = (lane >> 2) & 3, p4 = lane & 3;
    {
        const int b = bh >> 2, h = bh & 3;
#pragma unroll
        for (int i = 0; i < 16; ++i) { const int cid = tid + 512 * i, r = cid >> 5, c = cid & 31;
            *(LAS v4u*)(L + r * 512 + ((c ^ (r & 15)) << 4)) = *(const v4u*)(KC + (size_t)(b * 256 + r) * 1024 + h * 256 + c * 8); }
        const size_t qrow0 = (size_t)b * SEQ + qb * 256 + wave * 32;
        const bf16_t* Qp = QC + (qrow0 + q) * 1024 + h * 256 + 8 * hi;
        __syncthreads();
        f32x16_t st[8];
#pragma unroll
        for (int kt = 0; kt < 8; ++kt) st[kt] = (f32x16_t){};
#pragma unroll 2
        for (int ks = 0; ks < 16; ++ks) { const bf16x8_t qf = *(const bf16x8_t*)(Qp + 16 * ks);
#pragma unroll
            for (int kt = 0; kt < 8; ++kt) { const int row = 32 * kt + q;
                st[kt] = __builtin_amdgcn_mfma_f32_32x32x16_bf16(*(const LAS bf16x8_t*)(L + row * 512 + (((2 * ks + hi) ^ (row & 15)) << 4)), qf, st[kt], 0, 0, 0); } }
        float m = -INFINITY;
#pragma unroll
        for (int kt = 0; kt < 8; ++kt)
#pragma unroll
            for (int r = 0; r < 16; ++r) { st[kt][r] *= 0.0625f; m = fmaxf(m, st[kt][r]); }
        m = fmaxf(m, __shfl_xor(m, 32));
        float l = 0.f;
#pragma unroll
        for (int kt = 0; kt < 8; ++kt)
#pragma unroll
            for (int r = 0; r < 16; ++r) { st[kt][r] = __expf(st[kt][r] - m); l += st[kt][r]; }
        l += __shfl_xor(l, 32);
        const float il = 1.f / l;
        bf16x8_t pa[8][2];
#pragma unroll
        for (int kt = 0; kt < 8; ++kt)
#pragma unroll
            for (int s = 0; s < 2; ++s) pa[kt][s] = __builtin_bit_cast(bf16x8_t, (v4u){cvtpk(st[kt][8 * s] * il, st[kt][8 * s + 1] * il), cvtpk(st[kt][8 * s + 2] * il, st[kt][8 * s + 3] * il),
                                                                                        cvtpk(st[kt][8 * s + 4] * il, st[kt][8 * s + 5] * il), cvtpk(st[kt][8 * s + 6] * il, st[kt][8 * s + 7] * il)});
        __syncthreads();
#pragma unroll
        for (int i = 0; i < 16; ++i) { const int cid = tid + 512 * i, r = cid >> 5, c = cid & 31;
            *(LAS v4u*)(L + r * 512 + ((c ^ (4 * (r & 3))) << 4)) = *(const v4u*)(VC + (size_t)(b * 256 + r) * 1024 + h * 256 + c * 8); }
        __syncthreads();
        bf16_t* Op = OC + qrow0 * 1024 + h * 256 + q;
#pragma unroll 1
        for (int dt = 0; dt < 8; ++dt) {
            f32x16_t o = {};
            LAS unsigned char* vb = L + (4 * (g4 >> 1) + qq) * 512 + (((dt * 64) ^ (qq << 6)) + (g4 & 1) * 32 + p4 * 8);
#pragma unroll
            for (int kt = 0; kt < 8; ++kt)
#pragma unroll
                for (int s = 0; s < 2; ++s) { const v4i16_t a0 = lds_tr16(vb + (32 * kt + 16 * s) * 512), a1 = lds_tr16(vb + (32 * kt + 16 * s + 8) * 512);
                    const bf16x8_t vf = {a0[0], a0[1], a0[2], a0[3], a1[0], a1[1], a1[2], a1[3]};
                    o = __builtin_amdgcn_mfma_f32_32x32x16_bf16(pa[kt][s], vf, o, 0, 0, 0); }
#pragma unroll
            for (int r = 0; r < 16; ++r) { const int row = (r & 3) + 8 * (r >> 2) + 4 * hi; Op[(size_t)row * 1024 + dt * 32] = f2bf(o[r]); }
        }
        __syncthreads();
    }
}
template <bool REMAP>
__device__ __forceinline__ void transpose_tile(const float* W, int K, int N, const float* gain, bf16_t* WT, LAS float* tile, int item, int tid) {
    const int nblk = (N + 255) / 256, kb = item / nblk, nb = item % nblk, k0 = 64 * kb, n0 = 256 * nb;
    const int c4 = (tid & 63) * 4, kr = tid >> 6;
    f32x4 v[8];
#pragma unroll
    for (int i = 0; i < 8; ++i) { const int k = kr + 8 * i; v[i] = (n0 + c4 < N) ? *(const GAS f32x4*)(W + (size_t)(k0 + k) * N + n0 + c4) : (f32x4){0.f, 0.f, 0.f, 0.f}; }
#pragma unroll
    for (int i = 0; i < 8; ++i) { const int k = kr + 8 * i; LAS float* d = tile + k * 257 + c4; d[0] = v[i].x; d[1] = v[i].y; d[2] = v[i].z; d[3] = v[i].w; }
    __syncthreads();
#pragma unroll
    for (int i = 0; i < 4; ++i) { const int p = tid + 512 * i, n = p >> 3, c = p & 7; const LAS float* sp = tile + (8 * c) * 257 + n;
        float g[8];
#pragma unroll
        for (int q = 0; q < 8; ++q) g[q] = gain ? gain[k0 + 8 * c + q] : 1.f;
        v4u o; o.x = pk2(sp[0 * 257] * g[0], sp[1 * 257] * g[1]); o.y = pk2(sp[2 * 257] * g[2], sp[3 * 257] * g[3]); o.z = pk2(sp[4 * 257] * g[4], sp[5 * 257] * g[5]); o.w = pk2(sp[6 * 257] * g[6], sp[7 * 257] * g[7]);
        int ng = n0 + n; bool ok = ng < N;
        if (REMAP) { if (ng >= 3584 && ng < 3592) ok = false; else if (ng >= 3592) ng -= 8; }
        if (ok) *(GAS v4u*)(WT + (size_t)ng * K + k0 + 8 * c) = o; }
    __syncthreads();
}

__device__ __forceinline__ void p0_prologue(Frame& F, const Args& a) {
    unsigned char* ws = a.ws;
    LAS float* tile = (LAS float*)F.lds;
    const int gw = F.vcu * NWAVES + F.wave, NGW = F.G * NWAVES;
    constexpr int I_IN = 16 * 23;
    for (int it = F.vcu; it < I_IN; it += F.G) transpose_tile<true>(a.w_in, 1024, IN_COLS, a.g_mix, (bf16_t*)(ws + WS_WIN), tile, it, F.tid);
    __syncthreads();
    LAS float* wsm = (LAS float*)F.lds;
    for (int i = F.tid; i < 8192; i += NWAVES * 64) { const int j = i >> 10, k = i & 1023; wsm[i] = a.w_in[(size_t)k * IN_COLS + 3584 + j] * a.g_mix[k]; }
    __syncthreads();
    bf16_t* XB = (bf16_t*)(ws + WS_A0); float* rstd0 = (float*)(ws + WS_RSTD0); float* GB = (float*)(ws + WS_GB); float* GA = GB + T * 4;
    for (int row0 = gw * 4; row0 < T; row0 += NGW * 4) {
        f32x4 v[4][4];
#pragma unroll
        for (int r = 0; r < 4; ++r)
#pragma unroll
            for (int j = 0; j < 4; ++j) v[r][j] = *((const GAS f32x4*)(a.x + (size_t)(row0 + r) * D) + F.lane + 64 * j);
#pragma unroll
        for (int r = 0; r < 4; ++r) { const int row = row0 + r; float s = 0.f;
#pragma unroll
            for (int j = 0; j < 4; ++j) s += (v[r][j].x * v[r][j].x + v[r][j].y * v[r][j].y) + (v[r][j].z * v[r][j].z + v[r][j].w * v[r][j].w);
            const float rstd = rsqrtf(wave_sum(s) * (1.f / D) + EPS);
            GAS unsigned long long* o8 = (GAS unsigned long long*)(XB + (size_t)row * D) + F.lane;
#pragma unroll
            for (int j = 0; j < 4; ++j) o8[64 * j] = (unsigned long long)pk2(v[r][j].x, v[r][j].y) | ((unsigned long long)pk2(v[r][j].z, v[r][j].w) << 32);
            float dj[8];
#pragma unroll
            for (int jj = 0; jj < 8; ++jj) { float d = 0.f;
#pragma unroll
                for (int j = 0; j < 4; ++j) { const f32x4 w = *(const LAS f32x4*)(wsm + jj * 1024 + (F.lane + 64 * j) * 4); d += (v[r][j].x * w.x + v[r][j].y * w.y) + (v[r][j].z * w.z + v[r][j].w * w.w); }
                dj[jj] = d; }
#pragma unroll
            for (int off = 4; off >= 1; off >>= 1) { const bool up = (F.lane & off) != 0;
#pragma unroll
                for (int i = 0; i < off; ++i) { const float lo = dj[i], hi = dj[i + off]; const float send = up ? lo : hi, keep = up ? hi : lo; dj[i] = keep + __shfl_xor(send, off); } }
            float d0 = dj[0]; d0 += __shfl_xor(d0, 8); d0 += __shfl_xor(d0, 16); d0 += __shfl_xor(d0, 32);
            if (F.lane == 0) rstd0[row] = rstd;
            if (F.lane < 4) GB[(size_t)row * 4 + F.lane] = d0 * rstd; else if (F.lane < 8) GA[(size_t)row * 4 + F.lane - 4] = d0 * rstd; }
    }
}
__device__ __forceinline__ void late_prologue(Frame& F, const Args& a, int wgi, int nwg) {
    unsigned char* ws = a.ws;
    LAS float* tile = (LAS float*)F.lds;
    const int gw = wgi * NWAVES + F.wave, NGW = nwg * NWAVES;
    constexpr int I_S = 8 * 4, I_M = 16 * 4, I_L = 16 * 8;
    constexpr int NITEMS = 2 * I_S + 3 * I_M + 2 * I_L;
    for (int it = wgi; it < NITEMS; it += nwg) {
        int r = it;
        if (r < I_S) { transpose_tile<false>(a.w_sb_up, 512, 1024, nullptr, (bf16_t*)(ws + WS_WSB), tile, r, F.tid); continue; } r -= I_S;
        if (r < I_S) { transpose_tile<false>(a.w_gdn_up, 512, 1024, nullptr, (bf16_t*)(ws + WS_WGDN), tile, r, F.tid); continue; } r -= I_S;
        if (r < I_M) { transpose_tile<false>(a.w_mix_out, 1024, 1024, nullptr, (bf16_t*)(ws + WS_WMIX), tile, r, F.tid); continue; } r -= I_M;
        if (r < I_M) { transpose_tile<false>(a.w_cq, 1024, 1024, a.g_cross, (bf16_t*)(ws + WS_WCQ), tile, r, F.tid); continue; } r -= I_M;
        if (r < I_M) { transpose_tile<false>(a.w_co, 1024, 1024, nullptr, (bf16_t*)(ws + WS_WCO), tile, r, F.tid); continue; } r -= I_M;
        if (r < I_L) { transpose_tile<false>(a.w_ckv, 1024, 2048, nullptr, (bf16_t*)(ws + WS_WCKV), tile, r, F.tid); continue; } r -= I_L;
        transpose_tile<false>(a.w_pq, 1024, 2048, a.g_peer, (bf16_t*)(ws + WS_WPQ), tile, r, F.tid);
    }
    __syncthreads();
    {
        float* SUV = (float*)(ws + WS_SUV);
        for (int row0 = gw * 4; row0 < 2 * 16384; row0 += NGW * 4) {
            f32x4 v[4][4];
#pragma unroll
            for (int r = 0; r < 4; ++r) { const int row = row0 + r, tb = row >> 14, e = row & 16383; const float* src = (tb ? a.peer_v : a.peer_u) + (size_t)e * 1024 + 16 * F.lane;
#pragma unroll
                for (int q = 0; q < 4; ++q) v[r][q] = *(const GAS f32x4*)(src + 4 * q); }
#pragma unroll
            for (int r = 0; r < 4; ++r) { const int row = row0 + r, tb = row >> 14, e = row & 16383; float am = 0.f;
#pragma unroll
                for (int q = 0; q < 4; ++q) am = fmaxf(am, fmaxf(fmaxf(fabsf(v[r][q].x), fabsf(v[r][q].y)), fmaxf(fabsf(v[r][q].z), fabsf(v[r][q].w))));
#pragma unroll
                for (int o = 1; o < 64; o <<= 1) am = fmaxf(am, __shfl_xor(am, o));
                int ex = 0; if (am > 0.f) (void)frexpf(am, &ex);
                const float sc = ldexpf(1.f, 8 - ex), inv = ldexpf(1.f, ex - 8);
                v4u o; int rr;
                rr = __builtin_amdgcn_cvt_pk_fp8_f32(v[r][0].x * sc, v[r][0].y * sc, 0, false); rr = __builtin_amdgcn_cvt_pk_fp8_f32(v[r][0].z * sc, v[r][0].w * sc, rr, true); o.x = (unsigned)rr;
                rr = __builtin_amdgcn_cvt_pk_fp8_f32(v[r][1].x * sc, v[r][1].y * sc, 0, false); rr = __builtin_amdgcn_cvt_pk_fp8_f32(v[r][1].z * sc, v[r][1].w * sc, rr, true); o.y = (unsigned)rr;
                rr = __builtin_amdgcn_cvt_pk_fp8_f32(v[r][2].x * sc, v[r][2].y * sc, 0, false); rr = __builtin_amdgcn_cvt_pk_fp8_f32(v[r][2].z * sc, v[r][2].w * sc, rr, true); o.z = (unsigned)rr;
                rr = __builtin_amdgcn_cvt_pk_fp8_f32(v[r][3].x * sc, v[r][3].y * sc, 0, false); rr = __builtin_amdgcn_cvt_pk_fp8_f32(v[r][3].z * sc, v[r][3].w * sc, rr, true); o.w = (unsigned)rr;
                *(GAS v4u*)(ws + (tb ? WS_V8 : WS_U8) + ((size_t)(F.lane >> 3) * 16384 + e) * 128 + 16 * (F.lane & 7)) = o;
                if (F.lane == 0) SUV[row] = inv; }
        }
    }
    {
        const int gt = gw * 64 + F.lane, ngt = NGW * 64;
        for (int p = gt; p < 262144 / 8; p += ngt) { const float* src = a.subkeys + (size_t)p * 8; const f32x4 v0 = *(const GAS f32x4*)src, v1 = *(const GAS f32x4*)(src + 4);
            v4u o; o.x = pk2(v0.x, v0.y); o.y = pk2(v0.z, v0.w); o.z = pk2(v1.x, v1.y); o.w = pk2(v1.z, v1.w); *(GAS v4u*)((bf16_t*)(ws + WS_SKB) + (size_t)p * 8) = o; }
    }
    bf16_t* MN = (bf16_t*)(ws + WS_MN);
    for (int row = gw; row < 1024; row += NGW) {
        const GAS f32x4* xr = (const GAS f32x4*)(a.mem + (size_t)row * D) + F.lane;
        f32x4 v[4]; float s = 0.f;
#pragma unroll
        for (int j = 0; j < 4; ++j) { v[j] = xr[64 * j]; s += (v[j].x * v[j].x + v[j].y * v[j].y) + (v[j].z * v[j].z + v[j].w * v[j].w); }
        const float rstd = rsqrtf(wave_sum(s) * (1.f / D) + EPS);
        GAS unsigned long long* o8 = (GAS unsigned long long*)(MN + (size_t)row * D) + F.lane;
#pragma unroll
        for (int j = 0; j < 4; ++j) { const f32x4 g = *((const f32x4*)a.g_mem + F.lane + 64 * j); const f32x4 o = v[j] * g * rstd;
            o8[64 * j] = (unsigned long long)pk2(o.x, o.y) | ((unsigned long long)pk2(o.z, o.w) << 32); }
    }
}
__device__ __forceinline__ void rstd_rows_for_units(Frame& F, int N, const float* SS, float* rstd) {
    pg8::StaticOrder S2; S2.init(T, N, F.G, (int)blockIdx.x); pg8::Unit u;
    for (int i = 0; S2.next(i, u); ++i) if (F.tid < 256) { const int row = u.pm * 256 + F.tid; const f32x4* sp = (const f32x4*)(SS + (size_t)row * 16);
        const f32x4 a = (sp[0] + sp[1]) + (sp[2] + sp[3]); rstd[row] = rsqrtf(((a.x + a.y) + (a.z + a.w)) * (1.f / 1024.f) + EPS); }
    asm volatile("s_waitcnt vmcnt(0)" ::: "memory"); __syncthreads();
}

__device__ __forceinline__ void sub_barrier(gu32* cnt, unsigned n, gu32* tmo) {
    asm volatile("s_waitcnt vmcnt(0)" ::: "memory");
    __syncthreads();
    if (threadIdx.x == 0) {
        __builtin_amdgcn_fence(__ATOMIC_RELEASE, "agent");
        asm volatile("s_waitcnt vmcnt(0)" ::: "memory");
        __hip_atomic_fetch_add(cnt, 1u, __ATOMIC_RELAXED, __HIP_MEMORY_SCOPE_AGENT);
        unsigned sp = 0;
        while (__hip_atomic_load(cnt, __ATOMIC_RELAXED, __HIP_MEMORY_SCOPE_AGENT) < n) { __builtin_amdgcn_s_sleep(2); if (++sp > (1u << 22)) { __hip_atomic_store(tmo, 1u, __ATOMIC_RELAXED, __HIP_MEMORY_SCOPE_AGENT); break; } }
        __builtin_amdgcn_fence(__ATOMIC_ACQUIRE, "agent");
        asm volatile("s_waitcnt vmcnt(0)" ::: "memory");
    }
    __syncthreads();
}

__global__ void __launch_bounds__(NWAVES * 64, 2) mk_fwd(Args args) {
    extern __shared__ __attribute__((aligned(16))) unsigned char lds_raw[];
    Frame F;
    F.lds = (LAS unsigned char*)lds_raw;
    F.tid = threadIdx.x; F.lane = F.tid & 63; F.wave = __builtin_amdgcn_readfirstlane(F.tid >> 6);
    F.G = gridDim.x; { const int bx = blockIdx.x; F.vcu = (F.G % 8 == 0) ? (bx % 8) * (F.G / 8) + bx / 8 : bx; }
    unsigned char* ws = args.ws;
    gu32* ctl = (gu32*)(ws + WS_CTL);
    volatile LAS unsigned* MISC = (volatile LAS unsigned*)(F.lds + MISC_OFF);
    for (int u = F.tid; u < (LDS_BYTES - LDSCTL_OFF) / 4; u += NWAVES * 64) ((LAS unsigned*)(F.lds + LDSCTL_OFF))[u] = 0u;
    __syncthreads();
    XcdBarrier bar = xcd_barrier_post((unsigned*)(ctl + CW_BAR) + args.bar_region * XCD_BAR_WORDS, MISC + 8);
    const int lo = args.ph_lo, hi = args.ph_hi;
#define IN(k) (lo <= (k) && (k) < hi)
#define SEAM(k) do { if (IN(k) && IN((k) + 1)) xcd_barrier(bar); } while (0)
    bf16_t* A0 = (bf16_t*)(ws + WS_A0); bf16_t* A1 = (bf16_t*)(ws + WS_A1);
    bf16_t* MG = (bf16_t*)args.out;
    bf16_t* SBQ = (bf16_t*)args.out; bf16_t* SBK = SBQ + (size_t)T * 512; bf16_t* SBV = SBK + (size_t)T * 512; bf16_t* OSB = SBV + (size_t)T * 512;

    GdnBufs Gb{(bf16_t*)(ws + WS_NW), (bf16_t*)(ws + WS_QD), (bf16_t*)(ws + WS_KDT), (bf16_t*)(ws + WS_QK), (bf16_t*)(ws + WS_UT), (float*)(ws + WS_CD), (bf16_t*)(ws + WS_ORAW), (float*)(ws + WS_OSS)};
    if (IN(0)) { p0_prologue(F, args);}
    SEAM(0);
    if (IN(1)) {
        { pg8::Gemm g{A0, (const bf16_t*)(ws + WS_WIN), T, NPROJ, 1024}; pg8::StaticOrder S; S.init(T, NPROJ, F.G, (int)blockIdx.x);
          pg8::EpiProj E{(const float*)(ws + WS_RSTD0), SBQ, SBK, SBV, A1, (bf16_t*)(ws + WS_GZ), (bf16_t*)(ws + WS_GSB), (bf16_t*)(ws + WS_GGDN)};
          pg8::gemm_phase<pg8::EpiProj, pg8::StaticOrder, true, true>(F.lds, g, S, E); }
    }
    SEAM(1);
    if (IN(2)) { gdn_prep_phase(F, args, A1, (const float*)(ws + WS_GB), (const float*)(ws + WS_GB) + T * 4, Gb); }
    SEAM(2);
    if (IN(3)) {
        const int nscan = F.G > 64 ? 64 : F.G, sb0 = F.G > 64 ? 64 : 0;
        if ((int)blockIdx.x < nscan) for (int s0 = blockIdx.x; s0 < 64; s0 += nscan) { const int s = (nscan == 64) ? ((s0 & 7) + 8 * (s0 >> 5)) * 4 + ((s0 >> 3) & 3) : s0; gdn_scan_unit(F, s, Gb); __syncthreads(); }
        if ((int)blockIdx.x >= sb0) { late_prologue(F, args, (int)blockIdx.x - sb0, F.G - sb0); __syncthreads(); }
        if ((int)blockIdx.x >= sb0) sb_phase(F.lds + F.wave * 8192, SBQ, SBK, SBV, OSB, ((int)blockIdx.x - sb0) * NWAVES + F.wave, (F.G - sb0) * NWAVES, F.lane);
        __syncthreads();
        if (sb0 > 0 && (int)blockIdx.x >= sb0) {
            sub_barrier(ctl + CW_SUB, (unsigned)(F.G - sb0), ctl + CW_SUB + 64);
            pg8::Gemm g{OSB, (const bf16_t*)(ws + WS_WSB), T, 1024, 512}; pg8::StaticOrder S; S.init(T, 1024, F.G - sb0, (int)blockIdx.x - sb0);
            pg8::EpiMerge<false> E{(const bf16_t*)(ws + WS_GSB), MG};
            pg8::gemm_phase<pg8::EpiMerge<false>, pg8::StaticOrder, true, true>(F.lds, g, S, E);
            const int wgi = (int)blockIdx.x - sb0;
            if (F.G - sb0 >= 160 && wgi >= 128 && wgi < 160) { pg8::Gemm g2{(const bf16_t*)(ws + WS_MN), (const bf16_t*)(ws + WS_WCKV), 1024, 2048, 1024}; pg8::StaticOrder S2; S2.init(1024, 2048, 32, wgi - 128);
                pg8::EpiSplit E2{(bf16_t*)(ws + WS_KC), (bf16_t*)(ws + WS_VC), 1024, 4};
                pg8::gemm_phase<pg8::EpiSplit, pg8::StaticOrder, true, true>(F.lds, g2, S2, E2); }
        }
    }
    SEAM(3);
    if (IN(4)) {
        if (!(F.G > 64 && F.G - 64 >= 160)) { pg8::Gemm g{(const bf16_t*)(ws + WS_MN), (const bf16_t*)(ws + WS_WCKV), 1024, 2048, 1024}; pg8::StaticOrder S; S.init(1024, 2048, F.G, (int)blockIdx.x);
          pg8::EpiSplit E{(bf16_t*)(ws + WS_KC), (bf16_t*)(ws + WS_VC), 1024, 4};
          pg8::gemm_phase<pg8::EpiSplit, pg8::StaticOrder, true, true>(F.lds, g, S, E); }
        gdn_finish_phase(F, args, Gb, (const bf16_t*)(ws + WS_GZ), (bf16_t*)(ws + WS_OG)); }
    SEAM(4);
    if (IN(5)) {
        if (!(F.G > 64)) { pg8::Gemm g{OSB, (const bf16_t*)(ws + WS_WSB), T, 1024, 512}; pg8::StaticOrder S; S.init(T, 1024, F.G, (int)blockIdx.x);
          pg8::EpiMerge<false> E{(const bf16_t*)(ws + WS_GSB), MG};
          pg8::gemm_phase<pg8::EpiMerge<false>, pg8::StaticOrder, true, true>(F.lds, g, S, E);
          xcd_barrier(bar); }
        { pg8::Gemm g{(const bf16_t*)(ws + WS_OG), (const bf16_t*)(ws + WS_WGDN), T, 1024, 512}; pg8::StaticOrder S; S.init(T, 1024, F.G, (int)blockIdx.x);
          pg8::EpiMerge<true> E{(const bf16_t*)(ws + WS_GGDN), MG};
          pg8::gemm_phase<pg8::EpiMerge<true>, pg8::StaticOrder, true, true>(F.lds, g, S, E); }
    }
    SEAM(5);
    if (IN(6)) {
        pg8::Gemm g{MG, (const bf16_t*)(ws + WS_WMIX), T, 1024, 1024}; pg8::StaticOrder S; S.init(T, 1024, F.G, (int)blockIdx.x);
        pg8::EpiRes<true> E{args.x, nullptr, A1, (float*)(ws + WS_SS)};
        pg8::gemm_phase<pg8::EpiRes<true>, pg8::StaticOrder, true, true>(F.lds, g, S, E);
    }
    SEAM(6);
    if (IN(7)) {
        rstd_rows_for_units(F, 1024, (const float*)(ws + WS_SS), (float*)(ws + WS_RSTD0));
        pg8::Gemm g{A1, (const bf16_t*)(ws + WS_WCQ), T, 1024, 1024}; pg8::StaticOrder S; S.init(T, 1024, F.G, (int)blockIdx.x);
        pg8::EpiScale E{(const float*)(ws + WS_RSTD0), (bf16_t*)(ws + WS_GSB), 1024};
        pg8::gemm_phase<pg8::EpiScale, pg8::StaticOrder, true, true>(F.lds, g, S, E);
        asm volatile("s_waitcnt vmcnt(0)" ::: "memory"); __syncthreads();
        pg8::StaticOrder S2; S2.init(T, 1024, F.G, (int)blockIdx.x); pg8::Unit u;
        for (int i = 0; S2.next(i, u); ++i) cross_item(F, (const bf16_t*)(ws + WS_GSB), (const bf16_t*)(ws + WS_KC), (const bf16_t*)(ws + WS_VC), (bf16_t*)(ws + WS_GGDN), (u.pm >> 5) * 4 + u.pn, u.pm & 31);
    }
    SEAM(7);
    if (IN(9)) {
        pg8::Gemm g{(const bf16_t*)(ws + WS_GGDN), (const bf16_t*)(ws + WS_WCO), T, 1024, 1024}; pg8::StaticOrder S; S.init(T, 1024, F.G, (int)blockIdx.x);
        pg8::EpiRes<false> E{nullptr, A1, A0, (float*)(ws + WS_SS)};
        pg8::gemm_phase<pg8::EpiRes<false>, pg8::StaticOrder, true, true>(F.lds, g, S, E);
    }
    SEAM(9);
    if (IN(10)) {
        rstd_rows_for_units(F, 2048, (const float*)(ws + WS_SS), (float*)(ws + WS_RSTD2));
        pg8::Gemm g{A0, (const bf16_t*)(ws + WS_WPQ), T, 2048, 1024}; pg8::StaticOrder S; S.init(T, 2048, F.G, (int)blockIdx.x);
        pg8::EpiScale E{(const float*)(ws + WS_RSTD2), A1, 2048};
        pg8::gemm_phase<pg8::EpiScale, pg8::StaticOrder, true, true>(F.lds, g, S, E);
        asm volatile("s_waitcnt vmcnt(0)" ::: "memory"); __syncthreads();
        pg8::StaticOrder S2; S2.init(T, 2048, F.G, (int)blockIdx.x); pg8::Unit u;
        for (int i = 0; S2.next(i, u); ++i) peer_route_task(F, A1, (const bf16_t*)(ws + WS_SKB), (int*)(ws + 296 * MiB), (float*)(ws + 312 * MiB), u.pm * 8 + F.wave, u.pn);
        __syncthreads();
    }
    SEAM(10);
    if (IN(12)) { peer_u_phase(F, args, ctl, A0, (const float*)(ws + WS_RSTD2), (const int*)(ws + 296 * MiB), (const unsigned char*)(ws + WS_U8), (bf16_t*)(ws + WS_PART)); }
    SEAM(12);
    if (IN(13)) { peer_combine_phase(F, (const bf16_t*)(ws + WS_PART), (const int*)(ws + 296 * MiB), (const float*)(ws + 312 * MiB), (const float*)(ws + WS_SUV), (const float*)(ws + WS_SUV) + 16384, (float*)(ws + 328 * MiB)); }
    SEAM(13);
    if (IN(14)) { peer_v_phase(F, ctl, (const int*)(ws + 296 * MiB), (const float*)(ws + 328 * MiB), (const unsigned char*)(ws + WS_V8), A0, A1, (float*)(ws + WS_SS)); }
    SEAM(14);
    if (IN(15)) { peer_norm_phase(F, args, (const float*)(ws + WS_SS), A1, args.out); }
#undef IN
#undef SEAM
}
extern "C" void kernel_launch(void* const* d_in, const int* in_sizes, int n_in, void* d_out, int out_size, void* d_ws, size_t ws_size, hipStream_t stream) {
    static int grid = 0;
    if (grid == 0) {
        if (n_in != 22 || ws_size < WS_END || out_size != T * D) { fprintf(stderr, "kernel_launch: unexpected n_in %d / ws %zu / out %d\n", n_in, ws_size, out_size); grid = -1; return; }
        int dev = 0, cus = 0, per_cu = 0;
        if (hipGetDevice(&dev) != hipSuccess || hipDeviceGetAttribute(&cus, hipDeviceAttributeMultiprocessorCount, dev) != hipSuccess) { grid = -1; return; }
        if (hipFuncSetAttribute((const void*)mk_fwd, hipFuncAttributeMaxDynamicSharedMemorySize, LDS_BYTES) != hipSuccess) { fprintf(stderr, "kernel_launch: hipFuncSetAttribute failed\n"); grid = -1; return; }
        if (hipOccupancyMaxActiveBlocksPerMultiprocessor(&per_cu, (const void*)mk_fwd, NWAVES * 64, LDS_BYTES) != hipSuccess || per_cu < 1) { fprintf(stderr, "kernel_launch: occupancy query says %d\n", per_cu); per_cu = 1; }
        (void)hipGetLastError();
        grid = cus;
    }
    if (grid < 0) return;
    hipMemsetAsync((char*)d_ws + WS_CTL, 0, CTL_ZERO_BYTES, stream);
    Args a{};
    const float** ap = (const float**)&a;
    for (int i = 0; i < 22; ++i) ap[i] = (const float*)d_in[i];
    a.out = (float*)d_out; a.ws = (unsigned char*)d_ws;
    char* ws = (char*)d_ws; float* out = (float*)d_out;
    float* rstd2 = (float*)(ws + WS_RSTD2);
    bf16_t* KC = (bf16_t*)(ws + WS_KC); bf16_t* VC = (bf16_t*)(ws + WS_VC);
    bf16_t* PQ = (bf16_t*)(ws + WS_A1); bf16_t* QC = (bf16_t*)(ws + WS_GSB); bf16_t* OC = (bf16_t*)(ws + WS_GGDN);
    int* EIDX = (int*)(ws + 296 * MiB); float* EGATE = (float*)(ws + 312 * MiB);
#define MK(lo, hi, reg) do { a.ph_lo = (lo); a.ph_hi = (hi); a.bar_region = (reg); hipLaunchKernelGGL(mk_fwd, dim3(grid), dim3(NWAVES * 64), LDS_BYTES, stream, a); } while (0)
    MK(0, 16, 0);
#undef MK
}
```

```cpp
#include <hip/hip_runtime.h>
#include <stdint.h>
#include <cstdio>

typedef unsigned short bf16_t;
__device__ __forceinline__ float bf2f(bf16_t v) { return __uint_as_float(((unsigned)v) << 16); }
__device__ __forceinline__ bf16_t f2bf(float f) { unsigned u = __float_as_uint(f); return (bf16_t)((u + 0x7fffu + ((u >> 16) & 1u)) >> 16); }

constexpr int T = 32768, D = 1024, SEQ = 8192, NB = 4;
constexpr int IN_COLS = 5640, NPROJ = 5632;
constexpr float EPS = 1e-6f;
constexpr size_t MiB = 1u << 20;

__device__ __forceinline__ float wave_sum(float v) {
#pragma unroll
    for (int o = 1; o < 64; o <<= 1) v += __shfl_xor(v, o);
    return v;
}
__device__ __forceinline__ float sigmoidf_(float x) { return 1.f / (1.f + __expf(-x)); }
__device__ __forceinline__ float softplusf_(float x) { return fmaxf(x, 0.f) + log1pf(__expf(-fabsf(x))); }

namespace pg8 {
#define PG8_LAS __attribute__((address_space(3)))
typedef unsigned short bf16_t;
typedef short bf16x8 __attribute__((ext_vector_type(8)));
typedef float f32x4 __attribute__((ext_vector_type(4)));
typedef unsigned u32x4 __attribute__((ext_vector_type(4)));
constexpr int BM = 256, BK = 64, HALF = 128, HTB = HALF * BK * 2  , STAGE_BYTES = 8 * HTB, NXCD = 8, WGM = 8;

__host__ __device__ __forceinline__ int lds_byte(int r, int c) { const int st = (r >> 4) * 2 + (c >> 5), rr = r & 15, cc = c & 31, ob = rr * 64 + cc * 2; return st * 1024 + (ob ^ (((ob >> 9) & 1) << 5)); }
__host__ __device__ __forceinline__ void stage_rc(int b, int& R, int& C) { const int st = b / 1024, sb = b % 1024, swz = sb ^ (((sb >> 9) & 1) << 5); R = (st >> 1) * 16 + swz / 64; C = (st & 1) * 32 + (swz % 64) / 2; }
__host__ __device__ __forceinline__ int perm32(int rho) { const int n = rho >> 4, i = rho & 15; return 8 * (i >> 2) + 4 * n + (i & 3); }

struct Unit { int pm, pn; };
struct Gemm { const bf16_t* A; const bf16_t* Bt; int M, N, K; };

struct StaticOrder {
    int nM, nN, nwg, G, c;
    __host__ __device__ __forceinline__ void init(int M, int N, int G_, int c_) { nM = M / BM; nN = N / BM; nwg = nM * nN; G = G_; c = c_; }
    __host__ __device__ __forceinline__ bool next(int i, Unit& u) const {
        const long L = (long)i * G + c; if (L >= nwg) return false;
        int wgid = (int)L; { const int q = nwg / NXCD, r = nwg % NXCD, xcd = wgid % NXCD, off = wgid / NXCD; wgid = (xcd < r ? xcd * (q + 1) : r * (q + 1) + (xcd - r) * q) + off; }
        const int nig = WGM * nN, gid = wgid / nig, fm = gid * WGM, gsz = (nM - fm) < WGM ? (nM - fm) : WGM;
        u.pm = fm + ((wgid % nig) % gsz); u.pn = (wgid % nig) / gsz; return true;
    }
    __device__ __forceinline__ void a_ready(const Unit&) const {}
    __device__ __forceinline__ void done(const Unit&) const {}
};

__device__ __forceinline__ unsigned cvt_pk_bf16(float lo, float hi) { unsigned r; asm volatile("v_cvt_pk_bf16_f32 %0, %1, %2" : "=v"(r) : "v"(lo), "v"(hi)); return r; }
typedef float f32x2 __attribute__((ext_vector_type(2)));
__device__ __forceinline__ float bfl(unsigned w) { return __uint_as_float(w << 16); }
__device__ __forceinline__ float bfh(unsigned w) { return __uint_as_float(w & 0xffff0000u); }
constexpr int EPI_STAGE_OFF = 131072 + 1024;
__device__ __forceinline__ void stage_store16x64(int wid, int fr, int fq, u32x4 w0, u32x4 w1, bf16_t* rowbase  , size_t ld) {
    PG8_LAS unsigned char* sl = (PG8_LAS unsigned char*)(EPI_STAGE_OFF + wid * 2048);
    *(PG8_LAS u32x4*)(sl + fr * 128 + ((fq ^ (fr & 7)) << 4)) = w0;
    *(PG8_LAS u32x4*)(sl + fr * 128 + (((4 + fq) ^ (fr & 7)) << 4)) = w1;
    const int lane = fr + 16 * fq, r0 = lane >> 3, c = lane & 7;
    const u32x4 a = *(const PG8_LAS u32x4*)(sl + r0 * 128 + ((c ^ r0) << 4));
    const u32x4 b = *(const PG8_LAS u32x4*)(sl + (r0 + 8) * 128 + ((c ^ r0) << 4));
    *(u32x4*)(rowbase + (size_t)r0 * ld + c * 8) = a;
    *(u32x4*)(rowbase + (size_t)(r0 + 8) * ld + c * 8) = b;
}
__device__ __forceinline__ u32x4 pack8(const f32x4& v0, const f32x4& v1) { u32x4 w; w.x = cvt_pk_bf16(v0[0], v0[1]); w.y = cvt_pk_bf16(v0[2], v0[3]); w.z = cvt_pk_bf16(v1[0], v1[1]); w.w = cvt_pk_bf16(v1[2], v1[3]); return w; }

struct EpiProj {
    static constexpr bool PERM = true, AFTER_DRAIN = false, COL64 = true;
    const float* rstd; bf16_t *SBQ, *SBK, *SBV, *GQKV, *GZ, *GSB, *GGDN;
    __device__ __forceinline__ void operator()(const f32x4 (&acc)[2][2][4][2], const Unit& u, int wr, int wc, int fr_in, int fq_in) const {
        int lane_ = fr_in + 16 * fq_in; asm volatile("" : "+v"(lane_));
        const int fr = lane_ & 15, fq = lane_ >> 4;
        const int pn = u.pn; bf16_t* base; int ld, coff;
        if (pn < 2) { base = SBQ; ld = 512; coff = pn * 256; } else if (pn < 4) { base = SBK; ld = 512; coff = (pn - 2) * 256; } else if (pn < 6) { base = SBV; ld = 512; coff = (pn - 4) * 256; }
        else if (pn < 12) { base = GQKV; ld = 1536; coff = (pn - 6) * 256; } else if (pn < 14) { base = GZ; ld = 512; coff = (pn - 12) * 256; }
        else if (pn < 18) { base = GSB; ld = 1024; coff = (pn - 14) * 256; } else { base = GGDN; ld = 1024; coff = (pn - 18) * 256; }
        const int row0 = u.pm * BM + wr * 64, wid = wr * 4 + wc;
        float rsv[2][4];
#pragma unroll
        for (int ai = 0; ai < 2; ++ai)
#pragma unroll
            for (int m = 0; m < 4; ++m) rsv[ai][m] = rstd[row0 + ai * HALF + m * 16 + fr];
#pragma unroll
        for (int ai = 0; ai < 2; ++ai)
#pragma unroll
            for (int m = 0; m < 4; ++m) { const int rg = row0 + ai * HALF + m * 16; const float rs = rsv[ai][m];
                stage_store16x64(wid, fr, fq, pack8(acc[ai][0][m][0] * rs, acc[ai][0][m][1] * rs), pack8(acc[ai][1][m][0] * rs, acc[ai][1][m][1] * rs), base + (size_t)rg * ld + coff + wc * 64, ld); }
    }
};
struct EpiSplit {
    static constexpr bool PERM = true, AFTER_DRAIN = false, COL64 = true;
    bf16_t *O0, *O1; int ldc, split_tiles;
    __device__ __forceinline__ void operator()(const f32x4 (&acc)[2][2][4][2], const Unit& u, int wr, int wc, int fr_in, int fq_in) const {
        int lane_ = fr_in + 16 * fq_in; asm volatile("" : "+v"(lane_));
        const int fr = lane_ & 15, fq = lane_ >> 4;
        bf16_t* base = u.pn < split_tiles ? O0 : O1; const int coff = (u.pn < split_tiles ? u.pn : u.pn - split_tiles) * 256;
        const int row0 = u.pm * BM + wr * 64, wid = wr * 4 + wc;
#pragma unroll
        for (int ai = 0; ai < 2; ++ai)
#pragma unroll
            for (int m = 0; m < 4; ++m) { const int rg = row0 + ai * HALF + m * 16;
                stage_store16x64(wid, fr, fq, pack8(acc[ai][0][m][0], acc[ai][0][m][1]), pack8(acc[ai][1][m][0], acc[ai][1][m][1]), base + (size_t)rg * ldc + coff + wc * 64, ldc); }
    }
};
template <bool ADD> struct EpiMerge {
    static constexpr bool PERM = true, AFTER_DRAIN = false, COL64 = true;
    const bf16_t* gate; bf16_t* M;
    __device__ __forceinline__ void operator()(const f32x4 (&acc)[2][2][4][2], const Unit& u, int wr, int wc, int fr_in, int fq_in) const {
        int lane_ = fr_in + 16 * fq_in; asm volatile("" : "+v"(lane_));
        const int fr = lane_ & 15, fq = lane_ >> 4;
        const int row0 = u.pm * BM + wr * 64, col0 = u.pn * BM + wc * 64, wid = wr * 4 + wc;
#pragma unroll
        for (int ab = 0; ab < 4; ++ab) { const int ai = ab >> 1, mb = (ab & 1) * 2;
            u32x4 gl[4][2], pl[4][2];
#pragma unroll
            for (int m = mb; m < mb + 2; ++m)
#pragma unroll
                for (int bj = 0; bj < 2; ++bj) { const size_t o = (size_t)(row0 + ai * HALF + m * 16 + fr) * 1024 + col0 + 8 * fq + bj * 32; gl[m][bj] = *(const u32x4*)(gate + o); if (ADD) pl[m][bj] = *(const u32x4*)(M + o); }
#pragma unroll
            for (int m = mb; m < mb + 2; ++m) { const int rg = row0 + ai * HALF + m * 16;
                u32x4 wv[2];
#pragma unroll
                for (int bj = 0; bj < 2; ++bj) { const u32x4 g = gl[m][bj];
                    float gv[8] = {bfl(g.x), bfh(g.x), bfl(g.y), bfh(g.y), bfl(g.z), bfh(g.z), bfl(g.w), bfh(g.w)};
                    float pv[8] = {0.f, 0.f, 0.f, 0.f, 0.f, 0.f, 0.f, 0.f};
                    if (ADD) { const u32x4 p = pl[m][bj]; pv[0] = bfl(p.x); pv[1] = bfh(p.x); pv[2] = bfl(p.y); pv[3] = bfh(p.y); pv[4] = bfl(p.z); pv[5] = bfh(p.z); pv[6] = bfl(p.w); pv[7] = bfh(p.w); }
                    float r[8];
#pragma unroll
                    for (int j = 0; j < 8; ++j) { const float a = j < 4 ? acc[ai][bj][m][0][j] : acc[ai][bj][m][1][j - 4]; r[j] = pv[j] + a * __builtin_amdgcn_rcpf(1.f + __expf(-gv[j])); }
                    wv[bj].x = cvt_pk_bf16(r[0], r[1]); wv[bj].y = cvt_pk_bf16(r[2], r[3]); wv[bj].z = cvt_pk_bf16(r[4], r[5]); wv[bj].w = cvt_pk_bf16(r[6], r[7]); }
                stage_store16x64(wid, fr, fq, wv[0], wv[1], M + (size_t)rg * 1024 + col0, 1024); }
        }
    }
};
template <bool IN_F32> struct EpiRes {
    static constexpr bool PERM = true, AFTER_DRAIN = false, COL64 = true;
    const float* xin_f; const bf16_t* xin_b; bf16_t* xb; float* SS;
    __device__ __forceinline__ void operator()(const f32x4 (&acc)[2][2][4][2], const Unit& u, int wr, int wc, int fr_in, int fq_in) const {
        int lane_ = fr_in + 16 * fq_in; asm volatile("" : "+v"(lane_));
        const int fr = lane_ & 15, fq = lane_ >> 4;
        const int row0 = u.pm * BM + wr * 64, col0 = u.pn * BM + wc * 64, wid = wr * 4 + wc;
#pragma unroll
        for (int ab = 0; ab < 4; ++ab) { const int ai = ab >> 1, mb = (ab & 1) * 2;
            f32x4 xl[4][2][2];
#pragma unroll
            for (int m = mb; m < mb + 2; ++m)
#pragma unroll
                for (int bj = 0; bj < 2; ++bj) { const size_t o = (size_t)(row0 + ai * HALF + m * 16 + fr) * 1024 + col0 + 8 * fq + bj * 32;
                    if (IN_F32) { xl[m][bj][0] = *(const f32x4*)(xin_f + o); xl[m][bj][1] = *(const f32x4*)(xin_f + o + 4); }
                    else { const u32x4 p = *(const u32x4*)(xin_b + o); xl[m][bj][0] = (f32x4){bfl(p.x), bfh(p.x), bfl(p.y), bfh(p.y)}; xl[m][bj][1] = (f32x4){bfl(p.z), bfh(p.z), bfl(p.w), bfh(p.w)}; } }
            float sv[4];
#pragma unroll
            for (int m = mb; m < mb + 2; ++m) { const int rg = row0 + ai * HALF + m * 16; float s = 0.f;
                u32x4 wv[2];
#pragma unroll
                for (int bj = 0; bj < 2; ++bj) { const u32x4 w = pack8(xl[m][bj][0] + acc[ai][bj][m][0], xl[m][bj][1] + acc[ai][bj][m][1]); wv[bj] = w;
                    const float r0 = bfl(w.x), r1 = bfh(w.x), r2 = bfl(w.y), r3 = bfh(w.y), r4 = bfl(w.z), r5 = bfh(w.z), r6 = bfl(w.w), r7 = bfh(w.w);
                    s += (r0 * r0 + r1 * r1) + (r2 * r2 + r3 * r3) + (r4 * r4 + r5 * r5) + (r6 * r6 + r7 * r7); }
                stage_store16x64(wid, fr, fq, wv[0], wv[1], xb + (size_t)rg * 1024 + col0, 1024);
                s += __shfl_xor(s, 16); s += __shfl_xor(s, 32); sv[m] = s; }
#pragma unroll
            for (int m = mb; m < mb + 2; ++m) if (fq == 0) SS[(size_t)(row0 + ai * HALF + m * 16 + fr) * 16 + u.pn * 4 + wc] = sv[m];
        }
    }
};
struct EpiScale {
    static constexpr bool PERM = true, AFTER_DRAIN = false, COL64 = true;
    const float* rstd; bf16_t* O; int ldc;
    __device__ __forceinline__ void operator()(const f32x4 (&acc)[2][2][4][2], const Unit& u, int wr, int wc, int fr_in, int fq_in) const {
        int lane_ = fr_in + 16 * fq_in; asm volatile("" : "+v"(lane_));
        const int fr = lane_ & 15, fq = lane_ >> 4;
        const int row0 = u.pm * BM + wr * 64, col0 = u.pn * BM + wc * 64, wid = wr * 4 + wc;
        float rsv[2][4];
#pragma unroll
        for (int ai = 0; ai < 2; ++ai)
#pragma unroll
            for (int m = 0; m < 4; ++m) rsv[ai][m] = rstd[row0 + ai * HALF + m * 16 + fr];
#pragma unroll
        for (int ai = 0; ai < 2; ++ai)
#pragma unroll
            for (int m = 0; m < 4; ++m) { const int rg = row0 + ai * HALF + m * 16; const float rs = rsv[ai][m];
                stage_store16x64(wid, fr, fq, pack8(acc[ai][0][m][0] * rs, acc[ai][0][m][1] * rs), pack8(acc[ai][1][m][0] * rs, acc[ai][1][m][1] * rs), O + (size_t)rg * ldc + col0, ldc); }
    }
};
template <class Epi, class Sched, bool ALIGN_EPI = false, bool SP2 = false>
__device__ __forceinline__ void gemm_phase(PG8_LAS unsigned char* lds, const Gemm g, const Sched& S, const Epi& E) {
    const int tid = threadIdx.x, wid = __builtin_amdgcn_readfirstlane(tid >> 6), lane = tid & 63, wr = wid >> 2, wc = wid & 3, fr = lane & 15, fq = lane >> 4;
    const int K = g.K, nt = K / BK;
    unsigned voffA[2], voffB[2];
#pragma unroll
    for (int i = 0; i < 2; ++i) { int R, C; stage_rc(tid * 16 + i * 8192, R, C); const int Rb = Epi::PERM ? ((Epi::COL64 ? 2 * (R & ~31) : (R & ~31)) + perm32(R & 31)) : R;
        voffA[i] = (unsigned)(R * K + C) * 2u; voffB[i] = (unsigned)(Rb * K + C) * 2u; }
    const size_t kstep = (size_t)(BK * 2);
    const size_t hstep = (size_t)HALF * K * 2;
    const size_t bhstep = Epi::COL64 ? (size_t)32 * K * 2 : hstep;
    const size_t tstep = 2 * hstep;
    const unsigned ldsw = (unsigned)wid * 1024u;
    const int aoff = lds_byte(wr * 64 + fr, fq * 8), boff = lds_byte(wc * 32 + fr, fq * 8);
#define PG8_SA(b, h) (((b) * 2 + (h)) * HTB)
#define PG8_SB(b, h) ((4 + (b) * 2 + (h)) * HTB)
#define PG8_STAGE(bufoff, gbase, voff) do { _Pragma("unroll") for (int _i = 0; _i < 2; ++_i) \
        __builtin_amdgcn_global_load_lds((const unsigned*)((const char*)(gbase) + (voff)[_i]), (PG8_LAS unsigned*)(lds + (bufoff) + ldsw + _i * 8192), 16, 0, 0); } while (0)
#define PG8_LDA(dst, b, h) do { _Pragma("unroll") for (int m = 0; m < 4; ++m) _Pragma("unroll") for (int k = 0; k < 2; ++k) dst[m][k] = *(const PG8_LAS bf16x8*)(lds + PG8_SA(b, h) + aoff + m * 2048 + k * 1024); } while (0)
#define PG8_LDB(dst, b, h) do { _Pragma("unroll") for (int n = 0; n < 2; ++n) _Pragma("unroll") for (int k = 0; k < 2; ++k) dst[n][k] = *(const PG8_LAS bf16x8*)(lds + PG8_SB(b, h) + boff + n * 2048 + k * 1024); } while (0)
#define PG8_MMA(ai, bj, At, Bt) do { __builtin_amdgcn_s_setprio(1); _Pragma("unroll") for (int m = 0; m < 4; ++m) _Pragma("unroll") for (int n = 0; n < 2; ++n) _Pragma("unroll") for (int k = 0; k < 2; ++k) \
        acc[ai][bj][m][n] = __builtin_amdgcn_mfma_f32_16x16x32_bf16(Bt[n][k], At[m][k], acc[ai][bj][m][n], 0, 0, 0); __builtin_amdgcn_s_setprio(0); } while (0)
#define PG8_WAIT_V(n) asm volatile("s_waitcnt vmcnt(" #n ")" ::: "memory")
#define PG8_WAIT_L(n) asm volatile("s_waitcnt lgkmcnt(" #n ")" ::: "memory")
#define PG8_BAR __builtin_amdgcn_s_barrier()
#define PG8_SCHED __builtin_amdgcn_sched_barrier(0)
    Unit cur, nxt; int ui = 0;
    if (!S.next(0, cur)) return;
    f32x4 acc[2][2][4][2];
#pragma unroll
    for (int a = 0; a < 2; ++a)
#pragma unroll
        for (int b = 0; b < 2; ++b)
#pragma unroll
            for (int m = 0; m < 4; ++m)
#pragma unroll
                for (int n = 0; n < 2; ++n) acc[a][b][m][n] = (f32x4){0.f, 0.f, 0.f, 0.f};
    bf16x8 At[4][2], B0[2][2], B1[2][2];
    const char* cA = (const char*)g.A + (size_t)cur.pm * tstep; const char* cB = (const char*)g.Bt + (size_t)cur.pn * tstep;
    S.a_ready(cur);
    if constexpr (SP2) {
        PG8_STAGE(PG8_SB(0, 0), cB, voffB); PG8_STAGE(PG8_SB(0, 1), cB + bhstep, voffB); PG8_STAGE(PG8_SA(0, 0), cA, voffA); PG8_STAGE(PG8_SA(0, 1), cA + hstep, voffA);
        if (wr == 1) PG8_BAR;
        PG8_WAIT_V(2); PG8_BAR;
        PG8_STAGE(PG8_SB(1, 0), cB + kstep, voffB); PG8_STAGE(PG8_SA(1, 0), cA + kstep, voffA); PG8_STAGE(PG8_SB(1, 1), cB + bhstep + kstep, voffB);
        PG8_WAIT_V(6); PG8_BAR;
    } else {
        PG8_STAGE(PG8_SB(0, 0), cB, voffB); PG8_STAGE(PG8_SA(0, 0), cA, voffA); PG8_STAGE(PG8_SB(0, 1), cB + bhstep, voffB); PG8_STAGE(PG8_SA(0, 1), cA + hstep, voffA);
        if (wr == 1) PG8_BAR;
        PG8_WAIT_V(4); PG8_BAR;
        PG8_STAGE(PG8_SB(1, 0), cB + kstep, voffB); PG8_STAGE(PG8_SA(1, 0), cA + kstep, voffA); PG8_STAGE(PG8_SB(1, 1), cB + bhstep + kstep, voffB);
        PG8_WAIT_V(6); PG8_BAR;
    }
    for (;;) {
        const bool has_next = S.next(ui + 1, nxt);
        const char* nA = has_next ? (const char*)g.A + (size_t)nxt.pm * tstep : cA; const char* nB = has_next ? (const char*)g.Bt + (size_t)nxt.pn * tstep : cB;
        for (int t = 0; t < nt; t += 2) {
            const bool last = (t == nt - 2);
            const char* a1 = cA + (size_t)(t + 1) * kstep;
            const char* a2 = last ? nA : cA + (size_t)(t + 2) * kstep; const char* b2 = last ? nB : cB + (size_t)(t + 2) * kstep;
            const char* a3 = a2 + kstep; const char* b3 = b2 + kstep;
            if (last && has_next) S.a_ready(nxt);
            if constexpr (SP2) {
            PG8_LDB(B0, 0, 0); PG8_LDB(B1, 0, 1); PG8_SCHED; PG8_LDA(At, 0, 0); PG8_STAGE(PG8_SA(1, 1), a1 + hstep, voffA);
            PG8_WAIT_V(8); PG8_WAIT_L(0); PG8_BAR; PG8_MMA(0, 0, At, B0); PG8_MMA(0, 1, At, B1); PG8_BAR; PG8_SCHED;
            PG8_LDA(At, 0, 1); PG8_STAGE(PG8_SB(0, 0), b2, voffB); PG8_STAGE(PG8_SB(0, 1), b2 + bhstep, voffB); PG8_STAGE(PG8_SA(0, 0), a2, voffA);
            PG8_WAIT_V(8); PG8_WAIT_L(0); PG8_BAR; PG8_MMA(1, 0, At, B0); PG8_MMA(1, 1, At, B1); PG8_BAR; PG8_SCHED;
            PG8_LDB(B0, 1, 0); PG8_LDB(B1, 1, 1); PG8_SCHED; PG8_LDA(At, 1, 0); PG8_STAGE(PG8_SA(0, 1), a2 + hstep, voffA);
            PG8_WAIT_V(8); PG8_WAIT_L(0); PG8_BAR; PG8_MMA(0, 0, At, B0); PG8_MMA(0, 1, At, B1); PG8_BAR; PG8_SCHED;
            PG8_LDA(At, 1, 1); PG8_STAGE(PG8_SB(1, 0), b3, voffB); PG8_STAGE(PG8_SB(1, 1), b3 + bhstep, voffB); PG8_STAGE(PG8_SA(1, 0), a3, voffA);
            PG8_WAIT_V(8); PG8_WAIT_L(0); PG8_BAR; PG8_MMA(1, 0, At, B0); PG8_MMA(1, 1, At, B1); PG8_BAR; PG8_SCHED;
            } else {
            PG8_LDB(B0, 0, 0); PG8_SCHED; PG8_LDA(At, 0, 0); PG8_STAGE(PG8_SA(1, 1), a1 + hstep, voffA);
            PG8_WAIT_L(8); PG8_BAR; PG8_WAIT_L(0); PG8_MMA(0, 0, At, B0); PG8_BAR; PG8_SCHED;
            PG8_LDB(B1, 0, 1); PG8_STAGE(PG8_SB(0, 0), b2, voffB);
            PG8_BAR; PG8_WAIT_L(0); PG8_MMA(0, 1, At, B1); PG8_BAR;
            PG8_LDA(At, 0, 1); PG8_STAGE(PG8_SA(0, 0), a2, voffA);
            PG8_BAR; PG8_WAIT_L(0); PG8_MMA(1, 0, At, B0); PG8_BAR; PG8_SCHED;
            PG8_STAGE(PG8_SB(0, 1), b2 + bhstep, voffB);
            PG8_WAIT_V(6); PG8_BAR; PG8_MMA(1, 1, At, B1); PG8_BAR;
            PG8_LDB(B0, 1, 0); PG8_SCHED; PG8_LDA(At, 1, 0); PG8_STAGE(PG8_SA(0, 1), a2 + hstep, voffA);
            PG8_WAIT_L(8); PG8_BAR; PG8_WAIT_L(0); PG8_MMA(0, 0, At, B0); PG8_BAR; PG8_SCHED;
            PG8_LDB(B1, 1, 1); PG8_STAGE(PG8_SB(1, 0), b3, voffB);
            PG8_BAR; PG8_WAIT_L(0); PG8_MMA(0, 1, At, B1); PG8_BAR;
            PG8_LDA(At, 1, 1); PG8_STAGE(PG8_SA(1, 0), a3, voffA);
            PG8_BAR; PG8_WAIT_L(0); PG8_MMA(1, 0, At, B0); PG8_BAR; PG8_SCHED;
            PG8_STAGE(PG8_SB(1, 1), b3 + bhstep, voffB);
            PG8_WAIT_V(6); PG8_BAR; PG8_MMA(1, 1, At, B1); PG8_BAR;
            }
        }
        if constexpr (ALIGN_EPI) { if (wr == 0) PG8_BAR; }
        if constexpr (!Epi::AFTER_DRAIN) { E(acc, cur, wr, wc, fr, fq); S.done(cur); }
        if (!has_next) break;
#pragma unroll
        for (int a = 0; a < 2; ++a)
#pragma unroll
            for (int b = 0; b < 2; ++b)
#pragma unroll
                for (int m = 0; m < 4; ++m)
#pragma unroll
                    for (int n = 0; n < 2; ++n) acc[a][b][m][n] = (f32x4){0.f, 0.f, 0.f, 0.f};
        cur = nxt; cA = nA; cB = nB; ++ui;
        if constexpr (ALIGN_EPI) { if (wr == 1) PG8_BAR; }
    }
    PG8_WAIT_V(0);
    if constexpr (!ALIGN_EPI) { if (wr == 0) PG8_BAR; }
    PG8_BAR;
    if constexpr (Epi::AFTER_DRAIN) { E.fused(acc, cur, wr, wc, fr, fq, lds, wid, lane); S.done(cur); }
#undef PG8_SA
#undef PG8_SB
#undef PG8_STAGE
#undef PG8_LDA
#undef PG8_LDB
#undef PG8_MMA
#undef PG8_WAIT_V
#undef PG8_WAIT_L
#undef PG8_BAR
#undef PG8_SCHED
}
}
#define GAS __attribute__((address_space(1)))
#define LAS __attribute__((address_space(3)))
typedef unsigned short bf16;
typedef unsigned v4u __attribute__((ext_vector_type(4)));
typedef float f32x4 __attribute__((ext_vector_type(4)));
typedef short bf16x8 __attribute__((ext_vector_type(8)));
typedef GAS unsigned gu32;
typedef GAS unsigned long long gu64;
#define RLX_AGENT __ATOMIC_RELAXED, __HIP_MEMORY_SCOPE_AGENT
#define LDS_WAIT() asm volatile("s_waitcnt lgkmcnt(0)" ::: "memory")
#define VM_WAIT() asm volatile("s_waitcnt vmcnt(0)" ::: "memory")
__device__ __forceinline__ unsigned long long rt() { return __builtin_amdgcn_s_memrealtime(); }
__device__ __forceinline__ unsigned pk2(float lo, float hi) { return (unsigned)f2bf(lo) | ((unsigned)f2bf(hi) << 16); }

#define XB_TMO      128
#define XB_XCNT(j)  (256  + 64 * (j))
#define XB_XSUB(j)  (1280 + 64 * (j))
#define XB_XGEN(j)  (2304 + 64 * (j))
#define XB_TOP      3328
#define XB_TOPGEN   3392
#define XCD_BAR_WORDS 3456
#define XB_SPIN_CAP (1u << 18)

__device__ __forceinline__ unsigned xb_ld(unsigned* p)              { return __hip_atomic_load(p, __ATOMIC_RELAXED, __HIP_MEMORY_SCOPE_AGENT); }
__device__ __forceinline__ unsigned xb_add(unsigned* p, unsigned v) { return __hip_atomic_fetch_add(p, v, __ATOMIC_RELAXED, __HIP_MEMORY_SCOPE_AGENT); }
__device__ __forceinline__ unsigned xb_xcc_id() { return (unsigned)__builtin_amdgcn_s_getreg((3 << 11) | 20) & 0xFu; }
#define XB_SPIN(cond, bar) do { unsigned _sp = 0; while (cond) { __builtin_amdgcn_s_sleep(1); \
    if ((++_sp & 255u) == 0u) { if (xb_ld(&(bar)[XB_TMO])) break; if (_sp > XB_SPIN_CAP) { atomicAdd(&(bar)[XB_TMO], 1u); break; } } } } while (0)

struct XcdBarrier {
    unsigned* bar; unsigned x;
    volatile LAS unsigned* st;
};

__device__ __forceinline__ XcdBarrier xcd_barrier_post(unsigned* bar, volatile LAS unsigned* st) {
    XcdBarrier b; b.bar = bar; b.x = xb_xcc_id(); b.st = st;
    if (threadIdx.x == 0) (void)xb_add(&bar[XB_XCNT(b.x)], 1u);
    return b;
}
__device__ __forceinline__ void xcd_barrier_complete(unsigned* bar, unsigned x, unsigned& nloc, unsigned& nx) {
    const unsigned G = gridDim.x * gridDim.y * gridDim.z;
    unsigned sum, cnt, mine, sp = 0u;
    for (;;) {
        sum = 0u; cnt = 0u; mine = 0u;
#pragma unroll
        for (unsigned j = 0; j < 16; ++j) { const unsigned c = xb_ld(&bar[XB_XCNT(j)]); sum += c; cnt += (c > 0u) ? 1u : 0u; mine = (j == x) ? c : mine; }
        if (sum == G) break;
        __builtin_amdgcn_s_sleep(1);
        if ((++sp & 255u) == 0u) { if (xb_ld(&bar[XB_TMO])) break; if (sp > XB_SPIN_CAP) { atomicAdd(&bar[XB_TMO], 1u); break; } }
    }
    nloc = mine > 0u ? mine : 1u; nx = cnt > 0u ? cnt : 1u;
}

__device__ __forceinline__ void xcd_barrier(const XcdBarrier& b) {
    asm volatile("s_waitcnt vmcnt(0)" ::: "memory");
    __syncthreads();
    if (threadIdx.x == 0) {
        unsigned* bar = b.bar;
        __builtin_amdgcn_s_waitcnt(0);
        unsigned nloc = b.st[0], nx = b.st[1];
        if (nloc == 0u) { xcd_barrier_complete(bar, b.x, nloc, nx); b.st[0] = nloc; b.st[1] = nx; }
        const unsigned old = xb_add(&bar[XB_XSUB(b.x)], 1u);
        const unsigned gen = old / nloc;
        if (old + 1u == (gen + 1u) * nloc) {
            __builtin_amdgcn_fence(__ATOMIC_RELEASE, "agent");
            asm volatile("s_waitcnt vmcnt(0)" ::: "memory");
            const unsigned og = xb_add(&bar[XB_TOP], 1u);
            const unsigned tg = og / nx;
            if (og + 1u == (tg + 1u) * nx) xb_add(&bar[XB_TOPGEN], 1u);
            else XB_SPIN(xb_ld(&bar[XB_TOPGEN]) == tg, bar);
            __builtin_amdgcn_fence(__ATOMIC_ACQUIRE, "agent");
            xb_add(&bar[XB_XGEN(b.x)], 1u);
            asm volatile("s_waitcnt vmcnt(0)" ::: "memory");
        } else {
            XB_SPIN(xb_ld(&bar[XB_XGEN(b.x)]) == gen, bar);
            __builtin_amdgcn_fence(__ATOMIC_ACQUIRE, "agent");
            asm volatile("s_waitcnt vmcnt(0)" ::: "memory");
        }
    }
    __syncthreads();
}
constexpr size_t KiB = 1024;
constexpr size_t WS_CTL = 0, CTL_ZERO_BYTES = 1 * MiB;
constexpr size_t WS_WIN = 1 * MiB, WS_WSB = 12 * MiB, WS_WGDN = 13 * MiB, WS_WMIX = 14 * MiB, WS_WCQ = 16 * MiB, WS_WCO = 18 * MiB, WS_WCKV = 20 * MiB, WS_WPQ = 24 * MiB, WS_SKB = 28 * MiB, WS_U16 = 30 * MiB, WS_V16 = 62 * MiB;
constexpr size_t WS_RSTD0 = 94 * MiB, WS_RSTD2 = 94 * MiB + 256 * KiB, WS_CD = 94 * MiB + 384 * KiB, WS_GB = 94 * MiB + 512 * KiB;
constexpr size_t WS_MN = 96 * MiB, WS_KC = 98 * MiB, WS_VC = 100 * MiB, WS_SS = 102 * MiB;
constexpr size_t WS_A0 = 104 * MiB;
constexpr size_t WS_NW = 104 * MiB, WS_QD = 136 * MiB;
constexpr size_t WS_A1 = 168 * MiB;
constexpr size_t WS_ORAW = 168 * MiB, WS_OSS = 200 * MiB, WS_OG = 232 * MiB;
constexpr size_t WS_GZ = 264 * MiB;
constexpr size_t WS_GSB = 296 * MiB, WS_GGDN = 360 * MiB;
constexpr size_t WS_KDT = 424 * MiB, WS_QK = 456 * MiB, WS_UT = 472 * MiB;
constexpr size_t WS_U8 = 30 * MiB, WS_V8 = 46 * MiB, WS_SUV = 62 * MiB;
constexpr size_t WS_PART = 344 * MiB;
constexpr size_t WS_END = 512 * MiB;
constexpr int CW_SUB = 12288;
constexpr int CW_BAR = 4096;

constexpr int NWAVES = 8;
constexpr int RING_BYTES = 131072, LDSCTL_OFF = RING_BYTES, MISC_OFF = LDSCTL_OFF + 320, LDS_BYTES = 149504;

struct Args {
    const float *x, *mem, *g_mix, *w_in, *gdn_conv, *a_log, *dt_bias, *gdn_norm_g, *w_sb_up, *w_gdn_up, *w_mix_out, *g_cross, *g_mem, *w_cq, *w_ckv, *w_co, *g_peer, *w_pq, *subkeys, *peer_u, *peer_v, *g_final;
    float* out; unsigned char* ws; int ph_lo, ph_hi, bar_region, pad;
};

struct Frame {
    LAS unsigned char* lds; int tid, lane, wave, vcu, G;
};


typedef short bf16x8_t __attribute__((ext_vector_type(8)));
typedef float f32x16_t __attribute__((ext_vector_type(16)));
typedef short v4i16_t __attribute__((ext_vector_type(4)));
typedef float f32x2v_t __attribute__((ext_vector_type(2))); typedef __bf16 bf16x2v_t __attribute__((ext_vector_type(2)));
__device__ __forceinline__ unsigned cvtpk(float lo, float hi) { f32x2v_t v = {lo, hi}; bf16x2v_t b = __builtin_convertvector(v, bf16x2v_t); return __builtin_bit_cast(unsigned, b); }
__device__ __forceinline__ v4i16_t lds_tr16(LAS unsigned char* p) { return __builtin_amdgcn_ds_read_tr16_b64_v4i16((LAS v4i16_t*)p); }

__device__ __forceinline__ void sb_phase(LAS unsigned char* wlds  , const bf16_t* SBQ, const bf16_t* SBK, const bf16_t* SBV, bf16_t* OSB, int gw, int ngw, int lane) {
    const int q = lane & 31, hi = lane >> 5;
    bf16x8_t Mf[2];
#pragma unroll
    for (int s = 0; s < 2; ++s)
#pragma unroll
        for (int j = 0; j < 8; ++j) { const int k = 16 * s + 8 * (j >> 2) + 4 * hi + (j & 3); Mf[s][j] = (k > q) ? (short)0x3F80 : (short)0; }
    const int vrow = lane >> 3, vch = lane & 7;
    const int g4 = lane >> 4, qq = (lane >> 2) & 3, p4 = lane & 3;
    LAS unsigned char* trb = wlds + (4 * (g4 >> 1) + qq) * 192 + ((g4 & 1) * 16 + 4 * p4) * 2;
    for (int item = gw; item < 32 * 256; item += ngw) {
        const int bh = item >> 8, qt = item & 255, b = bh >> 3, h = bh & 7;
        const size_t base = (size_t)b * SEQ;
        const bf16_t* Qp = SBQ + (base + qt * 32 + q) * 512 + h * 64 + 8 * hi;
        bf16x8_t Qf[4];
#pragma unroll
        for (int ks = 0; ks < 4; ++ks) Qf[ks] = *(const bf16x8_t*)(Qp + 16 * ks);
        f32x16_t o0 = {}, o1 = {};
        float carry = 0.f;
        bf16x8_t Kn[4]; v4u vn[4];
        {   const bf16_t* Kp = SBK + (base + qt * 32 + q) * 512 + h * 64 + 8 * hi;
#pragma unroll
            for (int ks = 0; ks < 4; ++ks) Kn[ks] = *(const bf16x8_t*)(Kp + 16 * ks);
#pragma unroll
            for (int i = 0; i < 4; ++i) vn[i] = *(const v4u*)(SBV + (base + qt * 32 + vrow + 8 * i) * 512 + h * 64 + vch * 8); }
        for (int kb = qt; kb >= 0; --kb) {
            bf16x8_t Kf[4]; v4u vv[4];
#pragma unroll
            for (int ks = 0; ks < 4; ++ks) Kf[ks] = Kn[ks];
#pragma unroll
            for (int i = 0; i < 4; ++i) vv[i] = vn[i];
            {   const int kn = kb > 0 ? kb - 1 : 0;
                const bf16_t* Kp = SBK + (base + kn * 32 + q) * 512 + h * 64 + 8 * hi;
#pragma unroll
                for (int ks = 0; ks < 4; ++ks) Kn[ks] = *(const bf16x8_t*)(Kp + 16 * ks);
#pragma unroll
                for (int i = 0; i < 4; ++i) vn[i] = *(const v4u*)(SBV + (base + kn * 32 + vrow + 8 * i) * 512 + h * 64 + vch * 8); }
            f32x16_t st = {};
#pragma unroll
            for (int ks = 0; ks < 4; ++ks) st = __builtin_amdgcn_mfma_f32_32x32x16_bf16(Kf[ks], Qf[ks], st, 0, 0, 0);
#pragma unroll
            for (int i = 0; i < 4; ++i) *(LAS v4u*)(wlds + (vrow + 8 * i) * 192 + vch * 16) = vv[i];
            const bool diag = (kb == qt);
            float z[16], lk[16];
#pragma unroll
            for (int r = 0; r < 16; ++r) {
                const int key = (r & 3) + 8 * (r >> 2) + 4 * hi;
                z[r] = st[r] * 0.125f;
                const float sp = fmaxf(z[r], 0.f) + __logf(1.f + __expf(-fabsf(z[r])));
                const bool valid = !diag || key < q;
                lk[r] = valid ? -sp : 0.f;
                z[r] = valid ? z[r] - sp : -INFINITY;
            }
            bf16x8_t lh[2], ll[2];
#pragma unroll
            for (int s = 0; s < 2; ++s) {
                unsigned wh[4], wl[4];
#pragma unroll
                for (int jj = 0; jj < 4; ++jj) { const float a = lk[8 * s + 2 * jj], c = lk[8 * s + 2 * jj + 1]; wh[jj] = cvtpk(a, c);
                    wl[jj] = cvtpk(a - __uint_as_float(wh[jj] << 16), c - __uint_as_float(wh[jj] & 0xffff0000u)); }
                lh[s] = __builtin_bit_cast(bf16x8_t, (v4u){wh[0], wh[1], wh[2], wh[3]}); ll[s] = __builtin_bit_cast(bf16x8_t, (v4u){wl[0], wl[1], wl[2], wl[3]});
            }
            f32x16_t af;
#pragma unroll
            for (int r = 0; r < 16; ++r) af[r] = carry;
            af = __builtin_amdgcn_mfma_f32_32x32x16_bf16(Mf[0], lh[0], af, 0, 0, 0);
            af = __builtin_amdgcn_mfma_f32_32x32x16_bf16(Mf[1], lh[1], af, 0, 0, 0);
            af = __builtin_amdgcn_mfma_f32_32x32x16_bf16(Mf[0], ll[0], af, 0, 0, 0);
            af = __builtin_amdgcn_mfma_f32_32x32x16_bf16(Mf[1], ll[1], af, 0, 0, 0);
            float tot = af[0] + lk[0];
            tot = __shfl(tot, q);
            float pr[16];
#pragma unroll
            for (int r = 0; r < 16; ++r) pr[r] = __expf(z[r] + af[r]);
            bf16x8_t pa[2];
#pragma unroll
            for (int s = 0; s < 2; ++s) pa[s] = __builtin_bit_cast(bf16x8_t, (v4u){cvtpk(pr[8 * s], pr[8 * s + 1]), cvtpk(pr[8 * s + 2], pr[8 * s + 3]), cvtpk(pr[8 * s + 4], pr[8 * s + 5]), cvtpk(pr[8 * s + 6], pr[8 * s + 7])});
            asm volatile("s_waitcnt lgkmcnt(0)" ::: "memory");
#pragma unroll
            for (int s = 0; s < 2; ++s) {
                const v4i16_t a0 = lds_tr16(trb + (16 * s) * 192), a1 = lds_tr16(trb + (16 * s + 8) * 192);
                const v4i16_t c0 = lds_tr16(trb + (16 * s) * 192 + 64), c1 = lds_tr16(trb + (16 * s + 8) * 192 + 64);
                const bf16x8_t vb0 = {a0[0], a0[1], a0[2], a0[3], a1[0], a1[1], a1[2], a1[3]}, vb1 = {c0[0], c0[1], c0[2], c0[3], c1[0], c1[1], c1[2], c1[3]};
                o0 = __builtin_amdgcn_mfma_f32_32x32x16_bf16(pa[s], vb0, o0, 0, 0, 0);
                o1 = __builtin_amdgcn_mfma_f32_32x32x16_bf16(pa[s], vb1, o1, 0, 0, 0);
            }
            carry = tot;
            if (__all(carry < -104.f)) break;
        }
        bf16_t* Op = OSB + (base + qt * 32) * 512 + h * 64 + q;
#pragma unroll
        for (int r = 0; r < 16; ++r) { const int row = (r & 3) + 8 * (r >> 2) + 4 * hi; Op[(size_t)row * 512] = f2bf(o0[r]); Op[(size_t)row * 512 + 32] = f2bf(o1[r]); }
    }
}
typedef float f32x4_t __attribute__((ext_vector_type(4)));
typedef unsigned v2u __attribute__((ext_vector_type(2)));
__device__ __forceinline__ float bflo(unsigned w) { return __uint_as_float(w << 16); }
__device__ __forceinline__ float bfhi(unsigned w) { return __uint_as_float(w & 0xffff0000u); }
__device__ __forceinline__ int frag_off(int r, int k0, int KS) { return (((r >> 4) * KS + (k0 >> 5)) << 9) + (((r & 15) + 16 * ((k0 & 15) >> 2)) << 3) + (((k0 & 31) >> 4) << 2); }

constexpr int GP_KS = 0, GP_QS = 17408, GP_VS = 34816, GP_AS = 52224, GP_WT = 69632, GP_GC = 87040, GP_BETA = 87296, GP_EGC = 87552, GP_CW = 88064, GP_TS = 94208;
constexpr int GROW = 136;

#define LDS_BARRIER() do { asm volatile("s_waitcnt lgkmcnt(0)" ::: "memory"); __builtin_amdgcn_s_barrier(); asm volatile("" ::: "memory"); } while (0)
struct GdnBufs { bf16_t *NW, *QD, *KDT, *QK, *UT; float* CD; bf16_t* ORAW; float* OSS; };

__device__ __forceinline__ void gdn_prep_phase(Frame& F, const Args& a, const bf16_t* GQKV, const float* GB, const float* GA, const GdnBufs& Gb) {
    LAS unsigned char* L = F.lds;
    LAS bf16_t* KS = (LAS bf16_t*)(L + GP_KS); LAS bf16_t* QS = (LAS bf16_t*)(L + GP_QS); LAS bf16_t* VS = (LAS bf16_t*)(L + GP_VS); LAS bf16_t* WT = (LAS bf16_t*)(L + GP_WT);
    LAS float* AS = (LAS float*)(L + GP_AS); LAS float* GC = (LAS float*)(L + GP_GC); LAS float* BETA = (LAS float*)(L + GP_BETA); LAS float* EGC = (LAS float*)(L + GP_EGC); LAS float* CW = (LAS float*)(L + GP_CW); LAS float* TS = (LAS float*)(L + GP_TS);
    const int tid = F.tid, lane = F.lane, wave = F.wave;
    const int per = (2048 + F.G - 1) / F.G;
    int hcur = -1;
    for (int ii = 0; ii < per; ++ii) {
        const int item = F.vcu * per + ii; if (item >= 2048) break;
        const int bh = item >> 7, n = item & 127, b = bh >> 2, h = bh & 3;
        const size_t t0 = (size_t)b * SEQ + n * 64;
        if (h != hcur) { hcur = h; for (int i = tid; i < 1536; i += NWAVES * 64) { const int j = i / 384, cc = i % 384; CW[i] = a.gdn_conv[j * 1536 + (cc >> 7) * 512 + h * 128 + (cc & 127)]; } }
        unsigned pf = 0u;
        if (ii + 1 < per && item + 1 < 2048 && tid < 384) {
            const int r = tid / 6, q6 = tid % 6; const int item2 = item + 1, bh2 = item2 >> 7, n2 = item2 & 127;
            pf = *(const unsigned*)(GQKV + ((size_t)(bh2 >> 2) * SEQ + n2 * 64 + r) * 1536 + (q6 >> 1) * 512 + (bh2 & 3) * 128 + (q6 & 1) * 64);
        }
        if (wave == 0) {
            const size_t t = t0 + lane;
            float g = -__expf(a.a_log[h]) * softplusf_(GA[t * 4 + h] + a.dt_bias[h]);
#pragma unroll
            for (int o = 1; o < 64; o <<= 1) { const float up = __shfl_up(g, o); if (lane >= o) g += up; }
            GC[lane] = g; BETA[lane] = sigmoidf_(GB[t * 4 + h]); EGC[lane] = __expf(g);
            if (lane == 63) Gb.CD[item] = __expf(g);
        }
        LDS_BARRIER();
        {
            const int c = tid >> 3, d0 = (tid & 7) * 16;
#pragma unroll
            for (int part = 0; part < 3; ++part) {
                float acc[16];
#pragma unroll
                for (int i = 0; i < 16; ++i) acc[i] = 0.f;
#pragma unroll
                for (int j = 0; j < 4; ++j) {
                    if (n * 64 + c - 3 + j >= 0) {
                        const bf16_t* src = GQKV + (t0 + c - 3 + j) * 1536 + part * 512 + h * 128 + d0;
                        const v4u r0 = *(const v4u*)src, r1 = *(const v4u*)(src + 8);
                        const unsigned rw[8] = {r0.x, r0.y, r0.z, r0.w, r1.x, r1.y, r1.z, r1.w};
                        const LAS float* cw = CW + j * 384 + part * 128 + d0;
#pragma unroll
                        for (int i = 0; i < 8; ++i) { acc[2 * i] += bflo(rw[i]) * cw[2 * i]; acc[2 * i + 1] += bfhi(rw[i]) * cw[2 * i + 1]; }
                    }
                }
                float ss = 0.f;
#pragma unroll
                for (int i = 0; i < 16; ++i) { acc[i] = acc[i] / (1.f + __expf(-acc[i])); ss += acc[i] * acc[i]; }
                if (part < 2) { ss += __shfl_xor(ss, 1); ss += __shfl_xor(ss, 2); ss += __shfl_xor(ss, 4); const float inv = rsqrtf(ss + EPS);
#pragma unroll
                    for (int i = 0; i < 16; ++i) acc[i] *= inv; }
                LAS bf16_t* dst = (part == 0 ? QS : part == 1 ? KS : VS) + c * GROW + d0;
                v4u w0, w1; w0.x = cvtpk(acc[0], acc[1]); w0.y = cvtpk(acc[2], acc[3]); w0.z = cvtpk(acc[4], acc[5]); w0.w = cvtpk(acc[6], acc[7]);
                w1.x = cvtpk(acc[8], acc[9]); w1.y = cvtpk(acc[10], acc[11]); w1.z = cvtpk(acc[12], acc[13]); w1.w = cvtpk(acc[14], acc[15]);
                *(LAS v4u*)dst = w0; *(LAS v4u*)(dst + 8) = w1;
            }
        }
        LDS_BARRIER();
        {
            const int fr = lane & 15, g = lane >> 4;
            for (int task = wave; task < 26; task += NWAVES) {
                const bool isKK = task < 10; int ct, mt;
                if (isKK) { ct = task >= 6 ? 3 : task >= 3 ? 2 : task >= 1 ? 1 : 0; mt = task - ct * (ct + 1) / 2; } else { ct = (task - 10) >> 2; mt = (task - 10) & 3; }
                f32x4_t acc = {0.f, 0.f, 0.f, 0.f};
                if (mt <= ct) {
                    const LAS bf16_t* Ap = KS + (mt * 16 + fr) * GROW + 8 * g; const LAS bf16_t* Bp = (isKK ? KS : QS) + (ct * 16 + fr) * GROW + 8 * g;
#pragma unroll
                    for (int ks = 0; ks < 4; ++ks) acc = __builtin_amdgcn_mfma_f32_16x16x32_bf16(*(const LAS bf16x8_t*)(Ap + 32 * ks), *(const LAS bf16x8_t*)(Bp + 32 * ks), acc, 0, 0, 0);
                }
                const int c = ct * 16 + fr, m0 = mt * 16 + 4 * g; const float gcc = GC[c];
                float v[4];
#pragma unroll
                for (int r = 0; r < 4; ++r) { const int m = m0 + r; const float dec = __expf(fminf(gcc - GC[m], 0.f)); v[r] = acc[r] * dec; }
                if (isKK) { const float bc = BETA[c];
                    f32x4_t o;
#pragma unroll
                    for (int r = 0; r < 4; ++r) o[r] = (c > m0 + r) ? v[r] * bc : 0.f;
                    *(LAS f32x4_t*)(AS + c * 68 + m0) = o;
                } else {
#pragma unroll
                    for (int r = 0; r < 4; ++r) v[r] = (c >= m0 + r) ? v[r] * 0.08838834764831845f : 0.f;
                    v2u w; w.x = cvtpk(v[0], v[1]); w.y = cvtpk(v[2], v[3]);
                    *(v2u*)(Gb.QK + (size_t)item * 4096 + (ct * 2 + (mt >> 1)) * 512 + lane * 8 + (mt & 1) * 4) = w;
                }
            }
        }
        LDS_BARRIER();
        if (wave == 0) {
            const int q4 = lane >> 4, c = lane & 15; const LAS float* Ab = AS + (16 * q4) * 68 + 16 * q4;
            float t[16];
#pragma unroll
            for (int r = 0; r < 16; ++r) { float s = (r == c) ? 1.f : 0.f;
#pragma unroll
                for (int j4 = 0; j4 < (r + 3) / 4; ++j4) { const f32x4_t av = *(const LAS f32x4_t*)(Ab + r * 68 + 4 * j4);
#pragma unroll
                    for (int i = 0; i < 4; ++i) if (4 * j4 + i < r) s -= av[i] * t[4 * j4 + i]; }
                t[r] = s; TS[(q4 * 16 + r) * 20 + c] = (r == c) ? 0.f : s; }
        }
        LDS_BARRIER();
        {
            const int fr = lane & 15, g = lane >> 4;
#pragma unroll
            for (int cc = 0; cc < 2; ++cc) {
                const int ct2 = wave * 2 + cc; const bool isW = ct2 >= 8; const int col = (ct2 & 7) * 16 + fr;
                const LAS bf16_t* src = (isW ? KS : VS) + col;
                unsigned xb[4][2];
#pragma unroll
                for (int i = 0; i < 4; ++i) {
                    f32x4_t y;
#pragma unroll
                    for (int r = 0; r < 4; ++r) { const int row = 16 * i + 4 * g + r; float v = bf2f(src[row * GROW]) * BETA[row]; if (isW) v *= EGC[row]; y[r] = v; }
#pragma unroll
                    for (int j = 0; j < i; j += 2) {
                        const LAS float* ap = AS + (16 * i + fr) * 68 + 16 * j + 4 * g;
                        const f32x4_t a0 = *(const LAS f32x4_t*)ap; f32x4_t a1 = {0.f, 0.f, 0.f, 0.f}; if (j + 1 < i) a1 = *(const LAS f32x4_t*)(ap + 16);
                        const bf16x8_t af = __builtin_bit_cast(bf16x8_t, (v4u){cvtpk(-a0[0], -a0[1]), cvtpk(-a0[2], -a0[3]), cvtpk(-a1[0], -a1[1]), cvtpk(-a1[2], -a1[3])});
                        const bf16x8_t bfr = __builtin_bit_cast(bf16x8_t, (v4u){xb[j][0], xb[j][1], (j + 1 < i) ? xb[j + 1][0] : 0u, (j + 1 < i) ? xb[j + 1][1] : 0u});
                        y = __builtin_amdgcn_mfma_f32_16x16x32_bf16(af, bfr, y, 0, 0, 0);
                    }
                    const f32x4_t tv = *(const LAS f32x4_t*)(TS + (i * 16 + fr) * 20 + 4 * g);
                    const bf16x8_t tf = __builtin_bit_cast(bf16x8_t, (v4u){cvtpk(tv[0], tv[1]), cvtpk(tv[2], tv[3]), 0u, 0u});
                    const bf16x8_t yf = __builtin_bit_cast(bf16x8_t, (v4u){cvtpk(y[0], y[1]), cvtpk(y[2], y[3]), 0u, 0u});
                    const f32x4_t x = __builtin_amdgcn_mfma_f32_16x16x32_bf16(tf, yf, y, 0, 0, 0);
                    xb[i][0] = cvtpk(x[0], x[1]); xb[i][1] = cvtpk(x[2], x[3]);
                    if (!isW) { *(v2u*)(Gb.UT + (size_t)item * 8192 + col * 64 + 16 * i + 4 * g) = (v2u){xb[i][0], xb[i][1]}; }
                    else {
#pragma unroll
                        for (int r = 0; r < 4; ++r) WT[(16 * i + 4 * g + r) * GROW + col] = f2bf(-x[r]); }
                }
            }
        }
        {
            const float glast = GC[63];
#pragma unroll
            for (int i = 0; i < 4; ++i) { const int p = tid + 512 * i, c = p >> 5, d0 = (p & 31) * 4; const v2u r = *(const LAS v2u*)(QS + c * GROW + d0); const float sc = EGC[c] * 0.08838834764831845f;
                v2u w; w.x = cvtpk(bflo(r.x) * sc, bfhi(r.x) * sc); w.y = cvtpk(bflo(r.y) * sc, bfhi(r.y) * sc);
                *(v2u*)(Gb.QD + (size_t)item * 8192 + frag_off(c, d0, 4)) = w; }
#pragma unroll
            for (int i = 0; i < 4; ++i) { const int p = tid + 512 * i, d = p >> 4, c0 = (p & 15) * 4; float v[4];
#pragma unroll
                for (int r = 0; r < 4; ++r) v[r] = bf2f(KS[(c0 + r) * GROW + d]) * __expf(glast - GC[c0 + r]);
                v2u w; w.x = cvtpk(v[0], v[1]); w.y = cvtpk(v[2], v[3]);
                *(v2u*)(Gb.KDT + (size_t)item * 8192 + frag_off(d, c0, 2)) = w; }
        }
        LDS_BARRIER();
#pragma unroll
        for (int i = 0; i < 4; ++i) { const int p = tid + 512 * i, c = p >> 5, d0 = (p & 31) * 4; const v2u r = *(const LAS v2u*)(WT + c * GROW + d0);
            *(v2u*)(Gb.NW + (size_t)item * 8192 + frag_off(c, d0, 4)) = r; }
        asm volatile("" :: "v"(pf));
        LDS_BARRIER();
    }
}

__device__ __forceinline__ void gdn_scan_unit(Frame& F, int s, const GdnBufs& Gb) {
    const int bh = s >> 2, half = s & 3, h = bh & 3, b = bh >> 2;
    const int tid = F.tid, lane = F.lane, wave = F.wave, fr = lane & 15, g = lane >> 4;
    LAS unsigned char* L = F.lds;
    const size_t tb = (size_t)b * SEQ;
    const int item0 = bh * 128;
    const int lt = tid - 256;
#define GDN_SRC(it, i) ((i) < 4 ? (const v4u*)(Gb.NW + (size_t)(it) * 8192) + lt + 256 * (i) : (i) < 8 ? (const v4u*)(Gb.QD + (size_t)(it) * 8192) + lt + 256 * ((i) - 4) : \
                        (i) < 12 ? (const v4u*)(Gb.KDT + (size_t)(it) * 8192) + lt + 256 * ((i) - 8) : (i) < 14 ? (const v4u*)(Gb.QK + (size_t)(it) * 4096) + lt + 256 * ((i) - 12) : \
                        (const v4u*)(Gb.UT + (size_t)(it) * 8192 + half * 2048) + lt + 256 * ((i) - 14))
#define GDN_LOADR(R, it) do { _Pragma("unroll") for (int i_ = 0; i_ < 15; ++i_) R[i_] = *GDN_SRC(it, i_); } while (0)
#define GDN_STORER(R, bufp) do { _Pragma("unroll") for (int i_ = 0; i_ < 15; ++i_) *(LAS v4u*)((bufp) + (i_ * 256 + lt) * 16) = R[i_]; } while (0)
    LAS float* CDL = (LAS float*)(L + 131072 + 1024);
    LAS bf16_t* OTB = (LAS bf16_t*)(L + 131072 + 2048);
#define GDN_OSTORE(step) do { if (wave < 6 && (step) < 128) { const LAS bf16_t* ot_ = OTB + ((wave - 4) * 2 + ((step) & 1)) * 1024; \
        const v4u o0_ = *(const LAS v4u*)(ot_ + lane * 16), o1_ = *(const LAS v4u*)(ot_ + lane * 16 + 8); \
        bf16_t* dst_ = Gb.ORAW + (tb + (size_t)(step) * 64 + lane) * 512 + h * 128 + half * 32 + (wave - 4) * 16; *(v4u*)dst_ = o0_; *(v4u*)(dst_ + 8) = o1_; } } while (0)
    if (wave >= 4) {
        if (wave == 4) { CDL[lane] = Gb.CD[item0 + lane]; CDL[64 + lane] = Gb.CD[item0 + 64 + lane]; }
        v4u r0[15], r1[15], r2[15];
        GDN_LOADR(r0, item0); GDN_LOADR(r1, item0 + 1); GDN_LOADR(r2, item0 + 2);
        GDN_STORER(r0, L);
        LDS_BARRIER();
#define GDN_CL(k) (item0 + ((k) < 127 ? (k) : 127))
        for (int n = 0; n < 129; n += 3) {
            GDN_LOADR(r0, GDN_CL(n + 3)); GDN_STORER(r1, L + ((n + 1) & 1) * 65536); LDS_BARRIER(); GDN_OSTORE(n);
            GDN_LOADR(r1, GDN_CL(n + 4)); GDN_STORER(r2, L + ((n + 2) & 1) * 65536); LDS_BARRIER(); GDN_OSTORE(n + 1);
            GDN_LOADR(r2, GDN_CL(n + 5)); GDN_STORER(r0, L + ((n + 3) & 1) * 65536); LDS_BARRIER(); GDN_OSTORE(n + 2);
        }
#undef GDN_CL
    } else if (wave >= 2) {
        for (int n = 0; n < 130; ++n) LDS_BARRIER();
    } else {
        LDS_BARRIER();
        f32x4_t S[8];
#pragma unroll
        for (int i = 0; i < 8; ++i) S[i] = (f32x4_t){0.f, 0.f, 0.f, 0.f};
        for (int n = 0; n < 128; ++n) {
            LAS unsigned char* B = L + (n & 1) * 65536;
            const float cd = CDL[n];
            bf16x8_t sb[4];
#pragma unroll
            for (int ks = 0; ks < 4; ++ks) sb[ks] = __builtin_bit_cast(bf16x8_t, (v4u){cvtpk(S[2 * ks][0], S[2 * ks][1]), cvtpk(S[2 * ks][2], S[2 * ks][3]), cvtpk(S[2 * ks + 1][0], S[2 * ks + 1][1]), cvtpk(S[2 * ks + 1][2], S[2 * ks + 1][3])});
#define GDN_SB() __builtin_amdgcn_sched_barrier(0)
            const LAS unsigned char* Bl = B + lane * 16;
            v2u u8[4]; bf16x8_t fa[16], fb[16];
#pragma unroll
            for (int rt = 0; rt < 4; ++rt) u8[rt] = *(const LAS v2u*)(B + 57344 + ((wave * 16 + fr) * 64 + 16 * rt + 4 * g) * 2);
#pragma unroll
            for (int i = 0; i < 16; ++i) fa[i] = *(const LAS bf16x8_t*)(Bl + ((i & 3) * 4 + (i >> 2)) * 1024);
            GDN_SB();
#pragma unroll
            for (int i = 0; i < 16; ++i) fb[i] = *(const LAS bf16x8_t*)(Bl + 16384 + ((i & 3) * 4 + (i >> 2)) * 1024);
            GDN_SB();
            f32x4_t va[4], oa[4];
#pragma unroll
            for (int rt = 0; rt < 4; ++rt) { va[rt] = (f32x4_t){bflo(u8[rt].x), bfhi(u8[rt].x), bflo(u8[rt].y), bfhi(u8[rt].y)}; oa[rt] = (f32x4_t){0.f, 0.f, 0.f, 0.f}; }
#pragma unroll
            for (int i = 0; i < 16; ++i) va[i & 3] = __builtin_amdgcn_mfma_f32_16x16x32_bf16(fa[i], sb[i >> 2], va[i & 3], 0, 0, 0);
            GDN_SB();
#pragma unroll
            for (int i = 0; i < 8; ++i) fa[i] = *(const LAS bf16x8_t*)(Bl + 49152 + ((i & 3) * 2 + (i >> 2)) * 1024);
#pragma unroll
            for (int i = 0; i < 8; ++i) fa[8 + i] = *(const LAS bf16x8_t*)(Bl + 32768 + ((i & 3) * 2 + (i >> 2)) * 1024);
            GDN_SB();
#pragma unroll
            for (int i = 0; i < 16; ++i) oa[i & 3] = __builtin_amdgcn_mfma_f32_16x16x32_bf16(fb[i], sb[i >> 2], oa[i & 3], 0, 0, 0);
            bf16x8_t vb[2];
#pragma unroll
            for (int k2 = 0; k2 < 2; ++k2) vb[k2] = __builtin_bit_cast(bf16x8_t, (v4u){cvtpk(va[2 * k2][0], va[2 * k2][1]), cvtpk(va[2 * k2][2], va[2 * k2][3]), cvtpk(va[2 * k2 + 1][0], va[2 * k2 + 1][1]), cvtpk(va[2 * k2 + 1][2], va[2 * k2 + 1][3])});
#pragma unroll
            for (int dt = 0; dt < 8; ++dt) S[dt] = S[dt] * cd;
            GDN_SB();
#pragma unroll
            for (int i = 0; i < 8; ++i) fb[i] = *(const LAS bf16x8_t*)(Bl + 32768 + 8192 + ((i & 3) * 2 + (i >> 2)) * 1024);
            GDN_SB();
#pragma unroll
            for (int i = 0; i < 8; ++i) oa[i & 3] = __builtin_amdgcn_mfma_f32_16x16x32_bf16(fa[i], vb[i >> 2], oa[i & 3], 0, 0, 0);
#pragma unroll
            for (int i = 0; i < 8; ++i) S[i & 3] = __builtin_amdgcn_mfma_f32_16x16x32_bf16(fa[8 + i], vb[i >> 2], S[i & 3], 0, 0, 0);
            GDN_SB();
#pragma unroll
            for (int i = 0; i < 8; ++i) S[4 + (i & 3)] = __builtin_amdgcn_mfma_f32_16x16x32_bf16(fb[i], vb[i >> 2], S[4 + (i & 3)], 0, 0, 0);
            GDN_SB();
#undef GDN_SB
            { LAS bf16_t* OT = OTB + (wave * 2 + (n & 1)) * 1024;
#pragma unroll
              for (int rt = 0; rt < 4; ++rt)
#pragma unroll
                for (int r = 0; r < 4; ++r) OT[(16 * rt + 4 * g + r) * 16 + fr] = f2bf(oa[rt][r]); }
            LDS_BARRIER();
        }
        LDS_BARRIER();
    }
#undef GDN_SRC
#undef GDN_LOADR
#undef GDN_OSTORE
#undef GDN_STORER
}

__device__ __forceinline__ void gdn_finish_phase(Frame& F, const Args& a, const GdnBufs& Gb, const bf16_t* GZ, bf16_t* OG) {
    const int gt = F.vcu * NWAVES * 64 + F.tid, ngt = F.G * NWAVES * 64;
    for (int p = gt; p < T * 64; p += ngt) {
        const size_t t = (size_t)(p >> 6); const int col = (p & 63) * 8, e0 = col & 127;
        const v4u o = *(const v4u*)(Gb.ORAW + t * 512 + col), z = *(const v4u*)(GZ + t * 512 + col);
        const unsigned ow[4] = {o.x, o.y, o.z, o.w}, zw[4] = {z.x, z.y, z.z, z.w};
        float ss = 0.f;
#pragma unroll
        for (int i = 0; i < 4; ++i) { const float a0 = bflo(ow[i]), a1 = bfhi(ow[i]); ss += a0 * a0 + a1 * a1; }
        ss += __shfl_xor(ss, 1); ss += __shfl_xor(ss, 2); ss += __shfl_xor(ss, 4); ss += __shfl_xor(ss, 8);
        const float rinv = rsqrtf(ss * (1.f / 128.f) + EPS);
        const f32x4_t g0 = *(const f32x4_t*)(a.gdn_norm_g + e0), g1 = *(const f32x4_t*)(a.gdn_norm_g + e0 + 4);
        const float gg[8] = {g0[0], g0[1], g0[2], g0[3], g1[0], g1[1], g1[2], g1[3]};
        unsigned r[4];
#pragma unroll
        for (int i = 0; i < 4; ++i) { const float z0 = bflo(zw[i]), z1 = bfhi(zw[i]);
            r[i] = cvtpk(bflo(ow[i]) * rinv * gg[2 * i] * (z0 / (1.f + __expf(-z0))), bfhi(ow[i]) * rinv * gg[2 * i + 1] * (z1 / (1.f + __expf(-z1)))); }
        *(v4u*)(OG + t * 512 + col) = (v4u){r[0], r[1], r[2], r[3]};
    }
}
typedef float f32x2_t __attribute__((ext_vector_type(2)));
__device__ __forceinline__ float gelu_erf(float v) { return 0.5f * v * (1.f + erff(v * 0.70710678118654752f)); }
constexpr int PEER_CH = 16;
constexpr int CW_PEERU = 8192, CW_PEERV = 8192 + 1024;

#define PEER_SHUF(EN, R0, R1) do { _Pragma("unroll") for (int i = 0; i < 16; ++i) EN[i] = __shfl(i < 8 ? (R0) : (R1), 8 * (i & 7) + g); } while (0)
#define PEER_U_COMPUTE(W, TOK, XR0, XR1, RS) do { const size_t t_ = (TOK); const float rs = (RS); \
        const unsigned xw[8] = {XR0.x, XR0.y, XR0.z, XR0.w, XR1.x, XR1.y, XR1.z, XR1.w}; f32x2_t xf[8]; \
        _Pragma("unroll") for (int q = 0; q < 8; ++q) { xf[q].x = bflo(xw[q]) * rs * gp[q >> 1][(q & 1) * 2]; xf[q].y = bfhi(xw[q]) * rs * gp[q >> 1][(q & 1) * 2 + 1]; } \
        float p[16]; \
        _Pragma("unroll") for (int i = 0; i < 16; ++i) { const unsigned ww[4] = {W[i].x, W[i].y, W[i].z, W[i].w}; f32x2_t acc = {0.f, 0.f}; \
            _Pragma("unroll") for (int q = 0; q < 4; ++q) { acc = __builtin_elementwise_fma(__builtin_amdgcn_cvt_pk_f32_fp8(ww[q], false), xf[2 * q], acc); acc = __builtin_elementwise_fma(__builtin_amdgcn_cvt_pk_f32_fp8(ww[q], true), xf[2 * q + 1], acc); } \
            p[i] = acc.x + acc.y; } \
        _Pragma("unroll") for (int off = 4; off >= 1; off >>= 1) { const bool up = (j & off) != 0; \
            _Pragma("unroll") for (int i = 0; i < 2 * off; ++i) { const float lo = p[i], hi = p[i + 2 * off]; const float send = up ? lo : hi, keep = up ? hi : lo; p[i] = keep + __shfl_xor(send, off); } } \
        bf16_t* dst = PART + ((size_t)x * T + t_) * 128 + 16 * j + g; dst[0] = f2bf(p[0]); dst[8] = f2bf(p[1]); } while (0)
__device__ __forceinline__ void peer_u_phase(Frame& F, const Args& a, gu32* ctl, const bf16_t* X2B, const float* rstd2, const int* EIDX, const unsigned char* U8, bf16_t* PART) {
    const int lane = F.lane, g = lane >> 3, j = lane & 7;
    const int x0 = (int)(xb_xcc_id() & 7u);
    for (int s = 0; s < 8; ++s) {
        const int x = (x0 + s) & 7;
        f32x4_t gp[4];
#pragma unroll
        for (int q = 0; q < 4; ++q) gp[q] = *(const f32x4_t*)(a.g_peer + 128 * x + 16 * j + 4 * q);
        const unsigned char* Ux = U8 + (size_t)x * 16384 * 128 + 16 * j;
        const bf16_t* Xx = X2B + 128 * x + 16 * j;
        for (;;) {
            int c = 0; if (lane == 0) c = (int)__hip_atomic_fetch_add(ctl + CW_PEERU + 64 * x, 1u, __ATOMIC_RELAXED, __HIP_MEMORY_SCOPE_AGENT);
            c = __builtin_amdgcn_readfirstlane(c);
            if (c >= T / PEER_CH) break;
            const size_t tc = (size_t)c * PEER_CH, tl = tc + PEER_CH - 1;
            int en[16]; v4u wa[16], wb[16];
            int er0 = EIDX[tc * 128 + lane], er1 = EIDX[tc * 128 + 64 + lane];
            v4u xa0 = *(const v4u*)(Xx + tc * 1024), xa1 = *(const v4u*)(Xx + tc * 1024 + 8), xb0, xb1; float rsa = rstd2[tc], rsb;
            PEER_SHUF(en, er0, er1);
#pragma unroll
            for (int i = 0; i < 16; ++i) wa[i] = *(const v4u*)(Ux + (size_t)en[i] * 128);
            er0 = EIDX[(tc + 1) * 128 + lane]; er1 = EIDX[(tc + 1) * 128 + 64 + lane];
            for (int tt = 0; tt < PEER_CH; tt += 2) {
                const size_t t = tc + tt, t2 = (t + 2 < tl) ? t + 2 : tl, t3 = (t + 3 < tl) ? t + 3 : tl;
                PEER_SHUF(en, er0, er1);
#pragma unroll
                for (int i = 0; i < 16; ++i) wb[i] = *(const v4u*)(Ux + (size_t)en[i] * 128);
                er0 = EIDX[t2 * 128 + lane]; er1 = EIDX[t2 * 128 + 64 + lane];
                xb0 = *(const v4u*)(Xx + (t + 1) * 1024); xb1 = *(const v4u*)(Xx + (t + 1) * 1024 + 8); rsb = rstd2[t + 1];
                PEER_U_COMPUTE(wa, t, xa0, xa1, rsa);
                PEER_SHUF(en, er0, er1);
#pragma unroll
                for (int i = 0; i < 16; ++i) wa[i] = *(const v4u*)(Ux + (size_t)en[i] * 128);
                er0 = EIDX[t3 * 128 + lane]; er1 = EIDX[t3 * 128 + 64 + lane];
                xa0 = *(const v4u*)(Xx + t2 * 1024); xa1 = *(const v4u*)(Xx + t2 * 1024 + 8); rsa = rstd2[t2];
                PEER_U_COMPUTE(wb, t + 1, xb0, xb1, rsb);
            }
        }
    }
}
__device__ __forceinline__ void peer_combine_phase(Frame& F, const bf16_t* PART, const int* EIDX, const float* EGATE, const float* SU, const float* SV, float* ACTS) {
    const int gt = F.vcu * NWAVES * 64 + F.tid, ngt = F.G * NWAVES * 64;
    for (int p = gt; p < T * 32; p += ngt) {
        f32x4_t s = {0.f, 0.f, 0.f, 0.f};
#pragma unroll
        for (int x = 0; x < 8; ++x) { const v2u w = *(const v2u*)(PART + (size_t)x * T * 128 + (size_t)p * 4); s += (f32x4_t){bflo(w.x), bfhi(w.x), bflo(w.y), bfhi(w.y)}; }
        const int4 e = *(const int4*)(EIDX + (size_t)p * 4); const f32x4_t gt4 = *(const f32x4_t*)(EGATE + (size_t)p * 4);
        *(f32x4_t*)(ACTS + (size_t)p * 4) = (f32x4_t){gelu_erf(s[0] * SU[e.x]) * gt4[0] * SV[e.x], gelu_erf(s[1] * SU[e.y]) * gt4[1] * SV[e.y], gelu_erf(s[2] * SU[e.z]) * gt4[2] * SV[e.z], gelu_erf(s[3] * SU[e.w]) * gt4[3] * SV[e.w]};
    }
}
#define PEER_V_COMPUTE(W, TOK, A0R, A1R, XWR) do { const size_t t_ = (TOK); float av[16]; \
        _Pragma("unroll") for (int i = 0; i < 16; ++i) av[i] = __shfl(i < 8 ? (A0R) : (A1R), 8 * (i & 7) + g); \
        const size_t oo_ = t_ * 1024 + 128 * x + 16 * j + 2 * g; const unsigned xw_ = (XWR); const f32x2_t xv = {bflo(xw_), bfhi(xw_)}; \
        f32x2_t o2[8]; _Pragma("unroll") for (int q = 0; q < 8; ++q) o2[q] = (f32x2_t){0.f, 0.f}; \
        _Pragma("unroll") for (int i = 0; i < 16; ++i) { const unsigned ww[4] = {W[i].x, W[i].y, W[i].z, W[i].w}; const f32x2_t a2 = {av[i], av[i]}; \
            _Pragma("unroll") for (int q = 0; q < 4; ++q) { o2[2 * q] = __builtin_elementwise_fma(__builtin_amdgcn_cvt_pk_f32_fp8(ww[q], false), a2, o2[2 * q]); o2[2 * q + 1] = __builtin_elementwise_fma(__builtin_amdgcn_cvt_pk_f32_fp8(ww[q], true), a2, o2[2 * q + 1]); } } \
        float o[16]; _Pragma("unroll") for (int q = 0; q < 8; ++q) { o[2 * q] = o2[q].x; o[2 * q + 1] = o2[q].y; } \
        _Pragma("unroll") for (int off = 4; off >= 1; off >>= 1) { const bool up = (g & off) != 0; \
            _Pragma("unroll") for (int i = 0; i < 2 * off; ++i) { const float lo = o[i], hi = o[i + 2 * off]; const float send = up ? lo : hi, keep = up ? hi : lo; o[i] = keep + __shfl_xor(send, 8 * off); } } \
        const unsigned rw_ = cvtpk(xv.x + o[0], xv.y + o[1]); *(unsigned*)(X3B + oo_) = rw_; const float r0 = bflo(rw_), r1 = bfhi(rw_); \
        const float ss = wave_sum(r0 * r0 + r1 * r1); if (lane == 0) SS3[t_ * 8 + x] = ss; } while (0)
__device__ __forceinline__ void peer_v_phase(Frame& F, gu32* ctl, const int* EIDX, const float* ACTS, const unsigned char* V8, const bf16_t* X2B, bf16_t* X3B, float* SS3) {
    const int lane = F.lane, g = lane >> 3, j = lane & 7;
    const int x0 = (int)(xb_xcc_id() & 7u);
    for (int s = 0; s < 8; ++s) {
        const int x = (x0 + s) & 7;
        const unsigned char* Vx = V8 + (size_t)x * 16384 * 128 + 16 * j;
        const bf16_t* Xx = X2B + 128 * x + 16 * j + 2 * g;
        for (;;) {
            int c = 0; if (lane == 0) c = (int)__hip_atomic_fetch_add(ctl + CW_PEERV + 64 * x, 1u, __ATOMIC_RELAXED, __HIP_MEMORY_SCOPE_AGENT);
            c = __builtin_amdgcn_readfirstlane(c);
            if (c >= T / PEER_CH) break;
            const size_t tc = (size_t)c * PEER_CH, tl = tc + PEER_CH - 1;
            int en[16]; v4u wa[16], wb[16];
            int er0 = EIDX[tc * 128 + lane], er1 = EIDX[tc * 128 + 64 + lane];
            float aa0 = ACTS[tc * 128 + lane], aa1 = ACTS[tc * 128 + 64 + lane], ab0, ab1; unsigned xwa = *(const unsigned*)(Xx + tc * 1024), xwb;
            PEER_SHUF(en, er0, er1);
#pragma unroll
            for (int i = 0; i < 16; ++i) wa[i] = *(const v4u*)(Vx + (size_t)en[i] * 128);
            er0 = EIDX[(tc + 1) * 128 + lane]; er1 = EIDX[(tc + 1) * 128 + 64 + lane];
            for (int tt = 0; tt < PEER_CH; tt += 2) {
                const size_t t = tc + tt, t2 = (t + 2 < tl) ? t + 2 : tl, t3 = (t + 3 < tl) ? t + 3 : tl;
                PEER_SHUF(en, er0, er1);
#pragma unroll
                for (int i = 0; i < 16; ++i) wb[i] = *(const v4u*)(Vx + (size_t)en[i] * 128);
                er0 = EIDX[t2 * 128 + lane]; er1 = EIDX[t2 * 128 + 64 + lane];
                ab0 = ACTS[(t + 1) * 128 + lane]; ab1 = ACTS[(t + 1) * 128 + 64 + lane]; xwb = *(const unsigned*)(Xx + (t + 1) * 1024);
                PEER_V_COMPUTE(wa, t, aa0, aa1, xwa);
                PEER_SHUF(en, er0, er1);
#pragma unroll
                for (int i = 0; i < 16; ++i) wa[i] = *(const v4u*)(Vx + (size_t)en[i] * 128);
                er0 = EIDX[t3 * 128 + lane]; er1 = EIDX[t3 * 128 + 64 + lane];
                aa0 = ACTS[t2 * 128 + lane]; aa1 = ACTS[t2 * 128 + 64 + lane]; xwa = *(const unsigned*)(Xx + t2 * 1024);
                PEER_V_COMPUTE(wb, t + 1, ab0, ab1, xwb);
            }
        }
    }
}
__device__ __forceinline__ void peer_norm_phase(Frame& F, const Args& a, const float* SS3, const bf16_t* X3B, float* out) {
    const int gt = F.vcu * NWAVES * 64 + F.tid, ngt = F.G * NWAVES * 64;
    for (int p = gt; p < T * 128; p += ngt) {
        const size_t t = (size_t)(p >> 7); const int c = (p & 127) * 8;
        const f32x4_t s0 = *(const f32x4_t*)(SS3 + t * 8), s1 = *(const f32x4_t*)(SS3 + t * 8 + 4);
        const float r3 = rsqrtf(((s0[0] + s0[1]) + (s0[2] + s0[3]) + (s1[0] + s1[1]) + (s1[2] + s1[3])) * (1.f / D) + EPS);
        const v4u w = *(const v4u*)(X3B + t * 1024 + c);
        const f32x4_t g0 = *(const f32x4_t*)(a.g_final + c), g1 = *(const f32x4_t*)(a.g_final + c + 4);
        *(f32x4_t*)(out + t * 1024 + c) = (f32x4_t){bflo(w.x), bfhi(w.x), bflo(w.y), bfhi(w.y)} * g0 * r3;
        *(f32x4_t*)(out + t * 1024 + c + 4) = (f32x4_t){bflo(w.z), bfhi(w.z), bflo(w.w), bfhi(w.w)} * g1 * r3;
    }
}
#ifndef TOPK_HD
#define TOPK_HD __device__ __forceinline__
#endif
TOPK_HD void ce_desc(unsigned& a, unsigned& b) { const unsigned hi = a > b ? a : b, lo = a > b ? b : a; a = hi; b = lo; }
TOPK_HD void sort16_desc(unsigned (&v)[16]) {
#pragma unroll
    for (int k = 2; k <= 16; k <<= 1)
#pragma unroll
        for (int j = k >> 1; j >= 1; j >>= 1)
#pragma unroll
            for (int i = 0; i < 16; ++i) { const int l = i ^ j; if (l > i) { if ((i & k) == 0) ce_desc(v[i], v[l]); else ce_desc(v[l], v[i]); } }
}
TOPK_HD void bitonic_merge16_desc(unsigned (&v)[16]) {
#pragma unroll
    for (int j = 8; j >= 1; j >>= 1)
#pragma unroll
        for (int i = 0; i < 16; ++i) { const int l = i ^ j; if (l > i) ce_desc(v[i], v[l]); }
}
TOPK_HD void top16_merge(unsigned (&a)[16], const unsigned (&b)[16]) {
#pragma unroll
    for (int i = 0; i < 16; ++i) a[i] = a[i] > b[15 - i] ? a[i] : b[15 - i];
    bitonic_merge16_desc(a);
}
TOPK_HD unsigned f2ord(float f) { const unsigned u = __builtin_bit_cast(unsigned, f); return (u & 0x80000000u) ? ~u : (u | 0x80000000u); }
TOPK_HD float ord2f(unsigned o) { const unsigned u = (o & 0x80000000u) ? (o & 0x7fffffffu) : ~o; return __builtin_bit_cast(float, u); }

__device__ __forceinline__ void peer_route_task(Frame& F, const bf16_t* PQ, const bf16_t* SK16, int* EIDX, float* EGATE, int tt, int h) {
    constexpr int CI[50] = {0,0,0,0,0,0,0,0,0,0,0,0,0,0,0,0,1,1,1,1,1,1,1,1,2,2,2,2,2,3,3,3,3,4,4,4,5,5,6,6,7,7,8,9,10,11,12,13,14,15};
    constexpr int CJ[50] = {0,1,2,3,4,5,6,7,8,9,10,11,12,13,14,15,0,1,2,3,4,5,6,7,0,1,2,3,4,0,1,2,3,0,1,2,0,1,0,1,0,1,0,0,0,0,0,0,0,0};
    int lane = F.lane; asm volatile("" : "+v"(lane));
    const int t = lane & 31, hi = lane >> 5;
    LAS unsigned* wl = (LAS unsigned*)(F.lds + 65536 + F.wave * 8192) + lane;
    {
        const size_t row = (size_t)tt * 32 + t;
        unsigned L[2][16];
#pragma unroll
        for (int p = 0; p < 2; ++p) {
            const int hp = h * 2 + p;
            bf16x8_t Bf[8];
#pragma unroll
            for (int ks = 0; ks < 8; ++ks) Bf[ks] = *(const bf16x8_t*)(PQ + row * 2048 + hp * 128 + 16 * ks + 8 * hi);
#pragma unroll
            for (int i = 0; i < 16; ++i) L[p][i] = 0u;
#pragma unroll 1
            for (int nt = 0; nt < 4; ++nt) {
                const int srow = p * 128 + 32 * nt + t;
                bf16x8_t Ac[8];
#pragma unroll
                for (int ks = 0; ks < 8; ++ks) Ac[ks] = *(const LAS bf16x8_t*)(F.lds + srow * 256 + (((2 * ks + hi) ^ (srow & 15)) << 4));
                f32x16_t acc = {};
#pragma unroll
                for (int ks = 0; ks < 8; ++ks) acc = __builtin_amdgcn_mfma_f32_32x32x16_bf16(Ac[ks], Bf[ks], acc, 0, 0, 0);
                unsigned k[16];
#pragma unroll
                for (int r = 0; r < 16; ++r) { const int n = 32 * nt + (r & 3) + 8 * (r >> 2) + 4 * hi; k[r] = (f2ord(acc[r]) & ~127u) | (unsigned)(127 - n); }
                sort16_desc(k);
                top16_merge(L[p], k);
            }
            unsigned pb[16];
#pragma unroll
            for (int i = 0; i < 16; ++i) pb[i] = __shfl_xor(L[p][i], 32);
            top16_merge(L[p], pb);
        }
        float sa[16], sb[16];
#pragma unroll
        for (int i = 0; i < 16; ++i) { sa[i] = ord2f(L[0][i] & ~127u); sb[i] = ord2f(L[1][i] & ~127u); wl[i * 64] = 127u - (L[0][i] & 127u); wl[(16 + i) * 64] = 127u - (L[1][i] & 127u); }
        unsigned c0[16], c1[16];
#pragma unroll
        for (int s = 0; s < 32; ++s) {
            unsigned key = 0u;
            if (s < 25) { const float v = hi ? sa[CI[25 + s]] + sb[CJ[25 + s]] : sa[CI[s]] + sb[CJ[s]]; const int pos = hi ? CI[25 + s] * 16 + CJ[25 + s] : CI[s] * 16 + CJ[s];
                key = (f2ord(v) & ~255u) | (unsigned)(255 - pos); }
            if (s < 16) c0[s] = key; else c1[s - 16] = key;
        }
        sort16_desc(c0); sort16_desc(c1); top16_merge(c0, c1);
        unsigned pb[16];
#pragma unroll
        for (int i = 0; i < 16; ++i) pb[i] = __shfl_xor(c0[i], 32);
        top16_merge(c0, pb);
        float e[16]; const float m = ord2f(c0[0] & ~255u); float l = 0.f;
#pragma unroll
        for (int r = 0; r < 16; ++r) { e[r] = __expf(ord2f(c0[r] & ~255u) - m); l += e[r]; }
        const float il = 1.f / l;
        int ex[8]; float gt[8];
#pragma unroll
        for (int q = 0; q < 8; ++q) { const unsigned kk = hi ? c0[8 + q] : c0[q]; const int pos = 255 - (int)(kk & 255u); ex[q] = (int)(wl[(pos >> 4) * 64] * 128u + wl[(16 + (pos & 15)) * 64]); gt[q] = (hi ? e[8 + q] : e[q]) * il; }
        int* ep = EIDX + row * 128 + h * 16 + hi * 8; float* gp = EGATE + row * 128 + h * 16 + hi * 8;
        *(int4*)ep = make_int4(ex[0], ex[1], ex[2], ex[3]); *(int4*)(ep + 4) = make_int4(ex[4], ex[5], ex[6], ex[7]);
        *(f32x4_t*)gp = (f32x4_t){gt[0], gt[1], gt[2], gt[3]}; *(f32x4_t*)(gp + 4) = (f32x4_t){gt[4], gt[5], gt[6], gt[7]};
    }
}
__device__ __forceinline__ void cross_item(Frame& F, const bf16_t* QC, const bf16_t* KC, const bf16_t* VC, bf16_t* OC, int bh, int qb) {
    int tid = F.tid; asm volatile("" : "+v"(tid));
    const int lane = tid & 63, wave = F.wave, q = lane & 31, hi = lane >> 5;
    LAS unsigned char* L = F.lds;
    const int g4 = lane >> 4, qq = (lane >> 2) & 3, p4 = lane & 3;
    {
        const int b = bh >> 2, h = bh & 3;
#pragma unroll
        for (int i = 0; i < 16; ++i) { const int cid = tid + 512 * i, r = cid >> 5, c = cid & 31;
            *(LAS v4u*)(L + r * 512 + ((c ^ (r & 15)) << 4)) = *(const v4u*)(KC + (size_t)(b * 256 + r) * 1024 + h * 256 + c * 8); }
        const size_t qrow0 = (size_t)b * SEQ + qb * 256 + wave * 32;
        const bf16_t* Qp = QC + (qrow0 + q) * 1024 + h * 256 + 8 * hi;
        __syncthreads();
        f32x16_t st[8];
#pragma unroll
        for (int kt = 0; kt < 8; ++kt) st[kt] = (f32x16_t){};
#pragma unroll 2
        for (int ks = 0; ks < 16; ++ks) { const bf16x8_t qf = *(const bf16x8_t*)(Qp + 16 * ks);
#pragma unroll
            for (int kt = 0; kt < 8; ++kt) { const int row = 32 * kt + q;
                st[kt] = __builtin_amdgcn_mfma_f32_32x32x16_bf16(*(const LAS bf16x8_t*)(L + row * 512 + (((2 * ks + hi) ^ (row & 15)) << 4)), qf, st[kt], 0, 0, 0); } }
        float m = -INFINITY;
#pragma unroll
        for (int kt = 0; kt < 8; ++kt)
#pragma unroll
            for (int r = 0; r < 16; ++r) { st[kt][r] *= 0.0625f; m = fmaxf(m, st[kt][r]); }
        m = fmaxf(m, __shfl_xor(m, 32));
        float l = 0.f;
#pragma unroll
        for (int kt = 0; kt < 8; ++kt)
#pragma unroll
            for (int r = 0; r < 16; ++r) { st[kt][r] = __expf(st[kt][r] - m); l += st[kt][r]; }
        l += __shfl_xor(l, 32);
        const float il = 1.f / l;
        bf16x8_t pa[8][2];
#pragma unroll
        for (int kt = 0; kt < 8; ++kt)
#pragma unroll
            for (int s = 0; s < 2; ++s) pa[kt][s] = __builtin_bit_cast(bf16x8_t, (v4u){cvtpk(st[kt][8 * s] * il, st[kt][8 * s + 1] * il), cvtpk(st[kt][8 * s + 2] * il, st[kt][8 * s + 3] * il),
                                                                                        cvtpk(st[kt][8 * s + 4] * il, st[kt][8 * s + 5] * il), cvtpk(st[kt][8 * s + 6] * il, st[kt][8 * s + 7] * il)});
        __syncthreads();
#pragma unroll
        for (int i = 0; i < 16; ++i) { const int cid = tid + 512 * i, r = cid >> 5, c = cid & 31;
            *(LAS v4u*)(L + r * 512 + ((c ^ (4 * (r & 3))) << 4)) = *(const v4u*)(VC + (size_t)(b * 256 + r) * 1024 + h * 256 + c * 8); }
        __syncthreads();
        bf16_t* Op = OC + qrow0 * 1024 + h * 256 + q;
#pragma unroll 1
        for (int dt = 0; dt < 8; ++dt) {
            f32x16_t o = {};
            LAS unsigned char* vb = L + (4 * (g4 >> 1) + qq) * 512 + (((dt * 64) ^ (qq << 6)) + (g4 & 1) * 32 + p4 * 8);
#pragma unroll
            for (int kt = 0; kt < 8; ++kt)
#pragma unroll
                for (int s = 0; s < 2; ++s) { const v4i16_t a0 = lds_tr16(vb + (32 * kt + 16 * s) * 512), a1 = lds_tr16(vb + (32 * kt + 16 * s + 8) * 512);
                    const bf16x8_t vf = {a0[0], a0[1], a0[2], a0[3], a1[0], a1[1], a1[2], a1[3]};
                    o = __builtin_amdgcn_mfma_f32_32x32x16_bf16(pa[kt][s], vf, o, 0, 0, 0); }
#pragma unroll
            for (int r = 0; r < 16; ++r) { const int row = (r & 3) + 8 * (r >> 2) + 4 * hi; Op[(size_t)row * 1024 + dt * 32] = f2bf(o[r]); }
        }
        __syncthreads();
    }
}
template <bool REMAP>
__device__ __forceinline__ void transpose_tile(const float* W, int K, int N, const float* gain, bf16_t* WT, LAS float* tile, int item, int tid) {
    const int nblk = (N + 255) / 256, kb = item / nblk, nb = item % nblk, k0 = 64 * kb, n0 = 256 * nb;
    const int c4 = (tid & 63) * 4, kr = tid >> 6;
    f32x4 v[8];
#pragma unroll
    for (int i = 0; i < 8; ++i) { const int k = kr + 8 * i; v[i] = (n0 + c4 < N) ? *(const GAS f32x4*)(W + (size_t)(k0 + k) * N + n0 + c4) : (f32x4){0.f, 0.f, 0.f, 0.f}; }
#pragma unroll
    for (int i = 0; i < 8; ++i) { const int k = kr + 8 * i; LAS float* d = tile + k * 257 + c4; d[0] = v[i].x; d[1] = v[i].y; d[2] = v[i].z; d[3] = v[i].w; }
    __syncthreads();
#pragma unroll
    for (int i = 0; i < 4; ++i) { const int p = tid + 512 * i, n = p >> 3, c = p & 7; const LAS float* sp = tile + (8 * c) * 257 + n;
        float g[8];
#pragma unroll
        for (int q = 0; q < 8; ++q) g[q] = gain ? gain[k0 + 8 * c + q] : 1.f;
        v4u o; o.x = pk2(sp[0 * 257] * g[0], sp[1 * 257] * g[1]); o.y = pk2(sp[2 * 257] * g[2], sp[3 * 257] * g[3]); o.z = pk2(sp[4 * 257] * g[4], sp[5 * 257] * g[5]); o.w = pk2(sp[6 * 257] * g[6], sp[7 * 257] * g[7]);
        int ng = n0 + n; bool ok = ng < N;
        if (REMAP) { if (ng >= 3584 && ng < 3592) ok = false; else if (ng >= 3592) ng -= 8; }
        if (ok) *(GAS v4u*)(WT + (size_t)ng * K + k0 + 8 * c) = o; }
    __syncthreads();
}

__device__ __forceinline__ void p0_prologue(Frame& F, const Args& a) {
    unsigned char* ws = a.ws;
    LAS float* tile = (LAS float*)F.lds;
    const int gw = F.vcu * NWAVES + F.wave, NGW = F.G * NWAVES;
    constexpr int I_IN = 16 * 23;
    for (int it = F.vcu; it < I_IN; it += F.G) transpose_tile<true>(a.w_in, 1024, IN_COLS, a.g_mix, (bf16_t*)(ws + WS_WIN), tile, it, F.tid);
    __syncthreads();
    LAS float* wsm = (LAS float*)F.lds;
    for (int i = F.tid; i < 8192; i += NWAVES * 64) { const int j = i >> 10, k = i & 1023; wsm[i] = a.w_in[(size_t)k * IN_COLS + 3584 + j] * a.g_mix[k]; }
    __syncthreads();
    bf16_t* XB = (bf16_t*)(ws + WS_A0); float* rstd0 = (float*)(ws + WS_RSTD0); float* GB = (float*)(ws + WS_GB); float* GA = GB + T * 4;
    for (int row0 = gw * 4; row0 < T; row0 += NGW * 4) {
        f32x4 v[4][4];
#pragma unroll
        for (int r = 0; r < 4; ++r)
#pragma unroll
            for (int j = 0; j < 4; ++j) v[r][j] = *((const GAS f32x4*)(a.x + (size_t)(row0 + r) * D) + F.lane + 64 * j);
#pragma unroll
        for (int r = 0; r < 4; ++r) { const int row = row0 + r; float s = 0.f;
#pragma unroll
            for (int j = 0; j < 4; ++j) s += (v[r][j].x * v[r][j].x + v[r][j].y * v[r][j].y) + (v[r][j].z * v[r][j].z + v[r][j].w * v[r][j].w);
            const float rstd = rsqrtf(wave_sum(s) * (1.f / D) + EPS);
            GAS unsigned long long* o8 = (GAS unsigned long long*)(XB + (size_t)row * D) + F.lane;
#pragma unroll
            for (int j = 0; j < 4; ++j) o8[64 * j] = (unsigned long long)pk2(v[r][j].x, v[r][j].y) | ((unsigned long long)pk2(v[r][j].z, v[r][j].w) << 32);
            float dj[8];
#pragma unroll
            for (int jj = 0; jj < 8; ++jj) { float d = 0.f;
#pragma unroll
                for (int j = 0; j < 4; ++j) { const f32x4 w = *(const LAS f32x4*)(wsm + jj * 1024 + (F.lane + 64 * j) * 4); d += (v[r][j].x * w.x + v[r][j].y * w.y) + (v[r][j].z * w.z + v[r][j].w * w.w); }
                dj[jj] = d; }
#pragma unroll
            for (int off = 4; off >= 1; off >>= 1) { const bool up = (F.lane & off) != 0;
#pragma unroll
                for (int i = 0; i < off; ++i) { const float lo = dj[i], hi = dj[i + off]; const float send = up ? lo : hi, keep = up ? hi : lo; dj[i] = keep + __shfl_xor(send, off); } }
            float d0 = dj[0]; d0 += __shfl_xor(d0, 8); d0 += __shfl_xor(d0, 16); d0 += __shfl_xor(d0, 32);
            if (F.lane == 0) rstd0[row] = rstd;
            if (F.lane < 4) GB[(size_t)row * 4 + F.lane] = d0 * rstd; else if (F.lane < 8) GA[(size_t)row * 4 + F.lane - 4] = d0 * rstd; }
    }
}
__device__ __forceinline__ void late_prologue(Frame& F, const Args& a, int wgi, int nwg) {
    unsigned char* ws = a.ws;
    LAS float* tile = (LAS float*)F.lds;
    const int gw = wgi * NWAVES + F.wave, NGW = nwg * NWAVES;
    constexpr int I_S = 8 * 4, I_M = 16 * 4, I_L = 16 * 8;
    constexpr int NITEMS = 2 * I_S + 3 * I_M + 2 * I_L;
    for (int it = wgi; it < NITEMS; it += nwg) {
        int r = it;
        if (r < I_S) { transpose_tile<false>(a.w_sb_up, 512, 1024, nullptr, (bf16_t*)(ws + WS_WSB), tile, r, F.tid); continue; } r -= I_S;
        if (r < I_S) { transpose_tile<false>(a.w_gdn_up, 512, 1024, nullptr, (bf16_t*)(ws + WS_WGDN), tile, r, F.tid); continue; } r -= I_S;
        if (r < I_M) { transpose_tile<false>(a.w_mix_out, 1024, 1024, nullptr, (bf16_t*)(ws + WS_WMIX), tile, r, F.tid); continue; } r -= I_M;
        if (r < I_M) { transpose_tile<false>(a.w_cq, 1024, 1024, a.g_cross, (bf16_t*)(ws + WS_WCQ), tile, r, F.tid); continue; } r -= I_M;
        if (r < I_M) { transpose_tile<false>(a.w_co, 1024, 1024, nullptr, (bf16_t*)(ws + WS_WCO), tile, r, F.tid); continue; } r -= I_M;
        if (r < I_L) { transpose_tile<false>(a.w_ckv, 1024, 2048, nullptr, (bf16_t*)(ws + WS_WCKV), tile, r, F.tid); continue; } r -= I_L;
        transpose_tile<false>(a.w_pq, 1024, 2048, a.g_peer, (bf16_t*)(ws + WS_WPQ), tile, r, F.tid);
    }
    __syncthreads();
    {
        float* SUV = (float*)(ws + WS_SUV);
        for (int row0 = gw * 4; row0 < 2 * 16384; row0 += NGW * 4) {
            f32x4 v[4][4];
#pragma unroll
            for (int r = 0; r < 4; ++r) { const int row = row0 + r, tb = row >> 14, e = row & 16383; const float* src = (tb ? a.peer_v : a.peer_u) + (size_t)e * 1024 + 16 * F.lane;
#pragma unroll
                for (int q = 0; q < 4; ++q) v[r][q] = *(const GAS f32x4*)(src + 4 * q); }
#pragma unroll
            for (int r = 0; r < 4; ++r) { const int row = row0 + r, tb = row >> 14, e = row & 16383; float am = 0.f;
#pragma unroll
                for (int q = 0; q < 4; ++q) am = fmaxf(am, fmaxf(fmaxf(fabsf(v[r][q].x), fabsf(v[r][q].y)), fmaxf(fabsf(v[r][q].z), fabsf(v[r][q].w))));
#pragma unroll
                for (int o = 1; o < 64; o <<= 1) am = fmaxf(am, __shfl_xor(am, o));
                int ex = 0; if (am > 0.f) (void)frexpf(am, &ex);
                const float sc = ldexpf(1.f, 8 - ex), inv = ldexpf(1.f, ex - 8);
                v4u o; int rr;
                rr = __builtin_amdgcn_cvt_pk_fp8_f32(v[r][0].x * sc, v[r][0].y * sc, 0, false); rr = __builtin_amdgcn_cvt_pk_fp8_f32(v[r][0].z * sc, v[r][0].w * sc, rr, true); o.x = (unsigned)rr;
                rr = __builtin_amdgcn_cvt_pk_fp8_f32(v[r][1].x * sc, v[r][1].y * sc, 0, false); rr = __builtin_amdgcn_cvt_pk_fp8_f32(v[r][1].z * sc, v[r][1].w * sc, rr, true); o.y = (unsigned)rr;
                rr = __builtin_amdgcn_cvt_pk_fp8_f32(v[r][2].x * sc, v[r][2].y * sc, 0, false); rr = __builtin_amdgcn_cvt_pk_fp8_f32(v[r][2].z * sc, v[r][2].w * sc, rr, true); o.z = (unsigned)rr;
                rr = __builtin_amdgcn_cvt_pk_fp8_f32(v[r][3].x * sc, v[r][3].y * sc, 0, false); rr = __builtin_amdgcn_cvt_pk_fp8_f32(v[r][3].z * sc, v[r][3].w * sc, rr, true); o.w = (unsigned)rr;
                *(GAS v4u*)(ws + (tb ? WS_V8 : WS_U8) + ((size_t)(F.lane >> 3) * 16384 + e) * 128 + 16 * (F.lane & 7)) = o;
                if (F.lane == 0) SUV[row] = inv; }
        }
    }
    {
        const int gt = gw * 64 + F.lane, ngt = NGW * 64;
        for (int p = gt; p < 262144 / 8; p += ngt) { const float* src = a.subkeys + (size_t)p * 8; const f32x4 v0 = *(const GAS f32x4*)src, v1 = *(const GAS f32x4*)(src + 4);
            v4u o; o.x = pk2(v0.x, v0.y); o.y = pk2(v0.z, v0.w); o.z = pk2(v1.x, v1.y); o.w = pk2(v1.z, v1.w); *(GAS v4u*)((bf16_t*)(ws + WS_SKB) + (size_t)p * 8) = o; }
    }
    bf16_t* MN = (bf16_t*)(ws + WS_MN);
    for (int row = gw; row < 1024; row += NGW) {
        const GAS f32x4* xr = (const GAS f32x4*)(a.mem + (size_t)row * D) + F.lane;
        f32x4 v[4]; float s = 0.f;
#pragma unroll
        for (int j = 0; j < 4; ++j) { v[j] = xr[64 * j]; s += (v[j].x * v[j].x + v[j].y * v[j].y) + (v[j].z * v[j].z + v[j].w * v[j].w); }
        const float rstd = rsqrtf(wave_sum(s) * (1.f / D) + EPS);
        GAS unsigned long long* o8 = (GAS unsigned long long*)(MN + (size_t)row * D) + F.lane;
#pragma unroll
        for (int j = 0; j < 4; ++j) { const f32x4 g = *((const f32x4*)a.g_mem + F.lane + 64 * j); const f32x4 o = v[j] * g * rstd;
            o8[64 * j] = (unsigned long long)pk2(o.x, o.y) | ((unsigned long long)pk2(o.z, o.w) << 32); }
    }
}
__device__ __forceinline__ void rstd_rows_for_units(Frame& F, int N, const float* SS, float* rstd) {
    pg8::StaticOrder S2; S2.init(T, N, F.G, (int)blockIdx.x); pg8::Unit u;
    for (int i = 0; S2.next(i, u); ++i) if (F.tid < 256) { const int row = u.pm * 256 + F.tid; const f32x4* sp = (const f32x4*)(SS + (size_t)row * 16);
        const f32x4 a = (sp[0] + sp[1]) + (sp[2] + sp[3]); rstd[row] = rsqrtf(((a.x + a.y) + (a.z + a.w)) * (1.f / 1024.f) + EPS); }
    asm volatile("s_waitcnt vmcnt(0)" ::: "memory"); __syncthreads();
}

__device__ __forceinline__ void sub_barrier(gu32* cnt, unsigned n, gu32* tmo) {
    asm volatile("s_waitcnt vmcnt(0)" ::: "memory");
    __syncthreads();
    if (threadIdx.x == 0) {
        __builtin_amdgcn_fence(__ATOMIC_RELEASE, "agent");
        asm volatile("s_waitcnt vmcnt(0)" ::: "memory");
        __hip_atomic_fetch_add(cnt, 1u, __ATOMIC_RELAXED, __HIP_MEMORY_SCOPE_AGENT);
        unsigned sp = 0;
        while (__hip_atomic_load(cnt, __ATOMIC_RELAXED, __HIP_MEMORY_SCOPE_AGENT) < n) { __builtin_amdgcn_s_sleep(2); if (++sp > (1u << 22)) { __hip_atomic_store(tmo, 1u, __ATOMIC_RELAXED, __HIP_MEMORY_SCOPE_AGENT); break; } }
        __builtin_amdgcn_fence(__ATOMIC_ACQUIRE, "agent");
        asm volatile("s_waitcnt vmcnt(0)" ::: "memory");
    }
    __syncthreads();
}

__global__ void __launch_bounds__(NWAVES * 64, 2) mk_fwd(Args args) {
    extern __shared__ __attribute__((aligned(16))) unsigned char lds_raw[];
    Frame F;
    F.lds = (LAS unsigned char*)lds_raw;
    F.tid = threadIdx.x; F.lane = F.tid & 63; F.wave = __builtin_amdgcn_readfirstlane(F.tid >> 6);
    F.G = gridDim.x; { const int bx = blockIdx.x; F.vcu = (F.G % 8 == 0) ? (bx % 8) * (F.G / 8) + bx / 8 : bx; }
    unsigned char* ws = args.ws;
    gu32* ctl = (gu32*)(ws + WS_CTL);
    volatile LAS unsigned* MISC = (volatile LAS unsigned*)(F.lds + MISC_OFF);
    for (int u = F.tid; u < (LDS_BYTES - LDSCTL_OFF) / 4; u += NWAVES * 64) ((LAS unsigned*)(F.lds + LDSCTL_OFF))[u] = 0u;
    __syncthreads();
    XcdBarrier bar = xcd_barrier_post((unsigned*)(ctl + CW_BAR) + args.bar_region * XCD_BAR_WORDS, MISC + 8);
    const int lo = args.ph_lo, hi = args.ph_hi;
#define IN(k) (lo <= (k) && (k) < hi)
#define SEAM(k) do { if (IN(k) && IN((k) + 1)) xcd_barrier(bar); } while (0)
    bf16_t* A0 = (bf16_t*)(ws + WS_A0); bf16_t* A1 = (bf16_t*)(ws + WS_A1);
    bf16_t* MG = (bf16_t*)args.out;
    bf16_t* SBQ = (bf16_t*)args.out; bf16_t* SBK = SBQ + (size_t)T * 512; bf16_t* SBV = SBK + (size_t)T * 512; bf16_t* OSB = SBV + (size_t)T * 512;

    GdnBufs Gb{(bf16_t*)(ws + WS_NW), (bf16_t*)(ws + WS_QD), (bf16_t*)(ws + WS_KDT), (bf16_t*)(ws + WS_QK), (bf16_t*)(ws + WS_UT), (float*)(ws + WS_CD), (bf16_t*)(ws + WS_ORAW), (float*)(ws + WS_OSS)};
    if (IN(0)) { p0_prologue(F, args);}
    SEAM(0);
    if (IN(1)) {
        { pg8::Gemm g{A0, (const bf16_t*)(ws + WS_WIN), T, NPROJ, 1024}; pg8::StaticOrder S; S.init(T, NPROJ, F.G, (int)blockIdx.x);
          pg8::EpiProj E{(const float*)(ws + WS_RSTD0), SBQ, SBK, SBV, A1, (bf16_t*)(ws + WS_GZ), (bf16_t*)(ws + WS_GSB), (bf16_t*)(ws + WS_GGDN)};
          pg8::gemm_phase<pg8::EpiProj, pg8::StaticOrder, true, true>(F.lds, g, S, E); }
    }
    SEAM(1);
    if (IN(2)) { gdn_prep_phase(F, args, A1, (const float*)(ws + WS_GB), (const float*)(ws + WS_GB) + T * 4, Gb); }
    SEAM(2);
    if (IN(3)) {
        const int nscan = F.G > 64 ? 64 : F.G, sb0 = F.G > 64 ? 64 : 0;
        if ((int)blockIdx.x < nscan) for (int s0 = blockIdx.x; s0 < 64; s0 += nscan) { const int s = (nscan == 64) ? ((s0 & 7) + 8 * (s0 >> 5)) * 4 + ((s0 >> 3) & 3) : s0; gdn_scan_unit(F, s, Gb); __syncthreads(); }
        if ((int)blockIdx.x >= sb0) { late_prologue(F, args, (int)blockIdx.x - sb0, F.G - sb0); __syncthreads(); }
        if ((int)blockIdx.x >= sb0) sb_phase(F.lds + F.wave * 8192, SBQ, SBK, SBV, OSB, ((int)blockIdx.x - sb0) * NWAVES + F.wave, (F.G - sb0) * NWAVES, F.lane);
        __syncthreads();
        if (sb0 > 0 && (int)blockIdx.x >= sb0) {
            sub_barrier(ctl + CW_SUB, (unsigned)(F.G - sb0), ctl + CW_SUB + 64);
            pg8::Gemm g{OSB, (const bf16_t*)(ws + WS_WSB), T, 1024, 512}; pg8::StaticOrder S; S.init(T, 1024, F.G - sb0, (int)blockIdx.x - sb0);
            pg8::EpiMerge<false> E{(const bf16_t*)(ws + WS_GSB), MG};
            pg8::gemm_phase<pg8::EpiMerge<false>, pg8::StaticOrder, true, true>(F.lds, g, S, E);
            const int wgi = (int)blockIdx.x - sb0;
            if (F.G - sb0 >= 160 && wgi >= 128 && wgi < 160) { pg8::Gemm g2{(const bf16_t*)(ws + WS_MN), (const bf16_t*)(ws + WS_WCKV), 1024, 2048, 1024}; pg8::StaticOrder S2; S2.init(1024, 2048, 32, wgi - 128);
                pg8::EpiSplit E2{(bf16_t*)(ws + WS_KC), (bf16_t*)(ws + WS_VC), 1024, 4};
                pg8::gemm_phase<pg8::EpiSplit, pg8::StaticOrder, true, true>(F.lds, g2, S2, E2); }
        }
    }
    SEAM(3);
    if (IN(4)) {
        if (!(F.G > 64 && F.G - 64 >= 160)) { pg8::Gemm g{(const bf16_t*)(ws + WS_MN), (const bf16_t*)(ws + WS_WCKV), 1024, 2048, 1024}; pg8::StaticOrder S; S.init(1024, 2048, F.G, (int)blockIdx.x);
          pg8::EpiSplit E{(bf16_t*)(ws + WS_KC), (bf16_t*)(ws + WS_VC), 1024, 4};
          pg8::gemm_phase<pg8::EpiSplit, pg8::StaticOrder, true, true>(F.lds, g, S, E); }
        gdn_finish_phase(F, args, Gb, (const bf16_t*)(ws + WS_GZ), (bf16_t*)(ws + WS_OG)); }
    SEAM(4);
    if (IN(5)) {
        if (!(F.G > 64)) { pg8::Gemm g{OSB, (const bf16_t*)(ws + WS_WSB), T, 1024, 512}; pg8::StaticOrder S; S.init(T, 1024, F.G, (int)blockIdx.x);
          pg8::EpiMerge<false> E{(const bf16_t*)(ws + WS_GSB), MG};
          pg8::gemm_phase<pg8::EpiMerge<false>, pg8::StaticOrder, true, true>(F.lds, g, S, E);
          xcd_barrier(bar); }
        { pg8::Gemm g{(const bf16_t*)(ws + WS_OG), (const bf16_t*)(ws + WS_WGDN), T, 1024, 512}; pg8::StaticOrder S; S.init(T, 1024, F.G, (int)blockIdx.x);
          pg8::EpiMerge<true> E{(const bf16_t*)(ws + WS_GGDN), MG};
          pg8::gemm_phase<pg8::EpiMerge<true>, pg8::StaticOrder, true, true>(F.lds, g, S, E); }
    }
    SEAM(5);
    if (IN(6)) {
        pg8::Gemm g{MG, (const bf16_t*)(ws + WS_WMIX), T, 1024, 1024}; pg8::StaticOrder S; S.init(T, 1024, F.G, (int)blockIdx.x);
        pg8::EpiRes<true> E{args.x, nullptr, A1, (float*)(ws + WS_SS)};
        pg8::gemm_phase<pg8::EpiRes<true>, pg8::StaticOrder, true, true>(F.lds, g, S, E);
    }
    SEAM(6);
    if (IN(7)) {
        rstd_rows_for_units(F, 1024, (const float*)(ws + WS_SS), (float*)(ws + WS_RSTD0));
        pg8::Gemm g{A1, (const bf16_t*)(ws + WS_WCQ), T, 1024, 1024}; pg8::StaticOrder S; S.init(T, 1024, F.G, (int)blockIdx.x);
        pg8::EpiScale E{(const float*)(ws + WS_RSTD0), (bf16_t*)(ws + WS_GSB), 1024};
        pg8::gemm_phase<pg8::EpiScale, pg8::StaticOrder, true, true>(F.lds, g, S, E);
        asm volatile("s_waitcnt vmcnt(0)" ::: "memory"); __syncthreads();
        pg8::StaticOrder S2; S2.init(T, 1024, F.G, (int)blockIdx.x); pg8::Unit u;
        for (int i = 0; S2.next(i, u); ++i) cross_item(F, (const bf16_t*)(ws + WS_GSB), (const bf16_t*)(ws + WS_KC), (const bf16_t*)(ws + WS_VC), (bf16_t*)(ws + WS_GGDN), (u.pm >> 5) * 4 + u.pn, u.pm & 31);
    }
    SEAM(7);
    if (IN(9)) {
        pg8::Gemm g{(const bf16_t*)(ws + WS_GGDN), (const bf16_t*)(ws + WS_WCO), T, 1024, 1024}; pg8::StaticOrder S; S.init(T, 1024, F.G, (int)blockIdx.x);
        pg8::EpiRes<false> E{nullptr, A1, A0, (float*)(ws + WS_SS)};
        pg8::gemm_phase<pg8::EpiRes<false>, pg8::StaticOrder, true, true>(F.lds, g, S, E);
    }
    SEAM(9);
    if (IN(10)) {
        rstd_rows_for_units(F, 2048, (const float*)(ws + WS_SS), (float*)(ws + WS_RSTD2));
        pg8::Gemm g{A0, (const bf16_t*)(ws + WS_WPQ), T, 2048, 1024}; pg8::StaticOrder S; S.init(T, 2048, F.G, (int)blockIdx.x);
        pg8::EpiScale E{(const float*)(ws + WS_RSTD2), A1, 2048};
        pg8::gemm_phase<pg8::EpiScale, pg8::StaticOrder, true, true>(F.lds, g, S, E);
        asm volatile("s_waitcnt vmcnt(0)" ::: "memory"); __syncthreads();
        pg8::StaticOrder S2; S2.init(T, 2048, F.G, (int)blockIdx.x); pg8::Unit u;
        int hst = -1;
        for (int i = 0; S2.next(i, u); ++i) {
            if (u.pn != hst) { hst = u.pn; __syncthreads();
#pragma unroll
                for (int q = 0; q < 8; ++q) { const int cid = F.tid + 512 * q, r = cid >> 4, c = cid & 15;
                    *(LAS v4u*)(F.lds + r * 256 + ((c ^ (r & 15)) << 4)) = *(const v4u*)((const bf16_t*)(ws + WS_SKB) + ((size_t)u.pn * 256 + r) * 128 + c * 8); }
                __syncthreads(); }
            peer_route_task(F, A1, (const bf16_t*)(ws + WS_SKB), (int*)(ws + 296 * MiB), (float*)(ws + 312 * MiB), u.pm * 8 + F.wave, u.pn);
        }
        __syncthreads();
    }
    SEAM(10);
    if (IN(12)) { peer_u_phase(F, args, ctl, A0, (const float*)(ws + WS_RSTD2), (const int*)(ws + 296 * MiB), (const unsigned char*)(ws + WS_U8), (bf16_t*)(ws + WS_PART)); }
    SEAM(12);
    if (IN(13)) { peer_combine_phase(F, (const bf16_t*)(ws + WS_PART), (const int*)(ws + 296 * MiB), (const float*)(ws + 312 * MiB), (const float*)(ws + WS_SUV), (const float*)(ws + WS_SUV) + 16384, (float*)(ws + 328 * MiB)); }
    SEAM(13);
    if (IN(14)) { peer_v_phase(F, ctl, (const int*)(ws + 296 * MiB), (const float*)(ws + 328 * MiB), (const unsigned char*)(ws + WS_V8), A0, A1, (float*)(ws + WS_SS)); }
    SEAM(14);
    if (IN(15)) { peer_norm_phase(F, args, (const float*)(ws + WS_SS), A1, args.out); }
#undef IN
#undef SEAM
}
extern "C" void kernel_launch(void* const* d_in, const int* in_sizes, int n_in, void* d_out, int out_size, void* d_ws, size_t ws_size, hipStream_t stream) {
    static int grid = 0;
    if (grid == 0) {
        if (n_in != 22 || ws_size < WS_END || out_size != T * D) { fprintf(stderr, "kernel_launch: unexpected n_in %d / ws %zu / out %d\n", n_in, ws_size, out_size); grid = -1; return; }
        int dev = 0, cus = 0, per_cu = 0;
        if (hipGetDevice(&dev) != hipSuccess || hipDeviceGetAttribute(&cus, hipDeviceAttributeMultiprocessorCount, dev) != hipSuccess) { grid = -1; return; }
        if (hipFuncSetAttribute((const void*)mk_fwd, hipFuncAttributeMaxDynamicSharedMemorySize, LDS_BYTES) != hipSuccess) { fprintf(stderr, "kernel_launch: hipFuncSetAttribute failed\n"); grid = -1; return; }
        if (hipOccupancyMaxActiveBlocksPerMultiprocessor(&per_cu, (const void*)mk_fwd, NWAVES * 64, LDS_BYTES) != hipSuccess || per_cu < 1) { fprintf(stderr, "kernel_launch: occupancy query says %d\n", per_cu); per_cu = 1; }
        (void)hipGetLastError();
        grid = cus;
    }
    if (grid < 0) return;
    hipMemsetAsync((char*)d_ws + WS_CTL, 0, CTL_ZERO_BYTES, stream);
    Args a{};
    const float** ap = (const float**)&a;
    for (int i = 0; i < 22; ++i) ap[i] = (const float*)d_in[i];
    a.out = (float*)d_out; a.ws = (unsigned char*)d_ws;
    char* ws = (char*)d_ws; float* out = (float*)d_out;
    float* rstd2 = (float*)(ws + WS_RSTD2);
    bf16_t* KC = (bf16_t*)(ws + WS_KC); bf16_t* VC = (bf16_t*)(ws + WS_VC);
    bf16_t* PQ = (bf16_t*)(ws + WS_A1); bf16_t* QC = (bf16_t*)(ws + WS_GSB); bf16_t* OC = (bf16_t*)(ws + WS_GGDN);
    int* EIDX = (int*)(ws + 296 * MiB); float* EGATE = (float*)(ws + 312 * MiB);
#define MK(lo, hi, reg) do { a.ph_lo = (lo); a.ph_hi = (hi); a.bar_region = (reg); hipLaunchKernelGGL(mk_fwd, dim3(grid), dim3(NWAVES * 64), LDS_BYTES, stream, a); } while (0)
    MK(0, 16, 0);
#undef MK
}
```

```cpp
#include <hip/hip_runtime.h>
#include <stdint.h>
#include <cstdio>

typedef unsigned short bf16_t;
__device__ __forceinline__ float bf2f(bf16_t v) { return __uint_as_float(((unsigned)v) << 16); }
__device__ __forceinline__ bf16_t f2bf(float f) { unsigned u = __float_as_uint(f); return (bf16_t)((u + 0x7fffu + ((u >> 16) & 1u)) >> 16); }

constexpr int T = 32768, D = 1024, SEQ = 8192, NB = 4;
constexpr int IN_COLS = 5640, NPROJ = 5632;
constexpr float EPS = 1e-6f;
constexpr size_t MiB = 1u << 20;

__device__ __forceinline__ float wave_sum(float v) {
#pragma unroll
    for (int o = 1; o < 64; o <<= 1) v += __shfl_xor(v, o);
    return v;
}
__device__ __forceinline__ float sigmoidf_(float x) { return 1.f / (1.f + __expf(-x)); }
__device__ __forceinline__ float softplusf_(float x) { return fmaxf(x, 0.f) + log1pf(__expf(-fabsf(x))); }

namespace pg8 {
#define PG8_LAS __attribute__((address_space(3)))
typedef unsigned short bf16_t;
typedef short bf16x8 __attribute__((ext_vector_type(8)));
typedef float f32x4 __attribute__((ext_vector_type(4)));
typedef unsigned u32x4 __attribute__((ext_vector_type(4)));
constexpr int BM = 256, BK = 64, HALF = 128, HTB = HALF * BK * 2  , STAGE_BYTES = 8 * HTB, NXCD = 8, WGM = 8;

__host__ __device__ __forceinline__ int lds_byte(int r, int c) { const int st = (r >> 4) * 2 + (c >> 5), rr = r & 15, cc = c & 31, ob = rr * 64 + cc * 2; return st * 1024 + (ob ^ (((ob >> 9) & 1) << 5)); }
__host__ __device__ __forceinline__ void stage_rc(int b, int& R, int& C) { const int st = b / 1024, sb = b % 1024, swz = sb ^ (((sb >> 9) & 1) << 5); R = (st >> 1) * 16 + swz / 64; C = (st & 1) * 32 + (swz % 64) / 2; }
__host__ __device__ __forceinline__ int perm32(int rho) { const int n = rho >> 4, i = rho & 15; return 8 * (i >> 2) + 4 * n + (i & 3); }

struct Unit { int pm, pn; };
struct Gemm { const bf16_t* A; const bf16_t* Bt; int M, N, K; };

struct StaticOrder {
    int nM, nN, nwg, G, c;
    __host__ __device__ __forceinline__ void init(int M, int N, int G_, int c_) { nM = M / BM; nN = N / BM; nwg = nM * nN; G = G_; c = c_; }
    __host__ __device__ __forceinline__ bool next(int i, Unit& u) const {
        const long L = (long)i * G + c; if (L >= nwg) return false;
        int wgid = (int)L; { const int q = nwg / NXCD, r = nwg % NXCD, xcd = wgid % NXCD, off = wgid / NXCD; wgid = (xcd < r ? xcd * (q + 1) : r * (q + 1) + (xcd - r) * q) + off; }
        const int nig = WGM * nN, gid = wgid / nig, fm = gid * WGM, gsz = (nM - fm) < WGM ? (nM - fm) : WGM;
        u.pm = fm + ((wgid % nig) % gsz); u.pn = (wgid % nig) / gsz; return true;
    }
    __device__ __forceinline__ void a_ready(const Unit&) const {}
    __device__ __forceinline__ void done(const Unit&) const {}
};

__device__ __forceinline__ unsigned cvt_pk_bf16(float lo, float hi) { unsigned r; asm volatile("v_cvt_pk_bf16_f32 %0, %1, %2" : "=v"(r) : "v"(lo), "v"(hi)); return r; }
typedef float f32x2 __attribute__((ext_vector_type(2)));
__device__ __forceinline__ float bfl(unsigned w) { return __uint_as_float(w << 16); }
__device__ __forceinline__ float bfh(unsigned w) { return __uint_as_float(w & 0xffff0000u); }
constexpr int EPI_STAGE_OFF = 131072 + 1024;
__device__ __forceinline__ void stage_store16x64(int wid, int fr, int fq, u32x4 w0, u32x4 w1, bf16_t* rowbase  , size_t ld) {
    PG8_LAS unsigned char* sl = (PG8_LAS unsigned char*)(EPI_STAGE_OFF + wid * 2048);
    *(PG8_LAS u32x4*)(sl + fr * 128 + ((fq ^ (fr & 7)) << 4)) = w0;
    *(PG8_LAS u32x4*)(sl + fr * 128 + (((4 + fq) ^ (fr & 7)) << 4)) = w1;
    const int lane = fr + 16 * fq, r0 = lane >> 3, c = lane & 7;
    const u32x4 a = *(const PG8_LAS u32x4*)(sl + r0 * 128 + ((c ^ r0) << 4));
    const u32x4 b = *(const PG8_LAS u32x4*)(sl + (r0 + 8) * 128 + ((c ^ r0) << 4));
    *(u32x4*)(rowbase + (size_t)r0 * ld + c * 8) = a;
    *(u32x4*)(rowbase + (size_t)(r0 + 8) * ld + c * 8) = b;
}
__device__ __forceinline__ u32x4 pack8(const f32x4& v0, const f32x4& v1) { u32x4 w; w.x = cvt_pk_bf16(v0[0], v0[1]); w.y = cvt_pk_bf16(v0[2], v0[3]); w.z = cvt_pk_bf16(v1[0], v1[1]); w.w = cvt_pk_bf16(v1[2], v1[3]); return w; }

struct EpiProj {
    static constexpr bool PERM = true, AFTER_DRAIN = false, COL64 = true;
    const float* rstd; bf16_t *SBQ, *SBK, *SBV, *GQKV, *GZ, *GSB, *GGDN;
    __device__ __forceinline__ void operator()(const f32x4 (&acc)[2][2][4][2], const Unit& u, int wr, int wc, int fr_in, int fq_in) const {
        int lane_ = fr_in + 16 * fq_in; asm volatile("" : "+v"(lane_));
        const int fr = lane_ & 15, fq = lane_ >> 4;
        const int pn = u.pn; bf16_t* base; int ld, coff;
        if (pn < 2) { base = SBQ; ld = 512; coff = pn * 256; } else if (pn < 4) { base = SBK; ld = 512; coff = (pn - 2) * 256; } else if (pn < 6) { base = SBV; ld = 512; coff = (pn - 4) * 256; }
        else if (pn < 12) { base = GQKV; ld = 1536; coff = (pn - 6) * 256; } else if (pn < 14) { base = GZ; ld = 512; coff = (pn - 12) * 256; }
        else if (pn < 18) { base = GSB; ld = 1024; coff = (pn - 14) * 256; } else { base = GGDN; ld = 1024; coff = (pn - 18) * 256; }
        const int row0 = u.pm * BM + wr * 64, wid = wr * 4 + wc;
        float rsv[2][4];
#pragma unroll
        for (int ai = 0; ai < 2; ++ai)
#pragma unroll
            for (int m = 0; m < 4; ++m) rsv[ai][m] = rstd[row0 + ai * HALF + m * 16 + fr];
#pragma unroll
        for (int ai = 0; ai < 2; ++ai)
#pragma unroll
            for (int m = 0; m < 4; ++m) { const int rg = row0 + ai * HALF + m * 16; const float rs = rsv[ai][m];
                stage_store16x64(wid, fr, fq, pack8(acc[ai][0][m][0] * rs, acc[ai][0][m][1] * rs), pack8(acc[ai][1][m][0] * rs, acc[ai][1][m][1] * rs), base + (size_t)rg * ld + coff + wc * 64, ld); }
    }
};
struct EpiSplit {
    static constexpr bool PERM = true, AFTER_DRAIN = false, COL64 = true;
    bf16_t *O0, *O1; int ldc, split_tiles;
    __device__ __forceinline__ void operator()(const f32x4 (&acc)[2][2][4][2], const Unit& u, int wr, int wc, int fr_in, int fq_in) const {
        int lane_ = fr_in + 16 * fq_in; asm volatile("" : "+v"(lane_));
        const int fr = lane_ & 15, fq = lane_ >> 4;
        bf16_t* base = u.pn < split_tiles ? O0 : O1; const int coff = (u.pn < split_tiles ? u.pn : u.pn - split_tiles) * 256;
        const int row0 = u.pm * BM + wr * 64, wid = wr * 4 + wc;
#pragma unroll
        for (int ai = 0; ai < 2; ++ai)
#pragma unroll
            for (int m = 0; m < 4; ++m) { const int rg = row0 + ai * HALF + m * 16;
                stage_store16x64(wid, fr, fq, pack8(acc[ai][0][m][0], acc[ai][0][m][1]), pack8(acc[ai][1][m][0], acc[ai][1][m][1]), base + (size_t)rg * ldc + coff + wc * 64, ldc); }
    }
};
template <bool ADD> struct EpiMerge {
    static constexpr bool PERM = true, AFTER_DRAIN = false, COL64 = true;
    const bf16_t* gate; bf16_t* M;
    __device__ __forceinline__ void operator()(const f32x4 (&acc)[2][2][4][2], const Unit& u, int wr, int wc, int fr_in, int fq_in) const {
        int lane_ = fr_in + 16 * fq_in; asm volatile("" : "+v"(lane_));
        const int fr = lane_ & 15, fq = lane_ >> 4;
        const int row0 = u.pm * BM + wr * 64, col0 = u.pn * BM + wc * 64, wid = wr * 4 + wc;
#pragma unroll
        for (int ab = 0; ab < 4; ++ab) { const int ai = ab >> 1, mb = (ab & 1) * 2;
            u32x4 gl[4][2], pl[4][2];
#pragma unroll
            for (int m = mb; m < mb + 2; ++m)
#pragma unroll
                for (int bj = 0; bj < 2; ++bj) { const size_t o = (size_t)(row0 + ai * HALF + m * 16 + fr) * 1024 + col0 + 8 * fq + bj * 32; gl[m][bj] = *(const u32x4*)(gate + o); if (ADD) pl[m][bj] = *(const u32x4*)(M + o); }
#pragma unroll
            for (int m = mb; m < mb + 2; ++m) { const int rg = row0 + ai * HALF + m * 16;
                u32x4 wv[2];
#pragma unroll
                for (int bj = 0; bj < 2; ++bj) { const u32x4 g = gl[m][bj];
                    float gv[8] = {bfl(g.x), bfh(g.x), bfl(g.y), bfh(g.y), bfl(g.z), bfh(g.z), bfl(g.w), bfh(g.w)};
                    float pv[8] = {0.f, 0.f, 0.f, 0.f, 0.f, 0.f, 0.f, 0.f};
                    if (ADD) { const u32x4 p = pl[m][bj]; pv[0] = bfl(p.x); pv[1] = bfh(p.x); pv[2] = bfl(p.y); pv[3] = bfh(p.y); pv[4] = bfl(p.z); pv[5] = bfh(p.z); pv[6] = bfl(p.w); pv[7] = bfh(p.w); }
                    float r[8];
#pragma unroll
                    for (int j = 0; j < 8; ++j) { const float a = j < 4 ? acc[ai][bj][m][0][j] : acc[ai][bj][m][1][j - 4]; r[j] = pv[j] + a * __builtin_amdgcn_rcpf(1.f + __expf(-gv[j])); }
                    wv[bj].x = cvt_pk_bf16(r[0], r[1]); wv[bj].y = cvt_pk_bf16(r[2], r[3]); wv[bj].z = cvt_pk_bf16(r[4], r[5]); wv[bj].w = cvt_pk_bf16(r[6], r[7]); }
                stage_store16x64(wid, fr, fq, wv[0], wv[1], M + (size_t)rg * 1024 + col0, 1024); }
        }
    }
};
template <bool IN_F32> struct EpiRes {
    static constexpr bool PERM = true, AFTER_DRAIN = false, COL64 = true;
    const float* xin_f; const bf16_t* xin_b; bf16_t* xb; float* SS;
    __device__ __forceinline__ void operator()(const f32x4 (&acc)[2][2][4][2], const Unit& u, int wr, int wc, int fr_in, int fq_in) const {
        int lane_ = fr_in + 16 * fq_in; asm volatile("" : "+v"(lane_));
        const int fr = lane_ & 15, fq = lane_ >> 4;
        const int row0 = u.pm * BM + wr * 64, col0 = u.pn * BM + wc * 64, wid = wr * 4 + wc;
#pragma unroll
        for (int ab = 0; ab < 4; ++ab) { const int ai = ab >> 1, mb = (ab & 1) * 2;
            f32x4 xl[4][2][2];
#pragma unroll
            for (int m = mb; m < mb + 2; ++m)
#pragma unroll
                for (int bj = 0; bj < 2; ++bj) { const size_t o = (size_t)(row0 + ai * HALF + m * 16 + fr) * 1024 + col0 + 8 * fq + bj * 32;
                    if (IN_F32) { xl[m][bj][0] = *(const f32x4*)(xin_f + o); xl[m][bj][1] = *(const f32x4*)(xin_f + o + 4); }
                    else { const u32x4 p = *(const u32x4*)(xin_b + o); xl[m][bj][0] = (f32x4){bfl(p.x), bfh(p.x), bfl(p.y), bfh(p.y)}; xl[m][bj][1] = (f32x4){bfl(p.z), bfh(p.z), bfl(p.w), bfh(p.w)}; } }
            float sv[4];
#pragma unroll
            for (int m = mb; m < mb + 2; ++m) { const int rg = row0 + ai * HALF + m * 16; float s = 0.f;
                u32x4 wv[2];
#pragma unroll
                for (int bj = 0; bj < 2; ++bj) { const u32x4 w = pack8(xl[m][bj][0] + acc[ai][bj][m][0], xl[m][bj][1] + acc[ai][bj][m][1]); wv[bj] = w;
                    const float r0 = bfl(w.x), r1 = bfh(w.x), r2 = bfl(w.y), r3 = bfh(w.y), r4 = bfl(w.z), r5 = bfh(w.z), r6 = bfl(w.w), r7 = bfh(w.w);
                    s += (r0 * r0 + r1 * r1) + (r2 * r2 + r3 * r3) + (r4 * r4 + r5 * r5) + (r6 * r6 + r7 * r7); }
                stage_store16x64(wid, fr, fq, wv[0], wv[1], xb + (size_t)rg * 1024 + col0, 1024);
                s += __shfl_xor(s, 16); s += __shfl_xor(s, 32); sv[m] = s; }
#pragma unroll
            for (int m = mb; m < mb + 2; ++m) if (fq == 0) SS[(size_t)(row0 + ai * HALF + m * 16 + fr) * 16 + u.pn * 4 + wc] = sv[m];
        }
    }
};
struct EpiScale {
    static constexpr bool PERM = true, AFTER_DRAIN = false, COL64 = true;
    const float* rstd; bf16_t* O; int ldc;
    __device__ __forceinline__ void operator()(const f32x4 (&acc)[2][2][4][2], const Unit& u, int wr, int wc, int fr_in, int fq_in) const {
        int lane_ = fr_in + 16 * fq_in; asm volatile("" : "+v"(lane_));
        const int fr = lane_ & 15, fq = lane_ >> 4;
        const int row0 = u.pm * BM + wr * 64, col0 = u.pn * BM + wc * 64, wid = wr * 4 + wc;
        float rsv[2][4];
#pragma unroll
        for (int ai = 0; ai < 2; ++ai)
#pragma unroll
            for (int m = 0; m < 4; ++m) rsv[ai][m] = rstd[row0 + ai * HALF + m * 16 + fr];
#pragma unroll
        for (int ai = 0; ai < 2; ++ai)
#pragma unroll
            for (int m = 0; m < 4; ++m) { const int rg = row0 + ai * HALF + m * 16; const float rs = rsv[ai][m];
                stage_store16x64(wid, fr, fq, pack8(acc[ai][0][m][0] * rs, acc[ai][0][m][1] * rs), pack8(acc[ai][1][m][0] * rs, acc[ai][1][m][1] * rs), O + (size_t)rg * ldc + col0, ldc); }
    }
};
template <class Epi, class Sched, bool ALIGN_EPI = false, bool SP2 = false>
__device__ __forceinline__ void gemm_phase(PG8_LAS unsigned char* lds, const Gemm g, const Sched& S, const Epi& E) {
    const int tid = threadIdx.x, wid = __builtin_amdgcn_readfirstlane(tid >> 6), lane = tid & 63, wr = wid >> 2, wc = wid & 3, fr = lane & 15, fq = lane >> 4;
    const int K = g.K, nt = K / BK;
    unsigned voffA[2], voffB[2];
#pragma unroll
    for (int i = 0; i < 2; ++i) { int R, C; stage_rc(tid * 16 + i * 8192, R, C); const int Rb = Epi::PERM ? ((Epi::COL64 ? 2 * (R & ~31) : (R & ~31)) + perm32(R & 31)) : R;
        voffA[i] = (unsigned)(R * K + C) * 2u; voffB[i] = (unsigned)(Rb * K + C) * 2u; }
    const size_t kstep = (size_t)(BK * 2);
    const size_t hstep = (size_t)HALF * K * 2;
    const size_t bhstep = Epi::COL64 ? (size_t)32 * K * 2 : hstep;
    const size_t tstep = 2 * hstep;
    const unsigned ldsw = (unsigned)wid * 1024u;
    const int aoff = lds_byte(wr * 64 + fr, fq * 8), boff = lds_byte(wc * 32 + fr, fq * 8);
#define PG8_SA(b, h) (((b) * 2 + (h)) * HTB)
#define PG8_SB(b, h) ((4 + (b) * 2 + (h)) * HTB)
#define PG8_STAGE(bufoff, gbase, voff) do { _Pragma("unroll") for (int _i = 0; _i < 2; ++_i) \
        __builtin_amdgcn_global_load_lds((const unsigned*)((const char*)(gbase) + (voff)[_i]), (PG8_LAS unsigned*)(lds + (bufoff) + ldsw + _i * 8192), 16, 0, 0); } while (0)
#define PG8_LDA(dst, b, h) do { _Pragma("unroll") for (int m = 0; m < 4; ++m) _Pragma("unroll") for (int k = 0; k < 2; ++k) dst[m][k] = *(const PG8_LAS bf16x8*)(lds + PG8_SA(b, h) + aoff + m * 2048 + k * 1024); } while (0)
#define PG8_LDB(dst, b, h) do { _Pragma("unroll") for (int n = 0; n < 2; ++n) _Pragma("unroll") for (int k = 0; k < 2; ++k) dst[n][k] = *(const PG8_LAS bf16x8*)(lds + PG8_SB(b, h) + boff + n * 2048 + k * 1024); } while (0)
#define PG8_MMA(ai, bj, At, Bt) do { __builtin_amdgcn_s_setprio(1); _Pragma("unroll") for (int m = 0; m < 4; ++m) _Pragma("unroll") for (int n = 0; n < 2; ++n) _Pragma("unroll") for (int k = 0; k < 2; ++k) \
        acc[ai][bj][m][n] = __builtin_amdgcn_mfma_f32_16x16x32_bf16(Bt[n][k], At[m][k], acc[ai][bj][m][n], 0, 0, 0); __builtin_amdgcn_s_setprio(0); } while (0)
#define PG8_WAIT_V(n) asm volatile("s_waitcnt vmcnt(" #n ")" ::: "memory")
#define PG8_WAIT_L(n) asm volatile("s_waitcnt lgkmcnt(" #n ")" ::: "memory")
#define PG8_BAR __builtin_amdgcn_s_barrier()
#define PG8_SCHED __builtin_amdgcn_sched_barrier(0)
    Unit cur, nxt; int ui = 0;
    if (!S.next(0, cur)) return;
    f32x4 acc[2][2][4][2];
#pragma unroll
    for (int a = 0; a < 2; ++a)
#pragma unroll
        for (int b = 0; b < 2; ++b)
#pragma unroll
            for (int m = 0; m < 4; ++m)
#pragma unroll
                for (int n = 0; n < 2; ++n) acc[a][b][m][n] = (f32x4){0.f, 0.f, 0.f, 0.f};
    bf16x8 At[4][2], B0[2][2], B1[2][2];
    const char* cA = (const char*)g.A + (size_t)cur.pm * tstep; const char* cB = (const char*)g.Bt + (size_t)cur.pn * tstep;
    S.a_ready(cur);
    if constexpr (SP2) {
        PG8_STAGE(PG8_SB(0, 0), cB, voffB); PG8_STAGE(PG8_SB(0, 1), cB + bhstep, voffB); PG8_STAGE(PG8_SA(0, 0), cA, voffA); PG8_STAGE(PG8_SA(0, 1), cA + hstep, voffA);
        if (wr == 1) PG8_BAR;
        PG8_WAIT_V(2); PG8_BAR;
        PG8_STAGE(PG8_SB(1, 0), cB + kstep, voffB); PG8_STAGE(PG8_SA(1, 0), cA + kstep, voffA); PG8_STAGE(PG8_SB(1, 1), cB + bhstep + kstep, voffB);
        PG8_WAIT_V(6); PG8_BAR;
    } else {
        PG8_STAGE(PG8_SB(0, 0), cB, voffB); PG8_STAGE(PG8_SA(0, 0), cA, voffA); PG8_STAGE(PG8_SB(0, 1), cB + bhstep, voffB); PG8_STAGE(PG8_SA(0, 1), cA + hstep, voffA);
        if (wr == 1) PG8_BAR;
        PG8_WAIT_V(4); PG8_BAR;
        PG8_STAGE(PG8_SB(1, 0), cB + kstep, voffB); PG8_STAGE(PG8_SA(1, 0), cA + kstep, voffA); PG8_STAGE(PG8_SB(1, 1), cB + bhstep + kstep, voffB);
        PG8_WAIT_V(6); PG8_BAR;
    }
    for (;;) {
        const bool has_next = S.next(ui + 1, nxt);
        const char* nA = has_next ? (const char*)g.A + (size_t)nxt.pm * tstep : cA; const char* nB = has_next ? (const char*)g.Bt + (size_t)nxt.pn * tstep : cB;
        for (int t = 0; t < nt; t += 2) {
            const bool last = (t == nt - 2);
            const char* a1 = cA + (size_t)(t + 1) * kstep;
            const char* a2 = last ? nA : cA + (size_t)(t + 2) * kstep; const char* b2 = last ? nB : cB + (size_t)(t + 2) * kstep;
            const char* a3 = a2 + kstep; const char* b3 = b2 + kstep;
            if (last && has_next) S.a_ready(nxt);
            if constexpr (SP2) {
            PG8_LDB(B0, 0, 0); PG8_LDB(B1, 0, 1); PG8_SCHED; PG8_LDA(At, 0, 0); PG8_STAGE(PG8_SA(1, 1), a1 + hstep, voffA);
            PG8_WAIT_V(8); PG8_WAIT_L(0); PG8_BAR; PG8_MMA(0, 0, At, B0); PG8_MMA(0, 1, At, B1); PG8_BAR; PG8_SCHED;
            PG8_LDA(At, 0, 1); PG8_STAGE(PG8_SB(0, 0), b2, voffB); PG8_STAGE(PG8_SB(0, 1), b2 + bhstep, voffB); PG8_STAGE(PG8_SA(0, 0), a2, voffA);
            PG8_WAIT_V(8); PG8_WAIT_L(0); PG8_BAR; PG8_MMA(1, 0, At, B0); PG8_MMA(1, 1, At, B1); PG8_BAR; PG8_SCHED;
            PG8_LDB(B0, 1, 0); PG8_LDB(B1, 1, 1); PG8_SCHED; PG8_LDA(At, 1, 0); PG8_STAGE(PG8_SA(0, 1), a2 + hstep, voffA);
            PG8_WAIT_V(8); PG8_WAIT_L(0); PG8_BAR; PG8_MMA(0, 0, At, B0); PG8_MMA(0, 1, At, B1); PG8_BAR; PG8_SCHED;
            PG8_LDA(At, 1, 1); PG8_STAGE(PG8_SB(1, 0), b3, voffB); PG8_STAGE(PG8_SB(1, 1), b3 + bhstep, voffB); PG8_STAGE(PG8_SA(1, 0), a3, voffA);
            PG8_WAIT_V(8); PG8_WAIT_L(0); PG8_BAR; PG8_MMA(1, 0, At, B0); PG8_MMA(1, 1, At, B1); PG8_BAR; PG8_SCHED;
            } else {
            PG8_LDB(B0, 0, 0); PG8_SCHED; PG8_LDA(At, 0, 0); PG8_STAGE(PG8_SA(1, 1), a1 + hstep, voffA);
            PG8_WAIT_L(8); PG8_BAR; PG8_WAIT_L(0); PG8_MMA(0, 0, At, B0); PG8_BAR; PG8_SCHED;
            PG8_LDB(B1, 0, 1); PG8_STAGE(PG8_SB(0, 0), b2, voffB);
            PG8_BAR; PG8_WAIT_L(0); PG8_MMA(0, 1, At, B1); PG8_BAR;
            PG8_LDA(At, 0, 1); PG8_STAGE(PG8_SA(0, 0), a2, voffA);
            PG8_BAR; PG8_WAIT_L(0); PG8_MMA(1, 0, At, B0); PG8_BAR; PG8_SCHED;
            PG8_STAGE(PG8_SB(0, 1), b2 + bhstep, voffB);
            PG8_WAIT_V(6); PG8_BAR; PG8_MMA(1, 1, At, B1); PG8_BAR;
            PG8_LDB(B0, 1, 0); PG8_SCHED; PG8_LDA(At, 1, 0); PG8_STAGE(PG8_SA(0, 1), a2 + hstep, voffA);
            PG8_WAIT_L(8); PG8_BAR; PG8_WAIT_L(0); PG8_MMA(0, 0, At, B0); PG8_BAR; PG8_SCHED;
            PG8_LDB(B1, 1, 1); PG8_STAGE(PG8_SB(1, 0), b3, voffB);
            PG8_BAR; PG8_WAIT_L(0); PG8_MMA(0, 1, At, B1); PG8_BAR;
            PG8_LDA(At, 1, 1); PG8_STAGE(PG8_SA(1, 0), a3, voffA);
            PG8_BAR; PG8_WAIT_L(0); PG8_MMA(1, 0, At, B0); PG8_BAR; PG8_SCHED;
            PG8_STAGE(PG8_SB(1, 1), b3 + bhstep, voffB);
            PG8_WAIT_V(6); PG8_BAR; PG8_MMA(1, 1, At, B1); PG8_BAR;
            }
        }
        if constexpr (ALIGN_EPI) { if (wr == 0) PG8_BAR; }
        if constexpr (!Epi::AFTER_DRAIN) { E(acc, cur, wr, wc, fr, fq); S.done(cur); }
        if (!has_next) break;
#pragma unroll
        for (int a = 0; a < 2; ++a)
#pragma unroll
            for (int b = 0; b < 2; ++b)
#pragma unroll
                for (int m = 0; m < 4; ++m)
#pragma unroll
                    for (int n = 0; n < 2; ++n) acc[a][b][m][n] = (f32x4){0.f, 0.f, 0.f, 0.f};
        cur = nxt; cA = nA; cB = nB; ++ui;
        if constexpr (ALIGN_EPI) { if (wr == 1) PG8_BAR; }
    }
    PG8_WAIT_V(0);
    if constexpr (!ALIGN_EPI) { if (wr == 0) PG8_BAR; }
    PG8_BAR;
    if constexpr (Epi::AFTER_DRAIN) { E.fused(acc, cur, wr, wc, fr, fq, lds, wid, lane); S.done(cur); }
#undef PG8_SA
#undef PG8_SB
#undef PG8_STAGE
#undef PG8_LDA
#undef PG8_LDB
#undef PG8_MMA
#undef PG8_WAIT_V
#undef PG8_WAIT_L
#undef PG8_BAR
#undef PG8_SCHED
}
}
#define GAS __attribute__((address_space(1)))
#define LAS __attribute__((address_space(3)))
typedef unsigned short bf16;
typedef unsigned v4u __attribute__((ext_vector_type(4)));
typedef float f32x4 __attribute__((ext_vector_type(4)));
typedef short bf16x8 __attribute__((ext_vector_type(8)));
typedef GAS unsigned gu32;
typedef GAS unsigned long long gu64;
#define RLX_AGENT __ATOMIC_RELAXED, __HIP_MEMORY_SCOPE_AGENT
#define LDS_WAIT() asm volatile("s_waitcnt lgkmcnt(0)" ::: "memory")
#define VM_WAIT() asm volatile("s_waitcnt vmcnt(0)" ::: "memory")
__device__ __forceinline__ unsigned long long rt() { return __builtin_amdgcn_s_memrealtime(); }
__device__ __forceinline__ unsigned pk2(float lo, float hi) { return (unsigned)f2bf(lo) | ((unsigned)f2bf(hi) << 16); }

#define XB_TMO      128
#define XB_XCNT(j)  (256  + 64 * (j))
#define XB_XSUB(j)  (1280 + 64 * (j))
#define XB_XGEN(j)  (2304 + 64 * (j))
#define XB_TOP      3328
#define XB_TOPGEN   3392
#define XCD_BAR_WORDS 3456
#define XB_SPIN_CAP (1u << 18)

__device__ __forceinline__ unsigned xb_ld(unsigned* p)              { return __hip_atomic_load(p, __ATOMIC_RELAXED, __HIP_MEMORY_SCOPE_AGENT); }
__device__ __forceinline__ unsigned xb_add(unsigned* p, unsigned v) { return __hip_atomic_fetch_add(p, v, __ATOMIC_RELAXED, __HIP_MEMORY_SCOPE_AGENT); }
__device__ __forceinline__ unsigned xb_xcc_id() { return (unsigned)__builtin_amdgcn_s_getreg((3 << 11) | 20) & 0xFu; }
#define XB_SPIN(cond, bar) do { unsigned _sp = 0; while (cond) { __builtin_amdgcn_s_sleep(1); \
    if ((++_sp & 255u) == 0u) { if (xb_ld(&(bar)[XB_TMO])) break; if (_sp > XB_SPIN_CAP) { atomicAdd(&(bar)[XB_TMO], 1u); break; } } } } while (0)

struct XcdBarrier {
    unsigned* bar; unsigned x;
    volatile LAS unsigned* st;
};

__device__ __forceinline__ XcdBarrier xcd_barrier_post(unsigned* bar, volatile LAS unsigned* st) {
    XcdBarrier b; b.bar = bar; b.x = xb_xcc_id(); b.st = st;
    if (threadIdx.x == 0) (void)xb_add(&bar[XB_XCNT(b.x)], 1u);
    return b;
}
__device__ __forceinline__ void xcd_barrier_complete(unsigned* bar, unsigned x, unsigned& nloc, unsigned& nx) {
    const unsigned G = gridDim.x * gridDim.y * gridDim.z;
    unsigned sum, cnt, mine, sp = 0u;
    for (;;) {
        sum = 0u; cnt = 0u; mine = 0u;
#pragma unroll
        for (unsigned j = 0; j < 16; ++j) { const unsigned c = xb_ld(&bar[XB_XCNT(j)]); sum += c; cnt += (c > 0u) ? 1u : 0u; mine = (j == x) ? c : mine; }
        if (sum == G) break;
        __builtin_amdgcn_s_sleep(1);
        if ((++sp & 255u) == 0u) { if (xb_ld(&bar[XB_TMO])) break; if (sp > XB_SPIN_CAP) { atomicAdd(&bar[XB_TMO], 1u); break; } }
    }
    nloc = mine > 0u ? mine : 1u; nx = cnt > 0u ? cnt : 1u;
}

__device__ __forceinline__ void xcd_barrier(const XcdBarrier& b) {
    asm volatile("s_waitcnt vmcnt(0)" ::: "memory");
    __syncthreads();
    if (threadIdx.x == 0) {
        unsigned* bar = b.bar;
        __builtin_amdgcn_s_waitcnt(0);
        unsigned nloc = b.st[0], nx = b.st[1];
        if (nloc == 0u) { xcd_barrier_complete(bar, b.x, nloc, nx); b.st[0] = nloc; b.st[1] = nx; }
        const unsigned old = xb_add(&bar[XB_XSUB(b.x)], 1u);
        const unsigned gen = old / nloc;
        if (old + 1u == (gen + 1u) * nloc) {
            __builtin_amdgcn_fence(__ATOMIC_RELEASE, "agent");
            asm volatile("s_waitcnt vmcnt(0)" ::: "memory");
            const unsigned og = xb_add(&bar[XB_TOP], 1u);
            const unsigned tg = og / nx;
            if (og + 1u == (tg + 1u) * nx) xb_add(&bar[XB_TOPGEN], 1u);
            else XB_SPIN(xb_ld(&bar[XB_TOPGEN]) == tg, bar);
            __builtin_amdgcn_fence(__ATOMIC_ACQUIRE, "agent");
            xb_add(&bar[XB_XGEN(b.x)], 1u);
            asm volatile("s_waitcnt vmcnt(0)" ::: "memory");
        } else {
            XB_SPIN(xb_ld(&bar[XB_XGEN(b.x)]) == gen, bar);
            __builtin_amdgcn_fence(__ATOMIC_ACQUIRE, "agent");
            asm volatile("s_waitcnt vmcnt(0)" ::: "memory");
        }
    }
    __syncthreads();
}
constexpr size_t KiB = 1024;
constexpr size_t WS_CTL = 0, CTL_ZERO_BYTES = 1 * MiB;
constexpr size_t WS_WIN = 1 * MiB, WS_WSB = 12 * MiB, WS_WGDN = 13 * MiB, WS_WMIX = 14 * MiB, WS_WCQ = 16 * MiB, WS_WCO = 18 * MiB, WS_WCKV = 20 * MiB, WS_WPQ = 24 * MiB, WS_SKB = 28 * MiB, WS_U16 = 30 * MiB, WS_V16 = 62 * MiB;
constexpr size_t WS_RSTD0 = 94 * MiB, WS_RSTD2 = 94 * MiB + 256 * KiB, WS_CD = 94 * MiB + 384 * KiB, WS_GB = 94 * MiB + 512 * KiB;
constexpr size_t WS_MN = 96 * MiB, WS_KC = 98 * MiB, WS_VC = 100 * MiB, WS_SS = 102 * MiB;
constexpr size_t WS_A0 = 104 * MiB;
constexpr size_t WS_NW = 104 * MiB, WS_QD = 136 * MiB;
constexpr size_t WS_A1 = 168 * MiB;
constexpr size_t WS_ORAW = 168 * MiB, WS_OSS = 200 * MiB, WS_OG = 232 * MiB;
constexpr size_t WS_GZ = 264 * MiB;
constexpr size_t WS_GSB = 296 * MiB, WS_GGDN = 360 * MiB;
constexpr size_t WS_KDT = 424 * MiB, WS_QK = 456 * MiB, WS_UT = 472 * MiB;
constexpr size_t WS_U8 = 30 * MiB, WS_V8 = 46 * MiB, WS_SUV = 62 * MiB;
constexpr size_t WS_PART = 344 * MiB;
constexpr size_t WS_END = 512 * MiB;
constexpr int CW_SUB = 12288;
constexpr int CW_BAR = 4096;

constexpr int NWAVES = 8;
constexpr int RING_BYTES = 131072, LDSCTL_OFF = RING_BYTES, MISC_OFF = LDSCTL_OFF + 320, LDS_BYTES = 149504;

struct Args {
    const float *x, *mem, *g_mix, *w_in, *gdn_conv, *a_log, *dt_bias, *gdn_norm_g, *w_sb_up, *w_gdn_up, *w_mix_out, *g_cross, *g_mem, *w_cq, *w_ckv, *w_co, *g_peer, *w_pq, *subkeys, *peer_u, *peer_v, *g_final;
    float* out; unsigned char* ws; int ph_lo, ph_hi, bar_region, pad;
};

struct Frame {
    LAS unsigned char* lds; int tid, lane, wave, vcu, G;
};


typedef short bf16x8_t __attribute__((ext_vector_type(8)));
typedef float f32x16_t __attribute__((ext_vector_type(16)));
typedef short v4i16_t __attribute__((ext_vector_type(4)));
typedef float f32x2v_t __attribute__((ext_vector_type(2))); typedef __bf16 bf16x2v_t __attribute__((ext_vector_type(2)));
__device__ __forceinline__ unsigned cvtpk(float lo, float hi) { f32x2v_t v = {lo, hi}; bf16x2v_t b = __builtin_convertvector(v, bf16x2v_t); return __builtin_bit_cast(unsigned, b); }
__device__ __forceinline__ v4i16_t lds_tr16(LAS unsigned char* p) { return __builtin_amdgcn_ds_read_tr16_b64_v4i16((LAS v4i16_t*)p); }

__device__ __forceinline__ void sb_phase(LAS unsigned char* wlds  , const bf16_t* SBQ, const bf16_t* SBK, const bf16_t* SBV, bf16_t* OSB, int gw, int ngw, int lane) {
    const int q = lane & 31, hi = lane >> 5;
    bf16x8_t Mf[2];
#pragma unroll
    for (int s = 0; s < 2; ++s)
#pragma unroll
        for (int j = 0; j < 8; ++j) { const int k = 16 * s + 8 * (j >> 2) + 4 * hi + (j & 3); Mf[s][j] = (k > q) ? (short)0x3F80 : (short)0; }
    const int vrow = lane >> 3, vch = lane & 7;
    const int g4 = lane >> 4, qq = (lane >> 2) & 3, p4 = lane & 3;
    LAS unsigned char* trb = wlds + (4 * (g4 >> 1) + qq) * 192 + ((g4 & 1) * 16 + 4 * p4) * 2;
    for (int item = gw; item < 32 * 256; item += ngw) {
        const int bh = item >> 8, qt = item & 255, b = bh >> 3, h = bh & 7;
        const size_t base = (size_t)b * SEQ;
        const bf16_t* Qp = SBQ + (base + qt * 32 + q) * 512 + h * 64 + 8 * hi;
        bf16x8_t Qf[4];
#pragma unroll
        for (int ks = 0; ks < 4; ++ks) Qf[ks] = *(const bf16x8_t*)(Qp + 16 * ks);
        f32x16_t o0 = {}, o1 = {};
        float carry = 0.f;
        bf16x8_t Kn[4]; v4u vn[4];
        {   const bf16_t* Kp = SBK + (base + qt * 32 + q) * 512 + h * 64 + 8 * hi;
#pragma unroll
            for (int ks = 0; ks < 4; ++ks) Kn[ks] = *(const bf16x8_t*)(Kp + 16 * ks);
#pragma unroll
            for (int i = 0; i < 4; ++i) vn[i] = *(const v4u*)(SBV + (base + qt * 32 + vrow + 8 * i) * 512 + h * 64 + vch * 8); }
        for (int kb = qt; kb >= 0; --kb) {
            bf16x8_t Kf[4]; v4u vv[4];
#pragma unroll
            for (int ks = 0; ks < 4; ++ks) Kf[ks] = Kn[ks];
#pragma unroll
            for (int i = 0; i < 4; ++i) vv[i] = vn[i];
            {   const int kn = kb > 0 ? kb - 1 : 0;
                const bf16_t* Kp = SBK + (base + kn * 32 + q) * 512 + h * 64 + 8 * hi;
#pragma unroll
                for (int ks = 0; ks < 4; ++ks) Kn[ks] = *(const bf16x8_t*)(Kp + 16 * ks);
#pragma unroll
                for (int i = 0; i < 4; ++i) vn[i] = *(const v4u*)(SBV + (base + kn * 32 + vrow + 8 * i) * 512 + h * 64 + vch * 8); }
            f32x16_t st = {};
#pragma unroll
            for (int ks = 0; ks < 4; ++ks) st = __builtin_amdgcn_mfma_f32_32x32x16_bf16(Kf[ks], Qf[ks], st, 0, 0, 0);
#pragma unroll
            for (int i = 0; i < 4; ++i) *(LAS v4u*)(wlds + (vrow + 8 * i) * 192 + vch * 16) = vv[i];
            const bool diag = (kb == qt);
            float z[16], lk[16];
#pragma unroll
            for (int r = 0; r < 16; ++r) {
                const int key = (r & 3) + 8 * (r >> 2) + 4 * hi;
                z[r] = st[r] * 0.125f;
                const float sp = fmaxf(z[r], 0.f) + __logf(1.f + __expf(-fabsf(z[r])));
                const bool valid = !diag || key < q;
                lk[r] = valid ? -sp : 0.f;
                z[r] = valid ? z[r] - sp : -INFINITY;
            }
            bf16x8_t lh[2], ll[2];
#pragma unroll
            for (int s = 0; s < 2; ++s) {
                unsigned wh[4], wl[4];
#pragma unroll
                for (int jj = 0; jj < 4; ++jj) { const float a = lk[8 * s + 2 * jj], c = lk[8 * s + 2 * jj + 1]; wh[jj] = cvtpk(a, c);
                    wl[jj] = cvtpk(a - __uint_as_float(wh[jj] << 16), c - __uint_as_float(wh[jj] & 0xffff0000u)); }
                lh[s] = __builtin_bit_cast(bf16x8_t, (v4u){wh[0], wh[1], wh[2], wh[3]}); ll[s] = __builtin_bit_cast(bf16x8_t, (v4u){wl[0], wl[1], wl[2], wl[3]});
            }
            f32x16_t af;
#pragma unroll
            for (int r = 0; r < 16; ++r) af[r] = carry;
            af = __builtin_amdgcn_mfma_f32_32x32x16_bf16(Mf[0], lh[0], af, 0, 0, 0);
            af = __builtin_amdgcn_mfma_f32_32x32x16_bf16(Mf[1], lh[1], af, 0, 0, 0);
            af = __builtin_amdgcn_mfma_f32_32x32x16_bf16(Mf[0], ll[0], af, 0, 0, 0);
            af = __builtin_amdgcn_mfma_f32_32x32x16_bf16(Mf[1], ll[1], af, 0, 0, 0);
            float tot = af[0] + lk[0];
            tot = __shfl(tot, q);
            float pr[16];
#pragma unroll
            for (int r = 0; r < 16; ++r) pr[r] = __expf(z[r] + af[r]);
            bf16x8_t pa[2];
#pragma unroll
            for (int s = 0; s < 2; ++s) pa[s] = __builtin_bit_cast(bf16x8_t, (v4u){cvtpk(pr[8 * s], pr[8 * s + 1]), cvtpk(pr[8 * s + 2], pr[8 * s + 3]), cvtpk(pr[8 * s + 4], pr[8 * s + 5]), cvtpk(pr[8 * s + 6], pr[8 * s + 7])});
            asm volatile("s_waitcnt lgkmcnt(0)" ::: "memory");
#pragma unroll
            for (int s = 0; s < 2; ++s) {
                const v4i16_t a0 = lds_tr16(trb + (16 * s) * 192), a1 = lds_tr16(trb + (16 * s + 8) * 192);
                const v4i16_t c0 = lds_tr16(trb + (16 * s) * 192 + 64), c1 = lds_tr16(trb + (16 * s + 8) * 192 + 64);
                const bf16x8_t vb0 = {a0[0], a0[1], a0[2], a0[3], a1[0], a1[1], a1[2], a1[3]}, vb1 = {c0[0], c0[1], c0[2], c0[3], c1[0], c1[1], c1[2], c1[3]};
                o0 = __builtin_amdgcn_mfma_f32_32x32x16_bf16(pa[s], vb0, o0, 0, 0, 0);
                o1 = __builtin_amdgcn_mfma_f32_32x32x16_bf16(pa[s], vb1, o1, 0, 0, 0);
            }
            carry = tot;
            if (__all(carry < -104.f)) break;
        }
        bf16_t* Op = OSB + (base + qt * 32) * 512 + h * 64 + q;
#pragma unroll
        for (int r = 0; r < 16; ++r) { const int row = (r & 3) + 8 * (r >> 2) + 4 * hi; Op[(size_t)row * 512] = f2bf(o0[r]); Op[(size_t)row * 512 + 32] = f2bf(o1[r]); }
    }
}
typedef float f32x4_t __attribute__((ext_vector_type(4)));
typedef unsigned v2u __attribute__((ext_vector_type(2)));
__device__ __forceinline__ float bflo(unsigned w) { return __uint_as_float(w << 16); }
__device__ __forceinline__ float bfhi(unsigned w) { return __uint_as_float(w & 0xffff0000u); }
__device__ __forceinline__ int frag_off(int r, int k0, int KS) { return (((r >> 4) * KS + (k0 >> 5)) << 9) + (((r & 15) + 16 * ((k0 & 15) >> 2)) << 3) + (((k0 & 31) >> 4) << 2); }

constexpr int GP_KS = 0, GP_QS = 17408, GP_VS = 34816, GP_AS = 52224, GP_WT = 69632, GP_GC = 87040, GP_BETA = 87296, GP_EGC = 87552, GP_CW = 88064, GP_TS = 94208;
constexpr int GROW = 136;

#define LDS_BARRIER() do { asm volatile("s_waitcnt lgkmcnt(0)" ::: "memory"); __builtin_amdgcn_s_barrier(); asm volatile("" ::: "memory"); } while (0)
struct GdnBufs { bf16_t *NW, *QD, *KDT, *QK, *UT; float* CD; bf16_t* ORAW; float* OSS; };

__device__ __forceinline__ void gdn_prep_phase(Frame& F, const Args& a, const bf16_t* GQKV, const float* GB, const float* GA, const GdnBufs& Gb) {
    LAS unsigned char* L = F.lds;
    LAS bf16_t* KS = (LAS bf16_t*)(L + GP_KS); LAS bf16_t* QS = (LAS bf16_t*)(L + GP_QS); LAS bf16_t* VS = (LAS bf16_t*)(L + GP_VS); LAS bf16_t* WT = (LAS bf16_t*)(L + GP_WT);
    LAS float* AS = (LAS float*)(L + GP_AS); LAS float* GC = (LAS float*)(L + GP_GC); LAS float* BETA = (LAS float*)(L + GP_BETA); LAS float* EGC = (LAS float*)(L + GP_EGC); LAS float* CW = (LAS float*)(L + GP_CW); LAS float* TS = (LAS float*)(L + GP_TS);
    const int tid = F.tid, lane = F.lane, wave = F.wave;
    const int per = (2048 + F.G - 1) / F.G;
    int hcur = -1;
    for (int ii = 0; ii < per; ++ii) {
        const int item = F.vcu * per + ii; if (item >= 2048) break;
        const int bh = item >> 7, n = item & 127, b = bh >> 2, h = bh & 3;
        const size_t t0 = (size_t)b * SEQ + n * 64;
        if (h != hcur) { hcur = h; for (int i = tid; i < 1536; i += NWAVES * 64) { const int j = i / 384, cc = i % 384; CW[i] = a.gdn_conv[j * 1536 + (cc >> 7) * 512 + h * 128 + (cc & 127)]; } }
        unsigned pf = 0u;
        if (ii + 1 < per && item + 1 < 2048 && tid < 384) {
            const int r = tid / 6, q6 = tid % 6; const int item2 = item + 1, bh2 = item2 >> 7, n2 = item2 & 127;
            pf = *(const unsigned*)(GQKV + ((size_t)(bh2 >> 2) * SEQ + n2 * 64 + r) * 1536 + (q6 >> 1) * 512 + (bh2 & 3) * 128 + (q6 & 1) * 64);
        }
        if (wave == 0) {
            const size_t t = t0 + lane;
            float g = -__expf(a.a_log[h]) * softplusf_(GA[t * 4 + h] + a.dt_bias[h]);
#pragma unroll
            for (int o = 1; o < 64; o <<= 1) { const float up = __shfl_up(g, o); if (lane >= o) g += up; }
            GC[lane] = g; BETA[lane] = sigmoidf_(GB[t * 4 + h]); EGC[lane] = __expf(g);
            if (lane == 63) Gb.CD[item] = __expf(g);
        }
        LDS_BARRIER();
        {
            const int c = tid >> 3, d0 = (tid & 7) * 16;
#pragma unroll
            for (int part = 0; part < 3; ++part) {
                float acc[16];
#pragma unroll
                for (int i = 0; i < 16; ++i) acc[i] = 0.f;
#pragma unroll
                for (int j = 0; j < 4; ++j) {
                    if (n * 64 + c - 3 + j >= 0) {
                        const bf16_t* src = GQKV + (t0 + c - 3 + j) * 1536 + part * 512 + h * 128 + d0;
                        const v4u r0 = *(const v4u*)src, r1 = *(const v4u*)(src + 8);
                        const unsigned rw[8] = {r0.x, r0.y, r0.z, r0.w, r1.x, r1.y, r1.z, r1.w};
                        const LAS float* cw = CW + j * 384 + part * 128 + d0;
#pragma unroll
                        for (int i = 0; i < 8; ++i) { acc[2 * i] += bflo(rw[i]) * cw[2 * i]; acc[2 * i + 1] += bfhi(rw[i]) * cw[2 * i + 1]; }
                    }
                }
                float ss = 0.f;
#pragma unroll
                for (int i = 0; i < 16; ++i) { acc[i] = acc[i] / (1.f + __expf(-acc[i])); ss += acc[i] * acc[i]; }
                if (part < 2) { ss += __shfl_xor(ss, 1); ss += __shfl_xor(ss, 2); ss += __shfl_xor(ss, 4); const float inv = rsqrtf(ss + EPS);
#pragma unroll
                    for (int i = 0; i < 16; ++i) acc[i] *= inv; }
                LAS bf16_t* dst = (part == 0 ? QS : part == 1 ? KS : VS) + c * GROW + d0;
                v4u w0, w1; w0.x = cvtpk(acc[0], acc[1]); w0.y = cvtpk(acc[2], acc[3]); w0.z = cvtpk(acc[4], acc[5]); w0.w = cvtpk(acc[6], acc[7]);
                w1.x = cvtpk(acc[8], acc[9]); w1.y = cvtpk(acc[10], acc[11]); w1.z = cvtpk(acc[12], acc[13]); w1.w = cvtpk(acc[14], acc[15]);
                *(LAS v4u*)dst = w0; *(LAS v4u*)(dst + 8) = w1;
            }
        }
        LDS_BARRIER();
        {
            const int fr = lane & 15, g = lane >> 4;
            for (int task = wave; task < 26; task += NWAVES) {
                const bool isKK = task < 10; int ct, mt;
                if (isKK) { ct = task >= 6 ? 3 : task >= 3 ? 2 : task >= 1 ? 1 : 0; mt = task - ct * (ct + 1) / 2; } else { ct = (task - 10) >> 2; mt = (task - 10) & 3; }
                f32x4_t acc = {0.f, 0.f, 0.f, 0.f};
                if (mt <= ct) {
                    const LAS bf16_t* Ap = KS + (mt * 16 + fr) * GROW + 8 * g; const LAS bf16_t* Bp = (isKK ? KS : QS) + (ct * 16 + fr) * GROW + 8 * g;
#pragma unroll
                    for (int ks = 0; ks < 4; ++ks) acc = __builtin_amdgcn_mfma_f32_16x16x32_bf16(*(const LAS bf16x8_t*)(Ap + 32 * ks), *(const LAS bf16x8_t*)(Bp + 32 * ks), acc, 0, 0, 0);
                }
                const int c = ct * 16 + fr, m0 = mt * 16 + 4 * g; const float gcc = GC[c];
                float v[4];
#pragma unroll
                for (int r = 0; r < 4; ++r) { const int m = m0 + r; const float dec = __expf(fminf(gcc - GC[m], 0.f)); v[r] = acc[r] * dec; }
                if (isKK) { const float bc = BETA[c];
                    f32x4_t o;
#pragma unroll
                    for (int r = 0; r < 4; ++r) o[r] = (c > m0 + r) ? v[r] * bc : 0.f;
                    *(LAS f32x4_t*)(AS + c * 68 + m0) = o;
                } else {
#pragma unroll
                    for (int r = 0; r < 4; ++r) v[r] = (c >= m0 + r) ? v[r] * 0.08838834764831845f : 0.f;
                    v2u w; w.x = cvtpk(v[0], v[1]); w.y = cvtpk(v[2], v[3]);
                    *(v2u*)(Gb.QK + (size_t)item * 4096 + (ct * 2 + (mt >> 1)) * 512 + lane * 8 + (mt & 1) * 4) = w;
                }
            }
        }
        LDS_BARRIER();
        if (wave == 0) {
            const int q4 = lane >> 4, c = lane & 15; const LAS float* Ab = AS + (16 * q4) * 68 + 16 * q4;
            float t[16];
#pragma unroll
            for (int r = 0; r < 16; ++r) { float s = (r == c) ? 1.f : 0.f;
#pragma unroll
                for (int j4 = 0; j4 < (r + 3) / 4; ++j4) { const f32x4_t av = *(const LAS f32x4_t*)(Ab + r * 68 + 4 * j4);
#pragma unroll
                    for (int i = 0; i < 4; ++i) if (4 * j4 + i < r) s -= av[i] * t[4 * j4 + i]; }
                t[r] = s; TS[(q4 * 16 + r) * 20 + c] = (r == c) ? 0.f : s; }
        }
        LDS_BARRIER();
        {
            const int fr = lane & 15, g = lane >> 4;
#pragma unroll
            for (int cc = 0; cc < 2; ++cc) {
                const int ct2 = wave * 2 + cc; const bool isW = ct2 >= 8; const int col = (ct2 & 7) * 16 + fr;
                const LAS bf16_t* src = (isW ? KS : VS) + col;
                unsigned xb[4][2];
#pragma unroll
                for (int i = 0; i < 4; ++i) {
                    f32x4_t y;
#pragma unroll
                    for (int r = 0; r < 4; ++r) { const int row = 16 * i + 4 * g + r; float v = bf2f(src[row * GROW]) * BETA[row]; if (isW) v *= EGC[row]; y[r] = v; }
#pragma unroll
                    for (int j = 0; j < i; j += 2) {
                        const LAS float* ap = AS + (16 * i + fr) * 68 + 16 * j + 4 * g;
                        const f32x4_t a0 = *(const LAS f32x4_t*)ap; f32x4_t a1 = {0.f, 0.f, 0.f, 0.f}; if (j + 1 < i) a1 = *(const LAS f32x4_t*)(ap + 16);
                        const bf16x8_t af = __builtin_bit_cast(bf16x8_t, (v4u){cvtpk(-a0[0], -a0[1]), cvtpk(-a0[2], -a0[3]), cvtpk(-a1[0], -a1[1]), cvtpk(-a1[2], -a1[3])});
                        const bf16x8_t bfr = __builtin_bit_cast(bf16x8_t, (v4u){xb[j][0], xb[j][1], (j + 1 < i) ? xb[j + 1][0] : 0u, (j + 1 < i) ? xb[j + 1][1] : 0u});
                        y = __builtin_amdgcn_mfma_f32_16x16x32_bf16(af, bfr, y, 0, 0, 0);
                    }
                    const f32x4_t tv = *(const LAS f32x4_t*)(TS + (i * 16 + fr) * 20 + 4 * g);
                    const bf16x8_t tf = __builtin_bit_cast(bf16x8_t, (v4u){cvtpk(tv[0], tv[1]), cvtpk(tv[2], tv[3]), 0u, 0u});
                    const bf16x8_t yf = __builtin_bit_cast(bf16x8_t, (v4u){cvtpk(y[0], y[1]), cvtpk(y[2], y[3]), 0u, 0u});
                    const f32x4_t x = __builtin_amdgcn_mfma_f32_16x16x32_bf16(tf, yf, y, 0, 0, 0);
                    xb[i][0] = cvtpk(x[0], x[1]); xb[i][1] = cvtpk(x[2], x[3]);
                    if (!isW) { *(v2u*)(Gb.UT + (size_t)item * 8192 + col * 64 + 16 * i + 4 * g) = (v2u){xb[i][0], xb[i][1]}; }
                    else {
#pragma unroll
                        for (int r = 0; r < 4; ++r) WT[(16 * i + 4 * g + r) * GROW + col] = f2bf(-x[r]); }
                }
            }
        }
        {
            const float glast = GC[63];
#pragma unroll
            for (int i = 0; i < 4; ++i) { const int p = tid + 512 * i, c = p >> 5, d0 = (p & 31) * 4; const v2u r = *(const LAS v2u*)(QS + c * GROW + d0); const float sc = EGC[c] * 0.08838834764831845f;
                v2u w; w.x = cvtpk(bflo(r.x) * sc, bfhi(r.x) * sc); w.y = cvtpk(bflo(r.y) * sc, bfhi(r.y) * sc);
                *(v2u*)(Gb.QD + (size_t)item * 8192 + frag_off(c, d0, 4)) = w; }
#pragma unroll
            for (int i = 0; i < 4; ++i) { const int p = tid + 512 * i, d = p >> 4, c0 = (p & 15) * 4; float v[4];
#pragma unroll
                for (int r = 0; r < 4; ++r) v[r] = bf2f(KS[(c0 + r) * GROW + d]) * __expf(glast - GC[c0 + r]);
                v2u w; w.x = cvtpk(v[0], v[1]); w.y = cvtpk(v[2], v[3]);
                *(v2u*)(Gb.KDT + (size_t)item * 8192 + frag_off(d, c0, 2)) = w; }
        }
        LDS_BARRIER();
#pragma unroll
        for (int i = 0; i < 4; ++i) { const int p = tid + 512 * i, c = p >> 5, d0 = (p & 31) * 4; const v2u r = *(const LAS v2u*)(WT + c * GROW + d0);
            *(v2u*)(Gb.NW + (size_t)item * 8192 + frag_off(c, d0, 4)) = r; }
        asm volatile("" :: "v"(pf));
        LDS_BARRIER();
    }
}

__device__ __forceinline__ void gdn_scan_unit(Frame& F, int s, const GdnBufs& Gb) {
    const int bh = s >> 2, half = s & 3, h = bh & 3, b = bh >> 2;
    const int tid = F.tid, lane = F.lane, wave = F.wave, fr = lane & 15, g = lane >> 4;
    LAS unsigned char* L = F.lds;
    const size_t tb = (size_t)b * SEQ;
    const int item0 = bh * 128;
    const int lt = tid - 256;
#define GDN_SRC(it, i) ((i) < 4 ? (const v4u*)(Gb.NW + (size_t)(it) * 8192) + lt + 256 * (i) : (i) < 8 ? (const v4u*)(Gb.QD + (size_t)(it) * 8192) + lt + 256 * ((i) - 4) : \
                        (i) < 12 ? (const v4u*)(Gb.KDT + (size_t)(it) * 8192) + lt + 256 * ((i) - 8) : (i) < 14 ? (const v4u*)(Gb.QK + (size_t)(it) * 4096) + lt + 256 * ((i) - 12) : \
                        (const v4u*)(Gb.UT + (size_t)(it) * 8192 + half * 2048) + lt + 256 * ((i) - 14))
#define GDN_LOADR(R, it) do { _Pragma("unroll") for (int i_ = 0; i_ < 15; ++i_) R[i_] = *GDN_SRC(it, i_); } while (0)
#define GDN_STORER(R, bufp) do { _Pragma("unroll") for (int i_ = 0; i_ < 15; ++i_) *(LAS v4u*)((bufp) + (i_ * 256 + lt) * 16) = R[i_]; } while (0)
    LAS float* CDL = (LAS float*)(L + 131072 + 1024);
    LAS bf16_t* OTB = (LAS bf16_t*)(L + 131072 + 2048);
#define GDN_OSTORE(step) do { if (wave < 6 && (step) < 128) { const LAS bf16_t* ot_ = OTB + ((wave - 4) * 2 + ((step) & 1)) * 1024; \
        const v4u o0_ = *(const LAS v4u*)(ot_ + lane * 16), o1_ = *(const LAS v4u*)(ot_ + lane * 16 + 8); \
        bf16_t* dst_ = Gb.ORAW + (tb + (size_t)(step) * 64 + lane) * 512 + h * 128 + half * 32 + (wave - 4) * 16; *(v4u*)dst_ = o0_; *(v4u*)(dst_ + 8) = o1_; } } while (0)
    if (wave >= 4) {
        if (wave == 4) { CDL[lane] = Gb.CD[item0 + lane]; CDL[64 + lane] = Gb.CD[item0 + 64 + lane]; }
        v4u r0[15], r1[15], r2[15];
        GDN_LOADR(r0, item0); GDN_LOADR(r1, item0 + 1); GDN_LOADR(r2, item0 + 2);
        GDN_STORER(r0, L);
        LDS_BARRIER();
#define GDN_CL(k) (item0 + ((k) < 127 ? (k) : 127))
        for (int n = 0; n < 129; n += 3) {
            GDN_LOADR(r0, GDN_CL(n + 3)); GDN_STORER(r1, L + ((n + 1) & 1) * 65536); LDS_BARRIER(); GDN_OSTORE(n);
            GDN_LOADR(r1, GDN_CL(n + 4)); GDN_STORER(r2, L + ((n + 2) & 1) * 65536); LDS_BARRIER(); GDN_OSTORE(n + 1);
            GDN_LOADR(r2, GDN_CL(n + 5)); GDN_STORER(r0, L + ((n + 3) & 1) * 65536); LDS_BARRIER(); GDN_OSTORE(n + 2);
        }
#undef GDN_CL
    } else if (wave >= 2) {
        for (int n = 0; n < 130; ++n) LDS_BARRIER();
    } else {
        LDS_BARRIER();
        f32x4_t S[8];
#pragma unroll
        for (int i = 0; i < 8; ++i) S[i] = (f32x4_t){0.f, 0.f, 0.f, 0.f};
        for (int n = 0; n < 128; ++n) {
            LAS unsigned char* B = L + (n & 1) * 65536;
            const float cd = CDL[n];
            bf16x8_t sb[4];
#pragma unroll
            for (int ks = 0; ks < 4; ++ks) sb[ks] = __builtin_bit_cast(bf16x8_t, (v4u){cvtpk(S[2 * ks][0], S[2 * ks][1]), cvtpk(S[2 * ks][2], S[2 * ks][3]), cvtpk(S[2 * ks + 1][0], S[2 * ks + 1][1]), cvtpk(S[2 * ks + 1][2], S[2 * ks + 1][3])});
#define GDN_SB() __builtin_amdgcn_sched_barrier(0)
            const LAS unsigned char* Bl = B + lane * 16;
            v2u u8[4]; bf16x8_t fa[16], fb[16];
#pragma unroll
            for (int rt = 0; rt < 4; ++rt) u8[rt] = *(const LAS v2u*)(B + 57344 + ((wave * 16 + fr) * 64 + 16 * rt + 4 * g) * 2);
#pragma unroll
            for (int i = 0; i < 16; ++i) fa[i] = *(const LAS bf16x8_t*)(Bl + ((i & 3) * 4 + (i >> 2)) * 1024);
            GDN_SB();
#pragma unroll
            for (int i = 0; i < 16; ++i) fb[i] = *(const LAS bf16x8_t*)(Bl + 16384 + ((i & 3) * 4 + (i >> 2)) * 1024);
            GDN_SB();
            f32x4_t va[4], oa[4];
#pragma unroll
            for (int rt = 0; rt < 4; ++rt) { va[rt] = (f32x4_t){bflo(u8[rt].x), bfhi(u8[rt].x), bflo(u8[rt].y), bfhi(u8[rt].y)}; oa[rt] = (f32x4_t){0.f, 0.f, 0.f, 0.f}; }
#pragma unroll
            for (int i = 0; i < 16; ++i) va[i & 3] = __builtin_amdgcn_mfma_f32_16x16x32_bf16(fa[i], sb[i >> 2], va[i & 3], 0, 0, 0);
            GDN_SB();
#pragma unroll
            for (int i = 0; i < 8; ++i) fa[i] = *(const LAS bf16x8_t*)(Bl + 49152 + ((i & 3) * 2 + (i >> 2)) * 1024);
#pragma unroll
            for (int i = 0; i < 8; ++i) fa[8 + i] = *(const LAS bf16x8_t*)(Bl + 32768 + ((i & 3) * 2 + (i >> 2)) * 1024);
            GDN_SB();
#pragma unroll
            for (int i = 0; i < 16; ++i) oa[i & 3] = __builtin_amdgcn_mfma_f32_16x16x32_bf16(fb[i], sb[i >> 2], oa[i & 3], 0, 0, 0);
            bf16x8_t vb[2];
#pragma unroll
            for (int k2 = 0; k2 < 2; ++k2) vb[k2] = __builtin_bit_cast(bf16x8_t, (v4u){cvtpk(va[2 * k2][0], va[2 * k2][1]), cvtpk(va[2 * k2][2], va[2 * k2][3]), cvtpk(va[2 * k2 + 1][0], va[2 * k2 + 1][1]), cvtpk(va[2 * k2 + 1][2], va[2 * k2 + 1][3])});
#pragma unroll
            for (int dt = 0; dt < 8; ++dt) S[dt] = S[dt] * cd;
            GDN_SB();
#pragma unroll
            for (int i = 0; i < 8; ++i) fb[i] = *(const LAS bf16x8_t*)(Bl + 32768 + 8192 + ((i & 3) * 2 + (i >> 2)) * 1024);
            GDN_SB();
#pragma unroll
            for (int i = 0; i < 8; ++i) oa[i & 3] = __builtin_amdgcn_mfma_f32_16x16x32_bf16(fa[i], vb[i >> 2], oa[i & 3], 0, 0, 0);
#pragma unroll
            for (int i = 0; i < 8; ++i) S[i & 3] = __builtin_amdgcn_mfma_f32_16x16x32_bf16(fa[8 + i], vb[i >> 2], S[i & 3], 0, 0, 0);
            GDN_SB();
#pragma unroll
            for (int i = 0; i < 8; ++i) S[4 + (i & 3)] = __builtin_amdgcn_mfma_f32_16x16x32_bf16(fb[i], vb[i >> 2], S[4 + (i & 3)], 0, 0, 0);
            GDN_SB();
#undef GDN_SB
            { LAS bf16_t* OT = OTB + (wave * 2 + (n & 1)) * 1024;
#pragma unroll
              for (int rt = 0; rt < 4; ++rt)
#pragma unroll
                for (int r = 0; r < 4; ++r) OT[(16 * rt + 4 * g + r) * 16 + fr] = f2bf(oa[rt][r]); }
            LDS_BARRIER();
        }
        LDS_BARRIER();
    }
#undef GDN_SRC
#undef GDN_LOADR
#undef GDN_OSTORE
#undef GDN_STORER
}

__device__ __forceinline__ void gdn_finish_phase(Frame& F, const Args& a, const GdnBufs& Gb, const bf16_t* GZ, bf16_t* OG) {
    const int gt = F.vcu * NWAVES * 64 + F.tid, ngt = F.G * NWAVES * 64;
    for (int p = gt; p < T * 64; p += ngt) {
        const size_t t = (size_t)(p >> 6); const int col = (p & 63) * 8, e0 = col & 127;
        const v4u o = *(const v4u*)(Gb.ORAW + t * 512 + col), z = *(const v4u*)(GZ + t * 512 + col);
        const unsigned ow[4] = {o.x, o.y, o.z, o.w}, zw[4] = {z.x, z.y, z.z, z.w};
        float ss = 0.f;
#pragma unroll
        for (int i = 0; i < 4; ++i) { const float a0 = bflo(ow[i]), a1 = bfhi(ow[i]); ss += a0 * a0 + a1 * a1; }
        ss += __shfl_xor(ss, 1); ss += __shfl_xor(ss, 2); ss += __shfl_xor(ss, 4); ss += __shfl_xor(ss, 8);
        const float rinv = rsqrtf(ss * (1.f / 128.f) + EPS);
        const f32x4_t g0 = *(const f32x4_t*)(a.gdn_norm_g + e0), g1 = *(const f32x4_t*)(a.gdn_norm_g + e0 + 4);
        const float gg[8] = {g0[0], g0[1], g0[2], g0[3], g1[0], g1[1], g1[2], g1[3]};
        unsigned r[4];
#pragma unroll
        for (int i = 0; i < 4; ++i) { const float z0 = bflo(zw[i]), z1 = bfhi(zw[i]);
            r[i] = cvtpk(bflo(ow[i]) * rinv * gg[2 * i] * (z0 / (1.f + __expf(-z0))), bfhi(ow[i]) * rinv * gg[2 * i + 1] * (z1 / (1.f + __expf(-z1)))); }
        *(v4u*)(OG + t * 512 + col) = (v4u){r[0], r[1], r[2], r[3]};
    }
}
typedef float f32x2_t __attribute__((ext_vector_type(2)));
__device__ __forceinline__ float gelu_erf(float v) { return 0.5f * v * (1.f + erff(v * 0.70710678118654752f)); }
constexpr int PEER_CH = 16;
constexpr int CW_PEERU = 8192, CW_PEERV = 8192 + 1024;

#define PEER_SHUF(EN, R0, R1) do { _Pragma("unroll") for (int i = 0; i < 16; ++i) EN[i] = __shfl(i < 8 ? (R0) : (R1), 8 * (i & 7) + g); } while (0)
template <int CTRL> __device__ __forceinline__ int dpp_i(int v) { return __builtin_amdgcn_update_dpp(0, v, CTRL, 0xf, 0xf, false); }
template <int CTRL> __device__ __forceinline__ float dpp_f(float v) { return __builtin_bit_cast(float, __builtin_amdgcn_update_dpp(0, __builtin_bit_cast(int, v), CTRL, 0xf, 0xf, false)); }
constexpr int DPP_X1 = 0xB1, DPP_X2 = 0x4E, DPP_HM = 0x141;
#define PEER_U_COMPUTE(W, TOK, XR0, XR1, RS) do { const size_t t_ = (TOK); \
        const unsigned xw[8] = {XR0.x, XR0.y, XR0.z, XR0.w, XR1.x, XR1.y, XR1.z, XR1.w}; float xf[16]; \
        _Pragma("unroll") for (int q = 0; q < 8; ++q) { xf[2 * q] = bflo(xw[q]); xf[2 * q + 1] = bfhi(xw[q]); } \
        float am = 0.f; \
        _Pragma("unroll") for (int q = 0; q < 16; q += 2) am = fmaxf(am, fmaxf(fabsf(xf[q]), fabsf(xf[q + 1]))); \
        am = fmaxf(am, dpp_f<DPP_X1>(am)); am = fmaxf(am, dpp_f<DPP_X2>(am)); am = fmaxf(am, dpp_f<DPP_HM>(am)); \
        const float sx = am > 0.f ? 127.f * __builtin_amdgcn_rcpf(am) : 0.f, mo = am * (1.f / 127.f) * (RS); \
        int xq[4]; \
        _Pragma("unroll") for (int d = 0; d < 4; ++d) { \
            const unsigned b0 = __builtin_bit_cast(unsigned, fmaf(xf[4 * d], sx, 12582912.f)), b1 = __builtin_bit_cast(unsigned, fmaf(xf[4 * d + 1], sx, 12582912.f)); \
            const unsigned b2 = __builtin_bit_cast(unsigned, fmaf(xf[4 * d + 2], sx, 12582912.f)), b3 = __builtin_bit_cast(unsigned, fmaf(xf[4 * d + 3], sx, 12582912.f)); \
            xq[d] = (int)(__builtin_amdgcn_perm(b1, b0, 0x0c0c0400u) | __builtin_amdgcn_perm(b3, b2, 0x04000c0cu)); } \
        int p[16]; \
        _Pragma("unroll") for (int i = 0; i < 16; ++i) { int acc = __builtin_amdgcn_sdot4((int)W[i].x, xq[0], 0, false); acc = __builtin_amdgcn_sdot4((int)W[i].y, xq[1], acc, false); \
            acc = __builtin_amdgcn_sdot4((int)W[i].z, xq[2], acc, false); p[i] = __builtin_amdgcn_sdot4((int)W[i].w, xq[3], acc, false); } \
        _Pragma("unroll") for (int i = 0; i < 8; ++i) { const int lo = p[i], hi = p[i + 8]; p[i] = (up4 ? hi : lo) + dpp_i<DPP_HM>(up4 ? lo : hi); } \
        _Pragma("unroll") for (int i = 0; i < 4; ++i) { const int lo = p[i], hi = p[i + 4]; p[i] = (up2 ? hi : lo) + dpp_i<DPP_X2>(up2 ? lo : hi); } \
        _Pragma("unroll") for (int i = 0; i < 2; ++i) { const int lo = p[i], hi = p[i + 2]; p[i] = (up1 ? hi : lo) + dpp_i<DPP_X1>(up1 ? lo : hi); } \
        bf16_t* dst = PART + ((size_t)x * T + t_) * 128 + 16 * j + g; dst[0] = f2bf((float)p[0] * mo); dst[8] = f2bf((float)p[1] * mo); } while (0)
#define PEER_GATHER(W, EN, BASE) do { _Pragma("unroll") for (int i = 0; i < 16; ++i) W[i] = *(const v4u*)((BASE) + (unsigned)((unsigned)EN[i] * 128u + lo16)); } while (0)
__device__ __forceinline__ void peer_u_phase(Frame& F, const Args& a, gu32* ctl, const bf16_t* X2B, const float* rstd2, const int* EIDX, const unsigned char* U8, bf16_t* PART) {
    const int lane = F.lane, g = lane >> 3, j = lane & 7; const unsigned lo16 = 16u * (unsigned)j;
    const bool up4 = (j & 4) != 0, up2 = (j & 2) != 0, up1 = (j & 1) != 0;
    const int x0 = (int)(xb_xcc_id() & 7u);
    for (int s = 0; s < 8; ++s) {
        const int x = (x0 + s) & 7;
        const unsigned char* Ux = U8 + (size_t)x * 16384 * 128;
        const bf16_t* Xx = X2B + 128 * x + 16 * j;
        for (;;) {
            int c = 0; if (lane == 0) c = (int)__hip_atomic_fetch_add(ctl + CW_PEERU + 64 * x, 1u, __ATOMIC_RELAXED, __HIP_MEMORY_SCOPE_AGENT);
            c = __builtin_amdgcn_readfirstlane(c);
            if (c >= T / PEER_CH) break;
            const size_t tc = (size_t)c * PEER_CH, tl = tc + PEER_CH - 1;
            int en[16]; v4u wa[16], wb[16];
            int er0 = EIDX[tc * 128 + lane], er1 = EIDX[tc * 128 + 64 + lane];
            v4u xa0 = *(const v4u*)(Xx + tc * 1024), xa1 = *(const v4u*)(Xx + tc * 1024 + 8), xb0, xb1; float rsa = rstd2[tc], rsb;
            PEER_SHUF(en, er0, er1);
            PEER_GATHER(wa, en, Ux);
            er0 = EIDX[(tc + 1) * 128 + lane]; er1 = EIDX[(tc + 1) * 128 + 64 + lane];
            for (int tt = 0; tt < PEER_CH; tt += 2) {
                const size_t t = tc + tt, t2 = (t + 2 < tl) ? t + 2 : tl, t3 = (t + 3 < tl) ? t + 3 : tl;
                PEER_SHUF(en, er0, er1);
                PEER_GATHER(wb, en, Ux);
                er0 = EIDX[t2 * 128 + lane]; er1 = EIDX[t2 * 128 + 64 + lane];
                xb0 = *(const v4u*)(Xx + (t + 1) * 1024); xb1 = *(const v4u*)(Xx + (t + 1) * 1024 + 8); rsb = rstd2[t + 1];
                PEER_U_COMPUTE(wa, t, xa0, xa1, rsa);
                PEER_SHUF(en, er0, er1);
                PEER_GATHER(wa, en, Ux);
                er0 = EIDX[t3 * 128 + lane]; er1 = EIDX[t3 * 128 + 64 + lane];
                xa0 = *(const v4u*)(Xx + t2 * 1024); xa1 = *(const v4u*)(Xx + t2 * 1024 + 8); rsa = rstd2[t2];
                PEER_U_COMPUTE(wb, t + 1, xb0, xb1, rsb);
            }
        }
    }
}
__device__ __forceinline__ void peer_combine_phase(Frame& F, const bf16_t* PART, const int* EIDX, const float* EGATE, const float* SU, const float* SV, float* ACTS) {
    const int gt = F.vcu * NWAVES * 64 + F.tid, ngt = F.G * NWAVES * 64;
    for (int p = gt; p < T * 32; p += ngt) {
        f32x4_t s = {0.f, 0.f, 0.f, 0.f};
#pragma unroll
        for (int x = 0; x < 8; ++x) { const v2u w = *(const v2u*)(PART + (size_t)x * T * 128 + (size_t)p * 4); s += (f32x4_t){bflo(w.x), bfhi(w.x), bflo(w.y), bfhi(w.y)}; }
        const int4 e = *(const int4*)(EIDX + (size_t)p * 4); const f32x4_t gt4 = *(const f32x4_t*)(EGATE + (size_t)p * 4);
        *(f32x4_t*)(ACTS + (size_t)p * 4) = (f32x4_t){gelu_erf(s[0] * SU[e.x]) * gt4[0] * SV[e.x], gelu_erf(s[1] * SU[e.y]) * gt4[1] * SV[e.y], gelu_erf(s[2] * SU[e.z]) * gt4[2] * SV[e.z], gelu_erf(s[3] * SU[e.w]) * gt4[3] * SV[e.w]};
    }
}
#define PEER_V_COMPUTE(W, TOK, A0R, A1R, XWR) do { const size_t t_ = (TOK); float av[16]; \
        _Pragma("unroll") for (int i = 0; i < 16; ++i) av[i] = __shfl(i < 8 ? (A0R) : (A1R), 8 * (i & 7) + g); \
        const size_t oo_ = t_ * 1024 + 128 * x + 16 * j + 2 * g; const unsigned xw_ = (XWR); const f32x2_t xv = {bflo(xw_), bfhi(xw_)}; \
        f32x2_t o2[8]; _Pragma("unroll") for (int q = 0; q < 8; ++q) o2[q] = (f32x2_t){0.f, 0.f}; \
        _Pragma("unroll") for (int i = 0; i < 16; ++i) { const unsigned ww[4] = {W[i].x, W[i].y, W[i].z, W[i].w}; const f32x2_t a2 = {av[i], av[i]}; \
            _Pragma("unroll") for (int q = 0; q < 4; ++q) { o2[2 * q] = __builtin_elementwise_fma(__builtin_amdgcn_cvt_pk_f32_fp8(ww[q], false), a2, o2[2 * q]); o2[2 * q + 1] = __builtin_elementwise_fma(__builtin_amdgcn_cvt_pk_f32_fp8(ww[q], true), a2, o2[2 * q + 1]); } } \
        float o[16]; _Pragma("unroll") for (int q = 0; q < 8; ++q) { o[2 * q] = o2[q].x; o[2 * q + 1] = o2[q].y; } \
        _Pragma("unroll") for (int off = 4; off >= 1; off >>= 1) { const bool up = (g & off) != 0; \
            _Pragma("unroll") for (int i = 0; i < 2 * off; ++i) { const float lo = o[i], hi = o[i + 2 * off]; const float send = up ? lo : hi, keep = up ? hi : lo; o[i] = keep + __shfl_xor(send, 8 * off); } } \
        const unsigned rw_ = cvtpk(xv.x + o[0], xv.y + o[1]); *(unsigned*)(X3B + oo_) = rw_; const float r0 = bflo(rw_), r1 = bfhi(rw_); \
        const float ss = wave_sum(r0 * r0 + r1 * r1); if (lane == 0) SS3[t_ * 8 + x] = ss; } while (0)
__device__ __forceinline__ void peer_v_phase(Frame& F, gu32* ctl, const int* EIDX, const float* ACTS, const unsigned char* V8, const bf16_t* X2B, bf16_t* X3B, float* SS3) {
    const int lane = F.lane, g = lane >> 3, j = lane & 7;
    const int x0 = (int)(xb_xcc_id() & 7u);
    for (int s = 0; s < 8; ++s) {
        const int x = (x0 + s) & 7;
        const unsigned char* Vx = V8 + (size_t)x * 16384 * 128 + 16 * j;
        const bf16_t* Xx = X2B + 128 * x + 16 * j + 2 * g;
        for (;;) {
            int c = 0; if (lane == 0) c = (int)__hip_atomic_fetch_add(ctl + CW_PEERV + 64 * x, 1u, __ATOMIC_RELAXED, __HIP_MEMORY_SCOPE_AGENT);
            c = __builtin_amdgcn_readfirstlane(c);
            if (c >= T / PEER_CH) break;
            const size_t tc = (size_t)c * PEER_CH, tl = tc + PEER_CH - 1;
            int en[16]; v4u wa[16], wb[16];
            int er0 = EIDX[tc * 128 + lane], er1 = EIDX[tc * 128 + 64 + lane];
            float aa0 = ACTS[tc * 128 + lane], aa1 = ACTS[tc * 128 + 64 + lane], ab0, ab1; unsigned xwa = *(const unsigned*)(Xx + tc * 1024), xwb;
            PEER_SHUF(en, er0, er1);
#pragma unroll
            for (int i = 0; i < 16; ++i) wa[i] = *(const v4u*)(Vx + (size_t)en[i] * 128);
            er0 = EIDX[(tc + 1) * 128 + lane]; er1 = EIDX[(tc + 1) * 128 + 64 + lane];
            for (int tt = 0; tt < PEER_CH; tt += 2) {
                const size_t t = tc + tt, t2 = (t + 2 < tl) ? t + 2 : tl, t3 = (t + 3 < tl) ? t + 3 : tl;
                PEER_SHUF(en, er0, er1);
#pragma unroll
                for (int i = 0; i < 16; ++i) wb[i] = *(const v4u*)(Vx + (size_t)en[i] * 128);
                er0 = EIDX[t2 * 128 + lane]; er1 = EIDX[t2 * 128 + 64 + lane];
                ab0 = ACTS[(t + 1) * 128 + lane]; ab1 = ACTS[(t + 1) * 128 + 64 + lane]; xwb = *(const unsigned*)(Xx + (t + 1) * 1024);
                PEER_V_COMPUTE(wa, t, aa0, aa1, xwa);
                PEER_SHUF(en, er0, er1);
#pragma unroll
                for (int i = 0; i < 16; ++i) wa[i] = *(const v4u*)(Vx + (size_t)en[i] * 128);
                er0 = EIDX[t3 * 128 + lane]; er1 = EIDX[t3 * 128 + 64 + lane];
                aa0 = ACTS[t2 * 128 + lane]; aa1 = ACTS[t2 * 128 + 64 + lane]; xwa = *(const unsigned*)(Xx + t2 * 1024);
                PEER_V_COMPUTE(wb, t + 1, ab0, ab1, xwb);
            }
        }
    }
}
__device__ __forceinline__ void peer_norm_phase(Frame& F, const Args& a, const float* SS3, const bf16_t* X3B, float* out) {
    const int gt = F.vcu * NWAVES * 64 + F.tid, ngt = F.G * NWAVES * 64;
    for (int p = gt; p < T * 128; p += ngt) {
        const size_t t = (size_t)(p >> 7); const int c = (p & 127) * 8;
        const f32x4_t s0 = *(const f32x4_t*)(SS3 + t * 8), s1 = *(const f32x4_t*)(SS3 + t * 8 + 4);
        const float r3 = rsqrtf(((s0[0] + s0[1]) + (s0[2] + s0[3]) + (s1[0] + s1[1]) + (s1[2] + s1[3])) * (1.f / D) + EPS);
        const v4u w = *(const v4u*)(X3B + t * 1024 + c);
        const f32x4_t g0 = *(const f32x4_t*)(a.g_final + c), g1 = *(const f32x4_t*)(a.g_final + c + 4);
        *(f32x4_t*)(out + t * 1024 + c) = (f32x4_t){bflo(w.x), bfhi(w.x), bflo(w.y), bfhi(w.y)} * g0 * r3;
        *(f32x4_t*)(out + t * 1024 + c + 4) = (f32x4_t){bflo(w.z), bfhi(w.z), bflo(w.w), bfhi(w.w)} * g1 * r3;
    }
}
#ifndef TOPK_HD
#define TOPK_HD __device__ __forceinline__
#endif
TOPK_HD void ce_desc(unsigned& a, unsigned& b) { const unsigned hi = a > b ? a : b, lo = a > b ? b : a; a = hi; b = lo; }
TOPK_HD void sort16_desc(unsigned (&v)[16]) {
#pragma unroll
    for (int k = 2; k <= 16; k <<= 1)
#pragma unroll
        for (int j = k >> 1; j >= 1; j >>= 1)
#pragma unroll
            for (int i = 0; i < 16; ++i) { const int l = i ^ j; if (l > i) { if ((i & k) == 0) ce_desc(v[i], v[l]); else ce_desc(v[l], v[i]); } }
}
TOPK_HD void bitonic_merge16_desc(unsigned (&v)[16]) {
#pragma unroll
    for (int j = 8; j >= 1; j >>= 1)
#pragma unroll
        for (int i = 0; i < 16; ++i) { const int l = i ^ j; if (l > i) ce_desc(v[i], v[l]); }
}
TOPK_HD void top16_merge(unsigned (&a)[16], const unsigned (&b)[16]) {
#pragma unroll
    for (int i = 0; i < 16; ++i) a[i] = a[i] > b[15 - i] ? a[i] : b[15 - i];
    bitonic_merge16_desc(a);
}
TOPK_HD unsigned f2ord(float f) { const unsigned u = __builtin_bit_cast(unsigned, f); return (u & 0x80000000u) ? ~u : (u | 0x80000000u); }
TOPK_HD float ord2f(unsigned o) { const unsigned u = (o & 0x80000000u) ? (o & 0x7fffffffu) : ~o; return __builtin_bit_cast(float, u); }

__device__ __forceinline__ void peer_route_task(Frame& F, const bf16_t* PQ, const bf16_t* SK16, int* EIDX, float* EGATE, int tt, int h) {
    constexpr int CI[50] = {0,0,0,0,0,0,0,0,0,0,0,0,0,0,0,0,1,1,1,1,1,1,1,1,2,2,2,2,2,3,3,3,3,4,4,4,5,5,6,6,7,7,8,9,10,11,12,13,14,15};
    constexpr int CJ[50] = {0,1,2,3,4,5,6,7,8,9,10,11,12,13,14,15,0,1,2,3,4,5,6,7,0,1,2,3,4,0,1,2,3,0,1,2,0,1,0,1,0,1,0,0,0,0,0,0,0,0};
    int lane = F.lane; asm volatile("" : "+v"(lane));
    const int t = lane & 31, hi = lane >> 5;
    LAS unsigned* wl = (LAS unsigned*)(F.lds + 65536 + F.wave * 8192) + lane;
    {
        const size_t row = (size_t)tt * 32 + t;
        unsigned L[2][16];
#pragma unroll
        for (int p = 0; p < 2; ++p) {
            const int hp = h * 2 + p;
            bf16x8_t Bf[8];
#pragma unroll
            for (int ks = 0; ks < 8; ++ks) Bf[ks] = *(const bf16x8_t*)(PQ + row * 2048 + hp * 128 + 16 * ks + 8 * hi);
#pragma unroll
            for (int i = 0; i < 16; ++i) L[p][i] = 0u;
#pragma unroll 1
            for (int nt = 0; nt < 4; ++nt) {
                const int srow = p * 128 + 32 * nt + t;
                bf16x8_t Ac[8];
#pragma unroll
                for (int ks = 0; ks < 8; ++ks) Ac[ks] = *(const LAS bf16x8_t*)(F.lds + srow * 256 + (((2 * ks + hi) ^ (srow & 15)) << 4));
                f32x16_t acc = {};
#pragma unroll
                for (int ks = 0; ks < 8; ++ks) acc = __builtin_amdgcn_mfma_f32_32x32x16_bf16(Ac[ks], Bf[ks], acc, 0, 0, 0);
                unsigned k[16];
#pragma unroll
                for (int r = 0; r < 16; ++r) { const int n = 32 * nt + (r & 3) + 8 * (r >> 2) + 4 * hi; k[r] = (f2ord(acc[r]) & ~127u) | (unsigned)(127 - n); }
                sort16_desc(k);
                top16_merge(L[p], k);
            }
            unsigned pb[16];
#pragma unroll
            for (int i = 0; i < 16; ++i) pb[i] = __shfl_xor(L[p][i], 32);
            top16_merge(L[p], pb);
        }
        float sa[16], sb[16];
#pragma unroll
        for (int i = 0; i < 16; ++i) { sa[i] = ord2f(L[0][i] & ~127u); sb[i] = ord2f(L[1][i] & ~127u); wl[i * 64] = 127u - (L[0][i] & 127u); wl[(16 + i) * 64] = 127u - (L[1][i] & 127u); }
        unsigned c0[16], c1[16];
#pragma unroll
        for (int s = 0; s < 32; ++s) {
            unsigned key = 0u;
            if (s < 25) { const float v = hi ? sa[CI[25 + s]] + sb[CJ[25 + s]] : sa[CI[s]] + sb[CJ[s]]; const int pos = hi ? CI[25 + s] * 16 + CJ[25 + s] : CI[s] * 16 + CJ[s];
                key = (f2ord(v) & ~255u) | (unsigned)(255 - pos); }
            if (s < 16) c0[s] = key; else c1[s - 16] = key;
        }
        sort16_desc(c0); sort16_desc(c1); top16_merge(c0, c1);
        unsigned pb[16];
#pragma unroll
        for (int i = 0; i < 16; ++i) pb[i] = __shfl_xor(c0[i], 32);
        top16_merge(c0, pb);
        float e[16]; const float m = ord2f(c0[0] & ~255u); float l = 0.f;
#pragma unroll
        for (int r = 0; r < 16; ++r) { e[r] = __expf(ord2f(c0[r] & ~255u) - m); l += e[r]; }
        const float il = 1.f / l;
        int ex[8]; float gt[8];
#pragma unroll
        for (int q = 0; q < 8; ++q) { const unsigned kk = hi ? c0[8 + q] : c0[q]; const int pos = 255 - (int)(kk & 255u); ex[q] = (int)(wl[(pos >> 4) * 64] * 128u + wl[(16 + (pos & 15)) * 64]); gt[q] = (hi ? e[8 + q] : e[q]) * il; }
        int* ep = EIDX + row * 128 + h * 16 + hi * 8; float* gp = EGATE + row * 128 + h * 16 + hi * 8;
        *(int4*)ep = make_int4(ex[0], ex[1], ex[2], ex[3]); *(int4*)(ep + 4) = make_int4(ex[4], ex[5], ex[6], ex[7]);
        *(f32x4_t*)gp = (f32x4_t){gt[0], gt[1], gt[2], gt[3]}; *(f32x4_t*)(gp + 4) = (f32x4_t){gt[4], gt[5], gt[6], gt[7]};
    }
}
__device__ __forceinline__ void cross_item(Frame& F, const bf16_t* QC, const bf16_t* KC, const bf16_t* VC, bf16_t* OC, int bh, int qb) {
    int tid = F.tid; asm volatile("" : "+v"(tid));
    const int lane = tid & 63, wave = F.wave, q = lane & 31, hi = lane >> 5;
    LAS unsigned char* L = F.lds;
    const int g4 = lane >> 4, qq = (lane >> 2) & 3, p4 = lane & 3;
    {
        const int b = bh >> 2, h = bh & 3;
#pragma unroll
        for (int i = 0; i < 16; ++i) { const int cid = tid + 512 * i, r = cid >> 5, c = cid & 31;
            *(LAS v4u*)(L + r * 512 + ((c ^ (r & 15)) << 4)) = *(const v4u*)(KC + (size_t)(b * 256 + r) * 1024 + h * 256 + c * 8); }
        const size_t qrow0 = (size_t)b * SEQ + qb * 256 + wave * 32;
        const bf16_t* Qp = QC + (qrow0 + q) * 1024 + h * 256 + 8 * hi;
        __syncthreads();
        f32x16_t st[8];
#pragma unroll
        for (int kt = 0; kt < 8; ++kt) st[kt] = (f32x16_t){};
#pragma unroll 2
        for (int ks = 0; ks < 16; ++ks) { const bf16x8_t qf = *(const bf16x8_t*)(Qp + 16 * ks);
#pragma unroll
            for (int kt = 0; kt < 8; ++kt) { const int row = 32 * kt + q;
                st[kt] = __builtin_amdgcn_mfma_f32_32x32x16_bf16(*(const LAS bf16x8_t*)(L + row * 512 + (((2 * ks + hi) ^ (row & 15)) << 4)), qf, st[kt], 0, 0, 0); } }
        float m = -INFINITY;
#pragma unroll
        for (int kt = 0; kt < 8; ++kt)
#pragma unroll
            for (int r = 0; r < 16; ++r) { st[kt][r] *= 0.0625f; m = fmaxf(m, st[kt][r]); }
        m = fmaxf(m, __shfl_xor(m, 32));
        float l = 0.f;
#pragma unroll
        for (int kt = 0; kt < 8; ++kt)
#pragma unroll
            for (int r = 0; r < 16; ++r) { st[kt][r] = __expf(st[kt][r] - m); l += st[kt][r]; }
        l += __shfl_xor(l, 32);
        const float il = 1.f / l;
        bf16x8_t pa[8][2];
#pragma unroll
        for (int kt = 0; kt < 8; ++kt)
#pragma unroll
            for (int s = 0; s < 2; ++s) pa[kt][s] = __builtin_bit_cast(bf16x8_t, (v4u){cvtpk(st[kt][8 * s] * il, st[kt][8 * s + 1] * il), cvtpk(st[kt][8 * s + 2] * il, st[kt][8 * s + 3] * il),
                                                                                        cvtpk(st[kt][8 * s + 4] * il, st[kt][8 * s + 5] * il), cvtpk(st[kt][8 * s + 6] * il, st[kt][8 * s + 7] * il)});
        __syncthreads();
#pragma unroll
        for (int i = 0; i < 16; ++i) { const int cid = tid + 512 * i, r = cid >> 5, c = cid & 31;
            *(LAS v4u*)(L + r * 512 + ((c ^ (4 * (r & 3))) << 4)) = *(const v4u*)(VC + (size_t)(b * 256 + r) * 1024 + h * 256 + c * 8); }
        __syncthreads();
        bf16_t* Op = OC + qrow0 * 1024 + h * 256 + q;
#pragma unroll 1
        for (int dt = 0; dt < 8; ++dt) {
            f32x16_t o = {};
            LAS unsigned char* vb = L + (4 * (g4 >> 1) + qq) * 512 + (((dt * 64) ^ (qq << 6)) + (g4 & 1) * 32 + p4 * 8);
#pragma unroll
            for (int kt = 0; kt < 8; ++kt)
#pragma unroll
                for (int s = 0; s < 2; ++s) { const v4i16_t a0 = lds_tr16(vb + (32 * kt + 16 * s) * 512), a1 = lds_tr16(vb + (32 * kt + 16 * s + 8) * 512);
                    const bf16x8_t vf = {a0[0], a0[1], a0[2], a0[3], a1[0], a1[1], a1[2], a1[3]};
                    o = __builtin_amdgcn_mfma_f32_32x32x16_bf16(pa[kt][s], vf, o, 0, 0, 0); }
#pragma unroll
            for (int r = 0; r < 16; ++r) { const int row = (r & 3) + 8 * (r >> 2) + 4 * hi; Op[(size_t)row * 1024 + dt * 32] = f2bf(o[r]); }
        }
        __syncthreads();
    }
}
template <bool REMAP>
__device__ __forceinline__ void transpose_tile(const float* W, int K, int N, const float* gain, bf16_t* WT, LAS float* tile, int item, int tid) {
    const int nblk = (N + 255) / 256, kb = item / nblk, nb = item % nblk, k0 = 64 * kb, n0 = 256 * nb;
    const int c4 = (tid & 63) * 4, kr = tid >> 6;
    f32x4 v[8];
#pragma unroll
    for (int i = 0; i < 8; ++i) { const int k = kr + 8 * i; v[i] = (n0 + c4 < N) ? *(const GAS f32x4*)(W + (size_t)(k0 + k) * N + n0 + c4) : (f32x4){0.f, 0.f, 0.f, 0.f}; }
#pragma unroll
    for (int i = 0; i < 8; ++i) { const int k = kr + 8 * i; LAS float* d = tile + k * 257 + c4; d[0] = v[i].x; d[1] = v[i].y; d[2] = v[i].z; d[3] = v[i].w; }
    __syncthreads();
#pragma unroll
    for (int i = 0; i < 4; ++i) { const int p = tid + 512 * i, n = p >> 3, c = p & 7; const LAS float* sp = tile + (8 * c) * 257 + n;
        float g[8];
#pragma unroll
        for (int q = 0; q < 8; ++q) g[q] = gain ? gain[k0 + 8 * c + q] : 1.f;
        v4u o; o.x = pk2(sp[0 * 257] * g[0], sp[1 * 257] * g[1]); o.y = pk2(sp[2 * 257] * g[2], sp[3 * 257] * g[3]); o.z = pk2(sp[4 * 257] * g[4], sp[5 * 257] * g[5]); o.w = pk2(sp[6 * 257] * g[6], sp[7 * 257] * g[7]);
        int ng = n0 + n; bool ok = ng < N;
        if (REMAP) { if (ng >= 3584 && ng < 3592) ok = false; else if (ng >= 3592) ng -= 8; }
        if (ok) *(GAS v4u*)(WT + (size_t)ng * K + k0 + 8 * c) = o; }
    __syncthreads();
}

__device__ __forceinline__ void p0_prologue(Frame& F, const Args& a) {
    unsigned char* ws = a.ws;
    LAS float* tile = (LAS float*)F.lds;
    const int gw = F.vcu * NWAVES + F.wave, NGW = F.G * NWAVES;
    constexpr int I_IN = 16 * 23;
    for (int it = F.vcu; it < I_IN; it += F.G) transpose_tile<true>(a.w_in, 1024, IN_COLS, a.g_mix, (bf16_t*)(ws + WS_WIN), tile, it, F.tid);
    __syncthreads();
    LAS float* wsm = (LAS float*)F.lds;
    for (int i = F.tid; i < 8192; i += NWAVES * 64) { const int j = i >> 10, k = i & 1023; wsm[i] = a.w_in[(size_t)k * IN_COLS + 3584 + j] * a.g_mix[k]; }
    __syncthreads();
    bf16_t* XB = (bf16_t*)(ws + WS_A0); float* rstd0 = (float*)(ws + WS_RSTD0); float* GB = (float*)(ws + WS_GB); float* GA = GB + T * 4;
    for (int row0 = gw * 4; row0 < T; row0 += NGW * 4) {
        f32x4 v[4][4];
#pragma unroll
        for (int r = 0; r < 4; ++r)
#pragma unroll
            for (int j = 0; j < 4; ++j) v[r][j] = *((const GAS f32x4*)(a.x + (size_t)(row0 + r) * D) + F.lane + 64 * j);
#pragma unroll
        for (int r = 0; r < 4; ++r) { const int row = row0 + r; float s = 0.f;
#pragma unroll
            for (int j = 0; j < 4; ++j) s += (v[r][j].x * v[r][j].x + v[r][j].y * v[r][j].y) + (v[r][j].z * v[r][j].z + v[r][j].w * v[r][j].w);
            const float rstd = rsqrtf(wave_sum(s) * (1.f / D) + EPS);
            GAS unsigned long long* o8 = (GAS unsigned long long*)(XB + (size_t)row * D) + F.lane;
#pragma unroll
            for (int j = 0; j < 4; ++j) o8[64 * j] = (unsigned long long)pk2(v[r][j].x, v[r][j].y) | ((unsigned long long)pk2(v[r][j].z, v[r][j].w) << 32);
            float dj[8];
#pragma unroll
            for (int jj = 0; jj < 8; ++jj) { float d = 0.f;
#pragma unroll
                for (int j = 0; j < 4; ++j) { const f32x4 w = *(const LAS f32x4*)(wsm + jj * 1024 + (F.lane + 64 * j) * 4); d += (v[r][j].x * w.x + v[r][j].y * w.y) + (v[r][j].z * w.z + v[r][j].w * w.w); }
                dj[jj] = d; }
#pragma unroll
            for (int off = 4; off >= 1; off >>= 1) { const bool up = (F.lane & off) != 0;
#pragma unroll
                for (int i = 0; i < off; ++i) { const float lo = dj[i], hi = dj[i + off]; const float send = up ? lo : hi, keep = up ? hi : lo; dj[i] = keep + __shfl_xor(send, off); } }
            float d0 = dj[0]; d0 += __shfl_xor(d0, 8); d0 += __shfl_xor(d0, 16); d0 += __shfl_xor(d0, 32);
            if (F.lane == 0) rstd0[row] = rstd;
            if (F.lane < 4) GB[(size_t)row * 4 + F.lane] = d0 * rstd; else if (F.lane < 8) GA[(size_t)row * 4 + F.lane - 4] = d0 * rstd; }
    }
}
__device__ __forceinline__ void late_prologue(Frame& F, const Args& a, int wgi, int nwg) {
    unsigned char* ws = a.ws;
    LAS float* tile = (LAS float*)F.lds;
    const int gw = wgi * NWAVES + F.wave, NGW = nwg * NWAVES;
    constexpr int I_S = 8 * 4, I_M = 16 * 4, I_L = 16 * 8;
    constexpr int NITEMS = 2 * I_S + 3 * I_M + 2 * I_L;
    for (int it = wgi; it < NITEMS; it += nwg) {
        int r = it;
        if (r < I_S) { transpose_tile<false>(a.w_sb_up, 512, 1024, nullptr, (bf16_t*)(ws + WS_WSB), tile, r, F.tid); continue; } r -= I_S;
        if (r < I_S) { transpose_tile<false>(a.w_gdn_up, 512, 1024, nullptr, (bf16_t*)(ws + WS_WGDN), tile, r, F.tid); continue; } r -= I_S;
        if (r < I_M) { transpose_tile<false>(a.w_mix_out, 1024, 1024, nullptr, (bf16_t*)(ws + WS_WMIX), tile, r, F.tid); continue; } r -= I_M;
        if (r < I_M) { transpose_tile<false>(a.w_cq, 1024, 1024, a.g_cross, (bf16_t*)(ws + WS_WCQ), tile, r, F.tid); continue; } r -= I_M;
        if (r < I_M) { transpose_tile<false>(a.w_co, 1024, 1024, nullptr, (bf16_t*)(ws + WS_WCO), tile, r, F.tid); continue; } r -= I_M;
        if (r < I_L) { transpose_tile<false>(a.w_ckv, 1024, 2048, nullptr, (bf16_t*)(ws + WS_WCKV), tile, r, F.tid); continue; } r -= I_L;
        transpose_tile<false>(a.w_pq, 1024, 2048, a.g_peer, (bf16_t*)(ws + WS_WPQ), tile, r, F.tid);
    }
    __syncthreads();
    {
        float* SUV = (float*)(ws + WS_SUV);
        f32x4 gq[4];
#pragma unroll
        for (int q = 0; q < 4; ++q) gq[q] = *(const GAS f32x4*)(a.g_peer + 16 * F.lane + 4 * q);
        for (int row0 = gw * 4; row0 < 2 * 16384; row0 += NGW * 4) {
            f32x4 v[4][4];
#pragma unroll
            for (int r = 0; r < 4; ++r) { const int row = row0 + r, tb = row >> 14, e = row & 16383; const float* src = (tb ? a.peer_v : a.peer_u) + (size_t)e * 1024 + 16 * F.lane;
#pragma unroll
                for (int q = 0; q < 4; ++q) { v[r][q] = *(const GAS f32x4*)(src + 4 * q); if (!tb) v[r][q] *= gq[q]; } }
#pragma unroll
            for (int r = 0; r < 4; ++r) { const int row = row0 + r, tb = row >> 14, e = row & 16383; float am = 0.f;
#pragma unroll
                for (int q = 0; q < 4; ++q) am = fmaxf(am, fmaxf(fmaxf(fabsf(v[r][q].x), fabsf(v[r][q].y)), fmaxf(fabsf(v[r][q].z), fabsf(v[r][q].w))));
#pragma unroll
                for (int o = 1; o < 64; o <<= 1) am = fmaxf(am, __shfl_xor(am, o));
                if (!tb) {
                    const float sc8 = am > 0.f ? 127.f / am : 0.f; v4u o8;
#pragma unroll
                    for (int q = 0; q < 4; ++q) {
                        const unsigned b0 = __builtin_bit_cast(unsigned, fmaf(v[r][q].x, sc8, 12582912.f)), b1 = __builtin_bit_cast(unsigned, fmaf(v[r][q].y, sc8, 12582912.f));
                        const unsigned b2 = __builtin_bit_cast(unsigned, fmaf(v[r][q].z, sc8, 12582912.f)), b3 = __builtin_bit_cast(unsigned, fmaf(v[r][q].w, sc8, 12582912.f));
                        o8[q] = __builtin_amdgcn_perm(b1, b0, 0x0c0c0400u) | __builtin_amdgcn_perm(b3, b2, 0x04000c0cu); }
                    *(GAS v4u*)(ws + WS_U8 + ((size_t)(F.lane >> 3) * 16384 + e) * 128 + 16 * (F.lane & 7)) = o8;
                    if (F.lane == 0) SUV[row] = am * (1.f / 127.f);
                    continue; }
                int ex = 0; if (am > 0.f) (void)frexpf(am, &ex);
                const float sc = ldexpf(1.f, 8 - ex), inv = ldexpf(1.f, ex - 8);
                v4u o; int rr;
                rr = __builtin_amdgcn_cvt_pk_fp8_f32(v[r][0].x * sc, v[r][0].y * sc, 0, false); rr = __builtin_amdgcn_cvt_pk_fp8_f32(v[r][0].z * sc, v[r][0].w * sc, rr, true); o.x = (unsigned)rr;
                rr = __builtin_amdgcn_cvt_pk_fp8_f32(v[r][1].x * sc, v[r][1].y * sc, 0, false); rr = __builtin_amdgcn_cvt_pk_fp8_f32(v[r][1].z * sc, v[r][1].w * sc, rr, true); o.y = (unsigned)rr;
                rr = __builtin_amdgcn_cvt_pk_fp8_f32(v[r][2].x * sc, v[r][2].y * sc, 0, false); rr = __builtin_amdgcn_cvt_pk_fp8_f32(v[r][2].z * sc, v[r][2].w * sc, rr, true); o.z = (unsigned)rr;
                rr = __builtin_amdgcn_cvt_pk_fp8_f32(v[r][3].x * sc, v[r][3].y * sc, 0, false); rr = __builtin_amdgcn_cvt_pk_fp8_f32(v[r][3].z * sc, v[r][3].w * sc, rr, true); o.w = (unsigned)rr;
                *(GAS v4u*)(ws + (tb ? WS_V8 : WS_U8) + ((size_t)(F.lane >> 3) * 16384 + e) * 128 + 16 * (F.lane & 7)) = o;
                if (F.lane == 0) SUV[row] = inv; }
        }
    }
    {
        const int gt = gw * 64 + F.lane, ngt = NGW * 64;
        for (int p = gt; p < 262144 / 8; p += ngt) { const float* src = a.subkeys + (size_t)p * 8; const f32x4 v0 = *(const GAS f32x4*)src, v1 = *(const GAS f32x4*)(src + 4);
            v4u o; o.x = pk2(v0.x, v0.y); o.y = pk2(v0.z, v0.w); o.z = pk2(v1.x, v1.y); o.w = pk2(v1.z, v1.w); *(GAS v4u*)((bf16_t*)(ws + WS_SKB) + (size_t)p * 8) = o; }
    }
    bf16_t* MN = (bf16_t*)(ws + WS_MN);
    for (int row = gw; row < 1024; row += NGW) {
        const GAS f32x4* xr = (const GAS f32x4*)(a.mem + (size_t)row * D) + F.lane;
        f32x4 v[4]; float s = 0.f;
#pragma unroll
        for (int j = 0; j < 4; ++j) { v[j] = xr[64 * j]; s += (v[j].x * v[j].x + v[j].y * v[j].y) + (v[j].z * v[j].z + v[j].w * v[j].w); }
        const float rstd = rsqrtf(wave_sum(s) * (1.f / D) + EPS);
        GAS unsigned long long* o8 = (GAS unsigned long long*)(MN + (size_t)row * D) + F.lane;
#pragma unroll
        for (int j = 0; j < 4; ++j) { const f32x4 g = *((const f32x4*)a.g_mem + F.lane + 64 * j); const f32x4 o = v[j] * g * rstd;
            o8[64 * j] = (unsigned long long)pk2(o.x, o.y) | ((unsigned long long)pk2(o.z, o.w) << 32); }
    }
}
__device__ __forceinline__ void rstd_rows_for_units(Frame& F, int N, const float* SS, float* rstd) {
    pg8::StaticOrder S2; S2.init(T, N, F.G, (int)blockIdx.x); pg8::Unit u;
    for (int i = 0; S2.next(i, u); ++i) if (F.tid < 256) { const int row = u.pm * 256 + F.tid; const f32x4* sp = (const f32x4*)(SS + (size_t)row * 16);
        const f32x4 a = (sp[0] + sp[1]) + (sp[2] + sp[3]); rstd[row] = rsqrtf(((a.x + a.y) + (a.z + a.w)) * (1.f / 1024.f) + EPS); }
    asm volatile("s_waitcnt vmcnt(0)" ::: "memory"); __syncthreads();
}

__device__ __forceinline__ void sub_barrier(gu32* cnt, unsigned n, gu32* tmo) {
    asm volatile("s_waitcnt vmcnt(0)" ::: "memory");
    __syncthreads();
    if (threadIdx.x == 0) {
        __builtin_amdgcn_fence(__ATOMIC_RELEASE, "agent");
        asm volatile("s_waitcnt vmcnt(0)" ::: "memory");
        __hip_atomic_fetch_add(cnt, 1u, __ATOMIC_RELAXED, __HIP_MEMORY_SCOPE_AGENT);
        unsigned sp = 0;
        while (__hip_atomic_load(cnt, __ATOMIC_RELAXED, __HIP_MEMORY_SCOPE_AGENT) < n) { __builtin_amdgcn_s_sleep(2); if (++sp > (1u << 22)) { __hip_atomic_store(tmo, 1u, __ATOMIC_RELAXED, __HIP_MEMORY_SCOPE_AGENT); break; } }
        __builtin_amdgcn_fence(__ATOMIC_ACQUIRE, "agent");
        asm volatile("s_waitcnt vmcnt(0)" ::: "memory");
    }
    __syncthreads();
}

__global__ void __launch_bounds__(NWAVES * 64, 2) mk_fwd(Args args) {
    extern __shared__ __attribute__((aligned(16))) unsigned char lds_raw[];
    Frame F;
    F.lds = (LAS unsigned char*)lds_raw;
    F.tid = threadIdx.x; F.lane = F.tid & 63; F.wave = __builtin_amdgcn_readfirstlane(F.tid >> 6);
    F.G = gridDim.x; { const int bx = blockIdx.x; F.vcu = (F.G % 8 == 0) ? (bx % 8) * (F.G / 8) + bx / 8 : bx; }
    unsigned char* ws = args.ws;
    gu32* ctl = (gu32*)(ws + WS_CTL);
    volatile LAS unsigned* MISC = (volatile LAS unsigned*)(F.lds + MISC_OFF);
    for (int u = F.tid; u < (LDS_BYTES - LDSCTL_OFF) / 4; u += NWAVES * 64) ((LAS unsigned*)(F.lds + LDSCTL_OFF))[u] = 0u;
    __syncthreads();
    XcdBarrier bar = xcd_barrier_post((unsigned*)(ctl + CW_BAR) + args.bar_region * XCD_BAR_WORDS, MISC + 8);
    const int lo = args.ph_lo, hi = args.ph_hi;
#define IN(k) (lo <= (k) && (k) < hi)
#define SEAM(k) do { if (IN(k) && IN((k) + 1)) xcd_barrier(bar); } while (0)
    bf16_t* A0 = (bf16_t*)(ws + WS_A0); bf16_t* A1 = (bf16_t*)(ws + WS_A1);
    bf16_t* MG = (bf16_t*)args.out;
    bf16_t* SBQ = (bf16_t*)args.out; bf16_t* SBK = SBQ + (size_t)T * 512; bf16_t* SBV = SBK + (size_t)T * 512; bf16_t* OSB = SBV + (size_t)T * 512;

    GdnBufs Gb{(bf16_t*)(ws + WS_NW), (bf16_t*)(ws + WS_QD), (bf16_t*)(ws + WS_KDT), (bf16_t*)(ws + WS_QK), (bf16_t*)(ws + WS_UT), (float*)(ws + WS_CD), (bf16_t*)(ws + WS_ORAW), (float*)(ws + WS_OSS)};
    if (IN(0)) { p0_prologue(F, args);}
    SEAM(0);
    if (IN(1)) {
        { pg8::Gemm g{A0, (const bf16_t*)(ws + WS_WIN), T, NPROJ, 1024}; pg8::StaticOrder S; S.init(T, NPROJ, F.G, (int)blockIdx.x);
          pg8::EpiProj E{(const float*)(ws + WS_RSTD0), SBQ, SBK, SBV, A1, (bf16_t*)(ws + WS_GZ), (bf16_t*)(ws + WS_GSB), (bf16_t*)(ws + WS_GGDN)};
          pg8::gemm_phase<pg8::EpiProj, pg8::StaticOrder, true, true>(F.lds, g, S, E); }
    }
    SEAM(1);
    if (IN(2)) { gdn_prep_phase(F, args, A1, (const float*)(ws + WS_GB), (const float*)(ws + WS_GB) + T * 4, Gb); }
    SEAM(2);
    if (IN(3)) {
        const int nscan = F.G > 64 ? 64 : F.G, sb0 = F.G > 64 ? 64 : 0;
        if ((int)blockIdx.x < nscan) for (int s0 = blockIdx.x; s0 < 64; s0 += nscan) { const int s = (nscan == 64) ? ((s0 & 7) + 8 * (s0 >> 5)) * 4 + ((s0 >> 3) & 3) : s0; gdn_scan_unit(F, s, Gb); __syncthreads(); }
        if ((int)blockIdx.x >= sb0) { late_prologue(F, args, (int)blockIdx.x - sb0, F.G - sb0); __syncthreads(); }
        if ((int)blockIdx.x >= sb0) sb_phase(F.lds + F.wave * 8192, SBQ, SBK, SBV, OSB, ((int)blockIdx.x - sb0) * NWAVES + F.wave, (F.G - sb0) * NWAVES, F.lane);
        __syncthreads();
        if (sb0 > 0 && (int)blockIdx.x >= sb0) {
            sub_barrier(ctl + CW_SUB, (unsigned)(F.G - sb0), ctl + CW_SUB + 64);
            pg8::Gemm g{OSB, (const bf16_t*)(ws + WS_WSB), T, 1024, 512}; pg8::StaticOrder S; S.init(T, 1024, F.G - sb0, (int)blockIdx.x - sb0);
            pg8::EpiMerge<false> E{(const bf16_t*)(ws + WS_GSB), MG};
            pg8::gemm_phase<pg8::EpiMerge<false>, pg8::StaticOrder, true, true>(F.lds, g, S, E);
            const int wgi = (int)blockIdx.x - sb0;
            if (F.G - sb0 >= 160 && wgi >= 128 && wgi < 160) { pg8::Gemm g2{(const bf16_t*)(ws + WS_MN), (const bf16_t*)(ws + WS_WCKV), 1024, 2048, 1024}; pg8::StaticOrder S2; S2.init(1024, 2048, 32, wgi - 128);
                pg8::EpiSplit E2{(bf16_t*)(ws + WS_KC), (bf16_t*)(ws + WS_VC), 1024, 4};
                pg8::gemm_phase<pg8::EpiSplit, pg8::StaticOrder, true, true>(F.lds, g2, S2, E2); }
        }
    }
    SEAM(3);
    if (IN(4)) {
        if (!(F.G > 64 && F.G - 64 >= 160)) { pg8::Gemm g{(const bf16_t*)(ws + WS_MN), (const bf16_t*)(ws + WS_WCKV), 1024, 2048, 1024}; pg8::StaticOrder S; S.init(1024, 2048, F.G, (int)blockIdx.x);
          pg8::EpiSplit E{(bf16_t*)(ws + WS_KC), (bf16_t*)(ws + WS_VC), 1024, 4};
          pg8::gemm_phase<pg8::EpiSplit, pg8::StaticOrder, true, true>(F.lds, g, S, E); }
        gdn_finish_phase(F, args, Gb, (const bf16_t*)(ws + WS_GZ), (bf16_t*)(ws + WS_OG)); }
    SEAM(4);
    if (IN(5)) {
        if (!(F.G > 64)) { pg8::Gemm g{OSB, (const bf16_t*)(ws + WS_WSB), T, 1024, 512}; pg8::StaticOrder S; S.init(T, 1024, F.G, (int)blockIdx.x);
          pg8::EpiMerge<false> E{(const bf16_t*)(ws + WS_GSB), MG};
          pg8::gemm_phase<pg8::EpiMerge<false>, pg8::StaticOrder, true, true>(F.lds, g, S, E);
          xcd_barrier(bar); }
        { pg8::Gemm g{(const bf16_t*)(ws + WS_OG), (const bf16_t*)(ws + WS_WGDN), T, 1024, 512}; pg8::StaticOrder S; S.init(T, 1024, F.G, (int)blockIdx.x);
          pg8::EpiMerge<true> E{(const bf16_t*)(ws + WS_GGDN), MG};
          pg8::gemm_phase<pg8::EpiMerge<true>, pg8::StaticOrder, true, true>(F.lds, g, S, E); }
    }
    SEAM(5);
    if (IN(6)) {
        pg8::Gemm g{MG, (const bf16_t*)(ws + WS_WMIX), T, 1024, 1024}; pg8::StaticOrder S; S.init(T, 1024, F.G, (int)blockIdx.x);
        pg8::EpiRes<true> E{args.x, nullptr, A1, (float*)(ws + WS_SS)};
        pg8::gemm_phase<pg8::EpiRes<true>, pg8::StaticOrder, true, true>(F.lds, g, S, E);
    }
    SEAM(6);
    if (IN(7)) {
        rstd_rows_for_units(F, 1024, (const float*)(ws + WS_SS), (float*)(ws + WS_RSTD0));
        pg8::Gemm g{A1, (const bf16_t*)(ws + WS_WCQ), T, 1024, 1024}; pg8::StaticOrder S; S.init(T, 1024, F.G, (int)blockIdx.x);
        pg8::EpiScale E{(const float*)(ws + WS_RSTD0), (bf16_t*)(ws + WS_GSB), 1024};
        pg8::gemm_phase<pg8::EpiScale, pg8::StaticOrder, true, true>(F.lds, g, S, E);
        asm volatile("s_waitcnt vmcnt(0)" ::: "memory"); __syncthreads();
        pg8::StaticOrder S2; S2.init(T, 1024, F.G, (int)blockIdx.x); pg8::Unit u;
        for (int i = 0; S2.next(i, u); ++i) cross_item(F, (const bf16_t*)(ws + WS_GSB), (const bf16_t*)(ws + WS_KC), (const bf16_t*)(ws + WS_VC), (bf16_t*)(ws + WS_GGDN), (u.pm >> 5) * 4 + u.pn, u.pm & 31);
    }
    SEAM(7);
    if (IN(9)) {
        pg8::Gemm g{(const bf16_t*)(ws + WS_GGDN), (const bf16_t*)(ws + WS_WCO), T, 1024, 1024}; pg8::StaticOrder S; S.init(T, 1024, F.G, (int)blockIdx.x);
        pg8::EpiRes<false> E{nullptr, A1, A0, (float*)(ws + WS_SS)};
        pg8::gemm_phase<pg8::EpiRes<false>, pg8::StaticOrder, true, true>(F.lds, g, S, E);
    }
    SEAM(9);
    if (IN(10)) {
        rstd_rows_for_units(F, 2048, (const float*)(ws + WS_SS), (float*)(ws + WS_RSTD2));
        pg8::Gemm g{A0, (const bf16_t*)(ws + WS_WPQ), T, 2048, 1024}; pg8::StaticOrder S; S.init(T, 2048, F.G, (int)blockIdx.x);
        pg8::EpiScale E{(const float*)(ws + WS_RSTD2), A1, 2048};
        pg8::gemm_phase<pg8::EpiScale, pg8::StaticOrder, true, true>(F.lds, g, S, E);
        asm volatile("s_waitcnt vmcnt(0)" ::: "memory"); __syncthreads();
        pg8::StaticOrder S2; S2.init(T, 2048, F.G, (int)blockIdx.x); pg8::Unit u;
        int hst = -1;
        for (int i = 0; S2.next(i, u); ++i) {
            if (u.pn != hst) { hst = u.pn; __syncthreads();
#pragma unroll
                for (int q = 0; q < 8; ++q) { const int cid = F.tid + 512 * q, r = cid >> 4, c = cid & 15;
                    *(LAS v4u*)(F.lds + r * 256 + ((c ^ (r & 15)) << 4)) = *(const v4u*)((const bf16_t*)(ws + WS_SKB) + ((size_t)u.pn * 256 + r) * 128 + c * 8); }
                __syncthreads(); }
            peer_route_task(F, A1, (const bf16_t*)(ws + WS_SKB), (int*)(ws + 296 * MiB), (float*)(ws + 312 * MiB), u.pm * 8 + F.wave, u.pn);
        }
        __syncthreads();
    }
    SEAM(10);
    if (IN(12)) { peer_u_phase(F, args, ctl, A0, (const float*)(ws + WS_RSTD2), (const int*)(ws + 296 * MiB), (const unsigned char*)(ws + WS_U8), (bf16_t*)(ws + WS_PART)); }
    SEAM(12);
    if (IN(13)) { peer_combine_phase(F, (const bf16_t*)(ws + WS_PART), (const int*)(ws + 296 * MiB), (const float*)(ws + 312 * MiB), (const float*)(ws + WS_SUV), (const float*)(ws + WS_SUV) + 16384, (float*)(ws + 328 * MiB)); }
    SEAM(13);
    if (IN(14)) { peer_v_phase(F, ctl, (const int*)(ws + 296 * MiB), (const float*)(ws + 328 * MiB), (const unsigned char*)(ws + WS_V8), A0, A1, (float*)(ws + WS_SS)); }
    SEAM(14);
    if (IN(15)) { peer_norm_phase(F, args, (const float*)(ws + WS_SS), A1, args.out); }
#undef IN
#undef SEAM
}
extern "C" void kernel_launch(void* const* d_in, const int* in_sizes, int n_in, void* d_out, int out_size, void* d_ws, size_t ws_size, hipStream_t stream) {
    static int grid = 0;
    if (grid == 0) {
        if (n_in != 22 || ws_size < WS_END || out_size != T * D) { fprintf(stderr, "kernel_launch: unexpected n_in %d / ws %zu / out %d\n", n_in, ws_size, out_size); grid = -1; return; }
        int dev = 0, cus = 0, per_cu = 0;
        if (hipGetDevice(&dev) != hipSuccess || hipDeviceGetAttribute(&cus, hipDeviceAttributeMultiprocessorCount, dev) != hipSuccess) { grid = -1; return; }
        if (hipFuncSetAttribute((const void*)mk_fwd, hipFuncAttributeMaxDynamicSharedMemorySize, LDS_BYTES) != hipSuccess) { fprintf(stderr, "kernel_launch: hipFuncSetAttribute failed\n"); grid = -1; return; }
        if (hipOccupancyMaxActiveBlocksPerMultiprocessor(&per_cu, (const void*)mk_fwd, NWAVES * 64, LDS_BYTES) != hipSuccess || per_cu < 1) { fprintf(stderr, "kernel_launch: occupancy query says %d\n", per_cu); per_cu = 1; }
        (void)hipGetLastError();
        grid = cus;
    }
    if (grid < 0) return;
    hipMemsetAsync((char*)d_ws + WS_CTL, 0, CTL_ZERO_BYTES, stream);
    Args a{};
    const float** ap = (const float**)&a;
    for (int i = 0; i < 22; ++i) ap[i] = (const float*)d_in[i];
    a.out = (float*)d_out; a.ws = (unsigned char*)d_ws;
    char* ws = (char*)d_ws; float* out = (float*)d_out;
    float* rstd2 = (float*)(ws + WS_RSTD2);
    bf16_t* KC = (bf16_t*)(ws + WS_KC); bf16_t* VC = (bf16_t*)(ws + WS_VC);
    bf16_t* PQ = (bf16_t*)(ws + WS_A1); bf16_t* QC = (bf16_t*)(ws + WS_GSB); bf16_t* OC = (bf16_t*)(ws + WS_GGDN);
    int* EIDX = (int*)(ws + 296 * MiB); float* EGATE = (float*)(ws + 312 * MiB);
#define MK(lo, hi, reg) do { a.ph_lo = (lo); a.ph_hi = (hi); a.bar_region = (reg); hipLaunchKernelGGL(mk_fwd, dim3(grid), dim3(NWAVES * 64), LDS_BYTES, stream, a); } while (0)
    MK(0, 16, 0);
#undef MK
}
```

```cpp
#include <hip/hip_runtime.h>
#include <stdint.h>
#include <cstdio>

typedef unsigned short bf16_t;
__device__ __forceinline__ float bf2f(bf16_t v) { return __uint_as_float(((unsigned)v) << 16); }
__device__ __forceinline__ bf16_t f2bf(float f) { unsigned u = __float_as_uint(f); return (bf16_t)((u + 0x7fffu + ((u >> 16) & 1u)) >> 16); }

constexpr int T = 32768, D = 1024, SEQ = 8192, NB = 4;
constexpr int IN_COLS = 5640, NPROJ = 5632;
constexpr float EPS = 1e-6f;
constexpr size_t MiB = 1u << 20;

__device__ __forceinline__ float wave_sum(float v) {
#pragma unroll
    for (int o = 1; o < 64; o <<= 1) v += __shfl_xor(v, o);
    return v;
}
__device__ __forceinline__ float sigmoidf_(float x) { return 1.f / (1.f + __expf(-x)); }
__device__ __forceinline__ float softplusf_(float x) { return fmaxf(x, 0.f) + log1pf(__expf(-fabsf(x))); }

namespace pg8 {
#define PG8_LAS __attribute__((address_space(3)))
typedef unsigned short bf16_t;
typedef short bf16x8 __attribute__((ext_vector_type(8)));
typedef float f32x4 __attribute__((ext_vector_type(4)));
typedef unsigned u32x4 __attribute__((ext_vector_type(4)));
constexpr int BM = 256, BK = 64, HALF = 128, HTB = HALF * BK * 2  , STAGE_BYTES = 8 * HTB, NXCD = 8, WGM = 8;

__host__ __device__ __forceinline__ int lds_byte(int r, int c) { const int st = (r >> 4) * 2 + (c >> 5), rr = r & 15, cc = c & 31, ob = rr * 64 + cc * 2; return st * 1024 + (ob ^ (((ob >> 9) & 1) << 5)); }
__host__ __device__ __forceinline__ void stage_rc(int b, int& R, int& C) { const int st = b / 1024, sb = b % 1024, swz = sb ^ (((sb >> 9) & 1) << 5); R = (st >> 1) * 16 + swz / 64; C = (st & 1) * 32 + (swz % 64) / 2; }
__host__ __device__ __forceinline__ int perm32(int rho) { const int n = rho >> 4, i = rho & 15; return 8 * (i >> 2) + 4 * n + (i & 3); }

struct Unit { int pm, pn; };
struct Gemm { const bf16_t* A; const bf16_t* Bt; int M, N, K; };

struct StaticOrder {
    int nM, nN, nwg, G, c;
    __host__ __device__ __forceinline__ void init(int M, int N, int G_, int c_) { nM = M / BM; nN = N / BM; nwg = nM * nN; G = G_; c = c_; }
    __host__ __device__ __forceinline__ bool next(int i, Unit& u) const {
        const long L = (long)i * G + c; if (L >= nwg) return false;
        int wgid = (int)L; { const int q = nwg / NXCD, r = nwg % NXCD, xcd = wgid % NXCD, off = wgid / NXCD; wgid = (xcd < r ? xcd * (q + 1) : r * (q + 1) + (xcd - r) * q) + off; }
        const int nig = WGM * nN, gid = wgid / nig, fm = gid * WGM, gsz = (nM - fm) < WGM ? (nM - fm) : WGM;
        u.pm = fm + ((wgid % nig) % gsz); u.pn = (wgid % nig) / gsz; return true;
    }
    __device__ __forceinline__ void a_ready(const Unit&) const {}
    __device__ __forceinline__ void done(const Unit&) const {}
};

__device__ __forceinline__ unsigned cvt_pk_bf16(float lo, float hi) { unsigned r; asm volatile("v_cvt_pk_bf16_f32 %0, %1, %2" : "=v"(r) : "v"(lo), "v"(hi)); return r; }
typedef float f32x2 __attribute__((ext_vector_type(2)));
__device__ __forceinline__ float bfl(unsigned w) { return __uint_as_float(w << 16); }
__device__ __forceinline__ float bfh(unsigned w) { return __uint_as_float(w & 0xffff0000u); }
constexpr int EPI_STAGE_OFF = 131072 + 1024;
__device__ __forceinline__ void stage_store16x64(int wid, int fr, int fq, u32x4 w0, u32x4 w1, bf16_t* rowbase  , size_t ld) {
    PG8_LAS unsigned char* sl = (PG8_LAS unsigned char*)(EPI_STAGE_OFF + wid * 2048);
    *(PG8_LAS u32x4*)(sl + fr * 128 + ((fq ^ (fr & 7)) << 4)) = w0;
    *(PG8_LAS u32x4*)(sl + fr * 128 + (((4 + fq) ^ (fr & 7)) << 4)) = w1;
    const int lane = fr + 16 * fq, r0 = lane >> 3, c = lane & 7;
    const u32x4 a = *(const PG8_LAS u32x4*)(sl + r0 * 128 + ((c ^ r0) << 4));
    const u32x4 b = *(const PG8_LAS u32x4*)(sl + (r0 + 8) * 128 + ((c ^ r0) << 4));
    *(u32x4*)(rowbase + (size_t)r0 * ld + c * 8) = a;
    *(u32x4*)(rowbase + (size_t)(r0 + 8) * ld + c * 8) = b;
}
__device__ __forceinline__ u32x4 pack8(const f32x4& v0, const f32x4& v1) { u32x4 w; w.x = cvt_pk_bf16(v0[0], v0[1]); w.y = cvt_pk_bf16(v0[2], v0[3]); w.z = cvt_pk_bf16(v1[0], v1[1]); w.w = cvt_pk_bf16(v1[2], v1[3]); return w; }

struct EpiProj {
    static constexpr bool PERM = true, AFTER_DRAIN = false, COL64 = true;
    const float* rstd; bf16_t *SBQ, *SBK, *SBV, *GQKV, *GZ, *GSB, *GGDN;
    __device__ __forceinline__ void operator()(const f32x4 (&acc)[2][2][4][2], const Unit& u, int wr, int wc, int fr_in, int fq_in) const {
        int lane_ = fr_in + 16 * fq_in; asm volatile("" : "+v"(lane_));
        const int fr = lane_ & 15, fq = lane_ >> 4;
        const int pn = u.pn; bf16_t* base; int ld, coff;
        if (pn < 2) { base = SBQ; ld = 512; coff = pn * 256; } else if (pn < 4) { base = SBK; ld = 512; coff = (pn - 2) * 256; } else if (pn < 6) { base = SBV; ld = 512; coff = (pn - 4) * 256; }
        else if (pn < 12) { base = GQKV; ld = 1536; coff = (pn - 6) * 256; } else if (pn < 14) { base = GZ; ld = 512; coff = (pn - 12) * 256; }
        else if (pn < 18) { base = GSB; ld = 1024; coff = (pn - 14) * 256; } else { base = GGDN; ld = 1024; coff = (pn - 18) * 256; }
        const int row0 = u.pm * BM + wr * 64, wid = wr * 4 + wc;
        float rsv[2][4];
#pragma unroll
        for (int ai = 0; ai < 2; ++ai)
#pragma unroll
            for (int m = 0; m < 4; ++m) rsv[ai][m] = rstd[row0 + ai * HALF + m * 16 + fr];
#pragma unroll
        for (int ai = 0; ai < 2; ++ai)
#pragma unroll
            for (int m = 0; m < 4; ++m) { const int rg = row0 + ai * HALF + m * 16; const float rs = rsv[ai][m];
                stage_store16x64(wid, fr, fq, pack8(acc[ai][0][m][0] * rs, acc[ai][0][m][1] * rs), pack8(acc[ai][1][m][0] * rs, acc[ai][1][m][1] * rs), base + (size_t)rg * ld + coff + wc * 64, ld); }
    }
};
struct EpiSplit {
    static constexpr bool PERM = true, AFTER_DRAIN = false, COL64 = true;
    bf16_t *O0, *O1; int ldc, split_tiles;
    __device__ __forceinline__ void operator()(const f32x4 (&acc)[2][2][4][2], const Unit& u, int wr, int wc, int fr_in, int fq_in) const {
        int lane_ = fr_in + 16 * fq_in; asm volatile("" : "+v"(lane_));
        const int fr = lane_ & 15, fq = lane_ >> 4;
        bf16_t* base = u.pn < split_tiles ? O0 : O1; const int coff = (u.pn < split_tiles ? u.pn : u.pn - split_tiles) * 256;
        const int row0 = u.pm * BM + wr * 64, wid = wr * 4 + wc;
#pragma unroll
        for (int ai = 0; ai < 2; ++ai)
#pragma unroll
            for (int m = 0; m < 4; ++m) { const int rg = row0 + ai * HALF + m * 16;
                stage_store16x64(wid, fr, fq, pack8(acc[ai][0][m][0], acc[ai][0][m][1]), pack8(acc[ai][1][m][0], acc[ai][1][m][1]), base + (size_t)rg * ldc + coff + wc * 64, ldc); }
    }
};
template <bool ADD> struct EpiMerge {
    static constexpr bool PERM = true, AFTER_DRAIN = false, COL64 = true;
    const bf16_t* gate; bf16_t* M;
    __device__ __forceinline__ void operator()(const f32x4 (&acc)[2][2][4][2], const Unit& u, int wr, int wc, int fr_in, int fq_in) const {
        int lane_ = fr_in + 16 * fq_in; asm volatile("" : "+v"(lane_));
        const int fr = lane_ & 15, fq = lane_ >> 4;
        const int row0 = u.pm * BM + wr * 64, col0 = u.pn * BM + wc * 64, wid = wr * 4 + wc;
#pragma unroll
        for (int ab = 0; ab < 4; ++ab) { const int ai = ab >> 1, mb = (ab & 1) * 2;
            u32x4 gl[4][2], pl[4][2];
#pragma unroll
            for (int m = mb; m < mb + 2; ++m)
#pragma unroll
                for (int bj = 0; bj < 2; ++bj) { const size_t o = (size_t)(row0 + ai * HALF + m * 16 + fr) * 1024 + col0 + 8 * fq + bj * 32; gl[m][bj] = *(const u32x4*)(gate + o); if (ADD) pl[m][bj] = *(const u32x4*)(M + o); }
#pragma unroll
            for (int m = mb; m < mb + 2; ++m) { const int rg = row0 + ai * HALF + m * 16;
                u32x4 wv[2];
#pragma unroll
                for (int bj = 0; bj < 2; ++bj) { const u32x4 g = gl[m][bj];
                    float gv[8] = {bfl(g.x), bfh(g.x), bfl(g.y), bfh(g.y), bfl(g.z), bfh(g.z), bfl(g.w), bfh(g.w)};
                    float pv[8] = {0.f, 0.f, 0.f, 0.f, 0.f, 0.f, 0.f, 0.f};
                    if (ADD) { const u32x4 p = pl[m][bj]; pv[0] = bfl(p.x); pv[1] = bfh(p.x); pv[2] = bfl(p.y); pv[3] = bfh(p.y); pv[4] = bfl(p.z); pv[5] = bfh(p.z); pv[6] = bfl(p.w); pv[7] = bfh(p.w); }
                    float r[8];
#pragma unroll
                    for (int j = 0; j < 8; ++j) { const float a = j < 4 ? acc[ai][bj][m][0][j] : acc[ai][bj][m][1][j - 4]; r[j] = pv[j] + a * __builtin_amdgcn_rcpf(1.f + __expf(-gv[j])); }
                    wv[bj].x = cvt_pk_bf16(r[0], r[1]); wv[bj].y = cvt_pk_bf16(r[2], r[3]); wv[bj].z = cvt_pk_bf16(r[4], r[5]); wv[bj].w = cvt_pk_bf16(r[6], r[7]); }
                stage_store16x64(wid, fr, fq, wv[0], wv[1], M + (size_t)rg * 1024 + col0, 1024); }
        }
    }
};
template <bool IN_F32> struct EpiRes {
    static constexpr bool PERM = true, AFTER_DRAIN = false, COL64 = true;
    const float* xin_f; const bf16_t* xin_b; bf16_t* xb; float* SS;
    __device__ __forceinline__ void operator()(const f32x4 (&acc)[2][2][4][2], const Unit& u, int wr, int wc, int fr_in, int fq_in) const {
        int lane_ = fr_in + 16 * fq_in; asm volatile("" : "+v"(lane_));
        const int fr = lane_ & 15, fq = lane_ >> 4;
        const int row0 = u.pm * BM + wr * 64, col0 = u.pn * BM + wc * 64, wid = wr * 4 + wc;
#pragma unroll
        for (int ab = 0; ab < 4; ++ab) { const int ai = ab >> 1, mb = (ab & 1) * 2;
            f32x4 xl[4][2][2];
#pragma unroll
            for (int m = mb; m < mb + 2; ++m)
#pragma unroll
                for (int bj = 0; bj < 2; ++bj) { const size_t o = (size_t)(row0 + ai * HALF + m * 16 + fr) * 1024 + col0 + 8 * fq + bj * 32;
                    if (IN_F32) { xl[m][bj][0] = *(const f32x4*)(xin_f + o); xl[m][bj][1] = *(const f32x4*)(xin_f + o + 4); }
                    else { const u32x4 p = *(const u32x4*)(xin_b + o); xl[m][bj][0] = (f32x4){bfl(p.x), bfh(p.x), bfl(p.y), bfh(p.y)}; xl[m][bj][1] = (f32x4){bfl(p.z), bfh(p.z), bfl(p.w), bfh(p.w)}; } }
            float sv[4];
#pragma unroll
            for (int m = mb; m < mb + 2; ++m) { const int rg = row0 + ai * HALF + m * 16; float s = 0.f;
                u32x4 wv[2];
#pragma unroll
                for (int bj = 0; bj < 2; ++bj) { const u32x4 w = pack8(xl[m][bj][0] + acc[ai][bj][m][0], xl[m][bj][1] + acc[ai][bj][m][1]); wv[bj] = w;
                    const float r0 = bfl(w.x), r1 = bfh(w.x), r2 = bfl(w.y), r3 = bfh(w.y), r4 = bfl(w.z), r5 = bfh(w.z), r6 = bfl(w.w), r7 = bfh(w.w);
                    s += (r0 * r0 + r1 * r1) + (r2 * r2 + r3 * r3) + (r4 * r4 + r5 * r5) + (r6 * r6 + r7 * r7); }
                stage_store16x64(wid, fr, fq, wv[0], wv[1], xb + (size_t)rg * 1024 + col0, 1024);
                s += __shfl_xor(s, 16); s += __shfl_xor(s, 32); sv[m] = s; }
#pragma unroll
            for (int m = mb; m < mb + 2; ++m) if (fq == 0) SS[(size_t)(row0 + ai * HALF + m * 16 + fr) * 16 + u.pn * 4 + wc] = sv[m];
        }
    }
};
struct EpiScale {
    static constexpr bool PERM = true, AFTER_DRAIN = false, COL64 = true;
    const float* rstd; bf16_t* O; int ldc;
    __device__ __forceinline__ void operator()(const f32x4 (&acc)[2][2][4][2], const Unit& u, int wr, int wc, int fr_in, int fq_in) const {
        int lane_ = fr_in + 16 * fq_in; asm volatile("" : "+v"(lane_));
        const int fr = lane_ & 15, fq = lane_ >> 4;
        const int row0 = u.pm * BM + wr * 64, col0 = u.pn * BM + wc * 64, wid = wr * 4 + wc;
        float rsv[2][4];
#pragma unroll
        for (int ai = 0; ai < 2; ++ai)
#pragma unroll
            for (int m = 0; m < 4; ++m) rsv[ai][m] = rstd[row0 + ai * HALF + m * 16 + fr];
#pragma unroll
        for (int ai = 0; ai < 2; ++ai)
#pragma unroll
            for (int m = 0; m < 4; ++m) { const int rg = row0 + ai * HALF + m * 16; const float rs = rsv[ai][m];
                stage_store16x64(wid, fr, fq, pack8(acc[ai][0][m][0] * rs, acc[ai][0][m][1] * rs), pack8(acc[ai][1][m][0] * rs, acc[ai][1][m][1] * rs), O + (size_t)rg * ldc + col0, ldc); }
    }
};
template <class Epi, class Sched, bool ALIGN_EPI = false, bool SP2 = false>
__device__ __forceinline__ void gemm_phase(PG8_LAS unsigned char* lds, const Gemm g, const Sched& S, const Epi& E) {
    const int tid = threadIdx.x, wid = __builtin_amdgcn_readfirstlane(tid >> 6), lane = tid & 63, wr = wid >> 2, wc = wid & 3, fr = lane & 15, fq = lane >> 4;
    const int K = g.K, nt = K / BK;
    unsigned voffA[2], voffB[2];
#pragma unroll
    for (int i = 0; i < 2; ++i) { int R, C; stage_rc(tid * 16 + i * 8192, R, C); const int Rb = Epi::PERM ? ((Epi::COL64 ? 2 * (R & ~31) : (R & ~31)) + perm32(R & 31)) : R;
        voffA[i] = (unsigned)(R * K + C) * 2u; voffB[i] = (unsigned)(Rb * K + C) * 2u; }
    const size_t kstep = (size_t)(BK * 2);
    const size_t hstep = (size_t)HALF * K * 2;
    const size_t bhstep = Epi::COL64 ? (size_t)32 * K * 2 : hstep;
    const size_t tstep = 2 * hstep;
    const unsigned ldsw = (unsigned)wid * 1024u;
    const int aoff = lds_byte(wr * 64 + fr, fq * 8), boff = lds_byte(wc * 32 + fr, fq * 8);
#define PG8_SA(b, h) (((b) * 2 + (h)) * HTB)
#define PG8_SB(b, h) ((4 + (b) * 2 + (h)) * HTB)
#define PG8_STAGE(bufoff, gbase, voff) do { _Pragma("unroll") for (int _i = 0; _i < 2; ++_i) \
        __builtin_amdgcn_global_load_lds((const unsigned*)((const char*)(gbase) + (voff)[_i]), (PG8_LAS unsigned*)(lds + (bufoff) + ldsw + _i * 8192), 16, 0, 0); } while (0)
#define PG8_LDA(dst, b, h) do { _Pragma("unroll") for (int m = 0; m < 4; ++m) _Pragma("unroll") for (int k = 0; k < 2; ++k) dst[m][k] = *(const PG8_LAS bf16x8*)(lds + PG8_SA(b, h) + aoff + m * 2048 + k * 1024); } while (0)
#define PG8_LDB(dst, b, h) do { _Pragma("unroll") for (int n = 0; n < 2; ++n) _Pragma("unroll") for (int k = 0; k < 2; ++k) dst[n][k] = *(const PG8_LAS bf16x8*)(lds + PG8_SB(b, h) + boff + n * 2048 + k * 1024); } while (0)
#define PG8_MMA(ai, bj, At, Bt) do { __builtin_amdgcn_s_setprio(1); _Pragma("unroll") for (int m = 0; m < 4; ++m) _Pragma("unroll") for (int n = 0; n < 2; ++n) _Pragma("unroll") for (int k = 0; k < 2; ++k) \
        acc[ai][bj][m][n] = __builtin_amdgcn_mfma_f32_16x16x32_bf16(Bt[n][k], At[m][k], acc[ai][bj][m][n], 0, 0, 0); __builtin_amdgcn_s_setprio(0); } while (0)
#define PG8_WAIT_V(n) asm volatile("s_waitcnt vmcnt(" #n ")" ::: "memory")
#define PG8_WAIT_L(n) asm volatile("s_waitcnt lgkmcnt(" #n ")" ::: "memory")
#define PG8_BAR __builtin_amdgcn_s_barrier()
#define PG8_SCHED __builtin_amdgcn_sched_barrier(0)
    Unit cur, nxt; int ui = 0;
    if (!S.next(0, cur)) return;
    f32x4 acc[2][2][4][2];
#pragma unroll
    for (int a = 0; a < 2; ++a)
#pragma unroll
        for (int b = 0; b < 2; ++b)
#pragma unroll
            for (int m = 0; m < 4; ++m)
#pragma unroll
                for (int n = 0; n < 2; ++n) acc[a][b][m][n] = (f32x4){0.f, 0.f, 0.f, 0.f};
    bf16x8 At[4][2], B0[2][2], B1[2][2];
    const char* cA = (const char*)g.A + (size_t)cur.pm * tstep; const char* cB = (const char*)g.Bt + (size_t)cur.pn * tstep;
    S.a_ready(cur);
    if constexpr (SP2) {
        PG8_STAGE(PG8_SB(0, 0), cB, voffB); PG8_STAGE(PG8_SB(0, 1), cB + bhstep, voffB); PG8_STAGE(PG8_SA(0, 0), cA, voffA); PG8_STAGE(PG8_SA(0, 1), cA + hstep, voffA);
        if (wr == 1) PG8_BAR;
        PG8_WAIT_V(2); PG8_BAR;
        PG8_STAGE(PG8_SB(1, 0), cB + kstep, voffB); PG8_STAGE(PG8_SA(1, 0), cA + kstep, voffA); PG8_STAGE(PG8_SB(1, 1), cB + bhstep + kstep, voffB);
        PG8_WAIT_V(6); PG8_BAR;
    } else {
        PG8_STAGE(PG8_SB(0, 0), cB, voffB); PG8_STAGE(PG8_SA(0, 0), cA, voffA); PG8_STAGE(PG8_SB(0, 1), cB + bhstep, voffB); PG8_STAGE(PG8_SA(0, 1), cA + hstep, voffA);
        if (wr == 1) PG8_BAR;
        PG8_WAIT_V(4); PG8_BAR;
        PG8_STAGE(PG8_SB(1, 0), cB + kstep, voffB); PG8_STAGE(PG8_SA(1, 0), cA + kstep, voffA); PG8_STAGE(PG8_SB(1, 1), cB + bhstep + kstep, voffB);
        PG8_WAIT_V(6); PG8_BAR;
    }
    for (;;) {
        const bool has_next = S.next(ui + 1, nxt);
        const char* nA = has_next ? (const char*)g.A + (size_t)nxt.pm * tstep : cA; const char* nB = has_next ? (const char*)g.Bt + (size_t)nxt.pn * tstep : cB;
        for (int t = 0; t < nt; t += 2) {
            const bool last = (t == nt - 2);
            const char* a1 = cA + (size_t)(t + 1) * kstep;
            const char* a2 = last ? nA : cA + (size_t)(t + 2) * kstep; const char* b2 = last ? nB : cB + (size_t)(t + 2) * kstep;
            const char* a3 = a2 + kstep; const char* b3 = b2 + kstep;
            if (last && has_next) S.a_ready(nxt);
            if constexpr (SP2) {
            PG8_LDB(B0, 0, 0); PG8_LDB(B1, 0, 1); PG8_SCHED; PG8_LDA(At, 0, 0); PG8_STAGE(PG8_SA(1, 1), a1 + hstep, voffA);
            PG8_WAIT_V(8); PG8_WAIT_L(0); PG8_BAR; PG8_MMA(0, 0, At, B0); PG8_MMA(0, 1, At, B1); PG8_BAR; PG8_SCHED;
            PG8_LDA(At, 0, 1); PG8_STAGE(PG8_SB(0, 0), b2, voffB); PG8_STAGE(PG8_SB(0, 1), b2 + bhstep, voffB); PG8_STAGE(PG8_SA(0, 0), a2, voffA);
            PG8_WAIT_V(8); PG8_WAIT_L(0); PG8_BAR; PG8_MMA(1, 0, At, B0); PG8_MMA(1, 1, At, B1); PG8_BAR; PG8_SCHED;
            PG8_LDB(B0, 1, 0); PG8_LDB(B1, 1, 1); PG8_SCHED; PG8_LDA(At, 1, 0); PG8_STAGE(PG8_SA(0, 1), a2 + hstep, voffA);
            PG8_WAIT_V(8); PG8_WAIT_L(0); PG8_BAR; PG8_MMA(0, 0, At, B0); PG8_MMA(0, 1, At, B1); PG8_BAR; PG8_SCHED;
            PG8_LDA(At, 1, 1); PG8_STAGE(PG8_SB(1, 0), b3, voffB); PG8_STAGE(PG8_SB(1, 1), b3 + bhstep, voffB); PG8_STAGE(PG8_SA(1, 0), a3, voffA);
            PG8_WAIT_V(8); PG8_WAIT_L(0); PG8_BAR; PG8_MMA(1, 0, At, B0); PG8_MMA(1, 1, At, B1); PG8_BAR; PG8_SCHED;
            } else {
            PG8_LDB(B0, 0, 0); PG8_SCHED; PG8_LDA(At, 0, 0); PG8_STAGE(PG8_SA(1, 1), a1 + hstep, voffA);
            PG8_WAIT_L(8); PG8_BAR; PG8_WAIT_L(0); PG8_MMA(0, 0, At, B0); PG8_BAR; PG8_SCHED;
            PG8_LDB(B1, 0, 1); PG8_STAGE(PG8_SB(0, 0), b2, voffB);
            PG8_BAR; PG8_WAIT_L(0); PG8_MMA(0, 1, At, B1); PG8_BAR;
            PG8_LDA(At, 0, 1); PG8_STAGE(PG8_SA(0, 0), a2, voffA);
            PG8_BAR; PG8_WAIT_L(0); PG8_MMA(1, 0, At, B0); PG8_BAR; PG8_SCHED;
            PG8_STAGE(PG8_SB(0, 1), b2 + bhstep, voffB);
            PG8_WAIT_V(6); PG8_BAR; PG8_MMA(1, 1, At, B1); PG8_BAR;
            PG8_LDB(B0, 1, 0); PG8_SCHED; PG8_LDA(At, 1, 0); PG8_STAGE(PG8_SA(0, 1), a2 + hstep, voffA);
            PG8_WAIT_L(8); PG8_BAR; PG8_WAIT_L(0); PG8_MMA(0, 0, At, B0); PG8_BAR; PG8_SCHED;
            PG8_LDB(B1, 1, 1); PG8_STAGE(PG8_SB(1, 0), b3, voffB);
            PG8_BAR; PG8_WAIT_L(0); PG8_MMA(0, 1, At, B1); PG8_BAR;
            PG8_LDA(At, 1, 1); PG8_STAGE(PG8_SA(1, 0), a3, voffA);
            PG8_BAR; PG8_WAIT_L(0); PG8_MMA(1, 0, At, B0); PG8_BAR; PG8_SCHED;
            PG8_STAGE(PG8_SB(1, 1), b3 + bhstep, voffB);
            PG8_WAIT_V(6); PG8_BAR; PG8_MMA(1, 1, At, B1); PG8_BAR;
            }
        }
        if constexpr (ALIGN_EPI) { if (wr == 0) PG8_BAR; }
        if constexpr (!Epi::AFTER_DRAIN) { E(acc, cur, wr, wc, fr, fq); S.done(cur); }
        if (!has_next) break;
#pragma unroll
        for (int a = 0; a < 2; ++a)
#pragma unroll
            for (int b = 0; b < 2; ++b)
#pragma unroll
                for (int m = 0; m < 4; ++m)
#pragma unroll
                    for (int n = 0; n < 2; ++n) acc[a][b][m][n] = (f32x4){0.f, 0.f, 0.f, 0.f};
        cur = nxt; cA = nA; cB = nB; ++ui;
        if constexpr (ALIGN_EPI) { if (wr == 1) PG8_BAR; }
    }
    PG8_WAIT_V(0);
    if constexpr (!ALIGN_EPI) { if (wr == 0) PG8_BAR; }
    PG8_BAR;
    if constexpr (Epi::AFTER_DRAIN) { E.fused(acc, cur, wr, wc, fr, fq, lds, wid, lane); S.done(cur); }
#undef PG8_SA
#undef PG8_SB
#undef PG8_STAGE
#undef PG8_LDA
#undef PG8_LDB
#undef PG8_MMA
#undef PG8_WAIT_V
#undef PG8_WAIT_L
#undef PG8_BAR
#undef PG8_SCHED
}
}
#define GAS __attribute__((address_space(1)))
#define LAS __attribute__((address_space(3)))
typedef unsigned short bf16;
typedef unsigned v4u __attribute__((ext_vector_type(4)));
typedef float f32x4 __attribute__((ext_vector_type(4)));
typedef short bf16x8 __attribute__((ext_vector_type(8)));
typedef GAS unsigned gu32;
typedef GAS unsigned long long gu64;
#define RLX_AGENT __ATOMIC_RELAXED, __HIP_MEMORY_SCOPE_AGENT
#define LDS_WAIT() asm volatile("s_waitcnt lgkmcnt(0)" ::: "memory")
#define VM_WAIT() asm volatile("s_waitcnt vmcnt(0)" ::: "memory")
__device__ __forceinline__ unsigned long long rt() { return __builtin_amdgcn_s_memrealtime(); }
__device__ __forceinline__ unsigned pk2(float lo, float hi) { return (unsigned)f2bf(lo) | ((unsigned)f2bf(hi) << 16); }

#define XB_TMO      128
#define XB_XCNT(j)  (256  + 64 * (j))
#define XB_XSUB(j)  (1280 + 64 * (j))
#define XB_XGEN(j)  (2304 + 64 * (j))
#define XB_TOP      3328
#define XB_TOPGEN   3392
#define XCD_BAR_WORDS 3456
#define XB_SPIN_CAP (1u << 18)

__device__ __forceinline__ unsigned xb_ld(unsigned* p)              { return __hip_atomic_load(p, __ATOMIC_RELAXED, __HIP_MEMORY_SCOPE_AGENT); }
__device__ __forceinline__ unsigned xb_add(unsigned* p, unsigned v) { return __hip_atomic_fetch_add(p, v, __ATOMIC_RELAXED, __HIP_MEMORY_SCOPE_AGENT); }
__device__ __forceinline__ unsigned xb_xcc_id() { return (unsigned)__builtin_amdgcn_s_getreg((3 << 11) | 20) & 0xFu; }
#define XB_SPIN(cond, bar) do { unsigned _sp = 0; while (cond) { __builtin_amdgcn_s_sleep(1); \
    if ((++_sp & 255u) == 0u) { if (xb_ld(&(bar)[XB_TMO])) break; if (_sp > XB_SPIN_CAP) { atomicAdd(&(bar)[XB_TMO], 1u); break; } } } } while (0)

struct XcdBarrier {
    unsigned* bar; unsigned x;
    volatile LAS unsigned* st;
};

__device__ __forceinline__ XcdBarrier xcd_barrier_post(unsigned* bar, volatile LAS unsigned* st) {
    XcdBarrier b; b.bar = bar; b.x = xb_xcc_id(); b.st = st;
    if (threadIdx.x == 0) (void)xb_add(&bar[XB_XCNT(b.x)], 1u);
    return b;
}
__device__ __forceinline__ void xcd_barrier_complete(unsigned* bar, unsigned x, unsigned& nloc, unsigned& nx) {
    const unsigned G = gridDim.x * gridDim.y * gridDim.z;
    unsigned sum, cnt, mine, sp = 0u;
    for (;;) {
        sum = 0u; cnt = 0u; mine = 0u;
#pragma unroll
        for (unsigned j = 0; j < 16; ++j) { const unsigned c = xb_ld(&bar[XB_XCNT(j)]); sum += c; cnt += (c > 0u) ? 1u : 0u; mine = (j == x) ? c : mine; }
        if (sum == G) break;
        __builtin_amdgcn_s_sleep(1);
        if ((++sp & 255u) == 0u) { if (xb_ld(&bar[XB_TMO])) break; if (sp > XB_SPIN_CAP) { atomicAdd(&bar[XB_TMO], 1u); break; } }
    }
    nloc = mine > 0u ? mine : 1u; nx = cnt > 0u ? cnt : 1u;
}

__device__ __forceinline__ void xcd_barrier(const XcdBarrier& b) {
    asm volatile("s_waitcnt vmcnt(0)" ::: "memory");
    __syncthreads();
    if (threadIdx.x == 0) {
        unsigned* bar = b.bar;
        __builtin_amdgcn_s_waitcnt(0);
        unsigned nloc = b.st[0], nx = b.st[1];
        if (nloc == 0u) { xcd_barrier_complete(bar, b.x, nloc, nx); b.st[0] = nloc; b.st[1] = nx; }
        const unsigned old = xb_add(&bar[XB_XSUB(b.x)], 1u);
        const unsigned gen = old / nloc;
        if (old + 1u == (gen + 1u) * nloc) {
            __builtin_amdgcn_fence(__ATOMIC_RELEASE, "agent");
            asm volatile("s_waitcnt vmcnt(0)" ::: "memory");
            const unsigned og = xb_add(&bar[XB_TOP], 1u);
            const unsigned tg = og / nx;
            if (og + 1u == (tg + 1u) * nx) xb_add(&bar[XB_TOPGEN], 1u);
            else XB_SPIN(xb_ld(&bar[XB_TOPGEN]) == tg, bar);
            __builtin_amdgcn_fence(__ATOMIC_ACQUIRE, "agent");
            xb_add(&bar[XB_XGEN(b.x)], 1u);
            asm volatile("s_waitcnt vmcnt(0)" ::: "memory");
        } else {
            XB_SPIN(xb_ld(&bar[XB_XGEN(b.x)]) == gen, bar);
            __builtin_amdgcn_fence(__ATOMIC_ACQUIRE, "agent");
            asm volatile("s_waitcnt vmcnt(0)" ::: "memory");
        }
    }
    __syncthreads();
}
constexpr size_t KiB = 1024;
constexpr size_t WS_CTL = 0, CTL_ZERO_BYTES = 1 * MiB;
constexpr size_t WS_WIN = 1 * MiB, WS_WSB = 12 * MiB, WS_WGDN = 13 * MiB, WS_WMIX = 14 * MiB, WS_WCQ = 16 * MiB, WS_WCO = 18 * MiB, WS_WCKV = 20 * MiB, WS_WPQ = 24 * MiB, WS_SKB = 28 * MiB, WS_U16 = 30 * MiB, WS_V16 = 62 * MiB;
constexpr size_t WS_RSTD0 = 94 * MiB, WS_RSTD2 = 94 * MiB + 256 * KiB, WS_CD = 94 * MiB + 384 * KiB, WS_GB = 94 * MiB + 512 * KiB;
constexpr size_t WS_MN = 96 * MiB, WS_KC = 98 * MiB, WS_VC = 100 * MiB, WS_SS = 102 * MiB;
constexpr size_t WS_A0 = 104 * MiB;
constexpr size_t WS_NW = 104 * MiB, WS_QD = 136 * MiB;
constexpr size_t WS_A1 = 168 * MiB;
constexpr size_t WS_ORAW = 168 * MiB, WS_OSS = 200 * MiB, WS_OG = 232 * MiB;
constexpr size_t WS_GZ = 264 * MiB;
constexpr size_t WS_GSB = 296 * MiB, WS_GGDN = 360 * MiB;
constexpr size_t WS_KDT = 424 * MiB, WS_QK = 456 * MiB, WS_UT = 472 * MiB;
constexpr size_t WS_U8 = 30 * MiB, WS_V8 = 46 * MiB, WS_SUV = 62 * MiB;
constexpr size_t WS_PART = 344 * MiB;
constexpr size_t WS_END = 512 * MiB;
constexpr int CW_SUB = 12288;
constexpr int CW_BAR = 4096;

constexpr int NWAVES = 8;
constexpr int RING_BYTES = 131072, LDSCTL_OFF = RING_BYTES, MISC_OFF = LDSCTL_OFF + 320, LDS_BYTES = 149504;

struct Args {
    const float *x, *mem, *g_mix, *w_in, *gdn_conv, *a_log, *dt_bias, *gdn_norm_g, *w_sb_up, *w_gdn_up, *w_mix_out, *g_cross, *g_mem, *w_cq, *w_ckv, *w_co, *g_peer, *w_pq, *subkeys, *peer_u, *peer_v, *g_final;
    float* out; unsigned char* ws; int ph_lo, ph_hi, bar_region, pad;
};

struct Frame {
    LAS unsigned char* lds; int tid, lane, wave, vcu, G;
};


typedef short bf16x8_t __attribute__((ext_vector_type(8)));
typedef float f32x16_t __attribute__((ext_vector_type(16)));
typedef short v4i16_t __attribute__((ext_vector_type(4)));
typedef float f32x2v_t __attribute__((ext_vector_type(2))); typedef __bf16 bf16x2v_t __attribute__((ext_vector_type(2)));
__device__ __forceinline__ unsigned cvtpk(float lo, float hi) { f32x2v_t v = {lo, hi}; bf16x2v_t b = __builtin_convertvector(v, bf16x2v_t); return __builtin_bit_cast(unsigned, b); }
__device__ __forceinline__ v4i16_t lds_tr16(LAS unsigned char* p) { return __builtin_amdgcn_ds_read_tr16_b64_v4i16((LAS v4i16_t*)p); }

__device__ __forceinline__ void sb_phase(LAS unsigned char* wlds  , const bf16_t* SBQ, const bf16_t* SBK, const bf16_t* SBV, bf16_t* OSB, int gw, int ngw, int lane) {
    const int q = lane & 31, hi = lane >> 5;
    bf16x8_t Mf[2];
#pragma unroll
    for (int s = 0; s < 2; ++s)
#pragma unroll
        for (int j = 0; j < 8; ++j) { const int k = 16 * s + 8 * (j >> 2) + 4 * hi + (j & 3); Mf[s][j] = (k > q) ? (short)0x3F80 : (short)0; }
    const int vrow = lane >> 3, vch = lane & 7;
    const int g4 = lane >> 4, qq = (lane >> 2) & 3, p4 = lane & 3;
    LAS unsigned char* trb = wlds + (4 * (g4 >> 1) + qq) * 192 + ((g4 & 1) * 16 + 4 * p4) * 2;
    for (int item = gw; item < 32 * 256; item += ngw) {
        const int bh = item >> 8, qt = item & 255, b = bh >> 3, h = bh & 7;
        const size_t base = (size_t)b * SEQ;
        const bf16_t* Qp = SBQ + (base + qt * 32 + q) * 512 + h * 64 + 8 * hi;
        bf16x8_t Qf[4];
#pragma unroll
        for (int ks = 0; ks < 4; ++ks) Qf[ks] = *(const bf16x8_t*)(Qp + 16 * ks);
        f32x16_t o0 = {}, o1 = {};
        float carry = 0.f;
        bf16x8_t Kn[4]; v4u vn[4];
        {   const bf16_t* Kp = SBK + (base + qt * 32 + q) * 512 + h * 64 + 8 * hi;
#pragma unroll
            for (int ks = 0; ks < 4; ++ks) Kn[ks] = *(const bf16x8_t*)(Kp + 16 * ks);
#pragma unroll
            for (int i = 0; i < 4; ++i) vn[i] = *(const v4u*)(SBV + (base + qt * 32 + vrow + 8 * i) * 512 + h * 64 + vch * 8); }
        for (int kb = qt; kb >= 0; --kb) {
            bf16x8_t Kf[4]; v4u vv[4];
#pragma unroll
            for (int ks = 0; ks < 4; ++ks) Kf[ks] = Kn[ks];
#pragma unroll
            for (int i = 0; i < 4; ++i) vv[i] = vn[i];
            {   const int kn = kb > 0 ? kb - 1 : 0;
                const bf16_t* Kp = SBK + (base + kn * 32 + q) * 512 + h * 64 + 8 * hi;
#pragma unroll
                for (int ks = 0; ks < 4; ++ks) Kn[ks] = *(const bf16x8_t*)(Kp + 16 * ks);
#pragma unroll
                for (int i = 0; i < 4; ++i) vn[i] = *(const v4u*)(SBV + (base + kn * 32 + vrow + 8 * i) * 512 + h * 64 + vch * 8); }
            f32x16_t st = {};
#pragma unroll
            for (int ks = 0; ks < 4; ++ks) st = __builtin_amdgcn_mfma_f32_32x32x16_bf16(Kf[ks], Qf[ks], st, 0, 0, 0);
#pragma unroll
            for (int i = 0; i < 4; ++i) *(LAS v4u*)(wlds + (vrow + 8 * i) * 192 + vch * 16) = vv[i];
            const bool diag = (kb == qt);
            float z[16], lk[16];
#pragma unroll
            for (int r = 0; r < 16; ++r) {
                const int key = (r & 3) + 8 * (r >> 2) + 4 * hi;
                z[r] = st[r] * 0.125f;
                const float sp = fmaxf(z[r], 0.f) + __logf(1.f + __expf(-fabsf(z[r])));
                const bool valid = !diag || key < q;
                lk[r] = valid ? -sp : 0.f;
                z[r] = valid ? z[r] - sp : -INFINITY;
            }
            bf16x8_t lh[2], ll[2];
#pragma unroll
            for (int s = 0; s < 2; ++s) {
                unsigned wh[4], wl[4];
#pragma unroll
                for (int jj = 0; jj < 4; ++jj) { const float a = lk[8 * s + 2 * jj], c = lk[8 * s + 2 * jj + 1]; wh[jj] = cvtpk(a, c);
                    wl[jj] = cvtpk(a - __uint_as_float(wh[jj] << 16), c - __uint_as_float(wh[jj] & 0xffff0000u)); }
                lh[s] = __builtin_bit_cast(bf16x8_t, (v4u){wh[0], wh[1], wh[2], wh[3]}); ll[s] = __builtin_bit_cast(bf16x8_t, (v4u){wl[0], wl[1], wl[2], wl[3]});
            }
            f32x16_t af;
#pragma unroll
            for (int r = 0; r < 16; ++r) af[r] = carry;
            af = __builtin_amdgcn_mfma_f32_32x32x16_bf16(Mf[0], lh[0], af, 0, 0, 0);
            af = __builtin_amdgcn_mfma_f32_32x32x16_bf16(Mf[1], lh[1], af, 0, 0, 0);
            af = __builtin_amdgcn_mfma_f32_32x32x16_bf16(Mf[0], ll[0], af, 0, 0, 0);
            af = __builtin_amdgcn_mfma_f32_32x32x16_bf16(Mf[1], ll[1], af, 0, 0, 0);
            float tot = af[0] + lk[0];
            tot = __shfl(tot, q);
            float pr[16];
#pragma unroll
            for (int r = 0; r < 16; ++r) pr[r] = __expf(z[r] + af[r]);
            bf16x8_t pa[2];
#pragma unroll
            for (int s = 0; s < 2; ++s) pa[s] = __builtin_bit_cast(bf16x8_t, (v4u){cvtpk(pr[8 * s], pr[8 * s + 1]), cvtpk(pr[8 * s + 2], pr[8 * s + 3]), cvtpk(pr[8 * s + 4], pr[8 * s + 5]), cvtpk(pr[8 * s + 6], pr[8 * s + 7])});
            asm volatile("s_waitcnt lgkmcnt(0)" ::: "memory");
#pragma unroll
            for (int s = 0; s < 2; ++s) {
                const v4i16_t a0 = lds_tr16(trb + (16 * s) * 192), a1 = lds_tr16(trb + (16 * s + 8) * 192);
                const v4i16_t c0 = lds_tr16(trb + (16 * s) * 192 + 64), c1 = lds_tr16(trb + (16 * s + 8) * 192 + 64);
                const bf16x8_t vb0 = {a0[0], a0[1], a0[2], a0[3], a1[0], a1[1], a1[2], a1[3]}, vb1 = {c0[0], c0[1], c0[2], c0[3], c1[0], c1[1], c1[2], c1[3]};
                o0 = __builtin_amdgcn_mfma_f32_32x32x16_bf16(pa[s], vb0, o0, 0, 0, 0);
                o1 = __builtin_amdgcn_mfma_f32_32x32x16_bf16(pa[s], vb1, o1, 0, 0, 0);
            }
            carry = tot;
            if (__all(carry < -104.f)) break;
        }
        bf16_t* Op = OSB + (base + qt * 32) * 512 + h * 64 + q;
#pragma unroll
        for (int r = 0; r < 16; ++r) { const int row = (r & 3) + 8 * (r >> 2) + 4 * hi; Op[(size_t)row * 512] = f2bf(o0[r]); Op[(size_t)row * 512 + 32] = f2bf(o1[r]); }
    }
}
typedef float f32x4_t __attribute__((ext_vector_type(4)));
typedef unsigned v2u __attribute__((ext_vector_type(2)));
__device__ __forceinline__ float bflo(unsigned w) { return __uint_as_float(w << 16); }
__device__ __forceinline__ float bfhi(unsigned w) { return __uint_as_float(w & 0xffff0000u); }
__device__ __forceinline__ int frag_off(int r, int k0, int KS) { return (((r >> 4) * KS + (k0 >> 5)) << 9) + (((r & 15) + 16 * ((k0 & 15) >> 2)) << 3) + (((k0 & 31) >> 4) << 2); }

constexpr int GP_KS = 0, GP_QS = 17408, GP_VS = 34816, GP_AS = 52224, GP_WT = 69632, GP_GC = 87040, GP_BETA = 87296, GP_EGC = 87552, GP_CW = 88064, GP_TS = 94208;
constexpr int GROW = 136;

#define LDS_BARRIER() do { asm volatile("s_waitcnt lgkmcnt(0)" ::: "memory"); __builtin_amdgcn_s_barrier(); asm volatile("" ::: "memory"); } while (0)
struct GdnBufs { bf16_t *NW, *QD, *KDT, *QK, *UT; float* CD; bf16_t* ORAW; float* OSS; };

__device__ __forceinline__ void gdn_prep_phase(Frame& F, const Args& a, const bf16_t* GQKV, const float* GB, const float* GA, const GdnBufs& Gb) {
    LAS unsigned char* L = F.lds;
    LAS bf16_t* KS = (LAS bf16_t*)(L + GP_KS); LAS bf16_t* QS = (LAS bf16_t*)(L + GP_QS); LAS bf16_t* VS = (LAS bf16_t*)(L + GP_VS); LAS bf16_t* WT = (LAS bf16_t*)(L + GP_WT);
    LAS float* AS = (LAS float*)(L + GP_AS); LAS float* GC = (LAS float*)(L + GP_GC); LAS float* BETA = (LAS float*)(L + GP_BETA); LAS float* EGC = (LAS float*)(L + GP_EGC); LAS float* CW = (LAS float*)(L + GP_CW); LAS float* TS = (LAS float*)(L + GP_TS);
    const int tid = F.tid, lane = F.lane, wave = F.wave;
    const int per = (2048 + F.G - 1) / F.G;
    int hcur = -1;
    for (int ii = 0; ii < per; ++ii) {
        const int item = F.vcu * per + ii; if (item >= 2048) break;
        const int bh = item >> 7, n = item & 127, b = bh >> 2, h = bh & 3;
        const size_t t0 = (size_t)b * SEQ + n * 64;
        if (h != hcur) { hcur = h; for (int i = tid; i < 1536; i += NWAVES * 64) { const int j = i / 384, cc = i % 384; CW[i] = a.gdn_conv[j * 1536 + (cc >> 7) * 512 + h * 128 + (cc & 127)]; } }
        unsigned pf = 0u;
        if (ii + 1 < per && item + 1 < 2048 && tid < 384) {
            const int r = tid / 6, q6 = tid % 6; const int item2 = item + 1, bh2 = item2 >> 7, n2 = item2 & 127;
            pf = *(const unsigned*)(GQKV + ((size_t)(bh2 >> 2) * SEQ + n2 * 64 + r) * 1536 + (q6 >> 1) * 512 + (bh2 & 3) * 128 + (q6 & 1) * 64);
        }
        if (wave == 0) {
            const size_t t = t0 + lane;
            float g = -__expf(a.a_log[h]) * softplusf_(GA[t * 4 + h] + a.dt_bias[h]);
#pragma unroll
            for (int o = 1; o < 64; o <<= 1) { const float up = __shfl_up(g, o); if (lane >= o) g += up; }
            GC[lane] = g; BETA[lane] = sigmoidf_(GB[t * 4 + h]); EGC[lane] = __expf(g);
            if (lane == 63) Gb.CD[item] = __expf(g);
        }
        LDS_BARRIER();
        {
            const int c = tid >> 3, d0 = (tid & 7) * 16;
#pragma unroll
            for (int part = 0; part < 3; ++part) {
                float acc[16];
#pragma unroll
                for (int i = 0; i < 16; ++i) acc[i] = 0.f;
#pragma unroll
                for (int j = 0; j < 4; ++j) {
                    if (n * 64 + c - 3 + j >= 0) {
                        const bf16_t* src = GQKV + (t0 + c - 3 + j) * 1536 + part * 512 + h * 128 + d0;
                        const v4u r0 = *(const v4u*)src, r1 = *(const v4u*)(src + 8);
                        const unsigned rw[8] = {r0.x, r0.y, r0.z, r0.w, r1.x, r1.y, r1.z, r1.w};
                        const LAS float* cw = CW + j * 384 + part * 128 + d0;
#pragma unroll
                        for (int i = 0; i < 8; ++i) { acc[2 * i] += bflo(rw[i]) * cw[2 * i]; acc[2 * i + 1] += bfhi(rw[i]) * cw[2 * i + 1]; }
                    }
                }
                float ss = 0.f;
#pragma unroll
                for (int i = 0; i < 16; ++i) { acc[i] = acc[i] / (1.f + __expf(-acc[i])); ss += acc[i] * acc[i]; }
                if (part < 2) { ss += __shfl_xor(ss, 1); ss += __shfl_xor(ss, 2); ss += __shfl_xor(ss, 4); const float inv = rsqrtf(ss + EPS);
#pragma unroll
                    for (int i = 0; i < 16; ++i) acc[i] *= inv; }
                LAS bf16_t* dst = (part == 0 ? QS : part == 1 ? KS : VS) + c * GROW + d0;
                v4u w0, w1; w0.x = cvtpk(acc[0], acc[1]); w0.y = cvtpk(acc[2], acc[3]); w0.z = cvtpk(acc[4], acc[5]); w0.w = cvtpk(acc[6], acc[7]);
                w1.x = cvtpk(acc[8], acc[9]); w1.y = cvtpk(acc[10], acc[11]); w1.z = cvtpk(acc[12], acc[13]); w1.w = cvtpk(acc[14], acc[15]);
                *(LAS v4u*)dst = w0; *(LAS v4u*)(dst + 8) = w1;
            }
        }
        LDS_BARRIER();
        {
            const int fr = lane & 15, g = lane >> 4;
            for (int task = wave; task < 26; task += NWAVES) {
                const bool isKK = task < 10; int ct, mt;
                if (isKK) { ct = task >= 6 ? 3 : task >= 3 ? 2 : task >= 1 ? 1 : 0; mt = task - ct * (ct + 1) / 2; } else { ct = (task - 10) >> 2; mt = (task - 10) & 3; }
                f32x4_t acc = {0.f, 0.f, 0.f, 0.f};
                if (mt <= ct) {
                    const LAS bf16_t* Ap = KS + (mt * 16 + fr) * GROW + 8 * g; const LAS bf16_t* Bp = (isKK ? KS : QS) + (ct * 16 + fr) * GROW + 8 * g;
#pragma unroll
                    for (int ks = 0; ks < 4; ++ks) acc = __builtin_amdgcn_mfma_f32_16x16x32_bf16(*(const LAS bf16x8_t*)(Ap + 32 * ks), *(const LAS bf16x8_t*)(Bp + 32 * ks), acc, 0, 0, 0);
                }
                const int c = ct * 16 + fr, m0 = mt * 16 + 4 * g; const float gcc = GC[c];
                float v[4];
#pragma unroll
                for (int r = 0; r < 4; ++r) { const int m = m0 + r; const float dec = __expf(fminf(gcc - GC[m], 0.f)); v[r] = acc[r] * dec; }
                if (isKK) { const float bc = BETA[c];
                    f32x4_t o;
#pragma unroll
                    for (int r = 0; r < 4; ++r) o[r] = (c > m0 + r) ? v[r] * bc : 0.f;
                    *(LAS f32x4_t*)(AS + c * 68 + m0) = o;
                } else {
#pragma unroll
                    for (int r = 0; r < 4; ++r) v[r] = (c >= m0 + r) ? v[r] * 0.08838834764831845f : 0.f;
                    v2u w; w.x = cvtpk(v[0], v[1]); w.y = cvtpk(v[2], v[3]);
                    *(v2u*)(Gb.QK + (size_t)item * 4096 + (ct * 2 + (mt >> 1)) * 512 + lane * 8 + (mt & 1) * 4) = w;
                }
            }
        }
        LDS_BARRIER();
        if (wave == 0) {
            const int q4 = lane >> 4, c = lane & 15; const LAS float* Ab = AS + (16 * q4) * 68 + 16 * q4;
            float t[16];
#pragma unroll
            for (int r = 0; r < 16; ++r) { float s = (r == c) ? 1.f : 0.f;
#pragma unroll
                for (int j4 = 0; j4 < (r + 3) / 4; ++j4) { const f32x4_t av = *(const LAS f32x4_t*)(Ab + r * 68 + 4 * j4);
#pragma unroll
                    for (int i = 0; i < 4; ++i) if (4 * j4 + i < r) s -= av[i] * t[4 * j4 + i]; }
                t[r] = s; TS[(q4 * 16 + r) * 20 + c] = (r == c) ? 0.f : s; }
        }
        LDS_BARRIER();
        {
            const int fr = lane & 15, g = lane >> 4;
#pragma unroll
            for (int cc = 0; cc < 2; ++cc) {
                const int ct2 = wave * 2 + cc; const bool isW = ct2 >= 8; const int col = (ct2 & 7) * 16 + fr;
                const LAS bf16_t* src = (isW ? KS : VS) + col;
                unsigned xb[4][2];
#pragma unroll
                for (int i = 0; i < 4; ++i) {
                    f32x4_t y;
#pragma unroll
                    for (int r = 0; r < 4; ++r) { const int row = 16 * i + 4 * g + r; float v = bf2f(src[row * GROW]) * BETA[row]; if (isW) v *= EGC[row]; y[r] = v; }
#pragma unroll
                    for (int j = 0; j < i; j += 2) {
                        const LAS float* ap = AS + (16 * i + fr) * 68 + 16 * j + 4 * g;
                        const f32x4_t a0 = *(const LAS f32x4_t*)ap; f32x4_t a1 = {0.f, 0.f, 0.f, 0.f}; if (j + 1 < i) a1 = *(const LAS f32x4_t*)(ap + 16);
                        const bf16x8_t af = __builtin_bit_cast(bf16x8_t, (v4u){cvtpk(-a0[0], -a0[1]), cvtpk(-a0[2], -a0[3]), cvtpk(-a1[0], -a1[1]), cvtpk(-a1[2], -a1[3])});
                        const bf16x8_t bfr = __builtin_bit_cast(bf16x8_t, (v4u){xb[j][0], xb[j][1], (j + 1 < i) ? xb[j + 1][0] : 0u, (j + 1 < i) ? xb[j + 1][1] : 0u});
                        y = __builtin_amdgcn_mfma_f32_16x16x32_bf16(af, bfr, y, 0, 0, 0);
                    }
                    const f32x4_t tv = *(const LAS f32x4_t*)(TS + (i * 16 + fr) * 20 + 4 * g);
                    const bf16x8_t tf = __builtin_bit_cast(bf16x8_t, (v4u){cvtpk(tv[0], tv[1]), cvtpk(tv[2], tv[3]), 0u, 0u});
                    const bf16x8_t yf = __builtin_bit_cast(bf16x8_t, (v4u){cvtpk(y[0], y[1]), cvtpk(y[2], y[3]), 0u, 0u});
                    const f32x4_t x = __builtin_amdgcn_mfma_f32_16x16x32_bf16(tf, yf, y, 0, 0, 0);
                    xb[i][0] = cvtpk(x[0], x[1]); xb[i][1] = cvtpk(x[2], x[3]);
                    if (!isW) { *(v2u*)(Gb.UT + (size_t)item * 8192 + col * 64 + 16 * i + 4 * g) = (v2u){xb[i][0], xb[i][1]}; }
                    else {
#pragma unroll
                        for (int r = 0; r < 4; ++r) WT[(16 * i + 4 * g + r) * GROW + col] = f2bf(-x[r]); }
                }
            }
        }
        {
            const float glast = GC[63];
#pragma unroll
            for (int i = 0; i < 4; ++i) { const int p = tid + 512 * i, c = p >> 5, d0 = (p & 31) * 4; const v2u r = *(const LAS v2u*)(QS + c * GROW + d0); const float sc = EGC[c] * 0.08838834764831845f;
                v2u w; w.x = cvtpk(bflo(r.x) * sc, bfhi(r.x) * sc); w.y = cvtpk(bflo(r.y) * sc, bfhi(r.y) * sc);
                *(v2u*)(Gb.QD + (size_t)item * 8192 + frag_off(c, d0, 4)) = w; }
#pragma unroll
            for (int i = 0; i < 4; ++i) { const int p = tid + 512 * i, d = p >> 4, c0 = (p & 15) * 4; float v[4];
#pragma unroll
                for (int r = 0; r < 4; ++r) v[r] = bf2f(KS[(c0 + r) * GROW + d]) * __expf(glast - GC[c0 + r]);
                v2u w; w.x = cvtpk(v[0], v[1]); w.y = cvtpk(v[2], v[3]);
                *(v2u*)(Gb.KDT + (size_t)item * 8192 + frag_off(d, c0, 2)) = w; }
        }
        LDS_BARRIER();
#pragma unroll
        for (int i = 0; i < 4; ++i) { const int p = tid + 512 * i, c = p >> 5, d0 = (p & 31) * 4; const v2u r = *(const LAS v2u*)(WT + c * GROW + d0);
            *(v2u*)(Gb.NW + (size_t)item * 8192 + frag_off(c, d0, 4)) = r; }
        asm volatile("" :: "v"(pf));
        LDS_BARRIER();
    }
}

__device__ __forceinline__ void gdn_scan_unit(Frame& F, int s, const GdnBufs& Gb) {
    const int bh = s >> 2, half = s & 3, h = bh & 3, b = bh >> 2;
    const int tid = F.tid, lane = F.lane, wave = F.wave, fr = lane & 15, g = lane >> 4;
    LAS unsigned char* L = F.lds;
    const size_t tb = (size_t)b * SEQ;
    const int item0 = bh * 128;
    const int lt = tid - 256;
#define GDN_SRC(it, i) ((i) < 4 ? (const v4u*)(Gb.NW + (size_t)(it) * 8192) + lt + 256 * (i) : (i) < 8 ? (const v4u*)(Gb.QD + (size_t)(it) * 8192) + lt + 256 * ((i) - 4) : \
                        (i) < 12 ? (const v4u*)(Gb.KDT + (size_t)(it) * 8192) + lt + 256 * ((i) - 8) : (i) < 14 ? (const v4u*)(Gb.QK + (size_t)(it) * 4096) + lt + 256 * ((i) - 12) : \
                        (const v4u*)(Gb.UT + (size_t)(it) * 8192 + half * 2048) + lt + 256 * ((i) - 14))
#define GDN_LOADR(R, it) do { _Pragma("unroll") for (int i_ = 0; i_ < 15; ++i_) R[i_] = *GDN_SRC(it, i_); } while (0)
#define GDN_STORER(R, bufp) do { _Pragma("unroll") for (int i_ = 0; i_ < 15; ++i_) *(LAS v4u*)((bufp) + (i_ * 256 + lt) * 16) = R[i_]; } while (0)
    LAS float* CDL = (LAS float*)(L + 131072 + 1024);
    LAS bf16_t* OTB = (LAS bf16_t*)(L + 131072 + 2048);
#define GDN_OSTORE(step) do { if (wave < 6 && (step) < 128) { const LAS bf16_t* ot_ = OTB + ((wave - 4) * 2 + ((step) & 1)) * 1024; \
        const v4u o0_ = *(const LAS v4u*)(ot_ + lane * 16), o1_ = *(const LAS v4u*)(ot_ + lane * 16 + 8); \
        bf16_t* dst_ = Gb.ORAW + (tb + (size_t)(step) * 64 + lane) * 512 + h * 128 + half * 32 + (wave - 4) * 16; *(v4u*)dst_ = o0_; *(v4u*)(dst_ + 8) = o1_; } } while (0)
    if (wave >= 4) {
        if (wave == 4) { CDL[lane] = Gb.CD[item0 + lane]; CDL[64 + lane] = Gb.CD[item0 + 64 + lane]; }
        v4u r0[15], r1[15], r2[15];
        GDN_LOADR(r0, item0); GDN_LOADR(r1, item0 + 1); GDN_LOADR(r2, item0 + 2);
        GDN_STORER(r0, L);
        LDS_BARRIER();
#define GDN_CL(k) (item0 + ((k) < 127 ? (k) : 127))
        for (int n = 0; n < 129; n += 3) {
            GDN_LOADR(r0, GDN_CL(n + 3)); GDN_STORER(r1, L + ((n + 1) & 1) * 65536); LDS_BARRIER(); GDN_OSTORE(n);
            GDN_LOADR(r1, GDN_CL(n + 4)); GDN_STORER(r2, L + ((n + 2) & 1) * 65536); LDS_BARRIER(); GDN_OSTORE(n + 1);
            GDN_LOADR(r2, GDN_CL(n + 5)); GDN_STORER(r0, L + ((n + 3) & 1) * 65536); LDS_BARRIER(); GDN_OSTORE(n + 2);
        }
#undef GDN_CL
    } else if (wave >= 2) {
        for (int n = 0; n < 130; ++n) LDS_BARRIER();
    } else {
        LDS_BARRIER();
        f32x4_t S[8];
#pragma unroll
        for (int i = 0; i < 8; ++i) S[i] = (f32x4_t){0.f, 0.f, 0.f, 0.f};
        for (int n = 0; n < 128; ++n) {
            LAS unsigned char* B = L + (n & 1) * 65536;
            const float cd = CDL[n];
            bf16x8_t sb[4];
#pragma unroll
            for (int ks = 0; ks < 4; ++ks) sb[ks] = __builtin_bit_cast(bf16x8_t, (v4u){cvtpk(S[2 * ks][0], S[2 * ks][1]), cvtpk(S[2 * ks][2], S[2 * ks][3]), cvtpk(S[2 * ks + 1][0], S[2 * ks + 1][1]), cvtpk(S[2 * ks + 1][2], S[2 * ks + 1][3])});
#define GDN_SB() __builtin_amdgcn_sched_barrier(0)
            const LAS unsigned char* Bl = B + lane * 16;
            v2u u8[4]; bf16x8_t fa[16], fb[16];
#pragma unroll
            for (int rt = 0; rt < 4; ++rt) u8[rt] = *(const LAS v2u*)(B + 57344 + ((wave * 16 + fr) * 64 + 16 * rt + 4 * g) * 2);
#pragma unroll
            for (int i = 0; i < 16; ++i) fa[i] = *(const LAS bf16x8_t*)(Bl + ((i & 3) * 4 + (i >> 2)) * 1024);
            GDN_SB();
#pragma unroll
            for (int i = 0; i < 16; ++i) fb[i] = *(const LAS bf16x8_t*)(Bl + 16384 + ((i & 3) * 4 + (i >> 2)) * 1024);
            GDN_SB();
            f32x4_t va[4], oa[4];
#pragma unroll
            for (int rt = 0; rt < 4; ++rt) { va[rt] = (f32x4_t){bflo(u8[rt].x), bfhi(u8[rt].x), bflo(u8[rt].y), bfhi(u8[rt].y)}; oa[rt] = (f32x4_t){0.f, 0.f, 0.f, 0.f}; }
#pragma unroll
            for (int i = 0; i < 16; ++i) va[i & 3] = __builtin_amdgcn_mfma_f32_16x16x32_bf16(fa[i], sb[i >> 2], va[i & 3], 0, 0, 0);
            GDN_SB();
#pragma unroll
            for (int i = 0; i < 8; ++i) fa[i] = *(const LAS bf16x8_t*)(Bl + 49152 + ((i & 3) * 2 + (i >> 2)) * 1024);
#pragma unroll
            for (int i = 0; i < 8; ++i) fa[8 + i] = *(const LAS bf16x8_t*)(Bl + 32768 + ((i & 3) * 2 + (i >> 2)) * 1024);
            GDN_SB();
#pragma unroll
            for (int i = 0; i < 16; ++i) oa[i & 3] = __builtin_amdgcn_mfma_f32_16x16x32_bf16(fb[i], sb[i >> 2], oa[i & 3], 0, 0, 0);
            bf16x8_t vb[2];
#pragma unroll
            for (int k2 = 0; k2 < 2; ++k2) vb[k2] = __builtin_bit_cast(bf16x8_t, (v4u){cvtpk(va[2 * k2][0], va[2 * k2][1]), cvtpk(va[2 * k2][2], va[2 * k2][3]), cvtpk(va[2 * k2 + 1][0], va[2 * k2 + 1][1]), cvtpk(va[2 * k2 + 1][2], va[2 * k2 + 1][3])});
#pragma unroll
            for (int dt = 0; dt < 8; ++dt) S[dt] = S[dt] * cd;
            GDN_SB();
#pragma unroll
            for (int i = 0; i < 8; ++i) fb[i] = *(const LAS bf16x8_t*)(Bl + 32768 + 8192 + ((i & 3) * 2 + (i >> 2)) * 1024);
            GDN_SB();
#pragma unroll
            for (int i = 0; i < 8; ++i) oa[i & 3] = __builtin_amdgcn_mfma_f32_16x16x32_bf16(fa[i], vb[i >> 2], oa[i & 3], 0, 0, 0);
#pragma unroll
            for (int i = 0; i < 8; ++i) S[i & 3] = __builtin_amdgcn_mfma_f32_16x16x32_bf16(fa[8 + i], vb[i >> 2], S[i & 3], 0, 0, 0);
            GDN_SB();
#pragma unroll
            for (int i = 0; i < 8; ++i) S[4 + (i & 3)] = __builtin_amdgcn_mfma_f32_16x16x32_bf16(fb[i], vb[i >> 2], S[4 + (i & 3)], 0, 0, 0);
            GDN_SB();
#undef GDN_SB
            { LAS bf16_t* OT = OTB + (wave * 2 + (n & 1)) * 1024;
#pragma unroll
              for (int rt = 0; rt < 4; ++rt)
#pragma unroll
                for (int r = 0; r < 4; ++r) OT[(16 * rt + 4 * g + r) * 16 + fr] = f2bf(oa[rt][r]); }
            LDS_BARRIER();
        }
        LDS_BARRIER();
    }
#undef GDN_SRC
#undef GDN_LOADR
#undef GDN_OSTORE
#undef GDN_STORER
}

__device__ __forceinline__ void gdn_finish_phase(Frame& F, const Args& a, const GdnBufs& Gb, const bf16_t* GZ, bf16_t* OG) {
    const int gt = F.vcu * NWAVES * 64 + F.tid, ngt = F.G * NWAVES * 64;
    for (int p = gt; p < T * 64; p += ngt) {
        const size_t t = (size_t)(p >> 6); const int col = (p & 63) * 8, e0 = col & 127;
        const v4u o = *(const v4u*)(Gb.ORAW + t * 512 + col), z = *(const v4u*)(GZ + t * 512 + col);
        const unsigned ow[4] = {o.x, o.y, o.z, o.w}, zw[4] = {z.x, z.y, z.z, z.w};
        float ss = 0.f;
#pragma unroll
        for (int i = 0; i < 4; ++i) { const float a0 = bflo(ow[i]), a1 = bfhi(ow[i]); ss += a0 * a0 + a1 * a1; }
        ss += __shfl_xor(ss, 1); ss += __shfl_xor(ss, 2); ss += __shfl_xor(ss, 4); ss += __shfl_xor(ss, 8);
        const float rinv = rsqrtf(ss * (1.f / 128.f) + EPS);
        const f32x4_t g0 = *(const f32x4_t*)(a.gdn_norm_g + e0), g1 = *(const f32x4_t*)(a.gdn_norm_g + e0 + 4);
        const float gg[8] = {g0[0], g0[1], g0[2], g0[3], g1[0], g1[1], g1[2], g1[3]};
        unsigned r[4];
#pragma unroll
        for (int i = 0; i < 4; ++i) { const float z0 = bflo(zw[i]), z1 = bfhi(zw[i]);
            r[i] = cvtpk(bflo(ow[i]) * rinv * gg[2 * i] * (z0 / (1.f + __expf(-z0))), bfhi(ow[i]) * rinv * gg[2 * i + 1] * (z1 / (1.f + __expf(-z1)))); }
        *(v4u*)(OG + t * 512 + col) = (v4u){r[0], r[1], r[2], r[3]};
    }
}
typedef float f32x2_t __attribute__((ext_vector_type(2)));
__device__ __forceinline__ float gelu_erf(float v) { return 0.5f * v * (1.f + erff(v * 0.70710678118654752f)); }
constexpr int PEER_CH = 16;
constexpr int CW_PEERU = 8192, CW_PEERV = 8192 + 1024;

typedef int v2i_t __attribute__((ext_vector_type(2)));
#define PEER_SWZ(V, JP) __builtin_amdgcn_ds_swizzle((V), 0x18 | ((JP) << 5))
#define PEER_SHUF(EN, ER) do { EN[0] = PEER_SWZ(ER.x, 0); EN[1] = PEER_SWZ(ER.y, 0); EN[2] = PEER_SWZ(ER.x, 1); EN[3] = PEER_SWZ(ER.y, 1); EN[4] = PEER_SWZ(ER.x, 2); EN[5] = PEER_SWZ(ER.y, 2); EN[6] = PEER_SWZ(ER.x, 3); EN[7] = PEER_SWZ(ER.y, 3); EN[8] = PEER_SWZ(ER.x, 4); EN[9] = PEER_SWZ(ER.y, 4); EN[10] = PEER_SWZ(ER.x, 5); EN[11] = PEER_SWZ(ER.y, 5); EN[12] = PEER_SWZ(ER.x, 6); EN[13] = PEER_SWZ(ER.y, 6); EN[14] = PEER_SWZ(ER.x, 7); EN[15] = PEER_SWZ(ER.y, 7); } while (0)
#define PEER_LDIDX(TOK) (*(const v2i_t*)(EIDX + (size_t)(TOK) * 128 + 2 * lane))
template <int CTRL> __device__ __forceinline__ int dpp_i(int v) { return __builtin_amdgcn_update_dpp(0, v, CTRL, 0xf, 0xf, false); }
template <int CTRL> __device__ __forceinline__ float dpp_f(float v) { return __builtin_bit_cast(float, __builtin_amdgcn_update_dpp(0, __builtin_bit_cast(int, v), CTRL, 0xf, 0xf, false)); }
constexpr int DPP_X1 = 0xB1, DPP_X2 = 0x4E, DPP_HM = 0x141;
#define PEER_U_COMPUTE(W, TOK, XR0, XR1, RS) do { const size_t t_ = (TOK); \
        const unsigned xw[8] = {XR0.x, XR0.y, XR0.z, XR0.w, XR1.x, XR1.y, XR1.z, XR1.w}; float xf[16]; \
        _Pragma("unroll") for (int q = 0; q < 8; ++q) { xf[2 * q] = bflo(xw[q]); xf[2 * q + 1] = bfhi(xw[q]); } \
        float am = 0.f; \
        _Pragma("unroll") for (int q = 0; q < 16; q += 2) am = fmaxf(am, fmaxf(fabsf(xf[q]), fabsf(xf[q + 1]))); \
        am = fmaxf(am, dpp_f<DPP_X1>(am)); am = fmaxf(am, dpp_f<DPP_X2>(am)); am = fmaxf(am, dpp_f<DPP_HM>(am)); \
        const float sx = am > 0.f ? 127.f * __builtin_amdgcn_rcpf(am) : 0.f, mo = am * (1.f / 127.f) * (RS); \
        int xq[4]; \
        _Pragma("unroll") for (int d = 0; d < 4; ++d) { \
            const unsigned b0 = __builtin_bit_cast(unsigned, fmaf(xf[4 * d], sx, 12582912.f)), b1 = __builtin_bit_cast(unsigned, fmaf(xf[4 * d + 1], sx, 12582912.f)); \
            const unsigned b2 = __builtin_bit_cast(unsigned, fmaf(xf[4 * d + 2], sx, 12582912.f)), b3 = __builtin_bit_cast(unsigned, fmaf(xf[4 * d + 3], sx, 12582912.f)); \
            xq[d] = (int)(__builtin_amdgcn_perm(b1, b0, 0x0c0c0400u) | __builtin_amdgcn_perm(b3, b2, 0x04000c0cu)); } \
        int p[16]; \
        _Pragma("unroll") for (int i = 0; i < 16; ++i) { int acc = __builtin_amdgcn_sdot4((int)W[i].x, xq[0], 0, false); acc = __builtin_amdgcn_sdot4((int)W[i].y, xq[1], acc, false); \
            acc = __builtin_amdgcn_sdot4((int)W[i].z, xq[2], acc, false); p[i] = __builtin_amdgcn_sdot4((int)W[i].w, xq[3], acc, false); } \
        _Pragma("unroll") for (int i = 0; i < 8; ++i) { const int lo = p[i], hi = p[i + 8]; p[i] = (up4 ? hi : lo) + dpp_i<DPP_HM>(up4 ? lo : hi); } \
        _Pragma("unroll") for (int i = 0; i < 4; ++i) { const int lo = p[i], hi = p[i + 4]; p[i] = (up2 ? hi : lo) + dpp_i<DPP_X2>(up2 ? lo : hi); } \
        _Pragma("unroll") for (int i = 0; i < 2; ++i) { const int lo = p[i], hi = p[i + 2]; p[i] = (up1 ? hi : lo) + dpp_i<DPP_X1>(up1 ? lo : hi); } \
        *(unsigned*)(PART + ((size_t)x * T + t_) * 128 + 2 * lane) = cvtpk((float)p[0] * mo, (float)p[1] * mo); } while (0)
#define PEER_GATHER(W, EN, BASE) do { _Pragma("unroll") for (int i = 0; i < 16; ++i) W[i] = *(const v4u*)((BASE) + (unsigned)((unsigned)EN[i] * 128u + lo16)); } while (0)
__device__ __forceinline__ void peer_u_phase(Frame& F, const Args& a, gu32* ctl, const bf16_t* X2B, const float* rstd2, const int* EIDX, const unsigned char* U8, bf16_t* PART) {
    const int lane = F.lane, g = lane >> 3, j = lane & 7; const unsigned lo16 = 16u * (unsigned)j;
    const bool up4 = (j & 4) != 0, up2 = (j & 2) != 0, up1 = (j & 1) != 0;
    const int x0 = (int)(xb_xcc_id() & 7u);
    for (int s = 0; s < 8; ++s) {
        const int x = (x0 + s) & 7;
        const unsigned char* Ux = U8 + (size_t)x * 16384 * 128;
        const bf16_t* Xx = X2B + 128 * x + 16 * j;
        for (;;) {
            int c = 0; if (lane == 0) c = (int)__hip_atomic_fetch_add(ctl + CW_PEERU + 64 * x, 1u, __ATOMIC_RELAXED, __HIP_MEMORY_SCOPE_AGENT);
            c = __builtin_amdgcn_readfirstlane(c);
            if (c >= T / PEER_CH) break;
            const size_t tc = (size_t)c * PEER_CH, tl = tc + PEER_CH - 1;
            int en[16]; v4u wa[16], wb[16];
            v2i_t er = PEER_LDIDX(tc);
            v4u xa0 = *(const v4u*)(Xx + tc * 1024), xa1 = *(const v4u*)(Xx + tc * 1024 + 8), xb0, xb1; float rsa = rstd2[tc], rsb;
            PEER_SHUF(en, er);
            PEER_GATHER(wa, en, Ux);
            er = PEER_LDIDX(tc + 1);
            for (int tt = 0; tt < PEER_CH; tt += 2) {
                const size_t t = tc + tt, t2 = (t + 2 < tl) ? t + 2 : tl, t3 = (t + 3 < tl) ? t + 3 : tl;
                PEER_SHUF(en, er);
                PEER_GATHER(wb, en, Ux);
                er = PEER_LDIDX(t2);
                xb0 = *(const v4u*)(Xx + (t + 1) * 1024); xb1 = *(const v4u*)(Xx + (t + 1) * 1024 + 8); rsb = rstd2[t + 1];
                PEER_U_COMPUTE(wa, t, xa0, xa1, rsa);
                PEER_SHUF(en, er);
                PEER_GATHER(wa, en, Ux);
                er = PEER_LDIDX(t3);
                xa0 = *(const v4u*)(Xx + t2 * 1024); xa1 = *(const v4u*)(Xx + t2 * 1024 + 8); rsa = rstd2[t2];
                PEER_U_COMPUTE(wb, t + 1, xb0, xb1, rsb);
            }
        }
    }
}
__device__ __forceinline__ void peer_combine_phase(Frame& F, const bf16_t* PART, const int* EIDX, const float* EGATE, const float* SU, const float* SV, float* ACTS) {
    const int gt = F.vcu * NWAVES * 64 + F.tid, ngt = F.G * NWAVES * 64;
    for (int p = gt; p < T * 32; p += ngt) {
        f32x4_t s = {0.f, 0.f, 0.f, 0.f};
#pragma unroll
        for (int x = 0; x < 8; ++x) { const v2u w = *(const v2u*)(PART + (size_t)x * T * 128 + (size_t)p * 4); s += (f32x4_t){bflo(w.x), bfhi(w.x), bflo(w.y), bfhi(w.y)}; }
        const int4 e = *(const int4*)(EIDX + (size_t)p * 4); const f32x4_t gt4 = *(const f32x4_t*)(EGATE + (size_t)p * 4);
        *(f32x4_t*)(ACTS + (size_t)p * 4) = (f32x4_t){gelu_erf(s[0] * SU[e.x]) * gt4[0] * SV[e.x], gelu_erf(s[1] * SU[e.y]) * gt4[1] * SV[e.y], gelu_erf(s[2] * SU[e.z]) * gt4[2] * SV[e.z], gelu_erf(s[3] * SU[e.w]) * gt4[3] * SV[e.w]};
    }
}
#define PEER_V_COMPUTE(W, TOK, A0R, XWR) do { const size_t t_ = (TOK); float av[16]; \
        const float axf_ = (A0R).x, ayf_ = (A0R).y; const int ax_ = __builtin_bit_cast(int, axf_), ay_ = __builtin_bit_cast(int, ayf_); av[0] = __builtin_bit_cast(float, PEER_SWZ(ax_, 0)); av[1] = __builtin_bit_cast(float, PEER_SWZ(ay_, 0)); av[2] = __builtin_bit_cast(float, PEER_SWZ(ax_, 1)); av[3] = __builtin_bit_cast(float, PEER_SWZ(ay_, 1)); av[4] = __builtin_bit_cast(float, PEER_SWZ(ax_, 2)); av[5] = __builtin_bit_cast(float, PEER_SWZ(ay_, 2)); av[6] = __builtin_bit_cast(float, PEER_SWZ(ax_, 3)); av[7] = __builtin_bit_cast(float, PEER_SWZ(ay_, 3)); av[8] = __builtin_bit_cast(float, PEER_SWZ(ax_, 4)); av[9] = __builtin_bit_cast(float, PEER_SWZ(ay_, 4)); av[10] = __builtin_bit_cast(float, PEER_SWZ(ax_, 5)); av[11] = __builtin_bit_cast(float, PEER_SWZ(ay_, 5)); av[12] = __builtin_bit_cast(float, PEER_SWZ(ax_, 6)); av[13] = __builtin_bit_cast(float, PEER_SWZ(ay_, 6)); av[14] = __builtin_bit_cast(float, PEER_SWZ(ax_, 7)); av[15] = __builtin_bit_cast(float, PEER_SWZ(ay_, 7)); \
        const size_t oo_ = t_ * 1024 + 128 * x + 2 * lane; const unsigned xw_ = (XWR); const f32x2_t xv = {bflo(xw_), bfhi(xw_)}; \
        f32x2_t o2[8]; _Pragma("unroll") for (int q = 0; q < 8; ++q) o2[q] = (f32x2_t){0.f, 0.f}; \
        _Pragma("unroll") for (int i = 0; i < 16; ++i) { const unsigned ww[4] = {W[i].x, W[i].y, W[i].z, W[i].w}; const f32x2_t a2 = {av[i], av[i]}; \
            _Pragma("unroll") for (int q = 0; q < 4; ++q) { o2[2 * q] = __builtin_elementwise_fma(__builtin_amdgcn_cvt_pk_f32_fp8(ww[q], false), a2, o2[2 * q]); o2[2 * q + 1] = __builtin_elementwise_fma(__builtin_amdgcn_cvt_pk_f32_fp8(ww[q], true), a2, o2[2 * q + 1]); } } \
        float o[16]; _Pragma("unroll") for (int q = 0; q < 8; ++q) { o[2 * q] = o2[q].x; o[2 * q + 1] = o2[q].y; } \
        _Pragma("unroll") for (int i = 0; i < 8; ++i) { const v2u r_ = __builtin_amdgcn_permlane32_swap(__builtin_bit_cast(unsigned, o[i]), __builtin_bit_cast(unsigned, o[i + 8]), false, false); { const unsigned r0_ = r_.x, r1_ = r_.y; o[i] = __builtin_bit_cast(float, r0_) + __builtin_bit_cast(float, r1_); } } \
        _Pragma("unroll") for (int i = 0; i < 4; ++i) { const v2u r_ = __builtin_amdgcn_permlane16_swap(__builtin_bit_cast(unsigned, o[i]), __builtin_bit_cast(unsigned, o[i + 4]), false, false); { const unsigned r0_ = r_.x, r1_ = r_.y; o[i] = __builtin_bit_cast(float, r0_) + __builtin_bit_cast(float, r1_); } } \
        _Pragma("unroll") for (int i = 0; i < 2; ++i) { const float lo = o[i], hi = o[i + 2]; o[i] = (upg ? hi : lo) + dpp_f<0x128>(upg ? lo : hi); } \
        const unsigned rw_ = cvtpk(xv.x + o[0], xv.y + o[1]); *(unsigned*)(X3B + oo_) = rw_; const float r0 = bflo(rw_), r1 = bfhi(rw_); \
        const float ss = wave_sum(r0 * r0 + r1 * r1); if (lane == 0) SS3[t_ * 8 + x] = ss; } while (0)
__device__ __forceinline__ void peer_v_phase(Frame& F, gu32* ctl, const int* EIDX, const float* ACTS, const unsigned char* V8, const bf16_t* X2B, bf16_t* X3B, float* SS3) {
    const int lane = F.lane, g = lane >> 3, j = lane & 7; const unsigned lo16 = 16u * (unsigned)j; const bool upg = (g & 1) != 0;
    const int x0 = (int)(xb_xcc_id() & 7u);
    for (int s = 0; s < 8; ++s) {
        const int x = (x0 + s) & 7;
        const unsigned char* Vx = V8 + (size_t)x * 16384 * 128;
        const bf16_t* Xx = X2B + 128 * x + 2 * lane;
        for (;;) {
            int c = 0; if (lane == 0) c = (int)__hip_atomic_fetch_add(ctl + CW_PEERV + 64 * x, 1u, __ATOMIC_RELAXED, __HIP_MEMORY_SCOPE_AGENT);
            c = __builtin_amdgcn_readfirstlane(c);
            if (c >= T / PEER_CH) break;
            const size_t tc = (size_t)c * PEER_CH, tl = tc + PEER_CH - 1;
            int en[16]; v4u wa[16], wb[16];
            v2i_t er = PEER_LDIDX(tc);
            f32x2_t aa = *(const f32x2_t*)(ACTS + tc * 128 + 2 * lane), ab; unsigned xwa = *(const unsigned*)(Xx + tc * 1024), xwb;
            PEER_SHUF(en, er);
            PEER_GATHER(wa, en, Vx);
            er = PEER_LDIDX(tc + 1);
            for (int tt = 0; tt < PEER_CH; tt += 2) {
                const size_t t = tc + tt, t2 = (t + 2 < tl) ? t + 2 : tl, t3 = (t + 3 < tl) ? t + 3 : tl;
                PEER_SHUF(en, er);
                PEER_GATHER(wb, en, Vx);
                er = PEER_LDIDX(t2);
                ab = *(const f32x2_t*)(ACTS + (t + 1) * 128 + 2 * lane); xwb = *(const unsigned*)(Xx + (t + 1) * 1024);
                PEER_V_COMPUTE(wa, t, aa, xwa);
                PEER_SHUF(en, er);
                PEER_GATHER(wa, en, Vx);
                er = PEER_LDIDX(t3);
                aa = *(const f32x2_t*)(ACTS + t2 * 128 + 2 * lane); xwa = *(const unsigned*)(Xx + t2 * 1024);
                PEER_V_COMPUTE(wb, t + 1, ab, xwb);
            }
        }
    }
}
__device__ __forceinline__ void peer_norm_phase(Frame& F, const Args& a, const float* SS3, const bf16_t* X3B, float* out) {
    const int gt = F.vcu * NWAVES * 64 + F.tid, ngt = F.G * NWAVES * 64;
    for (int p = gt; p < T * 128; p += ngt) {
        const size_t t = (size_t)(p >> 7); const int c = (p & 127) * 8;
        const f32x4_t s0 = *(const f32x4_t*)(SS3 + t * 8), s1 = *(const f32x4_t*)(SS3 + t * 8 + 4);
        const float r3 = rsqrtf(((s0[0] + s0[1]) + (s0[2] + s0[3]) + (s1[0] + s1[1]) + (s1[2] + s1[3])) * (1.f / D) + EPS);
        const v4u w = *(const v4u*)(X3B + t * 1024 + c);
        const f32x4_t g0 = *(const f32x4_t*)(a.g_final + c), g1 = *(const f32x4_t*)(a.g_final + c + 4);
        *(f32x4_t*)(out + t * 1024 + c) = (f32x4_t){bflo(w.x), bfhi(w.x), bflo(w.y), bfhi(w.y)} * g0 * r3;
        *(f32x4_t*)(out + t * 1024 + c + 4) = (f32x4_t){bflo(w.z), bfhi(w.z), bflo(w.w), bfhi(w.w)} * g1 * r3;
    }
}
#ifndef TOPK_HD
#define TOPK_HD __device__ __forceinline__
#endif
TOPK_HD void ce_desc(unsigned& a, unsigned& b) { const unsigned hi = a > b ? a : b, lo = a > b ? b : a; a = hi; b = lo; }
TOPK_HD void sort16_desc(unsigned (&v)[16]) {
#pragma unroll
    for (int k = 2; k <= 16; k <<= 1)
#pragma unroll
        for (int j = k >> 1; j >= 1; j >>= 1)
#pragma unroll
            for (int i = 0; i < 16; ++i) { const int l = i ^ j; if (l > i) { if ((i & k) == 0) ce_desc(v[i], v[l]); else ce_desc(v[l], v[i]); } }
}
TOPK_HD void bitonic_merge16_desc(unsigned (&v)[16]) {
#pragma unroll
    for (int j = 8; j >= 1; j >>= 1)
#pragma unroll
        for (int i = 0; i < 16; ++i) { const int l = i ^ j; if (l > i) ce_desc(v[i], v[l]); }
}
TOPK_HD void top16_merge(unsigned (&a)[16], const unsigned (&b)[16]) {
#pragma unroll
    for (int i = 0; i < 16; ++i) a[i] = a[i] > b[15 - i] ? a[i] : b[15 - i];
    bitonic_merge16_desc(a);
}
TOPK_HD unsigned f2ord(float f) { const unsigned u = __builtin_bit_cast(unsigned, f); return (u & 0x80000000u) ? ~u : (u | 0x80000000u); }
TOPK_HD float ord2f(unsigned o) { const unsigned u = (o & 0x80000000u) ? (o & 0x7fffffffu) : ~o; return __builtin_bit_cast(float, u); }

__device__ __forceinline__ void peer_route_task(Frame& F, const bf16_t* PQ, const bf16_t* SK16, int* EIDX, float* EGATE, int tt, int h) {
    constexpr int CI[50] = {0,0,0,0,0,0,0,0,0,0,0,0,0,0,0,0,1,1,1,1,1,1,1,1,2,2,2,2,2,3,3,3,3,4,4,4,5,5,6,6,7,7,8,9,10,11,12,13,14,15};
    constexpr int CJ[50] = {0,1,2,3,4,5,6,7,8,9,10,11,12,13,14,15,0,1,2,3,4,5,6,7,0,1,2,3,4,0,1,2,3,0,1,2,0,1,0,1,0,1,0,0,0,0,0,0,0,0};
    int lane = F.lane; asm volatile("" : "+v"(lane));
    const int t = lane & 31, hi = lane >> 5;
    LAS unsigned* wl = (LAS unsigned*)(F.lds + 65536 + F.wave * 8192) + lane;
    {
        const size_t row = (size_t)tt * 32 + t;
        unsigned L[2][16];
#pragma unroll
        for (int p = 0; p < 2; ++p) {
            const int hp = h * 2 + p;
            bf16x8_t Bf[8];
#pragma unroll
            for (int ks = 0; ks < 8; ++ks) Bf[ks] = *(const bf16x8_t*)(PQ + row * 2048 + hp * 128 + 16 * ks + 8 * hi);
#pragma unroll
            for (int i = 0; i < 16; ++i) L[p][i] = 0u;
#pragma unroll 1
            for (int nt = 0; nt < 4; ++nt) {
                const int srow = p * 128 + 32 * nt + t;
                bf16x8_t Ac[8];
#pragma unroll
                for (int ks = 0; ks < 8; ++ks) Ac[ks] = *(const LAS bf16x8_t*)(F.lds + srow * 256 + (((2 * ks + hi) ^ (srow & 15)) << 4));
                f32x16_t acc = {};
#pragma unroll
                for (int ks = 0; ks < 8; ++ks) acc = __builtin_amdgcn_mfma_f32_32x32x16_bf16(Ac[ks], Bf[ks], acc, 0, 0, 0);
                unsigned k[16];
#pragma unroll
                for (int r = 0; r < 16; ++r) { const int n = 32 * nt + (r & 3) + 8 * (r >> 2) + 4 * hi; k[r] = (f2ord(acc[r]) & ~127u) | (unsigned)(127 - n); }
                sort16_desc(k);
                top16_merge(L[p], k);
            }
            unsigned pb[16];
#pragma unroll
            for (int i = 0; i < 16; ++i) pb[i] = __shfl_xor(L[p][i], 32);
            top16_merge(L[p], pb);
        }
        float sa[16], sb[16];
#pragma unroll
        for (int i = 0; i < 16; ++i) { sa[i] = ord2f(L[0][i] & ~127u); sb[i] = ord2f(L[1][i] & ~127u); wl[i * 64] = 127u - (L[0][i] & 127u); wl[(16 + i) * 64] = 127u - (L[1][i] & 127u); }
        unsigned c0[16], c1[16];
#pragma unroll
        for (int s = 0; s < 32; ++s) {
            unsigned key = 0u;
            if (s < 25) { const float v = hi ? sa[CI[25 + s]] + sb[CJ[25 + s]] : sa[CI[s]] + sb[CJ[s]]; const int pos = hi ? CI[25 + s] * 16 + CJ[25 + s] : CI[s] * 16 + CJ[s];
                key = (f2ord(v) & ~255u) | (unsigned)(255 - pos); }
            if (s < 16) c0[s] = key; else c1[s - 16] = key;
        }
        sort16_desc(c0); sort16_desc(c1); top16_merge(c0, c1);
        unsigned pb[16];
#pragma unroll
        for (int i = 0; i < 16; ++i) pb[i] = __shfl_xor(c0[i], 32);
        top16_merge(c0, pb);
        float e[16]; const float m = ord2f(c0[0] & ~255u); float l = 0.f;
#pragma unroll
        for (int r = 0; r < 16; ++r) { e[r] = __expf(ord2f(c0[r] & ~255u) - m); l += e[r]; }
        const float il = 1.f / l;
        int ex[8]; float gt[8];
#pragma unroll
        for (int q = 0; q < 8; ++q) { const unsigned kk = hi ? c0[8 + q] : c0[q]; const int pos = 255 - (int)(kk & 255u); ex[q] = (int)(wl[(pos >> 4) * 64] * 128u + wl[(16 + (pos & 15)) * 64]); gt[q] = (hi ? e[8 + q] : e[q]) * il; }
        int* ep = EIDX + row * 128 + h * 16 + hi * 8; float* gp = EGATE + row * 128 + h * 16 + hi * 8;
        *(int4*)ep = make_int4(ex[0], ex[1], ex[2], ex[3]); *(int4*)(ep + 4) = make_int4(ex[4], ex[5], ex[6], ex[7]);
        *(f32x4_t*)gp = (f32x4_t){gt[0], gt[1], gt[2], gt[3]}; *(f32x4_t*)(gp + 4) = (f32x4_t){gt[4], gt[5], gt[6], gt[7]};
    }
}
__device__ __forceinline__ void cross_item(Frame& F, const bf16_t* QC, const bf16_t* KC, const bf16_t* VC, bf16_t* OC, int bh, int qb) {
    int tid = F.tid; asm volatile("" : "+v"(tid));
    const int lane = tid & 63, wave = F.wave, q = lane & 31, hi = lane >> 5;
    LAS unsigned char* L = F.lds;
    const int g4 = lane >> 4, qq = (lane >> 2) & 3, p4 = lane & 3;
    {
        const int b = bh >> 2, h = bh & 3;
#pragma unroll
        for (int i = 0; i < 16; ++i) { const int cid = tid + 512 * i, r = cid >> 5, c = cid & 31;
            *(LAS v4u*)(L + r * 512 + ((c ^ (r & 15)) << 4)) = *(const v4u*)(KC + (size_t)(b * 256 + r) * 1024 + h * 256 + c * 8); }
        const size_t qrow0 = (size_t)b * SEQ + qb * 256 + wave * 32;
        const bf16_t* Qp = QC + (qrow0 + q) * 1024 + h * 256 + 8 * hi;
        __syncthreads();
        f32x16_t st[8];
#pragma unroll
        for (int kt = 0; kt < 8; ++kt) st[kt] = (f32x16_t){};
#pragma unroll 2
        for (int ks = 0; ks < 16; ++ks) { const bf16x8_t qf = *(const bf16x8_t*)(Qp + 16 * ks);
#pragma unroll
            for (int kt = 0; kt < 8; ++kt) { const int row = 32 * kt + q;
                st[kt] = __builtin_amdgcn_mfma_f32_32x32x16_bf16(*(const LAS bf16x8_t*)(L + row * 512 + (((2 * ks + hi) ^ (row & 15)) << 4)), qf, st[kt], 0, 0, 0); } }
        float m = -INFINITY;
#pragma unroll
        for (int kt = 0; kt < 8; ++kt)
#pragma unroll
            for (int r = 0; r < 16; ++r) { st[kt][r] *= 0.0625f; m = fmaxf(m, st[kt][r]); }
        m = fmaxf(m, __shfl_xor(m, 32));
        float l = 0.f;
#pragma unroll
        for (int kt = 0; kt < 8; ++kt)
#pragma unroll
            for (int r = 0; r < 16; ++r) { st[kt][r] = __expf(st[kt][r] - m); l += st[kt][r]; }
        l += __shfl_xor(l, 32);
        const float il = 1.f / l;
        bf16x8_t pa[8][2];
#pragma unroll
        for (int kt = 0; kt < 8; ++kt)
#pragma unroll
            for (int s = 0; s < 2; ++s) pa[kt][s] = __builtin_bit_cast(bf16x8_t, (v4u){cvtpk(st[kt][8 * s] * il, st[kt][8 * s + 1] * il), cvtpk(st[kt][8 * s + 2] * il, st[kt][8 * s + 3] * il),
                                                                                        cvtpk(st[kt][8 * s + 4] * il, st[kt][8 * s + 5] * il), cvtpk(st[kt][8 * s + 6] * il, st[kt][8 * s + 7] * il)});
        __syncthreads();
#pragma unroll
        for (int i = 0; i < 16; ++i) { const int cid = tid + 512 * i, r = cid >> 5, c = cid & 31;
            *(LAS v4u*)(L + r * 512 + ((c ^ (4 * (r & 3))) << 4)) = *(const v4u*)(VC + (size_t)(b * 256 + r) * 1024 + h * 256 + c * 8); }
        __syncthreads();
        bf16_t* Op = OC + qrow0 * 1024 + h * 256 + q;
#pragma unroll 1
        for (int dt = 0; dt < 8; ++dt) {
            f32x16_t o = {};
            LAS unsigned char* vb = L + (4 * (g4 >> 1) + qq) * 512 + (((dt * 64) ^ (qq << 6)) + (g4 & 1) * 32 + p4 * 8);
#pragma unroll
            for (int kt = 0; kt < 8; ++kt)
#pragma unroll
                for (int s = 0; s < 2; ++s) { const v4i16_t a0 = lds_tr16(vb + (32 * kt + 16 * s) * 512), a1 = lds_tr16(vb + (32 * kt + 16 * s + 8) * 512);
                    const bf16x8_t vf = {a0[0], a0[1], a0[2], a0[3], a1[0], a1[1], a1[2], a1[3]};
                    o = __builtin_amdgcn_mfma_f32_32x32x16_bf16(pa[kt][s], vf, o, 0, 0, 0); }
#pragma unroll
            for (int r = 0; r < 16; ++r) { const int row = (r & 3) + 8 * (r >> 2) + 4 * hi; Op[(size_t)row * 1024 + dt * 32] = f2bf(o[r]); }
        }
        __syncthreads();
    }
}
template <bool REMAP>
__device__ __forceinline__ void transpose_tile(const float* W, int K, int N, const float* gain, bf16_t* WT, LAS float* tile, int item, int tid) {
    const int nblk = (N + 255) / 256, kb = item / nblk, nb = item % nblk, k0 = 64 * kb, n0 = 256 * nb;
    const int c4 = (tid & 63) * 4, kr = tid >> 6;
    f32x4 v[8];
#pragma unroll
    for (int i = 0; i < 8; ++i) { const int k = kr + 8 * i; v[i] = (n0 + c4 < N) ? *(const GAS f32x4*)(W + (size_t)(k0 + k) * N + n0 + c4) : (f32x4){0.f, 0.f, 0.f, 0.f}; }
#pragma unroll
    for (int i = 0; i < 8; ++i) { const int k = kr + 8 * i; LAS float* d = tile + k * 257 + c4; d[0] = v[i].x; d[1] = v[i].y; d[2] = v[i].z; d[3] = v[i].w; }
    __syncthreads();
#pragma unroll
    for (int i = 0; i < 4; ++i) { const int p = tid + 512 * i, n = p >> 3, c = p & 7; const LAS float* sp = tile + (8 * c) * 257 + n;
        float g[8];
#pragma unroll
        for (int q = 0; q < 8; ++q) g[q] = gain ? gain[k0 + 8 * c + q] : 1.f;
        v4u o; o.x = pk2(sp[0 * 257] * g[0], sp[1 * 257] * g[1]); o.y = pk2(sp[2 * 257] * g[2], sp[3 * 257] * g[3]); o.z = pk2(sp[4 * 257] * g[4], sp[5 * 257] * g[5]); o.w = pk2(sp[6 * 257] * g[6], sp[7 * 257] * g[7]);
        int ng = n0 + n; bool ok = ng < N;
        if (REMAP) { if (ng >= 3584 && ng < 3592) ok = false; else if (ng >= 3592) ng -= 8; }
        if (ok) *(GAS v4u*)(WT + (size_t)ng * K + k0 + 8 * c) = o; }
    __syncthreads();
}

__device__ __forceinline__ void p0_prologue(Frame& F, const Args& a) {
    unsigned char* ws = a.ws;
    LAS float* tile = (LAS float*)F.lds;
    const int gw = F.vcu * NWAVES + F.wave, NGW = F.G * NWAVES;
    constexpr int I_IN = 16 * 23;
    for (int it = F.vcu; it < I_IN; it += F.G) transpose_tile<true>(a.w_in, 1024, IN_COLS, a.g_mix, (bf16_t*)(ws + WS_WIN), tile, it, F.tid);
    __syncthreads();
    LAS float* wsm = (LAS float*)F.lds;
    for (int i = F.tid; i < 8192; i += NWAVES * 64) { const int j = i >> 10, k = i & 1023; wsm[i] = a.w_in[(size_t)k * IN_COLS + 3584 + j] * a.g_mix[k]; }
    __syncthreads();
    bf16_t* XB = (bf16_t*)(ws + WS_A0); float* rstd0 = (float*)(ws + WS_RSTD0); float* GB = (float*)(ws + WS_GB); float* GA = GB + T * 4;
    for (int row0 = gw * 4; row0 < T; row0 += NGW * 4) {
        f32x4 v[4][4];
#pragma unroll
        for (int r = 0; r < 4; ++r)
#pragma unroll
            for (int j = 0; j < 4; ++j) v[r][j] = *((const GAS f32x4*)(a.x + (size_t)(row0 + r) * D) + F.lane + 64 * j);
#pragma unroll
        for (int r = 0; r < 4; ++r) { const int row = row0 + r; float s = 0.f;
#pragma unroll
            for (int j = 0; j < 4; ++j) s += (v[r][j].x * v[r][j].x + v[r][j].y * v[r][j].y) + (v[r][j].z * v[r][j].z + v[r][j].w * v[r][j].w);
            const float rstd = rsqrtf(wave_sum(s) * (1.f / D) + EPS);
            GAS unsigned long long* o8 = (GAS unsigned long long*)(XB + (size_t)row * D) + F.lane;
#pragma unroll
            for (int j = 0; j < 4; ++j) o8[64 * j] = (unsigned long long)pk2(v[r][j].x, v[r][j].y) | ((unsigned long long)pk2(v[r][j].z, v[r][j].w) << 32);
            float dj[8];
#pragma unroll
            for (int jj = 0; jj < 8; ++jj) { float d = 0.f;
#pragma unroll
                for (int j = 0; j < 4; ++j) { const f32x4 w = *(const LAS f32x4*)(wsm + jj * 1024 + (F.lane + 64 * j) * 4); d += (v[r][j].x * w.x + v[r][j].y * w.y) + (v[r][j].z * w.z + v[r][j].w * w.w); }
                dj[jj] = d; }
#pragma unroll
            for (int off = 4; off >= 1; off >>= 1) { const bool up = (F.lane & off) != 0;
#pragma unroll
                for (int i = 0; i < off; ++i) { const float lo = dj[i], hi = dj[i + off]; const float send = up ? lo : hi, keep = up ? hi : lo; dj[i] = keep + __shfl_xor(send, off); } }
            float d0 = dj[0]; d0 += __shfl_xor(d0, 8); d0 += __shfl_xor(d0, 16); d0 += __shfl_xor(d0, 32);
            if (F.lane == 0) rstd0[row] = rstd;
            if (F.lane < 4) GB[(size_t)row * 4 + F.lane] = d0 * rstd; else if (F.lane < 8) GA[(size_t)row * 4 + F.lane - 4] = d0 * rstd; }
    }
}
__device__ __forceinline__ void late_prologue(Frame& F, const Args& a, int wgi, int nwg) {
    unsigned char* ws = a.ws;
    LAS float* tile = (LAS float*)F.lds;
    const int gw = wgi * NWAVES + F.wave, NGW = nwg * NWAVES;
    constexpr int I_S = 8 * 4, I_M = 16 * 4, I_L = 16 * 8;
    constexpr int NITEMS = 2 * I_S + 3 * I_M + 2 * I_L;
    for (int it = wgi; it < NITEMS; it += nwg) {
        int r = it;
        if (r < I_S) { transpose_tile<false>(a.w_sb_up, 512, 1024, nullptr, (bf16_t*)(ws + WS_WSB), tile, r, F.tid); continue; } r -= I_S;
        if (r < I_S) { transpose_tile<false>(a.w_gdn_up, 512, 1024, nullptr, (bf16_t*)(ws + WS_WGDN), tile, r, F.tid); continue; } r -= I_S;
        if (r < I_M) { transpose_tile<false>(a.w_mix_out, 1024, 1024, nullptr, (bf16_t*)(ws + WS_WMIX), tile, r, F.tid); continue; } r -= I_M;
        if (r < I_M) { transpose_tile<false>(a.w_cq, 1024, 1024, a.g_cross, (bf16_t*)(ws + WS_WCQ), tile, r, F.tid); continue; } r -= I_M;
        if (r < I_M) { transpose_tile<false>(a.w_co, 1024, 1024, nullptr, (bf16_t*)(ws + WS_WCO), tile, r, F.tid); continue; } r -= I_M;
        if (r < I_L) { transpose_tile<false>(a.w_ckv, 1024, 2048, nullptr, (bf16_t*)(ws + WS_WCKV), tile, r, F.tid); continue; } r -= I_L;
        transpose_tile<false>(a.w_pq, 1024, 2048, a.g_peer, (bf16_t*)(ws + WS_WPQ), tile, r, F.tid);
    }
    __syncthreads();
    {
        float* SUV = (float*)(ws + WS_SUV);
        f32x4 gq[4];
#pragma unroll
        for (int q = 0; q < 4; ++q) gq[q] = *(const GAS f32x4*)(a.g_peer + 16 * F.lane + 4 * q);
        for (int row0 = gw * 4; row0 < 2 * 16384; row0 += NGW * 4) {
            f32x4 v[4][4];
#pragma unroll
            for (int r = 0; r < 4; ++r) { const int row = row0 + r, tb = row >> 14, e = row & 16383; const float* src = (tb ? a.peer_v : a.peer_u) + (size_t)e * 1024 + 16 * F.lane;
#pragma unroll
                for (int q = 0; q < 4; ++q) { v[r][q] = *(const GAS f32x4*)(src + 4 * q); if (!tb) v[r][q] *= gq[q]; } }
#pragma unroll
            for (int r = 0; r < 4; ++r) { const int row = row0 + r, tb = row >> 14, e = row & 16383; float am = 0.f;
#pragma unroll
                for (int q = 0; q < 4; ++q) am = fmaxf(am, fmaxf(fmaxf(fabsf(v[r][q].x), fabsf(v[r][q].y)), fmaxf(fabsf(v[r][q].z), fabsf(v[r][q].w))));
#pragma unroll
                for (int o = 1; o < 64; o <<= 1) am = fmaxf(am, __shfl_xor(am, o));
                if (!tb) {
                    const float sc8 = am > 0.f ? 127.f / am : 0.f; v4u o8;
#pragma unroll
                    for (int q = 0; q < 4; ++q) {
                        const unsigned b0 = __builtin_bit_cast(unsigned, fmaf(v[r][q].x, sc8, 12582912.f)), b1 = __builtin_bit_cast(unsigned, fmaf(v[r][q].y, sc8, 12582912.f));
                        const unsigned b2 = __builtin_bit_cast(unsigned, fmaf(v[r][q].z, sc8, 12582912.f)), b3 = __builtin_bit_cast(unsigned, fmaf(v[r][q].w, sc8, 12582912.f));
                        o8[q] = __builtin_amdgcn_perm(b1, b0, 0x0c0c0400u) | __builtin_amdgcn_perm(b3, b2, 0x04000c0cu); }
                    *(GAS v4u*)(ws + WS_U8 + ((size_t)(F.lane >> 3) * 16384 + e) * 128 + 16 * (F.lane & 7)) = o8;
                    if (F.lane == 0) SUV[row] = am * (1.f / 127.f);
                    continue; }
                int ex = 0; if (am > 0.f) (void)frexpf(am, &ex);
                const float sc = ldexpf(1.f, 8 - ex), inv = ldexpf(1.f, ex - 8);
                v4u o; int rr;
                rr = __builtin_amdgcn_cvt_pk_fp8_f32(v[r][0].x * sc, v[r][0].y * sc, 0, false); rr = __builtin_amdgcn_cvt_pk_fp8_f32(v[r][0].z * sc, v[r][0].w * sc, rr, true); o.x = (unsigned)rr;
                rr = __builtin_amdgcn_cvt_pk_fp8_f32(v[r][1].x * sc, v[r][1].y * sc, 0, false); rr = __builtin_amdgcn_cvt_pk_fp8_f32(v[r][1].z * sc, v[r][1].w * sc, rr, true); o.y = (unsigned)rr;
                rr = __builtin_amdgcn_cvt_pk_fp8_f32(v[r][2].x * sc, v[r][2].y * sc, 0, false); rr = __builtin_amdgcn_cvt_pk_fp8_f32(v[r][2].z * sc, v[r][2].w * sc, rr, true); o.z = (unsigned)rr;
                rr = __builtin_amdgcn_cvt_pk_fp8_f32(v[r][3].x * sc, v[r][3].y * sc, 0, false); rr = __builtin_amdgcn_cvt_pk_fp8_f32(v[r][3].z * sc, v[r][3].w * sc, rr, true); o.w = (unsigned)rr;
                {
                    GAS unsigned short* vp = (GAS unsigned short*)(ws + WS_V8 + ((size_t)(F.lane >> 3) * 16384 + e) * 128 + 2 * (F.lane & 7));
#pragma unroll
                    for (int d = 0; d < 4; ++d) { vp[8 * (2 * d)] = (unsigned short)(o[d] & 0xffffu); vp[8 * (2 * d + 1)] = (unsigned short)(o[d] >> 16); } }
                if (F.lane == 0) SUV[row] = inv; }
        }
    }
    {
        const int gt = gw * 64 + F.lane, ngt = NGW * 64;
        for (int p = gt; p < 262144 / 8; p += ngt) { const float* src = a.subkeys + (size_t)p * 8; const f32x4 v0 = *(const GAS f32x4*)src, v1 = *(const GAS f32x4*)(src + 4);
            v4u o; o.x = pk2(v0.x, v0.y); o.y = pk2(v0.z, v0.w); o.z = pk2(v1.x, v1.y); o.w = pk2(v1.z, v1.w); *(GAS v4u*)((bf16_t*)(ws + WS_SKB) + (size_t)p * 8) = o; }
    }
    bf16_t* MN = (bf16_t*)(ws + WS_MN);
    for (int row = gw; row < 1024; row += NGW) {
        const GAS f32x4* xr = (const GAS f32x4*)(a.mem + (size_t)row * D) + F.lane;
        f32x4 v[4]; float s = 0.f;
#pragma unroll
        for (int j = 0; j < 4; ++j) { v[j] = xr[64 * j]; s += (v[j].x * v[j].x + v[j].y * v[j].y) + (v[j].z * v[j].z + v[j].w * v[j].w); }
        const float rstd = rsqrtf(wave_sum(s) * (1.f / D) + EPS);
        GAS unsigned long long* o8 = (GAS unsigned long long*)(MN + (size_t)row * D) + F.lane;
#pragma unroll
        for (int j = 0; j < 4; ++j) { const f32x4 g = *((const f32x4*)a.g_mem + F.lane + 64 * j); const f32x4 o = v[j] * g * rstd;
            o8[64 * j] = (unsigned long long)pk2(o.x, o.y) | ((unsigned long long)pk2(o.z, o.w) << 32); }
    }
}
__device__ __forceinline__ void rstd_rows_for_units(Frame& F, int N, const float* SS, float* rstd) {
    pg8::StaticOrder S2; S2.init(T, N, F.G, (int)blockIdx.x); pg8::Unit u;
    for (int i = 0; S2.next(i, u); ++i) if (F.tid < 256) { const int row = u.pm * 256 + F.tid; const f32x4* sp = (const f32x4*)(SS + (size_t)row * 16);
        const f32x4 a = (sp[0] + sp[1]) + (sp[2] + sp[3]); rstd[row] = rsqrtf(((a.x + a.y) + (a.z + a.w)) * (1.f / 1024.f) + EPS); }
    asm volatile("s_waitcnt vmcnt(0)" ::: "memory"); __syncthreads();
}

__device__ __forceinline__ void sub_barrier(gu32* cnt, unsigned n, gu32* tmo) {
    asm volatile("s_waitcnt vmcnt(0)" ::: "memory");
    __syncthreads();
    if (threadIdx.x == 0) {
        __builtin_amdgcn_fence(__ATOMIC_RELEASE, "agent");
        asm volatile("s_waitcnt vmcnt(0)" ::: "memory");
        __hip_atomic_fetch_add(cnt, 1u, __ATOMIC_RELAXED, __HIP_MEMORY_SCOPE_AGENT);
        unsigned sp = 0;
        while (__hip_atomic_load(cnt, __ATOMIC_RELAXED, __HIP_MEMORY_SCOPE_AGENT) < n) { __builtin_amdgcn_s_sleep(2); if (++sp > (1u << 22)) { __hip_atomic_store(tmo, 1u, __ATOMIC_RELAXED, __HIP_MEMORY_SCOPE_AGENT); break; } }
        __builtin_amdgcn_fence(__ATOMIC_ACQUIRE, "agent");
        asm volatile("s_waitcnt vmcnt(0)" ::: "memory");
    }
    __syncthreads();
}

__global__ void __launch_bounds__(NWAVES * 64, 2) mk_fwd(Args args) {
    extern __shared__ __attribute__((aligned(16))) unsigned char lds_raw[];
    Frame F;
    F.lds = (LAS unsigned char*)lds_raw;
    F.tid = threadIdx.x; F.lane = F.tid & 63; F.wave = __builtin_amdgcn_readfirstlane(F.tid >> 6);
    F.G = gridDim.x; { const int bx = blockIdx.x; F.vcu = (F.G % 8 == 0) ? (bx % 8) * (F.G / 8) + bx / 8 : bx; }
    unsigned char* ws = args.ws;
    gu32* ctl = (gu32*)(ws + WS_CTL);
    volatile LAS unsigned* MISC = (volatile LAS unsigned*)(F.lds + MISC_OFF);
    for (int u = F.tid; u < (LDS_BYTES - LDSCTL_OFF) / 4; u += NWAVES * 64) ((LAS unsigned*)(F.lds + LDSCTL_OFF))[u] = 0u;
    __syncthreads();
    XcdBarrier bar = xcd_barrier_post((unsigned*)(ctl + CW_BAR) + args.bar_region * XCD_BAR_WORDS, MISC + 8);
    const int lo = args.ph_lo, hi = args.ph_hi;
#define IN(k) (lo <= (k) && (k) < hi)
#define SEAM(k) do { if (IN(k) && IN((k) + 1)) xcd_barrier(bar); } while (0)
    bf16_t* A0 = (bf16_t*)(ws + WS_A0); bf16_t* A1 = (bf16_t*)(ws + WS_A1);
    bf16_t* MG = (bf16_t*)args.out;
    bf16_t* SBQ = (bf16_t*)args.out; bf16_t* SBK = SBQ + (size_t)T * 512; bf16_t* SBV = SBK + (size_t)T * 512; bf16_t* OSB = SBV + (size_t)T * 512;

    GdnBufs Gb{(bf16_t*)(ws + WS_NW), (bf16_t*)(ws + WS_QD), (bf16_t*)(ws + WS_KDT), (bf16_t*)(ws + WS_QK), (bf16_t*)(ws + WS_UT), (float*)(ws + WS_CD), (bf16_t*)(ws + WS_ORAW), (float*)(ws + WS_OSS)};
    if (IN(0)) { p0_prologue(F, args);}
    SEAM(0);
    if (IN(1)) {
        { pg8::Gemm g{A0, (const bf16_t*)(ws + WS_WIN), T, NPROJ, 1024}; pg8::StaticOrder S; S.init(T, NPROJ, F.G, (int)blockIdx.x);
          pg8::EpiProj E{(const float*)(ws + WS_RSTD0), SBQ, SBK, SBV, A1, (bf16_t*)(ws + WS_GZ), (bf16_t*)(ws + WS_GSB), (bf16_t*)(ws + WS_GGDN)};
          pg8::gemm_phase<pg8::EpiProj, pg8::StaticOrder, true, true>(F.lds, g, S, E); }
    }
    SEAM(1);
    if (IN(2)) { gdn_prep_phase(F, args, A1, (const float*)(ws + WS_GB), (const float*)(ws + WS_GB) + T * 4, Gb); }
    SEAM(2);
    if (IN(3)) {
        const int nscan = F.G > 64 ? 64 : F.G, sb0 = F.G > 64 ? 64 : 0;
        if ((int)blockIdx.x < nscan) for (int s0 = blockIdx.x; s0 < 64; s0 += nscan) { const int s = (nscan == 64) ? ((s0 & 7) + 8 * (s0 >> 5)) * 4 + ((s0 >> 3) & 3) : s0; gdn_scan_unit(F, s, Gb); __syncthreads(); }
        if ((int)blockIdx.x >= sb0) { late_prologue(F, args, (int)blockIdx.x - sb0, F.G - sb0); __syncthreads(); }
        if ((int)blockIdx.x >= sb0) sb_phase(F.lds + F.wave * 8192, SBQ, SBK, SBV, OSB, ((int)blockIdx.x - sb0) * NWAVES + F.wave, (F.G - sb0) * NWAVES, F.lane);
        __syncthreads();
        if (sb0 > 0 && (int)blockIdx.x >= sb0) {
            sub_barrier(ctl + CW_SUB, (unsigned)(F.G - sb0), ctl + CW_SUB + 64);
            pg8::Gemm g{OSB, (const bf16_t*)(ws + WS_WSB), T, 1024, 512}; pg8::StaticOrder S; S.init(T, 1024, F.G - sb0, (int)blockIdx.x - sb0);
            pg8::EpiMerge<false> E{(const bf16_t*)(ws + WS_GSB), MG};
            pg8::gemm_phase<pg8::EpiMerge<false>, pg8::StaticOrder, true, true>(F.lds, g, S, E);
            const int wgi = (int)blockIdx.x - sb0;
            if (F.G - sb0 >= 160 && wgi >= 128 && wgi < 160) { pg8::Gemm g2{(const bf16_t*)(ws + WS_MN), (const bf16_t*)(ws + WS_WCKV), 1024, 2048, 1024}; pg8::StaticOrder S2; S2.init(1024, 2048, 32, wgi - 128);
                pg8::EpiSplit E2{(bf16_t*)(ws + WS_KC), (bf16_t*)(ws + WS_VC), 1024, 4};
                pg8::gemm_phase<pg8::EpiSplit, pg8::StaticOrder, true, true>(F.lds, g2, S2, E2); }
        }
    }
    SEAM(3);
    if (IN(4)) {
        if (!(F.G > 64 && F.G - 64 >= 160)) { pg8::Gemm g{(const bf16_t*)(ws + WS_MN), (const bf16_t*)(ws + WS_WCKV), 1024, 2048, 1024}; pg8::StaticOrder S; S.init(1024, 2048, F.G, (int)blockIdx.x);
          pg8::EpiSplit E{(bf16_t*)(ws + WS_KC), (bf16_t*)(ws + WS_VC), 1024, 4};
          pg8::gemm_phase<pg8::EpiSplit, pg8::StaticOrder, true, true>(F.lds, g, S, E); }
        gdn_finish_phase(F, args, Gb, (const bf16_t*)(ws + WS_GZ), (bf16_t*)(ws + WS_OG)); }
    SEAM(4);
    if (IN(5)) {
        if (!(F.G > 64)) { pg8::Gemm g{OSB, (const bf16_t*)(ws + WS_WSB), T, 1024, 512}; pg8::StaticOrder S; S.init(T, 1024, F.G, (int)blockIdx.x);
          pg8::EpiMerge<false> E{(const bf16_t*)(ws + WS_GSB), MG};
          pg8::gemm_phase<pg8::EpiMerge<false>, pg8::StaticOrder, true, true>(F.lds, g, S, E);
          xcd_barrier(bar); }
        { pg8::Gemm g{(const bf16_t*)(ws + WS_OG), (const bf16_t*)(ws + WS_WGDN), T, 1024, 512}; pg8::StaticOrder S; S.init(T, 1024, F.G, (int)blockIdx.x);
          pg8::EpiMerge<true> E{(const bf16_t*)(ws + WS_GGDN), MG};
          pg8::gemm_phase<pg8::EpiMerge<true>, pg8::StaticOrder, true, true>(F.lds, g, S, E); }
    }
    SEAM(5);
    if (IN(6)) {
        pg8::Gemm g{MG, (const bf16_t*)(ws + WS_WMIX), T, 1024, 1024}; pg8::StaticOrder S; S.init(T, 1024, F.G, (int)blockIdx.x);
        pg8::EpiRes<true> E{args.x, nullptr, A1, (float*)(ws + WS_SS)};
        pg8::gemm_phase<pg8::EpiRes<true>, pg8::StaticOrder, true, true>(F.lds, g, S, E);
    }
    SEAM(6);
    if (IN(7)) {
        rstd_rows_for_units(F, 1024, (const float*)(ws + WS_SS), (float*)(ws + WS_RSTD0));
        pg8::Gemm g{A1, (const bf16_t*)(ws + WS_WCQ), T, 1024, 1024}; pg8::StaticOrder S; S.init(T, 1024, F.G, (int)blockIdx.x);
        pg8::EpiScale E{(const float*)(ws + WS_RSTD0), (bf16_t*)(ws + WS_GSB), 1024};
        pg8::gemm_phase<pg8::EpiScale, pg8::StaticOrder, true, true>(F.lds, g, S, E);
        asm volatile("s_waitcnt vmcnt(0)" ::: "memory"); __syncthreads();
        pg8::StaticOrder S2; S2.init(T, 1024, F.G, (int)blockIdx.x); pg8::Unit u;
        for (int i = 0; S2.next(i, u); ++i) cross_item(F, (const bf16_t*)(ws + WS_GSB), (const bf16_t*)(ws + WS_KC), (const bf16_t*)(ws + WS_VC), (bf16_t*)(ws + WS_GGDN), (u.pm >> 5) * 4 + u.pn, u.pm & 31);
    }
    SEAM(7);
    if (IN(9)) {
        pg8::Gemm g{(const bf16_t*)(ws + WS_GGDN), (const bf16_t*)(ws + WS_WCO), T, 1024, 1024}; pg8::StaticOrder S; S.init(T, 1024, F.G, (int)blockIdx.x);
        pg8::EpiRes<false> E{nullptr, A1, A0, (float*)(ws + WS_SS)};
        pg8::gemm_phase<pg8::EpiRes<false>, pg8::StaticOrder, true, true>(F.lds, g, S, E);
    }
    SEAM(9);
    if (IN(10)) {
        rstd_rows_for_units(F, 2048, (const float*)(ws + WS_SS), (float*)(ws + WS_RSTD2));
        pg8::Gemm g{A0, (const bf16_t*)(ws + WS_WPQ), T, 2048, 1024}; pg8::StaticOrder S; S.init(T, 2048, F.G, (int)blockIdx.x);
        pg8::EpiScale E{(const float*)(ws + WS_RSTD2), A1, 2048};
        pg8::gemm_phase<pg8::EpiScale, pg8::StaticOrder, true, true>(F.lds, g, S, E);
        asm volatile("s_waitcnt vmcnt(0)" ::: "memory"); __syncthreads();
        pg8::StaticOrder S2; S2.init(T, 2048, F.G, (int)blockIdx.x); pg8::Unit u;
        int hst = -1;
        for (int i = 0; S2.next(i, u); ++i) {
            if (u.pn != hst) { hst = u.pn; __syncthreads();
#pragma unroll
                for (int q = 0; q < 8; ++q) { const int cid = F.tid + 512 * q, r = cid >> 4, c = cid & 15;
                    *(LAS v4u*)(F.lds + r * 256 + ((c ^ (r & 15)) << 4)) = *(const v4u*)((const bf16_t*)(ws + WS_SKB) + ((size_t)u.pn * 256 + r) * 128 + c * 8); }
                __syncthreads(); }
            peer_route_task(F, A1, (const bf16_t*)(ws + WS_SKB), (int*)(ws + 296 * MiB), (float*)(ws + 312 * MiB), u.pm * 8 + F.wave, u.pn);
        }
        __syncthreads();
    }
    SEAM(10);
    if (IN(12)) { peer_u_phase(F, args, ctl, A0, (const float*)(ws + WS_RSTD2), (const int*)(ws + 296 * MiB), (const unsigned char*)(ws + WS_U8), (bf16_t*)(ws + WS_PART)); }
    SEAM(12);
    if (IN(13)) { peer_combine_phase(F, (const bf16_t*)(ws + WS_PART), (const int*)(ws + 296 * MiB), (const float*)(ws + 312 * MiB), (const float*)(ws + WS_SUV), (const float*)(ws + WS_SUV) + 16384, (float*)(ws + 328 * MiB)); }
    SEAM(13);
    if (IN(14)) { peer_v_phase(F, ctl, (const int*)(ws + 296 * MiB), (const float*)(ws + 328 * MiB), (const unsigned char*)(ws + WS_V8), A0, A1, (float*)(ws + WS_SS)); }
    SEAM(14);
    if (IN(15)) { peer_norm_phase(F, args, (const float*)(ws + WS_SS), A1, args.out); }
#undef IN
#undef SEAM
}
extern "C" void kernel_launch(void* const* d_in, const int* in_sizes, int n_in, void* d_out, int out_size, void* d_ws, size_t ws_size, hipStream_t stream) {
    static int grid = 0;
    if (grid == 0) {
        if (n_in != 22 || ws_size < WS_END || out_size != T * D) { fprintf(stderr, "kernel_launch: unexpected n_in %d / ws %zu / out %d\n", n_in, ws_size, out_size); grid = -1; return; }
        int dev = 0, cus = 0, per_cu = 0;
        if (hipGetDevice(&dev) != hipSuccess || hipDeviceGetAttribute(&cus, hipDeviceAttributeMultiprocessorCount, dev) != hipSuccess) { grid = -1; return; }
        if (hipFuncSetAttribute((const void*)mk_fwd, hipFuncAttributeMaxDynamicSharedMemorySize, LDS_BYTES) != hipSuccess) { fprintf(stderr, "kernel_launch: hipFuncSetAttribute failed\n"); grid = -1; return; }
        if (hipOccupancyMaxActiveBlocksPerMultiprocessor(&per_cu, (const void*)mk_fwd, NWAVES * 64, LDS_BYTES) != hipSuccess || per_cu < 1) { fprintf(stderr, "kernel_launch: occupancy query says %d\n", per_cu); per_cu = 1; }
        (void)hipGetLastError();
        grid = cus;
    }
    if (grid < 0) return;
    hipMemsetAsync((char*)d_ws + WS_CTL, 0, CTL_ZERO_BYTES, stream);
    Args a{};
    const float** ap = (const float**)&a;
    for (int i = 0; i < 22; ++i) ap[i] = (const float*)d_in[i];
    a.out = (float*)d_out; a.ws = (unsigned char*)d_ws;
    char* ws = (char*)d_ws; float* out = (float*)d_out;
    float* rstd2 = (float*)(ws + WS_RSTD2);
    bf16_t* KC = (bf16_t*)(ws + WS_KC); bf16_t* VC = (bf16_t*)(ws + WS_VC);
    bf16_t* PQ = (bf16_t*)(ws + WS_A1); bf16_t* QC = (bf16_t*)(ws + WS_GSB); bf16_t* OC = (bf16_t*)(ws + WS_GGDN);
    int* EIDX = (int*)(ws + 296 * MiB); float* EGATE = (float*)(ws + 312 * MiB);
#define MK(lo, hi, reg) do { a.ph_lo = (lo); a.ph_hi = (hi); a.bar_region = (reg); hipLaunchKernelGGL(mk_fwd, dim3(grid), dim3(NWAVES * 64), LDS_BYTES, stream, a); } while (0)
    MK(0, 16, 0);
#undef MK
}
```

```cpp
#include <hip/hip_runtime.h>
#include <stdint.h>
#include <cstdio>

typedef unsigned short bf16_t;
__device__ __forceinline__ float bf2f(bf16_t v) { return __uint_as_float(((unsigned)v) << 16); }
__device__ __forceinline__ bf16_t f2bf(float f) { unsigned u = __float_as_uint(f); return (bf16_t)((u + 0x7fffu + ((u >> 16) & 1u)) >> 16); }

constexpr int T = 32768, D = 1024, SEQ = 8192, NB = 4;
constexpr int IN_COLS = 5640, NPROJ = 5632;
constexpr float EPS = 1e-6f;
constexpr size_t MiB = 1u << 20;

__device__ __forceinline__ float wave_sum(float v) {
#pragma unroll
    for (int o = 1; o < 64; o <<= 1) v += __shfl_xor(v, o);
    return v;
}
__device__ __forceinline__ float sigmoidf_(float x) { return 1.f / (1.f + __expf(-x)); }
__device__ __forceinline__ float softplusf_(float x) { return fmaxf(x, 0.f) + log1pf(__expf(-fabsf(x))); }

namespace pg8 {
#define PG8_LAS __attribute__((address_space(3)))
typedef unsigned short bf16_t;
typedef short bf16x8 __attribute__((ext_vector_type(8)));
typedef float f32x4 __attribute__((ext_vector_type(4)));
typedef unsigned u32x4 __attribute__((ext_vector_type(4)));
constexpr int BM = 256, BK = 64, HALF = 128, HTB = HALF * BK * 2  , STAGE_BYTES = 8 * HTB, NXCD = 8, WGM = 8;

__host__ __device__ __forceinline__ int lds_byte(int r, int c) { const int st = (r >> 4) * 2 + (c >> 5), rr = r & 15, cc = c & 31, ob = rr * 64 + cc * 2; return st * 1024 + (ob ^ (((ob >> 9) & 1) << 5)); }
__host__ __device__ __forceinline__ void stage_rc(int b, int& R, int& C) { const int st = b / 1024, sb = b % 1024, swz = sb ^ (((sb >> 9) & 1) << 5); R = (st >> 1) * 16 + swz / 64; C = (st & 1) * 32 + (swz % 64) / 2; }
__host__ __device__ __forceinline__ int perm32(int rho) { const int n = rho >> 4, i = rho & 15; return 8 * (i >> 2) + 4 * n + (i & 3); }

struct Unit { int pm, pn; };
struct Gemm { const bf16_t* A; const bf16_t* Bt; int M, N, K; };

struct StaticOrder {
    int nM, nN, nwg, G, c;
    __host__ __device__ __forceinline__ void init(int M, int N, int G_, int c_) { nM = M / BM; nN = N / BM; nwg = nM * nN; G = G_; c = c_; }
    __host__ __device__ __forceinline__ bool next(int i, Unit& u) const {
        const long L = (long)i * G + c; if (L >= nwg) return false;
        int wgid = (int)L; { const int q = nwg / NXCD, r = nwg % NXCD, xcd = wgid % NXCD, off = wgid / NXCD; wgid = (xcd < r ? xcd * (q + 1) : r * (q + 1) + (xcd - r) * q) + off; }
        const int nig = WGM * nN, gid = wgid / nig, fm = gid * WGM, gsz = (nM - fm) < WGM ? (nM - fm) : WGM;
        u.pm = fm + ((wgid % nig) % gsz); u.pn = (wgid % nig) / gsz; return true;
    }
    __device__ __forceinline__ void a_ready(const Unit&) const {}
    __device__ __forceinline__ void done(const Unit&) const {}
};

__device__ __forceinline__ unsigned cvt_pk_bf16(float lo, float hi) { unsigned r; asm volatile("v_cvt_pk_bf16_f32 %0, %1, %2" : "=v"(r) : "v"(lo), "v"(hi)); return r; }
typedef float f32x2 __attribute__((ext_vector_type(2)));
__device__ __forceinline__ float bfl(unsigned w) { return __uint_as_float(w << 16); }
__device__ __forceinline__ float bfh(unsigned w) { return __uint_as_float(w & 0xffff0000u); }
constexpr int EPI_STAGE_OFF = 131072 + 1024;
__device__ __forceinline__ void stage_store16x64(int wid, int fr, int fq, u32x4 w0, u32x4 w1, bf16_t* rowbase  , size_t ld) {
    PG8_LAS unsigned char* sl = (PG8_LAS unsigned char*)(EPI_STAGE_OFF + wid * 2048);
    *(PG8_LAS u32x4*)(sl + fr * 128 + ((fq ^ (fr & 7)) << 4)) = w0;
    *(PG8_LAS u32x4*)(sl + fr * 128 + (((4 + fq) ^ (fr & 7)) << 4)) = w1;
    const int lane = fr + 16 * fq, r0 = lane >> 3, c = lane & 7;
    const u32x4 a = *(const PG8_LAS u32x4*)(sl + r0 * 128 + ((c ^ r0) << 4));
    const u32x4 b = *(const PG8_LAS u32x4*)(sl + (r0 + 8) * 128 + ((c ^ r0) << 4));
    *(u32x4*)(rowbase + (size_t)r0 * ld + c * 8) = a;
    *(u32x4*)(rowbase + (size_t)(r0 + 8) * ld + c * 8) = b;
}
__device__ __forceinline__ u32x4 pack8(const f32x4& v0, const f32x4& v1) { u32x4 w; w.x = cvt_pk_bf16(v0[0], v0[1]); w.y = cvt_pk_bf16(v0[2], v0[3]); w.z = cvt_pk_bf16(v1[0], v1[1]); w.w = cvt_pk_bf16(v1[2], v1[3]); return w; }

struct EpiProj {
    static constexpr bool PERM = true, AFTER_DRAIN = false, COL64 = true;
    const float* rstd; bf16_t *SBQ, *SBK, *SBV, *GQKV, *GZ, *GSB, *GGDN;
    __device__ __forceinline__ void operator()(const f32x4 (&acc)[2][2][4][2], const Unit& u, int wr, int wc, int fr_in, int fq_in) const {
        int lane_ = fr_in + 16 * fq_in; asm volatile("" : "+v"(lane_));
        const int fr = lane_ & 15, fq = lane_ >> 4;
        const int pn = u.pn; bf16_t* base; int ld, coff;
        if (pn < 2) { base = SBQ; ld = 512; coff = pn * 256; } else if (pn < 4) { base = SBK; ld = 512; coff = (pn - 2) * 256; } else if (pn < 6) { base = SBV; ld = 512; coff = (pn - 4) * 256; }
        else if (pn < 12) { base = GQKV; ld = 1536; coff = (pn - 6) * 256; } else if (pn < 14) { base = GZ; ld = 512; coff = (pn - 12) * 256; }
        else if (pn < 18) { base = GSB; ld = 1024; coff = (pn - 14) * 256; } else { base = GGDN; ld = 1024; coff = (pn - 18) * 256; }
        const int row0 = u.pm * BM + wr * 64, wid = wr * 4 + wc;
        float rsv[2][4];
#pragma unroll
        for (int ai = 0; ai < 2; ++ai)
#pragma unroll
            for (int m = 0; m < 4; ++m) rsv[ai][m] = rstd[row0 + ai * HALF + m * 16 + fr];
#pragma unroll
        for (int ai = 0; ai < 2; ++ai)
#pragma unroll
            for (int m = 0; m < 4; ++m) { const int rg = row0 + ai * HALF + m * 16; const float rs = rsv[ai][m];
                stage_store16x64(wid, fr, fq, pack8(acc[ai][0][m][0] * rs, acc[ai][0][m][1] * rs), pack8(acc[ai][1][m][0] * rs, acc[ai][1][m][1] * rs), base + (size_t)rg * ld + coff + wc * 64, ld); }
    }
};
struct EpiSplit {
    static constexpr bool PERM = true, AFTER_DRAIN = false, COL64 = true;
    bf16_t *O0, *O1; int ldc, split_tiles;
    __device__ __forceinline__ void operator()(const f32x4 (&acc)[2][2][4][2], const Unit& u, int wr, int wc, int fr_in, int fq_in) const {
        int lane_ = fr_in + 16 * fq_in; asm volatile("" : "+v"(lane_));
        const int fr = lane_ & 15, fq = lane_ >> 4;
        bf16_t* base = u.pn < split_tiles ? O0 : O1; const int coff = (u.pn < split_tiles ? u.pn : u.pn - split_tiles) * 256;
        const int row0 = u.pm * BM + wr * 64, wid = wr * 4 + wc;
#pragma unroll
        for (int ai = 0; ai < 2; ++ai)
#pragma unroll
            for (int m = 0; m < 4; ++m) { const int rg = row0 + ai * HALF + m * 16;
                stage_store16x64(wid, fr, fq, pack8(acc[ai][0][m][0], acc[ai][0][m][1]), pack8(acc[ai][1][m][0], acc[ai][1][m][1]), base + (size_t)rg * ldc + coff + wc * 64, ldc); }
    }
};
template <bool ADD> struct EpiMerge {
    static constexpr bool PERM = true, AFTER_DRAIN = false, COL64 = true;
    const bf16_t* gate; bf16_t* M;
    __device__ __forceinline__ void operator()(const f32x4 (&acc)[2][2][4][2], const Unit& u, int wr, int wc, int fr_in, int fq_in) const {
        int lane_ = fr_in + 16 * fq_in; asm volatile("" : "+v"(lane_));
        const int fr = lane_ & 15, fq = lane_ >> 4;
        const int row0 = u.pm * BM + wr * 64, col0 = u.pn * BM + wc * 64, wid = wr * 4 + wc;
#pragma unroll
        for (int ab = 0; ab < 4; ++ab) { const int ai = ab >> 1, mb = (ab & 1) * 2;
            u32x4 gl[4][2], pl[4][2];
#pragma unroll
            for (int m = mb; m < mb + 2; ++m)
#pragma unroll
                for (int bj = 0; bj < 2; ++bj) { const size_t o = (size_t)(row0 + ai * HALF + m * 16 + fr) * 1024 + col0 + 8 * fq + bj * 32; gl[m][bj] = *(const u32x4*)(gate + o); if (ADD) pl[m][bj] = *(const u32x4*)(M + o); }
#pragma unroll
            for (int m = mb; m < mb + 2; ++m) { const int rg = row0 + ai * HALF + m * 16;
                u32x4 wv[2];
#pragma unroll
                for (int bj = 0; bj < 2; ++bj) { const u32x4 g = gl[m][bj];
                    float gv[8] = {bfl(g.x), bfh(g.x), bfl(g.y), bfh(g.y), bfl(g.z), bfh(g.z), bfl(g.w), bfh(g.w)};
                    float pv[8] = {0.f, 0.f, 0.f, 0.f, 0.f, 0.f, 0.f, 0.f};
                    if (ADD) { const u32x4 p = pl[m][bj]; pv[0] = bfl(p.x); pv[1] = bfh(p.x); pv[2] = bfl(p.y); pv[3] = bfh(p.y); pv[4] = bfl(p.z); pv[5] = bfh(p.z); pv[6] = bfl(p.w); pv[7] = bfh(p.w); }
                    float r[8];
#pragma unroll
                    for (int j = 0; j < 8; ++j) { const float a = j < 4 ? acc[ai][bj][m][0][j] : acc[ai][bj][m][1][j - 4]; r[j] = pv[j] + a * __builtin_amdgcn_rcpf(1.f + __expf(-gv[j])); }
                    wv[bj].x = cvt_pk_bf16(r[0], r[1]); wv[bj].y = cvt_pk_bf16(r[2], r[3]); wv[bj].z = cvt_pk_bf16(r[4], r[5]); wv[bj].w = cvt_pk_bf16(r[6], r[7]); }
                stage_store16x64(wid, fr, fq, wv[0], wv[1], M + (size_t)rg * 1024 + col0, 1024); }
        }
    }
};
template <bool IN_F32> struct EpiRes {
    static constexpr bool PERM = true, AFTER_DRAIN = false, COL64 = true;
    const float* xin_f; const bf16_t* xin_b; bf16_t* xb; float* SS;
    __device__ __forceinline__ void operator()(const f32x4 (&acc)[2][2][4][2], const Unit& u, int wr, int wc, int fr_in, int fq_in) const {
        int lane_ = fr_in + 16 * fq_in; asm volatile("" : "+v"(lane_));
        const int fr = lane_ & 15, fq = lane_ >> 4;
        const int row0 = u.pm * BM + wr * 64, col0 = u.pn * BM + wc * 64, wid = wr * 4 + wc;
#pragma unroll
        for (int ab = 0; ab < 4; ++ab) { const int ai = ab >> 1, mb = (ab & 1) * 2;
            f32x4 xl[4][2][2];
#pragma unroll
            for (int m = mb; m < mb + 2; ++m)
#pragma unroll
                for (int bj = 0; bj < 2; ++bj) { const size_t o = (size_t)(row0 + ai * HALF + m * 16 + fr) * 1024 + col0 + 8 * fq + bj * 32;
                    if (IN_F32) { xl[m][bj][0] = *(const f32x4*)(xin_f + o); xl[m][bj][1] = *(const f32x4*)(xin_f + o + 4); }
                    else { const u32x4 p = *(const u32x4*)(xin_b + o); xl[m][bj][0] = (f32x4){bfl(p.x), bfh(p.x), bfl(p.y), bfh(p.y)}; xl[m][bj][1] = (f32x4){bfl(p.z), bfh(p.z), bfl(p.w), bfh(p.w)}; } }
            float sv[4];
#pragma unroll
            for (int m = mb; m < mb + 2; ++m) { const int rg = row0 + ai * HALF + m * 16; float s = 0.f;
                u32x4 wv[2];
#pragma unroll
                for (int bj = 0; bj < 2; ++bj) { const u32x4 w = pack8(xl[m][bj][0] + acc[ai][bj][m][0], xl[m][bj][1] + acc[ai][bj][m][1]); wv[bj] = w;
                    const float r0 = bfl(w.x), r1 = bfh(w.x), r2 = bfl(w.y), r3 = bfh(w.y), r4 = bfl(w.z), r5 = bfh(w.z), r6 = bfl(w.w), r7 = bfh(w.w);
                    s += (r0 * r0 + r1 * r1) + (r2 * r2 + r3 * r3) + (r4 * r4 + r5 * r5) + (r6 * r6 + r7 * r7); }
                stage_store16x64(wid, fr, fq, wv[0], wv[1], xb + (size_t)rg * 1024 + col0, 1024);
                s += __shfl_xor(s, 16); s += __shfl_xor(s, 32); sv[m] = s; }
#pragma unroll
            for (int m = mb; m < mb + 2; ++m) if (fq == 0) SS[(size_t)(row0 + ai * HALF + m * 16 + fr) * 16 + u.pn * 4 + wc] = sv[m];
        }
    }
};
struct EpiScale {
    static constexpr bool PERM = true, AFTER_DRAIN = false, COL64 = true;
    const float* rstd; bf16_t* O; int ldc;
    __device__ __forceinline__ void operator()(const f32x4 (&acc)[2][2][4][2], const Unit& u, int wr, int wc, int fr_in, int fq_in) const {
        int lane_ = fr_in + 16 * fq_in; asm volatile("" : "+v"(lane_));
        const int fr = lane_ & 15, fq = lane_ >> 4;
        const int row0 = u.pm * BM + wr * 64, col0 = u.pn * BM + wc * 64, wid = wr * 4 + wc;
        float rsv[2][4];
#pragma unroll
        for (int ai = 0; ai < 2; ++ai)
#pragma unroll
            for (int m = 0; m < 4; ++m) rsv[ai][m] = rstd[row0 + ai * HALF + m * 16 + fr];
#pragma unroll
        for (int ai = 0; ai < 2; ++ai)
#pragma unroll
            for (int m = 0; m < 4; ++m) { const int rg = row0 + ai * HALF + m * 16; const float rs = rsv[ai][m];
                stage_store16x64(wid, fr, fq, pack8(acc[ai][0][m][0] * rs, acc[ai][0][m][1] * rs), pack8(acc[ai][1][m][0] * rs, acc[ai][1][m][1] * rs), O + (size_t)rg * ldc + col0, ldc); }
    }
};
template <class Epi, class Sched, bool ALIGN_EPI = false, bool SP2 = false>
__device__ __forceinline__ void gemm_phase(PG8_LAS unsigned char* lds, const Gemm g, const Sched& S, const Epi& E) {
    const int tid = threadIdx.x, wid = __builtin_amdgcn_readfirstlane(tid >> 6), lane = tid & 63, wr = wid >> 2, wc = wid & 3, fr = lane & 15, fq = lane >> 4;
    const int K = g.K, nt = K / BK;
    unsigned voffA[2], voffB[2];
#pragma unroll
    for (int i = 0; i < 2; ++i) { int R, C; stage_rc(tid * 16 + i * 8192, R, C); const int Rb = Epi::PERM ? ((Epi::COL64 ? 2 * (R & ~31) : (R & ~31)) + perm32(R & 31)) : R;
        voffA[i] = (unsigned)(R * K + C) * 2u; voffB[i] = (unsigned)(Rb * K + C) * 2u; }
    const size_t kstep = (size_t)(BK * 2);
    const size_t hstep = (size_t)HALF * K * 2;
    const size_t bhstep = Epi::COL64 ? (size_t)32 * K * 2 : hstep;
    const size_t tstep = 2 * hstep;
    const unsigned ldsw = (unsigned)wid * 1024u;
    const int aoff = lds_byte(wr * 64 + fr, fq * 8), boff = lds_byte(wc * 32 + fr, fq * 8);
#define PG8_SA(b, h) (((b) * 2 + (h)) * HTB)
#define PG8_SB(b, h) ((4 + (b) * 2 + (h)) * HTB)
#define PG8_STAGE(bufoff, gbase, voff) do { _Pragma("unroll") for (int _i = 0; _i < 2; ++_i) \
        __builtin_amdgcn_global_load_lds((const unsigned*)((const char*)(gbase) + (voff)[_i]), (PG8_LAS unsigned*)(lds + (bufoff) + ldsw + _i * 8192), 16, 0, 0); } while (0)
#define PG8_LDA(dst, b, h) do { _Pragma("unroll") for (int m = 0; m < 4; ++m) _Pragma("unroll") for (int k = 0; k < 2; ++k) dst[m][k] = *(const PG8_LAS bf16x8*)(lds + PG8_SA(b, h) + aoff + m * 2048 + k * 1024); } while (0)
#define PG8_LDB(dst, b, h) do { _Pragma("unroll") for (int n = 0; n < 2; ++n) _Pragma("unroll") for (int k = 0; k < 2; ++k) dst[n][k] = *(const PG8_LAS bf16x8*)(lds + PG8_SB(b, h) + boff + n * 2048 + k * 1024); } while (0)
#define PG8_MMA(ai, bj, At, Bt) do { __builtin_amdgcn_s_setprio(1); _Pragma("unroll") for (int m = 0; m < 4; ++m) _Pragma("unroll") for (int n = 0; n < 2; ++n) _Pragma("unroll") for (int k = 0; k < 2; ++k) \
        acc[ai][bj][m][n] = __builtin_amdgcn_mfma_f32_16x16x32_bf16(Bt[n][k], At[m][k], acc[ai][bj][m][n], 0, 0, 0); __builtin_amdgcn_s_setprio(0); } while (0)
#define PG8_WAIT_V(n) asm volatile("s_waitcnt vmcnt(" #n ")" ::: "memory")
#define PG8_WAIT_L(n) asm volatile("s_waitcnt lgkmcnt(" #n ")" ::: "memory")
#define PG8_BAR __builtin_amdgcn_s_barrier()
#define PG8_SCHED __builtin_amdgcn_sched_barrier(0)
    Unit cur, nxt; int ui = 0;
    if (!S.next(0, cur)) return;
    f32x4 acc[2][2][4][2];
#pragma unroll
    for (int a = 0; a < 2; ++a)
#pragma unroll
        for (int b = 0; b < 2; ++b)
#pragma unroll
            for (int m = 0; m < 4; ++m)
#pragma unroll
                for (int n = 0; n < 2; ++n) acc[a][b][m][n] = (f32x4){0.f, 0.f, 0.f, 0.f};
    bf16x8 At[4][2], B0[2][2], B1[2][2];
    const char* cA = (const char*)g.A + (size_t)cur.pm * tstep; const char* cB = (const char*)g.Bt + (size_t)cur.pn * tstep;
    S.a_ready(cur);
    if constexpr (SP2) {
        PG8_STAGE(PG8_SB(0, 0), cB, voffB); PG8_STAGE(PG8_SB(0, 1), cB + bhstep, voffB); PG8_STAGE(PG8_SA(0, 0), cA, voffA); PG8_STAGE(PG8_SA(0, 1), cA + hstep, voffA);
        if (wr == 1) PG8_BAR;
        PG8_WAIT_V(2); PG8_BAR;
        PG8_STAGE(PG8_SB(1, 0), cB + kstep, voffB); PG8_STAGE(PG8_SA(1, 0), cA + kstep, voffA); PG8_STAGE(PG8_SB(1, 1), cB + bhstep + kstep, voffB);
        PG8_WAIT_V(6); PG8_BAR;
    } else {
        PG8_STAGE(PG8_SB(0, 0), cB, voffB); PG8_STAGE(PG8_SA(0, 0), cA, voffA); PG8_STAGE(PG8_SB(0, 1), cB + bhstep, voffB); PG8_STAGE(PG8_SA(0, 1), cA + hstep, voffA);
        if (wr == 1) PG8_BAR;
        PG8_WAIT_V(4); PG8_BAR;
        PG8_STAGE(PG8_SB(1, 0), cB + kstep, voffB); PG8_STAGE(PG8_SA(1, 0), cA + kstep, voffA); PG8_STAGE(PG8_SB(1, 1), cB + bhstep + kstep, voffB);
        PG8_WAIT_V(6); PG8_BAR;
    }
    for (;;) {
        const bool has_next = S.next(ui + 1, nxt);
        const char* nA = has_next ? (const char*)g.A + (size_t)nxt.pm * tstep : cA; const char* nB = has_next ? (const char*)g.Bt + (size_t)nxt.pn * tstep : cB;
        for (int t = 0; t < nt; t += 2) {
            const bool last = (t == nt - 2);
            const char* a1 = cA + (size_t)(t + 1) * kstep;
            const char* a2 = last ? nA : cA + (size_t)(t + 2) * kstep; const char* b2 = last ? nB : cB + (size_t)(t + 2) * kstep;
            const char* a3 = a2 + kstep; const char* b3 = b2 + kstep;
            if (last && has_next) S.a_ready(nxt);
            if constexpr (SP2) {
            PG8_LDB(B0, 0, 0); PG8_LDB(B1, 0, 1); PG8_SCHED; PG8_LDA(At, 0, 0); PG8_STAGE(PG8_SA(1, 1), a1 + hstep, voffA);
            PG8_WAIT_V(8); PG8_WAIT_L(0); PG8_BAR; PG8_MMA(0, 0, At, B0); PG8_MMA(0, 1, At, B1); PG8_BAR; PG8_SCHED;
            PG8_LDA(At, 0, 1); PG8_STAGE(PG8_SB(0, 0), b2, voffB); PG8_STAGE(PG8_SB(0, 1), b2 + bhstep, voffB); PG8_STAGE(PG8_SA(0, 0), a2, voffA);
            PG8_WAIT_V(8); PG8_WAIT_L(0); PG8_BAR; PG8_MMA(1, 0, At, B0); PG8_MMA(1, 1, At, B1); PG8_BAR; PG8_SCHED;
            PG8_LDB(B0, 1, 0); PG8_LDB(B1, 1, 1); PG8_SCHED; PG8_LDA(At, 1, 0); PG8_STAGE(PG8_SA(0, 1), a2 + hstep, voffA);
            PG8_WAIT_V(8); PG8_WAIT_L(0); PG8_BAR; PG8_MMA(0, 0, At, B0); PG8_MMA(0, 1, At, B1); PG8_BAR; PG8_SCHED;
            PG8_LDA(At, 1, 1); PG8_STAGE(PG8_SB(1, 0), b3, voffB); PG8_STAGE(PG8_SB(1, 1), b3 + bhstep, voffB); PG8_STAGE(PG8_SA(1, 0), a3, voffA);
            PG8_WAIT_V(8); PG8_WAIT_L(0); PG8_BAR; PG8_MMA(1, 0, At, B0); PG8_MMA(1, 1, At, B1); PG8_BAR; PG8_SCHED;
            } else {
            PG8_LDB(B0, 0, 0); PG8_SCHED; PG8_LDA(At, 0, 0); PG8_STAGE(PG8_SA(1, 1), a1 + hstep, voffA);
            PG8_WAIT_L(8); PG8_BAR; PG8_WAIT_L(0); PG8_MMA(0, 0, At, B0); PG8_BAR; PG8_SCHED;
            PG8_LDB(B1, 0, 1); PG8_STAGE(PG8_SB(0, 0), b2, voffB);
            PG8_BAR; PG8_WAIT_L(0); PG8_MMA(0, 1, At, B1); PG8_BAR;
            PG8_LDA(At, 0, 1); PG8_STAGE(PG8_SA(0, 0), a2, voffA);
            PG8_BAR; PG8_WAIT_L(0); PG8_MMA(1, 0, At, B0); PG8_BAR; PG8_SCHED;
            PG8_STAGE(PG8_SB(0, 1), b2 + bhstep, voffB);
            PG8_WAIT_V(6); PG8_BAR; PG8_MMA(1, 1, At, B1); PG8_BAR;
            PG8_LDB(B0, 1, 0); PG8_SCHED; PG8_LDA(At, 1, 0); PG8_STAGE(PG8_SA(0, 1), a2 + hstep, voffA);
            PG8_WAIT_L(8); PG8_BAR; PG8_WAIT_L(0); PG8_MMA(0, 0, At, B0); PG8_BAR; PG8_SCHED;
            PG8_LDB(B1, 1, 1); PG8_STAGE(PG8_SB(1, 0), b3, voffB);
            PG8_BAR; PG8_WAIT_L(0); PG8_MMA(0, 1, At, B1); PG8_BAR;
            PG8_LDA(At, 1, 1); PG8_STAGE(PG8_SA(1, 0), a3, voffA);
            PG8_BAR; PG8_WAIT_L(0); PG8_MMA(1, 0, At, B0); PG8_BAR; PG8_SCHED;
            PG8_STAGE(PG8_SB(1, 1), b3 + bhstep, voffB);
            PG8_WAIT_V(6); PG8_BAR; PG8_MMA(1, 1, At, B1); PG8_BAR;
            }
        }
        if constexpr (ALIGN_EPI) { if (wr == 0) PG8_BAR; }
        if constexpr (!Epi::AFTER_DRAIN) { E(acc, cur, wr, wc, fr, fq); S.done(cur); }
        if (!has_next) break;
#pragma unroll
        for (int a = 0; a < 2; ++a)
#pragma unroll
            for (int b = 0; b < 2; ++b)
#pragma unroll
                for (int m = 0; m < 4; ++m)
#pragma unroll
                    for (int n = 0; n < 2; ++n) acc[a][b][m][n] = (f32x4){0.f, 0.f, 0.f, 0.f};
        cur = nxt; cA = nA; cB = nB; ++ui;
        if constexpr (ALIGN_EPI) { if (wr == 1) PG8_BAR; }
    }
    PG8_WAIT_V(0);
    if constexpr (!ALIGN_EPI) { if (wr == 0) PG8_BAR; }
    PG8_BAR;
    if constexpr (Epi::AFTER_DRAIN) { E.fused(acc, cur, wr, wc, fr, fq, lds, wid, lane); S.done(cur); }
#undef PG8_SA
#undef PG8_SB
#undef PG8_STAGE
#undef PG8_LDA
#undef PG8_LDB
#undef PG8_MMA
#undef PG8_WAIT_V
#undef PG8_WAIT_L
#undef PG8_BAR
#undef PG8_SCHED
}
}
#define GAS __attribute__((address_space(1)))
#define LAS __attribute__((address_space(3)))
typedef unsigned short bf16;
typedef unsigned v4u __attribute__((ext_vector_type(4)));
typedef float f32x4 __attribute__((ext_vector_type(4)));
typedef short bf16x8 __attribute__((ext_vector_type(8)));
typedef GAS unsigned gu32;
typedef GAS unsigned long long gu64;
#define RLX_AGENT __ATOMIC_RELAXED, __HIP_MEMORY_SCOPE_AGENT
#define LDS_WAIT() asm volatile("s_waitcnt lgkmcnt(0)" ::: "memory")
#define VM_WAIT() asm volatile("s_waitcnt vmcnt(0)" ::: "memory")
__device__ __forceinline__ unsigned long long rt() { return __builtin_amdgcn_s_memrealtime(); }
__device__ __forceinline__ unsigned pk2(float lo, float hi) { return (unsigned)f2bf(lo) | ((unsigned)f2bf(hi) << 16); }

#define XB_TMO      128
#define XB_XCNT(j)  (256  + 64 * (j))
#define XB_XSUB(j)  (1280 + 64 * (j))
#define XB_XGEN(j)  (2304 + 64 * (j))
#define XB_TOP      3328
#define XB_TOPGEN   3392
#define XCD_BAR_WORDS 3456
#define XB_SPIN_CAP (1u << 18)

__device__ __forceinline__ unsigned xb_ld(unsigned* p)              { return __hip_atomic_load(p, __ATOMIC_RELAXED, __HIP_MEMORY_SCOPE_AGENT); }
__device__ __forceinline__ unsigned xb_add(unsigned* p, unsigned v) { return __hip_atomic_fetch_add(p, v, __ATOMIC_RELAXED, __HIP_MEMORY_SCOPE_AGENT); }
__device__ __forceinline__ unsigned xb_xcc_id() { return (unsigned)__builtin_amdgcn_s_getreg((3 << 11) | 20) & 0xFu; }
#define XB_SPIN(cond, bar) do { unsigned _sp = 0; while (cond) { __builtin_amdgcn_s_sleep(1); \
    if ((++_sp & 255u) == 0u) { if (xb_ld(&(bar)[XB_TMO])) break; if (_sp > XB_SPIN_CAP) { atomicAdd(&(bar)[XB_TMO], 1u); break; } } } } while (0)

struct XcdBarrier {
    unsigned* bar; unsigned x;
    volatile LAS unsigned* st;
};

__device__ __forceinline__ XcdBarrier xcd_barrier_post(unsigned* bar, volatile LAS unsigned* st) {
    XcdBarrier b; b.bar = bar; b.x = xb_xcc_id(); b.st = st;
    if (threadIdx.x == 0) (void)xb_add(&bar[XB_XCNT(b.x)], 1u);
    return b;
}
__device__ __forceinline__ void xcd_barrier_complete(unsigned* bar, unsigned x, unsigned& nloc, unsigned& nx) {
    const unsigned G = gridDim.x * gridDim.y * gridDim.z;
    unsigned sum, cnt, mine, sp = 0u;
    for (;;) {
        sum = 0u; cnt = 0u; mine = 0u;
#pragma unroll
        for (unsigned j = 0; j < 16; ++j) { const unsigned c = xb_ld(&bar[XB_XCNT(j)]); sum += c; cnt += (c > 0u) ? 1u : 0u; mine = (j == x) ? c : mine; }
        if (sum == G) break;
        __builtin_amdgcn_s_sleep(1);
        if ((++sp & 255u) == 0u) { if (xb_ld(&bar[XB_TMO])) break; if (sp > XB_SPIN_CAP) { atomicAdd(&bar[XB_TMO], 1u); break; } }
    }
    nloc = mine > 0u ? mine : 1u; nx = cnt > 0u ? cnt : 1u;
}

__device__ __forceinline__ void xcd_barrier(const XcdBarrier& b) {
    asm volatile("s_waitcnt vmcnt(0)" ::: "memory");
    __syncthreads();
    if (threadIdx.x == 0) {
        unsigned* bar = b.bar;
        __builtin_amdgcn_s_waitcnt(0);
        unsigned nloc = b.st[0], nx = b.st[1];
        if (nloc == 0u) { xcd_barrier_complete(bar, b.x, nloc, nx); b.st[0] = nloc; b.st[1] = nx; }
        const unsigned old = xb_add(&bar[XB_XSUB(b.x)], 1u);
        const unsigned gen = old / nloc;
        if (old + 1u == (gen + 1u) * nloc) {
            __builtin_amdgcn_fence(__ATOMIC_RELEASE, "agent");
            asm volatile("s_waitcnt vmcnt(0)" ::: "memory");
            const unsigned og = xb_add(&bar[XB_TOP], 1u);
            const unsigned tg = og / nx;
            if (og + 1u == (tg + 1u) * nx) xb_add(&bar[XB_TOPGEN], 1u);
            else XB_SPIN(xb_ld(&bar[XB_TOPGEN]) == tg, bar);
            __builtin_amdgcn_fence(__ATOMIC_ACQUIRE, "agent");
            xb_add(&bar[XB_XGEN(b.x)], 1u);
            asm volatile("s_waitcnt vmcnt(0)" ::: "memory");
        } else {
            XB_SPIN(xb_ld(&bar[XB_XGEN(b.x)]) == gen, bar);
            __builtin_amdgcn_fence(__ATOMIC_ACQUIRE, "agent");
            asm volatile("s_waitcnt vmcnt(0)" ::: "memory");
        }
    }
    __syncthreads();
}
constexpr size_t KiB = 1024;
constexpr size_t WS_CTL = 0, CTL_ZERO_BYTES = 1 * MiB;
constexpr size_t WS_WIN = 1 * MiB, WS_WSB = 12 * MiB, WS_WGDN = 13 * MiB, WS_WMIX = 14 * MiB, WS_WCQ = 16 * MiB, WS_WCO = 18 * MiB, WS_WCKV = 20 * MiB, WS_WPQ = 24 * MiB, WS_SKB = 28 * MiB, WS_U16 = 30 * MiB, WS_V16 = 62 * MiB;
constexpr size_t WS_RSTD0 = 94 * MiB, WS_RSTD2 = 94 * MiB + 256 * KiB, WS_CD = 94 * MiB + 384 * KiB, WS_GB = 94 * MiB + 512 * KiB;
constexpr size_t WS_MN = 96 * MiB, WS_KC = 98 * MiB, WS_VC = 100 * MiB, WS_SS = 102 * MiB;
constexpr size_t WS_A0 = 104 * MiB;
constexpr size_t WS_NW = 104 * MiB, WS_QD = 136 * MiB;
constexpr size_t WS_A1 = 168 * MiB;
constexpr size_t WS_ORAW = 168 * MiB, WS_OSS = 200 * MiB, WS_OG = 232 * MiB;
constexpr size_t WS_GZ = 264 * MiB;
constexpr size_t WS_GSB = 296 * MiB, WS_GGDN = 360 * MiB;
constexpr size_t WS_KDT = 424 * MiB, WS_QK = 456 * MiB, WS_UT = 472 * MiB;
constexpr size_t WS_U8 = 30 * MiB, WS_V8 = 46 * MiB, WS_SUV = 62 * MiB;
constexpr size_t WS_PART = 344 * MiB;
constexpr size_t WS_END = 512 * MiB;
constexpr int CW_SUB = 12288;
constexpr int CW_BAR = 4096;

constexpr int NWAVES = 8;
constexpr int RING_BYTES = 131072, LDSCTL_OFF = RING_BYTES, MISC_OFF = LDSCTL_OFF + 320, LDS_BYTES = 149504;

struct Args {
    const float *x, *mem, *g_mix, *w_in, *gdn_conv, *a_log, *dt_bias, *gdn_norm_g, *w_sb_up, *w_gdn_up, *w_mix_out, *g_cross, *g_mem, *w_cq, *w_ckv, *w_co, *g_peer, *w_pq, *subkeys, *peer_u, *peer_v, *g_final;
    float* out; unsigned char* ws; int ph_lo, ph_hi, bar_region, pad;
};

struct Frame {
    LAS unsigned char* lds; int tid, lane, wave, vcu, G;
};


typedef short bf16x8_t __attribute__((ext_vector_type(8)));
typedef float f32x16_t __attribute__((ext_vector_type(16)));
typedef short v4i16_t __attribute__((ext_vector_type(4)));
typedef float f32x2v_t __attribute__((ext_vector_type(2))); typedef __bf16 bf16x2v_t __attribute__((ext_vector_type(2)));
__device__ __forceinline__ unsigned cvtpk(float lo, float hi) { f32x2v_t v = {lo, hi}; bf16x2v_t b = __builtin_convertvector(v, bf16x2v_t); return __builtin_bit_cast(unsigned, b); }
__device__ __forceinline__ v4i16_t lds_tr16(LAS unsigned char* p) { return __builtin_amdgcn_ds_read_tr16_b64_v4i16((LAS v4i16_t*)p); }

__device__ __forceinline__ void sb_phase(LAS unsigned char* wlds  , const bf16_t* SBQ, const bf16_t* SBK, const bf16_t* SBV, bf16_t* OSB, int gw, int ngw, int lane) {
    const int q = lane & 31, hi = lane >> 5;
    bf16x8_t Mf[2];
#pragma unroll
    for (int s = 0; s < 2; ++s)
#pragma unroll
        for (int j = 0; j < 8; ++j) { const int k = 16 * s + 8 * (j >> 2) + 4 * hi + (j & 3); Mf[s][j] = (k > q) ? (short)0x3F80 : (short)0; }
    const int vrow = lane >> 3, vch = lane & 7;
    const int g4 = lane >> 4, qq = (lane >> 2) & 3, p4 = lane & 3;
    LAS unsigned char* trb = wlds + (4 * (g4 >> 1) + qq) * 192 + ((g4 & 1) * 16 + 4 * p4) * 2;
    for (int item = gw; item < 32 * 256; item += ngw) {
        const int bh = item >> 8, qt = item & 255, b = bh >> 3, h = bh & 7;
        const size_t base = (size_t)b * SEQ;
        const bf16_t* Qp = SBQ + (base + qt * 32 + q) * 512 + h * 64 + 8 * hi;
        bf16x8_t Qf[4];
#pragma unroll
        for (int ks = 0; ks < 4; ++ks) Qf[ks] = *(const bf16x8_t*)(Qp + 16 * ks);
        f32x16_t o0 = {}, o1 = {};
        float carry = 0.f;
        bf16x8_t Kn[4]; v4u vn[4];
        {   const bf16_t* Kp = SBK + (base + qt * 32 + q) * 512 + h * 64 + 8 * hi;
#pragma unroll
            for (int ks = 0; ks < 4; ++ks) Kn[ks] = *(const bf16x8_t*)(Kp + 16 * ks);
#pragma unroll
            for (int i = 0; i < 4; ++i) vn[i] = *(const v4u*)(SBV + (base + qt * 32 + vrow + 8 * i) * 512 + h * 64 + vch * 8); }
        for (int kb = qt; kb >= 0; --kb) {
            bf16x8_t Kf[4]; v4u vv[4];
#pragma unroll
            for (int ks = 0; ks < 4; ++ks) Kf[ks] = Kn[ks];
#pragma unroll
            for (int i = 0; i < 4; ++i) vv[i] = vn[i];
            {   const int kn = kb > 0 ? kb - 1 : 0;
                const bf16_t* Kp = SBK + (base + kn * 32 + q) * 512 + h * 64 + 8 * hi;
#pragma unroll
                for (int ks = 0; ks < 4; ++ks) Kn[ks] = *(const bf16x8_t*)(Kp + 16 * ks);
#pragma unroll
                for (int i = 0; i < 4; ++i) vn[i] = *(const v4u*)(SBV + (base + kn * 32 + vrow + 8 * i) * 512 + h * 64 + vch * 8); }
            f32x16_t st = {};
#pragma unroll
            for (int ks = 0; ks < 4; ++ks) st = __builtin_amdgcn_mfma_f32_32x32x16_bf16(Kf[ks], Qf[ks], st, 0, 0, 0);
#pragma unroll
            for (int i = 0; i < 4; ++i) *(LAS v4u*)(wlds + (vrow + 8 * i) * 192 + vch * 16) = vv[i];
            const bool diag = (kb == qt);
            float z[16], lk[16];
#pragma unroll
            for (int r = 0; r < 16; ++r) {
                const int key = (r & 3) + 8 * (r >> 2) + 4 * hi;
                z[r] = st[r] * 0.125f;
                const float sp = fmaxf(z[r], 0.f) + __logf(1.f + __expf(-fabsf(z[r])));
                const bool valid = !diag || key < q;
                lk[r] = valid ? -sp : 0.f;
                z[r] = valid ? z[r] - sp : -INFINITY;
            }
            bf16x8_t lh[2], ll[2];
#pragma unroll
            for (int s = 0; s < 2; ++s) {
                unsigned wh[4], wl[4];
#pragma unroll
                for (int jj = 0; jj < 4; ++jj) { const float a = lk[8 * s + 2 * jj], c = lk[8 * s + 2 * jj + 1]; wh[jj] = cvtpk(a, c);
                    wl[jj] = cvtpk(a - __uint_as_float(wh[jj] << 16), c - __uint_as_float(wh[jj] & 0xffff0000u)); }
                lh[s] = __builtin_bit_cast(bf16x8_t, (v4u){wh[0], wh[1], wh[2], wh[3]}); ll[s] = __builtin_bit_cast(bf16x8_t, (v4u){wl[0], wl[1], wl[2], wl[3]});
            }
            f32x16_t af;
#pragma unroll
            for (int r = 0; r < 16; ++r) af[r] = carry;
            af = __builtin_amdgcn_mfma_f32_32x32x16_bf16(Mf[0], lh[0], af, 0, 0, 0);
            af = __builtin_amdgcn_mfma_f32_32x32x16_bf16(Mf[1], lh[1], af, 0, 0, 0);
            af = __builtin_amdgcn_mfma_f32_32x32x16_bf16(Mf[0], ll[0], af, 0, 0, 0);
            af = __builtin_amdgcn_mfma_f32_32x32x16_bf16(Mf[1], ll[1], af, 0, 0, 0);
            float tot = af[0] + lk[0];
            tot = __shfl(tot, q);
            float pr[16];
#pragma unroll
            for (int r = 0; r < 16; ++r) pr[r] = __expf(z[r] + af[r]);
            bf16x8_t pa[2];
#pragma unroll
            for (int s = 0; s < 2; ++s) pa[s] = __builtin_bit_cast(bf16x8_t, (v4u){cvtpk(pr[8 * s], pr[8 * s + 1]), cvtpk(pr[8 * s + 2], pr[8 * s + 3]), cvtpk(pr[8 * s + 4], pr[8 * s + 5]), cvtpk(pr[8 * s + 6], pr[8 * s + 7])});
            asm volatile("s_waitcnt lgkmcnt(0)" ::: "memory");
#pragma unroll
            for (int s = 0; s < 2; ++s) {
                const v4i16_t a0 = lds_tr16(trb + (16 * s) * 192), a1 = lds_tr16(trb + (16 * s + 8) * 192);
                const v4i16_t c0 = lds_tr16(trb + (16 * s) * 192 + 64), c1 = lds_tr16(trb + (16 * s + 8) * 192 + 64);
                const bf16x8_t vb0 = {a0[0], a0[1], a0[2], a0[3], a1[0], a1[1], a1[2], a1[3]}, vb1 = {c0[0], c0[1], c0[2], c0[3], c1[0], c1[1], c1[2], c1[3]};
                o0 = __builtin_amdgcn_mfma_f32_32x32x16_bf16(pa[s], vb0, o0, 0, 0, 0);
                o1 = __builtin_amdgcn_mfma_f32_32x32x16_bf16(pa[s], vb1, o1, 0, 0, 0);
            }
            carry = tot;
            if (__all(carry < -104.f)) break;
        }
        bf16_t* Op = OSB + (base + qt * 32) * 512 + h * 64 + q;
#pragma unroll
        for (int r = 0; r < 16; ++r) { const int row = (r & 3) + 8 * (r >> 2) + 4 * hi; Op[(size_t)row * 512] = f2bf(o0[r]); Op[(size_t)row * 512 + 32] = f2bf(o1[r]); }
    }
}
typedef float f32x4_t __attribute__((ext_vector_type(4)));
typedef unsigned v2u __attribute__((ext_vector_type(2)));
__device__ __forceinline__ float bflo(unsigned w) { return __uint_as_float(w << 16); }
__device__ __forceinline__ float bfhi(unsigned w) { return __uint_as_float(w & 0xffff0000u); }
__device__ __forceinline__ int frag_off(int r, int k0, int KS) { return (((r >> 4) * KS + (k0 >> 5)) << 9) + (((r & 15) + 16 * ((k0 & 15) >> 2)) << 3) + (((k0 & 31) >> 4) << 2); }

constexpr int GP_KS = 0, GP_QS = 17408, GP_VS = 34816, GP_AS = 52224, GP_WT = 69632, GP_GC = 87040, GP_BETA = 87296, GP_EGC = 87552, GP_CW = 88064, GP_TS = 94208;
constexpr int GROW = 136;

#define LDS_BARRIER() do { asm volatile("s_waitcnt lgkmcnt(0)" ::: "memory"); __builtin_amdgcn_s_barrier(); asm volatile("" ::: "memory"); } while (0)
struct GdnBufs { bf16_t *NW, *QD, *KDT, *QK, *UT; float* CD; bf16_t* ORAW; float* OSS; };

__device__ __forceinline__ void gdn_prep_phase(Frame& F, const Args& a, const bf16_t* GQKV, const float* GB, const float* GA, const GdnBufs& Gb) {
    LAS unsigned char* L = F.lds;
    LAS bf16_t* KS = (LAS bf16_t*)(L + GP_KS); LAS bf16_t* QS = (LAS bf16_t*)(L + GP_QS); LAS bf16_t* VS = (LAS bf16_t*)(L + GP_VS); LAS bf16_t* WT = (LAS bf16_t*)(L + GP_WT);
    LAS float* AS = (LAS float*)(L + GP_AS); LAS float* GC = (LAS float*)(L + GP_GC); LAS float* BETA = (LAS float*)(L + GP_BETA); LAS float* EGC = (LAS float*)(L + GP_EGC); LAS float* CW = (LAS float*)(L + GP_CW); LAS float* TS = (LAS float*)(L + GP_TS);
    const int tid = F.tid, lane = F.lane, wave = F.wave;
    const int per = (2048 + F.G - 1) / F.G;
    int hcur = -1;
    for (int ii = 0; ii < per; ++ii) {
        const int item = F.vcu * per + ii; if (item >= 2048) break;
        const int bh = item >> 7, n = item & 127, b = bh >> 2, h = bh & 3;
        const size_t t0 = (size_t)b * SEQ + n * 64;
        if (h != hcur) { hcur = h; for (int i = tid; i < 1536; i += NWAVES * 64) { const int j = i / 384, cc = i % 384; CW[i] = a.gdn_conv[j * 1536 + (cc >> 7) * 512 + h * 128 + (cc & 127)]; } }
        unsigned pf = 0u;
        if (ii + 1 < per && item + 1 < 2048 && tid < 384) {
            const int r = tid / 6, q6 = tid % 6; const int item2 = item + 1, bh2 = item2 >> 7, n2 = item2 & 127;
            pf = *(const unsigned*)(GQKV + ((size_t)(bh2 >> 2) * SEQ + n2 * 64 + r) * 1536 + (q6 >> 1) * 512 + (bh2 & 3) * 128 + (q6 & 1) * 64);
        }
        if (wave == 0) {
            const size_t t = t0 + lane;
            float g = -__expf(a.a_log[h]) * softplusf_(GA[t * 4 + h] + a.dt_bias[h]);
#pragma unroll
            for (int o = 1; o < 64; o <<= 1) { const float up = __shfl_up(g, o); if (lane >= o) g += up; }
            GC[lane] = g; BETA[lane] = sigmoidf_(GB[t * 4 + h]); EGC[lane] = __expf(g);
            if (lane == 63) Gb.CD[item] = __expf(g);
        }
        LDS_BARRIER();
        {
            const int c = tid >> 3, d0 = (tid & 7) * 16;
#pragma unroll
            for (int part = 0; part < 3; ++part) {
                float acc[16];
#pragma unroll
                for (int i = 0; i < 16; ++i) acc[i] = 0.f;
#pragma unroll
                for (int j = 0; j < 4; ++j) {
                    if (n * 64 + c - 3 + j >= 0) {
                        const bf16_t* src = GQKV + (t0 + c - 3 + j) * 1536 + part * 512 + h * 128 + d0;
                        const v4u r0 = *(const v4u*)src, r1 = *(const v4u*)(src + 8);
                        const unsigned rw[8] = {r0.x, r0.y, r0.z, r0.w, r1.x, r1.y, r1.z, r1.w};
                        const LAS float* cw = CW + j * 384 + part * 128 + d0;
#pragma unroll
                        for (int i = 0; i < 8; ++i) { acc[2 * i] += bflo(rw[i]) * cw[2 * i]; acc[2 * i + 1] += bfhi(rw[i]) * cw[2 * i + 1]; }
                    }
                }
                float ss = 0.f;
#pragma unroll
                for (int i = 0; i < 16; ++i) { acc[i] = acc[i] / (1.f + __expf(-acc[i])); ss += acc[i] * acc[i]; }
                if (part < 2) { ss += __shfl_xor(ss, 1); ss += __shfl_xor(ss, 2); ss += __shfl_xor(ss, 4); const float inv = rsqrtf(ss + EPS);
#pragma unroll
                    for (int i = 0; i < 16; ++i) acc[i] *= inv; }
                LAS bf16_t* dst = (part == 0 ? QS : part == 1 ? KS : VS) + c * GROW + d0;
                v4u w0, w1; w0.x = cvtpk(acc[0], acc[1]); w0.y = cvtpk(acc[2], acc[3]); w0.z = cvtpk(acc[4], acc[5]); w0.w = cvtpk(acc[6], acc[7]);
                w1.x = cvtpk(acc[8], acc[9]); w1.y = cvtpk(acc[10], acc[11]); w1.z = cvtpk(acc[12], acc[13]); w1.w = cvtpk(acc[14], acc[15]);
                *(LAS v4u*)dst = w0; *(LAS v4u*)(dst + 8) = w1;
            }
        }
        LDS_BARRIER();
        {
            const int fr = lane & 15, g = lane >> 4;
            for (int task = wave; task < 26; task += NWAVES) {
                const bool isKK = task < 10; int ct, mt;
                if (isKK) { ct = task >= 6 ? 3 : task >= 3 ? 2 : task >= 1 ? 1 : 0; mt = task - ct * (ct + 1) / 2; } else { ct = (task - 10) >> 2; mt = (task - 10) & 3; }
                f32x4_t acc = {0.f, 0.f, 0.f, 0.f};
                if (mt <= ct) {
                    const LAS bf16_t* Ap = KS + (mt * 16 + fr) * GROW + 8 * g; const LAS bf16_t* Bp = (isKK ? KS : QS) + (ct * 16 + fr) * GROW + 8 * g;
#pragma unroll
                    for (int ks = 0; ks < 4; ++ks) acc = __builtin_amdgcn_mfma_f32_16x16x32_bf16(*(const LAS bf16x8_t*)(Ap + 32 * ks), *(const LAS bf16x8_t*)(Bp + 32 * ks), acc, 0, 0, 0);
                }
                const int c = ct * 16 + fr, m0 = mt * 16 + 4 * g; const float gcc = GC[c];
                float v[4];
#pragma unroll
                for (int r = 0; r < 4; ++r) { const int m = m0 + r; const float dec = __expf(fminf(gcc - GC[m], 0.f)); v[r] = acc[r] * dec; }
                if (isKK) { const float bc = BETA[c];
                    f32x4_t o;
#pragma unroll
                    for (int r = 0; r < 4; ++r) o[r] = (c > m0 + r) ? v[r] * bc : 0.f;
                    *(LAS f32x4_t*)(AS + c * 68 + m0) = o;
                } else {
#pragma unroll
                    for (int r = 0; r < 4; ++r) v[r] = (c >= m0 + r) ? v[r] * 0.08838834764831845f : 0.f;
                    v2u w; w.x = cvtpk(v[0], v[1]); w.y = cvtpk(v[2], v[3]);
                    *(v2u*)(Gb.QK + (size_t)item * 4096 + (ct * 2 + (mt >> 1)) * 512 + lane * 8 + (mt & 1) * 4) = w;
                }
            }
        }
        LDS_BARRIER();
        if (wave == 0) {
            const int q4 = lane >> 4, c = lane & 15; const LAS float* Ab = AS + (16 * q4) * 68 + 16 * q4;
            float t[16];
#pragma unroll
            for (int r = 0; r < 16; ++r) { float s = (r == c) ? 1.f : 0.f;
#pragma unroll
                for (int j4 = 0; j4 < (r + 3) / 4; ++j4) { const f32x4_t av = *(const LAS f32x4_t*)(Ab + r * 68 + 4 * j4);
#pragma unroll
                    for (int i = 0; i < 4; ++i) if (4 * j4 + i < r) s -= av[i] * t[4 * j4 + i]; }
                t[r] = s; TS[(q4 * 16 + r) * 20 + c] = (r == c) ? 0.f : s; }
        }
        LDS_BARRIER();
        {
            const int fr = lane & 15, g = lane >> 4;
#pragma unroll
            for (int cc = 0; cc < 2; ++cc) {
                const int ct2 = wave * 2 + cc; const bool isW = ct2 >= 8; const int col = (ct2 & 7) * 16 + fr;
                const LAS bf16_t* src = (isW ? KS : VS) + col;
                unsigned xb[4][2];
#pragma unroll
                for (int i = 0; i < 4; ++i) {
                    f32x4_t y;
#pragma unroll
                    for (int r = 0; r < 4; ++r) { const int row = 16 * i + 4 * g + r; float v = bf2f(src[row * GROW]) * BETA[row]; if (isW) v *= EGC[row]; y[r] = v; }
#pragma unroll
                    for (int j = 0; j < i; j += 2) {
                        const LAS float* ap = AS + (16 * i + fr) * 68 + 16 * j + 4 * g;
                        const f32x4_t a0 = *(const LAS f32x4_t*)ap; f32x4_t a1 = {0.f, 0.f, 0.f, 0.f}; if (j + 1 < i) a1 = *(const LAS f32x4_t*)(ap + 16);
                        const bf16x8_t af = __builtin_bit_cast(bf16x8_t, (v4u){cvtpk(-a0[0], -a0[1]), cvtpk(-a0[2], -a0[3]), cvtpk(-a1[0], -a1[1]), cvtpk(-a1[2], -a1[3])});
                        const bf16x8_t bfr = __builtin_bit_cast(bf16x8_t, (v4u){xb[j][0], xb[j][1], (j + 1 < i) ? xb[j + 1][0] : 0u, (j + 1 < i) ? xb[j + 1][1] : 0u});
                        y = __builtin_amdgcn_mfma_f32_16x16x32_bf16(af, bfr, y, 0, 0, 0);
                    }
                    const f32x4_t tv = *(const LAS f32x4_t*)(TS + (i * 16 + fr) * 20 + 4 * g);
                    const bf16x8_t tf = __builtin_bit_cast(bf16x8_t, (v4u){cvtpk(tv[0], tv[1]), cvtpk(tv[2], tv[3]), 0u, 0u});
                    const bf16x8_t yf = __builtin_bit_cast(bf16x8_t, (v4u){cvtpk(y[0], y[1]), cvtpk(y[2], y[3]), 0u, 0u});
                    const f32x4_t x = __builtin_amdgcn_mfma_f32_16x16x32_bf16(tf, yf, y, 0, 0, 0);
                    xb[i][0] = cvtpk(x[0], x[1]); xb[i][1] = cvtpk(x[2], x[3]);
                    if (!isW) { *(v2u*)(Gb.UT + (size_t)item * 8192 + col * 64 + 16 * i + 4 * g) = (v2u){xb[i][0], xb[i][1]}; }
                    else {
#pragma unroll
                        for (int r = 0; r < 4; ++r) WT[(16 * i + 4 * g + r) * GROW + col] = f2bf(-x[r]); }
                }
            }
        }
        {
            const float glast = GC[63];
#pragma unroll
            for (int i = 0; i < 4; ++i) { const int p = tid + 512 * i, c = p >> 5, d0 = (p & 31) * 4; const v2u r = *(const LAS v2u*)(QS + c * GROW + d0); const float sc = EGC[c] * 0.08838834764831845f;
                v2u w; w.x = cvtpk(bflo(r.x) * sc, bfhi(r.x) * sc); w.y = cvtpk(bflo(r.y) * sc, bfhi(r.y) * sc);
                *(v2u*)(Gb.QD + (size_t)item * 8192 + frag_off(c, d0, 4)) = w; }
#pragma unroll
            for (int i = 0; i < 4; ++i) { const int p = tid + 512 * i, d = p >> 4, c0 = (p & 15) * 4; float v[4];
#pragma unroll
                for (int r = 0; r < 4; ++r) v[r] = bf2f(KS[(c0 + r) * GROW + d]) * __expf(glast - GC[c0 + r]);
                v2u w; w.x = cvtpk(v[0], v[1]); w.y = cvtpk(v[2], v[3]);
                *(v2u*)(Gb.KDT + (size_t)item * 8192 + frag_off(d, c0, 2)) = w; }
        }
        LDS_BARRIER();
#pragma unroll
        for (int i = 0; i < 4; ++i) { const int p = tid + 512 * i, c = p >> 5, d0 = (p & 31) * 4; const v2u r = *(const LAS v2u*)(WT + c * GROW + d0);
            *(v2u*)(Gb.NW + (size_t)item * 8192 + frag_off(c, d0, 4)) = r; }
        asm volatile("" :: "v"(pf));
        LDS_BARRIER();
    }
}

__device__ __forceinline__ void gdn_scan_unit(Frame& F, int s, const GdnBufs& Gb) {
    const int bh = s >> 2, half = s & 3, h = bh & 3, b = bh >> 2;
    const int tid = F.tid, lane = F.lane, wave = F.wave, fr = lane & 15, g = lane >> 4;
    LAS unsigned char* L = F.lds;
    const size_t tb = (size_t)b * SEQ;
    const int item0 = bh * 128;
    const int lt = tid - 256;
#define GDN_SRC(it, i) ((i) < 4 ? (const v4u*)(Gb.NW + (size_t)(it) * 8192) + lt + 256 * (i) : (i) < 8 ? (const v4u*)(Gb.QD + (size_t)(it) * 8192) + lt + 256 * ((i) - 4) : \
                        (i) < 12 ? (const v4u*)(Gb.KDT + (size_t)(it) * 8192) + lt + 256 * ((i) - 8) : (i) < 14 ? (const v4u*)(Gb.QK + (size_t)(it) * 4096) + lt + 256 * ((i) - 12) : \
                        (const v4u*)(Gb.UT + (size_t)(it) * 8192 + half * 2048) + lt + 256 * ((i) - 14))
#define GDN_LOADR(R, it) do { _Pragma("unroll") for (int i_ = 0; i_ < 15; ++i_) R[i_] = *GDN_SRC(it, i_); } while (0)
#define GDN_STORER(R, bufp) do { _Pragma("unroll") for (int i_ = 0; i_ < 15; ++i_) *(LAS v4u*)((bufp) + (i_ * 256 + lt) * 16) = R[i_]; } while (0)
    LAS float* CDL = (LAS float*)(L + 131072 + 1024);
    LAS bf16_t* OTB = (LAS bf16_t*)(L + 131072 + 2048);
#define GDN_OSTORE(step) do { if (wave < 6 && (step) < 128) { const LAS bf16_t* ot_ = OTB + ((wave - 4) * 2 + ((step) & 1)) * 1024; \
        const v4u o0_ = *(const LAS v4u*)(ot_ + lane * 16), o1_ = *(const LAS v4u*)(ot_ + lane * 16 + 8); \
        bf16_t* dst_ = Gb.ORAW + (tb + (size_t)(step) * 64 + lane) * 512 + h * 128 + half * 32 + (wave - 4) * 16; *(v4u*)dst_ = o0_; *(v4u*)(dst_ + 8) = o1_; } } while (0)
    if (wave >= 4) {
        if (wave == 4) { CDL[lane] = Gb.CD[item0 + lane]; CDL[64 + lane] = Gb.CD[item0 + 64 + lane]; }
        v4u r0[15], r1[15], r2[15];
        GDN_LOADR(r0, item0); GDN_LOADR(r1, item0 + 1); GDN_LOADR(r2, item0 + 2);
        GDN_STORER(r0, L);
        LDS_BARRIER();
#define GDN_CL(k) (item0 + ((k) < 127 ? (k) : 127))
        for (int n = 0; n < 129; n += 3) {
            GDN_LOADR(r0, GDN_CL(n + 3)); GDN_STORER(r1, L + ((n + 1) & 1) * 65536); LDS_BARRIER(); GDN_OSTORE(n);
            GDN_LOADR(r1, GDN_CL(n + 4)); GDN_STORER(r2, L + ((n + 2) & 1) * 65536); LDS_BARRIER(); GDN_OSTORE(n + 1);
            GDN_LOADR(r2, GDN_CL(n + 5)); GDN_STORER(r0, L + ((n + 3) & 1) * 65536); LDS_BARRIER(); GDN_OSTORE(n + 2);
        }
#undef GDN_CL
    } else if (wave >= 2) {
        for (int n = 0; n < 130; ++n) LDS_BARRIER();
    } else {
        LDS_BARRIER();
        f32x4_t S[8];
#pragma unroll
        for (int i = 0; i < 8; ++i) S[i] = (f32x4_t){0.f, 0.f, 0.f, 0.f};
        for (int n = 0; n < 128; ++n) {
            LAS unsigned char* B = L + (n & 1) * 65536;
            const float cd = CDL[n];
            bf16x8_t sb[4];
#pragma unroll
            for (int ks = 0; ks < 4; ++ks) sb[ks] = __builtin_bit_cast(bf16x8_t, (v4u){cvtpk(S[2 * ks][0], S[2 * ks][1]), cvtpk(S[2 * ks][2], S[2 * ks][3]), cvtpk(S[2 * ks + 1][0], S[2 * ks + 1][1]), cvtpk(S[2 * ks + 1][2], S[2 * ks + 1][3])});
#define GDN_SB() __builtin_amdgcn_sched_barrier(0)
            const LAS unsigned char* Bl = B + lane * 16;
            v2u u8[4]; bf16x8_t fa[16], fb[16];
#pragma unroll
            for (int rt = 0; rt < 4; ++rt) u8[rt] = *(const LAS v2u*)(B + 57344 + ((wave * 16 + fr) * 64 + 16 * rt + 4 * g) * 2);
#pragma unroll
            for (int i = 0; i < 16; ++i) fa[i] = *(const LAS bf16x8_t*)(Bl + ((i & 3) * 4 + (i >> 2)) * 1024);
            GDN_SB();
#pragma unroll
            for (int i = 0; i < 16; ++i) fb[i] = *(const LAS bf16x8_t*)(Bl + 16384 + ((i & 3) * 4 + (i >> 2)) * 1024);
            GDN_SB();
            f32x4_t va[4], oa[4];
#pragma unroll
            for (int rt = 0; rt < 4; ++rt) { va[rt] = (f32x4_t){bflo(u8[rt].x), bfhi(u8[rt].x), bflo(u8[rt].y), bfhi(u8[rt].y)}; oa[rt] = (f32x4_t){0.f, 0.f, 0.f, 0.f}; }
#pragma unroll
            for (int i = 0; i < 16; ++i) va[i & 3] = __builtin_amdgcn_mfma_f32_16x16x32_bf16(fa[i], sb[i >> 2], va[i & 3], 0, 0, 0);
            GDN_SB();
#pragma unroll
            for (int i = 0; i < 8; ++i) fa[i] = *(const LAS bf16x8_t*)(Bl + 49152 + ((i & 3) * 2 + (i >> 2)) * 1024);
#pragma unroll
            for (int i = 0; i < 8; ++i) fa[8 + i] = *(const LAS bf16x8_t*)(Bl + 32768 + ((i & 3) * 2 + (i >> 2)) * 1024);
            GDN_SB();
#pragma unroll
            for (int i = 0; i < 16; ++i) oa[i & 3] = __builtin_amdgcn_mfma_f32_16x16x32_bf16(fb[i], sb[i >> 2], oa[i & 3], 0, 0, 0);
            bf16x8_t vb[2];
#pragma unroll
            for (int k2 = 0; k2 < 2; ++k2) vb[k2] = __builtin_bit_cast(bf16x8_t, (v4u){cvtpk(va[2 * k2][0], va[2 * k2][1]), cvtpk(va[2 * k2][2], va[2 * k2][3]), cvtpk(va[2 * k2 + 1][0], va[2 * k2 + 1][1]), cvtpk(va[2 * k2 + 1][2], va[2 * k2 + 1][3])});
#pragma unroll
            for (int dt = 0; dt < 8; ++dt) S[dt] = S[dt] * cd;
            GDN_SB();
#pragma unroll
            for (int i = 0; i < 8; ++i) fb[i] = *(const LAS bf16x8_t*)(Bl + 32768 + 8192 + ((i & 3) * 2 + (i >> 2)) * 1024);
            GDN_SB();
#pragma unroll
            for (int i = 0; i < 8; ++i) oa[i & 3] = __builtin_amdgcn_mfma_f32_16x16x32_bf16(fa[i], vb[i >> 2], oa[i & 3], 0, 0, 0);
#pragma unroll
            for (int i = 0; i < 8; ++i) S[i & 3] = __builtin_amdgcn_mfma_f32_16x16x32_bf16(fa[8 + i], vb[i >> 2], S[i & 3], 0, 0, 0);
            GDN_SB();
#pragma unroll
            for (int i = 0; i < 8; ++i) S[4 + (i & 3)] = __builtin_amdgcn_mfma_f32_16x16x32_bf16(fb[i], vb[i >> 2], S[4 + (i & 3)], 0, 0, 0);
            GDN_SB();
#undef GDN_SB
            { LAS bf16_t* OT = OTB + (wave * 2 + (n & 1)) * 1024;
#pragma unroll
              for (int rt = 0; rt < 4; ++rt)
#pragma unroll
                for (int r = 0; r < 4; ++r) OT[(16 * rt + 4 * g + r) * 16 + fr] = f2bf(oa[rt][r]); }
            LDS_BARRIER();
        }
        LDS_BARRIER();
    }
#undef GDN_SRC
#undef GDN_LOADR
#undef GDN_OSTORE
#undef GDN_STORER
}

__device__ __forceinline__ void gdn_finish_phase(Frame& F, const Args& a, const GdnBufs& Gb, const bf16_t* GZ, bf16_t* OG) {
    const int gt = F.vcu * NWAVES * 64 + F.tid, ngt = F.G * NWAVES * 64;
    for (int p = gt; p < T * 64; p += ngt) {
        const size_t t = (size_t)(p >> 6); const int col = (p & 63) * 8, e0 = col & 127;
        const v4u o = *(const v4u*)(Gb.ORAW + t * 512 + col), z = *(const v4u*)(GZ + t * 512 + col);
        const unsigned ow[4] = {o.x, o.y, o.z, o.w}, zw[4] = {z.x, z.y, z.z, z.w};
        float ss = 0.f;
#pragma unroll
        for (int i = 0; i < 4; ++i) { const float a0 = bflo(ow[i]), a1 = bfhi(ow[i]); ss += a0 * a0 + a1 * a1; }
        ss += __shfl_xor(ss, 1); ss += __shfl_xor(ss, 2); ss += __shfl_xor(ss, 4); ss += __shfl_xor(ss, 8);
        const float rinv = rsqrtf(ss * (1.f / 128.f) + EPS);
        const f32x4_t g0 = *(const f32x4_t*)(a.gdn_norm_g + e0), g1 = *(const f32x4_t*)(a.gdn_norm_g + e0 + 4);
        const float gg[8] = {g0[0], g0[1], g0[2], g0[3], g1[0], g1[1], g1[2], g1[3]};
        unsigned r[4];
#pragma unroll
        for (int i = 0; i < 4; ++i) { const float z0 = bflo(zw[i]), z1 = bfhi(zw[i]);
            r[i] = cvtpk(bflo(ow[i]) * rinv * gg[2 * i] * (z0 / (1.f + __expf(-z0))), bfhi(ow[i]) * rinv * gg[2 * i + 1] * (z1 / (1.f + __expf(-z1)))); }
        *(v4u*)(OG + t * 512 + col) = (v4u){r[0], r[1], r[2], r[3]};
    }
}
typedef float f32x2_t __attribute__((ext_vector_type(2)));
__device__ __forceinline__ float gelu_erf(float v) { return 0.5f * v * (1.f + erff(v * 0.70710678118654752f)); }
constexpr int PEER_CH = 16;
constexpr int CW_PEERU = 8192, CW_PEERV = 8192 + 1024;

typedef int v2i_t __attribute__((ext_vector_type(2)));
#define PEER_SWZ(V, JP) __builtin_amdgcn_ds_swizzle((V), 0x18 | ((JP) << 5))
#define PEER_SHUF(EN, ER) do { EN[0] = PEER_SWZ(ER.x, 0); EN[1] = PEER_SWZ(ER.y, 0); EN[2] = PEER_SWZ(ER.x, 1); EN[3] = PEER_SWZ(ER.y, 1); EN[4] = PEER_SWZ(ER.x, 2); EN[5] = PEER_SWZ(ER.y, 2); EN[6] = PEER_SWZ(ER.x, 3); EN[7] = PEER_SWZ(ER.y, 3); EN[8] = PEER_SWZ(ER.x, 4); EN[9] = PEER_SWZ(ER.y, 4); EN[10] = PEER_SWZ(ER.x, 5); EN[11] = PEER_SWZ(ER.y, 5); EN[12] = PEER_SWZ(ER.x, 6); EN[13] = PEER_SWZ(ER.y, 6); EN[14] = PEER_SWZ(ER.x, 7); EN[15] = PEER_SWZ(ER.y, 7); } while (0)
#define PEER_LDIDX(TOK) (*(const v2i_t*)(EIDX + (size_t)(TOK) * 128 + 2 * lane))
template <int CTRL> __device__ __forceinline__ int dpp_i(int v) { return __builtin_amdgcn_update_dpp(0, v, CTRL, 0xf, 0xf, false); }
template <int CTRL> __device__ __forceinline__ float dpp_f(float v) { return __builtin_bit_cast(float, __builtin_amdgcn_update_dpp(0, __builtin_bit_cast(int, v), CTRL, 0xf, 0xf, false)); }
constexpr int DPP_X1 = 0xB1, DPP_X2 = 0x4E, DPP_HM = 0x141;
#define PEER_U_COMPUTE(W, TOK, XR0, XR1, RS) do { const size_t t_ = (TOK); \
        const unsigned xw[8] = {XR0.x, XR0.y, XR0.z, XR0.w, XR1.x, XR1.y, XR1.z, XR1.w}; float xf[16]; \
        _Pragma("unroll") for (int q = 0; q < 8; ++q) { xf[2 * q] = bflo(xw[q]); xf[2 * q + 1] = bfhi(xw[q]); } \
        float am = 0.f; \
        _Pragma("unroll") for (int q = 0; q < 16; q += 2) am = fmaxf(am, fmaxf(fabsf(xf[q]), fabsf(xf[q + 1]))); \
        am = fmaxf(am, dpp_f<DPP_X1>(am)); am = fmaxf(am, dpp_f<DPP_X2>(am)); am = fmaxf(am, dpp_f<DPP_HM>(am)); \
        const float sx = am > 0.f ? 127.f * __builtin_amdgcn_rcpf(am) : 0.f, mo = am * (1.f / 127.f) * (RS); \
        int xq[4]; \
        _Pragma("unroll") for (int d = 0; d < 4; ++d) { \
            const unsigned b0 = __builtin_bit_cast(unsigned, fmaf(xf[4 * d], sx, 12582912.f)), b1 = __builtin_bit_cast(unsigned, fmaf(xf[4 * d + 1], sx, 12582912.f)); \
            const unsigned b2 = __builtin_bit_cast(unsigned, fmaf(xf[4 * d + 2], sx, 12582912.f)), b3 = __builtin_bit_cast(unsigned, fmaf(xf[4 * d + 3], sx, 12582912.f)); \
            xq[d] = (int)(__builtin_amdgcn_perm(b1, b0, 0x0c0c0400u) | __builtin_amdgcn_perm(b3, b2, 0x04000c0cu)); } \
        int p[16]; \
        _Pragma("unroll") for (int i = 0; i < 16; ++i) { int acc = __builtin_amdgcn_sdot4((int)W[i].x, xq[0], 0, false); acc = __builtin_amdgcn_sdot4((int)W[i].y, xq[1], acc, false); \
            acc = __builtin_amdgcn_sdot4((int)W[i].z, xq[2], acc, false); p[i] = __builtin_amdgcn_sdot4((int)W[i].w, xq[3], acc, false); } \
        _Pragma("unroll") for (int i = 0; i < 8; ++i) { const int lo = p[i], hi = p[i + 8]; p[i] = (up4 ? hi : lo) + dpp_i<DPP_HM>(up4 ? lo : hi); } \
        _Pragma("unroll") for (int i = 0; i < 4; ++i) { const int lo = p[i], hi = p[i + 4]; p[i] = (up2 ? hi : lo) + dpp_i<DPP_X2>(up2 ? lo : hi); } \
        _Pragma("unroll") for (int i = 0; i < 2; ++i) { const int lo = p[i], hi = p[i + 2]; p[i] = (up1 ? hi : lo) + dpp_i<DPP_X1>(up1 ? lo : hi); } \
        *(unsigned*)(PART + ((size_t)x * T + t_) * 128 + 2 * lane) = cvtpk((float)p[0] * mo, (float)p[1] * mo); } while (0)
#define PEER_GATHER(W, EN, BASE) do { _Pragma("unroll") for (int i = 0; i < 16; ++i) W[i] = *(const v4u*)((BASE) + (unsigned)((unsigned)EN[i] * 128u + lo16)); } while (0)
__device__ __forceinline__ void peer_u_phase(Frame& F, const Args& a, gu32* ctl, const bf16_t* X2B, const float* rstd2, const int* EIDX, const unsigned char* U8, bf16_t* PART) {
    const int lane = F.lane, g = lane >> 3, j = lane & 7; const unsigned lo16 = 16u * (unsigned)j;
    const bool up4 = (j & 4) != 0, up2 = (j & 2) != 0, up1 = (j & 1) != 0;
    const int x0 = (int)(xb_xcc_id() & 7u);
    for (int s = 0; s < 8; ++s) {
        const int x = (x0 + s) & 7;
        const unsigned char* Ux = U8 + (size_t)x * 16384 * 128;
        const bf16_t* Xx = X2B + 128 * x + 16 * j;
        for (;;) {
            int c = 0; if (lane == 0) c = (int)__hip_atomic_fetch_add(ctl + CW_PEERU + 64 * x, 1u, __ATOMIC_RELAXED, __HIP_MEMORY_SCOPE_AGENT);
            c = __builtin_amdgcn_readfirstlane(c);
            if (c >= T / PEER_CH) break;
            const size_t tc = (size_t)c * PEER_CH, tl = tc + PEER_CH - 1;
            int en[16]; v4u wa[16], wb[16];
            v2i_t er = PEER_LDIDX(tc);
            v4u xa0 = *(const v4u*)(Xx + tc * 1024), xa1 = *(const v4u*)(Xx + tc * 1024 + 8), xb0, xb1; float rsa = rstd2[tc], rsb;
            PEER_SHUF(en, er);
            PEER_GATHER(wa, en, Ux);
            er = PEER_LDIDX(tc + 1);
            for (int tt = 0; tt < PEER_CH; tt += 2) {
                const size_t t = tc + tt, t2 = (t + 2 < tl) ? t + 2 : tl, t3 = (t + 3 < tl) ? t + 3 : tl;
                PEER_SHUF(en, er);
                PEER_GATHER(wb, en, Ux);
                er = PEER_LDIDX(t2);
                xb0 = *(const v4u*)(Xx + (t + 1) * 1024); xb1 = *(const v4u*)(Xx + (t + 1) * 1024 + 8); rsb = rstd2[t + 1];
                PEER_U_COMPUTE(wa, t, xa0, xa1, rsa);
                PEER_SHUF(en, er);
                PEER_GATHER(wa, en, Ux);
                er = PEER_LDIDX(t3);
                xa0 = *(const v4u*)(Xx + t2 * 1024); xa1 = *(const v4u*)(Xx + t2 * 1024 + 8); rsa = rstd2[t2];
                PEER_U_COMPUTE(wb, t + 1, xb0, xb1, rsb);
            }
        }
    }
}
__device__ __forceinline__ void peer_combine_phase(Frame& F, const bf16_t* PART, const int* EIDX, const float* EGATE, const float* SU, const float* SV, float* ACTS) {
    const int gt = F.vcu * NWAVES * 64 + F.tid, ngt = F.G * NWAVES * 64;
    for (int p = gt; p < T * 32; p += ngt) {
        f32x4_t s = {0.f, 0.f, 0.f, 0.f};
#pragma unroll
        for (int x = 0; x < 8; ++x) { const v2u w = *(const v2u*)(PART + (size_t)x * T * 128 + (size_t)p * 4); s += (f32x4_t){bflo(w.x), bfhi(w.x), bflo(w.y), bfhi(w.y)}; }
        const int4 e = *(const int4*)(EIDX + (size_t)p * 4); const f32x4_t gt4 = *(const f32x4_t*)(EGATE + (size_t)p * 4);
        *(f32x4_t*)(ACTS + (size_t)p * 4) = (f32x4_t){gelu_erf(s[0] * SU[e.x]) * gt4[0] * SV[e.x], gelu_erf(s[1] * SU[e.y]) * gt4[1] * SV[e.y], gelu_erf(s[2] * SU[e.z]) * gt4[2] * SV[e.z], gelu_erf(s[3] * SU[e.w]) * gt4[3] * SV[e.w]};
    }
}
template <int K> __device__ __forceinline__ f32x2_t cvt_fp4x2(unsigned w) { return __builtin_amdgcn_cvt_scalef32_pk_f32_fp4(w, 1.0f, K); }
__device__ __forceinline__ float wave_sum_dpp(float v) {
    v += dpp_f<DPP_X1>(v); v += dpp_f<DPP_X2>(v); v += dpp_f<DPP_HM>(v); v += dpp_f<0x140>(v);
    const int b = __builtin_bit_cast(int, v);
    return (__builtin_bit_cast(float, __builtin_amdgcn_readlane(b, 0)) + __builtin_bit_cast(float, __builtin_amdgcn_readlane(b, 16))) + (__builtin_bit_cast(float, __builtin_amdgcn_readlane(b, 32)) + __builtin_bit_cast(float, __builtin_amdgcn_readlane(b, 48)));
}
#define PEER_V_COMPUTE(W, TOK, A0R, XWR) do { const size_t t_ = (TOK); float av[16]; \
        const float axf_ = (A0R).x, ayf_ = (A0R).y; const int ax_ = __builtin_bit_cast(int, axf_), ay_ = __builtin_bit_cast(int, ayf_); av[0] = __builtin_bit_cast(float, PEER_SWZ(ax_, 0)); av[1] = __builtin_bit_cast(float, PEER_SWZ(ay_, 0)); av[2] = __builtin_bit_cast(float, PEER_SWZ(ax_, 1)); av[3] = __builtin_bit_cast(float, PEER_SWZ(ay_, 1)); av[4] = __builtin_bit_cast(float, PEER_SWZ(ax_, 2)); av[5] = __builtin_bit_cast(float, PEER_SWZ(ay_, 2)); av[6] = __builtin_bit_cast(float, PEER_SWZ(ax_, 3)); av[7] = __builtin_bit_cast(float, PEER_SWZ(ay_, 3)); av[8] = __builtin_bit_cast(float, PEER_SWZ(ax_, 4)); av[9] = __builtin_bit_cast(float, PEER_SWZ(ay_, 4)); av[10] = __builtin_bit_cast(float, PEER_SWZ(ax_, 5)); av[11] = __builtin_bit_cast(float, PEER_SWZ(ay_, 5)); av[12] = __builtin_bit_cast(float, PEER_SWZ(ax_, 6)); av[13] = __builtin_bit_cast(float, PEER_SWZ(ay_, 6)); av[14] = __builtin_bit_cast(float, PEER_SWZ(ax_, 7)); av[15] = __builtin_bit_cast(float, PEER_SWZ(ay_, 7)); \
        const size_t oo_ = t_ * 1024 + 256 * x + 4 * lane; const v2u xw_ = (XWR); \
        f32x2_t o2[16]; _Pragma("unroll") for (int q = 0; q < 16; ++q) o2[q] = (f32x2_t){0.f, 0.f}; \
        _Pragma("unroll") for (int i = 0; i < 16; ++i) { const unsigned ww[4] = {W[i].x, W[i].y, W[i].z, W[i].w}; const f32x2_t a2 = {av[i], av[i]}; \
            _Pragma("unroll") for (int q = 0; q < 4; ++q) { o2[4 * q] = __builtin_elementwise_fma(cvt_fp4x2<0>(ww[q]), a2, o2[4 * q]); o2[4 * q + 1] = __builtin_elementwise_fma(cvt_fp4x2<1>(ww[q]), a2, o2[4 * q + 1]); \
                o2[4 * q + 2] = __builtin_elementwise_fma(cvt_fp4x2<2>(ww[q]), a2, o2[4 * q + 2]); o2[4 * q + 3] = __builtin_elementwise_fma(cvt_fp4x2<3>(ww[q]), a2, o2[4 * q + 3]); } } \
        float o[32]; _Pragma("unroll") for (int q = 0; q < 16; ++q) { o[2 * q] = o2[q].x; o[2 * q + 1] = o2[q].y; } \
        _Pragma("unroll") for (int i = 0; i < 16; ++i) { const v2u r_ = __builtin_amdgcn_permlane32_swap(__builtin_bit_cast(unsigned, o[i]), __builtin_bit_cast(unsigned, o[i + 16]), false, false); { const unsigned r0_ = r_.x, r1_ = r_.y; o[i] = __builtin_bit_cast(float, r0_) + __builtin_bit_cast(float, r1_); } } \
        _Pragma("unroll") for (int i = 0; i < 8; ++i) { const v2u r_ = __builtin_amdgcn_permlane16_swap(__builtin_bit_cast(unsigned, o[i]), __builtin_bit_cast(unsigned, o[i + 8]), false, false); { const unsigned r0_ = r_.x, r1_ = r_.y; o[i] = __builtin_bit_cast(float, r0_) + __builtin_bit_cast(float, r1_); } } \
        _Pragma("unroll") for (int i = 0; i < 4; ++i) { const float lo = o[i], hi = o[i + 4]; o[i] = (upg ? hi : lo) + dpp_f<0x128>(upg ? lo : hi); } \
        v2u rw_; rw_.x = cvtpk(bflo(xw_.x) + o[0], bfhi(xw_.x) + o[1]); rw_.y = cvtpk(bflo(xw_.y) + o[2], bfhi(xw_.y) + o[3]); *(v2u*)(X3B + oo_) = rw_; \
        const float r0 = bflo(rw_.x), r1 = bfhi(rw_.x), r2 = bflo(rw_.y), r3 = bfhi(rw_.y); \
        const float ss = wave_sum_dpp((r0 * r0 + r1 * r1) + (r2 * r2 + r3 * r3)); if (lane == 0) SS3[t_ * 4 + x] = ss; } while (0)
__device__ __forceinline__ void peer_v_phase(Frame& F, gu32* ctl, const int* EIDX, const float* ACTS, const unsigned char* V8, const bf16_t* X2B, bf16_t* X3B, float* SS3) {
    const int lane = F.lane, g = lane >> 3, j = lane & 7; const unsigned lo16 = 16u * (unsigned)j; const bool upg = (g & 1) != 0;
    const int x0 = (int)(xb_xcc_id() & 7u);
    for (int s = 0; s < 4; ++s) {
        const int x = (x0 + s) & 3;
        const unsigned char* Vx = V8 + (size_t)x * 16384 * 128;
        const bf16_t* Xx = X2B + 256 * x + 4 * lane;
        for (;;) {
            int c = 0; if (lane == 0) c = (int)__hip_atomic_fetch_add(ctl + CW_PEERV + 64 * x, 1u, __ATOMIC_RELAXED, __HIP_MEMORY_SCOPE_AGENT);
            c = __builtin_amdgcn_readfirstlane(c);
            if (c >= T / PEER_CH) break;
            const size_t tc = (size_t)c * PEER_CH, tl = tc + PEER_CH - 1;
            int en[16]; v4u wa[16], wb[16];
            v2i_t er = PEER_LDIDX(tc);
            f32x2_t aa = *(const f32x2_t*)(ACTS + tc * 128 + 2 * lane), ab; v2u xwa = *(const v2u*)(Xx + tc * 1024), xwb;
            PEER_SHUF(en, er);
            PEER_GATHER(wa, en, Vx);
            er = PEER_LDIDX(tc + 1);
            for (int tt = 0; tt < PEER_CH; tt += 2) {
                const size_t t = tc + tt, t2 = (t + 2 < tl) ? t + 2 : tl, t3 = (t + 3 < tl) ? t + 3 : tl;
                PEER_SHUF(en, er);
                PEER_GATHER(wb, en, Vx);
                er = PEER_LDIDX(t2);
                ab = *(const f32x2_t*)(ACTS + (t + 1) * 128 + 2 * lane); xwb = *(const v2u*)(Xx + (t + 1) * 1024);
                PEER_V_COMPUTE(wa, t, aa, xwa);
                PEER_SHUF(en, er);
                PEER_GATHER(wa, en, Vx);
                er = PEER_LDIDX(t3);
                aa = *(const f32x2_t*)(ACTS + t2 * 128 + 2 * lane); xwa = *(const v2u*)(Xx + t2 * 1024);
                PEER_V_COMPUTE(wb, t + 1, ab, xwb);
            }
        }
    }
}
__device__ __forceinline__ void peer_norm_phase(Frame& F, const Args& a, const float* SS3, const bf16_t* X3B, float* out) {
    const int gt = F.vcu * NWAVES * 64 + F.tid, ngt = F.G * NWAVES * 64;
    for (int p = gt; p < T * 128; p += ngt) {
        const size_t t = (size_t)(p >> 7); const int c = (p & 127) * 8;
        const f32x4_t s0 = *(const f32x4_t*)(SS3 + t * 4);
        const float r3 = rsqrtf(((s0[0] + s0[1]) + (s0[2] + s0[3])) * (1.f / D) + EPS);
        const v4u w = *(const v4u*)(X3B + t * 1024 + c);
        const f32x4_t g0 = *(const f32x4_t*)(a.g_final + c), g1 = *(const f32x4_t*)(a.g_final + c + 4);
        *(f32x4_t*)(out + t * 1024 + c) = (f32x4_t){bflo(w.x), bfhi(w.x), bflo(w.y), bfhi(w.y)} * g0 * r3;
        *(f32x4_t*)(out + t * 1024 + c + 4) = (f32x4_t){bflo(w.z), bfhi(w.z), bflo(w.w), bfhi(w.w)} * g1 * r3;
    }
}
#ifndef TOPK_HD
#define TOPK_HD __device__ __forceinline__
#endif
TOPK_HD void ce_desc(unsigned& a, unsigned& b) { const unsigned hi = a > b ? a : b, lo = a > b ? b : a; a = hi; b = lo; }
TOPK_HD void sort16_desc(unsigned (&v)[16]) {
#pragma unroll
    for (int k = 2; k <= 16; k <<= 1)
#pragma unroll
        for (int j = k >> 1; j >= 1; j >>= 1)
#pragma unroll
            for (int i = 0; i < 16; ++i) { const int l = i ^ j; if (l > i) { if ((i & k) == 0) ce_desc(v[i], v[l]); else ce_desc(v[l], v[i]); } }
}
TOPK_HD void bitonic_merge16_desc(unsigned (&v)[16]) {
#pragma unroll
    for (int j = 8; j >= 1; j >>= 1)
#pragma unroll
        for (int i = 0; i < 16; ++i) { const int l = i ^ j; if (l > i) ce_desc(v[i], v[l]); }
}
TOPK_HD void top16_merge(unsigned (&a)[16], const unsigned (&b)[16]) {
#pragma unroll
    for (int i = 0; i < 16; ++i) a[i] = a[i] > b[15 - i] ? a[i] : b[15 - i];
    bitonic_merge16_desc(a);
}
TOPK_HD unsigned f2ord(float f) { const unsigned u = __builtin_bit_cast(unsigned, f); return (u & 0x80000000u) ? ~u : (u | 0x80000000u); }
TOPK_HD float ord2f(unsigned o) { const unsigned u = (o & 0x80000000u) ? (o & 0x7fffffffu) : ~o; return __builtin_bit_cast(float, u); }

__device__ __forceinline__ void peer_route_task(Frame& F, const bf16_t* PQ, const bf16_t* SK16, int* EIDX, float* EGATE, int tt, int h) {
    constexpr int CI[50] = {0,0,0,0,0,0,0,0,0,0,0,0,0,0,0,0,1,1,1,1,1,1,1,1,2,2,2,2,2,3,3,3,3,4,4,4,5,5,6,6,7,7,8,9,10,11,12,13,14,15};
    constexpr int CJ[50] = {0,1,2,3,4,5,6,7,8,9,10,11,12,13,14,15,0,1,2,3,4,5,6,7,0,1,2,3,4,0,1,2,3,0,1,2,0,1,0,1,0,1,0,0,0,0,0,0,0,0};
    int lane = F.lane; asm volatile("" : "+v"(lane));
    const int t = lane & 31, hi = lane >> 5;
    LAS unsigned* wl = (LAS unsigned*)(F.lds + 65536 + F.wave * 8192) + lane;
    {
        const size_t row = (size_t)tt * 32 + t;
        unsigned L[2][16];
#pragma unroll
        for (int p = 0; p < 2; ++p) {
            const int hp = h * 2 + p;
            bf16x8_t Bf[8];
#pragma unroll
            for (int ks = 0; ks < 8; ++ks) Bf[ks] = *(const bf16x8_t*)(PQ + row * 2048 + hp * 128 + 16 * ks + 8 * hi);
#pragma unroll
            for (int i = 0; i < 16; ++i) L[p][i] = 0u;
#pragma unroll 1
            for (int nt = 0; nt < 4; ++nt) {
                const int srow = p * 128 + 32 * nt + t;
                bf16x8_t Ac[8];
#pragma unroll
                for (int ks = 0; ks < 8; ++ks) Ac[ks] = *(const LAS bf16x8_t*)(F.lds + srow * 256 + (((2 * ks + hi) ^ (srow & 15)) << 4));
                f32x16_t acc = {};
#pragma unroll
                for (int ks = 0; ks < 8; ++ks) acc = __builtin_amdgcn_mfma_f32_32x32x16_bf16(Ac[ks], Bf[ks], acc, 0, 0, 0);
                unsigned k[16];
#pragma unroll
                for (int r = 0; r < 16; ++r) { const int n = 32 * nt + (r & 3) + 8 * (r >> 2) + 4 * hi; k[r] = (f2ord(acc[r]) & ~127u) | (unsigned)(127 - n); }
                sort16_desc(k);
                top16_merge(L[p], k);
            }
            unsigned pb[16];
#pragma unroll
            for (int i = 0; i < 16; ++i) pb[i] = __shfl_xor(L[p][i], 32);
            top16_merge(L[p], pb);
        }
        float sa[16], sb[16];
#pragma unroll
        for (int i = 0; i < 16; ++i) { sa[i] = ord2f(L[0][i] & ~127u); sb[i] = ord2f(L[1][i] & ~127u); wl[i * 64] = 127u - (L[0][i] & 127u); wl[(16 + i) * 64] = 127u - (L[1][i] & 127u); }
        unsigned c0[16], c1[16];
#pragma unroll
        for (int s = 0; s < 32; ++s) {
            unsigned key = 0u;
            if (s < 25) { const float v = hi ? sa[CI[25 + s]] + sb[CJ[25 + s]] : sa[CI[s]] + sb[CJ[s]]; const int pos = hi ? CI[25 + s] * 16 + CJ[25 + s] : CI[s] * 16 + CJ[s];
                key = (f2ord(v) & ~255u) | (unsigned)(255 - pos); }
            if (s < 16) c0[s] = key; else c1[s - 16] = key;
        }
        sort16_desc(c0); sort16_desc(c1); top16_merge(c0, c1);
        unsigned pb[16];
#pragma unroll
        for (int i = 0; i < 16; ++i) pb[i] = __shfl_xor(c0[i], 32);
        top16_merge(c0, pb);
        float e[16]; const float m = ord2f(c0[0] & ~255u); float l = 0.f;
#pragma unroll
        for (int r = 0; r < 16; ++r) { e[r] = __expf(ord2f(c0[r] & ~255u) - m); l += e[r]; }
        const float il = 1.f / l;
        int ex[8]; float gt[8];
#pragma unroll
        for (int q = 0; q < 8; ++q) { const unsigned kk = hi ? c0[8 + q] : c0[q]; const int pos = 255 - (int)(kk & 255u); ex[q] = (int)(wl[(pos >> 4) * 64] * 128u + wl[(16 + (pos & 15)) * 64]); gt[q] = (hi ? e[8 + q] : e[q]) * il; }
        int* ep = EIDX + row * 128 + h * 16 + hi * 8; float* gp = EGATE + row * 128 + h * 16 + hi * 8;
        *(int4*)ep = make_int4(ex[0], ex[1], ex[2], ex[3]); *(int4*)(ep + 4) = make_int4(ex[4], ex[5], ex[6], ex[7]);
        *(f32x4_t*)gp = (f32x4_t){gt[0], gt[1], gt[2], gt[3]}; *(f32x4_t*)(gp + 4) = (f32x4_t){gt[4], gt[5], gt[6], gt[7]};
    }
}
__device__ __forceinline__ void cross_item(Frame& F, const bf16_t* QC, const bf16_t* KC, const bf16_t* VC, bf16_t* OC, int bh, int qb) {
    int tid = F.tid; asm volatile("" : "+v"(tid));
    const int lane = tid & 63, wave = F.wave, q = lane & 31, hi = lane >> 5;
    LAS unsigned char* L = F.lds;
    const int g4 = lane >> 4, qq = (lane >> 2) & 3, p4 = lane & 3;
    {
        const int b = bh >> 2, h = bh & 3;
#pragma unroll
        for (int i = 0; i < 16; ++i) { const int cid = tid + 512 * i, r = cid >> 5, c = cid & 31;
            *(LAS v4u*)(L + r * 512 + ((c ^ (r & 15)) << 4)) = *(const v4u*)(KC + (size_t)(b * 256 + r) * 1024 + h * 256 + c * 8); }
        const size_t qrow0 = (size_t)b * SEQ + qb * 256 + wave * 32;
        const bf16_t* Qp = QC + (qrow0 + q) * 1024 + h * 256 + 8 * hi;
        __syncthreads();
        f32x16_t st[8];
#pragma unroll
        for (int kt = 0; kt < 8; ++kt) st[kt] = (f32x16_t){};
#pragma unroll 2
        for (int ks = 0; ks < 16; ++ks) { const bf16x8_t qf = *(const bf16x8_t*)(Qp + 16 * ks);
#pragma unroll
            for (int kt = 0; kt < 8; ++kt) { const int row = 32 * kt + q;
                st[kt] = __builtin_amdgcn_mfma_f32_32x32x16_bf16(*(const LAS bf16x8_t*)(L + row * 512 + (((2 * ks + hi) ^ (row & 15)) << 4)), qf, st[kt], 0, 0, 0); } }
        float m = -INFINITY;
#pragma unroll
        for (int kt = 0; kt < 8; ++kt)
#pragma unroll
            for (int r = 0; r < 16; ++r) { st[kt][r] *= 0.0625f; m = fmaxf(m, st[kt][r]); }
        m = fmaxf(m, __shfl_xor(m, 32));
        float l = 0.f;
#pragma unroll
        for (int kt = 0; kt < 8; ++kt)
#pragma unroll
            for (int r = 0; r < 16; ++r) { st[kt][r] = __expf(st[kt][r] - m); l += st[kt][r]; }
        l += __shfl_xor(l, 32);
        const float il = 1.f / l;
        bf16x8_t pa[8][2];
#pragma unroll
        for (int kt = 0; kt < 8; ++kt)
#pragma unroll
            for (int s = 0; s < 2; ++s) pa[kt][s] = __builtin_bit_cast(bf16x8_t, (v4u){cvtpk(st[kt][8 * s] * il, st[kt][8 * s + 1] * il), cvtpk(st[kt][8 * s + 2] * il, st[kt][8 * s + 3] * il),
                                                                                        cvtpk(st[kt][8 * s + 4] * il, st[kt][8 * s + 5] * il), cvtpk(st[kt][8 * s + 6] * il, st[kt][8 * s + 7] * il)});
        __syncthreads();
#pragma unroll
        for (int i = 0; i < 16; ++i) { const int cid = tid + 512 * i, r = cid >> 5, c = cid & 31;
            *(LAS v4u*)(L + r * 512 + ((c ^ (4 * (r & 3))) << 4)) = *(const v4u*)(VC + (size_t)(b * 256 + r) * 1024 + h * 256 + c * 8); }
        __syncthreads();
        bf16_t* Op = OC + qrow0 * 1024 + h * 256 + q;
#pragma unroll 1
        for (int dt = 0; dt < 8; ++dt) {
            f32x16_t o = {};
            LAS unsigned char* vb = L + (4 * (g4 >> 1) + qq) * 512 + (((dt * 64) ^ (qq << 6)) + (g4 & 1) * 32 + p4 * 8);
#pragma unroll
            for (int kt = 0; kt < 8; ++kt)
#pragma unroll
                for (int s = 0; s < 2; ++s) { const v4i16_t a0 = lds_tr16(vb + (32 * kt + 16 * s) * 512), a1 = lds_tr16(vb + (32 * kt + 16 * s + 8) * 512);
                    const bf16x8_t vf = {a0[0], a0[1], a0[2], a0[3], a1[0], a1[1], a1[2], a1[3]};
                    o = __builtin_amdgcn_mfma_f32_32x32x16_bf16(pa[kt][s], vf, o, 0, 0, 0); }
#pragma unroll
            for (int r = 0; r < 16; ++r) { const int row = (r & 3) + 8 * (r >> 2) + 4 * hi; Op[(size_t)row * 1024 + dt * 32] = f2bf(o[r]); }
        }
        __syncthreads();
    }
}
template <bool REMAP>
__device__ __forceinline__ void transpose_tile(const float* W, int K, int N, const float* gain, bf16_t* WT, LAS float* tile, int item, int tid) {
    const int nblk = (N + 255) / 256, kb = item / nblk, nb = item % nblk, k0 = 64 * kb, n0 = 256 * nb;
    const int c4 = (tid & 63) * 4, kr = tid >> 6;
    f32x4 v[8];
#pragma unroll
    for (int i = 0; i < 8; ++i) { const int k = kr + 8 * i; v[i] = (n0 + c4 < N) ? *(const GAS f32x4*)(W + (size_t)(k0 + k) * N + n0 + c4) : (f32x4){0.f, 0.f, 0.f, 0.f}; }
#pragma unroll
    for (int i = 0; i < 8; ++i) { const int k = kr + 8 * i; LAS float* d = tile + k * 257 + c4; d[0] = v[i].x; d[1] = v[i].y; d[2] = v[i].z; d[3] = v[i].w; }
    __syncthreads();
#pragma unroll
    for (int i = 0; i < 4; ++i) { const int p = tid + 512 * i, n = p >> 3, c = p & 7; const LAS float* sp = tile + (8 * c) * 257 + n;
        float g[8];
#pragma unroll
        for (int q = 0; q < 8; ++q) g[q] = gain ? gain[k0 + 8 * c + q] : 1.f;
        v4u o; o.x = pk2(sp[0 * 257] * g[0], sp[1 * 257] * g[1]); o.y = pk2(sp[2 * 257] * g[2], sp[3 * 257] * g[3]); o.z = pk2(sp[4 * 257] * g[4], sp[5 * 257] * g[5]); o.w = pk2(sp[6 * 257] * g[6], sp[7 * 257] * g[7]);
        int ng = n0 + n; bool ok = ng < N;
        if (REMAP) { if (ng >= 3584 && ng < 3592) ok = false; else if (ng >= 3592) ng -= 8; }
        if (ok) *(GAS v4u*)(WT + (size_t)ng * K + k0 + 8 * c) = o; }
    __syncthreads();
}

__device__ __forceinline__ void p0_prologue(Frame& F, const Args& a) {
    unsigned char* ws = a.ws;
    LAS float* tile = (LAS float*)F.lds;
    const int gw = F.vcu * NWAVES + F.wave, NGW = F.G * NWAVES;
    constexpr int I_IN = 16 * 23;
    for (int it = F.vcu; it < I_IN; it += F.G) transpose_tile<true>(a.w_in, 1024, IN_COLS, a.g_mix, (bf16_t*)(ws + WS_WIN), tile, it, F.tid);
    __syncthreads();
    LAS float* wsm = (LAS float*)F.lds;
    for (int i = F.tid; i < 8192; i += NWAVES * 64) { const int j = i >> 10, k = i & 1023; wsm[i] = a.w_in[(size_t)k * IN_COLS + 3584 + j] * a.g_mix[k]; }
    __syncthreads();
    bf16_t* XB = (bf16_t*)(ws + WS_A0); float* rstd0 = (float*)(ws + WS_RSTD0); float* GB = (float*)(ws + WS_GB); float* GA = GB + T * 4;
    for (int row0 = gw * 4; row0 < T; row0 += NGW * 4) {
        f32x4 v[4][4];
#pragma unroll
        for (int r = 0; r < 4; ++r)
#pragma unroll
            for (int j = 0; j < 4; ++j) v[r][j] = *((const GAS f32x4*)(a.x + (size_t)(row0 + r) * D) + F.lane + 64 * j);
#pragma unroll
        for (int r = 0; r < 4; ++r) { const int row = row0 + r; float s = 0.f;
#pragma unroll
            for (int j = 0; j < 4; ++j) s += (v[r][j].x * v[r][j].x + v[r][j].y * v[r][j].y) + (v[r][j].z * v[r][j].z + v[r][j].w * v[r][j].w);
            const float rstd = rsqrtf(wave_sum(s) * (1.f / D) + EPS);
            GAS unsigned long long* o8 = (GAS unsigned long long*)(XB + (size_t)row * D) + F.lane;
#pragma unroll
            for (int j = 0; j < 4; ++j) o8[64 * j] = (unsigned long long)pk2(v[r][j].x, v[r][j].y) | ((unsigned long long)pk2(v[r][j].z, v[r][j].w) << 32);
            float dj[8];
#pragma unroll
            for (int jj = 0; jj < 8; ++jj) { float d = 0.f;
#pragma unroll
                for (int j = 0; j < 4; ++j) { const f32x4 w = *(const LAS f32x4*)(wsm + jj * 1024 + (F.lane + 64 * j) * 4); d += (v[r][j].x * w.x + v[r][j].y * w.y) + (v[r][j].z * w.z + v[r][j].w * w.w); }
                dj[jj] = d; }
#pragma unroll
            for (int off = 4; off >= 1; off >>= 1) { const bool up = (F.lane & off) != 0;
#pragma unroll
                for (int i = 0; i < off; ++i) { const float lo = dj[i], hi = dj[i + off]; const float send = up ? lo : hi, keep = up ? hi : lo; dj[i] = keep + __shfl_xor(send, off); } }
            float d0 = dj[0]; d0 += __shfl_xor(d0, 8); d0 += __shfl_xor(d0, 16); d0 += __shfl_xor(d0, 32);
            if (F.lane == 0) rstd0[row] = rstd;
            if (F.lane < 4) GB[(size_t)row * 4 + F.lane] = d0 * rstd; else if (F.lane < 8) GA[(size_t)row * 4 + F.lane - 4] = d0 * rstd; }
    }
}
__device__ __forceinline__ void late_prologue(Frame& F, const Args& a, int wgi, int nwg) {
    unsigned char* ws = a.ws;
    LAS float* tile = (LAS float*)F.lds;
    const int gw = wgi * NWAVES + F.wave, NGW = nwg * NWAVES;
    constexpr int I_S = 8 * 4, I_M = 16 * 4, I_L = 16 * 8;
    constexpr int NITEMS = 2 * I_S + 3 * I_M + 2 * I_L;
    for (int it = wgi; it < NITEMS; it += nwg) {
        int r = it;
        if (r < I_S) { transpose_tile<false>(a.w_sb_up, 512, 1024, nullptr, (bf16_t*)(ws + WS_WSB), tile, r, F.tid); continue; } r -= I_S;
        if (r < I_S) { transpose_tile<false>(a.w_gdn_up, 512, 1024, nullptr, (bf16_t*)(ws + WS_WGDN), tile, r, F.tid); continue; } r -= I_S;
        if (r < I_M) { transpose_tile<false>(a.w_mix_out, 1024, 1024, nullptr, (bf16_t*)(ws + WS_WMIX), tile, r, F.tid); continue; } r -= I_M;
        if (r < I_M) { transpose_tile<false>(a.w_cq, 1024, 1024, a.g_cross, (bf16_t*)(ws + WS_WCQ), tile, r, F.tid); continue; } r -= I_M;
        if (r < I_M) { transpose_tile<false>(a.w_co, 1024, 1024, nullptr, (bf16_t*)(ws + WS_WCO), tile, r, F.tid); continue; } r -= I_M;
        if (r < I_L) { transpose_tile<false>(a.w_ckv, 1024, 2048, nullptr, (bf16_t*)(ws + WS_WCKV), tile, r, F.tid); continue; } r -= I_L;
        transpose_tile<false>(a.w_pq, 1024, 2048, a.g_peer, (bf16_t*)(ws + WS_WPQ), tile, r, F.tid);
    }
    __syncthreads();
    {
        float* SUV = (float*)(ws + WS_SUV);
        f32x4 gq[4];
#pragma unroll
        for (int q = 0; q < 4; ++q) gq[q] = *(const GAS f32x4*)(a.g_peer + 16 * F.lane + 4 * q);
        for (int row0 = gw * 4; row0 < 2 * 16384; row0 += NGW * 4) {
            f32x4 v[4][4];
#pragma unroll
            for (int r = 0; r < 4; ++r) { const int row = row0 + r, tb = row >> 14, e = row & 16383; const float* src = (tb ? a.peer_v : a.peer_u) + (size_t)e * 1024 + 16 * F.lane;
#pragma unroll
                for (int q = 0; q < 4; ++q) { v[r][q] = *(const GAS f32x4*)(src + 4 * q); if (!tb) v[r][q] *= gq[q]; } }
#pragma unroll
            for (int r = 0; r < 4; ++r) { const int row = row0 + r, tb = row >> 14, e = row & 16383; float am = 0.f;
#pragma unroll
                for (int q = 0; q < 4; ++q) am = fmaxf(am, fmaxf(fmaxf(fabsf(v[r][q].x), fabsf(v[r][q].y)), fmaxf(fabsf(v[r][q].z), fabsf(v[r][q].w))));
#pragma unroll
                for (int o = 1; o < 64; o <<= 1) am = fmaxf(am, __shfl_xor(am, o));
                if (!tb) {
                    const float sc8 = am > 0.f ? 127.f / am : 0.f; v4u o8;
#pragma unroll
                    for (int q = 0; q < 4; ++q) {
                        const unsigned b0 = __builtin_bit_cast(unsigned, fmaf(v[r][q].x, sc8, 12582912.f)), b1 = __builtin_bit_cast(unsigned, fmaf(v[r][q].y, sc8, 12582912.f));
                        const unsigned b2 = __builtin_bit_cast(unsigned, fmaf(v[r][q].z, sc8, 12582912.f)), b3 = __builtin_bit_cast(unsigned, fmaf(v[r][q].w, sc8, 12582912.f));
                        o8[q] = __builtin_amdgcn_perm(b1, b0, 0x0c0c0400u) | __builtin_amdgcn_perm(b3, b2, 0x04000c0cu); }
                    *(GAS v4u*)(ws + WS_U8 + ((size_t)(F.lane >> 3) * 16384 + e) * 128 + 16 * (F.lane & 7)) = o8;
                    if (F.lane == 0) SUV[row] = am * (1.f / 127.f);
                    continue; }
                const float sc = am > 0.f ? 6.f / am : 0.f, inv = am * (1.f / 6.f);
                {   unsigned char* vrow = ws + WS_V8 + ((size_t)(F.lane >> 4) * 16384 + e) * 128;
                    const int gq = (F.lane & 15) >> 1, jb = 4 * (F.lane & 1);
#pragma unroll
                    for (int q = 0; q < 4; ++q) { unsigned w4 = __builtin_amdgcn_cvt_scalef32_pk_fp4_f32(0u, v[r][q].x * sc, v[r][q].y * sc, 1.0f, 0); w4 = __builtin_amdgcn_cvt_scalef32_pk_fp4_f32(w4, v[r][q].z * sc, v[r][q].w * sc, 1.0f, 1);
                        *(unsigned short*)(vrow + 16 * (jb + q) + 2 * gq) = (unsigned short)(w4 & 0xffffu); } }
                if (F.lane == 0) SUV[row] = inv; }
        }
    }
    {
        const int gt = gw * 64 + F.lane, ngt = NGW * 64;
        for (int p = gt; p < 262144 / 8; p += ngt) { const float* src = a.subkeys + (size_t)p * 8; const f32x4 v0 = *(const GAS f32x4*)src, v1 = *(const GAS f32x4*)(src + 4);
            v4u o; o.x = pk2(v0.x, v0.y); o.y = pk2(v0.z, v0.w); o.z = pk2(v1.x, v1.y); o.w = pk2(v1.z, v1.w); *(GAS v4u*)((bf16_t*)(ws + WS_SKB) + (size_t)p * 8) = o; }
    }
    bf16_t* MN = (bf16_t*)(ws + WS_MN);
    for (int row = gw; row < 1024; row += NGW) {
        const GAS f32x4* xr = (const GAS f32x4*)(a.mem + (size_t)row * D) + F.lane;
        f32x4 v[4]; float s = 0.f;
#pragma unroll
        for (int j = 0; j < 4; ++j) { v[j] = xr[64 * j]; s += (v[j].x * v[j].x + v[j].y * v[j].y) + (v[j].z * v[j].z + v[j].w * v[j].w); }
        const float rstd = rsqrtf(wave_sum(s) * (1.f / D) + EPS);
        GAS unsigned long long* o8 = (GAS unsigned long long*)(MN + (size_t)row * D) + F.lane;
#pragma unroll
        for (int j = 0; j < 4; ++j) { const f32x4 g = *((const f32x4*)a.g_mem + F.lane + 64 * j); const f32x4 o = v[j] * g * rstd;
            o8[64 * j] = (unsigned long long)pk2(o.x, o.y) | ((unsigned long long)pk2(o.z, o.w) << 32); }
    }
}
__device__ __forceinline__ void rstd_rows_for_units(Frame& F, int N, const float* SS, float* rstd) {
    pg8::StaticOrder S2; S2.init(T, N, F.G, (int)blockIdx.x); pg8::Unit u;
    for (int i = 0; S2.next(i, u); ++i) if (F.tid < 256) { const int row = u.pm * 256 + F.tid; const f32x4* sp = (const f32x4*)(SS + (size_t)row * 16);
        const f32x4 a = (sp[0] + sp[1]) + (sp[2] + sp[3]); rstd[row] = rsqrtf(((a.x + a.y) + (a.z + a.w)) * (1.f / 1024.f) + EPS); }
    asm volatile("s_waitcnt vmcnt(0)" ::: "memory"); __syncthreads();
}

__device__ __forceinline__ void sub_barrier(gu32* cnt, unsigned n, gu32* tmo) {
    asm volatile("s_waitcnt vmcnt(0)" ::: "memory");
    __syncthreads();
    if (threadIdx.x == 0) {
        __builtin_amdgcn_fence(__ATOMIC_RELEASE, "agent");
        asm volatile("s_waitcnt vmcnt(0)" ::: "memory");
        __hip_atomic_fetch_add(cnt, 1u, __ATOMIC_RELAXED, __HIP_MEMORY_SCOPE_AGENT);
        unsigned sp = 0;
        while (__hip_atomic_load(cnt, __ATOMIC_RELAXED, __HIP_MEMORY_SCOPE_AGENT) < n) { __builtin_amdgcn_s_sleep(2); if (++sp > (1u << 22)) { __hip_atomic_store(tmo, 1u, __ATOMIC_RELAXED, __HIP_MEMORY_SCOPE_AGENT); break; } }
        __builtin_amdgcn_fence(__ATOMIC_ACQUIRE, "agent");
        asm volatile("s_waitcnt vmcnt(0)" ::: "memory");
    }
    __syncthreads();
}

__global__ void __launch_bounds__(NWAVES * 64, 2) mk_fwd(Args args) {
    extern __shared__ __attribute__((aligned(16))) unsigned char lds_raw[];
    Frame F;
    F.lds = (LAS unsigned char*)lds_raw;
    F.tid = threadIdx.x; F.lane = F.tid & 63; F.wave = __builtin_amdgcn_readfirstlane(F.tid >> 6);
    F.G = gridDim.x; { const int bx = blockIdx.x; F.vcu = (F.G % 8 == 0) ? (bx % 8) * (F.G / 8) + bx / 8 : bx; }
    unsigned char* ws = args.ws;
    gu32* ctl = (gu32*)(ws + WS_CTL);
    volatile LAS unsigned* MISC = (volatile LAS unsigned*)(F.lds + MISC_OFF);
    for (int u = F.tid; u < (LDS_BYTES - LDSCTL_OFF) / 4; u += NWAVES * 64) ((LAS unsigned*)(F.lds + LDSCTL_OFF))[u] = 0u;
    __syncthreads();
    XcdBarrier bar = xcd_barrier_post((unsigned*)(ctl + CW_BAR) + args.bar_region * XCD_BAR_WORDS, MISC + 8);
    const int lo = args.ph_lo, hi = args.ph_hi;
#define IN(k) (lo <= (k) && (k) < hi)
#ifndef PROBE_PH
#define PROBE_PH (-1)
#endif
    unsigned long long pb_t = (PROBE_PH >= 0) ? __builtin_amdgcn_s_memrealtime() : 0ull;
#define PB_STRETCH() do { const unsigned long long e_ = __builtin_amdgcn_s_memrealtime(), d_ = e_ - pb_t; while (__builtin_amdgcn_s_memrealtime() - e_ < d_) __builtin_amdgcn_s_sleep(4); } while (0)
#define SEAM(k) do { if (PROBE_PH == (k)) PB_STRETCH(); if (IN(k) && IN((k) + 1)) xcd_barrier(bar); if ((k) < PROBE_PH) pb_t = __builtin_amdgcn_s_memrealtime(); } while (0)
    bf16_t* A0 = (bf16_t*)(ws + WS_A0); bf16_t* A1 = (bf16_t*)(ws + WS_A1);
    bf16_t* MG = (bf16_t*)args.out;
    bf16_t* SBQ = (bf16_t*)args.out; bf16_t* SBK = SBQ + (size_t)T * 512; bf16_t* SBV = SBK + (size_t)T * 512; bf16_t* OSB = SBV + (size_t)T * 512;

    GdnBufs Gb{(bf16_t*)(ws + WS_NW), (bf16_t*)(ws + WS_QD), (bf16_t*)(ws + WS_KDT), (bf16_t*)(ws + WS_QK), (bf16_t*)(ws + WS_UT), (float*)(ws + WS_CD), (bf16_t*)(ws + WS_ORAW), (float*)(ws + WS_OSS)};
    if (IN(0)) { p0_prologue(F, args);}
    SEAM(0);
    if (IN(1)) {
        { pg8::Gemm g{A0, (const bf16_t*)(ws + WS_WIN), T, NPROJ, 1024}; pg8::StaticOrder S; S.init(T, NPROJ, F.G, (int)blockIdx.x);
          pg8::EpiProj E{(const float*)(ws + WS_RSTD0), SBQ, SBK, SBV, A1, (bf16_t*)(ws + WS_GZ), (bf16_t*)(ws + WS_GSB), (bf16_t*)(ws + WS_GGDN)};
          pg8::gemm_phase<pg8::EpiProj, pg8::StaticOrder, true, true>(F.lds, g, S, E); }
    }
    SEAM(1);
    if (IN(2)) { gdn_prep_phase(F, args, A1, (const float*)(ws + WS_GB), (const float*)(ws + WS_GB) + T * 4, Gb); }
    SEAM(2);
    if (IN(3)) {
        const int nscan = F.G > 64 ? 64 : F.G, sb0 = F.G > 64 ? 64 : 0;
        if ((int)blockIdx.x < nscan) for (int s0 = blockIdx.x; s0 < 64; s0 += nscan) { const int s = (nscan == 64) ? ((s0 & 7) + 8 * (s0 >> 5)) * 4 + ((s0 >> 3) & 3) : s0; gdn_scan_unit(F, s, Gb); __syncthreads(); }
        if ((int)blockIdx.x >= sb0) { late_prologue(F, args, (int)blockIdx.x - sb0, F.G - sb0); __syncthreads(); }
        if ((int)blockIdx.x >= sb0) sb_phase(F.lds + F.wave * 8192, SBQ, SBK, SBV, OSB, ((int)blockIdx.x - sb0) * NWAVES + F.wave, (F.G - sb0) * NWAVES, F.lane);
        __syncthreads();
        if (sb0 > 0 && (int)blockIdx.x >= sb0) {
            sub_barrier(ctl + CW_SUB, (unsigned)(F.G - sb0), ctl + CW_SUB + 64);
            pg8::Gemm g{OSB, (const bf16_t*)(ws + WS_WSB), T, 1024, 512}; pg8::StaticOrder S; S.init(T, 1024, F.G - sb0, (int)blockIdx.x - sb0);
            pg8::EpiMerge<false> E{(const bf16_t*)(ws + WS_GSB), MG};
            pg8::gemm_phase<pg8::EpiMerge<false>, pg8::StaticOrder, true, true>(F.lds, g, S, E);
            const int wgi = (int)blockIdx.x - sb0;
            if (F.G - sb0 >= 160 && wgi >= 128 && wgi < 160) { pg8::Gemm g2{(const bf16_t*)(ws + WS_MN), (const bf16_t*)(ws + WS_WCKV), 1024, 2048, 1024}; pg8::StaticOrder S2; S2.init(1024, 2048, 32, wgi - 128);
                pg8::EpiSplit E2{(bf16_t*)(ws + WS_KC), (bf16_t*)(ws + WS_VC), 1024, 4};
                pg8::gemm_phase<pg8::EpiSplit, pg8::StaticOrder, true, true>(F.lds, g2, S2, E2); }
        }
    }
    SEAM(3);
    if (IN(4)) {
        if (!(F.G > 64 && F.G - 64 >= 160)) { pg8::Gemm g{(const bf16_t*)(ws + WS_MN), (const bf16_t*)(ws + WS_WCKV), 1024, 2048, 1024}; pg8::StaticOrder S; S.init(1024, 2048, F.G, (int)blockIdx.x);
          pg8::EpiSplit E{(bf16_t*)(ws + WS_KC), (bf16_t*)(ws + WS_VC), 1024, 4};
          pg8::gemm_phase<pg8::EpiSplit, pg8::StaticOrder, true, true>(F.lds, g, S, E); }
        gdn_finish_phase(F, args, Gb, (const bf16_t*)(ws + WS_GZ), (bf16_t*)(ws + WS_OG)); }
    SEAM(4);
    if (IN(5)) {
        if (!(F.G > 64)) { pg8::Gemm g{OSB, (const bf16_t*)(ws + WS_WSB), T, 1024, 512}; pg8::StaticOrder S; S.init(T, 1024, F.G, (int)blockIdx.x);
          pg8::EpiMerge<false> E{(const bf16_t*)(ws + WS_GSB), MG};
          pg8::gemm_phase<pg8::EpiMerge<false>, pg8::StaticOrder, true, true>(F.lds, g, S, E);
          xcd_barrier(bar); }
        { pg8::Gemm g{(const bf16_t*)(ws + WS_OG), (const bf16_t*)(ws + WS_WGDN), T, 1024, 512}; pg8::StaticOrder S; S.init(T, 1024, F.G, (int)blockIdx.x);
          pg8::EpiMerge<true> E{(const bf16_t*)(ws + WS_GGDN), MG};
          pg8::gemm_phase<pg8::EpiMerge<true>, pg8::StaticOrder, true, true>(F.lds, g, S, E); }
    }
    SEAM(5);
    if (IN(6)) {
        pg8::Gemm g{MG, (const bf16_t*)(ws + WS_WMIX), T, 1024, 1024}; pg8::StaticOrder S; S.init(T, 1024, F.G, (int)blockIdx.x);
        pg8::EpiRes<true> E{args.x, nullptr, A1, (float*)(ws + WS_SS)};
        pg8::gemm_phase<pg8::EpiRes<true>, pg8::StaticOrder, true, true>(F.lds, g, S, E);
    }
    SEAM(6);
    if (IN(7)) {
        rstd_rows_for_units(F, 1024, (const float*)(ws + WS_SS), (float*)(ws + WS_RSTD0));
        pg8::Gemm g{A1, (const bf16_t*)(ws + WS_WCQ), T, 1024, 1024}; pg8::StaticOrder S; S.init(T, 1024, F.G, (int)blockIdx.x);
        pg8::EpiScale E{(const float*)(ws + WS_RSTD0), (bf16_t*)(ws + WS_GSB), 1024};
        pg8::gemm_phase<pg8::EpiScale, pg8::StaticOrder, true, true>(F.lds, g, S, E);
        asm volatile("s_waitcnt vmcnt(0)" ::: "memory"); __syncthreads();
        pg8::StaticOrder S2; S2.init(T, 1024, F.G, (int)blockIdx.x); pg8::Unit u;
        for (int i = 0; S2.next(i, u); ++i) cross_item(F, (const bf16_t*)(ws + WS_GSB), (const bf16_t*)(ws + WS_KC), (const bf16_t*)(ws + WS_VC), (bf16_t*)(ws + WS_GGDN), (u.pm >> 5) * 4 + u.pn, u.pm & 31);
    }
    SEAM(7);
    if (IN(9)) {
        pg8::Gemm g{(const bf16_t*)(ws + WS_GGDN), (const bf16_t*)(ws + WS_WCO), T, 1024, 1024}; pg8::StaticOrder S; S.init(T, 1024, F.G, (int)blockIdx.x);
        pg8::EpiRes<false> E{nullptr, A1, A0, (float*)(ws + WS_SS)};
        pg8::gemm_phase<pg8::EpiRes<false>, pg8::StaticOrder, true, true>(F.lds, g, S, E);
    }
    SEAM(9);
    if (IN(10)) {
        rstd_rows_for_units(F, 2048, (const float*)(ws + WS_SS), (float*)(ws + WS_RSTD2));
        pg8::Gemm g{A0, (const bf16_t*)(ws + WS_WPQ), T, 2048, 1024}; pg8::StaticOrder S; S.init(T, 2048, F.G, (int)blockIdx.x);
        pg8::EpiScale E{(const float*)(ws + WS_RSTD2), A1, 2048};
        pg8::gemm_phase<pg8::EpiScale, pg8::StaticOrder, true, true>(F.lds, g, S, E);
        asm volatile("s_waitcnt vmcnt(0)" ::: "memory"); __syncthreads();
        pg8::StaticOrder S2; S2.init(T, 2048, F.G, (int)blockIdx.x); pg8::Unit u;
        int hst = -1;
        for (int i = 0; S2.next(i, u); ++i) {
            if (u.pn != hst) { hst = u.pn; __syncthreads();
#pragma unroll
                for (int q = 0; q < 8; ++q) { const int cid = F.tid + 512 * q, r = cid >> 4, c = cid & 15;
                    *(LAS v4u*)(F.lds + r * 256 + ((c ^ (r & 15)) << 4)) = *(const v4u*)((const bf16_t*)(ws + WS_SKB) + ((size_t)u.pn * 256 + r) * 128 + c * 8); }
                __syncthreads(); }
            peer_route_task(F, A1, (const bf16_t*)(ws + WS_SKB), (int*)(ws + 296 * MiB), (float*)(ws + 312 * MiB), u.pm * 8 + F.wave, u.pn);
        }
        __syncthreads();
    }
    SEAM(10);
    if (IN(12)) { peer_u_phase(F, args, ctl, A0, (const float*)(ws + WS_RSTD2), (const int*)(ws + 296 * MiB), (const unsigned char*)(ws + WS_U8), (bf16_t*)(ws + WS_PART)); }
    SEAM(12);
    if (IN(13)) { peer_combine_phase(F, (const bf16_t*)(ws + WS_PART), (const int*)(ws + 296 * MiB), (const float*)(ws + 312 * MiB), (const float*)(ws + WS_SUV), (const float*)(ws + WS_SUV) + 16384, (float*)(ws + 328 * MiB)); }
    SEAM(13);
    if (IN(14)) { peer_v_phase(F, ctl, (const int*)(ws + 296 * MiB), (const float*)(ws + 328 * MiB), (const unsigned char*)(ws + WS_V8), A0, A1, (float*)(ws + WS_SS)); }
    SEAM(14);
    if (IN(15)) { peer_norm_phase(F, args, (const float*)(ws + WS_SS), A1, args.out); }
    if (PROBE_PH == 15) PB_STRETCH();
#undef IN
#undef SEAM
#undef PB_STRETCH
}
extern "C" void kernel_launch(void* const* d_in, const int* in_sizes, int n_in, void* d_out, int out_size, void* d_ws, size_t ws_size, hipStream_t stream) {
    static int grid = 0;
    if (grid == 0) {
        if (n_in != 22 || ws_size < WS_END || out_size != T * D) { fprintf(stderr, "kernel_launch: unexpected n_in %d / ws %zu / out %d\n", n_in, ws_size, out_size); grid = -1; return; }
        int dev = 0, cus = 0, per_cu = 0;
        if (hipGetDevice(&dev) != hipSuccess || hipDeviceGetAttribute(&cus, hipDeviceAttributeMultiprocessorCount, dev) != hipSuccess) { grid = -1; return; }
        if (hipFuncSetAttribute((const void*)mk_fwd, hipFuncAttributeMaxDynamicSharedMemorySize, LDS_BYTES) != hipSuccess) { fprintf(stderr, "kernel_launch: hipFuncSetAttribute failed\n"); grid = -1; return; }
        if (hipOccupancyMaxActiveBlocksPerMultiprocessor(&per_cu, (const void*)mk_fwd, NWAVES * 64, LDS_BYTES) != hipSuccess || per_cu < 1) { fprintf(stderr, "kernel_launch: occupancy query says %d\n", per_cu); per_cu = 1; }
        (void)hipGetLastError();
        grid = cus;
    }
    if (grid < 0) return;
    hipMemsetAsync((char*)d_ws + WS_CTL, 0, CTL_ZERO_BYTES, stream);
    Args a{};
    const float** ap = (const float**)&a;
    for (int i = 0; i < 22; ++i) ap[i] = (const float*)d_in[i];
    a.out = (float*)d_out; a.ws = (unsigned char*)d_ws;
    char* ws = (char*)d_ws; float* out = (float*)d_out;
    float* rstd2 = (float*)(ws + WS_RSTD2);
    bf16_t* KC = (bf16_t*)(ws + WS_KC); bf16_t* VC = (bf16_t*)(ws + WS_VC);
    bf16_t* PQ = (bf16_t*)(ws + WS_A1); bf16_t* QC = (bf16_t*)(ws + WS_GSB); bf16_t* OC = (bf16_t*)(ws + WS_GGDN);
    int* EIDX = (int*)(ws + 296 * MiB); float* EGATE = (float*)(ws + 312 * MiB);
#define MK(lo, hi, reg) do { a.ph_lo = (lo); a.ph_hi = (hi); a.bar_region = (reg); hipLaunchKernelGGL(mk_fwd, dim3(grid), dim3(NWAVES * 64), LDS_BYTES, stream, a); } while (0)
    MK(0, 16, 0);
#undef MK
}
```

```cpp
#include <hip/hip_runtime.h>
#include <stdint.h>
#include <cstdio>

typedef unsigned short bf16_t;
__device__ __forceinline__ float bf2f(bf16_t v) { return __uint_as_float(((unsigned)v) << 16); }
__device__ __forceinline__ bf16_t f2bf(float f) { unsigned u = __float_as_uint(f); return (bf16_t)((u + 0x7fffu + ((u >> 16) & 1u)) >> 16); }

constexpr int T = 32768, D = 1024, SEQ = 8192, NB = 4;
constexpr int IN_COLS = 5640, NPROJ = 5632;
constexpr float EPS = 1e-6f;
constexpr size_t MiB = 1u << 20;

__device__ __forceinline__ float wave_sum(float v) {
#pragma unroll
    for (int o = 1; o < 64; o <<= 1) v += __shfl_xor(v, o);
    return v;
}
__device__ __forceinline__ float sigmoidf_(float x) { return 1.f / (1.f + __expf(-x)); }
__device__ __forceinline__ float softplusf_(float x) { return fmaxf(x, 0.f) + log1pf(__expf(-fabsf(x))); }

namespace pg8 {
#define PG8_LAS __attribute__((address_space(3)))
typedef unsigned short bf16_t;
typedef short bf16x8 __attribute__((ext_vector_type(8)));
typedef float f32x4 __attribute__((ext_vector_type(4)));
typedef unsigned u32x4 __attribute__((ext_vector_type(4)));
constexpr int BM = 256, BK = 64, HALF = 128, HTB = HALF * BK * 2  , STAGE_BYTES = 8 * HTB, NXCD = 8, WGM = 8;

__host__ __device__ __forceinline__ int lds_byte(int r, int c) { const int st = (r >> 4) * 2 + (c >> 5), rr = r & 15, cc = c & 31, ob = rr * 64 + cc * 2; return st * 1024 + (ob ^ (((ob >> 9) & 1) << 5)); }
__host__ __device__ __forceinline__ void stage_rc(int b, int& R, int& C) { const int st = b / 1024, sb = b % 1024, swz = sb ^ (((sb >> 9) & 1) << 5); R = (st >> 1) * 16 + swz / 64; C = (st & 1) * 32 + (swz % 64) / 2; }
__host__ __device__ __forceinline__ int perm32(int rho) { const int n = rho >> 4, i = rho & 15; return 8 * (i >> 2) + 4 * n + (i & 3); }

struct Unit { int pm, pn; };
struct Gemm { const bf16_t* A; const bf16_t* Bt; int M, N, K; };

struct StaticOrder {
    int nM, nN, nwg, G, c;
    __host__ __device__ __forceinline__ void init(int M, int N, int G_, int c_) { nM = M / BM; nN = N / BM; nwg = nM * nN; G = G_; c = c_; }
    __host__ __device__ __forceinline__ bool next(int i, Unit& u) const {
        const long L = (long)i * G + c; if (L >= nwg) return false;
        int wgid = (int)L; { const int q = nwg / NXCD, r = nwg % NXCD, xcd = wgid % NXCD, off = wgid / NXCD; wgid = (xcd < r ? xcd * (q + 1) : r * (q + 1) + (xcd - r) * q) + off; }
        const int nig = WGM * nN, gid = wgid / nig, fm = gid * WGM, gsz = (nM - fm) < WGM ? (nM - fm) : WGM;
        u.pm = fm + ((wgid % nig) % gsz); u.pn = (wgid % nig) / gsz; return true;
    }
    __device__ __forceinline__ void a_ready(const Unit&) const {}
    __device__ __forceinline__ void done(const Unit&) const {}
};

__device__ __forceinline__ unsigned cvt_pk_bf16(float lo, float hi) { unsigned r; asm volatile("v_cvt_pk_bf16_f32 %0, %1, %2" : "=v"(r) : "v"(lo), "v"(hi)); return r; }
typedef float f32x2 __attribute__((ext_vector_type(2)));
__device__ __forceinline__ float bfl(unsigned w) { return __uint_as_float(w << 16); }
__device__ __forceinline__ float bfh(unsigned w) { return __uint_as_float(w & 0xffff0000u); }
constexpr int EPI_STAGE_OFF = 131072 + 1024;
__device__ __forceinline__ void stage_store16x64(int wid, int fr, int fq, u32x4 w0, u32x4 w1, bf16_t* rowbase  , size_t ld) {
    PG8_LAS unsigned char* sl = (PG8_LAS unsigned char*)(EPI_STAGE_OFF + wid * 2048);
    *(PG8_LAS u32x4*)(sl + fr * 128 + ((fq ^ (fr & 7)) << 4)) = w0;
    *(PG8_LAS u32x4*)(sl + fr * 128 + (((4 + fq) ^ (fr & 7)) << 4)) = w1;
    const int lane = fr + 16 * fq, r0 = lane >> 3, c = lane & 7;
    const u32x4 a = *(const PG8_LAS u32x4*)(sl + r0 * 128 + ((c ^ r0) << 4));
    const u32x4 b = *(const PG8_LAS u32x4*)(sl + (r0 + 8) * 128 + ((c ^ r0) << 4));
    *(u32x4*)(rowbase + (size_t)r0 * ld + c * 8) = a;
    *(u32x4*)(rowbase + (size_t)(r0 + 8) * ld + c * 8) = b;
}
__device__ __forceinline__ u32x4 pack8(const f32x4& v0, const f32x4& v1) { u32x4 w; w.x = cvt_pk_bf16(v0[0], v0[1]); w.y = cvt_pk_bf16(v0[2], v0[3]); w.z = cvt_pk_bf16(v1[0], v1[1]); w.w = cvt_pk_bf16(v1[2], v1[3]); return w; }

struct EpiProj {
    static constexpr bool PERM = true, AFTER_DRAIN = false, COL64 = true;
    const float* rstd; bf16_t *SBQ, *SBK, *SBV, *GQKV, *GZ, *GSB, *GGDN;
    __device__ __forceinline__ void operator()(const f32x4 (&acc)[2][2][4][2], const Unit& u, int wr, int wc, int fr_in, int fq_in) const {
        int lane_ = fr_in + 16 * fq_in; asm volatile("" : "+v"(lane_));
        const int fr = lane_ & 15, fq = lane_ >> 4;
        const int pn = u.pn; bf16_t* base; int ld, coff;
        if (pn < 2) { base = SBQ; ld = 512; coff = pn * 256; } else if (pn < 4) { base = SBK; ld = 512; coff = (pn - 2) * 256; } else if (pn < 6) { base = SBV; ld = 512; coff = (pn - 4) * 256; }
        else if (pn < 12) { base = GQKV; ld = 1536; coff = (pn - 6) * 256; } else if (pn < 14) { base = GZ; ld = 512; coff = (pn - 12) * 256; }
        else if (pn < 18) { base = GSB; ld = 1024; coff = (pn - 14) * 256; } else { base = GGDN; ld = 1024; coff = (pn - 18) * 256; }
        const int row0 = u.pm * BM + wr * 64, wid = wr * 4 + wc;
        float rsv[2][4];
#pragma unroll
        for (int ai = 0; ai < 2; ++ai)
#pragma unroll
            for (int m = 0; m < 4; ++m) rsv[ai][m] = rstd[row0 + ai * HALF + m * 16 + fr];
#pragma unroll
        for (int ai = 0; ai < 2; ++ai)
#pragma unroll
            for (int m = 0; m < 4; ++m) { const int rg = row0 + ai * HALF + m * 16; const float rs = rsv[ai][m];
                stage_store16x64(wid, fr, fq, pack8(acc[ai][0][m][0] * rs, acc[ai][0][m][1] * rs), pack8(acc[ai][1][m][0] * rs, acc[ai][1][m][1] * rs), base + (size_t)rg * ld + coff + wc * 64, ld); }
    }
};
struct EpiSplit {
    static constexpr bool PERM = true, AFTER_DRAIN = false, COL64 = true;
    bf16_t *O0, *O1; int ldc, split_tiles;
    __device__ __forceinline__ void operator()(const f32x4 (&acc)[2][2][4][2], const Unit& u, int wr, int wc, int fr_in, int fq_in) const {
        int lane_ = fr_in + 16 * fq_in; asm volatile("" : "+v"(lane_));
        const int fr = lane_ & 15, fq = lane_ >> 4;
        bf16_t* base = u.pn < split_tiles ? O0 : O1; const int coff = (u.pn < split_tiles ? u.pn : u.pn - split_tiles) * 256;
        const int row0 = u.pm * BM + wr * 64, wid = wr * 4 + wc;
#pragma unroll
        for (int ai = 0; ai < 2; ++ai)
#pragma unroll
            for (int m = 0; m < 4; ++m) { const int rg = row0 + ai * HALF + m * 16;
                stage_store16x64(wid, fr, fq, pack8(acc[ai][0][m][0], acc[ai][0][m][1]), pack8(acc[ai][1][m][0], acc[ai][1][m][1]), base + (size_t)rg * ldc + coff + wc * 64, ldc); }
    }
};
template <bool ADD> struct EpiMerge {
    static constexpr bool PERM = true, AFTER_DRAIN = false, COL64 = true;
    const bf16_t* gate; bf16_t* M;
    __device__ __forceinline__ void operator()(const f32x4 (&acc)[2][2][4][2], const Unit& u, int wr, int wc, int fr_in, int fq_in) const {
        int lane_ = fr_in + 16 * fq_in; asm volatile("" : "+v"(lane_));
        const int fr = lane_ & 15, fq = lane_ >> 4;
        const int row0 = u.pm * BM + wr * 64, col0 = u.pn * BM + wc * 64, wid = wr * 4 + wc;
#pragma unroll
        for (int ab = 0; ab < 4; ++ab) { const int ai = ab >> 1, mb = (ab & 1) * 2;
            u32x4 gl[4][2], pl[4][2];
#pragma unroll
            for (int m = mb; m < mb + 2; ++m)
#pragma unroll
                for (int bj = 0; bj < 2; ++bj) { const size_t o = (size_t)(row0 + ai * HALF + m * 16 + fr) * 1024 + col0 + 8 * fq + bj * 32; gl[m][bj] = *(const u32x4*)(gate + o); if (ADD) pl[m][bj] = *(const u32x4*)(M + o); }
#pragma unroll
            for (int m = mb; m < mb + 2; ++m) { const int rg = row0 + ai * HALF + m * 16;
                u32x4 wv[2];
#pragma unroll
                for (int bj = 0; bj < 2; ++bj) { const u32x4 g = gl[m][bj];
                    float gv[8] = {bfl(g.x), bfh(g.x), bfl(g.y), bfh(g.y), bfl(g.z), bfh(g.z), bfl(g.w), bfh(g.w)};
                    float pv[8] = {0.f, 0.f, 0.f, 0.f, 0.f, 0.f, 0.f, 0.f};
                    if (ADD) { const u32x4 p = pl[m][bj]; pv[0] = bfl(p.x); pv[1] = bfh(p.x); pv[2] = bfl(p.y); pv[3] = bfh(p.y); pv[4] = bfl(p.z); pv[5] = bfh(p.z); pv[6] = bfl(p.w); pv[7] = bfh(p.w); }
                    float r[8];
#pragma unroll
                    for (int j = 0; j < 8; ++j) { const float a = j < 4 ? acc[ai][bj][m][0][j] : acc[ai][bj][m][1][j - 4]; r[j] = pv[j] + a * __builtin_amdgcn_rcpf(1.f + __expf(-gv[j])); }
                    wv[bj].x = cvt_pk_bf16(r[0], r[1]); wv[bj].y = cvt_pk_bf16(r[2], r[3]); wv[bj].z = cvt_pk_bf16(r[4], r[5]); wv[bj].w = cvt_pk_bf16(r[6], r[7]); }
                stage_store16x64(wid, fr, fq, wv[0], wv[1], M + (size_t)rg * 1024 + col0, 1024); }
        }
    }
};
template <bool IN_F32> struct EpiRes {
    static constexpr bool PERM = true, AFTER_DRAIN = false, COL64 = true;
    const float* xin_f; const bf16_t* xin_b; bf16_t* xb; float* SS;
    __device__ __forceinline__ void operator()(const f32x4 (&acc)[2][2][4][2], const Unit& u, int wr, int wc, int fr_in, int fq_in) const {
        int lane_ = fr_in + 16 * fq_in; asm volatile("" : "+v"(lane_));
        const int fr = lane_ & 15, fq = lane_ >> 4;
        const int row0 = u.pm * BM + wr * 64, col0 = u.pn * BM + wc * 64, wid = wr * 4 + wc;
#pragma unroll
        for (int ab = 0; ab < 4; ++ab) { const int ai = ab >> 1, mb = (ab & 1) * 2;
            f32x4 xl[4][2][2];
#pragma unroll
            for (int m = mb; m < mb + 2; ++m)
#pragma unroll
                for (int bj = 0; bj < 2; ++bj) { const size_t o = (size_t)(row0 + ai * HALF + m * 16 + fr) * 1024 + col0 + 8 * fq + bj * 32;
                    if (IN_F32) { xl[m][bj][0] = *(const f32x4*)(xin_f + o); xl[m][bj][1] = *(const f32x4*)(xin_f + o + 4); }
                    else { const u32x4 p = *(const u32x4*)(xin_b + o); xl[m][bj][0] = (f32x4){bfl(p.x), bfh(p.x), bfl(p.y), bfh(p.y)}; xl[m][bj][1] = (f32x4){bfl(p.z), bfh(p.z), bfl(p.w), bfh(p.w)}; } }
            float sv[4];
#pragma unroll
            for (int m = mb; m < mb + 2; ++m) { const int rg = row0 + ai * HALF + m * 16; float s = 0.f;
                u32x4 wv[2];
#pragma unroll
                for (int bj = 0; bj < 2; ++bj) { const u32x4 w = pack8(xl[m][bj][0] + acc[ai][bj][m][0], xl[m][bj][1] + acc[ai][bj][m][1]); wv[bj] = w;
                    const float r0 = bfl(w.x), r1 = bfh(w.x), r2 = bfl(w.y), r3 = bfh(w.y), r4 = bfl(w.z), r5 = bfh(w.z), r6 = bfl(w.w), r7 = bfh(w.w);
                    s += (r0 * r0 + r1 * r1) + (r2 * r2 + r3 * r3) + (r4 * r4 + r5 * r5) + (r6 * r6 + r7 * r7); }
                stage_store16x64(wid, fr, fq, wv[0], wv[1], xb + (size_t)rg * 1024 + col0, 1024);
                s += __shfl_xor(s, 16); s += __shfl_xor(s, 32); sv[m] = s; }
#pragma unroll
            for (int m = mb; m < mb + 2; ++m) if (fq == 0) SS[(size_t)(row0 + ai * HALF + m * 16 + fr) * 16 + u.pn * 4 + wc] = sv[m];
        }
    }
};
struct EpiScale {
    static constexpr bool PERM = true, AFTER_DRAIN = false, COL64 = true;
    const float* rstd; bf16_t* O; int ldc;
    __device__ __forceinline__ void operator()(const f32x4 (&acc)[2][2][4][2], const Unit& u, int wr, int wc, int fr_in, int fq_in) const {
        int lane_ = fr_in + 16 * fq_in; asm volatile("" : "+v"(lane_));
        const int fr = lane_ & 15, fq = lane_ >> 4;
        const int row0 = u.pm * BM + wr * 64, col0 = u.pn * BM + wc * 64, wid = wr * 4 + wc;
        float rsv[2][4];
#pragma unroll
        for (int ai = 0; ai < 2; ++ai)
#pragma unroll
            for (int m = 0; m < 4; ++m) rsv[ai][m] = rstd[row0 + ai * HALF + m * 16 + fr];
#pragma unroll
        for (int ai = 0; ai < 2; ++ai)
#pragma unroll
            for (int m = 0; m < 4; ++m) { const int rg = row0 + ai * HALF + m * 16; const float rs = rsv[ai][m];
                stage_store16x64(wid, fr, fq, pack8(acc[ai][0][m][0] * rs, acc[ai][0][m][1] * rs), pack8(acc[ai][1][m][0] * rs, acc[ai][1][m][1] * rs), O + (size_t)rg * ldc + col0, ldc); }
    }
};
template <class Epi, class Sched, bool ALIGN_EPI = false, bool SP2 = false>
__device__ __forceinline__ void gemm_phase(PG8_LAS unsigned char* lds, const Gemm g, const Sched& S, const Epi& E) {
    const int tid = threadIdx.x, wid = __builtin_amdgcn_readfirstlane(tid >> 6), lane = tid & 63, wr = wid >> 2, wc = wid & 3, fr = lane & 15, fq = lane >> 4;
    const int K = g.K, nt = K / BK;
    unsigned voffA[2], voffB[2];
#pragma unroll
    for (int i = 0; i < 2; ++i) { int R, C; stage_rc(tid * 16 + i * 8192, R, C); const int Rb = Epi::PERM ? ((Epi::COL64 ? 2 * (R & ~31) : (R & ~31)) + perm32(R & 31)) : R;
        voffA[i] = (unsigned)(R * K + C) * 2u; voffB[i] = (unsigned)(Rb * K + C) * 2u; }
    const size_t kstep = (size_t)(BK * 2);
    const size_t hstep = (size_t)HALF * K * 2;
    const size_t bhstep = Epi::COL64 ? (size_t)32 * K * 2 : hstep;
    const size_t tstep = 2 * hstep;
    const unsigned ldsw = (unsigned)wid * 1024u;
    const int aoff = lds_byte(wr * 64 + fr, fq * 8), boff = lds_byte(wc * 32 + fr, fq * 8);
#define PG8_SA(b, h) (((b) * 2 + (h)) * HTB)
#define PG8_SB(b, h) ((4 + (b) * 2 + (h)) * HTB)
#define PG8_STAGE(bufoff, gbase, voff) do { _Pragma("unroll") for (int _i = 0; _i < 2; ++_i) \
        __builtin_amdgcn_global_load_lds((const unsigned*)((const char*)(gbase) + (voff)[_i]), (PG8_LAS unsigned*)(lds + (bufoff) + ldsw + _i * 8192), 16, 0, 0); } while (0)
#define PG8_LDA(dst, b, h) do { _Pragma("unroll") for (int m = 0; m < 4; ++m) _Pragma("unroll") for (int k = 0; k < 2; ++k) dst[m][k] = *(const PG8_LAS bf16x8*)(lds + PG8_SA(b, h) + aoff + m * 2048 + k * 1024); } while (0)
#define PG8_LDB(dst, b, h) do { _Pragma("unroll") for (int n = 0; n < 2; ++n) _Pragma("unroll") for (int k = 0; k < 2; ++k) dst[n][k] = *(const PG8_LAS bf16x8*)(lds + PG8_SB(b, h) + boff + n * 2048 + k * 1024); } while (0)
#define PG8_MMA(ai, bj, At, Bt) do { __builtin_amdgcn_s_setprio(1); _Pragma("unroll") for (int m = 0; m < 4; ++m) _Pragma("unroll") for (int n = 0; n < 2; ++n) _Pragma("unroll") for (int k = 0; k < 2; ++k) \
        acc[ai][bj][m][n] = __builtin_amdgcn_mfma_f32_16x16x32_bf16(Bt[n][k], At[m][k], acc[ai][bj][m][n], 0, 0, 0); __builtin_amdgcn_s_setprio(0); } while (0)
#define PG8_WAIT_V(n) asm volatile("s_waitcnt vmcnt(" #n ")" ::: "memory")
#define PG8_WAIT_L(n) asm volatile("s_waitcnt lgkmcnt(" #n ")" ::: "memory")
#define PG8_BAR __builtin_amdgcn_s_barrier()
#define PG8_SCHED __builtin_amdgcn_sched_barrier(0)
    Unit cur, nxt; int ui = 0;
    if (!S.next(0, cur)) return;
    f32x4 acc[2][2][4][2];
#pragma unroll
    for (int a = 0; a < 2; ++a)
#pragma unroll
        for (int b = 0; b < 2; ++b)
#pragma unroll
            for (int m = 0; m < 4; ++m)
#pragma unroll
                for (int n = 0; n < 2; ++n) acc[a][b][m][n] = (f32x4){0.f, 0.f, 0.f, 0.f};
    bf16x8 At[4][2], B0[2][2], B1[2][2];
    const char* cA = (const char*)g.A + (size_t)cur.pm * tstep; const char* cB = (const char*)g.Bt + (size_t)cur.pn * tstep;
    S.a_ready(cur);
    if constexpr (SP2) {
        PG8_STAGE(PG8_SB(0, 0), cB, voffB); PG8_STAGE(PG8_SB(0, 1), cB + bhstep, voffB); PG8_STAGE(PG8_SA(0, 0), cA, voffA); PG8_STAGE(PG8_SA(0, 1), cA + hstep, voffA);
        if (wr == 1) PG8_BAR;
        PG8_WAIT_V(2); PG8_BAR;
        PG8_STAGE(PG8_SB(1, 0), cB + kstep, voffB); PG8_STAGE(PG8_SA(1, 0), cA + kstep, voffA); PG8_STAGE(PG8_SB(1, 1), cB + bhstep + kstep, voffB);
        PG8_WAIT_V(6); PG8_BAR;
    } else {
        PG8_STAGE(PG8_SB(0, 0), cB, voffB); PG8_STAGE(PG8_SA(0, 0), cA, voffA); PG8_STAGE(PG8_SB(0, 1), cB + bhstep, voffB); PG8_STAGE(PG8_SA(0, 1), cA + hstep, voffA);
        if (wr == 1) PG8_BAR;
        PG8_WAIT_V(4); PG8_BAR;
        PG8_STAGE(PG8_SB(1, 0), cB + kstep, voffB); PG8_STAGE(PG8_SA(1, 0), cA + kstep, voffA); PG8_STAGE(PG8_SB(1, 1), cB + bhstep + kstep, voffB);
        PG8_WAIT_V(6); PG8_BAR;
    }
    for (;;) {
        const bool has_next = S.next(ui + 1, nxt);
        const char* nA = has_next ? (const char*)g.A + (size_t)nxt.pm * tstep : cA; const char* nB = has_next ? (const char*)g.Bt + (size_t)nxt.pn * tstep : cB;
        for (int t = 0; t < nt; t += 2) {
            const bool last = (t == nt - 2);
            const char* a1 = cA + (size_t)(t + 1) * kstep;
            const char* a2 = last ? nA : cA + (size_t)(t + 2) * kstep; const char* b2 = last ? nB : cB + (size_t)(t + 2) * kstep;
            const char* a3 = a2 + kstep; const char* b3 = b2 + kstep;
            if (last && has_next) S.a_ready(nxt);
            if constexpr (SP2) {
            PG8_LDB(B0, 0, 0); PG8_LDB(B1, 0, 1); PG8_SCHED; PG8_LDA(At, 0, 0); PG8_STAGE(PG8_SA(1, 1), a1 + hstep, voffA);
            PG8_WAIT_V(8); PG8_WAIT_L(0); PG8_BAR; PG8_MMA(0, 0, At, B0); PG8_MMA(0, 1, At, B1); PG8_BAR; PG8_SCHED;
            PG8_LDA(At, 0, 1); PG8_STAGE(PG8_SB(0, 0), b2, voffB); PG8_STAGE(PG8_SB(0, 1), b2 + bhstep, voffB); PG8_STAGE(PG8_SA(0, 0), a2, voffA);
            PG8_WAIT_V(8); PG8_WAIT_L(0); PG8_BAR; PG8_MMA(1, 0, At, B0); PG8_MMA(1, 1, At, B1); PG8_BAR; PG8_SCHED;
            PG8_LDB(B0, 1, 0); PG8_LDB(B1, 1, 1); PG8_SCHED; PG8_LDA(At, 1, 0); PG8_STAGE(PG8_SA(0, 1), a2 + hstep, voffA);
            PG8_WAIT_V(8); PG8_WAIT_L(0); PG8_BAR; PG8_MMA(0, 0, At, B0); PG8_MMA(0, 1, At, B1); PG8_BAR; PG8_SCHED;
            PG8_LDA(At, 1, 1); PG8_STAGE(PG8_SB(1, 0), b3, voffB); PG8_STAGE(PG8_SB(1, 1), b3 + bhstep, voffB); PG8_STAGE(PG8_SA(1, 0), a3, voffA);
            PG8_WAIT_V(8); PG8_WAIT_L(0); PG8_BAR; PG8_MMA(1, 0, At, B0); PG8_MMA(1, 1, At, B1); PG8_BAR; PG8_SCHED;
            } else {
            PG8_LDB(B0, 0, 0); PG8_SCHED; PG8_LDA(At, 0, 0); PG8_STAGE(PG8_SA(1, 1), a1 + hstep, voffA);
            PG8_WAIT_L(8); PG8_BAR; PG8_WAIT_L(0); PG8_MMA(0, 0, At, B0); PG8_BAR; PG8_SCHED;
            PG8_LDB(B1, 0, 1); PG8_STAGE(PG8_SB(0, 0), b2, voffB);
            PG8_BAR; PG8_WAIT_L(0); PG8_MMA(0, 1, At, B1); PG8_BAR;
            PG8_LDA(At, 0, 1); PG8_STAGE(PG8_SA(0, 0), a2, voffA);
            PG8_BAR; PG8_WAIT_L(0); PG8_MMA(1, 0, At, B0); PG8_BAR; PG8_SCHED;
            PG8_STAGE(PG8_SB(0, 1), b2 + bhstep, voffB);
            PG8_WAIT_V(6); PG8_BAR; PG8_MMA(1, 1, At, B1); PG8_BAR;
            PG8_LDB(B0, 1, 0); PG8_SCHED; PG8_LDA(At, 1, 0); PG8_STAGE(PG8_SA(0, 1), a2 + hstep, voffA);
            PG8_WAIT_L(8); PG8_BAR; PG8_WAIT_L(0); PG8_MMA(0, 0, At, B0); PG8_BAR; PG8_SCHED;
            PG8_LDB(B1, 1, 1); PG8_STAGE(PG8_SB(1, 0), b3, voffB);
            PG8_BAR; PG8_WAIT_L(0); PG8_MMA(0, 1, At, B1); PG8_BAR;
            PG8_LDA(At, 1, 1); PG8_STAGE(PG8_SA(1, 0), a3, voffA);
            PG8_BAR; PG8_WAIT_L(0); PG8_MMA(1, 0, At, B0); PG8_BAR; PG8_SCHED;
            PG8_STAGE(PG8_SB(1, 1), b3 + bhstep, voffB);
            PG8_WAIT_V(6); PG8_BAR; PG8_MMA(1, 1, At, B1); PG8_BAR;
            }
        }
        if constexpr (ALIGN_EPI) { if (wr == 0) PG8_BAR; }
        if constexpr (!Epi::AFTER_DRAIN) { E(acc, cur, wr, wc, fr, fq); S.done(cur); }
        if (!has_next) break;
#pragma unroll
        for (int a = 0; a < 2; ++a)
#pragma unroll
            for (int b = 0; b < 2; ++b)
#pragma unroll
                for (int m = 0; m < 4; ++m)
#pragma unroll
                    for (int n = 0; n < 2; ++n) acc[a][b][m][n] = (f32x4){0.f, 0.f, 0.f, 0.f};
        cur = nxt; cA = nA; cB = nB; ++ui;
        if constexpr (ALIGN_EPI) { if (wr == 1) PG8_BAR; }
    }
    PG8_WAIT_V(0);
    if constexpr (!ALIGN_EPI) { if (wr == 0) PG8_BAR; }
    PG8_BAR;
    if constexpr (Epi::AFTER_DRAIN) { E.fused(acc, cur, wr, wc, fr, fq, lds, wid, lane); S.done(cur); }
#undef PG8_SA
#undef PG8_SB
#undef PG8_STAGE
#undef PG8_LDA
#undef PG8_LDB
#undef PG8_MMA
#undef PG8_WAIT_V
#undef PG8_WAIT_L
#undef PG8_BAR
#undef PG8_SCHED
}
}
#define GAS __attribute__((address_space(1)))
#define LAS __attribute__((address_space(3)))
typedef unsigned short bf16;
typedef unsigned v4u __attribute__((ext_vector_type(4)));
typedef float f32x4 __attribute__((ext_vector_type(4)));
typedef short bf16x8 __attribute__((ext_vector_type(8)));
typedef GAS unsigned gu32;
typedef GAS unsigned long long gu64;
#define RLX_AGENT __ATOMIC_RELAXED, __HIP_MEMORY_SCOPE_AGENT
#define LDS_WAIT() asm volatile("s_waitcnt lgkmcnt(0)" ::: "memory")
#define VM_WAIT() asm volatile("s_waitcnt vmcnt(0)" ::: "memory")
__device__ __forceinline__ unsigned long long rt() { return __builtin_amdgcn_s_memrealtime(); }
__device__ __forceinline__ unsigned pk2(float lo, float hi) { return (unsigned)f2bf(lo) | ((unsigned)f2bf(hi) << 16); }

#define XB_TMO      128
#define XB_XCNT(j)  (256  + 64 * (j))
#define XB_XSUB(j)  (1280 + 64 * (j))
#define XB_XGEN(j)  (2304 + 64 * (j))
#define XB_TOP      3328
#define XB_TOPGEN   3392
#define XCD_BAR_WORDS 3456
#define XB_SPIN_CAP (1u << 18)

__device__ __forceinline__ unsigned xb_ld(unsigned* p)              { return __hip_atomic_load(p, __ATOMIC_RELAXED, __HIP_MEMORY_SCOPE_AGENT); }
__device__ __forceinline__ unsigned xb_add(unsigned* p, unsigned v) { return __hip_atomic_fetch_add(p, v, __ATOMIC_RELAXED, __HIP_MEMORY_SCOPE_AGENT); }
__device__ __forceinline__ unsigned xb_xcc_id() { return (unsigned)__builtin_amdgcn_s_getreg((3 << 11) | 20) & 0xFu; }
#define XB_SPIN(cond, bar) do { unsigned _sp = 0; while (cond) { __builtin_amdgcn_s_sleep(1); \
    if ((++_sp & 255u) == 0u) { if (xb_ld(&(bar)[XB_TMO])) break; if (_sp > XB_SPIN_CAP) { atomicAdd(&(bar)[XB_TMO], 1u); break; } } } } while (0)

struct XcdBarrier {
    unsigned* bar; unsigned x;
    volatile LAS unsigned* st;
};

__device__ __forceinline__ XcdBarrier xcd_barrier_post(unsigned* bar, volatile LAS unsigned* st) {
    XcdBarrier b; b.bar = bar; b.x = xb_xcc_id(); b.st = st;
    if (threadIdx.x == 0) (void)xb_add(&bar[XB_XCNT(b.x)], 1u);
    return b;
}
__device__ __forceinline__ void xcd_barrier_complete(unsigned* bar, unsigned x, unsigned& nloc, unsigned& nx) {
    const unsigned G = gridDim.x * gridDim.y * gridDim.z;
    unsigned sum, cnt, mine, sp = 0u;
    for (;;) {
        sum = 0u; cnt = 0u; mine = 0u;
#pragma unroll
        for (unsigned j = 0; j < 16; ++j) { const unsigned c = xb_ld(&bar[XB_XCNT(j)]); sum += c; cnt += (c > 0u) ? 1u : 0u; mine = (j == x) ? c : mine; }
        if (sum == G) break;
        __builtin_amdgcn_s_sleep(1);
        if ((++sp & 255u) == 0u) { if (xb_ld(&bar[XB_TMO])) break; if (sp > XB_SPIN_CAP) { atomicAdd(&bar[XB_TMO], 1u); break; } }
    }
    nloc = mine > 0u ? mine : 1u; nx = cnt > 0u ? cnt : 1u;
}

__device__ __forceinline__ void xcd_barrier(const XcdBarrier& b) {
    asm volatile("s_waitcnt vmcnt(0)" ::: "memory");
    __syncthreads();
    if (threadIdx.x == 0) {
        unsigned* bar = b.bar;
        __builtin_amdgcn_s_waitcnt(0);
        unsigned nloc = b.st[0], nx = b.st[1];
        if (nloc == 0u) { xcd_barrier_complete(bar, b.x, nloc, nx); b.st[0] = nloc; b.st[1] = nx; }
        const unsigned old = xb_add(&bar[XB_XSUB(b.x)], 1u);
        const unsigned gen = old / nloc;
        if (old + 1u == (gen + 1u) * nloc) {
            __builtin_amdgcn_fence(__ATOMIC_RELEASE, "agent");
            asm volatile("s_waitcnt vmcnt(0)" ::: "memory");
            const unsigned og = xb_add(&bar[XB_TOP], 1u);
            const unsigned tg = og / nx;
            if (og + 1u == (tg + 1u) * nx) xb_add(&bar[XB_TOPGEN], 1u);
            else XB_SPIN(xb_ld(&bar[XB_TOPGEN]) == tg, bar);
            __builtin_amdgcn_fence(__ATOMIC_ACQUIRE, "agent");
            xb_add(&bar[XB_XGEN(b.x)], 1u);
            asm volatile("s_waitcnt vmcnt(0)" ::: "memory");
        } else {
            XB_SPIN(xb_ld(&bar[XB_XGEN(b.x)]) == gen, bar);
            __builtin_amdgcn_fence(__ATOMIC_ACQUIRE, "agent");
            asm volatile("s_waitcnt vmcnt(0)" ::: "memory");
        }
    }
    __syncthreads();
}
constexpr size_t KiB = 1024;
constexpr size_t WS_CTL = 0, CTL_ZERO_BYTES = 1 * MiB;
constexpr size_t WS_WIN = 1 * MiB, WS_WSB = 12 * MiB, WS_WGDN = 13 * MiB, WS_WMIX = 14 * MiB, WS_WCQ = 16 * MiB, WS_WCO = 18 * MiB, WS_WCKV = 20 * MiB, WS_WPQ = 24 * MiB, WS_SKB = 28 * MiB, WS_U16 = 30 * MiB, WS_V16 = 62 * MiB;
constexpr size_t WS_RSTD0 = 94 * MiB, WS_RSTD2 = 94 * MiB + 256 * KiB, WS_CD = 94 * MiB + 384 * KiB, WS_GB = 94 * MiB + 512 * KiB;
constexpr size_t WS_MN = 96 * MiB, WS_KC = 98 * MiB, WS_VC = 100 * MiB, WS_SS = 102 * MiB;
constexpr size_t WS_A0 = 104 * MiB;
constexpr size_t WS_NW = 104 * MiB, WS_QD = 136 * MiB;
constexpr size_t WS_A1 = 168 * MiB;
constexpr size_t WS_ORAW = 168 * MiB, WS_OSS = 200 * MiB, WS_OG = 232 * MiB;
constexpr size_t WS_GZ = 264 * MiB;
constexpr size_t WS_GSB = 296 * MiB, WS_GGDN = 360 * MiB;
constexpr size_t WS_KDT = 424 * MiB, WS_QK = 456 * MiB, WS_UT = 472 * MiB;
constexpr size_t WS_U8 = 30 * MiB, WS_V8 = 46 * MiB, WS_SUV = 62 * MiB;
constexpr size_t WS_PART = 344 * MiB;
constexpr size_t WS_END = 512 * MiB;
constexpr int CW_SUB = 12288;
constexpr int CW_BAR = 4096;

constexpr int NWAVES = 8;
constexpr int RING_BYTES = 131072, LDSCTL_OFF = RING_BYTES, MISC_OFF = LDSCTL_OFF + 320, LDS_BYTES = 149504;

struct Args {
    const float *x, *mem, *g_mix, *w_in, *gdn_conv, *a_log, *dt_bias, *gdn_norm_g, *w_sb_up, *w_gdn_up, *w_mix_out, *g_cross, *g_mem, *w_cq, *w_ckv, *w_co, *g_peer, *w_pq, *subkeys, *peer_u, *peer_v, *g_final;
    float* out; unsigned char* ws; int ph_lo, ph_hi, bar_region, pad;
};

struct Frame {
    LAS unsigned char* lds; int tid, lane, wave, vcu, G;
};


typedef short bf16x8_t __attribute__((ext_vector_type(8)));
typedef float f32x16_t __attribute__((ext_vector_type(16)));
typedef short v4i16_t __attribute__((ext_vector_type(4)));
typedef float f32x2v_t __attribute__((ext_vector_type(2))); typedef __bf16 bf16x2v_t __attribute__((ext_vector_type(2)));
__device__ __forceinline__ unsigned cvtpk(float lo, float hi) { f32x2v_t v = {lo, hi}; bf16x2v_t b = __builtin_convertvector(v, bf16x2v_t); return __builtin_bit_cast(unsigned, b); }
__device__ __forceinline__ v4i16_t lds_tr16(LAS unsigned char* p) { return __builtin_amdgcn_ds_read_tr16_b64_v4i16((LAS v4i16_t*)p); }

__device__ __forceinline__ void sb_phase(LAS unsigned char* wlds  , const bf16_t* SBQ, const bf16_t* SBK, const bf16_t* SBV, bf16_t* OSB, int gw, int ngw, int lane) {
    const int q = lane & 31, hi = lane >> 5;
    bf16x8_t Mf[2];
#pragma unroll
    for (int s = 0; s < 2; ++s)
#pragma unroll
        for (int j = 0; j < 8; ++j) { const int k = 16 * s + 8 * (j >> 2) + 4 * hi + (j & 3); Mf[s][j] = (k > q) ? (short)0x3F80 : (short)0; }
    const int vrow = lane >> 3, vch = lane & 7;
    const int g4 = lane >> 4, qq = (lane >> 2) & 3, p4 = lane & 3;
    LAS unsigned char* trb = wlds + (4 * (g4 >> 1) + qq) * 192 + ((g4 & 1) * 16 + 4 * p4) * 2;
    for (int item = gw; item < 32 * 256; item += ngw) {
        const int bh = item >> 8, qt = item & 255, b = bh >> 3, h = bh & 7;
        const size_t base = (size_t)b * SEQ;
        const bf16_t* Qp = SBQ + (base + qt * 32 + q) * 512 + h * 64 + 8 * hi;
        bf16x8_t Qf[4];
#pragma unroll
        for (int ks = 0; ks < 4; ++ks) Qf[ks] = *(const bf16x8_t*)(Qp + 16 * ks);
        f32x16_t o0 = {}, o1 = {};
        float carry = 0.f;
        bf16x8_t Kn[4]; v4u vn[4];
        {   const bf16_t* Kp = SBK + (base + qt * 32 + q) * 512 + h * 64 + 8 * hi;
#pragma unroll
            for (int ks = 0; ks < 4; ++ks) Kn[ks] = *(const bf16x8_t*)(Kp + 16 * ks);
#pragma unroll
            for (int i = 0; i < 4; ++i) vn[i] = *(const v4u*)(SBV + (base + qt * 32 + vrow + 8 * i) * 512 + h * 64 + vch * 8); }
        for (int kb = qt; kb >= 0; --kb) {
            bf16x8_t Kf[4]; v4u vv[4];
#pragma unroll
            for (int ks = 0; ks < 4; ++ks) Kf[ks] = Kn[ks];
#pragma unroll
            for (int i = 0; i < 4; ++i) vv[i] = vn[i];
            {   const int kn = kb > 0 ? kb - 1 : 0;
                const bf16_t* Kp = SBK + (base + kn * 32 + q) * 512 + h * 64 + 8 * hi;
#pragma unroll
                for (int ks = 0; ks < 4; ++ks) Kn[ks] = *(const bf16x8_t*)(Kp + 16 * ks);
#pragma unroll
                for (int i = 0; i < 4; ++i) vn[i] = *(const v4u*)(SBV + (base + kn * 32 + vrow + 8 * i) * 512 + h * 64 + vch * 8); }
            f32x16_t st = {};
#pragma unroll
            for (int ks = 0; ks < 4; ++ks) st = __builtin_amdgcn_mfma_f32_32x32x16_bf16(Kf[ks], Qf[ks], st, 0, 0, 0);
#pragma unroll
            for (int i = 0; i < 4; ++i) *(LAS v4u*)(wlds + (vrow + 8 * i) * 192 + vch * 16) = vv[i];
            const bool diag = (kb == qt);
            float z[16], lk[16];
#pragma unroll
            for (int r = 0; r < 16; ++r) {
                const int key = (r & 3) + 8 * (r >> 2) + 4 * hi;
                z[r] = st[r] * 0.125f;
                const float sp = fmaxf(z[r], 0.f) + __logf(1.f + __expf(-fabsf(z[r])));
                const bool valid = !diag || key < q;
                lk[r] = valid ? -sp : 0.f;
                z[r] = valid ? z[r] - sp : -INFINITY;
            }
            bf16x8_t lh[2], ll[2];
#pragma unroll
            for (int s = 0; s < 2; ++s) {
                unsigned wh[4], wl[4];
#pragma unroll
                for (int jj = 0; jj < 4; ++jj) { const float a = lk[8 * s + 2 * jj], c = lk[8 * s + 2 * jj + 1]; wh[jj] = cvtpk(a, c);
                    wl[jj] = cvtpk(a - __uint_as_float(wh[jj] << 16), c - __uint_as_float(wh[jj] & 0xffff0000u)); }
                lh[s] = __builtin_bit_cast(bf16x8_t, (v4u){wh[0], wh[1], wh[2], wh[3]}); ll[s] = __builtin_bit_cast(bf16x8_t, (v4u){wl[0], wl[1], wl[2], wl[3]});
            }
            f32x16_t af;
#pragma unroll
            for (int r = 0; r < 16; ++r) af[r] = carry;
            af = __builtin_amdgcn_mfma_f32_32x32x16_bf16(Mf[0], lh[0], af, 0, 0, 0);
            af = __builtin_amdgcn_mfma_f32_32x32x16_bf16(Mf[1], lh[1], af, 0, 0, 0);
            af = __builtin_amdgcn_mfma_f32_32x32x16_bf16(Mf[0], ll[0], af, 0, 0, 0);
            af = __builtin_amdgcn_mfma_f32_32x32x16_bf16(Mf[1], ll[1], af, 0, 0, 0);
            float tot = af[0] + lk[0];
            tot = __shfl(tot, q);
            float pr[16];
#pragma unroll
            for (int r = 0; r < 16; ++r) pr[r] = __expf(z[r] + af[r]);
            bf16x8_t pa[2];
#pragma unroll
            for (int s = 0; s < 2; ++s) pa[s] = __builtin_bit_cast(bf16x8_t, (v4u){cvtpk(pr[8 * s], pr[8 * s + 1]), cvtpk(pr[8 * s + 2], pr[8 * s + 3]), cvtpk(pr[8 * s + 4], pr[8 * s + 5]), cvtpk(pr[8 * s + 6], pr[8 * s + 7])});
            asm volatile("s_waitcnt lgkmcnt(0)" ::: "memory");
#pragma unroll
            for (int s = 0; s < 2; ++s) {
                const v4i16_t a0 = lds_tr16(trb + (16 * s) * 192), a1 = lds_tr16(trb + (16 * s + 8) * 192);
                const v4i16_t c0 = lds_tr16(trb + (16 * s) * 192 + 64), c1 = lds_tr16(trb + (16 * s + 8) * 192 + 64);
                const bf16x8_t vb0 = {a0[0], a0[1], a0[2], a0[3], a1[0], a1[1], a1[2], a1[3]}, vb1 = {c0[0], c0[1], c0[2], c0[3], c1[0], c1[1], c1[2], c1[3]};
                o0 = __builtin_amdgcn_mfma_f32_32x32x16_bf16(pa[s], vb0, o0, 0, 0, 0);
                o1 = __builtin_amdgcn_mfma_f32_32x32x16_bf16(pa[s], vb1, o1, 0, 0, 0);
            }
            carry = tot;
            if (__all(carry < -104.f)) break;
        }
        bf16_t* Op = OSB + (base + qt * 32) * 512 + h * 64 + q;
#pragma unroll
        for (int r = 0; r < 16; ++r) { const int row = (r & 3) + 8 * (r >> 2) + 4 * hi; Op[(size_t)row * 512] = f2bf(o0[r]); Op[(size_t)row * 512 + 32] = f2bf(o1[r]); }
    }
}
typedef float f32x4_t __attribute__((ext_vector_type(4)));
typedef unsigned v2u __attribute__((ext_vector_type(2)));
__device__ __forceinline__ float bflo(unsigned w) { return __uint_as_float(w << 16); }
__device__ __forceinline__ float bfhi(unsigned w) { return __uint_as_float(w & 0xffff0000u); }
__device__ __forceinline__ int frag_off(int r, int k0, int KS) { return (((r >> 4) * KS + (k0 >> 5)) << 9) + (((r & 15) + 16 * ((k0 & 15) >> 2)) << 3) + (((k0 & 31) >> 4) << 2); }

constexpr int GP_KS = 0, GP_QS = 17408, GP_VS = 34816, GP_AS = 52224, GP_WT = 69632, GP_GC = 87040, GP_BETA = 87296, GP_EGC = 87552, GP_CW = 88064, GP_TS = 94208;
constexpr int GROW = 136;

#define LDS_BARRIER() do { asm volatile("s_waitcnt lgkmcnt(0)" ::: "memory"); __builtin_amdgcn_s_barrier(); asm volatile("" ::: "memory"); } while (0)
struct GdnBufs { bf16_t *NW, *QD, *KDT, *QK, *UT; float* CD; bf16_t* ORAW; float* OSS; };

__device__ __forceinline__ void gdn_prep_phase(Frame& F, const Args& a, const bf16_t* GQKV, const float* GB, const float* GA, const GdnBufs& Gb) {
    LAS unsigned char* L = F.lds;
    LAS bf16_t* KS = (LAS bf16_t*)(L + GP_KS); LAS bf16_t* QS = (LAS bf16_t*)(L + GP_QS); LAS bf16_t* VS = (LAS bf16_t*)(L + GP_VS); LAS bf16_t* WT = (LAS bf16_t*)(L + GP_WT);
    LAS float* AS = (LAS float*)(L + GP_AS); LAS float* GC = (LAS float*)(L + GP_GC); LAS float* BETA = (LAS float*)(L + GP_BETA); LAS float* EGC = (LAS float*)(L + GP_EGC); LAS float* CW = (LAS float*)(L + GP_CW); LAS float* TS = (LAS float*)(L + GP_TS);
    const int tid = F.tid, lane = F.lane, wave = F.wave;
    const int per = (2048 + F.G - 1) / F.G;
    int hcur = -1;
    for (int ii = 0; ii < per; ++ii) {
        const int item = F.vcu * per + ii; if (item >= 2048) break;
        const int bh = item >> 7, n = item & 127, b = bh >> 2, h = bh & 3;
        const size_t t0 = (size_t)b * SEQ + n * 64;
        if (h != hcur) { hcur = h; for (int i = tid; i < 1536; i += NWAVES * 64) { const int j = i / 384, cc = i % 384; CW[i] = a.gdn_conv[j * 1536 + (cc >> 7) * 512 + h * 128 + (cc & 127)]; } }
        unsigned pf = 0u;
        if (ii + 1 < per && item + 1 < 2048 && tid < 384) {
            const int r = tid / 6, q6 = tid % 6; const int item2 = item + 1, bh2 = item2 >> 7, n2 = item2 & 127;
            pf = *(const unsigned*)(GQKV + ((size_t)(bh2 >> 2) * SEQ + n2 * 64 + r) * 1536 + (q6 >> 1) * 512 + (bh2 & 3) * 128 + (q6 & 1) * 64);
        }
        if (wave == 0) {
            const size_t t = t0 + lane;
            float g = -__expf(a.a_log[h]) * softplusf_(GA[t * 4 + h] + a.dt_bias[h]);
#pragma unroll
            for (int o = 1; o < 64; o <<= 1) { const float up = __shfl_up(g, o); if (lane >= o) g += up; }
            GC[lane] = g; BETA[lane] = sigmoidf_(GB[t * 4 + h]); EGC[lane] = __expf(g);
            if (lane == 63) Gb.CD[item] = __expf(g);
        }
        LDS_BARRIER();
        {
            const int c = tid >> 3, d0 = (tid & 7) * 16;
#pragma unroll
            for (int part = 0; part < 3; ++part) {
                float acc[16];
#pragma unroll
                for (int i = 0; i < 16; ++i) acc[i] = 0.f;
#pragma unroll
                for (int j = 0; j < 4; ++j) {
                    if (n * 64 + c - 3 + j >= 0) {
                        const bf16_t* src = GQKV + (t0 + c - 3 + j) * 1536 + part * 512 + h * 128 + d0;
                        const v4u r0 = *(const v4u*)src, r1 = *(const v4u*)(src + 8);
                        const unsigned rw[8] = {r0.x, r0.y, r0.z, r0.w, r1.x, r1.y, r1.z, r1.w};
                        const LAS float* cw = CW + j * 384 + part * 128 + d0;
#pragma unroll
                        for (int i = 0; i < 8; ++i) { acc[2 * i] += bflo(rw[i]) * cw[2 * i]; acc[2 * i + 1] += bfhi(rw[i]) * cw[2 * i + 1]; }
                    }
                }
                float ss = 0.f;
#pragma unroll
                for (int i = 0; i < 16; ++i) { acc[i] = acc[i] / (1.f + __expf(-acc[i])); ss += acc[i] * acc[i]; }
                if (part < 2) { ss += __shfl_xor(ss, 1); ss += __shfl_xor(ss, 2); ss += __shfl_xor(ss, 4); const float inv = rsqrtf(ss + EPS);
#pragma unroll
                    for (int i = 0; i < 16; ++i) acc[i] *= inv; }
                LAS bf16_t* dst = (part == 0 ? QS : part == 1 ? KS : VS) + c * GROW + d0;
                v4u w0, w1; w0.x = cvtpk(acc[0], acc[1]); w0.y = cvtpk(acc[2], acc[3]); w0.z = cvtpk(acc[4], acc[5]); w0.w = cvtpk(acc[6], acc[7]);
                w1.x = cvtpk(acc[8], acc[9]); w1.y = cvtpk(acc[10], acc[11]); w1.z = cvtpk(acc[12], acc[13]); w1.w = cvtpk(acc[14], acc[15]);
                *(LAS v4u*)dst = w0; *(LAS v4u*)(dst + 8) = w1;
            }
        }
        LDS_BARRIER();
        {
            const int fr = lane & 15, g = lane >> 4;
            for (int task = wave; task < 26; task += NWAVES) {
                const bool isKK = task < 10; int ct, mt;
                if (isKK) { ct = task >= 6 ? 3 : task >= 3 ? 2 : task >= 1 ? 1 : 0; mt = task - ct * (ct + 1) / 2; } else { ct = (task - 10) >> 2; mt = (task - 10) & 3; }
                f32x4_t acc = {0.f, 0.f, 0.f, 0.f};
                if (mt <= ct) {
                    const LAS bf16_t* Ap = KS + (mt * 16 + fr) * GROW + 8 * g; const LAS bf16_t* Bp = (isKK ? KS : QS) + (ct * 16 + fr) * GROW + 8 * g;
#pragma unroll
                    for (int ks = 0; ks < 4; ++ks) acc = __builtin_amdgcn_mfma_f32_16x16x32_bf16(*(const LAS bf16x8_t*)(Ap + 32 * ks), *(const LAS bf16x8_t*)(Bp + 32 * ks), acc, 0, 0, 0);
                }
                const int c = ct * 16 + fr, m0 = mt * 16 + 4 * g; const float gcc = GC[c];
                float v[4];
#pragma unroll
                for (int r = 0; r < 4; ++r) { const int m = m0 + r; const float dec = __expf(fminf(gcc - GC[m], 0.f)); v[r] = acc[r] * dec; }
                if (isKK) { const float bc = BETA[c];
                    f32x4_t o;
#pragma unroll
                    for (int r = 0; r < 4; ++r) o[r] = (c > m0 + r) ? v[r] * bc : 0.f;
                    *(LAS f32x4_t*)(AS + c * 68 + m0) = o;
                } else {
#pragma unroll
                    for (int r = 0; r < 4; ++r) v[r] = (c >= m0 + r) ? v[r] * 0.08838834764831845f : 0.f;
                    v2u w; w.x = cvtpk(v[0], v[1]); w.y = cvtpk(v[2], v[3]);
                    *(v2u*)(Gb.QK + (size_t)item * 4096 + (ct * 2 + (mt >> 1)) * 512 + lane * 8 + (mt & 1) * 4) = w;
                }
            }
        }
        LDS_BARRIER();
        if (wave == 0) {
            const int q4 = lane >> 4, c = lane & 15; const LAS float* Ab = AS + (16 * q4) * 68 + 16 * q4;
            float t[16];
#pragma unroll
            for (int r = 0; r < 16; ++r) { float s = (r == c) ? 1.f : 0.f;
#pragma unroll
                for (int j4 = 0; j4 < (r + 3) / 4; ++j4) { const f32x4_t av = *(const LAS f32x4_t*)(Ab + r * 68 + 4 * j4);
#pragma unroll
                    for (int i = 0; i < 4; ++i) if (4 * j4 + i < r) s -= av[i] * t[4 * j4 + i]; }
                t[r] = s; TS[(q4 * 16 + r) * 20 + c] = (r == c) ? 0.f : s; }
        }
        LDS_BARRIER();
        {
            const int fr = lane & 15, g = lane >> 4;
#pragma unroll
            for (int cc = 0; cc < 2; ++cc) {
                const int ct2 = wave * 2 + cc; const bool isW = ct2 >= 8; const int col = (ct2 & 7) * 16 + fr;
                const LAS bf16_t* src = (isW ? KS : VS) + col;
                unsigned xb[4][2];
#pragma unroll
                for (int i = 0; i < 4; ++i) {
                    f32x4_t y;
#pragma unroll
                    for (int r = 0; r < 4; ++r) { const int row = 16 * i + 4 * g + r; float v = bf2f(src[row * GROW]) * BETA[row]; if (isW) v *= EGC[row]; y[r] = v; }
#pragma unroll
                    for (int j = 0; j < i; j += 2) {
                        const LAS float* ap = AS + (16 * i + fr) * 68 + 16 * j + 4 * g;
                        const f32x4_t a0 = *(const LAS f32x4_t*)ap; f32x4_t a1 = {0.f, 0.f, 0.f, 0.f}; if (j + 1 < i) a1 = *(const LAS f32x4_t*)(ap + 16);
                        const bf16x8_t af = __builtin_bit_cast(bf16x8_t, (v4u){cvtpk(-a0[0], -a0[1]), cvtpk(-a0[2], -a0[3]), cvtpk(-a1[0], -a1[1]), cvtpk(-a1[2], -a1[3])});
                        const bf16x8_t bfr = __builtin_bit_cast(bf16x8_t, (v4u){xb[j][0], xb[j][1], (j + 1 < i) ? xb[j + 1][0] : 0u, (j + 1 < i) ? xb[j + 1][1] : 0u});
                        y = __builtin_amdgcn_mfma_f32_16x16x32_bf16(af, bfr, y, 0, 0, 0);
                    }
                    const f32x4_t tv = *(const LAS f32x4_t*)(TS + (i * 16 + fr) * 20 + 4 * g);
                    const bf16x8_t tf = __builtin_bit_cast(bf16x8_t, (v4u){cvtpk(tv[0], tv[1]), cvtpk(tv[2], tv[3]), 0u, 0u});
                    const bf16x8_t yf = __builtin_bit_cast(bf16x8_t, (v4u){cvtpk(y[0], y[1]), cvtpk(y[2], y[3]), 0u, 0u});
                    const f32x4_t x = __builtin_amdgcn_mfma_f32_16x16x32_bf16(tf, yf, y, 0, 0, 0);
                    xb[i][0] = cvtpk(x[0], x[1]); xb[i][1] = cvtpk(x[2], x[3]);
                    if (!isW) { *(v2u*)(Gb.UT + (size_t)item * 8192 + col * 64 + 16 * i + 4 * g) = (v2u){xb[i][0], xb[i][1]}; }
                    else {
#pragma unroll
                        for (int r = 0; r < 4; ++r) WT[(16 * i + 4 * g + r) * GROW + col] = f2bf(-x[r]); }
                }
            }
        }
        {
            const float glast = GC[63];
#pragma unroll
            for (int i = 0; i < 4; ++i) { const int p = tid + 512 * i, c = p >> 5, d0 = (p & 31) * 4; const v2u r = *(const LAS v2u*)(QS + c * GROW + d0); const float sc = EGC[c] * 0.08838834764831845f;
                v2u w; w.x = cvtpk(bflo(r.x) * sc, bfhi(r.x) * sc); w.y = cvtpk(bflo(r.y) * sc, bfhi(r.y) * sc);
                *(v2u*)(Gb.QD + (size_t)item * 8192 + frag_off(c, d0, 4)) = w; }
#pragma unroll
            for (int i = 0; i < 4; ++i) { const int p = tid + 512 * i, d = p >> 4, c0 = (p & 15) * 4; float v[4];
#pragma unroll
                for (int r = 0; r < 4; ++r) v[r] = bf2f(KS[(c0 + r) * GROW + d]) * __expf(glast - GC[c0 + r]);
                v2u w; w.x = cvtpk(v[0], v[1]); w.y = cvtpk(v[2], v[3]);
                *(v2u*)(Gb.KDT + (size_t)item * 8192 + frag_off(d, c0, 2)) = w; }
        }
        LDS_BARRIER();
#pragma unroll
        for (int i = 0; i < 4; ++i) { const int p = tid + 512 * i, c = p >> 5, d0 = (p & 31) * 4; const v2u r = *(const LAS v2u*)(WT + c * GROW + d0);
            *(v2u*)(Gb.NW + (size_t)item * 8192 + frag_off(c, d0, 4)) = r; }
        asm volatile("" :: "v"(pf));
        LDS_BARRIER();
    }
}

__device__ __forceinline__ void gdn_scan_unit(Frame& F, int s, const GdnBufs& Gb) {
    const int bh = s >> 2, half = s & 3, h = bh & 3, b = bh >> 2;
    const int tid = F.tid, lane = F.lane, wave = F.wave, fr = lane & 15, g = lane >> 4;
    LAS unsigned char* L = F.lds;
    const size_t tb = (size_t)b * SEQ;
    const int item0 = bh * 128;
    const int lt = tid - 256;
#define GDN_SRC(it, i) ((i) < 4 ? (const v4u*)(Gb.NW + (size_t)(it) * 8192) + lt + 256 * (i) : (i) < 8 ? (const v4u*)(Gb.QD + (size_t)(it) * 8192) + lt + 256 * ((i) - 4) : \
                        (i) < 12 ? (const v4u*)(Gb.KDT + (size_t)(it) * 8192) + lt + 256 * ((i) - 8) : (i) < 14 ? (const v4u*)(Gb.QK + (size_t)(it) * 4096) + lt + 256 * ((i) - 12) : \
                        (const v4u*)(Gb.UT + (size_t)(it) * 8192 + half * 2048) + lt + 256 * ((i) - 14))
#define GDN_LOADR(R, it) do { _Pragma("unroll") for (int i_ = 0; i_ < 15; ++i_) R[i_] = *GDN_SRC(it, i_); } while (0)
#define GDN_STORER(R, bufp) do { _Pragma("unroll") for (int i_ = 0; i_ < 15; ++i_) *(LAS v4u*)((bufp) + (i_ * 256 + lt) * 16) = R[i_]; } while (0)
    LAS float* CDL = (LAS float*)(L + 131072 + 1024);
    LAS bf16_t* OTB = (LAS bf16_t*)(L + 131072 + 2048);
#define GDN_OSTORE(step) do { if (wave < 6 && (step) < 128) { const LAS bf16_t* ot_ = OTB + ((wave - 4) * 2 + ((step) & 1)) * 1024; \
        const v4u o0_ = *(const LAS v4u*)(ot_ + lane * 16), o1_ = *(const LAS v4u*)(ot_ + lane * 16 + 8); \
        bf16_t* dst_ = Gb.ORAW + (tb + (size_t)(step) * 64 + lane) * 512 + h * 128 + half * 32 + (wave - 4) * 16; *(v4u*)dst_ = o0_; *(v4u*)(dst_ + 8) = o1_; } } while (0)
    if (wave >= 4) {
        if (wave == 4) { CDL[lane] = Gb.CD[item0 + lane]; CDL[64 + lane] = Gb.CD[item0 + 64 + lane]; }
        v4u r0[15], r1[15], r2[15];
        GDN_LOADR(r0, item0); GDN_LOADR(r1, item0 + 1); GDN_LOADR(r2, item0 + 2);
        GDN_STORER(r0, L);
        LDS_BARRIER();
#define GDN_CL(k) (item0 + ((k) < 127 ? (k) : 127))
        for (int n = 0; n < 129; n += 3) {
            GDN_LOADR(r0, GDN_CL(n + 3)); GDN_STORER(r1, L + ((n + 1) & 1) * 65536); LDS_BARRIER(); GDN_OSTORE(n);
            GDN_LOADR(r1, GDN_CL(n + 4)); GDN_STORER(r2, L + ((n + 2) & 1) * 65536); LDS_BARRIER(); GDN_OSTORE(n + 1);
            GDN_LOADR(r2, GDN_CL(n + 5)); GDN_STORER(r0, L + ((n + 3) & 1) * 65536); LDS_BARRIER(); GDN_OSTORE(n + 2);
        }
#undef GDN_CL
    } else if (wave >= 2) {
        for (int n = 0; n < 130; ++n) LDS_BARRIER();
    } else {
        LDS_BARRIER();
        f32x4_t S[8];
#pragma unroll
        for (int i = 0; i < 8; ++i) S[i] = (f32x4_t){0.f, 0.f, 0.f, 0.f};
        for (int n = 0; n < 128; ++n) {
            LAS unsigned char* B = L + (n & 1) * 65536;
            const float cd = CDL[n];
            bf16x8_t sb[4];
#pragma unroll
            for (int ks = 0; ks < 4; ++ks) sb[ks] = __builtin_bit_cast(bf16x8_t, (v4u){cvtpk(S[2 * ks][0], S[2 * ks][1]), cvtpk(S[2 * ks][2], S[2 * ks][3]), cvtpk(S[2 * ks + 1][0], S[2 * ks + 1][1]), cvtpk(S[2 * ks + 1][2], S[2 * ks + 1][3])});
#define GDN_SB() __builtin_amdgcn_sched_barrier(0)
            const LAS unsigned char* Bl = B + lane * 16;
            v2u u8[4]; bf16x8_t fa[16], fb[16];
#pragma unroll
            for (int rt = 0; rt < 4; ++rt) u8[rt] = *(const LAS v2u*)(B + 57344 + ((wave * 16 + fr) * 64 + 16 * rt + 4 * g) * 2);
#pragma unroll
            for (int i = 0; i < 16; ++i) fa[i] = *(const LAS bf16x8_t*)(Bl + ((i & 3) * 4 + (i >> 2)) * 1024);
            GDN_SB();
#pragma unroll
            for (int i = 0; i < 16; ++i) fb[i] = *(const LAS bf16x8_t*)(Bl + 16384 + ((i & 3) * 4 + (i >> 2)) * 1024);
            GDN_SB();
            f32x4_t va[4], oa[4];
#pragma unroll
            for (int rt = 0; rt < 4; ++rt) { va[rt] = (f32x4_t){bflo(u8[rt].x), bfhi(u8[rt].x), bflo(u8[rt].y), bfhi(u8[rt].y)}; oa[rt] = (f32x4_t){0.f, 0.f, 0.f, 0.f}; }
#pragma unroll
            for (int i = 0; i < 16; ++i) va[i & 3] = __builtin_amdgcn_mfma_f32_16x16x32_bf16(fa[i], sb[i >> 2], va[i & 3], 0, 0, 0);
            GDN_SB();
#pragma unroll
            for (int i = 0; i < 8; ++i) fa[i] = *(const LAS bf16x8_t*)(Bl + 49152 + ((i & 3) * 2 + (i >> 2)) * 1024);
#pragma unroll
            for (int i = 0; i < 8; ++i) fa[8 + i] = *(const LAS bf16x8_t*)(Bl + 32768 + ((i & 3) * 2 + (i >> 2)) * 1024);
            GDN_SB();
#pragma unroll
            for (int i = 0; i < 16; ++i) oa[i & 3] = __builtin_amdgcn_mfma_f32_16x16x32_bf16(fb[i], sb[i >> 2], oa[i & 3], 0, 0, 0);
            bf16x8_t vb[2];
#pragma unroll
            for (int k2 = 0; k2 < 2; ++k2) vb[k2] = __builtin_bit_cast(bf16x8_t, (v4u){cvtpk(va[2 * k2][0], va[2 * k2][1]), cvtpk(va[2 * k2][2], va[2 * k2][3]), cvtpk(va[2 * k2 + 1][0], va[2 * k2 + 1][1]), cvtpk(va[2 * k2 + 1][2], va[2 * k2 + 1][3])});
#pragma unroll
            for (int dt = 0; dt < 8; ++dt) S[dt] = S[dt] * cd;
            GDN_SB();
#pragma unroll
            for (int i = 0; i < 8; ++i) fb[i] = *(const LAS bf16x8_t*)(Bl + 32768 + 8192 + ((i & 3) * 2 + (i >> 2)) * 1024);
            GDN_SB();
#pragma unroll
            for (int i = 0; i < 8; ++i) oa[i & 3] = __builtin_amdgcn_mfma_f32_16x16x32_bf16(fa[i], vb[i >> 2], oa[i & 3], 0, 0, 0);
#pragma unroll
            for (int i = 0; i < 8; ++i) S[i & 3] = __builtin_amdgcn_mfma_f32_16x16x32_bf16(fa[8 + i], vb[i >> 2], S[i & 3], 0, 0, 0);
            GDN_SB();
#pragma unroll
            for (int i = 0; i < 8; ++i) S[4 + (i & 3)] = __builtin_amdgcn_mfma_f32_16x16x32_bf16(fb[i], vb[i >> 2], S[4 + (i & 3)], 0, 0, 0);
            GDN_SB();
#undef GDN_SB
            { LAS bf16_t* OT = OTB + (wave * 2 + (n & 1)) * 1024;
#pragma unroll
              for (int rt = 0; rt < 4; ++rt)
#pragma unroll
                for (int r = 0; r < 4; ++r) OT[(16 * rt + 4 * g + r) * 16 + fr] = f2bf(oa[rt][r]); }
            LDS_BARRIER();
        }
        LDS_BARRIER();
    }
#undef GDN_SRC
#undef GDN_LOADR
#undef GDN_OSTORE
#undef GDN_STORER
}

__device__ __forceinline__ void gdn_finish_phase(Frame& F, const Args& a, const GdnBufs& Gb, const bf16_t* GZ, bf16_t* OG) {
    const int gt = F.vcu * NWAVES * 64 + F.tid, ngt = F.G * NWAVES * 64;
    for (int p = gt; p < T * 64; p += ngt) {
        const size_t t = (size_t)(p >> 6); const int col = (p & 63) * 8, e0 = col & 127;
        const v4u o = *(const v4u*)(Gb.ORAW + t * 512 + col), z = *(const v4u*)(GZ + t * 512 + col);
        const unsigned ow[4] = {o.x, o.y, o.z, o.w}, zw[4] = {z.x, z.y, z.z, z.w};
        float ss = 0.f;
#pragma unroll
        for (int i = 0; i < 4; ++i) { const float a0 = bflo(ow[i]), a1 = bfhi(ow[i]); ss += a0 * a0 + a1 * a1; }
        ss += __shfl_xor(ss, 1); ss += __shfl_xor(ss, 2); ss += __shfl_xor(ss, 4); ss += __shfl_xor(ss, 8);
        const float rinv = rsqrtf(ss * (1.f / 128.f) + EPS);
        const f32x4_t g0 = *(const f32x4_t*)(a.gdn_norm_g + e0), g1 = *(const f32x4_t*)(a.gdn_norm_g + e0 + 4);
        const float gg[8] = {g0[0], g0[1], g0[2], g0[3], g1[0], g1[1], g1[2], g1[3]};
        unsigned r[4];
#pragma unroll
        for (int i = 0; i < 4; ++i) { const float z0 = bflo(zw[i]), z1 = bfhi(zw[i]);
            r[i] = cvtpk(bflo(ow[i]) * rinv * gg[2 * i] * (z0 / (1.f + __expf(-z0))), bfhi(ow[i]) * rinv * gg[2 * i + 1] * (z1 / (1.f + __expf(-z1)))); }
        *(v4u*)(OG + t * 512 + col) = (v4u){r[0], r[1], r[2], r[3]};
    }
}
typedef float f32x2_t __attribute__((ext_vector_type(2)));
__device__ __forceinline__ float gelu_erf(float v) { return 0.5f * v * (1.f + erff(v * 0.70710678118654752f)); }
constexpr int PEER_CH = 16;
constexpr int CW_PEERU = 8192, CW_PEERV = 8192 + 1024;

typedef int v2i_t __attribute__((ext_vector_type(2)));
#define PEER_SWZ(V, JP) __builtin_amdgcn_ds_swizzle((V), 0x18 | ((JP) << 5))
#define PEER_SHUF(EN, ER) do { EN[0] = PEER_SWZ(ER.x, 0); EN[1] = PEER_SWZ(ER.y, 0); EN[2] = PEER_SWZ(ER.x, 1); EN[3] = PEER_SWZ(ER.y, 1); EN[4] = PEER_SWZ(ER.x, 2); EN[5] = PEER_SWZ(ER.y, 2); EN[6] = PEER_SWZ(ER.x, 3); EN[7] = PEER_SWZ(ER.y, 3); EN[8] = PEER_SWZ(ER.x, 4); EN[9] = PEER_SWZ(ER.y, 4); EN[10] = PEER_SWZ(ER.x, 5); EN[11] = PEER_SWZ(ER.y, 5); EN[12] = PEER_SWZ(ER.x, 6); EN[13] = PEER_SWZ(ER.y, 6); EN[14] = PEER_SWZ(ER.x, 7); EN[15] = PEER_SWZ(ER.y, 7); } while (0)
#define PEER_LDIDX(TOK) (*(const v2i_t*)(EIDX + (size_t)(TOK) * 128 + 2 * lane))
template <int CTRL> __device__ __forceinline__ int dpp_i(int v) { return __builtin_amdgcn_update_dpp(0, v, CTRL, 0xf, 0xf, false); }
template <int CTRL> __device__ __forceinline__ float dpp_f(float v) { return __builtin_bit_cast(float, __builtin_amdgcn_update_dpp(0, __builtin_bit_cast(int, v), CTRL, 0xf, 0xf, false)); }
constexpr int DPP_X1 = 0xB1, DPP_X2 = 0x4E, DPP_HM = 0x141;
#define PEER_U_COMPUTE(W, TOK, XR, RS) do { const size_t t_ = (TOK); \
        float xf[32]; \
        _Pragma("unroll") for (int q = 0; q < 4; ++q) { const unsigned xw_[4] = {XR[q].x, XR[q].y, XR[q].z, XR[q].w}; \
            _Pragma("unroll") for (int c = 0; c < 4; ++c) { xf[8 * q + 2 * c] = bflo(xw_[c]); xf[8 * q + 2 * c + 1] = bfhi(xw_[c]); } } \
        float am = 0.f; \
        _Pragma("unroll") for (int q = 0; q < 32; q += 2) am = fmaxf(am, fmaxf(fabsf(xf[q]), fabsf(xf[q + 1]))); \
        am = fmaxf(am, dpp_f<DPP_X1>(am)); am = fmaxf(am, dpp_f<DPP_X2>(am)); am = fmaxf(am, dpp_f<DPP_HM>(am)); \
        const float sx = am > 0.f ? 127.f * __builtin_amdgcn_rcpf(am) : 0.f, mo = am * (1.f / (127.f * 16.f)) * (RS); \
        int xq[8]; \
        _Pragma("unroll") for (int d = 0; d < 8; ++d) { \
            const unsigned b0 = __builtin_bit_cast(unsigned, fmaf(xf[4 * d], sx, 12582912.f)), b1 = __builtin_bit_cast(unsigned, fmaf(xf[4 * d + 1], sx, 12582912.f)); \
            const unsigned b2 = __builtin_bit_cast(unsigned, fmaf(xf[4 * d + 2], sx, 12582912.f)), b3 = __builtin_bit_cast(unsigned, fmaf(xf[4 * d + 3], sx, 12582912.f)); \
            xq[d] = (int)(__builtin_amdgcn_perm(b1, b0, 0x0c0c0400u) | __builtin_amdgcn_perm(b3, b2, 0x04000c0cu)); } \
        int sl_ = __builtin_amdgcn_sdot4(0x01010101, xq[0], 0, false); sl_ = __builtin_amdgcn_sdot4(0x01010101, xq[2], sl_, false); sl_ = __builtin_amdgcn_sdot4(0x01010101, xq[4], sl_, false); sl_ = __builtin_amdgcn_sdot4(0x01010101, xq[6], sl_, false); \
        const int c0_ = -8 * sl_; \
        int p[16]; \
        _Pragma("unroll") for (int i = 0; i < 16; ++i) { const unsigned ww[4] = {W[i].x, W[i].y, W[i].z, W[i].w}; int ah = 0, al = c0_; \
            _Pragma("unroll") for (int d = 0; d < 4; ++d) { ah = __builtin_amdgcn_sdot4((int)(ww[d] & 0xF0F0F0F0u), xq[2 * d + 1], ah, false); al = __builtin_amdgcn_sdot4((int)(ww[d] & 0x0F0F0F0Fu), xq[2 * d], al, false); } \
            p[i] = ah + 16 * al; } \
        _Pragma("unroll") for (int i = 0; i < 8; ++i) { const int lo = p[i], hi = p[i + 8]; p[i] = (up4 ? hi : lo) + dpp_i<DPP_HM>(up4 ? lo : hi); } \
        _Pragma("unroll") for (int i = 0; i < 4; ++i) { const int lo = p[i], hi = p[i + 4]; p[i] = (up2 ? hi : lo) + dpp_i<DPP_X2>(up2 ? lo : hi); } \
        _Pragma("unroll") for (int i = 0; i < 2; ++i) { const int lo = p[i], hi = p[i + 2]; p[i] = (up1 ? hi : lo) + dpp_i<DPP_X1>(up1 ? lo : hi); } \
        *(unsigned*)(PART + ((size_t)x * T + t_) * 128 + 2 * lane) = cvtpk((float)p[0] * mo, (float)p[1] * mo); } while (0)
#define PEER_LDX(XR, TOK) do { const v4u* xp_ = (const v4u*)(Xx + (size_t)(TOK) * 1024); XR[0] = xp_[0]; XR[1] = xp_[1]; XR[2] = xp_[2]; XR[3] = xp_[3]; } while (0)
#define PEER_GATHER(W, EN, BASE) do { _Pragma("unroll") for (int i = 0; i < 16; ++i) W[i] = *(const v4u*)((BASE) + (unsigned)((unsigned)EN[i] * 128u + lo16)); } while (0)
__device__ __forceinline__ void peer_u_phase(Frame& F, const Args& a, gu32* ctl, const bf16_t* X2B, const float* rstd2, const int* EIDX, const unsigned char* U8, bf16_t* PART) {
    const int lane = F.lane, j = lane & 7; const unsigned lo16 = 16u * (unsigned)j;
    const bool up4 = (j & 4) != 0, up2 = (j & 2) != 0, up1 = (j & 1) != 0;
    const int x0 = (int)(xb_xcc_id() & 7u);
    for (int s = 0; s < 4; ++s) {
        const int x = (x0 + s) & 3;
        const unsigned char* Ux = U8 + (size_t)x * 16384 * 128;
        const bf16_t* Xx = X2B + 256 * x + 32 * j;
        for (;;) {
            int c = 0; if (lane == 0) c = (int)__hip_atomic_fetch_add(ctl + CW_PEERU + 64 * x, 1u, __ATOMIC_RELAXED, __HIP_MEMORY_SCOPE_AGENT);
            c = __builtin_amdgcn_readfirstlane(c);
            if (c >= T / PEER_CH) break;
            const size_t tc = (size_t)c * PEER_CH, tl = tc + PEER_CH - 1;
            int en[16]; v4u wa[16], wb[16], xa[4], xb[4];
            v2i_t er = PEER_LDIDX(tc);
            PEER_LDX(xa, tc); float rsa = rstd2[tc], rsb;
            PEER_SHUF(en, er);
            PEER_GATHER(wa, en, Ux);
            er = PEER_LDIDX(tc + 1);
            for (int tt = 0; tt < PEER_CH; tt += 2) {
                const size_t t = tc + tt, t2 = (t + 2 < tl) ? t + 2 : tl, t3 = (t + 3 < tl) ? t + 3 : tl;
                PEER_SHUF(en, er);
                PEER_GATHER(wb, en, Ux);
                er = PEER_LDIDX(t2);
                PEER_LDX(xb, t + 1); rsb = rstd2[t + 1];
                PEER_U_COMPUTE(wa, t, xa, rsa);
                PEER_SHUF(en, er);
                PEER_GATHER(wa, en, Ux);
                er = PEER_LDIDX(t3);
                PEER_LDX(xa, t2); rsa = rstd2[t2];
                PEER_U_COMPUTE(wb, t + 1, xb, rsb);
            }
        }
    }
}
__device__ __forceinline__ void peer_combine_phase(Frame& F, const bf16_t* PART, const int* EIDX, const float* EGATE, const float* SU, const float* SV, float* ACTS) {
    const int gt = F.vcu * NWAVES * 64 + F.tid, ngt = F.G * NWAVES * 64;
    for (int p = gt; p < T * 32; p += ngt) {
        f32x4_t s = {0.f, 0.f, 0.f, 0.f};
#pragma unroll
        for (int x = 0; x < 4; ++x) { const v2u w = *(const v2u*)(PART + (size_t)x * T * 128 + (size_t)p * 4); s += (f32x4_t){bflo(w.x), bfhi(w.x), bflo(w.y), bfhi(w.y)}; }
        const int4 e = *(const int4*)(EIDX + (size_t)p * 4); const f32x4_t gt4 = *(const f32x4_t*)(EGATE + (size_t)p * 4);
        *(f32x4_t*)(ACTS + (size_t)p * 4) = (f32x4_t){gelu_erf(s[0] * SU[e.x]) * gt4[0] * SV[e.x], gelu_erf(s[1] * SU[e.y]) * gt4[1] * SV[e.y], gelu_erf(s[2] * SU[e.z]) * gt4[2] * SV[e.z], gelu_erf(s[3] * SU[e.w]) * gt4[3] * SV[e.w]};
    }
}
template <int K> __device__ __forceinline__ f32x2_t cvt_fp4x2(unsigned w) { return __builtin_amdgcn_cvt_scalef32_pk_f32_fp4(w, 1.0f, K); }
__device__ __forceinline__ float wave_sum_dpp(float v) {
    v += dpp_f<DPP_X1>(v); v += dpp_f<DPP_X2>(v); v += dpp_f<DPP_HM>(v); v += dpp_f<0x140>(v);
    const int b = __builtin_bit_cast(int, v);
    return (__builtin_bit_cast(float, __builtin_amdgcn_readlane(b, 0)) + __builtin_bit_cast(float, __builtin_amdgcn_readlane(b, 16))) + (__builtin_bit_cast(float, __builtin_amdgcn_readlane(b, 32)) + __builtin_bit_cast(float, __builtin_amdgcn_readlane(b, 48)));
}
#define PEER_V_COMPUTE(W, TOK, A0R, XWR) do { const size_t t_ = (TOK); float av[16]; \
        const float axf_ = (A0R).x, ayf_ = (A0R).y; const int ax_ = __builtin_bit_cast(int, axf_), ay_ = __builtin_bit_cast(int, ayf_); av[0] = __builtin_bit_cast(float, PEER_SWZ(ax_, 0)); av[1] = __builtin_bit_cast(float, PEER_SWZ(ay_, 0)); av[2] = __builtin_bit_cast(float, PEER_SWZ(ax_, 1)); av[3] = __builtin_bit_cast(float, PEER_SWZ(ay_, 1)); av[4] = __builtin_bit_cast(float, PEER_SWZ(ax_, 2)); av[5] = __builtin_bit_cast(float, PEER_SWZ(ay_, 2)); av[6] = __builtin_bit_cast(float, PEER_SWZ(ax_, 3)); av[7] = __builtin_bit_cast(float, PEER_SWZ(ay_, 3)); av[8] = __builtin_bit_cast(float, PEER_SWZ(ax_, 4)); av[9] = __builtin_bit_cast(float, PEER_SWZ(ay_, 4)); av[10] = __builtin_bit_cast(float, PEER_SWZ(ax_, 5)); av[11] = __builtin_bit_cast(float, PEER_SWZ(ay_, 5)); av[12] = __builtin_bit_cast(float, PEER_SWZ(ax_, 6)); av[13] = __builtin_bit_cast(float, PEER_SWZ(ay_, 6)); av[14] = __builtin_bit_cast(float, PEER_SWZ(ax_, 7)); av[15] = __builtin_bit_cast(float, PEER_SWZ(ay_, 7)); \
        const size_t oo_ = t_ * 1024 + 256 * x + 4 * lane; const v2u xw_ = (XWR); \
        f32x2_t o2[16]; _Pragma("unroll") for (int q = 0; q < 16; ++q) o2[q] = (f32x2_t){0.f, 0.f}; \
        _Pragma("unroll") for (int i = 0; i < 16; ++i) { const unsigned ww[4] = {W[i].x, W[i].y, W[i].z, W[i].w}; const f32x2_t a2 = {av[i], av[i]}; \
            _Pragma("unroll") for (int q = 0; q < 4; ++q) { o2[4 * q] = __builtin_elementwise_fma(cvt_fp4x2<0>(ww[q]), a2, o2[4 * q]); o2[4 * q + 1] = __builtin_elementwise_fma(cvt_fp4x2<1>(ww[q]), a2, o2[4 * q + 1]); \
                o2[4 * q + 2] = __builtin_elementwise_fma(cvt_fp4x2<2>(ww[q]), a2, o2[4 * q + 2]); o2[4 * q + 3] = __builtin_elementwise_fma(cvt_fp4x2<3>(ww[q]), a2, o2[4 * q + 3]); } } \
        float o[32]; _Pragma("unroll") for (int q = 0; q < 16; ++q) { o[2 * q] = o2[q].x; o[2 * q + 1] = o2[q].y; } \
        _Pragma("unroll") for (int i = 0; i < 16; ++i) { const v2u r_ = __builtin_amdgcn_permlane32_swap(__builtin_bit_cast(unsigned, o[i]), __builtin_bit_cast(unsigned, o[i + 16]), false, false); { const unsigned r0_ = r_.x, r1_ = r_.y; o[i] = __builtin_bit_cast(float, r0_) + __builtin_bit_cast(float, r1_); } } \
        _Pragma("unroll") for (int i = 0; i < 8; ++i) { const v2u r_ = __builtin_amdgcn_permlane16_swap(__builtin_bit_cast(unsigned, o[i]), __builtin_bit_cast(unsigned, o[i + 8]), false, false); { const unsigned r0_ = r_.x, r1_ = r_.y; o[i] = __builtin_bit_cast(float, r0_) + __builtin_bit_cast(float, r1_); } } \
        _Pragma("unroll") for (int i = 0; i < 4; ++i) { const float lo = o[i], hi = o[i + 4]; o[i] = (upg ? hi : lo) + dpp_f<0x128>(upg ? lo : hi); } \
        v2u rw_; rw_.x = cvtpk(bflo(xw_.x) + o[0], bfhi(xw_.x) + o[1]); rw_.y = cvtpk(bflo(xw_.y) + o[2], bfhi(xw_.y) + o[3]); *(v2u*)(X3B + oo_) = rw_; \
        const float r0 = bflo(rw_.x), r1 = bfhi(rw_.x), r2 = bflo(rw_.y), r3 = bfhi(rw_.y); \
        const float ss = wave_sum_dpp((r0 * r0 + r1 * r1) + (r2 * r2 + r3 * r3)); if (lane == 0) SS3[t_ * 4 + x] = ss; } while (0)
__device__ __forceinline__ void peer_v_phase(Frame& F, gu32* ctl, const int* EIDX, const float* ACTS, const unsigned char* V8, const bf16_t* X2B, bf16_t* X3B, float* SS3) {
    const int lane = F.lane, g = lane >> 3, j = lane & 7; const unsigned lo16 = 16u * (unsigned)j; const bool upg = (g & 1) != 0;
    const int x0 = (int)(xb_xcc_id() & 7u);
    for (int s = 0; s < 4; ++s) {
        const int x = (x0 + s) & 3;
        const unsigned char* Vx = V8 + (size_t)x * 16384 * 128;
        const bf16_t* Xx = X2B + 256 * x + 4 * lane;
        for (;;) {
            int c = 0; if (lane == 0) c = (int)__hip_atomic_fetch_add(ctl + CW_PEERV + 64 * x, 1u, __ATOMIC_RELAXED, __HIP_MEMORY_SCOPE_AGENT);
            c = __builtin_amdgcn_readfirstlane(c);
            if (c >= T / PEER_CH) break;
            const size_t tc = (size_t)c * PEER_CH, tl = tc + PEER_CH - 1;
            int en[16]; v4u wa[16], wb[16];
            v2i_t er = PEER_LDIDX(tc);
            f32x2_t aa = *(const f32x2_t*)(ACTS + tc * 128 + 2 * lane), ab; v2u xwa = *(const v2u*)(Xx + tc * 1024), xwb;
            PEER_SHUF(en, er);
            PEER_GATHER(wa, en, Vx);
            er = PEER_LDIDX(tc + 1);
            for (int tt = 0; tt < PEER_CH; tt += 2) {
                const size_t t = tc + tt, t2 = (t + 2 < tl) ? t + 2 : tl, t3 = (t + 3 < tl) ? t + 3 : tl;
                PEER_SHUF(en, er);
                PEER_GATHER(wb, en, Vx);
                er = PEER_LDIDX(t2);
                ab = *(const f32x2_t*)(ACTS + (t + 1) * 128 + 2 * lane); xwb = *(const v2u*)(Xx + (t + 1) * 1024);
                PEER_V_COMPUTE(wa, t, aa, xwa);
                PEER_SHUF(en, er);
                PEER_GATHER(wa, en, Vx);
                er = PEER_LDIDX(t3);
                aa = *(const f32x2_t*)(ACTS + t2 * 128 + 2 * lane); xwa = *(const v2u*)(Xx + t2 * 1024);
                PEER_V_COMPUTE(wb, t + 1, ab, xwb);
            }
        }
    }
}
__device__ __forceinline__ void peer_norm_phase(Frame& F, const Args& a, const float* SS3, const bf16_t* X3B, float* out) {
    const int gt = F.vcu * NWAVES * 64 + F.tid, ngt = F.G * NWAVES * 64;
    for (int p = gt; p < T * 128; p += ngt) {
        const size_t t = (size_t)(p >> 7); const int c = (p & 127) * 8;
        const f32x4_t s0 = *(const f32x4_t*)(SS3 + t * 4);
        const float r3 = rsqrtf(((s0[0] + s0[1]) + (s0[2] + s0[3])) * (1.f / D) + EPS);
        const v4u w = *(const v4u*)(X3B + t * 1024 + c);
        const f32x4_t g0 = *(const f32x4_t*)(a.g_final + c), g1 = *(const f32x4_t*)(a.g_final + c + 4);
        *(f32x4_t*)(out + t * 1024 + c) = (f32x4_t){bflo(w.x), bfhi(w.x), bflo(w.y), bfhi(w.y)} * g0 * r3;
        *(f32x4_t*)(out + t * 1024 + c + 4) = (f32x4_t){bflo(w.z), bfhi(w.z), bflo(w.w), bfhi(w.w)} * g1 * r3;
    }
}
#ifndef TOPK_HD
#define TOPK_HD __device__ __forceinline__
#endif
TOPK_HD void ce_desc(unsigned& a, unsigned& b) { const unsigned hi = a > b ? a : b, lo = a > b ? b : a; a = hi; b = lo; }
TOPK_HD void sort16_desc(unsigned (&v)[16]) {
#pragma unroll
    for (int k = 2; k <= 16; k <<= 1)
#pragma unroll
        for (int j = k >> 1; j >= 1; j >>= 1)
#pragma unroll
            for (int i = 0; i < 16; ++i) { const int l = i ^ j; if (l > i) { if ((i & k) == 0) ce_desc(v[i], v[l]); else ce_desc(v[l], v[i]); } }
}
TOPK_HD void bitonic_merge16_desc(unsigned (&v)[16]) {
#pragma unroll
    for (int j = 8; j >= 1; j >>= 1)
#pragma unroll
        for (int i = 0; i < 16; ++i) { const int l = i ^ j; if (l > i) ce_desc(v[i], v[l]); }
}
TOPK_HD void top16_merge(unsigned (&a)[16], const unsigned (&b)[16]) {
#pragma unroll
    for (int i = 0; i < 16; ++i) a[i] = a[i] > b[15 - i] ? a[i] : b[15 - i];
    bitonic_merge16_desc(a);
}
TOPK_HD unsigned f2ord(float f) { const unsigned u = __builtin_bit_cast(unsigned, f); return (u & 0x80000000u) ? ~u : (u | 0x80000000u); }
TOPK_HD float ord2f(unsigned o) { const unsigned u = (o & 0x80000000u) ? (o & 0x7fffffffu) : ~o; return __builtin_bit_cast(float, u); }

__device__ __forceinline__ void peer_route_task(Frame& F, const bf16_t* PQ, const bf16_t* SK16, int* EIDX, float* EGATE, int tt, int h) {
    constexpr int CI[50] = {0,0,0,0,0,0,0,0,0,0,0,0,0,0,0,0,1,1,1,1,1,1,1,1,2,2,2,2,2,3,3,3,3,4,4,4,5,5,6,6,7,7,8,9,10,11,12,13,14,15};
    constexpr int CJ[50] = {0,1,2,3,4,5,6,7,8,9,10,11,12,13,14,15,0,1,2,3,4,5,6,7,0,1,2,3,4,0,1,2,3,0,1,2,0,1,0,1,0,1,0,0,0,0,0,0,0,0};
    int lane = F.lane; asm volatile("" : "+v"(lane));
    const int t = lane & 31, hi = lane >> 5;
    LAS unsigned* wl = (LAS unsigned*)(F.lds + 65536 + F.wave * 8192) + lane;
    {
        const size_t row = (size_t)tt * 32 + t;
        unsigned L[2][16];
#pragma unroll
        for (int p = 0; p < 2; ++p) {
            const int hp = h * 2 + p;
            bf16x8_t Bf[8];
#pragma unroll
            for (int ks = 0; ks < 8; ++ks) Bf[ks] = *(const bf16x8_t*)(PQ + row * 2048 + hp * 128 + 16 * ks + 8 * hi);
#pragma unroll
            for (int i = 0; i < 16; ++i) L[p][i] = 0u;
#pragma unroll 1
            for (int nt = 0; nt < 4; ++nt) {
                const int srow = p * 128 + 32 * nt + t;
                bf16x8_t Ac[8];
#pragma unroll
                for (int ks = 0; ks < 8; ++ks) Ac[ks] = *(const LAS bf16x8_t*)(F.lds + srow * 256 + (((2 * ks + hi) ^ (srow & 15)) << 4));
                f32x16_t acc = {};
#pragma unroll
                for (int ks = 0; ks < 8; ++ks) acc = __builtin_amdgcn_mfma_f32_32x32x16_bf16(Ac[ks], Bf[ks], acc, 0, 0, 0);
                unsigned k[16];
#pragma unroll
                for (int r = 0; r < 16; ++r) { const int n = 32 * nt + (r & 3) + 8 * (r >> 2) + 4 * hi; k[r] = (f2ord(acc[r]) & ~127u) | (unsigned)(127 - n); }
                sort16_desc(k);
                top16_merge(L[p], k);
            }
            unsigned pb[16];
#pragma unroll
            for (int i = 0; i < 16; ++i) pb[i] = __shfl_xor(L[p][i], 32);
            top16_merge(L[p], pb);
        }
        float sa[16], sb[16];
#pragma unroll
        for (int i = 0; i < 16; ++i) { sa[i] = ord2f(L[0][i] & ~127u); sb[i] = ord2f(L[1][i] & ~127u); wl[i * 64] = 127u - (L[0][i] & 127u); wl[(16 + i) * 64] = 127u - (L[1][i] & 127u); }
        unsigned c0[16], c1[16];
#pragma unroll
        for (int s = 0; s < 32; ++s) {
            unsigned key = 0u;
            if (s < 25) { const float v = hi ? sa[CI[25 + s]] + sb[CJ[25 + s]] : sa[CI[s]] + sb[CJ[s]]; const int pos = hi ? CI[25 + s] * 16 + CJ[25 + s] : CI[s] * 16 + CJ[s];
                key = (f2ord(v) & ~255u) | (unsigned)(255 - pos); }
            if (s < 16) c0[s] = key; else c1[s - 16] = key;
        }
        sort16_desc(c0); sort16_desc(c1); top16_merge(c0, c1);
        unsigned pb[16];
#pragma unroll
        for (int i = 0; i < 16; ++i) pb[i] = __shfl_xor(c0[i], 32);
        top16_merge(c0, pb);
        float e[16]; const float m = ord2f(c0[0] & ~255u); float l = 0.f;
#pragma unroll
        for (int r = 0; r < 16; ++r) { e[r] = __expf(ord2f(c0[r] & ~255u) - m); l += e[r]; }
        const float il = 1.f / l;
        int ex[8]; float gt[8];
#pragma unroll
        for (int q = 0; q < 8; ++q) { const unsigned kk = hi ? c0[8 + q] : c0[q]; const int pos = 255 - (int)(kk & 255u); ex[q] = (int)(wl[(pos >> 4) * 64] * 128u + wl[(16 + (pos & 15)) * 64]); gt[q] = (hi ? e[8 + q] : e[q]) * il; }
        int* ep = EIDX + row * 128 + h * 16 + hi * 8; float* gp = EGATE + row * 128 + h * 16 + hi * 8;
        *(int4*)ep = make_int4(ex[0], ex[1], ex[2], ex[3]); *(int4*)(ep + 4) = make_int4(ex[4], ex[5], ex[6], ex[7]);
        *(f32x4_t*)gp = (f32x4_t){gt[0], gt[1], gt[2], gt[3]}; *(f32x4_t*)(gp + 4) = (f32x4_t){gt[4], gt[5], gt[6], gt[7]};
    }
}
__device__ __forceinline__ void cross_item(Frame& F, const bf16_t* QC, const bf16_t* KC, const bf16_t* VC, bf16_t* OC, int bh, int qb) {
    int tid = F.tid; asm volatile("" : "+v"(tid));
    const int lane = tid & 63, wave = F.wave, q = lane & 31, hi = lane >> 5;
    LAS unsigned char* L = F.lds;
    const int g4 = lane >> 4, qq = (lane >> 2) & 3, p4 = lane & 3;
    {
        const int b = bh >> 2, h = bh & 3;
#pragma unroll
        for (int i = 0; i < 16; ++i) { const int cid = tid + 512 * i, r = cid >> 5, c = cid & 31;
            *(LAS v4u*)(L + r * 512 + ((c ^ (r & 15)) << 4)) = *(const v4u*)(KC + (size_t)(b * 256 + r) * 1024 + h * 256 + c * 8); }
        const size_t qrow0 = (size_t)b * SEQ + qb * 256 + wave * 32;
        const bf16_t* Qp = QC + (qrow0 + q) * 1024 + h * 256 + 8 * hi;
        __syncthreads();
        f32x16_t st[8];
#pragma unroll
        for (int kt = 0; kt < 8; ++kt) st[kt] = (f32x16_t){};
#pragma unroll 2
        for (int ks = 0; ks < 16; ++ks) { const bf16x8_t qf = *(const bf16x8_t*)(Qp + 16 * ks);
#pragma unroll
            for (int kt = 0; kt < 8; ++kt) { const int row = 32 * kt + q;
                st[kt] = __builtin_amdgcn_mfma_f32_32x32x16_bf16(*(const LAS bf16x8_t*)(L + row * 512 + (((2 * ks + hi) ^ (row & 15)) << 4)), qf, st[kt], 0, 0, 0); } }
        float m = -INFINITY;
#pragma unroll
        for (int kt = 0; kt < 8; ++kt)
#pragma unroll
            for (int r = 0; r < 16; ++r) { st[kt][r] *= 0.0625f; m = fmaxf(m, st[kt][r]); }
        m = fmaxf(m, __shfl_xor(m, 32));
        float l = 0.f;
#pragma unroll
        for (int kt = 0; kt < 8; ++kt)
#pragma unroll
            for (int r = 0; r < 16; ++r) { st[kt][r] = __expf(st[kt][r] - m); l += st[kt][r]; }
        l += __shfl_xor(l, 32);
        const float il = 1.f / l;
        bf16x8_t pa[8][2];
#pragma unroll
        for (int kt = 0; kt < 8; ++kt)
#pragma unroll
            for (int s = 0; s < 2; ++s) pa[kt][s] = __builtin_bit_cast(bf16x8_t, (v4u){cvtpk(st[kt][8 * s] * il, st[kt][8 * s + 1] * il), cvtpk(st[kt][8 * s + 2] * il, st[kt][8 * s + 3] * il),
                                                                                        cvtpk(st[kt][8 * s + 4] * il, st[kt][8 * s + 5] * il), cvtpk(st[kt][8 * s + 6] * il, st[kt][8 * s + 7] * il)});
        __syncthreads();
#pragma unroll
        for (int i = 0; i < 16; ++i) { const int cid = tid + 512 * i, r = cid >> 5, c = cid & 31;
            *(LAS v4u*)(L + r * 512 + ((c ^ (4 * (r & 3))) << 4)) = *(const v4u*)(VC + (size_t)(b * 256 + r) * 1024 + h * 256 + c * 8); }
        __syncthreads();
        bf16_t* Op = OC + qrow0 * 1024 + h * 256 + q;
#pragma unroll 1
        for (int dt = 0; dt < 8; ++dt) {
            f32x16_t o = {};
            LAS unsigned char* vb = L + (4 * (g4 >> 1) + qq) * 512 + (((dt * 64) ^ (qq << 6)) + (g4 & 1) * 32 + p4 * 8);
#pragma unroll
            for (int kt = 0; kt < 8; ++kt)
#pragma unroll
                for (int s = 0; s < 2; ++s) { const v4i16_t a0 = lds_tr16(vb + (32 * kt + 16 * s) * 512), a1 = lds_tr16(vb + (32 * kt + 16 * s + 8) * 512);
                    const bf16x8_t vf = {a0[0], a0[1], a0[2], a0[3], a1[0], a1[1], a1[2], a1[3]};
                    o = __builtin_amdgcn_mfma_f32_32x32x16_bf16(pa[kt][s], vf, o, 0, 0, 0); }
#pragma unroll
            for (int r = 0; r < 16; ++r) { const int row = (r & 3) + 8 * (r >> 2) + 4 * hi; Op[(size_t)row * 1024 + dt * 32] = f2bf(o[r]); }
        }
        __syncthreads();
    }
}
template <bool REMAP>
__device__ __forceinline__ void transpose_tile(const float* W, int K, int N, const float* gain, bf16_t* WT, LAS float* tile, int item, int tid) {
    const int nblk = (N + 255) / 256, kb = item / nblk, nb = item % nblk, k0 = 64 * kb, n0 = 256 * nb;
    const int c4 = (tid & 63) * 4, kr = tid >> 6;
    f32x4 v[8];
#pragma unroll
    for (int i = 0; i < 8; ++i) { const int k = kr + 8 * i; v[i] = (n0 + c4 < N) ? *(const GAS f32x4*)(W + (size_t)(k0 + k) * N + n0 + c4) : (f32x4){0.f, 0.f, 0.f, 0.f}; }
#pragma unroll
    for (int i = 0; i < 8; ++i) { const int k = kr + 8 * i; LAS float* d = tile + k * 257 + c4; d[0] = v[i].x; d[1] = v[i].y; d[2] = v[i].z; d[3] = v[i].w; }
    __syncthreads();
#pragma unroll
    for (int i = 0; i < 4; ++i) { const int p = tid + 512 * i, n = p >> 3, c = p & 7; const LAS float* sp = tile + (8 * c) * 257 + n;
        float g[8];
#pragma unroll
        for (int q = 0; q < 8; ++q) g[q] = gain ? gain[k0 + 8 * c + q] : 1.f;
        v4u o; o.x = pk2(sp[0 * 257] * g[0], sp[1 * 257] * g[1]); o.y = pk2(sp[2 * 257] * g[2], sp[3 * 257] * g[3]); o.z = pk2(sp[4 * 257] * g[4], sp[5 * 257] * g[5]); o.w = pk2(sp[6 * 257] * g[6], sp[7 * 257] * g[7]);
        int ng = n0 + n; bool ok = ng < N;
        if (REMAP) { if (ng >= 3584 && ng < 3592) ok = false; else if (ng >= 3592) ng -= 8; }
        if (ok) *(GAS v4u*)(WT + (size_t)ng * K + k0 + 8 * c) = o; }
    __syncthreads();
}

__device__ __forceinline__ void p0_prologue(Frame& F, const Args& a) {
    unsigned char* ws = a.ws;
    LAS float* tile = (LAS float*)F.lds;
    const int gw = F.vcu * NWAVES + F.wave, NGW = F.G * NWAVES;
    constexpr int I_IN = 16 * 23;
    for (int it = F.vcu; it < I_IN; it += F.G) transpose_tile<true>(a.w_in, 1024, IN_COLS, a.g_mix, (bf16_t*)(ws + WS_WIN), tile, it, F.tid);
    __syncthreads();
    LAS float* wsm = (LAS float*)F.lds;
    for (int i = F.tid; i < 8192; i += NWAVES * 64) { const int j = i >> 10, k = i & 1023; wsm[i] = a.w_in[(size_t)k * IN_COLS + 3584 + j] * a.g_mix[k]; }
    __syncthreads();
    bf16_t* XB = (bf16_t*)(ws + WS_A0); float* rstd0 = (float*)(ws + WS_RSTD0); float* GB = (float*)(ws + WS_GB); float* GA = GB + T * 4;
    for (int row0 = gw * 4; row0 < T; row0 += NGW * 4) {
        f32x4 v[4][4];
#pragma unroll
        for (int r = 0; r < 4; ++r)
#pragma unroll
            for (int j = 0; j < 4; ++j) v[r][j] = *((const GAS f32x4*)(a.x + (size_t)(row0 + r) * D) + F.lane + 64 * j);
#pragma unroll
        for (int r = 0; r < 4; ++r) { const int row = row0 + r; float s = 0.f;
#pragma unroll
            for (int j = 0; j < 4; ++j) s += (v[r][j].x * v[r][j].x + v[r][j].y * v[r][j].y) + (v[r][j].z * v[r][j].z + v[r][j].w * v[r][j].w);
            const float rstd = rsqrtf(wave_sum(s) * (1.f / D) + EPS);
            GAS unsigned long long* o8 = (GAS unsigned long long*)(XB + (size_t)row * D) + F.lane;
#pragma unroll
            for (int j = 0; j < 4; ++j) o8[64 * j] = (unsigned long long)pk2(v[r][j].x, v[r][j].y) | ((unsigned long long)pk2(v[r][j].z, v[r][j].w) << 32);
            float dj[8];
#pragma unroll
            for (int jj = 0; jj < 8; ++jj) { float d = 0.f;
#pragma unroll
                for (int j = 0; j < 4; ++j) { const f32x4 w = *(const LAS f32x4*)(wsm + jj * 1024 + (F.lane + 64 * j) * 4); d += (v[r][j].x * w.x + v[r][j].y * w.y) + (v[r][j].z * w.z + v[r][j].w * w.w); }
                dj[jj] = d; }
#pragma unroll
            for (int off = 4; off >= 1; off >>= 1) { const bool up = (F.lane & off) != 0;
#pragma unroll
                for (int i = 0; i < off; ++i) { const float lo = dj[i], hi = dj[i + off]; const float send = up ? lo : hi, keep = up ? hi : lo; dj[i] = keep + __shfl_xor(send, off); } }
            float d0 = dj[0]; d0 += __shfl_xor(d0, 8); d0 += __shfl_xor(d0, 16); d0 += __shfl_xor(d0, 32);
            if (F.lane == 0) rstd0[row] = rstd;
            if (F.lane < 4) GB[(size_t)row * 4 + F.lane] = d0 * rstd; else if (F.lane < 8) GA[(size_t)row * 4 + F.lane - 4] = d0 * rstd; }
    }
}
__device__ __forceinline__ void late_prologue(Frame& F, const Args& a, int wgi, int nwg) {
    unsigned char* ws = a.ws;
    LAS float* tile = (LAS float*)F.lds;
    const int gw = wgi * NWAVES + F.wave, NGW = nwg * NWAVES;
    constexpr int I_S = 8 * 4, I_M = 16 * 4, I_L = 16 * 8;
    constexpr int NITEMS = 2 * I_S + 3 * I_M + 2 * I_L;
    for (int it = wgi; it < NITEMS; it += nwg) {
        int r = it;
        if (r < I_S) { transpose_tile<false>(a.w_sb_up, 512, 1024, nullptr, (bf16_t*)(ws + WS_WSB), tile, r, F.tid); continue; } r -= I_S;
        if (r < I_S) { transpose_tile<false>(a.w_gdn_up, 512, 1024, nullptr, (bf16_t*)(ws + WS_WGDN), tile, r, F.tid); continue; } r -= I_S;
        if (r < I_M) { transpose_tile<false>(a.w_mix_out, 1024, 1024, nullptr, (bf16_t*)(ws + WS_WMIX), tile, r, F.tid); continue; } r -= I_M;
        if (r < I_M) { transpose_tile<false>(a.w_cq, 1024, 1024, a.g_cross, (bf16_t*)(ws + WS_WCQ), tile, r, F.tid); continue; } r -= I_M;
        if (r < I_M) { transpose_tile<false>(a.w_co, 1024, 1024, nullptr, (bf16_t*)(ws + WS_WCO), tile, r, F.tid); continue; } r -= I_M;
        if (r < I_L) { transpose_tile<false>(a.w_ckv, 1024, 2048, nullptr, (bf16_t*)(ws + WS_WCKV), tile, r, F.tid); continue; } r -= I_L;
        transpose_tile<false>(a.w_pq, 1024, 2048, a.g_peer, (bf16_t*)(ws + WS_WPQ), tile, r, F.tid);
    }
    __syncthreads();
    {
        float* SUV = (float*)(ws + WS_SUV);
        f32x4 gq[4];
#pragma unroll
        for (int q = 0; q < 4; ++q) gq[q] = *(const GAS f32x4*)(a.g_peer + 16 * F.lane + 4 * q);
        for (int row0 = gw * 4; row0 < 2 * 16384; row0 += NGW * 4) {
            f32x4 v[4][4];
#pragma unroll
            for (int r = 0; r < 4; ++r) { const int row = row0 + r, tb = row >> 14, e = row & 16383; const float* src = (tb ? a.peer_v : a.peer_u) + (size_t)e * 1024 + 16 * F.lane;
#pragma unroll
                for (int q = 0; q < 4; ++q) { v[r][q] = *(const GAS f32x4*)(src + 4 * q); if (!tb) v[r][q] *= gq[q]; } }
#pragma unroll
            for (int r = 0; r < 4; ++r) { const int row = row0 + r, tb = row >> 14, e = row & 16383; float am = 0.f;
#pragma unroll
                for (int q = 0; q < 4; ++q) am = fmaxf(am, fmaxf(fmaxf(fabsf(v[r][q].x), fabsf(v[r][q].y)), fmaxf(fabsf(v[r][q].z), fabsf(v[r][q].w))));
#pragma unroll
                for (int o = 1; o < 64; o <<= 1) am = fmaxf(am, __shfl_xor(am, o));
                if (!tb) {
                    float sq = 0.f;
#pragma unroll
                    for (int q = 0; q < 4; ++q) sq += (v[r][q].x * v[r][q].x + v[r][q].y * v[r][q].y) + (v[r][q].z * v[r][q].z + v[r][q].w * v[r][q].w);
                    sq = wave_sum(sq);
                    const float cl = fminf(am, 2.6f * sqrtf(sq * (1.f / 1024.f))), sc4 = cl > 0.f ? 7.f / cl : 0.f; v2u o4;
#pragma unroll
                    for (int h2 = 0; h2 < 2; ++h2) { const float lo4[4] = {v[r][2 * h2].x, v[r][2 * h2].y, v[r][2 * h2].z, v[r][2 * h2].w}, hi4[4] = {v[r][2 * h2 + 1].x, v[r][2 * h2 + 1].y, v[r][2 * h2 + 1].z, v[r][2 * h2 + 1].w}; unsigned wd = 0u;
#pragma unroll
                        for (int k = 0; k < 4; ++k) { const int nl = (int)fminf(fmaxf(rintf(lo4[k] * sc4), -7.f), 7.f), nh = (int)fminf(fmaxf(rintf(hi4[k] * sc4), -7.f), 7.f);
                            wd |= ((unsigned)(nl + 8) | (((unsigned)nh & 15u) << 4)) << (8 * k); }
                        o4[h2] = wd; }
                    *(GAS v2u*)(ws + WS_U8 + ((size_t)(F.lane >> 4) * 16384 + e) * 128 + 8 * (F.lane & 15)) = o4;
                    if (F.lane == 0) SUV[row] = cl * (1.f / 7.f);
                    continue; }
                const float sc = am > 0.f ? 6.f / am : 0.f, inv = am * (1.f / 6.f);
                {   unsigned char* vrow = ws + WS_V8 + ((size_t)(F.lane >> 4) * 16384 + e) * 128;
                    const int gq = (F.lane & 15) >> 1, jb = 4 * (F.lane & 1);
#pragma unroll
                    for (int q = 0; q < 4; ++q) { unsigned w4 = __builtin_amdgcn_cvt_scalef32_pk_fp4_f32(0u, v[r][q].x * sc, v[r][q].y * sc, 1.0f, 0); w4 = __builtin_amdgcn_cvt_scalef32_pk_fp4_f32(w4, v[r][q].z * sc, v[r][q].w * sc, 1.0f, 1);
                        *(unsigned short*)(vrow + 16 * (jb + q) + 2 * gq) = (unsigned short)(w4 & 0xffffu); } }
                if (F.lane == 0) SUV[row] = inv; }
        }
    }
    {
        const int gt = gw * 64 + F.lane, ngt = NGW * 64;
        for (int p = gt; p < 262144 / 8; p += ngt) { const float* src = a.subkeys + (size_t)p * 8; const f32x4 v0 = *(const GAS f32x4*)src, v1 = *(const GAS f32x4*)(src + 4);
            v4u o; o.x = pk2(v0.x, v0.y); o.y = pk2(v0.z, v0.w); o.z = pk2(v1.x, v1.y); o.w = pk2(v1.z, v1.w); *(GAS v4u*)((bf16_t*)(ws + WS_SKB) + (size_t)p * 8) = o; }
    }
    bf16_t* MN = (bf16_t*)(ws + WS_MN);
    for (int row = gw; row < 1024; row += NGW) {
        const GAS f32x4* xr = (const GAS f32x4*)(a.mem + (size_t)row * D) + F.lane;
        f32x4 v[4]; float s = 0.f;
#pragma unroll
        for (int j = 0; j < 4; ++j) { v[j] = xr[64 * j]; s += (v[j].x * v[j].x + v[j].y * v[j].y) + (v[j].z * v[j].z + v[j].w * v[j].w); }
        const float rstd = rsqrtf(wave_sum(s) * (1.f / D) + EPS);
        GAS unsigned long long* o8 = (GAS unsigned long long*)(MN + (size_t)row * D) + F.lane;
#pragma unroll
        for (int j = 0; j < 4; ++j) { const f32x4 g = *((const f32x4*)a.g_mem + F.lane + 64 * j); const f32x4 o = v[j] * g * rstd;
            o8[64 * j] = (unsigned long long)pk2(o.x, o.y) | ((unsigned long long)pk2(o.z, o.w) << 32); }
    }
}
__device__ __forceinline__ void rstd_rows_for_units(Frame& F, int N, const float* SS, float* rstd) {
    pg8::StaticOrder S2; S2.init(T, N, F.G, (int)blockIdx.x); pg8::Unit u;
    for (int i = 0; S2.next(i, u); ++i) if (F.tid < 256) { const int row = u.pm * 256 + F.tid; const f32x4* sp = (const f32x4*)(SS + (size_t)row * 16);
        const f32x4 a = (sp[0] + sp[1]) + (sp[2] + sp[3]); rstd[row] = rsqrtf(((a.x + a.y) + (a.z + a.w)) * (1.f / 1024.f) + EPS); }
    asm volatile("s_waitcnt vmcnt(0)" ::: "memory"); __syncthreads();
}

__device__ __forceinline__ void sub_barrier(gu32* cnt, unsigned n, gu32* tmo) {
    asm volatile("s_waitcnt vmcnt(0)" ::: "memory");
    __syncthreads();
    if (threadIdx.x == 0) {
        __builtin_amdgcn_fence(__ATOMIC_RELEASE, "agent");
        asm volatile("s_waitcnt vmcnt(0)" ::: "memory");
        __hip_atomic_fetch_add(cnt, 1u, __ATOMIC_RELAXED, __HIP_MEMORY_SCOPE_AGENT);
        unsigned sp = 0;
        while (__hip_atomic_load(cnt, __ATOMIC_RELAXED, __HIP_MEMORY_SCOPE_AGENT) < n) { __builtin_amdgcn_s_sleep(2); if (++sp > (1u << 22)) { __hip_atomic_store(tmo, 1u, __ATOMIC_RELAXED, __HIP_MEMORY_SCOPE_AGENT); break; } }
        __builtin_amdgcn_fence(__ATOMIC_ACQUIRE, "agent");
        asm volatile("s_waitcnt vmcnt(0)" ::: "memory");
    }
    __syncthreads();
}

__global__ void __launch_bounds__(NWAVES * 64, 2) mk_fwd(Args args) {
    extern __shared__ __attribute__((aligned(16))) unsigned char lds_raw[];
    Frame F;
    F.lds = (LAS unsigned char*)lds_raw;
    F.tid = threadIdx.x; F.lane = F.tid & 63; F.wave = __builtin_amdgcn_readfirstlane(F.tid >> 6);
    F.G = gridDim.x; { const int bx = blockIdx.x; F.vcu = (F.G % 8 == 0) ? (bx % 8) * (F.G / 8) + bx / 8 : bx; }
    unsigned char* ws = args.ws;
    gu32* ctl = (gu32*)(ws + WS_CTL);
    volatile LAS unsigned* MISC = (volatile LAS unsigned*)(F.lds + MISC_OFF);
    for (int u = F.tid; u < (LDS_BYTES - LDSCTL_OFF) / 4; u += NWAVES * 64) ((LAS unsigned*)(F.lds + LDSCTL_OFF))[u] = 0u;
    __syncthreads();
    XcdBarrier bar = xcd_barrier_post((unsigned*)(ctl + CW_BAR) + args.bar_region * XCD_BAR_WORDS, MISC + 8);
    const int lo = args.ph_lo, hi = args.ph_hi;
#define IN(k) (lo <= (k) && (k) < hi)
#ifndef PROBE_PH
#define PROBE_PH (-1)
#endif
    unsigned long long pb_t = (PROBE_PH >= 0) ? __builtin_amdgcn_s_memrealtime() : 0ull;
#define PB_STRETCH() do { const unsigned long long e_ = __builtin_amdgcn_s_memrealtime(), d_ = e_ - pb_t; while (__builtin_amdgcn_s_memrealtime() - e_ < d_) __builtin_amdgcn_s_sleep(4); } while (0)
#define SEAM(k) do { if (PROBE_PH == (k)) PB_STRETCH(); if (IN(k) && IN((k) + 1)) xcd_barrier(bar); if ((k) < PROBE_PH) pb_t = __builtin_amdgcn_s_memrealtime(); } while (0)
    bf16_t* A0 = (bf16_t*)(ws + WS_A0); bf16_t* A1 = (bf16_t*)(ws + WS_A1);
    bf16_t* MG = (bf16_t*)args.out;
    bf16_t* SBQ = (bf16_t*)args.out; bf16_t* SBK = SBQ + (size_t)T * 512; bf16_t* SBV = SBK + (size_t)T * 512; bf16_t* OSB = SBV + (size_t)T * 512;

    GdnBufs Gb{(bf16_t*)(ws + WS_NW), (bf16_t*)(ws + WS_QD), (bf16_t*)(ws + WS_KDT), (bf16_t*)(ws + WS_QK), (bf16_t*)(ws + WS_UT), (float*)(ws + WS_CD), (bf16_t*)(ws + WS_ORAW), (float*)(ws + WS_OSS)};
    if (IN(0)) { p0_prologue(F, args);}
    SEAM(0);
    if (IN(1)) {
        { pg8::Gemm g{A0, (const bf16_t*)(ws + WS_WIN), T, NPROJ, 1024}; pg8::StaticOrder S; S.init(T, NPROJ, F.G, (int)blockIdx.x);
          pg8::EpiProj E{(const float*)(ws + WS_RSTD0), SBQ, SBK, SBV, A1, (bf16_t*)(ws + WS_GZ), (bf16_t*)(ws + WS_GSB), (bf16_t*)(ws + WS_GGDN)};
          pg8::gemm_phase<pg8::EpiProj, pg8::StaticOrder, true, true>(F.lds, g, S, E); }
    }
    SEAM(1);
    if (IN(2)) { gdn_prep_phase(F, args, A1, (const float*)(ws + WS_GB), (const float*)(ws + WS_GB) + T * 4, Gb); }
    SEAM(2);
    if (IN(3)) {
        const int nscan = F.G > 64 ? 64 : F.G, sb0 = F.G > 64 ? 64 : 0;
        if ((int)blockIdx.x < nscan) for (int s0 = blockIdx.x; s0 < 64; s0 += nscan) { const int s = (nscan == 64) ? ((s0 & 7) + 8 * (s0 >> 5)) * 4 + ((s0 >> 3) & 3) : s0; gdn_scan_unit(F, s, Gb); __syncthreads(); }
        if ((int)blockIdx.x >= sb0) { late_prologue(F, args, (int)blockIdx.x - sb0, F.G - sb0); __syncthreads(); }
        if ((int)blockIdx.x >= sb0) sb_phase(F.lds + F.wave * 8192, SBQ, SBK, SBV, OSB, ((int)blockIdx.x - sb0) * NWAVES + F.wave, (F.G - sb0) * NWAVES, F.lane);
        __syncthreads();
        if (sb0 > 0 && (int)blockIdx.x >= sb0) {
            sub_barrier(ctl + CW_SUB, (unsigned)(F.G - sb0), ctl + CW_SUB + 64);
            pg8::Gemm g{OSB, (const bf16_t*)(ws + WS_WSB), T, 1024, 512}; pg8::StaticOrder S; S.init(T, 1024, F.G - sb0, (int)blockIdx.x - sb0);
            pg8::EpiMerge<false> E{(const bf16_t*)(ws + WS_GSB), MG};
            pg8::gemm_phase<pg8::EpiMerge<false>, pg8::StaticOrder, true, true>(F.lds, g, S, E);
            const int wgi = (int)blockIdx.x - sb0;
            if (F.G - sb0 >= 160 && wgi >= 128 && wgi < 160) { pg8::Gemm g2{(const bf16_t*)(ws + WS_MN), (const bf16_t*)(ws + WS_WCKV), 1024, 2048, 1024}; pg8::StaticOrder S2; S2.init(1024, 2048, 32, wgi - 128);
                pg8::EpiSplit E2{(bf16_t*)(ws + WS_KC), (bf16_t*)(ws + WS_VC), 1024, 4};
                pg8::gemm_phase<pg8::EpiSplit, pg8::StaticOrder, true, true>(F.lds, g2, S2, E2); }
        }
    }
    SEAM(3);
    if (IN(4)) {
        if (!(F.G > 64 && F.G - 64 >= 160)) { pg8::Gemm g{(const bf16_t*)(ws + WS_MN), (const bf16_t*)(ws + WS_WCKV), 1024, 2048, 1024}; pg8::StaticOrder S; S.init(1024, 2048, F.G, (int)blockIdx.x);
          pg8::EpiSplit E{(bf16_t*)(ws + WS_KC), (bf16_t*)(ws + WS_VC), 1024, 4};
          pg8::gemm_phase<pg8::EpiSplit, pg8::StaticOrder, true, true>(F.lds, g, S, E); }
        gdn_finish_phase(F, args, Gb, (const bf16_t*)(ws + WS_GZ), (bf16_t*)(ws + WS_OG)); }
    SEAM(4);
    if (IN(5)) {
        if (!(F.G > 64)) { pg8::Gemm g{OSB, (const bf16_t*)(ws + WS_WSB), T, 1024, 512}; pg8::StaticOrder S; S.init(T, 1024, F.G, (int)blockIdx.x);
          pg8::EpiMerge<false> E{(const bf16_t*)(ws + WS_GSB), MG};
          pg8::gemm_phase<pg8::EpiMerge<false>, pg8::StaticOrder, true, true>(F.lds, g, S, E);
          xcd_barrier(bar); }
        { pg8::Gemm g{(const bf16_t*)(ws + WS_OG), (const bf16_t*)(ws + WS_WGDN), T, 1024, 512}; pg8::StaticOrder S; S.init(T, 1024, F.G, (int)blockIdx.x);
          pg8::EpiMerge<true> E{(const bf16_t*)(ws + WS_GGDN), MG};
          pg8::gemm_phase<pg8::EpiMerge<true>, pg8::StaticOrder, true, true>(F.lds, g, S, E); }
    }
    SEAM(5);
    if (IN(6)) {
        pg8::Gemm g{MG, (const bf16_t*)(ws + WS_WMIX), T, 1024, 1024}; pg8::StaticOrder S; S.init(T, 1024, F.G, (int)blockIdx.x);
        pg8::EpiRes<true> E{args.x, nullptr, A1, (float*)(ws + WS_SS)};
        pg8::gemm_phase<pg8::EpiRes<true>, pg8::StaticOrder, true, true>(F.lds, g, S, E);
    }
    SEAM(6);
    if (IN(7)) {
        rstd_rows_for_units(F, 1024, (const float*)(ws + WS_SS), (float*)(ws + WS_RSTD0));
        pg8::Gemm g{A1, (const bf16_t*)(ws + WS_WCQ), T, 1024, 1024}; pg8::StaticOrder S; S.init(T, 1024, F.G, (int)blockIdx.x);
        pg8::EpiScale E{(const float*)(ws + WS_RSTD0), (bf16_t*)(ws + WS_GSB), 1024};
        pg8::gemm_phase<pg8::EpiScale, pg8::StaticOrder, true, true>(F.lds, g, S, E);
        asm volatile("s_waitcnt vmcnt(0)" ::: "memory"); __syncthreads();
        pg8::StaticOrder S2; S2.init(T, 1024, F.G, (int)blockIdx.x); pg8::Unit u;
        for (int i = 0; S2.next(i, u); ++i) cross_item(F, (const bf16_t*)(ws + WS_GSB), (const bf16_t*)(ws + WS_KC), (const bf16_t*)(ws + WS_VC), (bf16_t*)(ws + WS_GGDN), (u.pm >> 5) * 4 + u.pn, u.pm & 31);
    }
    SEAM(7);
    if (IN(9)) {
        pg8::Gemm g{(const bf16_t*)(ws + WS_GGDN), (const bf16_t*)(ws + WS_WCO), T, 1024, 1024}; pg8::StaticOrder S; S.init(T, 1024, F.G, (int)blockIdx.x);
        pg8::EpiRes<false> E{nullptr, A1, A0, (float*)(ws + WS_SS)};
        pg8::gemm_phase<pg8::EpiRes<false>, pg8::StaticOrder, true, true>(F.lds, g, S, E);
    }
    SEAM(9);
    if (IN(10)) {
        rstd_rows_for_units(F, 2048, (const float*)(ws + WS_SS), (float*)(ws + WS_RSTD2));
        pg8::Gemm g{A0, (const bf16_t*)(ws + WS_WPQ), T, 2048, 1024}; pg8::StaticOrder S; S.init(T, 2048, F.G, (int)blockIdx.x);
        pg8::EpiScale E{(const float*)(ws + WS_RSTD2), A1, 2048};
        pg8::gemm_phase<pg8::EpiScale, pg8::StaticOrder, true, true>(F.lds, g, S, E);
        asm volatile("s_waitcnt vmcnt(0)" ::: "memory"); __syncthreads();
        pg8::StaticOrder S2; S2.init(T, 2048, F.G, (int)blockIdx.x); pg8::Unit u;
        int hst = -1;
        for (int i = 0; S2.next(i, u); ++i) {
            if (u.pn != hst) { hst = u.pn; __syncthreads();
#pragma unroll
                for (int q = 0; q < 8; ++q) { const int cid = F.tid + 512 * q, r = cid >> 4, c = cid & 15;
                    *(LAS v4u*)(F.lds + r * 256 + ((c ^ (r & 15)) << 4)) = *(const v4u*)((const bf16_t*)(ws + WS_SKB) + ((size_t)u.pn * 256 + r) * 128 + c * 8); }
                __syncthreads(); }
            peer_route_task(F, A1, (const bf16_t*)(ws + WS_SKB), (int*)(ws + 296 * MiB), (float*)(ws + 312 * MiB), u.pm * 8 + F.wave, u.pn);
        }
        __syncthreads();
    }
    SEAM(10);
    if (IN(12)) { peer_u_phase(F, args, ctl, A0, (const float*)(ws + WS_RSTD2), (const int*)(ws + 296 * MiB), (const unsigned char*)(ws + WS_U8), (bf16_t*)(ws + WS_PART)); }
    SEAM(12);
    if (IN(13)) { peer_combine_phase(F, (const bf16_t*)(ws + WS_PART), (const int*)(ws + 296 * MiB), (const float*)(ws + 312 * MiB), (const float*)(ws + WS_SUV), (const float*)(ws + WS_SUV) + 16384, (float*)(ws + 328 * MiB)); }
    SEAM(13);
    if (IN(14)) { peer_v_phase(F, ctl, (const int*)(ws + 296 * MiB), (const float*)(ws + 328 * MiB), (const unsigned char*)(ws + WS_V8), A0, A1, (float*)(ws + WS_SS)); }
    SEAM(14);
    if (IN(15)) { peer_norm_phase(F, args, (const float*)(ws + WS_SS), A1, args.out); }
    if (PROBE_PH == 15) PB_STRETCH();
#undef IN
#undef SEAM
#undef PB_STRETCH
}
extern "C" void kernel_launch(void* const* d_in, const int* in_sizes, int n_in, void* d_out, int out_size, void* d_ws, size_t ws_size, hipStream_t stream) {
    static int grid = 0;
    if (grid == 0) {
        if (n_in != 22 || ws_size < WS_END || out_size != T * D) { fprintf(stderr, "kernel_launch: unexpected n_in %d / ws %zu / out %d\n", n_in, ws_size, out_size); grid = -1; return; }
        int dev = 0, cus = 0, per_cu = 0;
        if (hipGetDevice(&dev) != hipSuccess || hipDeviceGetAttribute(&cus, hipDeviceAttributeMultiprocessorCount, dev) != hipSuccess) { grid = -1; return; }
        if (hipFuncSetAttribute((const void*)mk_fwd, hipFuncAttributeMaxDynamicSharedMemorySize, LDS_BYTES) != hipSuccess) { fprintf(stderr, "kernel_launch: hipFuncSetAttribute failed\n"); grid = -1; return; }
        if (hipOccupancyMaxActiveBlocksPerMultiprocessor(&per_cu, (const void*)mk_fwd, NWAVES * 64, LDS_BYTES) != hipSuccess || per_cu < 1) { fprintf(stderr, "kernel_launch: occupancy query says %d\n", per_cu); per_cu = 1; }
        (void)hipGetLastError();
        grid = cus;
    }
    if (grid < 0) return;
    hipMemsetAsync((char*)d_ws + WS_CTL, 0, CTL_ZERO_BYTES, stream);
    Args a{};
    const float** ap = (const float**)&a;
    for (int i = 0; i < 22; ++i) ap[i] = (const float*)d_in[i];
    a.out = (float*)d_out; a.ws = (unsigned char*)d_ws;
    char* ws = (char*)d_ws; float* out = (float*)d_out;
    float* rstd2 = (float*)(ws + WS_RSTD2);
    bf16_t* KC = (bf16_t*)(ws + WS_KC); bf16_t* VC = (bf16_t*)(ws + WS_VC);
    bf16_t* PQ = (bf16_t*)(ws + WS_A1); bf16_t* QC = (bf16_t*)(ws + WS_GSB); bf16_t* OC = (bf16_t*)(ws + WS_GGDN);
    int* EIDX = (int*)(ws + 296 * MiB); float* EGATE = (float*)(ws + 312 * MiB);
#define MK(lo, hi, reg) do { a.ph_lo = (lo); a.ph_hi = (hi); a.bar_region = (reg); hipLaunchKernelGGL(mk_fwd, dim3(grid), dim3(NWAVES * 64), LDS_BYTES, stream, a); } while (0)
    MK(0, 16, 0);
#undef MK
}
```

```cpp
#include <hip/hip_runtime.h>
#include <stdint.h>
#include <cstdio>

typedef unsigned short bf16_t;
__device__ __forceinline__ float bf2f(bf16_t v) { return __uint_as_float(((unsigned)v) << 16); }
__device__ __forceinline__ bf16_t f2bf(float f) { unsigned u = __float_as_uint(f); return (bf16_t)((u + 0x7fffu + ((u >> 16) & 1u)) >> 16); }

constexpr int T = 32768, D = 1024, SEQ = 8192, NB = 4;
constexpr int IN_COLS = 5640, NPROJ = 5632;
constexpr float EPS = 1e-6f;
constexpr size_t MiB = 1u << 20;

__device__ __forceinline__ float wave_sum(float v) {
#pragma unroll
    for (int o = 1; o < 64; o <<= 1) v += __shfl_xor(v, o);
    return v;
}
__device__ __forceinline__ float sigmoidf_(float x) { return 1.f / (1.f + __expf(-x)); }
__device__ __forceinline__ float softplusf_(float x) { return fmaxf(x, 0.f) + log1pf(__expf(-fabsf(x))); }

namespace pg8 {
#define PG8_LAS __attribute__((address_space(3)))
typedef unsigned short bf16_t;
typedef short bf16x8 __attribute__((ext_vector_type(8)));
typedef float f32x4 __attribute__((ext_vector_type(4)));
typedef unsigned u32x4 __attribute__((ext_vector_type(4)));
constexpr int BM = 256, BK = 64, HALF = 128, HTB = HALF * BK * 2  , STAGE_BYTES = 8 * HTB, NXCD = 8, WGM = 8;

__host__ __device__ __forceinline__ int lds_byte(int r, int c) { const int st = (r >> 4) * 2 + (c >> 5), rr = r & 15, cc = c & 31, ob = rr * 64 + cc * 2; return st * 1024 + (ob ^ (((ob >> 9) & 1) << 5)); }
__host__ __device__ __forceinline__ void stage_rc(int b, int& R, int& C) { const int st = b / 1024, sb = b % 1024, swz = sb ^ (((sb >> 9) & 1) << 5); R = (st >> 1) * 16 + swz / 64; C = (st & 1) * 32 + (swz % 64) / 2; }
__host__ __device__ __forceinline__ int perm32(int rho) { const int n = rho >> 4, i = rho & 15; return 8 * (i >> 2) + 4 * n + (i & 3); }

struct Unit { int pm, pn; };
struct Gemm { const bf16_t* A; const bf16_t* Bt; int M, N, K; };

struct StaticOrder {
    int nM, nN, nwg, G, c;
    __host__ __device__ __forceinline__ void init(int M, int N, int G_, int c_) { nM = M / BM; nN = N / BM; nwg = nM * nN; G = G_; c = c_; }
    __host__ __device__ __forceinline__ bool next(int i, Unit& u) const {
        const long L = (long)i * G + c; if (L >= nwg) return false;
        int wgid = (int)L; { const int q = nwg / NXCD, r = nwg % NXCD, xcd = wgid % NXCD, off = wgid / NXCD; wgid = (xcd < r ? xcd * (q + 1) : r * (q + 1) + (xcd - r) * q) + off; }
        const int nig = WGM * nN, gid = wgid / nig, fm = gid * WGM, gsz = (nM - fm) < WGM ? (nM - fm) : WGM;
        u.pm = fm + ((wgid % nig) % gsz); u.pn = (wgid % nig) / gsz; return true;
    }
    __device__ __forceinline__ void a_ready(const Unit&) const {}
    __device__ __forceinline__ void done(const Unit&) const {}
};

__device__ __forceinline__ unsigned cvt_pk_bf16(float lo, float hi) { unsigned r; asm volatile("v_cvt_pk_bf16_f32 %0, %1, %2" : "=v"(r) : "v"(lo), "v"(hi)); return r; }
typedef float f32x2 __attribute__((ext_vector_type(2)));
__device__ __forceinline__ float bfl(unsigned w) { return __uint_as_float(w << 16); }
__device__ __forceinline__ float bfh(unsigned w) { return __uint_as_float(w & 0xffff0000u); }
constexpr int EPI_STAGE_OFF = 131072 + 1024;
__device__ __forceinline__ void stage_store16x64(int wid, int fr, int fq, u32x4 w0, u32x4 w1, bf16_t* rowbase  , size_t ld) {
    PG8_LAS unsigned char* sl = (PG8_LAS unsigned char*)(EPI_STAGE_OFF + wid * 2048);
    *(PG8_LAS u32x4*)(sl + fr * 128 + ((fq ^ (fr & 7)) << 4)) = w0;
    *(PG8_LAS u32x4*)(sl + fr * 128 + (((4 + fq) ^ (fr & 7)) << 4)) = w1;
    const int lane = fr + 16 * fq, r0 = lane >> 3, c = lane & 7;
    const u32x4 a = *(const PG8_LAS u32x4*)(sl + r0 * 128 + ((c ^ r0) << 4));
    const u32x4 b = *(const PG8_LAS u32x4*)(sl + (r0 + 8) * 128 + ((c ^ r0) << 4));
    *(u32x4*)(rowbase + (size_t)r0 * ld + c * 8) = a;
    *(u32x4*)(rowbase + (size_t)(r0 + 8) * ld + c * 8) = b;
}
__device__ __forceinline__ u32x4 pack8(const f32x4& v0, const f32x4& v1) { u32x4 w; w.x = cvt_pk_bf16(v0[0], v0[1]); w.y = cvt_pk_bf16(v0[2], v0[3]); w.z = cvt_pk_bf16(v1[0], v1[1]); w.w = cvt_pk_bf16(v1[2], v1[3]); return w; }

struct EpiProj {
    static constexpr bool PERM = true, AFTER_DRAIN = false, COL64 = true;
    const float* rstd; bf16_t *SBQ, *SBK, *SBV, *GQKV, *GZ, *GSB, *GGDN;
    __device__ __forceinline__ void operator()(const f32x4 (&acc)[2][2][4][2], const Unit& u, int wr, int wc, int fr_in, int fq_in) const {
        int lane_ = fr_in + 16 * fq_in; asm volatile("" : "+v"(lane_));
        const int fr = lane_ & 15, fq = lane_ >> 4;
        const int pn = u.pn; bf16_t* base; int ld, coff;
        if (pn < 2) { base = SBQ; ld = 512; coff = pn * 256; } else if (pn < 4) { base = SBK; ld = 512; coff = (pn - 2) * 256; } else if (pn < 6) { base = SBV; ld = 512; coff = (pn - 4) * 256; }
        else if (pn < 12) { base = GQKV; ld = 1536; coff = (pn - 6) * 256; } else if (pn < 14) { base = GZ; ld = 512; coff = (pn - 12) * 256; }
        else if (pn < 18) { base = GSB; ld = 1024; coff = (pn - 14) * 256; } else { base = GGDN; ld = 1024; coff = (pn - 18) * 256; }
        const int row0 = u.pm * BM + wr * 64, wid = wr * 4 + wc;
        float rsv[2][4];
#pragma unroll
        for (int ai = 0; ai < 2; ++ai)
#pragma unroll
            for (int m = 0; m < 4; ++m) rsv[ai][m] = rstd[row0 + ai * HALF + m * 16 + fr];
#pragma unroll
        for (int ai = 0; ai < 2; ++ai)
#pragma unroll
            for (int m = 0; m < 4; ++m) { const int rg = row0 + ai * HALF + m * 16; const float rs = rsv[ai][m];
                stage_store16x64(wid, fr, fq, pack8(acc[ai][0][m][0] * rs, acc[ai][0][m][1] * rs), pack8(acc[ai][1][m][0] * rs, acc[ai][1][m][1] * rs), base + (size_t)rg * ld + coff + wc * 64, ld); }
    }
};
struct EpiSplit {
    static constexpr bool PERM = true, AFTER_DRAIN = false, COL64 = true;
    bf16_t *O0, *O1; int ldc, split_tiles;
    __device__ __forceinline__ void operator()(const f32x4 (&acc)[2][2][4][2], const Unit& u, int wr, int wc, int fr_in, int fq_in) const {
        int lane_ = fr_in + 16 * fq_in; asm volatile("" : "+v"(lane_));
        const int fr = lane_ & 15, fq = lane_ >> 4;
        bf16_t* base = u.pn < split_tiles ? O0 : O1; const int coff = (u.pn < split_tiles ? u.pn : u.pn - split_tiles) * 256;
        const int row0 = u.pm * BM + wr * 64, wid = wr * 4 + wc;
#pragma unroll
        for (int ai = 0; ai < 2; ++ai)
#pragma unroll
            for (int m = 0; m < 4; ++m) { const int rg = row0 + ai * HALF + m * 16;
                stage_store16x64(wid, fr, fq, pack8(acc[ai][0][m][0], acc[ai][0][m][1]), pack8(acc[ai][1][m][0], acc[ai][1][m][1]), base + (size_t)rg * ldc + coff + wc * 64, ldc); }
    }
};
template <bool ADD> struct EpiMerge {
    static constexpr bool PERM = true, AFTER_DRAIN = false, COL64 = true;
    const bf16_t* gate; bf16_t* M;
    __device__ __forceinline__ void operator()(const f32x4 (&acc)[2][2][4][2], const Unit& u, int wr, int wc, int fr_in, int fq_in) const {
        int lane_ = fr_in + 16 * fq_in; asm volatile("" : "+v"(lane_));
        const int fr = lane_ & 15, fq = lane_ >> 4;
        const int row0 = u.pm * BM + wr * 64, col0 = u.pn * BM + wc * 64, wid = wr * 4 + wc;
#pragma unroll
        for (int ab = 0; ab < 4; ++ab) { const int ai = ab >> 1, mb = (ab & 1) * 2;
            u32x4 gl[4][2], pl[4][2];
#pragma unroll
            for (int m = mb; m < mb + 2; ++m)
#pragma unroll
                for (int bj = 0; bj < 2; ++bj) { const size_t o = (size_t)(row0 + ai * HALF + m * 16 + fr) * 1024 + col0 + 8 * fq + bj * 32; gl[m][bj] = *(const u32x4*)(gate + o); if (ADD) pl[m][bj] = *(const u32x4*)(M + o); }
#pragma unroll
            for (int m = mb; m < mb + 2; ++m) { const int rg = row0 + ai * HALF + m * 16;
                u32x4 wv[2];
#pragma unroll
                for (int bj = 0; bj < 2; ++bj) { const u32x4 g = gl[m][bj];
                    float gv[8] = {bfl(g.x), bfh(g.x), bfl(g.y), bfh(g.y), bfl(g.z), bfh(g.z), bfl(g.w), bfh(g.w)};
                    float pv[8] = {0.f, 0.f, 0.f, 0.f, 0.f, 0.f, 0.f, 0.f};
                    if (ADD) { const u32x4 p = pl[m][bj]; pv[0] = bfl(p.x); pv[1] = bfh(p.x); pv[2] = bfl(p.y); pv[3] = bfh(p.y); pv[4] = bfl(p.z); pv[5] = bfh(p.z); pv[6] = bfl(p.w); pv[7] = bfh(p.w); }
                    float r[8];
#pragma unroll
                    for (int j = 0; j < 8; ++j) { const float a = j < 4 ? acc[ai][bj][m][0][j] : acc[ai][bj][m][1][j - 4]; r[j] = pv[j] + a * __builtin_amdgcn_rcpf(1.f + __expf(-gv[j])); }
                    wv[bj].x = cvt_pk_bf16(r[0], r[1]); wv[bj].y = cvt_pk_bf16(r[2], r[3]); wv[bj].z = cvt_pk_bf16(r[4], r[5]); wv[bj].w = cvt_pk_bf16(r[6], r[7]); }
                stage_store16x64(wid, fr, fq, wv[0], wv[1], M + (size_t)rg * 1024 + col0, 1024); }
        }
    }
};
template <bool IN_F32> struct EpiRes {
    static constexpr bool PERM = true, AFTER_DRAIN = false, COL64 = true;
    const float* xin_f; const bf16_t* xin_b; bf16_t* xb; float* SS;
    __device__ __forceinline__ void operator()(const f32x4 (&acc)[2][2][4][2], const Unit& u, int wr, int wc, int fr_in, int fq_in) const {
        int lane_ = fr_in + 16 * fq_in; asm volatile("" : "+v"(lane_));
        const int fr = lane_ & 15, fq = lane_ >> 4;
        const int row0 = u.pm * BM + wr * 64, col0 = u.pn * BM + wc * 64, wid = wr * 4 + wc;
#pragma unroll
        for (int ab = 0; ab < 4; ++ab) { const int ai = ab >> 1, mb = (ab & 1) * 2;
            f32x4 xl[4][2][2];
#pragma unroll
            for (int m = mb; m < mb + 2; ++m)
#pragma unroll
                for (int bj = 0; bj < 2; ++bj) { const size_t o = (size_t)(row0 + ai * HALF + m * 16 + fr) * 1024 + col0 + 8 * fq + bj * 32;
                    if (IN_F32) { xl[m][bj][0] = *(const f32x4*)(xin_f + o); xl[m][bj][1] = *(const f32x4*)(xin_f + o + 4); }
                    else { const u32x4 p = *(const u32x4*)(xin_b + o); xl[m][bj][0] = (f32x4){bfl(p.x), bfh(p.x), bfl(p.y), bfh(p.y)}; xl[m][bj][1] = (f32x4){bfl(p.z), bfh(p.z), bfl(p.w), bfh(p.w)}; } }
            float sv[4];
#pragma unroll
            for (int m = mb; m < mb + 2; ++m) { const int rg = row0 + ai * HALF + m * 16; float s = 0.f;
                u32x4 wv[2];
#pragma unroll
                for (int bj = 0; bj < 2; ++bj) { const u32x4 w = pack8(xl[m][bj][0] + acc[ai][bj][m][0], xl[m][bj][1] + acc[ai][bj][m][1]); wv[bj] = w;
                    const float r0 = bfl(w.x), r1 = bfh(w.x), r2 = bfl(w.y), r3 = bfh(w.y), r4 = bfl(w.z), r5 = bfh(w.z), r6 = bfl(w.w), r7 = bfh(w.w);
                    s += (r0 * r0 + r1 * r1) + (r2 * r2 + r3 * r3) + (r4 * r4 + r5 * r5) + (r6 * r6 + r7 * r7); }
                stage_store16x64(wid, fr, fq, wv[0], wv[1], xb + (size_t)rg * 1024 + col0, 1024);
                s += __shfl_xor(s, 16); s += __shfl_xor(s, 32); sv[m] = s; }
#pragma unroll
            for (int m = mb; m < mb + 2; ++m) if (fq == 0) SS[(size_t)(row0 + ai * HALF + m * 16 + fr) * 16 + u.pn * 4 + wc] = sv[m];
        }
    }
};
struct EpiScale {
    static constexpr bool PERM = true, AFTER_DRAIN = false, COL64 = true;
    const float* rstd; bf16_t* O; int ldc;
    __device__ __forceinline__ void operator()(const f32x4 (&acc)[2][2][4][2], const Unit& u, int wr, int wc, int fr_in, int fq_in) const {
        int lane_ = fr_in + 16 * fq_in; asm volatile("" : "+v"(lane_));
        const int fr = lane_ & 15, fq = lane_ >> 4;
        const int row0 = u.pm * BM + wr * 64, col0 = u.pn * BM + wc * 64, wid = wr * 4 + wc;
        float rsv[2][4];
#pragma unroll
        for (int ai = 0; ai < 2; ++ai)
#pragma unroll
            for (int m = 0; m < 4; ++m) rsv[ai][m] = rstd[row0 + ai * HALF + m * 16 + fr];
#pragma unroll
        for (int ai = 0; ai < 2; ++ai)
#pragma unroll
            for (int m = 0; m < 4; ++m) { const int rg = row0 + ai * HALF + m * 16; const float rs = rsv[ai][m];
                stage_store16x64(wid, fr, fq, pack8(acc[ai][0][m][0] * rs, acc[ai][0][m][1] * rs), pack8(acc[ai][1][m][0] * rs, acc[ai][1][m][1] * rs), O + (size_t)rg * ldc + col0, ldc); }
    }
};
template <class Epi, class Sched, bool ALIGN_EPI = false, bool SP2 = false>
__device__ __forceinline__ void gemm_phase(PG8_LAS unsigned char* lds, const Gemm g, const Sched& S, const Epi& E) {
    const int tid = threadIdx.x, wid = __builtin_amdgcn_readfirstlane(tid >> 6), lane = tid & 63, wr = wid >> 2, wc = wid & 3, fr = lane & 15, fq = lane >> 4;
    const int K = g.K, nt = K / BK;
    unsigned voffA[2], voffB[2];
#pragma unroll
    for (int i = 0; i < 2; ++i) { int R, C; stage_rc(tid * 16 + i * 8192, R, C); const int Rb = Epi::PERM ? ((Epi::COL64 ? 2 * (R & ~31) : (R & ~31)) + perm32(R & 31)) : R;
        voffA[i] = (unsigned)(R * K + C) * 2u; voffB[i] = (unsigned)(Rb * K + C) * 2u; }
    const size_t kstep = (size_t)(BK * 2);
    const size_t hstep = (size_t)HALF * K * 2;
    const size_t bhstep = Epi::COL64 ? (size_t)32 * K * 2 : hstep;
    const size_t tstep = 2 * hstep;
    const unsigned ldsw = (unsigned)wid * 1024u;
    const int aoff = lds_byte(wr * 64 + fr, fq * 8), boff = lds_byte(wc * 32 + fr, fq * 8);
#define PG8_SA(b, h) (((b) * 2 + (h)) * HTB)
#define PG8_SB(b, h) ((4 + (b) * 2 + (h)) * HTB)
#define PG8_STAGE(bufoff, gbase, voff) do { _Pragma("unroll") for (int _i = 0; _i < 2; ++_i) \
        __builtin_amdgcn_global_load_lds((const unsigned*)((const char*)(gbase) + (voff)[_i]), (PG8_LAS unsigned*)(lds + (bufoff) + ldsw + _i * 8192), 16, 0, 0); } while (0)
#define PG8_LDA(dst, b, h) do { _Pragma("unroll") for (int m = 0; m < 4; ++m) _Pragma("unroll") for (int k = 0; k < 2; ++k) dst[m][k] = *(const PG8_LAS bf16x8*)(lds + PG8_SA(b, h) + aoff + m * 2048 + k * 1024); } while (0)
#define PG8_LDB(dst, b, h) do { _Pragma("unroll") for (int n = 0; n < 2; ++n) _Pragma("unroll") for (int k = 0; k < 2; ++k) dst[n][k] = *(const PG8_LAS bf16x8*)(lds + PG8_SB(b, h) + boff + n * 2048 + k * 1024); } while (0)
#define PG8_MMA(ai, bj, At, Bt) do { __builtin_amdgcn_s_setprio(1); _Pragma("unroll") for (int m = 0; m < 4; ++m) _Pragma("unroll") for (int n = 0; n < 2; ++n) _Pragma("unroll") for (int k = 0; k < 2; ++k) \
        acc[ai][bj][m][n] = __builtin_amdgcn_mfma_f32_16x16x32_bf16(Bt[n][k], At[m][k], acc[ai][bj][m][n], 0, 0, 0); __builtin_amdgcn_s_setprio(0); } while (0)
#define PG8_WAIT_V(n) asm volatile("s_waitcnt vmcnt(" #n ")" ::: "memory")
#define PG8_WAIT_L(n) asm volatile("s_waitcnt lgkmcnt(" #n ")" ::: "memory")
#define PG8_BAR __builtin_amdgcn_s_barrier()
#define PG8_SCHED __builtin_amdgcn_sched_barrier(0)
    Unit cur, nxt; int ui = 0;
    if (!S.next(0, cur)) return;
    f32x4 acc[2][2][4][2];
#pragma unroll
    for (int a = 0; a < 2; ++a)
#pragma unroll
        for (int b = 0; b < 2; ++b)
#pragma unroll
            for (int m = 0; m < 4; ++m)
#pragma unroll
                for (int n = 0; n < 2; ++n) acc[a][b][m][n] = (f32x4){0.f, 0.f, 0.f, 0.f};
    bf16x8 At[4][2], B0[2][2], B1[2][2];
    const char* cA = (const char*)g.A + (size_t)cur.pm * tstep; const char* cB = (const char*)g.Bt + (size_t)cur.pn * tstep;
    S.a_ready(cur);
    if constexpr (SP2) {
        PG8_STAGE(PG8_SB(0, 0), cB, voffB); PG8_STAGE(PG8_SB(0, 1), cB + bhstep, voffB); PG8_STAGE(PG8_SA(0, 0), cA, voffA); PG8_STAGE(PG8_SA(0, 1), cA + hstep, voffA);
        if (wr == 1) PG8_BAR;
        PG8_WAIT_V(2); PG8_BAR;
        PG8_STAGE(PG8_SB(1, 0), cB + kstep, voffB); PG8_STAGE(PG8_SA(1, 0), cA + kstep, voffA); PG8_STAGE(PG8_SB(1, 1), cB + bhstep + kstep, voffB);
        PG8_WAIT_V(6); PG8_BAR;
    } else {
        PG8_STAGE(PG8_SB(0, 0), cB, voffB); PG8_STAGE(PG8_SA(0, 0), cA, voffA); PG8_STAGE(PG8_SB(0, 1), cB + bhstep, voffB); PG8_STAGE(PG8_SA(0, 1), cA + hstep, voffA);
        if (wr == 1) PG8_BAR;
        PG8_WAIT_V(4); PG8_BAR;
        PG8_STAGE(PG8_SB(1, 0), cB + kstep, voffB); PG8_STAGE(PG8_SA(1, 0), cA + kstep, voffA); PG8_STAGE(PG8_SB(1, 1), cB + bhstep + kstep, voffB);
        PG8_WAIT_V(6); PG8_BAR;
    }
    for (;;) {
        const bool has_next = S.next(ui + 1, nxt);
        const char* nA = has_next ? (const char*)g.A + (size_t)nxt.pm * tstep : cA; const char* nB = has_next ? (const char*)g.Bt + (size_t)nxt.pn * tstep : cB;
        for (int t = 0; t < nt; t += 2) {
            const bool last = (t == nt - 2);
            const char* a1 = cA + (size_t)(t + 1) * kstep;
            const char* a2 = last ? nA : cA + (size_t)(t + 2) * kstep; const char* b2 = last ? nB : cB + (size_t)(t + 2) * kstep;
            const char* a3 = a2 + kstep; const char* b3 = b2 + kstep;
            if (last && has_next) S.a_ready(nxt);
            if constexpr (SP2) {
            PG8_LDB(B0, 0, 0); PG8_LDB(B1, 0, 1); PG8_SCHED; PG8_LDA(At, 0, 0); PG8_STAGE(PG8_SA(1, 1), a1 + hstep, voffA);
            PG8_WAIT_V(8); PG8_WAIT_L(0); PG8_BAR; PG8_MMA(0, 0, At, B0); PG8_MMA(0, 1, At, B1); PG8_BAR; PG8_SCHED;
            PG8_LDA(At, 0, 1); PG8_STAGE(PG8_SB(0, 0), b2, voffB); PG8_STAGE(PG8_SB(0, 1), b2 + bhstep, voffB); PG8_STAGE(PG8_SA(0, 0), a2, voffA);
            PG8_WAIT_V(8); PG8_WAIT_L(0); PG8_BAR; PG8_MMA(1, 0, At, B0); PG8_MMA(1, 1, At, B1); PG8_BAR; PG8_SCHED;
            PG8_LDB(B0, 1, 0); PG8_LDB(B1, 1, 1); PG8_SCHED; PG8_LDA(At, 1, 0); PG8_STAGE(PG8_SA(0, 1), a2 + hstep, voffA);
            PG8_WAIT_V(8); PG8_WAIT_L(0); PG8_BAR; PG8_MMA(0, 0, At, B0); PG8_MMA(0, 1, At, B1); PG8_BAR; PG8_SCHED;
            PG8_LDA(At, 1, 1); PG8_STAGE(PG8_SB(1, 0), b3, voffB); PG8_STAGE(PG8_SB(1, 1), b3 + bhstep, voffB); PG8_STAGE(PG8_SA(1, 0), a3, voffA);
            PG8_WAIT_V(8); PG8_WAIT_L(0); PG8_BAR; PG8_MMA(1, 0, At, B0); PG8_MMA(1, 1, At, B1); PG8_BAR; PG8_SCHED;
            } else {
            PG8_LDB(B0, 0, 0); PG8_SCHED; PG8_LDA(At, 0, 0); PG8_STAGE(PG8_SA(1, 1), a1 + hstep, voffA);
            PG8_WAIT_L(8); PG8_BAR; PG8_WAIT_L(0); PG8_MMA(0, 0, At, B0); PG8_BAR; PG8_SCHED;
            PG8_LDB(B1, 0, 1); PG8_STAGE(PG8_SB(0, 0), b2, voffB);
            PG8_BAR; PG8_WAIT_L(0); PG8_MMA(0, 1, At, B1); PG8_BAR;
            PG8_LDA(At, 0, 1); PG8_STAGE(PG8_SA(0, 0), a2, voffA);
            PG8_BAR; PG8_WAIT_L(0); PG8_MMA(1, 0, At, B0); PG8_BAR; PG8_SCHED;
            PG8_STAGE(PG8_SB(0, 1), b2 + bhstep, voffB);
            PG8_WAIT_V(6); PG8_BAR; PG8_MMA(1, 1, At, B1); PG8_BAR;
            PG8_LDB(B0, 1, 0); PG8_SCHED; PG8_LDA(At, 1, 0); PG8_STAGE(PG8_SA(0, 1), a2 + hstep, voffA);
            PG8_WAIT_L(8); PG8_BAR; PG8_WAIT_L(0); PG8_MMA(0, 0, At, B0); PG8_BAR; PG8_SCHED;
            PG8_LDB(B1, 1, 1); PG8_STAGE(PG8_SB(1, 0), b3, voffB);
            PG8_BAR; PG8_WAIT_L(0); PG8_MMA(0, 1, At, B1); PG8_BAR;
            PG8_LDA(At, 1, 1); PG8_STAGE(PG8_SA(1, 0), a3, voffA);
            PG8_BAR; PG8_WAIT_L(0); PG8_MMA(1, 0, At, B0); PG8_BAR; PG8_SCHED;
            PG8_STAGE(PG8_SB(1, 1), b3 + bhstep, voffB);
            PG8_WAIT_V(6); PG8_BAR; PG8_MMA(1, 1, At, B1); PG8_BAR;
            }
        }
        if constexpr (ALIGN_EPI) { if (wr == 0) PG8_BAR; }
        if constexpr (!Epi::AFTER_DRAIN) { E(acc, cur, wr, wc, fr, fq); S.done(cur); }
        if (!has_next) break;
#pragma unroll
        for (int a = 0; a < 2; ++a)
#pragma unroll
            for (int b = 0; b < 2; ++b)
#pragma unroll
                for (int m = 0; m < 4; ++m)
#pragma unroll
                    for (int n = 0; n < 2; ++n) acc[a][b][m][n] = (f32x4){0.f, 0.f, 0.f, 0.f};
        cur = nxt; cA = nA; cB = nB; ++ui;
        if constexpr (ALIGN_EPI) { if (wr == 1) PG8_BAR; }
    }
    PG8_WAIT_V(0);
    if constexpr (!ALIGN_EPI) { if (wr == 0) PG8_BAR; }
    PG8_BAR;
    if constexpr (Epi::AFTER_DRAIN) { E.fused(acc, cur, wr, wc, fr, fq, lds, wid, lane); S.done(cur); }
#undef PG8_SA
#undef PG8_SB
#undef PG8_STAGE
#undef PG8_LDA
#undef PG8_LDB
#undef PG8_MMA
#undef PG8_WAIT_V
#undef PG8_WAIT_L
#undef PG8_BAR
#undef PG8_SCHED
}
}
#define GAS __attribute__((address_space(1)))
#define LAS __attribute__((address_space(3)))
typedef unsigned short bf16;
typedef unsigned v4u __attribute__((ext_vector_type(4)));
typedef float f32x4 __attribute__((ext_vector_type(4)));
typedef short bf16x8 __attribute__((ext_vector_type(8)));
typedef GAS unsigned gu32;
typedef GAS unsigned long long gu64;
#define RLX_AGENT __ATOMIC_RELAXED, __HIP_MEMORY_SCOPE_AGENT
#define LDS_WAIT() asm volatile("s_waitcnt lgkmcnt(0)" ::: "memory")
#define VM_WAIT() asm volatile("s_waitcnt vmcnt(0)" ::: "memory")
__device__ __forceinline__ unsigned long long rt() { return __builtin_amdgcn_s_memrealtime(); }
__device__ __forceinline__ unsigned pk2(float lo, float hi) { return (unsigned)f2bf(lo) | ((unsigned)f2bf(hi) << 16); }

#define XB_TMO      128
#define XB_XCNT(j)  (256  + 64 * (j))
#define XB_XSUB(j)  (1280 + 64 * (j))
#define XB_XGEN(j)  (2304 + 64 * (j))
#define XB_TOP      3328
#define XB_TOPGEN   3392
#define XCD_BAR_WORDS 3456
#define XB_SPIN_CAP (1u << 18)

__device__ __forceinline__ unsigned xb_ld(unsigned* p)              { return __hip_atomic_load(p, __ATOMIC_RELAXED, __HIP_MEMORY_SCOPE_AGENT); }
__device__ __forceinline__ unsigned xb_add(unsigned* p, unsigned v) { return __hip_atomic_fetch_add(p, v, __ATOMIC_RELAXED, __HIP_MEMORY_SCOPE_AGENT); }
__device__ __forceinline__ unsigned xb_xcc_id() { return (unsigned)__builtin_amdgcn_s_getreg((3 << 11) | 20) & 0xFu; }
#define XB_SPIN(cond, bar) do { unsigned _sp = 0; while (cond) { __builtin_amdgcn_s_sleep(1); \
    if ((++_sp & 255u) == 0u) { if (xb_ld(&(bar)[XB_TMO])) break; if (_sp > XB_SPIN_CAP) { atomicAdd(&(bar)[XB_TMO], 1u); break; } } } } while (0)

struct XcdBarrier {
    unsigned* bar; unsigned x;
    volatile LAS unsigned* st;
};

__device__ __forceinline__ XcdBarrier xcd_barrier_post(unsigned* bar, volatile LAS unsigned* st) {
    XcdBarrier b; b.bar = bar; b.x = xb_xcc_id(); b.st = st;
    if (threadIdx.x == 0) (void)xb_add(&bar[XB_XCNT(b.x)], 1u);
    return b;
}
__device__ __forceinline__ void xcd_barrier_complete(unsigned* bar, unsigned x, unsigned& nloc, unsigned& nx) {
    const unsigned G = gridDim.x * gridDim.y * gridDim.z;
    unsigned sum, cnt, mine, sp = 0u;
    for (;;) {
        sum = 0u; cnt = 0u; mine = 0u;
#pragma unroll
        for (unsigned j = 0; j < 16; ++j) { const unsigned c = xb_ld(&bar[XB_XCNT(j)]); sum += c; cnt += (c > 0u) ? 1u : 0u; mine = (j == x) ? c : mine; }
        if (sum == G) break;
        __builtin_amdgcn_s_sleep(1);
        if ((++sp & 255u) == 0u) { if (xb_ld(&bar[XB_TMO])) break; if (sp > XB_SPIN_CAP) { atomicAdd(&bar[XB_TMO], 1u); break; } }
    }
    nloc = mine > 0u ? mine : 1u; nx = cnt > 0u ? cnt : 1u;
}

__device__ __forceinline__ void xcd_barrier(const XcdBarrier& b) {
    asm volatile("s_waitcnt vmcnt(0)" ::: "memory");
    __syncthreads();
    if (threadIdx.x == 0) {
        unsigned* bar = b.bar;
        __builtin_amdgcn_s_waitcnt(0);
        unsigned nloc = b.st[0], nx = b.st[1];
        if (nloc == 0u) { xcd_barrier_complete(bar, b.x, nloc, nx); b.st[0] = nloc; b.st[1] = nx; }
        const unsigned old = xb_add(&bar[XB_XSUB(b.x)], 1u);
        const unsigned gen = old / nloc;
        if (old + 1u == (gen + 1u) * nloc) {
            __builtin_amdgcn_fence(__ATOMIC_RELEASE, "agent");
            asm volatile("s_waitcnt vmcnt(0)" ::: "memory");
            const unsigned og = xb_add(&bar[XB_TOP], 1u);
            const unsigned tg = og / nx;
            if (og + 1u == (tg + 1u) * nx) xb_add(&bar[XB_TOPGEN], 1u);
            else XB_SPIN(xb_ld(&bar[XB_TOPGEN]) == tg, bar);
            __builtin_amdgcn_fence(__ATOMIC_ACQUIRE, "agent");
            xb_add(&bar[XB_XGEN(b.x)], 1u);
            asm volatile("s_waitcnt vmcnt(0)" ::: "memory");
        } else {
            XB_SPIN(xb_ld(&bar[XB_XGEN(b.x)]) == gen, bar);
            __builtin_amdgcn_fence(__ATOMIC_ACQUIRE, "agent");
            asm volatile("s_waitcnt vmcnt(0)" ::: "memory");
        }
    }
    __syncthreads();
}
constexpr size_t KiB = 1024;
constexpr size_t WS_CTL = 0, CTL_ZERO_BYTES = 1 * MiB;
constexpr size_t WS_WIN = 1 * MiB, WS_WSB = 12 * MiB, WS_WGDN = 13 * MiB, WS_WMIX = 14 * MiB, WS_WCQ = 16 * MiB, WS_WCO = 18 * MiB, WS_WCKV = 20 * MiB, WS_WPQ = 24 * MiB, WS_SKB = 28 * MiB, WS_U16 = 30 * MiB, WS_V16 = 62 * MiB;
constexpr size_t WS_RSTD0 = 94 * MiB, WS_RSTD2 = 94 * MiB + 256 * KiB, WS_CD = 94 * MiB + 384 * KiB, WS_GB = 94 * MiB + 512 * KiB;
constexpr size_t WS_MN = 96 * MiB, WS_KC = 98 * MiB, WS_VC = 100 * MiB, WS_SS = 102 * MiB;
constexpr size_t WS_A0 = 104 * MiB;
constexpr size_t WS_NW = 104 * MiB, WS_QD = 136 * MiB;
constexpr size_t WS_A1 = 168 * MiB;
constexpr size_t WS_ORAW = 168 * MiB, WS_OSS = 200 * MiB, WS_OG = 232 * MiB;
constexpr size_t WS_GZ = 264 * MiB;
constexpr size_t WS_GSB = 296 * MiB, WS_GGDN = 360 * MiB;
constexpr size_t WS_KDT = 424 * MiB, WS_QK = 456 * MiB, WS_UT = 472 * MiB;
constexpr size_t WS_U8 = 30 * MiB, WS_V8 = 46 * MiB, WS_SUV = 62 * MiB;
constexpr size_t WS_PART = 344 * MiB;
constexpr size_t WS_END = 512 * MiB;
constexpr int CW_SUB = 12288;
constexpr int CW_BAR = 4096;

constexpr int NWAVES = 8;
constexpr int RING_BYTES = 131072, LDSCTL_OFF = RING_BYTES, MISC_OFF = LDSCTL_OFF + 320, LDS_BYTES = 149504;

struct Args {
    const float *x, *mem, *g_mix, *w_in, *gdn_conv, *a_log, *dt_bias, *gdn_norm_g, *w_sb_up, *w_gdn_up, *w_mix_out, *g_cross, *g_mem, *w_cq, *w_ckv, *w_co, *g_peer, *w_pq, *subkeys, *peer_u, *peer_v, *g_final;
    float* out; unsigned char* ws; int ph_lo, ph_hi, bar_region, pad;
};

struct Frame {
    LAS unsigned char* lds; int tid, lane, wave, vcu, G;
};


typedef short bf16x8_t __attribute__((ext_vector_type(8)));
typedef float f32x16_t __attribute__((ext_vector_type(16)));
typedef short v4i16_t __attribute__((ext_vector_type(4)));
typedef float f32x2v_t __attribute__((ext_vector_type(2))); typedef __bf16 bf16x2v_t __attribute__((ext_vector_type(2)));
__device__ __forceinline__ unsigned cvtpk(float lo, float hi) { f32x2v_t v = {lo, hi}; bf16x2v_t b = __builtin_convertvector(v, bf16x2v_t); return __builtin_bit_cast(unsigned, b); }
__device__ __forceinline__ v4i16_t lds_tr16(LAS unsigned char* p) { return __builtin_amdgcn_ds_read_tr16_b64_v4i16((LAS v4i16_t*)p); }

__device__ __forceinline__ void sb_phase(LAS unsigned char* wlds  , const bf16_t* SBQ, const bf16_t* SBK, const bf16_t* SBV, bf16_t* OSB, int gw, int ngw, int lane) {
    const int q = lane & 31, hi = lane >> 5;
    bf16x8_t Mf[2];
#pragma unroll
    for (int s = 0; s < 2; ++s)
#pragma unroll
        for (int j = 0; j < 8; ++j) { const int k = 16 * s + 8 * (j >> 2) + 4 * hi + (j & 3); Mf[s][j] = (k > q) ? (short)0x3F80 : (short)0; }
    const int vrow = lane >> 3, vch = lane & 7;
    const int g4 = lane >> 4, qq = (lane >> 2) & 3, p4 = lane & 3;
    LAS unsigned char* trb = wlds + (4 * (g4 >> 1) + qq) * 192 + ((g4 & 1) * 16 + 4 * p4) * 2;
    for (int item = gw; item < 32 * 256; item += ngw) {
        const int bh = item >> 8, qt = item & 255, b = bh >> 3, h = bh & 7;
        const size_t base = (size_t)b * SEQ;
        const bf16_t* Qp = SBQ + (base + qt * 32 + q) * 512 + h * 64 + 8 * hi;
        bf16x8_t Qf[4];
#pragma unroll
        for (int ks = 0; ks < 4; ++ks) Qf[ks] = *(const bf16x8_t*)(Qp + 16 * ks);
        f32x16_t o0 = {}, o1 = {};
        float carry = 0.f;
        bf16x8_t Kn[4]; v4u vn[4];
        {   const bf16_t* Kp = SBK + (base + qt * 32 + q) * 512 + h * 64 + 8 * hi;
#pragma unroll
            for (int ks = 0; ks < 4; ++ks) Kn[ks] = *(const bf16x8_t*)(Kp + 16 * ks);
#pragma unroll
            for (int i = 0; i < 4; ++i) vn[i] = *(const v4u*)(SBV + (base + qt * 32 + vrow + 8 * i) * 512 + h * 64 + vch * 8); }
        for (int kb = qt; kb >= 0; --kb) {
            bf16x8_t Kf[4]; v4u vv[4];
#pragma unroll
            for (int ks = 0; ks < 4; ++ks) Kf[ks] = Kn[ks];
#pragma unroll
            for (int i = 0; i < 4; ++i) vv[i] = vn[i];
            {   const int kn = kb > 0 ? kb - 1 : 0;
                const bf16_t* Kp = SBK + (base + kn * 32 + q) * 512 + h * 64 + 8 * hi;
#pragma unroll
                for (int ks = 0; ks < 4; ++ks) Kn[ks] = *(const bf16x8_t*)(Kp + 16 * ks);
#pragma unroll
                for (int i = 0; i < 4; ++i) vn[i] = *(const v4u*)(SBV + (base + kn * 32 + vrow + 8 * i) * 512 + h * 64 + vch * 8); }
            f32x16_t st = {};
#pragma unroll
            for (int ks = 0; ks < 4; ++ks) st = __builtin_amdgcn_mfma_f32_32x32x16_bf16(Kf[ks], Qf[ks], st, 0, 0, 0);
#pragma unroll
            for (int i = 0; i < 4; ++i) *(LAS v4u*)(wlds + (vrow + 8 * i) * 192 + vch * 16) = vv[i];
            const bool diag = (kb == qt);
            float z[16], lk[16];
#pragma unroll
            for (int r = 0; r < 16; ++r) {
                const int key = (r & 3) + 8 * (r >> 2) + 4 * hi;
                z[r] = st[r] * 0.125f;
                const float sp = fmaxf(z[r], 0.f) + __logf(1.f + __expf(-fabsf(z[r])));
                const bool valid = !diag || key < q;
                lk[r] = valid ? -sp : 0.f;
                z[r] = valid ? z[r] - sp : -INFINITY;
            }
            bf16x8_t lh[2], ll[2];
#pragma unroll
            for (int s = 0; s < 2; ++s) {
                unsigned wh[4], wl[4];
#pragma unroll
                for (int jj = 0; jj < 4; ++jj) { const float a = lk[8 * s + 2 * jj], c = lk[8 * s + 2 * jj + 1]; wh[jj] = cvtpk(a, c);
                    wl[jj] = cvtpk(a - __uint_as_float(wh[jj] << 16), c - __uint_as_float(wh[jj] & 0xffff0000u)); }
                lh[s] = __builtin_bit_cast(bf16x8_t, (v4u){wh[0], wh[1], wh[2], wh[3]}); ll[s] = __builtin_bit_cast(bf16x8_t, (v4u){wl[0], wl[1], wl[2], wl[3]});
            }
            f32x16_t af;
#pragma unroll
            for (int r = 0; r < 16; ++r) af[r] = carry;
            af = __builtin_amdgcn_mfma_f32_32x32x16_bf16(Mf[0], lh[0], af, 0, 0, 0);
            af = __builtin_amdgcn_mfma_f32_32x32x16_bf16(Mf[1], lh[1], af, 0, 0, 0);
            af = __builtin_amdgcn_mfma_f32_32x32x16_bf16(Mf[0], ll[0], af, 0, 0, 0);
            af = __builtin_amdgcn_mfma_f32_32x32x16_bf16(Mf[1], ll[1], af, 0, 0, 0);
            float tot = af[0] + lk[0];
            tot = __shfl(tot, q);
            float pr[16];
#pragma unroll
            for (int r = 0; r < 16; ++r) pr[r] = __expf(z[r] + af[r]);
            bf16x8_t pa[2];
#pragma unroll
            for (int s = 0; s < 2; ++s) pa[s] = __builtin_bit_cast(bf16x8_t, (v4u){cvtpk(pr[8 * s], pr[8 * s + 1]), cvtpk(pr[8 * s + 2], pr[8 * s + 3]), cvtpk(pr[8 * s + 4], pr[8 * s + 5]), cvtpk(pr[8 * s + 6], pr[8 * s + 7])});
            asm volatile("s_waitcnt lgkmcnt(0)" ::: "memory");
#pragma unroll
            for (int s = 0; s < 2; ++s) {
                const v4i16_t a0 = lds_tr16(trb + (16 * s) * 192), a1 = lds_tr16(trb + (16 * s + 8) * 192);
                const v4i16_t c0 = lds_tr16(trb + (16 * s) * 192 + 64), c1 = lds_tr16(trb + (16 * s + 8) * 192 + 64);
                const bf16x8_t vb0 = {a0[0], a0[1], a0[2], a0[3], a1[0], a1[1], a1[2], a1[3]}, vb1 = {c0[0], c0[1], c0[2], c0[3], c1[0], c1[1], c1[2], c1[3]};
                o0 = __builtin_amdgcn_mfma_f32_32x32x16_bf16(pa[s], vb0, o0, 0, 0, 0);
                o1 = __builtin_amdgcn_mfma_f32_32x32x16_bf16(pa[s], vb1, o1, 0, 0, 0);
            }
            carry = tot;
            if (__all(carry < -104.f)) break;
        }
        bf16_t* Op = OSB + (base + qt * 32) * 512 + h * 64 + q;
#pragma unroll
        for (int r = 0; r < 16; ++r) { const int row = (r & 3) + 8 * (r >> 2) + 4 * hi; Op[(size_t)row * 512] = f2bf(o0[r]); Op[(size_t)row * 512 + 32] = f2bf(o1[r]); }
    }
}
typedef float f32x4_t __attribute__((ext_vector_type(4)));
typedef unsigned v2u __attribute__((ext_vector_type(2)));
__device__ __forceinline__ float bflo(unsigned w) { return __uint_as_float(w << 16); }
__device__ __forceinline__ float bfhi(unsigned w) { return __uint_as_float(w & 0xffff0000u); }
__device__ __forceinline__ int frag_off(int r, int k0, int KS) { return (((r >> 4) * KS + (k0 >> 5)) << 9) + (((r & 15) + 16 * ((k0 & 15) >> 2)) << 3) + (((k0 & 31) >> 4) << 2); }

constexpr int GP_KS = 0, GP_QS = 17408, GP_VS = 34816, GP_AS = 52224, GP_WT = 69632, GP_GC = 87040, GP_BETA = 87296, GP_EGC = 87552, GP_CW = 88064, GP_TS = 94208;
constexpr int GROW = 136;

#define LDS_BARRIER() do { asm volatile("s_waitcnt lgkmcnt(0)" ::: "memory"); __builtin_amdgcn_s_barrier(); asm volatile("" ::: "memory"); } while (0)
struct GdnBufs { bf16_t *NW, *QD, *KDT, *QK, *UT; float* CD; bf16_t* ORAW; float* OSS; };

__device__ __forceinline__ void gdn_prep_phase(Frame& F, const Args& a, const bf16_t* GQKV, const float* GB, const float* GA, const GdnBufs& Gb) {
    LAS unsigned char* L = F.lds;
    LAS bf16_t* KS = (LAS bf16_t*)(L + GP_KS); LAS bf16_t* QS = (LAS bf16_t*)(L + GP_QS); LAS bf16_t* VS = (LAS bf16_t*)(L + GP_VS); LAS bf16_t* WT = (LAS bf16_t*)(L + GP_WT);
    LAS float* AS = (LAS float*)(L + GP_AS); LAS float* GC = (LAS float*)(L + GP_GC); LAS float* BETA = (LAS float*)(L + GP_BETA); LAS float* EGC = (LAS float*)(L + GP_EGC); LAS float* CW = (LAS float*)(L + GP_CW); LAS float* TS = (LAS float*)(L + GP_TS);
    const int tid = F.tid, lane = F.lane, wave = F.wave;
    const int per = (2048 + F.G - 1) / F.G;
    int hcur = -1;
    for (int ii = 0; ii < per; ++ii) {
        const int item = F.vcu * per + ii; if (item >= 2048) break;
        const int bh = item >> 7, n = item & 127, b = bh >> 2, h = bh & 3;
        const size_t t0 = (size_t)b * SEQ + n * 64;
        if (h != hcur) { hcur = h; for (int i = tid; i < 1536; i += NWAVES * 64) { const int j = i / 384, cc = i % 384; CW[i] = a.gdn_conv[j * 1536 + (cc >> 7) * 512 + h * 128 + (cc & 127)]; } }
        unsigned pf = 0u;
        if (ii + 1 < per && item + 1 < 2048 && tid < 384) {
            const int r = tid / 6, q6 = tid % 6; const int item2 = item + 1, bh2 = item2 >> 7, n2 = item2 & 127;
            pf = *(const unsigned*)(GQKV + ((size_t)(bh2 >> 2) * SEQ + n2 * 64 + r) * 1536 + (q6 >> 1) * 512 + (bh2 & 3) * 128 + (q6 & 1) * 64);
        }
        if (wave == 0) {
            const size_t t = t0 + lane;
            float g = -__expf(a.a_log[h]) * softplusf_(GA[t * 4 + h] + a.dt_bias[h]);
#pragma unroll
            for (int o = 1; o < 64; o <<= 1) { const float up = __shfl_up(g, o); if (lane >= o) g += up; }
            GC[lane] = g; BETA[lane] = sigmoidf_(GB[t * 4 + h]); EGC[lane] = __expf(g);
            if (lane == 63) Gb.CD[item] = __expf(g);
        }
        LDS_BARRIER();
        {
            const int c = tid >> 3, d0 = (tid & 7) * 16;
#pragma unroll
            for (int part = 0; part < 3; ++part) {
                float acc[16];
#pragma unroll
                for (int i = 0; i < 16; ++i) acc[i] = 0.f;
#pragma unroll
                for (int j = 0; j < 4; ++j) {
                    if (n * 64 + c - 3 + j >= 0) {
                        const bf16_t* src = GQKV + (t0 + c - 3 + j) * 1536 + part * 512 + h * 128 + d0;
                        const v4u r0 = *(const v4u*)src, r1 = *(const v4u*)(src + 8);
                        const unsigned rw[8] = {r0.x, r0.y, r0.z, r0.w, r1.x, r1.y, r1.z, r1.w};
                        const LAS float* cw = CW + j * 384 + part * 128 + d0;
#pragma unroll
                        for (int i = 0; i < 8; ++i) { acc[2 * i] += bflo(rw[i]) * cw[2 * i]; acc[2 * i + 1] += bfhi(rw[i]) * cw[2 * i + 1]; }
                    }
                }
                float ss = 0.f;
#pragma unroll
                for (int i = 0; i < 16; ++i) { acc[i] = acc[i] / (1.f + __expf(-acc[i])); ss += acc[i] * acc[i]; }
                if (part < 2) { ss += __shfl_xor(ss, 1); ss += __shfl_xor(ss, 2); ss += __shfl_xor(ss, 4); const float inv = rsqrtf(ss + EPS);
#pragma unroll
                    for (int i = 0; i < 16; ++i) acc[i] *= inv; }
                LAS bf16_t* dst = (part == 0 ? QS : part == 1 ? KS : VS) + c * GROW + d0;
                v4u w0, w1; w0.x = cvtpk(acc[0], acc[1]); w0.y = cvtpk(acc[2], acc[3]); w0.z = cvtpk(acc[4], acc[5]); w0.w = cvtpk(acc[6], acc[7]);
                w1.x = cvtpk(acc[8], acc[9]); w1.y = cvtpk(acc[10], acc[11]); w1.z = cvtpk(acc[12], acc[13]); w1.w = cvtpk(acc[14], acc[15]);
                *(LAS v4u*)dst = w0; *(LAS v4u*)(dst + 8) = w1;
            }
        }
        LDS_BARRIER();
        {
            const int fr = lane & 15, g = lane >> 4;
            for (int task = wave; task < 26; task += NWAVES) {
                const bool isKK = task < 10; int ct, mt;
                if (isKK) { ct = task >= 6 ? 3 : task >= 3 ? 2 : task >= 1 ? 1 : 0; mt = task - ct * (ct + 1) / 2; } else { ct = (task - 10) >> 2; mt = (task - 10) & 3; }
                f32x4_t acc = {0.f, 0.f, 0.f, 0.f};
                if (mt <= ct) {
                    const LAS bf16_t* Ap = KS + (mt * 16 + fr) * GROW + 8 * g; const LAS bf16_t* Bp = (isKK ? KS : QS) + (ct * 16 + fr) * GROW + 8 * g;
#pragma unroll
                    for (int ks = 0; ks < 4; ++ks) acc = __builtin_amdgcn_mfma_f32_16x16x32_bf16(*(const LAS bf16x8_t*)(Ap + 32 * ks), *(const LAS bf16x8_t*)(Bp + 32 * ks), acc, 0, 0, 0);
                }
                const int c = ct * 16 + fr, m0 = mt * 16 + 4 * g; const float gcc = GC[c];
                float v[4];
#pragma unroll
                for (int r = 0; r < 4; ++r) { const int m = m0 + r; const float dec = __expf(fminf(gcc - GC[m], 0.f)); v[r] = acc[r] * dec; }
                if (isKK) { const float bc = BETA[c];
                    f32x4_t o;
#pragma unroll
                    for (int r = 0; r < 4; ++r) o[r] = (c > m0 + r) ? v[r] * bc : 0.f;
                    *(LAS f32x4_t*)(AS + c * 68 + m0) = o;
                } else {
#pragma unroll
                    for (int r = 0; r < 4; ++r) v[r] = (c >= m0 + r) ? v[r] * 0.08838834764831845f : 0.f;
                    v2u w; w.x = cvtpk(v[0], v[1]); w.y = cvtpk(v[2], v[3]);
                    *(v2u*)(Gb.QK + (size_t)item * 4096 + (ct * 2 + (mt >> 1)) * 512 + lane * 8 + (mt & 1) * 4) = w;
                }
            }
        }
        LDS_BARRIER();
        if (wave == 0) {
            const int q4 = lane >> 4, c = lane & 15; const LAS float* Ab = AS + (16 * q4) * 68 + 16 * q4;
            float t[16];
#pragma unroll
            for (int r = 0; r < 16; ++r) { float s = (r == c) ? 1.f : 0.f;
#pragma unroll
                for (int j4 = 0; j4 < (r + 3) / 4; ++j4) { const f32x4_t av = *(const LAS f32x4_t*)(Ab + r * 68 + 4 * j4);
#pragma unroll
                    for (int i = 0; i < 4; ++i) if (4 * j4 + i < r) s -= av[i] * t[4 * j4 + i]; }
                t[r] = s; TS[(q4 * 16 + r) * 20 + c] = (r == c) ? 0.f : s; }
        }
        LDS_BARRIER();
        {
            const int fr = lane & 15, g = lane >> 4;
#pragma unroll
            for (int cc = 0; cc < 2; ++cc) {
                const int ct2 = wave * 2 + cc; const bool isW = ct2 >= 8; const int col = (ct2 & 7) * 16 + fr;
                const LAS bf16_t* src = (isW ? KS : VS) + col;
                unsigned xb[4][2];
#pragma unroll
                for (int i = 0; i < 4; ++i) {
                    f32x4_t y;
#pragma unroll
                    for (int r = 0; r < 4; ++r) { const int row = 16 * i + 4 * g + r; float v = bf2f(src[row * GROW]) * BETA[row]; if (isW) v *= EGC[row]; y[r] = v; }
#pragma unroll
                    for (int j = 0; j < i; j += 2) {
                        const LAS float* ap = AS + (16 * i + fr) * 68 + 16 * j + 4 * g;
                        const f32x4_t a0 = *(const LAS f32x4_t*)ap; f32x4_t a1 = {0.f, 0.f, 0.f, 0.f}; if (j + 1 < i) a1 = *(const LAS f32x4_t*)(ap + 16);
                        const bf16x8_t af = __builtin_bit_cast(bf16x8_t, (v4u){cvtpk(-a0[0], -a0[1]), cvtpk(-a0[2], -a0[3]), cvtpk(-a1[0], -a1[1]), cvtpk(-a1[2], -a1[3])});
                        const bf16x8_t bfr = __builtin_bit_cast(bf16x8_t, (v4u){xb[j][0], xb[j][1], (j + 1 < i) ? xb[j + 1][0] : 0u, (j + 1 < i) ? xb[j + 1][1] : 0u});
                        y = __builtin_amdgcn_mfma_f32_16x16x32_bf16(af, bfr, y, 0, 0, 0);
                    }
                    const f32x4_t tv = *(const LAS f32x4_t*)(TS + (i * 16 + fr) * 20 + 4 * g);
                    const bf16x8_t tf = __builtin_bit_cast(bf16x8_t, (v4u){cvtpk(tv[0], tv[1]), cvtpk(tv[2], tv[3]), 0u, 0u});
                    const bf16x8_t yf = __builtin_bit_cast(bf16x8_t, (v4u){cvtpk(y[0], y[1]), cvtpk(y[2], y[3]), 0u, 0u});
                    const f32x4_t x = __builtin_amdgcn_mfma_f32_16x16x32_bf16(tf, yf, y, 0, 0, 0);
                    xb[i][0] = cvtpk(x[0], x[1]); xb[i][1] = cvtpk(x[2], x[3]);
                    if (!isW) { *(v2u*)(Gb.UT + (size_t)item * 8192 + col * 64 + 16 * i + 4 * g) = (v2u){xb[i][0], xb[i][1]}; }
                    else {
#pragma unroll
                        for (int r = 0; r < 4; ++r) WT[(16 * i + 4 * g + r) * GROW + col] = f2bf(-x[r]); }
                }
            }
        }
        {
            const float glast = GC[63];
#pragma unroll
            for (int i = 0; i < 4; ++i) { const int p = tid + 512 * i, c = p >> 5, d0 = (p & 31) * 4; const v2u r = *(const LAS v2u*)(QS + c * GROW + d0); const float sc = EGC[c] * 0.08838834764831845f;
                v2u w; w.x = cvtpk(bflo(r.x) * sc, bfhi(r.x) * sc); w.y = cvtpk(bflo(r.y) * sc, bfhi(r.y) * sc);
                *(v2u*)(Gb.QD + (size_t)item * 8192 + frag_off(c, d0, 4)) = w; }
#pragma unroll
            for (int i = 0; i < 4; ++i) { const int p = tid + 512 * i, d = p >> 4, c0 = (p & 15) * 4; float v[4];
#pragma unroll
                for (int r = 0; r < 4; ++r) v[r] = bf2f(KS[(c0 + r) * GROW + d]) * __expf(glast - GC[c0 + r]);
                v2u w; w.x = cvtpk(v[0], v[1]); w.y = cvtpk(v[2], v[3]);
                *(v2u*)(Gb.KDT + (size_t)item * 8192 + frag_off(d, c0, 2)) = w; }
        }
        LDS_BARRIER();
#pragma unroll
        for (int i = 0; i < 4; ++i) { const int p = tid + 512 * i, c = p >> 5, d0 = (p & 31) * 4; const v2u r = *(const LAS v2u*)(WT + c * GROW + d0);
            *(v2u*)(Gb.NW + (size_t)item * 8192 + frag_off(c, d0, 4)) = r; }
        asm volatile("" :: "v"(pf));
        LDS_BARRIER();
    }
}

__device__ __forceinline__ void gdn_scan_unit(Frame& F, int s, const GdnBufs& Gb) {
    const int bh = s >> 2, half = s & 3, h = bh & 3, b = bh >> 2;
    const int tid = F.tid, lane = F.lane, wave = F.wave, fr = lane & 15, g = lane >> 4;
    LAS unsigned char* L = F.lds;
    const size_t tb = (size_t)b * SEQ;
    const int item0 = bh * 128;
    const int lt = tid - 256;
#define GDN_SRC(it, i) ((i) < 4 ? (const v4u*)(Gb.NW + (size_t)(it) * 8192) + lt + 256 * (i) : (i) < 8 ? (const v4u*)(Gb.QD + (size_t)(it) * 8192) + lt + 256 * ((i) - 4) : \
                        (i) < 12 ? (const v4u*)(Gb.KDT + (size_t)(it) * 8192) + lt + 256 * ((i) - 8) : (i) < 14 ? (const v4u*)(Gb.QK + (size_t)(it) * 4096) + lt + 256 * ((i) - 12) : \
                        (const v4u*)(Gb.UT + (size_t)(it) * 8192 + half * 2048) + lt + 256 * ((i) - 14))
#define GDN_LOADR(R, it) do { _Pragma("unroll") for (int i_ = 0; i_ < 15; ++i_) R[i_] = *GDN_SRC(it, i_); } while (0)
#define GDN_STORER(R, bufp) do { _Pragma("unroll") for (int i_ = 0; i_ < 15; ++i_) *(LAS v4u*)((bufp) + (i_ * 256 + lt) * 16) = R[i_]; } while (0)
    LAS float* CDL = (LAS float*)(L + 131072 + 1024);
    LAS bf16_t* OTB = (LAS bf16_t*)(L + 131072 + 2048);
#define GDN_OSTORE(step) do { if (wave < 6 && (step) < 128) { const LAS bf16_t* ot_ = OTB + ((wave - 4) * 2 + ((step) & 1)) * 1024; \
        const v4u o0_ = *(const LAS v4u*)(ot_ + lane * 16), o1_ = *(const LAS v4u*)(ot_ + lane * 16 + 8); \
        bf16_t* dst_ = Gb.ORAW + (tb + (size_t)(step) * 64 + lane) * 512 + h * 128 + half * 32 + (wave - 4) * 16; *(v4u*)dst_ = o0_; *(v4u*)(dst_ + 8) = o1_; } } while (0)
    if (wave >= 4) {
        if (wave == 4) { CDL[lane] = Gb.CD[item0 + lane]; CDL[64 + lane] = Gb.CD[item0 + 64 + lane]; }
        v4u r0[15], r1[15], r2[15];
        GDN_LOADR(r0, item0); GDN_LOADR(r1, item0 + 1); GDN_LOADR(r2, item0 + 2);
        GDN_STORER(r0, L);
        LDS_BARRIER();
#define GDN_CL(k) (item0 + ((k) < 127 ? (k) : 127))
        for (int n = 0; n < 129; n += 3) {
            GDN_LOADR(r0, GDN_CL(n + 3)); GDN_STORER(r1, L + ((n + 1) & 1) * 65536); LDS_BARRIER(); GDN_OSTORE(n);
            GDN_LOADR(r1, GDN_CL(n + 4)); GDN_STORER(r2, L + ((n + 2) & 1) * 65536); LDS_BARRIER(); GDN_OSTORE(n + 1);
            GDN_LOADR(r2, GDN_CL(n + 5)); GDN_STORER(r0, L + ((n + 3) & 1) * 65536); LDS_BARRIER(); GDN_OSTORE(n + 2);
        }
#undef GDN_CL
    } else if (wave >= 2) {
        for (int n = 0; n < 130; ++n) LDS_BARRIER();
    } else {
        LDS_BARRIER();
        f32x4_t S[8];
#pragma unroll
        for (int i = 0; i < 8; ++i) S[i] = (f32x4_t){0.f, 0.f, 0.f, 0.f};
        for (int n = 0; n < 128; ++n) {
            LAS unsigned char* B = L + (n & 1) * 65536;
            const float cd = CDL[n];
            bf16x8_t sb[4];
#pragma unroll
            for (int ks = 0; ks < 4; ++ks) sb[ks] = __builtin_bit_cast(bf16x8_t, (v4u){cvtpk(S[2 * ks][0], S[2 * ks][1]), cvtpk(S[2 * ks][2], S[2 * ks][3]), cvtpk(S[2 * ks + 1][0], S[2 * ks + 1][1]), cvtpk(S[2 * ks + 1][2], S[2 * ks + 1][3])});
#define GDN_SB() __builtin_amdgcn_sched_barrier(0)
            const LAS unsigned char* Bl = B + lane * 16;
            v2u u8[4]; bf16x8_t fa[16], fb[16];
#pragma unroll
            for (int rt = 0; rt < 4; ++rt) u8[rt] = *(const LAS v2u*)(B + 57344 + ((wave * 16 + fr) * 64 + 16 * rt + 4 * g) * 2);
#pragma unroll
            for (int i = 0; i < 16; ++i) fa[i] = *(const LAS bf16x8_t*)(Bl + ((i & 3) * 4 + (i >> 2)) * 1024);
            GDN_SB();
#pragma unroll
            for (int i = 0; i < 16; ++i) fb[i] = *(const LAS bf16x8_t*)(Bl + 16384 + ((i & 3) * 4 + (i >> 2)) * 1024);
            GDN_SB();
            f32x4_t va[4], oa[4];
#pragma unroll
            for (int rt = 0; rt < 4; ++rt) { va[rt] = (f32x4_t){bflo(u8[rt].x), bfhi(u8[rt].x), bflo(u8[rt].y), bfhi(u8[rt].y)}; oa[rt] = (f32x4_t){0.f, 0.f, 0.f, 0.f}; }
#pragma unroll
            for (int i = 0; i < 16; ++i) va[i & 3] = __builtin_amdgcn_mfma_f32_16x16x32_bf16(fa[i], sb[i >> 2], va[i & 3], 0, 0, 0);
            GDN_SB();
#pragma unroll
            for (int i = 0; i < 8; ++i) fa[i] = *(const LAS bf16x8_t*)(Bl + 49152 + ((i & 3) * 2 + (i >> 2)) * 1024);
#pragma unroll
            for (int i = 0; i < 8; ++i) fa[8 + i] = *(const LAS bf16x8_t*)(Bl + 32768 + ((i & 3) * 2 + (i >> 2)) * 1024);
            GDN_SB();
#pragma unroll
            for (int i = 0; i < 16; ++i) oa[i & 3] = __builtin_amdgcn_mfma_f32_16x16x32_bf16(fb[i], sb[i >> 2], oa[i & 3], 0, 0, 0);
            bf16x8_t vb[2];
#pragma unroll
            for (int k2 = 0; k2 < 2; ++k2) vb[k2] = __builtin_bit_cast(bf16x8_t, (v4u){cvtpk(va[2 * k2][0], va[2 * k2][1]), cvtpk(va[2 * k2][2], va[2 * k2][3]), cvtpk(va[2 * k2 + 1][0], va[2 * k2 + 1][1]), cvtpk(va[2 * k2 + 1][2], va[2 * k2 + 1][3])});
#pragma unroll
            for (int dt = 0; dt < 8; ++dt) S[dt] = S[dt] * cd;
            GDN_SB();
#pragma unroll
            for (int i = 0; i < 8; ++i) fb[i] = *(const LAS bf16x8_t*)(Bl + 32768 + 8192 + ((i & 3) * 2 + (i >> 2)) * 1024);
            GDN_SB();
#pragma unroll
            for (int i = 0; i < 8; ++i) oa[i & 3] = __builtin_amdgcn_mfma_f32_16x16x32_bf16(fa[i], vb[i >> 2], oa[i & 3], 0, 0, 0);
#pragma unroll
            for (int i = 0; i < 8; ++i) S[i & 3] = __builtin_amdgcn_mfma_f32_16x16x32_bf16(fa[8 + i], vb[i >> 2], S[i & 3], 0, 0, 0);
            GDN_SB();
#pragma unroll
            for (int i = 0; i < 8; ++i) S[4 + (i & 3)] = __builtin_amdgcn_mfma_f32_16x16x32_bf16(fb[i], vb[i >> 2], S[4 + (i & 3)], 0, 0, 0);
            GDN_SB();
#undef GDN_SB
            { LAS bf16_t* OT = OTB + (wave * 2 + (n & 1)) * 1024;
#pragma unroll
              for (int rt = 0; rt < 4; ++rt)
#pragma unroll
                for (int r = 0; r < 4; ++r) OT[(16 * rt + 4 * g + r) * 16 + fr] = f2bf(oa[rt][r]); }
            LDS_BARRIER();
        }
        LDS_BARRIER();
    }
#undef GDN_SRC
#undef GDN_LOADR
#undef GDN_OSTORE
#undef GDN_STORER
}

__device__ __forceinline__ void gdn_finish_phase(Frame& F, const Args& a, const GdnBufs& Gb, const bf16_t* GZ, bf16_t* OG) {
    const int gt = F.vcu * NWAVES * 64 + F.tid, ngt = F.G * NWAVES * 64;
    for (int p = gt; p < T * 64; p += ngt) {
        const size_t t = (size_t)(p >> 6); const int col = (p & 63) * 8, e0 = col & 127;
        const v4u o = *(const v4u*)(Gb.ORAW + t * 512 + col), z = *(const v4u*)(GZ + t * 512 + col);
        const unsigned ow[4] = {o.x, o.y, o.z, o.w}, zw[4] = {z.x, z.y, z.z, z.w};
        float ss = 0.f;
#pragma unroll
        for (int i = 0; i < 4; ++i) { const float a0 = bflo(ow[i]), a1 = bfhi(ow[i]); ss += a0 * a0 + a1 * a1; }
        ss += __shfl_xor(ss, 1); ss += __shfl_xor(ss, 2); ss += __shfl_xor(ss, 4); ss += __shfl_xor(ss, 8);
        const float rinv = rsqrtf(ss * (1.f / 128.f) + EPS);
        const f32x4_t g0 = *(const f32x4_t*)(a.gdn_norm_g + e0), g1 = *(const f32x4_t*)(a.gdn_norm_g + e0 + 4);
        const float gg[8] = {g0[0], g0[1], g0[2], g0[3], g1[0], g1[1], g1[2], g1[3]};
        unsigned r[4];
#pragma unroll
        for (int i = 0; i < 4; ++i) { const float z0 = bflo(zw[i]), z1 = bfhi(zw[i]);
            r[i] = cvtpk(bflo(ow[i]) * rinv * gg[2 * i] * (z0 / (1.f + __expf(-z0))), bfhi(ow[i]) * rinv * gg[2 * i + 1] * (z1 / (1.f + __expf(-z1)))); }
        *(v4u*)(OG + t * 512 + col) = (v4u){r[0], r[1], r[2], r[3]};
    }
}
typedef float f32x2_t __attribute__((ext_vector_type(2)));
__device__ __forceinline__ float gelu_erf(float v) { return 0.5f * v * (1.f + erff(v * 0.70710678118654752f)); }
constexpr int PEER_CH = 16;
constexpr int CW_PEERU = 8192, CW_PEERV = 8192 + 1024;

typedef int v2i_t __attribute__((ext_vector_type(2)));
#define PEER_SWZ(V, JP) __builtin_amdgcn_ds_swizzle((V), 0x18 | ((JP) << 5))
#define PEER_SHUF(EN, ER) do { EN[0] = PEER_SWZ(ER.x, 0); EN[1] = PEER_SWZ(ER.y, 0); EN[2] = PEER_SWZ(ER.x, 1); EN[3] = PEER_SWZ(ER.y, 1); EN[4] = PEER_SWZ(ER.x, 2); EN[5] = PEER_SWZ(ER.y, 2); EN[6] = PEER_SWZ(ER.x, 3); EN[7] = PEER_SWZ(ER.y, 3); EN[8] = PEER_SWZ(ER.x, 4); EN[9] = PEER_SWZ(ER.y, 4); EN[10] = PEER_SWZ(ER.x, 5); EN[11] = PEER_SWZ(ER.y, 5); EN[12] = PEER_SWZ(ER.x, 6); EN[13] = PEER_SWZ(ER.y, 6); EN[14] = PEER_SWZ(ER.x, 7); EN[15] = PEER_SWZ(ER.y, 7); } while (0)
#define PEER_LDIDX(TOK) (*(const v2i_t*)(EIDX + (size_t)(TOK) * 128 + 2 * lane))
template <int CTRL> __device__ __forceinline__ int dpp_i(int v) { return __builtin_amdgcn_update_dpp(0, v, CTRL, 0xf, 0xf, false); }
template <int CTRL> __device__ __forceinline__ float dpp_f(float v) { return __builtin_bit_cast(float, __builtin_amdgcn_update_dpp(0, __builtin_bit_cast(int, v), CTRL, 0xf, 0xf, false)); }
constexpr int DPP_X1 = 0xB1, DPP_X2 = 0x4E, DPP_HM = 0x141;
#define PEER_U_COMPUTE(W, TOK, XR, RS) do { const size_t t_ = (TOK); \
        float xf[32]; \
        _Pragma("unroll") for (int q = 0; q < 4; ++q) { const unsigned xw_[4] = {XR[q].x, XR[q].y, XR[q].z, XR[q].w}; \
            _Pragma("unroll") for (int c = 0; c < 4; ++c) { xf[8 * q + 2 * c] = bflo(xw_[c]); xf[8 * q + 2 * c + 1] = bfhi(xw_[c]); } } \
        float am = 0.f; \
        _Pragma("unroll") for (int q = 0; q < 32; q += 2) am = fmaxf(am, fmaxf(fabsf(xf[q]), fabsf(xf[q + 1]))); \
        am = fmaxf(am, dpp_f<DPP_X1>(am)); am = fmaxf(am, dpp_f<DPP_X2>(am)); am = fmaxf(am, dpp_f<DPP_HM>(am)); \
        const float sx = am > 0.f ? 127.f * __builtin_amdgcn_rcpf(am) : 0.f, mo = am * (1.f / (127.f * 16.f)) * (RS); \
        int xq[8]; \
        _Pragma("unroll") for (int d = 0; d < 8; ++d) { \
            const unsigned b0 = __builtin_bit_cast(unsigned, fmaf(xf[4 * d], sx, 12582912.f)), b1 = __builtin_bit_cast(unsigned, fmaf(xf[4 * d + 1], sx, 12582912.f)); \
            const unsigned b2 = __builtin_bit_cast(unsigned, fmaf(xf[4 * d + 2], sx, 12582912.f)), b3 = __builtin_bit_cast(unsigned, fmaf(xf[4 * d + 3], sx, 12582912.f)); \
            xq[d] = (int)(__builtin_amdgcn_perm(b1, b0, 0x0c0c0400u) | __builtin_amdgcn_perm(b3, b2, 0x04000c0cu)); } \
        int sl_ = __builtin_amdgcn_sdot4(0x01010101, xq[0], 0, false); sl_ = __builtin_amdgcn_sdot4(0x01010101, xq[2], sl_, false); sl_ = __builtin_amdgcn_sdot4(0x01010101, xq[4], sl_, false); sl_ = __builtin_amdgcn_sdot4(0x01010101, xq[6], sl_, false); \
        const int c0_ = -8 * sl_; \
        int p[16]; \
        _Pragma("unroll") for (int i = 0; i < 16; ++i) { const unsigned ww[4] = {W[i].x, W[i].y, W[i].z, W[i].w}; int ah = 0, al = c0_; \
            _Pragma("unroll") for (int d = 0; d < 4; ++d) { ah = __builtin_amdgcn_sdot4((int)(ww[d] & 0xF0F0F0F0u), xq[2 * d + 1], ah, false); al = __builtin_amdgcn_sdot4((int)(ww[d] & 0x0F0F0F0Fu), xq[2 * d], al, false); } \
            p[i] = ah + 16 * al; } \
        _Pragma("unroll") for (int i = 0; i < 8; ++i) { const int lo = p[i], hi = p[i + 8]; p[i] = (up4 ? hi : lo) + dpp_i<DPP_HM>(up4 ? lo : hi); } \
        _Pragma("unroll") for (int i = 0; i < 4; ++i) { const int lo = p[i], hi = p[i + 4]; p[i] = (up2 ? hi : lo) + dpp_i<DPP_X2>(up2 ? lo : hi); } \
        _Pragma("unroll") for (int i = 0; i < 2; ++i) { const int lo = p[i], hi = p[i + 2]; p[i] = (up1 ? hi : lo) + dpp_i<DPP_X1>(up1 ? lo : hi); } \
        *(unsigned*)(PART + ((size_t)x * T + t_) * 128 + 2 * lane) = cvtpk((float)p[0] * mo, (float)p[1] * mo); } while (0)
#define PEER_LDX(XR, TOK) do { const v4u* xp_ = (const v4u*)(Xx + (size_t)(TOK) * 1024); XR[0] = xp_[0]; XR[1] = xp_[1]; XR[2] = xp_[2]; XR[3] = xp_[3]; } while (0)
#define PEER_GATHER(W, EN, BASE) do { _Pragma("unroll") for (int i = 0; i < 16; ++i) W[i] = *(const v4u*)((BASE) + (unsigned)((unsigned)EN[i] * 128u + lo16)); } while (0)
__device__ __forceinline__ void peer_u_phase(Frame& F, const Args& a, gu32* ctl, const bf16_t* X2B, const float* rstd2, const int* EIDX, const unsigned char* U8, bf16_t* PART) {
    const int lane = F.lane, j = lane & 7; const unsigned lo16 = 16u * (unsigned)j;
    const bool up4 = (j & 4) != 0, up2 = (j & 2) != 0, up1 = (j & 1) != 0;
    const int x0 = (int)(xb_xcc_id() & 7u);
    for (int s = 0; s < 4; ++s) {
        const int x = (x0 + s) & 3;
        const unsigned char* Ux = U8 + (size_t)x * 16384 * 128;
        const bf16_t* Xx = X2B + 256 * x + 32 * j;
        for (;;) {
            int c = 0; if (lane == 0) c = (int)__hip_atomic_fetch_add(ctl + CW_PEERU + 64 * x, 1u, __ATOMIC_RELAXED, __HIP_MEMORY_SCOPE_AGENT);
            c = __builtin_amdgcn_readfirstlane(c);
            if (c >= T / PEER_CH) break;
            const size_t tc = (size_t)c * PEER_CH, tl = tc + PEER_CH - 1;
            int en[16]; v4u wa[16], wb[16], xa[4], xb[4];
            v2i_t er = PEER_LDIDX(tc);
            PEER_LDX(xa, tc); float rsa = rstd2[tc], rsb;
            PEER_SHUF(en, er);
            PEER_GATHER(wa, en, Ux);
            er = PEER_LDIDX(tc + 1);
            for (int tt = 0; tt < PEER_CH; tt += 2) {
                const size_t t = tc + tt, t2 = (t + 2 < tl) ? t + 2 : tl, t3 = (t + 3 < tl) ? t + 3 : tl;
                PEER_SHUF(en, er);
                PEER_GATHER(wb, en, Ux);
                er = PEER_LDIDX(t2);
                PEER_LDX(xb, t + 1); rsb = rstd2[t + 1];
                PEER_U_COMPUTE(wa, t, xa, rsa);
                PEER_SHUF(en, er);
                PEER_GATHER(wa, en, Ux);
                er = PEER_LDIDX(t3);
                PEER_LDX(xa, t2); rsa = rstd2[t2];
                PEER_U_COMPUTE(wb, t + 1, xb, rsb);
            }
        }
    }
}
__device__ __forceinline__ unsigned fp4_code(float v, float& q) {
    const float a = fabsf(v); const int idx = (a >= 0.25f) + (a >= 0.75f) + (a >= 1.25f) + (a >= 1.75f) + (a >= 2.5f) + (a >= 3.5f) + (a >= 5.f);
    const float mg = idx < 4 ? 0.5f * (float)idx : (idx < 6 ? (float)(idx - 2) : (idx == 6 ? 4.f : 6.f)); q = v < 0.f ? -mg : mg; return (unsigned)idx | (v < 0.f ? 8u : 0u);
}
__device__ __forceinline__ void peer_combine_phase(Frame& F, const bf16_t* PART, const int* EIDX, const float* EGATE, const float* SU, const float* SV, unsigned char* ACT4, float* ASC) {
    const int gt = F.vcu * NWAVES * 64 + F.tid, ngt = F.G * NWAVES * 64;
    for (int p = gt; p < T * 32; p += ngt) {
        f32x4_t s = {0.f, 0.f, 0.f, 0.f};
#pragma unroll
        for (int x = 0; x < 4; ++x) { const v2u w = *(const v2u*)(PART + (size_t)x * T * 128 + (size_t)p * 4); s += (f32x4_t){bflo(w.x), bfhi(w.x), bflo(w.y), bfhi(w.y)}; }
        const int4 e = *(const int4*)(EIDX + (size_t)p * 4); const f32x4_t gt4 = *(const f32x4_t*)(EGATE + (size_t)p * 4);
        float av[4] = {gelu_erf(s[0] * SU[e.x]) * gt4[0] * SV[e.x], gelu_erf(s[1] * SU[e.y]) * gt4[1] * SV[e.y], gelu_erf(s[2] * SU[e.z]) * gt4[2] * SV[e.z], gelu_erf(s[3] * SU[e.w]) * gt4[3] * SV[e.w]};
        float m = fmaxf(fmaxf(fabsf(av[0]), fabsf(av[1])), fmaxf(fabsf(av[2]), fabsf(av[3])));
        m = fmaxf(m, dpp_f<DPP_X1>(m)); m = fmaxf(m, dpp_f<DPP_X2>(m)); m = fmaxf(m, dpp_f<DPP_HM>(m)); m = fmaxf(m, dpp_f<0x140>(m));
        m = fmaxf(m, __builtin_bit_cast(float, __builtin_amdgcn_ds_swizzle(__builtin_bit_cast(int, m), 0x401F)));
        const float sc = m > 0.f ? 6.f / m : 0.f;
        unsigned st[4] = {0u, 0u, 0u, 0u};
#pragma unroll
        for (int c = 0; c < 4; ++c) { float y = av[c] * sc, q;
            st[0] |= fp4_code(y, q) << (4 * c); y = (y - q) * 4.f;
            st[1] |= fp4_code(y, q) << (4 * c); y = (y - q) * 8.f;
            st[2] |= fp4_code(y, q) << (4 * c); y = (y - q) * 8.f;
            st[3] |= fp4_code(y, q) << (4 * c); }
        const size_t t = (size_t)(p >> 5); const int kb2 = (p & 31) * 2;
#pragma unroll
        for (int g = 0; g < 4; ++g) *(unsigned short*)(ACT4 + t * 256 + 64 * g + kb2) = (unsigned short)st[g];
        if ((p & 31) == 0) ASC[t] = m * (1.f / 6.f);
    }
}
typedef int v8i_t __attribute__((ext_vector_type(8)));
__device__ __forceinline__ v8i_t ld_a4(const unsigned char* p) { const v4u w = *(const v4u*)p; return (v8i_t){(int)w.x, (int)w.y, (int)w.z, (int)w.w, 0, 0, 0, 0}; }
__device__ __forceinline__ v2i_t lds_tr4(LAS unsigned char* p) { return __builtin_amdgcn_ds_read_tr4_b64_v2i32((LAS v2i_t*)p); }
__device__ __forceinline__ float row_sum_dpp(float v) { v += dpp_f<DPP_X1>(v); v += dpp_f<DPP_X2>(v); v += dpp_f<DPP_HM>(v); v += dpp_f<0x140>(v); return v; }
#define PEER_V_COMPUTE(W, TOK, AOP, XR0, XR1, ASCV) do { const size_t t_ = (TOK); \
        _Pragma("unroll") for (int i = 0; i < 16; ++i) *(LAS v4u*)(wimg + 128 * i + 16 * (j ^ (i & 7))) = W[i]; \
        asm volatile("" ::: "memory"); \
        float val[16]; \
        _Pragma("unroll") for (int cb = 0; cb < 16; ++cb) { \
            const v2i_t t0_ = lds_tr4(rimg + 16 * ((cb >> 1) ^ r7) + 8 * (cb & 1)), t1_ = lds_tr4(rimg + 2048 + 16 * ((cb >> 1) ^ r7) + 8 * (cb & 1)); \
            const int b0_ = t0_.x, b1_ = t0_.y, b2_ = t1_.x, b3_ = t1_.y; const v8i_t bb_ = {b0_, b1_, b2_, b3_, 0, 0, 0, 0}; \
            const f32x4_t c_ = __builtin_amdgcn_mfma_scale_f32_16x16x128_f8f6f4(AOP, bb_, (f32x4_t){0.f, 0.f, 0.f, 0.f}, 4, 4, 0, 0x7f7f7f7f, 0, 0x7f7f7f7f); \
            val[cb] = (c_[0] + c_[1] * 0.25f) + (c_[2] * 0.03125f + c_[3] * 0.00390625f); } \
        asm volatile("" ::: "memory"); \
        const float as_ = (ASCV); const unsigned xw_[8] = {XR0.x, XR0.y, XR0.z, XR0.w, XR1.x, XR1.y, XR1.z, XR1.w}; unsigned ow_[8]; float ss = 0.f; \
        _Pragma("unroll") for (int q = 0; q < 8; ++q) { ow_[q] = cvtpk(fmaf(val[2 * q], as_, bflo(xw_[q])), fmaf(val[2 * q + 1], as_, bfhi(xw_[q]))); const float r0 = bflo(ow_[q]), r1 = bfhi(ow_[q]); ss += r0 * r0 + r1 * r1; } \
        ss = row_sum_dpp(ss); \
        if (lane < 16) { bf16_t* dst = X3B + t_ * 1024 + 256 * x + 16 * lane; *(v4u*)dst = (v4u){ow_[0], ow_[1], ow_[2], ow_[3]}; *(v4u*)(dst + 8) = (v4u){ow_[4], ow_[5], ow_[6], ow_[7]}; if (lane == 0) SS3[t_ * 4 + x] = ss; } } while (0)
__device__ __forceinline__ void peer_v_phase(Frame& F, gu32* ctl, const int* EIDX, const unsigned char* ACT8, const float* ASC, const unsigned char* V8, const bf16_t* X2B, bf16_t* X3B, float* SS3) {
    const int lane = F.lane, g = lane >> 3, j = lane & 7, r7 = lane & 7; const unsigned lo16 = 16u * (unsigned)j;
    LAS unsigned char* wimg = F.lds + F.wave * 16384 + 2048 * g;
    LAS unsigned char* rimg = F.lds + F.wave * 16384 + 4096 * (lane >> 4) + 128 * (lane & 15);
    const int x0 = (int)(xb_xcc_id() & 7u);
    for (int s = 0; s < 4; ++s) {
        const int x = (x0 + s) & 3;
        const unsigned char* Vx = V8 + (size_t)x * 16384 * 128;
        const bf16_t* Xx = X2B + 256 * x + 16 * (lane & 15);
        const unsigned char* Ax = ACT8 + 64 * (lane & 3) + 16 * (lane >> 4);
        for (;;) {
            int c = 0; if (lane == 0) c = (int)__hip_atomic_fetch_add(ctl + CW_PEERV + 64 * x, 1u, __ATOMIC_RELAXED, __HIP_MEMORY_SCOPE_AGENT);
            c = __builtin_amdgcn_readfirstlane(c);
            if (c >= T / PEER_CH) break;
            const size_t tc = (size_t)c * PEER_CH, tl = tc + PEER_CH - 1;
            int en[16]; v4u wa[16], wb[16];
            v2i_t er = PEER_LDIDX(tc);
            v8i_t aa = ld_a4(Ax + tc * 256), ab; v4u xa0 = *(const v4u*)(Xx + tc * 1024), xa1 = *(const v4u*)(Xx + tc * 1024 + 8), xb0, xb1; float sa = ASC[tc], sb;
            PEER_SHUF(en, er);
            PEER_GATHER(wa, en, Vx);
            er = PEER_LDIDX(tc + 1);
            for (int tt = 0; tt < PEER_CH; tt += 2) {
                const size_t t = tc + tt, t2 = (t + 2 < tl) ? t + 2 : tl, t3 = (t + 3 < tl) ? t + 3 : tl;
                PEER_SHUF(en, er);
                PEER_GATHER(wb, en, Vx);
                er = PEER_LDIDX(t2);
                ab = ld_a4(Ax + (t + 1) * 256); xb0 = *(const v4u*)(Xx + (t + 1) * 1024); xb1 = *(const v4u*)(Xx + (t + 1) * 1024 + 8); sb = ASC[t + 1];
                PEER_V_COMPUTE(wa, t, aa, xa0, xa1, sa);
                PEER_SHUF(en, er);
                PEER_GATHER(wa, en, Vx);
                er = PEER_LDIDX(t3);
                aa = ld_a4(Ax + t2 * 256); xa0 = *(const v4u*)(Xx + t2 * 1024); xa1 = *(const v4u*)(Xx + t2 * 1024 + 8); sa = ASC[t2];
                PEER_V_COMPUTE(wb, t + 1, ab, xb0, xb1, sb);
            }
        }
    }
}
__device__ __forceinline__ void peer_norm_phase(Frame& F, const Args& a, const float* SS3, const bf16_t* X3B, float* out) {
    const int gt = F.vcu * NWAVES * 64 + F.tid, ngt = F.G * NWAVES * 64;
    for (int p = gt; p < T * 128; p += ngt) {
        const size_t t = (size_t)(p >> 7); const int c = (p & 127) * 8;
        const f32x4_t s0 = *(const f32x4_t*)(SS3 + t * 4);
        const float r3 = rsqrtf(((s0[0] + s0[1]) + (s0[2] + s0[3])) * (1.f / D) + EPS);
        const v4u w = *(const v4u*)(X3B + t * 1024 + c);
        const f32x4_t g0 = *(const f32x4_t*)(a.g_final + c), g1 = *(const f32x4_t*)(a.g_final + c + 4);
        *(f32x4_t*)(out + t * 1024 + c) = (f32x4_t){bflo(w.x), bfhi(w.x), bflo(w.y), bfhi(w.y)} * g0 * r3;
        *(f32x4_t*)(out + t * 1024 + c + 4) = (f32x4_t){bflo(w.z), bfhi(w.z), bflo(w.w), bfhi(w.w)} * g1 * r3;
    }
}
#ifndef TOPK_HD
#define TOPK_HD __device__ __forceinline__
#endif
TOPK_HD void ce_desc(unsigned& a, unsigned& b) { const unsigned hi = a > b ? a : b, lo = a > b ? b : a; a = hi; b = lo; }
TOPK_HD void sort16_desc(unsigned (&v)[16]) {
#pragma unroll
    for (int k = 2; k <= 16; k <<= 1)
#pragma unroll
        for (int j = k >> 1; j >= 1; j >>= 1)
#pragma unroll
            for (int i = 0; i < 16; ++i) { const int l = i ^ j; if (l > i) { if ((i & k) == 0) ce_desc(v[i], v[l]); else ce_desc(v[l], v[i]); } }
}
TOPK_HD void bitonic_merge16_desc(unsigned (&v)[16]) {
#pragma unroll
    for (int j = 8; j >= 1; j >>= 1)
#pragma unroll
        for (int i = 0; i < 16; ++i) { const int l = i ^ j; if (l > i) ce_desc(v[i], v[l]); }
}
TOPK_HD void top16_merge(unsigned (&a)[16], const unsigned (&b)[16]) {
#pragma unroll
    for (int i = 0; i < 16; ++i) a[i] = a[i] > b[15 - i] ? a[i] : b[15 - i];
    bitonic_merge16_desc(a);
}
TOPK_HD unsigned f2ord(float f) { const unsigned u = __builtin_bit_cast(unsigned, f); return (u & 0x80000000u) ? ~u : (u | 0x80000000u); }
TOPK_HD float ord2f(unsigned o) { const unsigned u = (o & 0x80000000u) ? (o & 0x7fffffffu) : ~o; return __builtin_bit_cast(float, u); }

__device__ __forceinline__ void peer_route_task(Frame& F, const bf16_t* PQ, const bf16_t* SK16, int* EIDX, float* EGATE, int tt, int h) {
    constexpr int CI[50] = {0,0,0,0,0,0,0,0,0,0,0,0,0,0,0,0,1,1,1,1,1,1,1,1,2,2,2,2,2,3,3,3,3,4,4,4,5,5,6,6,7,7,8,9,10,11,12,13,14,15};
    constexpr int CJ[50] = {0,1,2,3,4,5,6,7,8,9,10,11,12,13,14,15,0,1,2,3,4,5,6,7,0,1,2,3,4,0,1,2,3,0,1,2,0,1,0,1,0,1,0,0,0,0,0,0,0,0};
    int lane = F.lane; asm volatile("" : "+v"(lane));
    const int t = lane & 31, hi = lane >> 5;
    LAS unsigned* wl = (LAS unsigned*)(F.lds + 65536 + F.wave * 8192) + lane;
    {
        const size_t row = (size_t)tt * 32 + t;
        unsigned L[2][16];
#pragma unroll
        for (int p = 0; p < 2; ++p) {
            const int hp = h * 2 + p;
            bf16x8_t Bf[8];
#pragma unroll
            for (int ks = 0; ks < 8; ++ks) Bf[ks] = *(const bf16x8_t*)(PQ + row * 2048 + hp * 128 + 16 * ks + 8 * hi);
#pragma unroll
            for (int i = 0; i < 16; ++i) L[p][i] = 0u;
#pragma unroll 1
            for (int nt = 0; nt < 4; ++nt) {
                const int srow = p * 128 + 32 * nt + t;
                bf16x8_t Ac[8];
#pragma unroll
                for (int ks = 0; ks < 8; ++ks) Ac[ks] = *(const LAS bf16x8_t*)(F.lds + srow * 256 + (((2 * ks + hi) ^ (srow & 15)) << 4));
                f32x16_t acc = {};
#pragma unroll
                for (int ks = 0; ks < 8; ++ks) acc = __builtin_amdgcn_mfma_f32_32x32x16_bf16(Ac[ks], Bf[ks], acc, 0, 0, 0);
                unsigned k[16];
#pragma unroll
                for (int r = 0; r < 16; ++r) { const int n = 32 * nt + (r & 3) + 8 * (r >> 2) + 4 * hi; k[r] = (f2ord(acc[r]) & ~127u) | (unsigned)(127 - n); }
                sort16_desc(k);
                top16_merge(L[p], k);
            }
            unsigned pb[16];
#pragma unroll
            for (int i = 0; i < 16; ++i) pb[i] = __shfl_xor(L[p][i], 32);
            top16_merge(L[p], pb);
        }
        float sa[16], sb[16];
#pragma unroll
        for (int i = 0; i < 16; ++i) { sa[i] = ord2f(L[0][i] & ~127u); sb[i] = ord2f(L[1][i] & ~127u); wl[i * 64] = 127u - (L[0][i] & 127u); wl[(16 + i) * 64] = 127u - (L[1][i] & 127u); }
        unsigned c0[16], c1[16];
#pragma unroll
        for (int s = 0; s < 32; ++s) {
            unsigned key = 0u;
            if (s < 25) { const float v = hi ? sa[CI[25 + s]] + sb[CJ[25 + s]] : sa[CI[s]] + sb[CJ[s]]; const int pos = hi ? CI[25 + s] * 16 + CJ[25 + s] : CI[s] * 16 + CJ[s];
                key = (f2ord(v) & ~255u) | (unsigned)(255 - pos); }
            if (s < 16) c0[s] = key; else c1[s - 16] = key;
        }
        sort16_desc(c0); sort16_desc(c1); top16_merge(c0, c1);
        unsigned pb[16];
#pragma unroll
        for (int i = 0; i < 16; ++i) pb[i] = __shfl_xor(c0[i], 32);
        top16_merge(c0, pb);
        float e[16]; const float m = ord2f(c0[0] & ~255u); float l = 0.f;
#pragma unroll
        for (int r = 0; r < 16; ++r) { e[r] = __expf(ord2f(c0[r] & ~255u) - m); l += e[r]; }
        const float il = 1.f / l;
        int ex[8]; float gt[8];
#pragma unroll
        for (int q = 0; q < 8; ++q) { const unsigned kk = hi ? c0[8 + q] : c0[q]; const int pos = 255 - (int)(kk & 255u); ex[q] = (int)(wl[(pos >> 4) * 64] * 128u + wl[(16 + (pos & 15)) * 64]); gt[q] = (hi ? e[8 + q] : e[q]) * il; }
        int* ep = EIDX + row * 128 + h * 16 + hi * 8; float* gp = EGATE + row * 128 + h * 16 + hi * 8;
        *(int4*)ep = make_int4(ex[0], ex[1], ex[2], ex[3]); *(int4*)(ep + 4) = make_int4(ex[4], ex[5], ex[6], ex[7]);
        *(f32x4_t*)gp = (f32x4_t){gt[0], gt[1], gt[2], gt[3]}; *(f32x4_t*)(gp + 4) = (f32x4_t){gt[4], gt[5], gt[6], gt[7]};
    }
}
__device__ __forceinline__ void cross_item(Frame& F, const bf16_t* QC, const bf16_t* KC, const bf16_t* VC, bf16_t* OC, int bh, int qb) {
    int tid = F.tid; asm volatile("" : "+v"(tid));
    const int lane = tid & 63, wave = F.wave, q = lane & 31, hi = lane >> 5;
    LAS unsigned char* L = F.lds;
    const int g4 = lane >> 4, qq = (lane >> 2) & 3, p4 = lane & 3;
    {
        const int b = bh >> 2, h = bh & 3;
#pragma unroll
        for (int i = 0; i < 16; ++i) { const int cid = tid + 512 * i, r = cid >> 5, c = cid & 31;
            *(LAS v4u*)(L + r * 512 + ((c ^ (r & 15)) << 4)) = *(const v4u*)(KC + (size_t)(b * 256 + r) * 1024 + h * 256 + c * 8); }
        const size_t qrow0 = (size_t)b * SEQ + qb * 256 + wave * 32;
        const bf16_t* Qp = QC + (qrow0 + q) * 1024 + h * 256 + 8 * hi;
        __syncthreads();
        f32x16_t st[8];
#pragma unroll
        for (int kt = 0; kt < 8; ++kt) st[kt] = (f32x16_t){};
#pragma unroll 2
        for (int ks = 0; ks < 16; ++ks) { const bf16x8_t qf = *(const bf16x8_t*)(Qp + 16 * ks);
#pragma unroll
            for (int kt = 0; kt < 8; ++kt) { const int row = 32 * kt + q;
                st[kt] = __builtin_amdgcn_mfma_f32_32x32x16_bf16(*(const LAS bf16x8_t*)(L + row * 512 + (((2 * ks + hi) ^ (row & 15)) << 4)), qf, st[kt], 0, 0, 0); } }
        float m = -INFINITY;
#pragma unroll
        for (int kt = 0; kt < 8; ++kt)
#pragma unroll
            for (int r = 0; r < 16; ++r) { st[kt][r] *= 0.0625f; m = fmaxf(m, st[kt][r]); }
        m = fmaxf(m, __shfl_xor(m, 32));
        float l = 0.f;
#pragma unroll
        for (int kt = 0; kt < 8; ++kt)
#pragma unroll
            for (int r = 0; r < 16; ++r) { st[kt][r] = __expf(st[kt][r] - m); l += st[kt][r]; }
        l += __shfl_xor(l, 32);
        const float il = 1.f / l;
        bf16x8_t pa[8][2];
#pragma unroll
        for (int kt = 0; kt < 8; ++kt)
#pragma unroll
            for (int s = 0; s < 2; ++s) pa[kt][s] = __builtin_bit_cast(bf16x8_t, (v4u){cvtpk(st[kt][8 * s] * il, st[kt][8 * s + 1] * il), cvtpk(st[kt][8 * s + 2] * il, st[kt][8 * s + 3] * il),
                                                                                        cvtpk(st[kt][8 * s + 4] * il, st[kt][8 * s + 5] * il), cvtpk(st[kt][8 * s + 6] * il, st[kt][8 * s + 7] * il)});
        __syncthreads();
#pragma unroll
        for (int i = 0; i < 16; ++i) { const int cid = tid + 512 * i, r = cid >> 5, c = cid & 31;
            *(LAS v4u*)(L + r * 512 + ((c ^ (4 * (r & 3))) << 4)) = *(const v4u*)(VC + (size_t)(b * 256 + r) * 1024 + h * 256 + c * 8); }
        __syncthreads();
        bf16_t* Op = OC + qrow0 * 1024 + h * 256 + q;
#pragma unroll 1
        for (int dt = 0; dt < 8; ++dt) {
            f32x16_t o = {};
            LAS unsigned char* vb = L + (4 * (g4 >> 1) + qq) * 512 + (((dt * 64) ^ (qq << 6)) + (g4 & 1) * 32 + p4 * 8);
#pragma unroll
            for (int kt = 0; kt < 8; ++kt)
#pragma unroll
                for (int s = 0; s < 2; ++s) { const v4i16_t a0 = lds_tr16(vb + (32 * kt + 16 * s) * 512), a1 = lds_tr16(vb + (32 * kt + 16 * s + 8) * 512);
                    const bf16x8_t vf = {a0[0], a0[1], a0[2], a0[3], a1[0], a1[1], a1[2], a1[3]};
                    o = __builtin_amdgcn_mfma_f32_32x32x16_bf16(pa[kt][s], vf, o, 0, 0, 0); }
#pragma unroll
            for (int r = 0; r < 16; ++r) { const int row = (r & 3) + 8 * (r >> 2) + 4 * hi; Op[(size_t)row * 1024 + dt * 32] = f2bf(o[r]); }
        }
        __syncthreads();
    }
}
template <bool REMAP>
__device__ __forceinline__ void transpose_tile(const float* W, int K, int N, const float* gain, bf16_t* WT, LAS float* tile, int item, int tid) {
    const int nblk = (N + 255) / 256, kb = item / nblk, nb = item % nblk, k0 = 64 * kb, n0 = 256 * nb;
    const int c4 = (tid & 63) * 4, kr = tid >> 6;
    f32x4 v[8];
#pragma unroll
    for (int i = 0; i < 8; ++i) { const int k = kr + 8 * i; v[i] = (n0 + c4 < N) ? *(const GAS f32x4*)(W + (size_t)(k0 + k) * N + n0 + c4) : (f32x4){0.f, 0.f, 0.f, 0.f}; }
#pragma unroll
    for (int i = 0; i < 8; ++i) { const int k = kr + 8 * i; LAS float* d = tile + k * 257 + c4; d[0] = v[i].x; d[1] = v[i].y; d[2] = v[i].z; d[3] = v[i].w; }
    __syncthreads();
#pragma unroll
    for (int i = 0; i < 4; ++i) { const int p = tid + 512 * i, n = p >> 3, c = p & 7; const LAS float* sp = tile + (8 * c) * 257 + n;
        float g[8];
#pragma unroll
        for (int q = 0; q < 8; ++q) g[q] = gain ? gain[k0 + 8 * c + q] : 1.f;
        v4u o; o.x = pk2(sp[0 * 257] * g[0], sp[1 * 257] * g[1]); o.y = pk2(sp[2 * 257] * g[2], sp[3 * 257] * g[3]); o.z = pk2(sp[4 * 257] * g[4], sp[5 * 257] * g[5]); o.w = pk2(sp[6 * 257] * g[6], sp[7 * 257] * g[7]);
        int ng = n0 + n; bool ok = ng < N;
        if (REMAP) { if (ng >= 3584 && ng < 3592) ok = false; else if (ng >= 3592) ng -= 8; }
        if (ok) *(GAS v4u*)(WT + (size_t)ng * K + k0 + 8 * c) = o; }
    __syncthreads();
}

__device__ __forceinline__ void p0_prologue(Frame& F, const Args& a) {
    unsigned char* ws = a.ws;
    LAS float* tile = (LAS float*)F.lds;
    const int gw = F.vcu * NWAVES + F.wave, NGW = F.G * NWAVES;
    constexpr int I_IN = 16 * 23;
    for (int it = F.vcu; it < I_IN; it += F.G) transpose_tile<true>(a.w_in, 1024, IN_COLS, a.g_mix, (bf16_t*)(ws + WS_WIN), tile, it, F.tid);
    __syncthreads();
    LAS float* wsm = (LAS float*)F.lds;
    for (int i = F.tid; i < 8192; i += NWAVES * 64) { const int j = i >> 10, k = i & 1023; wsm[i] = a.w_in[(size_t)k * IN_COLS + 3584 + j] * a.g_mix[k]; }
    __syncthreads();
    bf16_t* XB = (bf16_t*)(ws + WS_A0); float* rstd0 = (float*)(ws + WS_RSTD0); float* GB = (float*)(ws + WS_GB); float* GA = GB + T * 4;
    for (int row0 = gw * 4; row0 < T; row0 += NGW * 4) {
        f32x4 v[4][4];
#pragma unroll
        for (int r = 0; r < 4; ++r)
#pragma unroll
            for (int j = 0; j < 4; ++j) v[r][j] = *((const GAS f32x4*)(a.x + (size_t)(row0 + r) * D) + F.lane + 64 * j);
#pragma unroll
        for (int r = 0; r < 4; ++r) { const int row = row0 + r; float s = 0.f;
#pragma unroll
            for (int j = 0; j < 4; ++j) s += (v[r][j].x * v[r][j].x + v[r][j].y * v[r][j].y) + (v[r][j].z * v[r][j].z + v[r][j].w * v[r][j].w);
            const float rstd = rsqrtf(wave_sum(s) * (1.f / D) + EPS);
            GAS unsigned long long* o8 = (GAS unsigned long long*)(XB + (size_t)row * D) + F.lane;
#pragma unroll
            for (int j = 0; j < 4; ++j) o8[64 * j] = (unsigned long long)pk2(v[r][j].x, v[r][j].y) | ((unsigned long long)pk2(v[r][j].z, v[r][j].w) << 32);
            float dj[8];
#pragma unroll
            for (int jj = 0; jj < 8; ++jj) { float d = 0.f;
#pragma unroll
                for (int j = 0; j < 4; ++j) { const f32x4 w = *(const LAS f32x4*)(wsm + jj * 1024 + (F.lane + 64 * j) * 4); d += (v[r][j].x * w.x + v[r][j].y * w.y) + (v[r][j].z * w.z + v[r][j].w * w.w); }
                dj[jj] = d; }
#pragma unroll
            for (int off = 4; off >= 1; off >>= 1) { const bool up = (F.lane & off) != 0;
#pragma unroll
                for (int i = 0; i < off; ++i) { const float lo = dj[i], hi = dj[i + off]; const float send = up ? lo : hi, keep = up ? hi : lo; dj[i] = keep + __shfl_xor(send, off); } }
            float d0 = dj[0]; d0 += __shfl_xor(d0, 8); d0 += __shfl_xor(d0, 16); d0 += __shfl_xor(d0, 32);
            if (F.lane == 0) rstd0[row] = rstd;
            if (F.lane < 4) GB[(size_t)row * 4 + F.lane] = d0 * rstd; else if (F.lane < 8) GA[(size_t)row * 4 + F.lane - 4] = d0 * rstd; }
    }
}
__device__ __forceinline__ void late_prologue(Frame& F, const Args& a, int wgi, int nwg) {
    unsigned char* ws = a.ws;
    LAS float* tile = (LAS float*)F.lds;
    const int gw = wgi * NWAVES + F.wave, NGW = nwg * NWAVES;
    constexpr int I_S = 8 * 4, I_M = 16 * 4, I_L = 16 * 8;
    constexpr int NITEMS = 2 * I_S + 3 * I_M + 2 * I_L;
    for (int it = wgi; it < NITEMS; it += nwg) {
        int r = it;
        if (r < I_S) { transpose_tile<false>(a.w_sb_up, 512, 1024, nullptr, (bf16_t*)(ws + WS_WSB), tile, r, F.tid); continue; } r -= I_S;
        if (r < I_S) { transpose_tile<false>(a.w_gdn_up, 512, 1024, nullptr, (bf16_t*)(ws + WS_WGDN), tile, r, F.tid); continue; } r -= I_S;
        if (r < I_M) { transpose_tile<false>(a.w_mix_out, 1024, 1024, nullptr, (bf16_t*)(ws + WS_WMIX), tile, r, F.tid); continue; } r -= I_M;
        if (r < I_M) { transpose_tile<false>(a.w_cq, 1024, 1024, a.g_cross, (bf16_t*)(ws + WS_WCQ), tile, r, F.tid); continue; } r -= I_M;
        if (r < I_M) { transpose_tile<false>(a.w_co, 1024, 1024, nullptr, (bf16_t*)(ws + WS_WCO), tile, r, F.tid); continue; } r -= I_M;
        if (r < I_L) { transpose_tile<false>(a.w_ckv, 1024, 2048, nullptr, (bf16_t*)(ws + WS_WCKV), tile, r, F.tid); continue; } r -= I_L;
        transpose_tile<false>(a.w_pq, 1024, 2048, a.g_peer, (bf16_t*)(ws + WS_WPQ), tile, r, F.tid);
    }
    __syncthreads();
    {
        float* SUV = (float*)(ws + WS_SUV);
        f32x4 gq[4];
#pragma unroll
        for (int q = 0; q < 4; ++q) gq[q] = *(const GAS f32x4*)(a.g_peer + 16 * F.lane + 4 * q);
        for (int row0 = gw * 4; row0 < 2 * 16384; row0 += NGW * 4) {
            f32x4 v[4][4];
#pragma unroll
            for (int r = 0; r < 4; ++r) { const int row = row0 + r, tb = row >> 14, e = row & 16383; const float* src = (tb ? a.peer_v : a.peer_u) + (size_t)e * 1024 + 16 * F.lane;
#pragma unroll
                for (int q = 0; q < 4; ++q) { v[r][q] = *(const GAS f32x4*)(src + 4 * q); if (!tb) v[r][q] *= gq[q]; } }
#pragma unroll
            for (int r = 0; r < 4; ++r) { const int row = row0 + r, tb = row >> 14, e = row & 16383; float am = 0.f;
#pragma unroll
                for (int q = 0; q < 4; ++q) am = fmaxf(am, fmaxf(fmaxf(fabsf(v[r][q].x), fabsf(v[r][q].y)), fmaxf(fabsf(v[r][q].z), fabsf(v[r][q].w))));
#pragma unroll
                for (int o = 1; o < 64; o <<= 1) am = fmaxf(am, __shfl_xor(am, o));
                if (!tb) {
                    float sq = 0.f;
#pragma unroll
                    for (int q = 0; q < 4; ++q) sq += (v[r][q].x * v[r][q].x + v[r][q].y * v[r][q].y) + (v[r][q].z * v[r][q].z + v[r][q].w * v[r][q].w);
                    sq = wave_sum(sq);
                    const float cl = fminf(am, 2.6f * sqrtf(sq * (1.f / 1024.f))), sc4 = cl > 0.f ? 7.f / cl : 0.f; v2u o4;
#pragma unroll
                    for (int h2 = 0; h2 < 2; ++h2) { const float lo4[4] = {v[r][2 * h2].x, v[r][2 * h2].y, v[r][2 * h2].z, v[r][2 * h2].w}, hi4[4] = {v[r][2 * h2 + 1].x, v[r][2 * h2 + 1].y, v[r][2 * h2 + 1].z, v[r][2 * h2 + 1].w}; unsigned wd = 0u;
#pragma unroll
                        for (int k = 0; k < 4; ++k) { const int nl = (int)fminf(fmaxf(rintf(lo4[k] * sc4), -7.f), 7.f), nh = (int)fminf(fmaxf(rintf(hi4[k] * sc4), -7.f), 7.f);
                            wd |= ((unsigned)(nl + 8) | (((unsigned)nh & 15u) << 4)) << (8 * k); }
                        o4[h2] = wd; }
                    *(GAS v2u*)(ws + WS_U8 + ((size_t)(F.lane >> 4) * 16384 + e) * 128 + 8 * (F.lane & 15)) = o4;
                    if (F.lane == 0) SUV[row] = cl * (1.f / 7.f);
                    continue; }
                const float sc = am > 0.f ? 6.f / am : 0.f, inv = am * (1.f / 6.f);
                {   unsigned char* vrow = ws + WS_V8 + ((size_t)(F.lane >> 4) * 16384 + e) * 128 + ((F.lane & 15) >> 1);
#pragma unroll
                    for (int q = 0; q < 4; ++q) {
#pragma unroll
                        for (int c = 0; c < 4; ++c) { const float vv = v[r][q][c] * sc, aa = fabsf(vv);
                            const int code = ((aa >= 0.25f) + (aa >= 0.75f) + (aa >= 1.25f) + (aa >= 1.75f) + (aa >= 2.5f) + (aa >= 3.5f) + (aa >= 5.f)) | (vv < 0.f ? 8 : 0);
                            const int pc = dpp_i<DPP_X1>(code);
                            if (!(F.lane & 1)) vrow[8 * (4 * q + c)] = (unsigned char)(code | (pc << 4)); } } }
                if (F.lane == 0) SUV[row] = inv; }
        }
    }
    {
        const int gt = gw * 64 + F.lane, ngt = NGW * 64;
        for (int p = gt; p < 262144 / 8; p += ngt) { const float* src = a.subkeys + (size_t)p * 8; const f32x4 v0 = *(const GAS f32x4*)src, v1 = *(const GAS f32x4*)(src + 4);
            v4u o; o.x = pk2(v0.x, v0.y); o.y = pk2(v0.z, v0.w); o.z = pk2(v1.x, v1.y); o.w = pk2(v1.z, v1.w); *(GAS v4u*)((bf16_t*)(ws + WS_SKB) + (size_t)p * 8) = o; }
    }
    bf16_t* MN = (bf16_t*)(ws + WS_MN);
    for (int row = gw; row < 1024; row += NGW) {
        const GAS f32x4* xr = (const GAS f32x4*)(a.mem + (size_t)row * D) + F.lane;
        f32x4 v[4]; float s = 0.f;
#pragma unroll
        for (int j = 0; j < 4; ++j) { v[j] = xr[64 * j]; s += (v[j].x * v[j].x + v[j].y * v[j].y) + (v[j].z * v[j].z + v[j].w * v[j].w); }
        const float rstd = rsqrtf(wave_sum(s) * (1.f / D) + EPS);
        GAS unsigned long long* o8 = (GAS unsigned long long*)(MN + (size_t)row * D) + F.lane;
#pragma unroll
        for (int j = 0; j < 4; ++j) { const f32x4 g = *((const f32x4*)a.g_mem + F.lane + 64 * j); const f32x4 o = v[j] * g * rstd;
            o8[64 * j] = (unsigned long long)pk2(o.x, o.y) | ((unsigned long long)pk2(o.z, o.w) << 32); }
    }
}
__device__ __forceinline__ void rstd_rows_for_units(Frame& F, int N, const float* SS, float* rstd) {
    pg8::StaticOrder S2; S2.init(T, N, F.G, (int)blockIdx.x); pg8::Unit u;
    for (int i = 0; S2.next(i, u); ++i) if (F.tid < 256) { const int row = u.pm * 256 + F.tid; const f32x4* sp = (const f32x4*)(SS + (size_t)row * 16);
        const f32x4 a = (sp[0] + sp[1]) + (sp[2] + sp[3]); rstd[row] = rsqrtf(((a.x + a.y) + (a.z + a.w)) * (1.f / 1024.f) + EPS); }
    asm volatile("s_waitcnt vmcnt(0)" ::: "memory"); __syncthreads();
}

__device__ __forceinline__ void sub_barrier(gu32* cnt, unsigned n, gu32* tmo) {
    asm volatile("s_waitcnt vmcnt(0)" ::: "memory");
    __syncthreads();
    if (threadIdx.x == 0) {
        __builtin_amdgcn_fence(__ATOMIC_RELEASE, "agent");
        asm volatile("s_waitcnt vmcnt(0)" ::: "memory");
        __hip_atomic_fetch_add(cnt, 1u, __ATOMIC_RELAXED, __HIP_MEMORY_SCOPE_AGENT);
        unsigned sp = 0;
        while (__hip_atomic_load(cnt, __ATOMIC_RELAXED, __HIP_MEMORY_SCOPE_AGENT) < n) { __builtin_amdgcn_s_sleep(2); if (++sp > (1u << 22)) { __hip_atomic_store(tmo, 1u, __ATOMIC_RELAXED, __HIP_MEMORY_SCOPE_AGENT); break; } }
        __builtin_amdgcn_fence(__ATOMIC_ACQUIRE, "agent");
        asm volatile("s_waitcnt vmcnt(0)" ::: "memory");
    }
    __syncthreads();
}

__global__ void __launch_bounds__(NWAVES * 64, 2) mk_fwd(Args args) {
    extern __shared__ __attribute__((aligned(16))) unsigned char lds_raw[];
    Frame F;
    F.lds = (LAS unsigned char*)lds_raw;
    F.tid = threadIdx.x; F.lane = F.tid & 63; F.wave = __builtin_amdgcn_readfirstlane(F.tid >> 6);
    F.G = gridDim.x; { const int bx = blockIdx.x; F.vcu = (F.G % 8 == 0) ? (bx % 8) * (F.G / 8) + bx / 8 : bx; }
    unsigned char* ws = args.ws;
    gu32* ctl = (gu32*)(ws + WS_CTL);
    volatile LAS unsigned* MISC = (volatile LAS unsigned*)(F.lds + MISC_OFF);
    for (int u = F.tid; u < (LDS_BYTES - LDSCTL_OFF) / 4; u += NWAVES * 64) ((LAS unsigned*)(F.lds + LDSCTL_OFF))[u] = 0u;
    __syncthreads();
    XcdBarrier bar = xcd_barrier_post((unsigned*)(ctl + CW_BAR) + args.bar_region * XCD_BAR_WORDS, MISC + 8);
    const int lo = args.ph_lo, hi = args.ph_hi;
#define IN(k) (lo <= (k) && (k) < hi)
#ifndef PROBE_PH
#define PROBE_PH (-1)
#endif
    unsigned long long pb_t = (PROBE_PH >= 0) ? __builtin_amdgcn_s_memrealtime() : 0ull;
#define PB_STRETCH() do { const unsigned long long e_ = __builtin_amdgcn_s_memrealtime(), d_ = e_ - pb_t; while (__builtin_amdgcn_s_memrealtime() - e_ < d_) __builtin_amdgcn_s_sleep(4); } while (0)
#define SEAM(k) do { if (PROBE_PH == (k)) PB_STRETCH(); if (IN(k) && IN((k) + 1)) xcd_barrier(bar); if ((k) < PROBE_PH) pb_t = __builtin_amdgcn_s_memrealtime(); } while (0)
    bf16_t* A0 = (bf16_t*)(ws + WS_A0); bf16_t* A1 = (bf16_t*)(ws + WS_A1);
    bf16_t* MG = (bf16_t*)args.out;
    bf16_t* SBQ = (bf16_t*)args.out; bf16_t* SBK = SBQ + (size_t)T * 512; bf16_t* SBV = SBK + (size_t)T * 512; bf16_t* OSB = SBV + (size_t)T * 512;

    GdnBufs Gb{(bf16_t*)(ws + WS_NW), (bf16_t*)(ws + WS_QD), (bf16_t*)(ws + WS_KDT), (bf16_t*)(ws + WS_QK), (bf16_t*)(ws + WS_UT), (float*)(ws + WS_CD), (bf16_t*)(ws + WS_ORAW), (float*)(ws + WS_OSS)};
    if (IN(0)) { p0_prologue(F, args);}
    SEAM(0);
    if (IN(1)) {
        { pg8::Gemm g{A0, (const bf16_t*)(ws + WS_WIN), T, NPROJ, 1024}; pg8::StaticOrder S; S.init(T, NPROJ, F.G, (int)blockIdx.x);
          pg8::EpiProj E{(const float*)(ws + WS_RSTD0), SBQ, SBK, SBV, A1, (bf16_t*)(ws + WS_GZ), (bf16_t*)(ws + WS_GSB), (bf16_t*)(ws + WS_GGDN)};
          pg8::gemm_phase<pg8::EpiProj, pg8::StaticOrder, true, true>(F.lds, g, S, E); }
    }
    SEAM(1);
    if (IN(2)) { gdn_prep_phase(F, args, A1, (const float*)(ws + WS_GB), (const float*)(ws + WS_GB) + T * 4, Gb); }
    SEAM(2);
    if (IN(3)) {
        const int nscan = F.G > 64 ? 64 : F.G, sb0 = F.G > 64 ? 64 : 0;
        if ((int)blockIdx.x < nscan) for (int s0 = blockIdx.x; s0 < 64; s0 += nscan) { const int s = (nscan == 64) ? ((s0 & 7) + 8 * (s0 >> 5)) * 4 + ((s0 >> 3) & 3) : s0; gdn_scan_unit(F, s, Gb); __syncthreads(); }
        if ((int)blockIdx.x >= sb0) { late_prologue(F, args, (int)blockIdx.x - sb0, F.G - sb0); __syncthreads(); }
        if ((int)blockIdx.x >= sb0) sb_phase(F.lds + F.wave * 8192, SBQ, SBK, SBV, OSB, ((int)blockIdx.x - sb0) * NWAVES + F.wave, (F.G - sb0) * NWAVES, F.lane);
        __syncthreads();
        if (sb0 > 0 && (int)blockIdx.x >= sb0) {
            sub_barrier(ctl + CW_SUB, (unsigned)(F.G - sb0), ctl + CW_SUB + 64);
            pg8::Gemm g{OSB, (const bf16_t*)(ws + WS_WSB), T, 1024, 512}; pg8::StaticOrder S; S.init(T, 1024, F.G - sb0, (int)blockIdx.x - sb0);
            pg8::EpiMerge<false> E{(const bf16_t*)(ws + WS_GSB), MG};
            pg8::gemm_phase<pg8::EpiMerge<false>, pg8::StaticOrder, true, true>(F.lds, g, S, E);
            const int wgi = (int)blockIdx.x - sb0;
            if (F.G - sb0 >= 160 && wgi >= 128 && wgi < 160) { pg8::Gemm g2{(const bf16_t*)(ws + WS_MN), (const bf16_t*)(ws + WS_WCKV), 1024, 2048, 1024}; pg8::StaticOrder S2; S2.init(1024, 2048, 32, wgi - 128);
                pg8::EpiSplit E2{(bf16_t*)(ws + WS_KC), (bf16_t*)(ws + WS_VC), 1024, 4};
                pg8::gemm_phase<pg8::EpiSplit, pg8::StaticOrder, true, true>(F.lds, g2, S2, E2); }
        }
    }
    SEAM(3);
    if (IN(4)) {
        if (!(F.G > 64 && F.G - 64 >= 160)) { pg8::Gemm g{(const bf16_t*)(ws + WS_MN), (const bf16_t*)(ws + WS_WCKV), 1024, 2048, 1024}; pg8::StaticOrder S; S.init(1024, 2048, F.G, (int)blockIdx.x);
          pg8::EpiSplit E{(bf16_t*)(ws + WS_KC), (bf16_t*)(ws + WS_VC), 1024, 4};
          pg8::gemm_phase<pg8::EpiSplit, pg8::StaticOrder, true, true>(F.lds, g, S, E); }
        gdn_finish_phase(F, args, Gb, (const bf16_t*)(ws + WS_GZ), (bf16_t*)(ws + WS_OG)); }
    SEAM(4);
    if (IN(5)) {
        if (!(F.G > 64)) { pg8::Gemm g{OSB, (const bf16_t*)(ws + WS_WSB), T, 1024, 512}; pg8::StaticOrder S; S.init(T, 1024, F.G, (int)blockIdx.x);
          pg8::EpiMerge<false> E{(const bf16_t*)(ws + WS_GSB), MG};
          pg8::gemm_phase<pg8::EpiMerge<false>, pg8::StaticOrder, true, true>(F.lds, g, S, E);
          xcd_barrier(bar); }
        { pg8::Gemm g{(const bf16_t*)(ws + WS_OG), (const bf16_t*)(ws + WS_WGDN), T, 1024, 512}; pg8::StaticOrder S; S.init(T, 1024, F.G, (int)blockIdx.x);
          pg8::EpiMerge<true> E{(const bf16_t*)(ws + WS_GGDN), MG};
          pg8::gemm_phase<pg8::EpiMerge<true>, pg8::StaticOrder, true, true>(F.lds, g, S, E); }
    }
    SEAM(5);
    if (IN(6)) {
        pg8::Gemm g{MG, (const bf16_t*)(ws + WS_WMIX), T, 1024, 1024}; pg8::StaticOrder S; S.init(T, 1024, F.G, (int)blockIdx.x);
        pg8::EpiRes<true> E{args.x, nullptr, A1, (float*)(ws + WS_SS)};
        pg8::gemm_phase<pg8::EpiRes<true>, pg8::StaticOrder, true, true>(F.lds, g, S, E);
    }
    SEAM(6);
    if (IN(7)) {
        rstd_rows_for_units(F, 1024, (const float*)(ws + WS_SS), (float*)(ws + WS_RSTD0));
        pg8::Gemm g{A1, (const bf16_t*)(ws + WS_WCQ), T, 1024, 1024}; pg8::StaticOrder S; S.init(T, 1024, F.G, (int)blockIdx.x);
        pg8::EpiScale E{(const float*)(ws + WS_RSTD0), (bf16_t*)(ws + WS_GSB), 1024};
        pg8::gemm_phase<pg8::EpiScale, pg8::StaticOrder, true, true>(F.lds, g, S, E);
        asm volatile("s_waitcnt vmcnt(0)" ::: "memory"); __syncthreads();
        pg8::StaticOrder S2; S2.init(T, 1024, F.G, (int)blockIdx.x); pg8::Unit u;
        for (int i = 0; S2.next(i, u); ++i) cross_item(F, (const bf16_t*)(ws + WS_GSB), (const bf16_t*)(ws + WS_KC), (const bf16_t*)(ws + WS_VC), (bf16_t*)(ws + WS_GGDN), (u.pm >> 5) * 4 + u.pn, u.pm & 31);
    }
    SEAM(7);
    if (IN(9)) {
        pg8::Gemm g{(const bf16_t*)(ws + WS_GGDN), (const bf16_t*)(ws + WS_WCO), T, 1024, 1024}; pg8::StaticOrder S; S.init(T, 1024, F.G, (int)blockIdx.x);
        pg8::EpiRes<false> E{nullptr, A1, A0, (float*)(ws + WS_SS)};
        pg8::gemm_phase<pg8::EpiRes<false>, pg8::StaticOrder, true, true>(F.lds, g, S, E);
    }
    SEAM(9);
    if (IN(10)) {
        rstd_rows_for_units(F, 2048, (const float*)(ws + WS_SS), (float*)(ws + WS_RSTD2));
        pg8::Gemm g{A0, (const bf16_t*)(ws + WS_WPQ), T, 2048, 1024}; pg8::StaticOrder S; S.init(T, 2048, F.G, (int)blockIdx.x);
        pg8::EpiScale E{(const float*)(ws + WS_RSTD2), A1, 2048};
        pg8::gemm_phase<pg8::EpiScale, pg8::StaticOrder, true, true>(F.lds, g, S, E);
        asm volatile("s_waitcnt vmcnt(0)" ::: "memory"); __syncthreads();
        pg8::StaticOrder S2; S2.init(T, 2048, F.G, (int)blockIdx.x); pg8::Unit u;
        int hst = -1;
        for (int i = 0; S2.next(i, u); ++i) {
            if (u.pn != hst) { hst = u.pn; __syncthreads();
#pragma unroll
                for (int q = 0; q < 8; ++q) { const int cid = F.tid + 512 * q, r = cid >> 4, c = cid & 15;
                    *(LAS v4u*)(F.lds + r * 256 + ((c ^ (r & 15)) << 4)) = *(const v4u*)((const bf16_t*)(ws + WS_SKB) + ((size_t)u.pn * 256 + r) * 128 + c * 8); }
                __syncthreads(); }
            peer_route_task(F, A1, (const bf16_t*)(ws + WS_SKB), (int*)(ws + 296 * MiB), (float*)(ws + 312 * MiB), u.pm * 8 + F.wave, u.pn);
        }
        __syncthreads();
    }
    SEAM(10);
    if (IN(12)) { peer_u_phase(F, args, ctl, A0, (const float*)(ws + WS_RSTD2), (const int*)(ws + 296 * MiB), (const unsigned char*)(ws + WS_U8), (bf16_t*)(ws + WS_PART)); }
    SEAM(12);
    if (IN(13)) { peer_combine_phase(F, (const bf16_t*)(ws + WS_PART), (const int*)(ws + 296 * MiB), (const float*)(ws + 312 * MiB), (const float*)(ws + WS_SUV), (const float*)(ws + WS_SUV) + 16384, ws + 328 * MiB, (float*)(ws + 336 * MiB)); }
    SEAM(13);
    if (IN(14)) { peer_v_phase(F, ctl, (const int*)(ws + 296 * MiB), ws + 328 * MiB, (const float*)(ws + 336 * MiB), (const unsigned char*)(ws + WS_V8), A0, A1, (float*)(ws + WS_SS)); }
    SEAM(14);
    if (IN(15)) { peer_norm_phase(F, args, (const float*)(ws + WS_SS), A1, args.out); }
    if (PROBE_PH == 15) PB_STRETCH();
#undef IN
#undef SEAM
#undef PB_STRETCH
}
extern "C" void kernel_launch(void* const* d_in, const int* in_sizes, int n_in, void* d_out, int out_size, void* d_ws, size_t ws_size, hipStream_t stream) {
    static int grid = 0;
    if (grid == 0) {
        if (n_in != 22 || ws_size < WS_END || out_size != T * D) { fprintf(stderr, "kernel_launch: unexpected n_in %d / ws %zu / out %d\n", n_in, ws_size, out_size); grid = -1; return; }
        int dev = 0, cus = 0, per_cu = 0;
        if (hipGetDevice(&dev) != hipSuccess || hipDeviceGetAttribute(&cus, hipDeviceAttributeMultiprocessorCount, dev) != hipSuccess) { grid = -1; return; }
        if (hipFuncSetAttribute((const void*)mk_fwd, hipFuncAttributeMaxDynamicSharedMemorySize, LDS_BYTES) != hipSuccess) { fprintf(stderr, "kernel_launch: hipFuncSetAttribute failed\n"); grid = -1; return; }
        if (hipOccupancyMaxActiveBlocksPerMultiprocessor(&per_cu, (const void*)mk_fwd, NWAVES * 64, LDS_BYTES) != hipSuccess || per_cu < 1) { fprintf(stderr, "kernel_launch: occupancy query says %d\n", per_cu); per_cu = 1; }
        (void)hipGetLastError();
        grid = cus;
    }
    if (grid < 0) return;
    hipMemsetAsync((char*)d_ws + WS_CTL, 0, CTL_ZERO_BYTES, stream);
    Args a{};
    const float** ap = (const float**)&a;
    for (int i = 0; i < 22; ++i) ap[i] = (const float*)d_in[i];
    a.out = (float*)d_out; a.ws = (unsigned char*)d_ws;
    char* ws = (char*)d_ws; float* out = (float*)d_out;
    float* rstd2 = (float*)(ws + WS_RSTD2);
    bf16_t* KC = (bf16_t*)(ws + WS_KC); bf16_t* VC = (bf16_t*)(ws + WS_VC);
    bf16_t* PQ = (bf16_t*)(ws + WS_A1); bf16_t* QC = (bf16_t*)(ws + WS_GSB); bf16_t* OC = (bf16_t*)(ws + WS_GGDN);
    int* EIDX = (int*)(ws + 296 * MiB); float* EGATE = (float*)(ws + 312 * MiB);
#define MK(lo, hi, reg) do { a.ph_lo = (lo); a.ph_hi = (hi); a.bar_region = (reg); hipLaunchKernelGGL(mk_fwd, dim3(grid), dim3(NWAVES * 64), LDS_BYTES, stream, a); } while (0)
    MK(0, 16, 0);
#undef MK
}
```

```cpp
#include <hip/hip_runtime.h>
#include <stdint.h>
#include <cstdio>

typedef unsigned short bf16_t;
__device__ __forceinline__ float bf2f(bf16_t v) { return __uint_as_float(((unsigned)v) << 16); }
typedef float f32x2v_t __attribute__((ext_vector_type(2))); typedef __bf16 bf16x2v_t __attribute__((ext_vector_type(2)));
__device__ __forceinline__ unsigned cvtpk(float lo, float hi) { f32x2v_t v = {lo, hi}; bf16x2v_t b = __builtin_convertvector(v, bf16x2v_t); return __builtin_bit_cast(unsigned, b); }
__device__ __forceinline__ bf16_t f2bf(float f) { return (bf16_t)(cvtpk(f, 0.f) & 0xffffu); }

constexpr int T = 32768, D = 1024, SEQ = 8192, NB = 4;
constexpr int IN_COLS = 5640, NPROJ = 5632;
constexpr float EPS = 1e-6f;
constexpr size_t MiB = 1u << 20;

template <int CTRL> __device__ __forceinline__ int dpp_i(int v) { return __builtin_amdgcn_update_dpp(0, v, CTRL, 0xf, 0xf, false); }
template <int CTRL> __device__ __forceinline__ float dpp_f(float v) { return __builtin_bit_cast(float, __builtin_amdgcn_update_dpp(0, __builtin_bit_cast(int, v), CTRL, 0xf, 0xf, false)); }
constexpr int DPP_X1 = 0xB1, DPP_X2 = 0x4E, DPP_HM = 0x141;
__device__ __forceinline__ float xor16_sum(float v) { const unsigned b = __builtin_bit_cast(unsigned, v); const auto r = __builtin_amdgcn_permlane16_swap(b, b, false, false); const unsigned r0 = r[0], r1 = r[1]; return __builtin_bit_cast(float, r0) + __builtin_bit_cast(float, r1); }
__device__ __forceinline__ float xor32_sum(float v) { const unsigned b = __builtin_bit_cast(unsigned, v); const auto r = __builtin_amdgcn_permlane32_swap(b, b, false, false); const unsigned r0 = r[0], r1 = r[1]; return __builtin_bit_cast(float, r0) + __builtin_bit_cast(float, r1); }
__device__ __forceinline__ float xor16_max(float v) { const unsigned b = __builtin_bit_cast(unsigned, v); const auto r = __builtin_amdgcn_permlane16_swap(b, b, false, false); const unsigned r0 = r[0], r1 = r[1]; return fmaxf(__builtin_bit_cast(float, r0), __builtin_bit_cast(float, r1)); }
__device__ __forceinline__ float xor32_max(float v) { const unsigned b = __builtin_bit_cast(unsigned, v); const auto r = __builtin_amdgcn_permlane32_swap(b, b, false, false); const unsigned r0 = r[0], r1 = r[1]; return fmaxf(__builtin_bit_cast(float, r0), __builtin_bit_cast(float, r1)); }
__device__ __forceinline__ unsigned xor32_get(unsigned v, bool upper) { const auto r = __builtin_amdgcn_permlane32_swap(v, v, false, false); const unsigned r0 = r[0], r1 = r[1]; return upper ? r0 : r1; }
__device__ __forceinline__ float lower32_bcast(float v) { const unsigned b = __builtin_bit_cast(unsigned, v); const auto r = __builtin_amdgcn_permlane32_swap(b, b, false, false); const unsigned r0 = r[0]; return __builtin_bit_cast(float, r0); }
__device__ __forceinline__ float wave_max(float v) { v = fmaxf(v, dpp_f<DPP_X1>(v)); v = fmaxf(v, dpp_f<DPP_X2>(v)); v = fmaxf(v, dpp_f<DPP_HM>(v)); v = fmaxf(v, dpp_f<0x140>(v)); return xor32_max(xor16_max(v)); }
__device__ __forceinline__ float wave_sum(float v) {
    v += dpp_f<DPP_X1>(v); v += dpp_f<DPP_X2>(v); v += dpp_f<DPP_HM>(v); v += dpp_f<0x140>(v);
    return xor32_sum(xor16_sum(v));
}
__device__ __forceinline__ float sigmoidf_(float x) { return 1.f / (1.f + __expf(-x)); }
__device__ __forceinline__ float softplusf_(float x) { return fmaxf(x, 0.f) + log1pf(__expf(-fabsf(x))); }

namespace pg8 {
#define PG8_LAS __attribute__((address_space(3)))
typedef unsigned short bf16_t;
typedef short bf16x8 __attribute__((ext_vector_type(8)));
typedef float f32x4 __attribute__((ext_vector_type(4)));
typedef unsigned u32x4 __attribute__((ext_vector_type(4)));
constexpr int BM = 256, BK = 64, HALF = 128, HTB = HALF * BK * 2  , STAGE_BYTES = 8 * HTB, NXCD = 8, WGM = 4;

__host__ __device__ __forceinline__ int lds_byte(int r, int c) { const int st = (r >> 4) * 2 + (c >> 5), rr = r & 15, cc = c & 31, ob = rr * 64 + cc * 2; return st * 1024 + (ob ^ (((ob >> 9) & 1) << 5)); }
__host__ __device__ __forceinline__ void stage_rc(int b, int& R, int& C) { const int st = b / 1024, sb = b % 1024, swz = sb ^ (((sb >> 9) & 1) << 5); R = (st >> 1) * 16 + swz / 64; C = (st & 1) * 32 + (swz % 64) / 2; }
__host__ __device__ __forceinline__ int perm32(int rho) { const int n = rho >> 4, i = rho & 15; return 8 * (i >> 2) + 4 * n + (i & 3); }

struct Unit { int pm, pn; };
struct Gemm { const bf16_t* A; const bf16_t* Bt; int M, N, K; };

struct StaticOrder {
    int nM, nN, nwg, G, c, wgm;
    __host__ __device__ __forceinline__ void init(int M, int N, int G_, int c_, int wgm_ = WGM) { nM = M / BM; nN = N / BM; nwg = nM * nN; G = G_; c = c_; wgm = wgm_; }
    __host__ __device__ __forceinline__ bool next(int i, Unit& u) const {
        const long L = (long)i * G + c; if (L >= nwg) return false;
        int wgid = (int)L; { const int q = nwg / NXCD, r = nwg % NXCD, xcd = wgid % NXCD, off = wgid / NXCD; wgid = (xcd < r ? xcd * (q + 1) : r * (q + 1) + (xcd - r) * q) + off; }
        const int nig = wgm * nN, gid = wgid / nig, fm = gid * wgm, gsz = (nM - fm) < wgm ? (nM - fm) : wgm;
        u.pm = fm + ((wgid % nig) % gsz); u.pn = (wgid % nig) / gsz; return true;
    }
    __device__ __forceinline__ void a_ready(const Unit&) const {}
    __device__ __forceinline__ void done(const Unit&) const {}
};

__device__ __forceinline__ unsigned cvt_pk_bf16(float lo, float hi) { unsigned r; asm volatile("v_cvt_pk_bf16_f32 %0, %1, %2" : "=v"(r) : "v"(lo), "v"(hi)); return r; }
typedef float f32x2 __attribute__((ext_vector_type(2)));
__device__ __forceinline__ float bfl(unsigned w) { return __uint_as_float(w << 16); }
__device__ __forceinline__ float bfh(unsigned w) { return __uint_as_float(w & 0xffff0000u); }
constexpr int EPI_STAGE_OFF = 131072 + 1024;
__device__ __forceinline__ void stage_store16x64(int wid, int fr, int fq, u32x4 w0, u32x4 w1, bf16_t* rowbase  , size_t ld) {
    PG8_LAS unsigned char* sl = (PG8_LAS unsigned char*)(EPI_STAGE_OFF + wid * 2048);
    *(PG8_LAS u32x4*)(sl + fr * 128 + ((fq ^ (fr & 7)) << 4)) = w0;
    *(PG8_LAS u32x4*)(sl + fr * 128 + (((4 + fq) ^ (fr & 7)) << 4)) = w1;
    const int lane = fr + 16 * fq, r0 = lane >> 3, c = lane & 7;
    const u32x4 a = *(const PG8_LAS u32x4*)(sl + r0 * 128 + ((c ^ r0) << 4));
    const u32x4 b = *(const PG8_LAS u32x4*)(sl + (r0 + 8) * 128 + ((c ^ r0) << 4));
    *(u32x4*)(rowbase + (size_t)r0 * ld + c * 8) = a;
    *(u32x4*)(rowbase + (size_t)(r0 + 8) * ld + c * 8) = b;
}
__device__ __forceinline__ u32x4 pack8(const f32x4& v0, const f32x4& v1) { u32x4 w; w.x = cvt_pk_bf16(v0[0], v0[1]); w.y = cvt_pk_bf16(v0[2], v0[3]); w.z = cvt_pk_bf16(v1[0], v1[1]); w.w = cvt_pk_bf16(v1[2], v1[3]); return w; }

struct EpiProj {
    static constexpr bool PERM = true, AFTER_DRAIN = false, COL64 = true;
    const float* rstd; bf16_t *SBQ, *SBK, *SBV, *GQKV, *GZ, *GSB, *GGDN;
    __device__ __forceinline__ void operator()(const f32x4 (&acc)[2][2][4][2], const Unit& u, int wr, int wc, int fr_in, int fq_in) const {
        int lane_ = fr_in + 16 * fq_in; asm volatile("" : "+v"(lane_));
        const int fr = lane_ & 15, fq = lane_ >> 4;
        const int pn = u.pn; bf16_t* base; int ld, coff;
        if (pn < 2) { base = SBQ; ld = 512; coff = pn * 256; } else if (pn < 4) { base = SBK; ld = 512; coff = (pn - 2) * 256; } else if (pn < 6) { base = SBV; ld = 512; coff = (pn - 4) * 256; }
        else if (pn < 12) { base = GQKV; ld = 1536; coff = (pn - 6) * 256; } else if (pn < 14) { base = GZ; ld = 512; coff = (pn - 12) * 256; }
        else if (pn < 18) { base = GSB; ld = 1024; coff = (pn - 14) * 256; } else { base = GGDN; ld = 1024; coff = (pn - 18) * 256; }
        const int row0 = u.pm * BM + wr * 64, wid = wr * 4 + wc;
        float rsv[2][4];
#pragma unroll
        for (int ai = 0; ai < 2; ++ai)
#pragma unroll
            for (int m = 0; m < 4; ++m) rsv[ai][m] = rstd[row0 + ai * HALF + m * 16 + fr];
#pragma unroll
        for (int ai = 0; ai < 2; ++ai)
#pragma unroll
            for (int m = 0; m < 4; ++m) { const int rg = row0 + ai * HALF + m * 16; const float rs = rsv[ai][m];
                stage_store16x64(wid, fr, fq, pack8(acc[ai][0][m][0] * rs, acc[ai][0][m][1] * rs), pack8(acc[ai][1][m][0] * rs, acc[ai][1][m][1] * rs), base + (size_t)rg * ld + coff + wc * 64, ld); }
    }
};
struct EpiSplit {
    static constexpr bool PERM = true, AFTER_DRAIN = false, COL64 = true;
    bf16_t *O0, *O1; int ldc, split_tiles;
    __device__ __forceinline__ void operator()(const f32x4 (&acc)[2][2][4][2], const Unit& u, int wr, int wc, int fr_in, int fq_in) const {
        int lane_ = fr_in + 16 * fq_in; asm volatile("" : "+v"(lane_));
        const int fr = lane_ & 15, fq = lane_ >> 4;
        bf16_t* base = u.pn < split_tiles ? O0 : O1; const int coff = (u.pn < split_tiles ? u.pn : u.pn - split_tiles) * 256;
        const int row0 = u.pm * BM + wr * 64, wid = wr * 4 + wc;
#pragma unroll
        for (int ai = 0; ai < 2; ++ai)
#pragma unroll
            for (int m = 0; m < 4; ++m) { const int rg = row0 + ai * HALF + m * 16;
                stage_store16x64(wid, fr, fq, pack8(acc[ai][0][m][0], acc[ai][0][m][1]), pack8(acc[ai][1][m][0], acc[ai][1][m][1]), base + (size_t)rg * ldc + coff + wc * 64, ldc); }
    }
};
template <bool ADD> struct EpiMerge {
    static constexpr bool PERM = true, AFTER_DRAIN = false, COL64 = true;
    const bf16_t* gate; bf16_t* M;
    __device__ __forceinline__ void operator()(const f32x4 (&acc)[2][2][4][2], const Unit& u, int wr, int wc, int fr_in, int fq_in) const {
        int lane_ = fr_in + 16 * fq_in; asm volatile("" : "+v"(lane_));
        const int fr = lane_ & 15, fq = lane_ >> 4;
        const int row0 = u.pm * BM + wr * 64, col0 = u.pn * BM + wc * 64, wid = wr * 4 + wc;
#pragma unroll
        for (int ab = 0; ab < 4; ++ab) { const int ai = ab >> 1, mb = (ab & 1) * 2;
            u32x4 gl[4][2], pl[4][2];
#pragma unroll
            for (int m = mb; m < mb + 2; ++m)
#pragma unroll
                for (int bj = 0; bj < 2; ++bj) { const size_t o = (size_t)(row0 + ai * HALF + m * 16 + fr) * 1024 + col0 + 8 * fq + bj * 32; gl[m][bj] = *(const u32x4*)(gate + o); if (ADD) pl[m][bj] = *(const u32x4*)(M + o); }
#pragma unroll
            for (int m = mb; m < mb + 2; ++m) { const int rg = row0 + ai * HALF + m * 16;
                u32x4 wv[2];
#pragma unroll
                for (int bj = 0; bj < 2; ++bj) { const u32x4 g = gl[m][bj];
                    float gv[8] = {bfl(g.x), bfh(g.x), bfl(g.y), bfh(g.y), bfl(g.z), bfh(g.z), bfl(g.w), bfh(g.w)};
                    float pv[8] = {0.f, 0.f, 0.f, 0.f, 0.f, 0.f, 0.f, 0.f};
                    if (ADD) { const u32x4 p = pl[m][bj]; pv[0] = bfl(p.x); pv[1] = bfh(p.x); pv[2] = bfl(p.y); pv[3] = bfh(p.y); pv[4] = bfl(p.z); pv[5] = bfh(p.z); pv[6] = bfl(p.w); pv[7] = bfh(p.w); }
                    float r[8];
#pragma unroll
                    for (int j = 0; j < 8; ++j) { const float a = j < 4 ? acc[ai][bj][m][0][j] : acc[ai][bj][m][1][j - 4]; r[j] = pv[j] + a * __builtin_amdgcn_rcpf(1.f + __expf(-gv[j])); }
                    wv[bj].x = cvt_pk_bf16(r[0], r[1]); wv[bj].y = cvt_pk_bf16(r[2], r[3]); wv[bj].z = cvt_pk_bf16(r[4], r[5]); wv[bj].w = cvt_pk_bf16(r[6], r[7]); }
                stage_store16x64(wid, fr, fq, wv[0], wv[1], M + (size_t)rg * 1024 + col0, 1024); }
        }
    }
};
template <bool IN_F32> struct EpiRes {
    static constexpr bool PERM = true, AFTER_DRAIN = false, COL64 = true;
    const float* xin_f; const bf16_t* xin_b; bf16_t* xb; float* SS;
    __device__ __forceinline__ void operator()(const f32x4 (&acc)[2][2][4][2], const Unit& u, int wr, int wc, int fr_in, int fq_in) const {
        int lane_ = fr_in + 16 * fq_in; asm volatile("" : "+v"(lane_));
        const int fr = lane_ & 15, fq = lane_ >> 4;
        const int row0 = u.pm * BM + wr * 64, col0 = u.pn * BM + wc * 64, wid = wr * 4 + wc;
#pragma unroll
        for (int ab = 0; ab < 4; ++ab) { const int ai = ab >> 1, mb = (ab & 1) * 2;
            f32x4 xl[4][2][2];
#pragma unroll
            for (int m = mb; m < mb + 2; ++m)
#pragma unroll
                for (int bj = 0; bj < 2; ++bj) { const size_t o = (size_t)(row0 + ai * HALF + m * 16 + fr) * 1024 + col0 + 8 * fq + bj * 32;
                    if (IN_F32) { xl[m][bj][0] = *(const f32x4*)(xin_f + o); xl[m][bj][1] = *(const f32x4*)(xin_f + o + 4); }
                    else { const u32x4 p = *(const u32x4*)(xin_b + o); xl[m][bj][0] = (f32x4){bfl(p.x), bfh(p.x), bfl(p.y), bfh(p.y)}; xl[m][bj][1] = (f32x4){bfl(p.z), bfh(p.z), bfl(p.w), bfh(p.w)}; } }
            float sv[4];
#pragma unroll
            for (int m = mb; m < mb + 2; ++m) { const int rg = row0 + ai * HALF + m * 16; float s = 0.f;
                u32x4 wv[2];
#pragma unroll
                for (int bj = 0; bj < 2; ++bj) { const u32x4 w = pack8(xl[m][bj][0] + acc[ai][bj][m][0], xl[m][bj][1] + acc[ai][bj][m][1]); wv[bj] = w;
                    const float r0 = bfl(w.x), r1 = bfh(w.x), r2 = bfl(w.y), r3 = bfh(w.y), r4 = bfl(w.z), r5 = bfh(w.z), r6 = bfl(w.w), r7 = bfh(w.w);
                    s += (r0 * r0 + r1 * r1) + (r2 * r2 + r3 * r3) + (r4 * r4 + r5 * r5) + (r6 * r6 + r7 * r7); }
                stage_store16x64(wid, fr, fq, wv[0], wv[1], xb + (size_t)rg * 1024 + col0, 1024);
                s = xor32_sum(xor16_sum(s)); sv[m] = s; }
#pragma unroll
            for (int m = mb; m < mb + 2; ++m) if (fq == 0) SS[(size_t)(row0 + ai * HALF + m * 16 + fr) * 16 + u.pn * 4 + wc] = sv[m];
        }
    }
};
struct EpiScale {
    static constexpr bool PERM = true, AFTER_DRAIN = false, COL64 = true;
    const float* rstd; bf16_t* O; int ldc;
    __device__ __forceinline__ void operator()(const f32x4 (&acc)[2][2][4][2], const Unit& u, int wr, int wc, int fr_in, int fq_in) const {
        int lane_ = fr_in + 16 * fq_in; asm volatile("" : "+v"(lane_));
        const int fr = lane_ & 15, fq = lane_ >> 4;
        const int row0 = u.pm * BM + wr * 64, col0 = u.pn * BM + wc * 64, wid = wr * 4 + wc;
        float rsv[2][4];
#pragma unroll
        for (int ai = 0; ai < 2; ++ai)
#pragma unroll
            for (int m = 0; m < 4; ++m) rsv[ai][m] = rstd[row0 + ai * HALF + m * 16 + fr];
#pragma unroll
        for (int ai = 0; ai < 2; ++ai)
#pragma unroll
            for (int m = 0; m < 4; ++m) { const int rg = row0 + ai * HALF + m * 16; const float rs = rsv[ai][m];
                stage_store16x64(wid, fr, fq, pack8(acc[ai][0][m][0] * rs, acc[ai][0][m][1] * rs), pack8(acc[ai][1][m][0] * rs, acc[ai][1][m][1] * rs), O + (size_t)rg * ldc + col0, ldc); }
    }
};
template <class Epi, class Sched, bool ALIGN_EPI = false, bool SP2 = false>
__device__ __forceinline__ void gemm_phase(PG8_LAS unsigned char* lds, const Gemm g, const Sched& S, const Epi& E) {
    const int tid = threadIdx.x, wid = __builtin_amdgcn_readfirstlane(tid >> 6), lane = tid & 63, wr = wid >> 2, wc = wid & 3, fr = lane & 15, fq = lane >> 4;
    const int K = g.K, nt = K / BK;
    unsigned voffA[2], voffB[2];
#pragma unroll
    for (int i = 0; i < 2; ++i) { int R, C; stage_rc(tid * 16 + i * 8192, R, C); const int Rb = Epi::PERM ? ((Epi::COL64 ? 2 * (R & ~31) : (R & ~31)) + perm32(R & 31)) : R;
        voffA[i] = (unsigned)(R * K + C) * 2u; voffB[i] = (unsigned)(Rb * K + C) * 2u; }
    const size_t kstep = (size_t)(BK * 2);
    const size_t hstep = (size_t)HALF * K * 2;
    const size_t bhstep = Epi::COL64 ? (size_t)32 * K * 2 : hstep;
    const size_t tstep = 2 * hstep;
    const unsigned ldsw = (unsigned)wid * 1024u;
    const int aoff = lds_byte(wr * 64 + fr, fq * 8), boff = lds_byte(wc * 32 + fr, fq * 8);
#define PG8_SA(b, h) (((b) * 2 + (h)) * HTB)
#define PG8_SB(b, h) ((4 + (b) * 2 + (h)) * HTB)
#define PG8_STAGE(bufoff, gbase, voff) do { _Pragma("unroll") for (int _i = 0; _i < 2; ++_i) \
        __builtin_amdgcn_global_load_lds((const unsigned*)((const char*)(gbase) + (voff)[_i]), (PG8_LAS unsigned*)(lds + (bufoff) + ldsw + _i * 8192), 16, 0, 0); } while (0)
#define PG8_LDA(dst, b, h) do { _Pragma("unroll") for (int m = 0; m < 4; ++m) _Pragma("unroll") for (int k = 0; k < 2; ++k) dst[m][k] = *(const PG8_LAS bf16x8*)(lds + PG8_SA(b, h) + aoff + m * 2048 + k * 1024); } while (0)
#define PG8_LDB(dst, b, h) do { _Pragma("unroll") for (int n = 0; n < 2; ++n) _Pragma("unroll") for (int k = 0; k < 2; ++k) dst[n][k] = *(const PG8_LAS bf16x8*)(lds + PG8_SB(b, h) + boff + n * 2048 + k * 1024); } while (0)
#define PG8_MMA(ai, bj, At, Bt) do { __builtin_amdgcn_s_setprio(1); _Pragma("unroll") for (int m = 0; m < 4; ++m) _Pragma("unroll") for (int n = 0; n < 2; ++n) _Pragma("unroll") for (int k = 0; k < 2; ++k) \
        acc[ai][bj][m][n] = __builtin_amdgcn_mfma_f32_16x16x32_bf16(Bt[n][k], At[m][k], acc[ai][bj][m][n], 0, 0, 0); __builtin_amdgcn_s_setprio(0); } while (0)
#define PG8_WAIT_V(n) asm volatile("s_waitcnt vmcnt(" #n ")" ::: "memory")
#define PG8_WAIT_L(n) asm volatile("s_waitcnt lgkmcnt(" #n ")" ::: "memory")
#define PG8_BAR __builtin_amdgcn_s_barrier()
#define PG8_SCHED __builtin_amdgcn_sched_barrier(0)
    Unit cur, nxt; int ui = 0;
    if (!S.next(0, cur)) return;
    f32x4 acc[2][2][4][2];
#pragma unroll
    for (int a = 0; a < 2; ++a)
#pragma unroll
        for (int b = 0; b < 2; ++b)
#pragma unroll
            for (int m = 0; m < 4; ++m)
#pragma unroll
                for (int n = 0; n < 2; ++n) acc[a][b][m][n] = (f32x4){0.f, 0.f, 0.f, 0.f};
    bf16x8 At[4][2], B0[2][2], B1[2][2];
    const char* cA = (const char*)g.A + (size_t)cur.pm * tstep; const char* cB = (const char*)g.Bt + (size_t)cur.pn * tstep;
    S.a_ready(cur);
    if constexpr (SP2) {
        PG8_STAGE(PG8_SB(0, 0), cB, voffB); PG8_STAGE(PG8_SB(0, 1), cB + bhstep, voffB); PG8_STAGE(PG8_SA(0, 0), cA, voffA); PG8_STAGE(PG8_SA(0, 1), cA + hstep, voffA);
        if (wr == 1) PG8_BAR;
        PG8_WAIT_V(2); PG8_BAR;
        PG8_STAGE(PG8_SB(1, 0), cB + kstep, voffB); PG8_STAGE(PG8_SA(1, 0), cA + kstep, voffA); PG8_STAGE(PG8_SB(1, 1), cB + bhstep + kstep, voffB);
        PG8_WAIT_V(6); PG8_BAR;
    } else {
        PG8_STAGE(PG8_SB(0, 0), cB, voffB); PG8_STAGE(PG8_SA(0, 0), cA, voffA); PG8_STAGE(PG8_SB(0, 1), cB + bhstep, voffB); PG8_STAGE(PG8_SA(0, 1), cA + hstep, voffA);
        if (wr == 1) PG8_BAR;
        PG8_WAIT_V(4); PG8_BAR;
        PG8_STAGE(PG8_SB(1, 0), cB + kstep, voffB); PG8_STAGE(PG8_SA(1, 0), cA + kstep, voffA); PG8_STAGE(PG8_SB(1, 1), cB + bhstep + kstep, voffB);
        PG8_WAIT_V(6); PG8_BAR;
    }
    for (;;) {
        const bool has_next = S.next(ui + 1, nxt);
        const char* nA = has_next ? (const char*)g.A + (size_t)nxt.pm * tstep : cA; const char* nB = has_next ? (const char*)g.Bt + (size_t)nxt.pn * tstep : cB;
        for (int t = 0; t < nt; t += 2) {
            const bool last = (t == nt - 2);
            const char* a1 = cA + (size_t)(t + 1) * kstep;
            const char* a2 = last ? nA : cA + (size_t)(t + 2) * kstep; const char* b2 = last ? nB : cB + (size_t)(t + 2) * kstep;
            const char* a3 = a2 + kstep; const char* b3 = b2 + kstep;
            if (last && has_next) S.a_ready(nxt);
            if constexpr (SP2) {
            PG8_LDB(B0, 0, 0); PG8_LDB(B1, 0, 1); PG8_SCHED; PG8_LDA(At, 0, 0); PG8_STAGE(PG8_SA(1, 1), a1 + hstep, voffA);
            PG8_WAIT_V(8); PG8_WAIT_L(0); PG8_BAR; PG8_MMA(0, 0, At, B0); PG8_MMA(0, 1, At, B1); PG8_BAR; PG8_SCHED;
            PG8_LDA(At, 0, 1); PG8_STAGE(PG8_SB(0, 0), b2, voffB); PG8_STAGE(PG8_SB(0, 1), b2 + bhstep, voffB); PG8_STAGE(PG8_SA(0, 0), a2, voffA);
            PG8_WAIT_V(8); PG8_WAIT_L(0); PG8_BAR; PG8_MMA(1, 0, At, B0); PG8_MMA(1, 1, At, B1); PG8_BAR; PG8_SCHED;
            PG8_LDB(B0, 1, 0); PG8_LDB(B1, 1, 1); PG8_SCHED; PG8_LDA(At, 1, 0); PG8_STAGE(PG8_SA(0, 1), a2 + hstep, voffA);
            PG8_WAIT_V(8); PG8_WAIT_L(0); PG8_BAR; PG8_MMA(0, 0, At, B0); PG8_MMA(0, 1, At, B1); PG8_BAR; PG8_SCHED;
            PG8_LDA(At, 1, 1); PG8_STAGE(PG8_SB(1, 0), b3, voffB); PG8_STAGE(PG8_SB(1, 1), b3 + bhstep, voffB); PG8_STAGE(PG8_SA(1, 0), a3, voffA);
            PG8_WAIT_V(8); PG8_WAIT_L(0); PG8_BAR; PG8_MMA(1, 0, At, B0); PG8_MMA(1, 1, At, B1); PG8_BAR; PG8_SCHED;
            } else {
            PG8_LDB(B0, 0, 0); PG8_SCHED; PG8_LDA(At, 0, 0); PG8_STAGE(PG8_SA(1, 1), a1 + hstep, voffA);
            PG8_WAIT_L(8); PG8_BAR; PG8_WAIT_L(0); PG8_MMA(0, 0, At, B0); PG8_BAR; PG8_SCHED;
            PG8_LDB(B1, 0, 1); PG8_STAGE(PG8_SB(0, 0), b2, voffB);
            PG8_BAR; PG8_WAIT_L(0); PG8_MMA(0, 1, At, B1); PG8_BAR;
            PG8_LDA(At, 0, 1); PG8_STAGE(PG8_SA(0, 0), a2, voffA);
            PG8_BAR; PG8_WAIT_L(0); PG8_MMA(1, 0, At, B0); PG8_BAR; PG8_SCHED;
            PG8_STAGE(PG8_SB(0, 1), b2 + bhstep, voffB);
            PG8_WAIT_V(6); PG8_BAR; PG8_MMA(1, 1, At, B1); PG8_BAR;
            PG8_LDB(B0, 1, 0); PG8_SCHED; PG8_LDA(At, 1, 0); PG8_STAGE(PG8_SA(0, 1), a2 + hstep, voffA);
            PG8_WAIT_L(8); PG8_BAR; PG8_WAIT_L(0); PG8_MMA(0, 0, At, B0); PG8_BAR; PG8_SCHED;
            PG8_LDB(B1, 1, 1); PG8_STAGE(PG8_SB(1, 0), b3, voffB);
            PG8_BAR; PG8_WAIT_L(0); PG8_MMA(0, 1, At, B1); PG8_BAR;
            PG8_LDA(At, 1, 1); PG8_STAGE(PG8_SA(1, 0), a3, voffA);
            PG8_BAR; PG8_WAIT_L(0); PG8_MMA(1, 0, At, B0); PG8_BAR; PG8_SCHED;
            PG8_STAGE(PG8_SB(1, 1), b3 + bhstep, voffB);
            PG8_WAIT_V(6); PG8_BAR; PG8_MMA(1, 1, At, B1); PG8_BAR;
            }
        }
        if constexpr (ALIGN_EPI) { if (wr == 0) PG8_BAR; }
        if constexpr (!Epi::AFTER_DRAIN) { E(acc, cur, wr, wc, fr, fq); S.done(cur); }
        if (!has_next) break;
#pragma unroll
        for (int a = 0; a < 2; ++a)
#pragma unroll
            for (int b = 0; b < 2; ++b)
#pragma unroll
                for (int m = 0; m < 4; ++m)
#pragma unroll
                    for (int n = 0; n < 2; ++n) acc[a][b][m][n] = (f32x4){0.f, 0.f, 0.f, 0.f};
        cur = nxt; cA = nA; cB = nB; ++ui;
        if constexpr (ALIGN_EPI) { if (wr == 1) PG8_BAR; }
    }
    PG8_WAIT_V(0);
    if constexpr (!ALIGN_EPI) { if (wr == 0) PG8_BAR; }
    PG8_BAR;
    if constexpr (Epi::AFTER_DRAIN) { E.fused(acc, cur, wr, wc, fr, fq, lds, wid, lane); S.done(cur); }
#undef PG8_SA
#undef PG8_SB
#undef PG8_STAGE
#undef PG8_LDA
#undef PG8_LDB
#undef PG8_MMA
#undef PG8_WAIT_V
#undef PG8_WAIT_L
#undef PG8_BAR
#undef PG8_SCHED
}
}
#define GAS __attribute__((address_space(1)))
#define LAS __attribute__((address_space(3)))
typedef unsigned short bf16;
typedef unsigned v4u __attribute__((ext_vector_type(4)));
typedef float f32x4 __attribute__((ext_vector_type(4)));
typedef short bf16x8 __attribute__((ext_vector_type(8)));
typedef GAS unsigned gu32;
typedef GAS unsigned long long gu64;
#define RLX_AGENT __ATOMIC_RELAXED, __HIP_MEMORY_SCOPE_AGENT
#define LDS_WAIT() asm volatile("s_waitcnt lgkmcnt(0)" ::: "memory")
#define VM_WAIT() asm volatile("s_waitcnt vmcnt(0)" ::: "memory")
__device__ __forceinline__ unsigned long long rt() { return __builtin_amdgcn_s_memrealtime(); }
__device__ __forceinline__ unsigned pk2(float lo, float hi) { return cvtpk(lo, hi); }

#define XB_TMO      128
#define XB_XCNT(j)  (256  + 64 * (j))
#define XB_XSUB(j)  (1280 + 64 * (j))
#define XB_XGEN(j)  (2304 + 64 * (j))
#define XB_TOP      3328
#define XB_TOPGEN   3392
#define XCD_BAR_WORDS 3456
#define XB_SPIN_CAP (1u << 18)

__device__ __forceinline__ unsigned xb_ld(unsigned* p)              { return __hip_atomic_load(p, __ATOMIC_RELAXED, __HIP_MEMORY_SCOPE_AGENT); }
__device__ __forceinline__ unsigned xb_add(unsigned* p, unsigned v) { return __hip_atomic_fetch_add(p, v, __ATOMIC_RELAXED, __HIP_MEMORY_SCOPE_AGENT); }
__device__ __forceinline__ unsigned xb_xcc_id() { return (unsigned)__builtin_amdgcn_s_getreg((3 << 11) | 20) & 0xFu; }
#define XB_SPIN(cond, bar) do { unsigned _sp = 0; while (cond) { __builtin_amdgcn_s_sleep(1); \
    if ((++_sp & 255u) == 0u) { if (xb_ld(&(bar)[XB_TMO])) break; if (_sp > XB_SPIN_CAP) { atomicAdd(&(bar)[XB_TMO], 1u); break; } } } } while (0)

struct XcdBarrier {
    unsigned* bar; unsigned x;
    volatile LAS unsigned* st;
};

__device__ __forceinline__ XcdBarrier xcd_barrier_post(unsigned* bar, volatile LAS unsigned* st) {
    XcdBarrier b; b.bar = bar; b.x = xb_xcc_id(); b.st = st;
    if (threadIdx.x == 0) (void)xb_add(&bar[XB_XCNT(b.x)], 1u);
    return b;
}
__device__ __forceinline__ void xcd_barrier_complete(unsigned* bar, unsigned x, unsigned& nloc, unsigned& nx) {
    const unsigned G = gridDim.x * gridDim.y * gridDim.z;
    unsigned sum, cnt, mine, sp = 0u;
    for (;;) {
        sum = 0u; cnt = 0u; mine = 0u;
#pragma unroll
        for (unsigned j = 0; j < 16; ++j) { const unsigned c = xb_ld(&bar[XB_XCNT(j)]); sum += c; cnt += (c > 0u) ? 1u : 0u; mine = (j == x) ? c : mine; }
        if (sum == G) break;
        __builtin_amdgcn_s_sleep(1);
        if ((++sp & 255u) == 0u) { if (xb_ld(&bar[XB_TMO])) break; if (sp > XB_SPIN_CAP) { atomicAdd(&bar[XB_TMO], 1u); break; } }
    }
    nloc = mine > 0u ? mine : 1u; nx = cnt > 0u ? cnt : 1u;
}

__device__ __forceinline__ void xcd_barrier(const XcdBarrier& b) {
    asm volatile("s_waitcnt vmcnt(0)" ::: "memory");
    __syncthreads();
    if (threadIdx.x == 0) {
        unsigned* bar = b.bar;
        __builtin_amdgcn_s_waitcnt(0);
        unsigned nloc = b.st[0], nx = b.st[1];
        if (nloc == 0u) { xcd_barrier_complete(bar, b.x, nloc, nx); b.st[0] = nloc; b.st[1] = nx; }
        const unsigned old = xb_add(&bar[XB_XSUB(b.x)], 1u);
        const unsigned gen = old / nloc;
        if (old + 1u == (gen + 1u) * nloc) {
            __builtin_amdgcn_fence(__ATOMIC_RELEASE, "agent");
            asm volatile("s_waitcnt vmcnt(0)" ::: "memory");
            const unsigned og = xb_add(&bar[XB_TOP], 1u);
            const unsigned tg = og / nx;
            if (og + 1u == (tg + 1u) * nx) xb_add(&bar[XB_TOPGEN], 1u);
            else XB_SPIN(xb_ld(&bar[XB_TOPGEN]) == tg, bar);
            __builtin_amdgcn_fence(__ATOMIC_ACQUIRE, "agent");
            xb_add(&bar[XB_XGEN(b.x)], 1u);
            asm volatile("s_waitcnt vmcnt(0)" ::: "memory");
        } else {
            XB_SPIN(xb_ld(&bar[XB_XGEN(b.x)]) == gen, bar);
            __builtin_amdgcn_fence(__ATOMIC_ACQUIRE, "agent");
            asm volatile("s_waitcnt vmcnt(0)" ::: "memory");
        }
    }
    __syncthreads();
}
constexpr size_t KiB = 1024;
constexpr size_t WS_CTL = 0, CTL_ZERO_BYTES = 1 * MiB;
constexpr size_t WS_WIN = 1 * MiB, WS_WSB = 12 * MiB, WS_WGDN = 13 * MiB, WS_WMIX = 14 * MiB, WS_WCQ = 16 * MiB, WS_WCO = 18 * MiB, WS_WCKV = 20 * MiB, WS_WPQ = 24 * MiB, WS_SKB = 28 * MiB, WS_U16 = 30 * MiB, WS_V16 = 62 * MiB;
constexpr size_t WS_RSTD0 = 94 * MiB, WS_RSTD2 = 94 * MiB + 256 * KiB, WS_CD = 94 * MiB + 384 * KiB, WS_GB = 94 * MiB + 512 * KiB;
constexpr size_t WS_MN = 96 * MiB, WS_KC = 98 * MiB, WS_VC = 100 * MiB, WS_SS = 102 * MiB;
constexpr size_t WS_A0 = 104 * MiB;
constexpr size_t WS_NW = 104 * MiB, WS_QD = 136 * MiB;
constexpr size_t WS_A1 = 168 * MiB;
constexpr size_t WS_ORAW = 168 * MiB, WS_OSS = 200 * MiB, WS_OG = 232 * MiB;
constexpr size_t WS_GZ = 264 * MiB;
constexpr size_t WS_GSB = 296 * MiB, WS_GGDN = 360 * MiB;
constexpr size_t WS_KDT = 424 * MiB, WS_QK = 456 * MiB, WS_UT = 472 * MiB;
constexpr size_t WS_U8 = 30 * MiB, WS_V8 = 46 * MiB, WS_SUV = 62 * MiB;
constexpr size_t WS_PART = 344 * MiB;
constexpr size_t WS_END = 512 * MiB;
constexpr int CW_SUB = 12288;
constexpr int CW_BAR = 4096;

constexpr int NWAVES = 8;
constexpr int RING_BYTES = 131072, LDSCTL_OFF = RING_BYTES, MISC_OFF = LDSCTL_OFF + 320, LDS_BYTES = 149504;

struct Args {
    const float *x, *mem, *g_mix, *w_in, *gdn_conv, *a_log, *dt_bias, *gdn_norm_g, *w_sb_up, *w_gdn_up, *w_mix_out, *g_cross, *g_mem, *w_cq, *w_ckv, *w_co, *g_peer, *w_pq, *subkeys, *peer_u, *peer_v, *g_final;
    float* out; unsigned char* ws; int ph_lo, ph_hi, bar_region, pad;
};

struct Frame {
    LAS unsigned char* lds; int tid, lane, wave, vcu, G;
};


typedef short bf16x8_t __attribute__((ext_vector_type(8)));
typedef float f32x16_t __attribute__((ext_vector_type(16)));
typedef short v4i16_t __attribute__((ext_vector_type(4)));
__device__ __forceinline__ v4i16_t lds_tr16(LAS unsigned char* p) { return __builtin_amdgcn_ds_read_tr16_b64_v4i16((LAS v4i16_t*)p); }

__device__ __forceinline__ void sb_phase(LAS unsigned char* wlds  , const bf16_t* SBQ, const bf16_t* SBK, const bf16_t* SBV, bf16_t* OSB, int gw, int ngw, int lane) {
    const int q = lane & 31, hi = lane >> 5;
    bf16x8_t Mf[2];
#pragma unroll
    for (int s = 0; s < 2; ++s)
#pragma unroll
        for (int j = 0; j < 8; ++j) { const int k = 16 * s + 8 * (j >> 2) + 4 * hi + (j & 3); Mf[s][j] = (k > q) ? (short)0x3F80 : (short)0; }
    const int vrow = lane >> 3, vch = lane & 7;
    const int g4 = lane >> 4, qq = (lane >> 2) & 3, p4 = lane & 3;
    LAS unsigned char* trb = wlds + (4 * (g4 >> 1) + qq) * 192 + ((g4 & 1) * 16 + 4 * p4) * 2;
    for (int item = gw; item < 32 * 256; item += ngw) {
        const int bh = item >> 8, qt = item & 255, b = bh >> 3, h = bh & 7;
        const size_t base = (size_t)b * SEQ;
        const bf16_t* Qp = SBQ + (base + qt * 32 + q) * 512 + h * 64 + 8 * hi;
        bf16x8_t Qf[4];
#pragma unroll
        for (int ks = 0; ks < 4; ++ks) Qf[ks] = *(const bf16x8_t*)(Qp + 16 * ks);
        f32x16_t o0 = {}, o1 = {};
        float carry = 0.f;
        bf16x8_t Kn[4]; v4u vn[4];
        {   const bf16_t* Kp = SBK + (base + qt * 32 + q) * 512 + h * 64 + 8 * hi;
#pragma unroll
            for (int ks = 0; ks < 4; ++ks) Kn[ks] = *(const bf16x8_t*)(Kp + 16 * ks);
#pragma unroll
            for (int i = 0; i < 4; ++i) vn[i] = *(const v4u*)(SBV + (base + qt * 32 + vrow + 8 * i) * 512 + h * 64 + vch * 8); }
        for (int kb = qt; kb >= 0; --kb) {
            bf16x8_t Kf[4]; v4u vv[4];
#pragma unroll
            for (int ks = 0; ks < 4; ++ks) Kf[ks] = Kn[ks];
#pragma unroll
            for (int i = 0; i < 4; ++i) vv[i] = vn[i];
            {   const int kn = kb > 0 ? kb - 1 : 0;
                const bf16_t* Kp = SBK + (base + kn * 32 + q) * 512 + h * 64 + 8 * hi;
#pragma unroll
                for (int ks = 0; ks < 4; ++ks) Kn[ks] = *(const bf16x8_t*)(Kp + 16 * ks);
#pragma unroll
                for (int i = 0; i < 4; ++i) vn[i] = *(const v4u*)(SBV + (base + kn * 32 + vrow + 8 * i) * 512 + h * 64 + vch * 8); }
            f32x16_t st = {};
#pragma unroll
            for (int ks = 0; ks < 4; ++ks) st = __builtin_amdgcn_mfma_f32_32x32x16_bf16(Kf[ks], Qf[ks], st, 0, 0, 0);
#pragma unroll
            for (int i = 0; i < 4; ++i) *(LAS v4u*)(wlds + (vrow + 8 * i) * 192 + vch * 16) = vv[i];
            const bool diag = (kb == qt);
            float z[16], lk[16];
#pragma unroll
            for (int r = 0; r < 16; ++r) {
                const int key = (r & 3) + 8 * (r >> 2) + 4 * hi;
                z[r] = st[r] * 0.125f;
                const float sp = fmaxf(z[r], 0.f) + __logf(1.f + __expf(-fabsf(z[r])));
                const bool valid = !diag || key < q;
                lk[r] = valid ? -sp : 0.f;
                z[r] = valid ? z[r] - sp : -INFINITY;
            }
            bf16x8_t lh[2], ll[2];
#pragma unroll
            for (int s = 0; s < 2; ++s) {
                unsigned wh[4], wl[4];
#pragma unroll
                for (int jj = 0; jj < 4; ++jj) { const float a = lk[8 * s + 2 * jj], c = lk[8 * s + 2 * jj + 1]; wh[jj] = cvtpk(a, c);
                    wl[jj] = cvtpk(a - __uint_as_float(wh[jj] << 16), c - __uint_as_float(wh[jj] & 0xffff0000u)); }
                lh[s] = __builtin_bit_cast(bf16x8_t, (v4u){wh[0], wh[1], wh[2], wh[3]}); ll[s] = __builtin_bit_cast(bf16x8_t, (v4u){wl[0], wl[1], wl[2], wl[3]});
            }
            f32x16_t af;
#pragma unroll
            for (int r = 0; r < 16; ++r) af[r] = carry;
            af = __builtin_amdgcn_mfma_f32_32x32x16_bf16(Mf[0], lh[0], af, 0, 0, 0);
            af = __builtin_amdgcn_mfma_f32_32x32x16_bf16(Mf[1], lh[1], af, 0, 0, 0);
            af = __builtin_amdgcn_mfma_f32_32x32x16_bf16(Mf[0], ll[0], af, 0, 0, 0);
            af = __builtin_amdgcn_mfma_f32_32x32x16_bf16(Mf[1], ll[1], af, 0, 0, 0);
            float tot = af[0] + lk[0];
            tot = lower32_bcast(tot);
            float pr[16];
#pragma unroll
            for (int r = 0; r < 16; ++r) pr[r] = __expf(z[r] + af[r]);
            bf16x8_t pa[2];
#pragma unroll
            for (int s = 0; s < 2; ++s) pa[s] = __builtin_bit_cast(bf16x8_t, (v4u){cvtpk(pr[8 * s], pr[8 * s + 1]), cvtpk(pr[8 * s + 2], pr[8 * s + 3]), cvtpk(pr[8 * s + 4], pr[8 * s + 5]), cvtpk(pr[8 * s + 6], pr[8 * s + 7])});
            asm volatile("s_waitcnt lgkmcnt(0)" ::: "memory");
#pragma unroll
            for (int s = 0; s < 2; ++s) {
                const v4i16_t a0 = lds_tr16(trb + (16 * s) * 192), a1 = lds_tr16(trb + (16 * s + 8) * 192);
                const v4i16_t c0 = lds_tr16(trb + (16 * s) * 192 + 64), c1 = lds_tr16(trb + (16 * s + 8) * 192 + 64);
                const bf16x8_t vb0 = {a0[0], a0[1], a0[2], a0[3], a1[0], a1[1], a1[2], a1[3]}, vb1 = {c0[0], c0[1], c0[2], c0[3], c1[0], c1[1], c1[2], c1[3]};
                o0 = __builtin_amdgcn_mfma_f32_32x32x16_bf16(pa[s], vb0, o0, 0, 0, 0);
                o1 = __builtin_amdgcn_mfma_f32_32x32x16_bf16(pa[s], vb1, o1, 0, 0, 0);
            }
            carry = tot;
            if (__all(carry < -104.f)) break;
        }
        bf16_t* Op = OSB + (base + qt * 32) * 512 + h * 64 + q;
#pragma unroll
        for (int r = 0; r < 16; ++r) { const int row = (r & 3) + 8 * (r >> 2) + 4 * hi; Op[(size_t)row * 512] = f2bf(o0[r]); Op[(size_t)row * 512 + 32] = f2bf(o1[r]); }
    }
}
typedef float f32x4_t __attribute__((ext_vector_type(4)));
typedef unsigned v2u __attribute__((ext_vector_type(2)));
__device__ __forceinline__ float bflo(unsigned w) { return __uint_as_float(w << 16); }
__device__ __forceinline__ float bfhi(unsigned w) { return __uint_as_float(w & 0xffff0000u); }
__device__ __forceinline__ int frag_off(int r, int k0, int KS) { return (((r >> 4) * KS + (k0 >> 5)) << 9) + (((r & 15) + 16 * ((k0 & 15) >> 2)) << 3) + (((k0 & 31) >> 4) << 2); }

constexpr int GP_KS = 0, GP_QS = 17408, GP_VS = 34816, GP_AS = 52224, GP_WT = 69632, GP_GC = 87040, GP_BETA = 87296, GP_EGC = 87552, GP_CW = 88064, GP_TS = 94208;
constexpr int GROW = 136;

#define LDS_BARRIER() do { asm volatile("s_waitcnt lgkmcnt(0)" ::: "memory"); __builtin_amdgcn_s_barrier(); asm volatile("" ::: "memory"); } while (0)
struct GdnBufs { bf16_t *NW, *QD, *KDT, *QK, *UT; float* CD; bf16_t* ORAW; float* OSS; };

__device__ __forceinline__ void gdn_prep_phase(Frame& F, const Args& a, const bf16_t* GQKV, const float* GB, const float* GA, const GdnBufs& Gb) {
    LAS unsigned char* L = F.lds;
    LAS bf16_t* KS = (LAS bf16_t*)(L + GP_KS); LAS bf16_t* QS = (LAS bf16_t*)(L + GP_QS); LAS bf16_t* VS = (LAS bf16_t*)(L + GP_VS); LAS bf16_t* WT = (LAS bf16_t*)(L + GP_WT);
    LAS float* AS = (LAS float*)(L + GP_AS); LAS float* GC = (LAS float*)(L + GP_GC); LAS float* BETA = (LAS float*)(L + GP_BETA); LAS float* EGC = (LAS float*)(L + GP_EGC); LAS float* GALL = (LAS float*)(L + 100352); LAS float* CW = (LAS float*)(L + GP_CW); LAS float* TS = (LAS float*)(L + GP_TS);
    const int tid = F.tid, lane = F.lane, wave = F.wave;
    const int per = (2048 + F.G - 1) / F.G;
    const bool pre = per <= NWAVES;
    if (pre) {
        const int item = F.vcu * per + wave;
        if (wave < per && item < 2048) { const int bh = item >> 7, n = item & 127, b = bh >> 2, h = bh & 3; const size_t t = (size_t)b * SEQ + n * 64 + lane;
            float g = -__expf(a.a_log[h]) * softplusf_(GA[t * 4 + h] + a.dt_bias[h]);
#pragma unroll
            for (int o = 1; o < 64; o <<= 1) { const float up = __shfl_up(g, o); if (lane >= o) g += up; }
            GALL[wave * 64 + lane] = g; GALL[512 + wave * 64 + lane] = sigmoidf_(GB[t * 4 + h]); GALL[1024 + wave * 64 + lane] = __expf(g);
            if (lane == 63) Gb.CD[item] = __expf(g); }
        LDS_BARRIER();
    }
    int hcur = -1;
    for (int ii = 0; ii < per; ++ii) {
        const int item = F.vcu * per + ii; if (item >= 2048) break;
        if (pre) { GC = GALL + ii * 64; BETA = GALL + 512 + ii * 64; EGC = GALL + 1024 + ii * 64; }
        const int bh = item >> 7, n = item & 127, b = bh >> 2, h = bh & 3;
        const size_t t0 = (size_t)b * SEQ + n * 64;
        if (h != hcur) { hcur = h; for (int i = tid; i < 1536; i += NWAVES * 64) { const int j = i / 384, cc = i % 384; CW[i] = a.gdn_conv[j * 1536 + (cc >> 7) * 512 + h * 128 + (cc & 127)]; } LDS_BARRIER(); }
        unsigned pf = 0u;
        if (ii + 1 < per && item + 1 < 2048 && tid < 384) {
            const int r = tid / 6, q6 = tid % 6; const int item2 = item + 1, bh2 = item2 >> 7, n2 = item2 & 127;
            pf = *(const unsigned*)(GQKV + ((size_t)(bh2 >> 2) * SEQ + n2 * 64 + r) * 1536 + (q6 >> 1) * 512 + (bh2 & 3) * 128 + (q6 & 1) * 64);
        }
        if (!pre && wave == 0) {
            const size_t t = t0 + lane;
            float g = -__expf(a.a_log[h]) * softplusf_(GA[t * 4 + h] + a.dt_bias[h]);
#pragma unroll
            for (int o = 1; o < 64; o <<= 1) { const float up = __shfl_up(g, o); if (lane >= o) g += up; }
            GC[lane] = g; BETA[lane] = sigmoidf_(GB[t * 4 + h]); EGC[lane] = __expf(g);
            if (lane == 63) Gb.CD[item] = __expf(g);
        }
#define GP_STAGE_A(MASKED) do { const int c = tid >> 3, d0 = (tid & 7) * 16; \
            _Pragma("unroll") for (int part = 0; part < 3; ++part) { \
                float acc[16]; \
                _Pragma("unroll") for (int i = 0; i < 16; ++i) acc[i] = 0.f; \
                _Pragma("unroll") for (int j = 0; j < 4; ++j) { \
                    const bool ok = !(MASKED) || (c - 3 + j >= 0); const float wz = ok ? 1.f : 0.f; \
                    const bf16_t* src = GQKV + (ok ? t0 + c - 3 + j : t0) * 1536 + part * 512 + h * 128 + d0; \
                    const v4u r0 = *(const v4u*)src, r1 = *(const v4u*)(src + 8); \
                    const unsigned rw[8] = {r0.x, r0.y, r0.z, r0.w, r1.x, r1.y, r1.z, r1.w}; \
                    const LAS float* cw = CW + j * 384 + part * 128 + d0; \
                    _Pragma("unroll") for (int i = 0; i < 8; ++i) { if (MASKED) { acc[2 * i] += bflo(rw[i]) * (cw[2 * i] * wz); acc[2 * i + 1] += bfhi(rw[i]) * (cw[2 * i + 1] * wz); } \
                                                                    else { acc[2 * i] += bflo(rw[i]) * cw[2 * i]; acc[2 * i + 1] += bfhi(rw[i]) * cw[2 * i + 1]; } } \
                } \
                float ss = 0.f; \
                _Pragma("unroll") for (int i = 0; i < 16; ++i) { acc[i] = acc[i] * __builtin_amdgcn_rcpf(1.f + __expf(-acc[i])); ss += acc[i] * acc[i]; } \
                if (part < 2) { ss += dpp_f<DPP_X1>(ss); ss += dpp_f<DPP_X2>(ss); ss += dpp_f<DPP_HM>(ss); const float inv = rsqrtf(ss + EPS); \
                    _Pragma("unroll") for (int i = 0; i < 16; ++i) acc[i] *= inv; } \
                LAS bf16_t* dst = (part == 0 ? QS : part == 1 ? KS : VS) + c * GROW + d0; \
                v4u w0, w1; w0.x = cvtpk(acc[0], acc[1]); w0.y = cvtpk(acc[2], acc[3]); w0.z = cvtpk(acc[4], acc[5]); w0.w = cvtpk(acc[6], acc[7]); \
                w1.x = cvtpk(acc[8], acc[9]); w1.y = cvtpk(acc[10], acc[11]); w1.z = cvtpk(acc[12], acc[13]); w1.w = cvtpk(acc[14], acc[15]); \
                *(LAS v4u*)dst = w0; *(LAS v4u*)(dst + 8) = w1; \
            } } while (0)
        if (n == 0) GP_STAGE_A(true); else GP_STAGE_A(false);
#undef GP_STAGE_A
        LDS_BARRIER();
        {
            const int fr = lane & 15, g = lane >> 4;
            for (int task = wave; task < 26; task += NWAVES) {
                const bool isKK = task < 10; int ct, mt;
                if (isKK) { ct = task >= 6 ? 3 : task >= 3 ? 2 : task >= 1 ? 1 : 0; mt = task - ct * (ct + 1) / 2; } else { ct = (task - 10) >> 2; mt = (task - 10) & 3; }
                f32x4_t acc = {0.f, 0.f, 0.f, 0.f};
                if (mt <= ct) {
                    const LAS bf16_t* Ap = KS + (mt * 16 + fr) * GROW + 8 * g; const LAS bf16_t* Bp = (isKK ? KS : QS) + (ct * 16 + fr) * GROW + 8 * g;
#pragma unroll
                    for (int ks = 0; ks < 4; ++ks) acc = __builtin_amdgcn_mfma_f32_16x16x32_bf16(*(const LAS bf16x8_t*)(Ap + 32 * ks), *(const LAS bf16x8_t*)(Bp + 32 * ks), acc, 0, 0, 0);
                }
                const int c = ct * 16 + fr, m0 = mt * 16 + 4 * g; const float gcc = GC[c];
                float v[4];
#pragma unroll
                for (int r = 0; r < 4; ++r) { const int m = m0 + r; const float dec = __expf(fminf(gcc - GC[m], 0.f)); v[r] = acc[r] * dec; }
                if (isKK) { const float bc = BETA[c];
                    f32x4_t o;
#pragma unroll
                    for (int r = 0; r < 4; ++r) o[r] = (c > m0 + r) ? v[r] * bc : 0.f;
                    *(LAS f32x4_t*)(AS + c * 68 + m0) = o;
                } else {
#pragma unroll
                    for (int r = 0; r < 4; ++r) v[r] = (c >= m0 + r) ? v[r] * 0.08838834764831845f : 0.f;
                    v2u w; w.x = cvtpk(v[0], v[1]); w.y = cvtpk(v[2], v[3]);
                    *(v2u*)(Gb.QK + (size_t)item * 4096 + (ct * 2 + (mt >> 1)) * 512 + lane * 8 + (mt & 1) * 4) = w;
                }
            }
        }
        LDS_BARRIER();
        if (wave == 0) {
            const int q4 = lane >> 4, c = lane & 15; const LAS float* Ab = AS + (16 * q4) * 68 + 16 * q4;
            float t[16];
#pragma unroll
            for (int r = 0; r < 16; ++r) { float s = (r == c) ? 1.f : 0.f;
#pragma unroll
                for (int j4 = 0; j4 < (r + 3) / 4; ++j4) { const f32x4_t av = *(const LAS f32x4_t*)(Ab + r * 68 + 4 * j4);
#pragma unroll
                    for (int i = 0; i < 4; ++i) if (4 * j4 + i < r) s -= av[i] * t[4 * j4 + i]; }
                t[r] = s; TS[(q4 * 16 + r) * 20 + c] = (r == c) ? 0.f : s; }
        }
        else {
            const float glast = GC[63];
            for (int p = tid - 64; p < 2048; p += 448) { const int c = p >> 5, d0 = (p & 31) * 4; const v2u r = *(const LAS v2u*)(QS + c * GROW + d0); const float sc = EGC[c] * 0.08838834764831845f;
                v2u w; w.x = cvtpk(bflo(r.x) * sc, bfhi(r.x) * sc); w.y = cvtpk(bflo(r.y) * sc, bfhi(r.y) * sc);
                *(v2u*)(Gb.QD + (size_t)item * 8192 + frag_off(c, d0, 4)) = w; }
            for (int p = tid - 64; p < 2048; p += 448) { const int d = p >> 4, c0 = (p & 15) * 4; float v[4];
#pragma unroll
                for (int r = 0; r < 4; ++r) v[r] = bf2f(KS[(c0 + r) * GROW + d]) * __expf(glast - GC[c0 + r]);
                v2u w; w.x = cvtpk(v[0], v[1]); w.y = cvtpk(v[2], v[3]);
                *(v2u*)(Gb.KDT + (size_t)item * 8192 + frag_off(d, c0, 2)) = w; }
        }
        LDS_BARRIER();
        {
            const int fr = lane & 15, g = lane >> 4;
#pragma unroll
            for (int cc = 0; cc < 2; ++cc) {
                const int ct2 = wave * 2 + cc; const bool isW = ct2 >= 8; const int col = (ct2 & 7) * 16 + fr;
                const LAS bf16_t* src = (isW ? KS : VS) + col;
                unsigned xb[4][2];
#pragma unroll
                for (int i = 0; i < 4; ++i) {
                    f32x4_t y;
#pragma unroll
                    for (int r = 0; r < 4; ++r) { const int row = 16 * i + 4 * g + r; float v = bf2f(src[row * GROW]) * BETA[row]; if (isW) v *= EGC[row]; y[r] = v; }
#pragma unroll
                    for (int j = 0; j < i; j += 2) {
                        const LAS float* ap = AS + (16 * i + fr) * 68 + 16 * j + 4 * g;
                        const f32x4_t a0 = *(const LAS f32x4_t*)ap; f32x4_t a1 = {0.f, 0.f, 0.f, 0.f}; if (j + 1 < i) a1 = *(const LAS f32x4_t*)(ap + 16);
                        const bf16x8_t af = __builtin_bit_cast(bf16x8_t, (v4u){cvtpk(-a0[0], -a0[1]), cvtpk(-a0[2], -a0[3]), cvtpk(-a1[0], -a1[1]), cvtpk(-a1[2], -a1[3])});
                        const bf16x8_t bfr = __builtin_bit_cast(bf16x8_t, (v4u){xb[j][0], xb[j][1], (j + 1 < i) ? xb[j + 1][0] : 0u, (j + 1 < i) ? xb[j + 1][1] : 0u});
                        y = __builtin_amdgcn_mfma_f32_16x16x32_bf16(af, bfr, y, 0, 0, 0);
                    }
                    const f32x4_t tv = *(const LAS f32x4_t*)(TS + (i * 16 + fr) * 20 + 4 * g);
                    const bf16x8_t tf = __builtin_bit_cast(bf16x8_t, (v4u){cvtpk(tv[0], tv[1]), cvtpk(tv[2], tv[3]), 0u, 0u});
                    const bf16x8_t yf = __builtin_bit_cast(bf16x8_t, (v4u){cvtpk(y[0], y[1]), cvtpk(y[2], y[3]), 0u, 0u});
                    const f32x4_t x = __builtin_amdgcn_mfma_f32_16x16x32_bf16(tf, yf, y, 0, 0, 0);
                    xb[i][0] = cvtpk(x[0], x[1]); xb[i][1] = cvtpk(x[2], x[3]);
                    if (!isW) { *(v2u*)(Gb.UT + (size_t)item * 8192 + col * 64 + 16 * i + 4 * g) = (v2u){xb[i][0], xb[i][1]}; }
                    else {
#pragma unroll
                        for (int r = 0; r < 4; ++r) WT[(16 * i + 4 * g + r) * GROW + col] = f2bf(-x[r]); }
                }
            }
        }
        LDS_BARRIER();
#pragma unroll
        for (int i = 0; i < 4; ++i) { const int p = tid + 512 * i, c = p >> 5, d0 = (p & 31) * 4; const v2u r = *(const LAS v2u*)(WT + c * GROW + d0);
            *(v2u*)(Gb.NW + (size_t)item * 8192 + frag_off(c, d0, 4)) = r; }
        asm volatile("" :: "v"(pf));
        LDS_BARRIER();
    }
}

template <int ROT0> __device__ __forceinline__ void gdn_scan_unit_t(Frame& F, int s, const GdnBufs& Gb) {
    const int bh = s >> 2, half = s & 3, h = bh & 3, b = bh >> 2;
    const int tid = F.tid, lane = F.lane, wave = F.wave, fr = lane & 15, g = lane >> 4;
    LAS unsigned char* L = F.lds;
    const size_t tb = (size_t)b * SEQ;
    const int item0 = bh * 128;
    const int lt = tid - 256;
#define GDN_SRC(it, i) ((i) < 4 ? (const v4u*)(Gb.NW + (size_t)(it) * 8192) + lt + 256 * (i) : (i) < 8 ? (const v4u*)(Gb.QD + (size_t)(it) * 8192) + lt + 256 * ((i) - 4) : \
                        (i) < 12 ? (const v4u*)(Gb.KDT + (size_t)(it) * 8192) + lt + 256 * ((i) - 8) : (i) < 14 ? (const v4u*)(Gb.QK + (size_t)(it) * 4096) + lt + 256 * ((i) - 12) : \
                        (const v4u*)(Gb.UT + (size_t)(it) * 8192 + half * 2048) + lt + 256 * ((i) - 14))
#define GDN_LOADR(R, it) do { _Pragma("unroll") for (int k_ = 0; k_ < 15; ++k_) { const int i_ = (k_ + ROT0) % 15; R[i_] = *GDN_SRC(it, i_); } } while (0)
#define GDN_STORER(R, bufp) do { _Pragma("unroll") for (int i_ = 0; i_ < 15; ++i_) *(LAS v4u*)((bufp) + (i_ * 256 + lt) * 16) = R[i_]; } while (0)
    LAS float* CDL = (LAS float*)(L + 131072 + 1024);
    LAS bf16_t* OTB = (LAS bf16_t*)(L + 131072 + 2048);
#define GDN_OSTORE(step) do { if (wave < 6 && (step) < 128) { const LAS bf16_t* ot_ = OTB + ((wave - 4) * 2 + ((step) & 1)) * 1024; \
        const v4u o0_ = *(const LAS v4u*)(ot_ + lane * 16), o1_ = *(const LAS v4u*)(ot_ + lane * 16 + 8); \
        bf16_t* dst_ = Gb.ORAW + (tb + (size_t)(step) * 64 + lane) * 512 + h * 128 + half * 32 + (wave - 4) * 16; *(v4u*)dst_ = o0_; *(v4u*)(dst_ + 8) = o1_; } } while (0)
    if (wave >= 4) {
        if (wave == 4) { CDL[lane] = Gb.CD[item0 + lane]; CDL[64 + lane] = Gb.CD[item0 + 64 + lane]; }
        v4u r0[15], r1[15], r2[15];
        GDN_LOADR(r0, item0); GDN_LOADR(r1, item0 + 1); GDN_LOADR(r2, item0 + 2);
        GDN_STORER(r0, L);
        LDS_BARRIER();
#define GDN_CL(k) (item0 + ((k) < 127 ? (k) : 127))
        for (int n = 0; n < 129; n += 3) {
            GDN_LOADR(r0, GDN_CL(n + 3)); GDN_STORER(r1, L + ((n + 1) & 1) * 65536); LDS_BARRIER(); GDN_OSTORE(n);
            GDN_LOADR(r1, GDN_CL(n + 4)); GDN_STORER(r2, L + ((n + 2) & 1) * 65536); LDS_BARRIER(); GDN_OSTORE(n + 1);
            GDN_LOADR(r2, GDN_CL(n + 5)); GDN_STORER(r0, L + ((n + 3) & 1) * 65536); LDS_BARRIER(); GDN_OSTORE(n + 2);
        }
#undef GDN_CL
    } else if (wave >= 2) {
        for (int n = 0; n < 130; ++n) LDS_BARRIER();
    } else {
        LDS_BARRIER();
        f32x4_t S[8];
#pragma unroll
        for (int i = 0; i < 8; ++i) S[i] = (f32x4_t){0.f, 0.f, 0.f, 0.f};
        for (int n = 0; n < 128; ++n) {
            LAS unsigned char* B = L + (n & 1) * 65536;
            const float cd = CDL[n];
            bf16x8_t sb[4];
#pragma unroll
            for (int ks = 0; ks < 4; ++ks) sb[ks] = __builtin_bit_cast(bf16x8_t, (v4u){cvtpk(S[2 * ks][0], S[2 * ks][1]), cvtpk(S[2 * ks][2], S[2 * ks][3]), cvtpk(S[2 * ks + 1][0], S[2 * ks + 1][1]), cvtpk(S[2 * ks + 1][2], S[2 * ks + 1][3])});
#define GDN_SB() __builtin_amdgcn_sched_barrier(0)
            const LAS unsigned char* Bl = B + lane * 16;
            v2u u8[4]; bf16x8_t fa[16], fb[16];
#pragma unroll
            for (int rt = 0; rt < 4; ++rt) u8[rt] = *(const LAS v2u*)(B + 57344 + ((wave * 16 + fr) * 64 + 16 * rt + 4 * g) * 2);
#pragma unroll
            for (int i = 0; i < 16; ++i) fa[i] = *(const LAS bf16x8_t*)(Bl + ((i & 3) * 4 + (i >> 2)) * 1024);
            GDN_SB();
#pragma unroll
            for (int i = 0; i < 16; ++i) fb[i] = *(const LAS bf16x8_t*)(Bl + 16384 + ((i & 3) * 4 + (i >> 2)) * 1024);
            GDN_SB();
            f32x4_t va[4], oa[4];
#pragma unroll
            for (int rt = 0; rt < 4; ++rt) { va[rt] = (f32x4_t){bflo(u8[rt].x), bfhi(u8[rt].x), bflo(u8[rt].y), bfhi(u8[rt].y)}; oa[rt] = (f32x4_t){0.f, 0.f, 0.f, 0.f}; }
#pragma unroll
            for (int i = 0; i < 16; ++i) va[i & 3] = __builtin_amdgcn_mfma_f32_16x16x32_bf16(fa[i], sb[i >> 2], va[i & 3], 0, 0, 0);
            GDN_SB();
#pragma unroll
            for (int i = 0; i < 8; ++i) fa[i] = *(const LAS bf16x8_t*)(Bl + 49152 + ((i & 3) * 2 + (i >> 2)) * 1024);
#pragma unroll
            for (int i = 0; i < 8; ++i) fa[8 + i] = *(const LAS bf16x8_t*)(Bl + 32768 + ((i & 3) * 2 + (i >> 2)) * 1024);
            GDN_SB();
#pragma unroll
            for (int i = 0; i < 16; ++i) oa[i & 3] = __builtin_amdgcn_mfma_f32_16x16x32_bf16(fb[i], sb[i >> 2], oa[i & 3], 0, 0, 0);
            bf16x8_t vb[2];
#pragma unroll
            for (int k2 = 0; k2 < 2; ++k2) vb[k2] = __builtin_bit_cast(bf16x8_t, (v4u){cvtpk(va[2 * k2][0], va[2 * k2][1]), cvtpk(va[2 * k2][2], va[2 * k2][3]), cvtpk(va[2 * k2 + 1][0], va[2 * k2 + 1][1]), cvtpk(va[2 * k2 + 1][2], va[2 * k2 + 1][3])});
#pragma unroll
            for (int dt = 0; dt < 8; ++dt) S[dt] = S[dt] * cd;
            GDN_SB();
#pragma unroll
            for (int i = 0; i < 8; ++i) fb[i] = *(const LAS bf16x8_t*)(Bl + 32768 + 8192 + ((i & 3) * 2 + (i >> 2)) * 1024);
            GDN_SB();
#pragma unroll
            for (int i = 0; i < 8; ++i) oa[i & 3] = __builtin_amdgcn_mfma_f32_16x16x32_bf16(fa[i], vb[i >> 2], oa[i & 3], 0, 0, 0);
#pragma unroll
            for (int i = 0; i < 8; ++i) S[i & 3] = __builtin_amdgcn_mfma_f32_16x16x32_bf16(fa[8 + i], vb[i >> 2], S[i & 3], 0, 0, 0);
            GDN_SB();
#pragma unroll
            for (int i = 0; i < 8; ++i) S[4 + (i & 3)] = __builtin_amdgcn_mfma_f32_16x16x32_bf16(fb[i], vb[i >> 2], S[4 + (i & 3)], 0, 0, 0);
            GDN_SB();
#undef GDN_SB
            { LAS bf16_t* OT = OTB + (wave * 2 + (n & 1)) * 1024;
#pragma unroll
              for (int rt = 0; rt < 4; ++rt)
#pragma unroll
                for (int r = 0; r < 4; ++r) OT[(16 * rt + 4 * g + r) * 16 + fr] = f2bf(oa[rt][r]); }
            LDS_BARRIER();
        }
        LDS_BARRIER();
    }
#undef GDN_SRC
#undef GDN_LOADR
#undef GDN_OSTORE
#undef GDN_STORER
}
__device__ __forceinline__ void gdn_scan_unit(Frame& F, int s, const GdnBufs& Gb) {
    switch (s & 3) { case 0: gdn_scan_unit_t<0>(F, s, Gb); break; case 1: gdn_scan_unit_t<4>(F, s, Gb); break; case 2: gdn_scan_unit_t<8>(F, s, Gb); break; default: gdn_scan_unit_t<12>(F, s, Gb); break; }
}

__device__ __forceinline__ void gdn_finish_phase(Frame& F, const Args& a, const GdnBufs& Gb, const bf16_t* GZ, bf16_t* OG) {
    const int gt = F.vcu * NWAVES * 64 + F.tid, ngt = F.G * NWAVES * 64;
    for (int p = gt; p < T * 64; p += ngt) {
        const size_t t = (size_t)(p >> 6); const int col = (p & 63) * 8, e0 = col & 127;
        const v4u o = *(const v4u*)(Gb.ORAW + t * 512 + col), z = *(const v4u*)(GZ + t * 512 + col);
        const unsigned ow[4] = {o.x, o.y, o.z, o.w}, zw[4] = {z.x, z.y, z.z, z.w};
        float ss = 0.f;
#pragma unroll
        for (int i = 0; i < 4; ++i) { const float a0 = bflo(ow[i]), a1 = bfhi(ow[i]); ss += a0 * a0 + a1 * a1; }
        ss += dpp_f<DPP_X1>(ss); ss += dpp_f<DPP_X2>(ss); ss += dpp_f<DPP_HM>(ss); ss += dpp_f<0x140>(ss);
        const float rinv = rsqrtf(ss * (1.f / 128.f) + EPS);
        const f32x4_t g0 = *(const f32x4_t*)(a.gdn_norm_g + e0), g1 = *(const f32x4_t*)(a.gdn_norm_g + e0 + 4);
        const float gg[8] = {g0[0], g0[1], g0[2], g0[3], g1[0], g1[1], g1[2], g1[3]};
        unsigned r[4];
#pragma unroll
        for (int i = 0; i < 4; ++i) { const float z0 = bflo(zw[i]), z1 = bfhi(zw[i]);
            r[i] = cvtpk(bflo(ow[i]) * rinv * gg[2 * i] * (z0 * __builtin_amdgcn_rcpf(1.f + __expf(-z0))), bfhi(ow[i]) * rinv * gg[2 * i + 1] * (z1 * __builtin_amdgcn_rcpf(1.f + __expf(-z1)))); }
        *(v4u*)(OG + t * 512 + col) = (v4u){r[0], r[1], r[2], r[3]};
    }
}
typedef float f32x2_t __attribute__((ext_vector_type(2)));
__device__ __forceinline__ float gelu_erf(float v) { return 0.5f * v * (1.f + erff(v * 0.70710678118654752f)); }
constexpr int PEER_CH = 64;
constexpr int CW_PEERU = 8192, CW_PEERV = 8192 + 1024;

typedef int v2i_t __attribute__((ext_vector_type(2)));
#define PEER_SWZ(V, JP) __builtin_amdgcn_ds_swizzle((V), 0x18 | ((JP) << 5))
#define PEER_SHUF(EN, ER) do { EN[0] = PEER_SWZ(ER.x, 0); EN[1] = PEER_SWZ(ER.y, 0); EN[2] = PEER_SWZ(ER.x, 1); EN[3] = PEER_SWZ(ER.y, 1); EN[4] = PEER_SWZ(ER.x, 2); EN[5] = PEER_SWZ(ER.y, 2); EN[6] = PEER_SWZ(ER.x, 3); EN[7] = PEER_SWZ(ER.y, 3); EN[8] = PEER_SWZ(ER.x, 4); EN[9] = PEER_SWZ(ER.y, 4); EN[10] = PEER_SWZ(ER.x, 5); EN[11] = PEER_SWZ(ER.y, 5); EN[12] = PEER_SWZ(ER.x, 6); EN[13] = PEER_SWZ(ER.y, 6); EN[14] = PEER_SWZ(ER.x, 7); EN[15] = PEER_SWZ(ER.y, 7); } while (0)
#define PEER_LDIDX(TOK) (*(const v2i_t*)(EIDX + (size_t)(TOK) * 128 + 2 * lane))
#define PEER_U_COMPUTE(W, TOK, XR, RS) do { const size_t t_ = (TOK); \
        const unsigned xw0_ = XR.x, xw1_ = XR.y; const float xf0_ = bflo(xw0_), xf1_ = bfhi(xw0_), xf2_ = bflo(xw1_), xf3_ = bfhi(xw1_);        \
        float am = fmaxf(fmaxf(fabsf(xf0_), fabsf(xf1_)), fmaxf(fabsf(xf2_), fabsf(xf3_))); \
        am = fmaxf(am, dpp_f<DPP_X1>(am)); am = fmaxf(am, dpp_f<DPP_X2>(am)); am = fmaxf(am, dpp_f<DPP_HM>(am)); am = fmaxf(am, dpp_f<0x140>(am)); \
        { const unsigned b_ = __builtin_bit_cast(unsigned, am); const auto r_ = __builtin_amdgcn_permlane16_swap(b_, b_, false, false); const unsigned r0_ = r_[0], r1_ = r_[1]; am = fmaxf(__builtin_bit_cast(float, r0_), __builtin_bit_cast(float, r1_)); } \
        { const unsigned b_ = __builtin_bit_cast(unsigned, am); const auto r_ = __builtin_amdgcn_permlane32_swap(b_, b_, false, false); const unsigned r0_ = r_[0], r1_ = r_[1]; am = fmaxf(__builtin_bit_cast(float, r0_), __builtin_bit_cast(float, r1_)); } \
        const float sx = am > 0.f ? 127.f * __builtin_amdgcn_rcpf(am) : 0.f, mo = am * (1.f / (127.f * 16.f)) * (RS); \
        const unsigned b0 = __builtin_bit_cast(unsigned, fmaf(xf0_, sx, 12582912.f)), b1 = __builtin_bit_cast(unsigned, fmaf(xf1_, sx, 12582912.f)), b2 = __builtin_bit_cast(unsigned, fmaf(xf2_, sx, 12582912.f)), b3 = __builtin_bit_cast(unsigned, fmaf(xf3_, sx, 12582912.f)); \
        const int xmine_ = (int)(__builtin_amdgcn_perm(b1, b0, 0x0c0c0400u) | __builtin_amdgcn_perm(b3, b2, 0x04000c0cu)); \
        int xq[8];        \
        _Pragma("unroll") for (int d = 0; d < 8; ++d) xq[d] = __builtin_amdgcn_ds_bpermute(32 * j + 4 * d, xmine_); \
        int sl_ = __builtin_amdgcn_sdot4(0x01010101, xq[0], 0, false); sl_ = __builtin_amdgcn_sdot4(0x01010101, xq[2], sl_, false); sl_ = __builtin_amdgcn_sdot4(0x01010101, xq[4], sl_, false); sl_ = __builtin_amdgcn_sdot4(0x01010101, xq[6], sl_, false); \
        const int c0_ = -8 * sl_; \
        int p[16]; \
        _Pragma("unroll") for (int i = 0; i < 16; ++i) { const unsigned ww[4] = {W[i].x, W[i].y, W[i].z, W[i].w}; int ah = 0, al = c0_; \
            _Pragma("unroll") for (int d = 0; d < 4; ++d) { ah = __builtin_amdgcn_sdot4((int)(ww[d] & 0xF0F0F0F0u), xq[2 * d + 1], ah, false); al = __builtin_amdgcn_sdot4((int)(ww[d] & 0x0F0F0F0Fu), xq[2 * d], al, false); } \
            p[i] = ah + 16 * al; } \
        _Pragma("unroll") for (int i = 0; i < 8; ++i) { const int lo = p[i], hi = p[i + 8]; p[i] = (up4 ? hi : lo) + dpp_i<DPP_HM>(up4 ? lo : hi); } \
        _Pragma("unroll") for (int i = 0; i < 4; ++i) { const int lo = p[i], hi = p[i + 4]; p[i] = (up2 ? hi : lo) + dpp_i<DPP_X2>(up2 ? lo : hi); } \
        _Pragma("unroll") for (int i = 0; i < 2; ++i) { const int lo = p[i], hi = p[i + 2]; p[i] = (up1 ? hi : lo) + dpp_i<DPP_X1>(up1 ? lo : hi); } \
        *(unsigned*)(PART + ((size_t)x * T + t_) * 128 + 2 * lane) = cvtpk((float)p[0] * mo, (float)p[1] * mo); } while (0)
#define PEER_LDX(XR, TOK) do { XR = *(const v2u*)(Xx + (size_t)(TOK) * 1024); } while (0)
#define PEER_GATHER(W, EN, BASE) do { _Pragma("unroll") for (int i = 0; i < 16; ++i) W[i] = *(const v4u*)((BASE) + (unsigned)((unsigned)EN[i] * 128u + lo16)); } while (0)
__device__ __forceinline__ void peer_u_phase(Frame& F, const Args& a, gu32* ctl, const bf16_t* X2B, const float* rstd2, const int* EIDX, const unsigned char* U8, bf16_t* PART) {
    const int lane = F.lane, j = lane & 7; const unsigned lo16 = 16u * (unsigned)j;
    const bool up4 = (j & 4) != 0, up2 = (j & 2) != 0, up1 = (j & 1) != 0;
    const int x0 = (int)(xb_xcc_id() & 7u);
    for (int s = 0; s < 4; ++s) {
        const int x = (((x0 & 1) | ((x0 >> 2) << 1)) + s) & 3;
        const unsigned char* Ux = U8 + (size_t)x * 16384 * 128;
        const bf16_t* Xx = X2B + 256 * x + 4 * lane;
        for (;;) {
            int c = 0; if (lane == 0) c = (int)__hip_atomic_fetch_add(ctl + CW_PEERU + 64 * x, 1u, __ATOMIC_RELAXED, __HIP_MEMORY_SCOPE_AGENT);
            c = __builtin_amdgcn_readfirstlane(c);
            if (c >= T / PEER_CH) break;
            const size_t tc = (size_t)c * PEER_CH, tl = tc + PEER_CH - 1;
            int en[16]; v4u wa[16], wb[16]; v2u xa, xb;
            v2i_t era = PEER_LDIDX(tc), erb = PEER_LDIDX(tc + 1);
            PEER_LDX(xa, tc); float rsa = rstd2[tc], rsb; PEER_LDX(xb, tc + 1); rsb = rstd2[tc + 1];
            PEER_SHUF(en, era);
            PEER_GATHER(wa, en, Ux);
            era = PEER_LDIDX(tc + 2);
            PEER_SHUF(en, erb);
            PEER_GATHER(wb, en, Ux);
            erb = PEER_LDIDX(tc + 3);
            for (int tt = 0; tt < PEER_CH; tt += 2) {
                const size_t t = tc + tt, t2 = (t + 2 < tl) ? t + 2 : tl, t3 = (t + 3 < tl) ? t + 3 : tl, t4 = (t + 4 < tl) ? t + 4 : tl, t5 = (t + 5 < tl) ? t + 5 : tl;
                PEER_U_COMPUTE(wa, t, xa, rsa);
                __builtin_amdgcn_sched_barrier(0);
                PEER_LDX(xa, t2); rsa = rstd2[t2];
                PEER_SHUF(en, era);
                PEER_GATHER(wa, en, Ux);
                era = PEER_LDIDX(t4);
                __builtin_amdgcn_sched_barrier(0);
                PEER_U_COMPUTE(wb, t + 1, xb, rsb);
                __builtin_amdgcn_sched_barrier(0);
                PEER_LDX(xb, t3); rsb = rstd2[t3];
                PEER_SHUF(en, erb);
                PEER_GATHER(wb, en, Ux);
                erb = PEER_LDIDX(t5);
                __builtin_amdgcn_sched_barrier(0);
            }
        }
    }
}
__device__ __forceinline__ unsigned fp4_code(float v, float& q) {
    const float a = fabsf(v); const int idx = (a >= 0.25f) + (a >= 0.75f) + (a >= 1.25f) + (a >= 1.75f) + (a >= 2.5f) + (a >= 3.5f) + (a >= 5.f);
    const float mg = idx < 4 ? 0.5f * (float)idx : (idx < 6 ? (float)(idx - 2) : (idx == 6 ? 4.f : 6.f)); q = v < 0.f ? -mg : mg; return (unsigned)idx | (v < 0.f ? 8u : 0u);
}
__device__ __forceinline__ void peer_combine_phase(Frame& F, const bf16_t* PART, const int* EIDX, const float* EGATE, const float* SU, const float* SV, unsigned char* ACT4, float* ASC) {
    const int gt = F.vcu * NWAVES * 64 + F.tid, ngt = F.G * NWAVES * 64;
    LAS float* LS = (LAS float*)F.lds;
    for (int i = F.tid; i < 8192; i += NWAVES * 64) *(LAS f32x4_t*)(LS + 4 * i) = *(const f32x4_t*)(SU + 4 * i);
    __syncthreads();
    LAS float* LV = LS + 16384;
    for (int p = gt; p < T * 32; p += ngt) {
        f32x4_t s = {0.f, 0.f, 0.f, 0.f};
#pragma unroll
        for (int x = 0; x < 4; ++x) { const v2u w = *(const v2u*)(PART + (size_t)x * T * 128 + (size_t)p * 4); s += (f32x4_t){bflo(w.x), bfhi(w.x), bflo(w.y), bfhi(w.y)}; }
        const int4 e = *(const int4*)(EIDX + (size_t)p * 4); const f32x4_t gt4 = *(const f32x4_t*)(EGATE + (size_t)p * 4);
        float av[4] = {gelu_erf(s[0] * LS[e.x]) * gt4[0] * LV[e.x], gelu_erf(s[1] * LS[e.y]) * gt4[1] * LV[e.y], gelu_erf(s[2] * LS[e.z]) * gt4[2] * LV[e.z], gelu_erf(s[3] * LS[e.w]) * gt4[3] * LV[e.w]};
        float m = fmaxf(fmaxf(fabsf(av[0]), fabsf(av[1])), fmaxf(fabsf(av[2]), fabsf(av[3])));
        m = fmaxf(m, dpp_f<DPP_X1>(m)); m = fmaxf(m, dpp_f<DPP_X2>(m)); m = fmaxf(m, dpp_f<DPP_HM>(m)); m = fmaxf(m, dpp_f<0x140>(m));
        m = fmaxf(m, __builtin_bit_cast(float, __builtin_amdgcn_ds_swizzle(__builtin_bit_cast(int, m), 0x401F)));
        const float sc = m > 0.f ? 6.f / m : 0.f;
        unsigned st[4]; float y0 = av[0] * sc, y1 = av[1] * sc, y2 = av[2] * sc, y3 = av[3] * sc;
#pragma unroll
        for (int g = 0; g < 4; ++g) { const float rs_ = (g == 0) ? 4.f : 8.f;
            unsigned w = __builtin_amdgcn_cvt_scalef32_pk_fp4_f32(0u, y0, y1, 1.0f, 0); w = __builtin_amdgcn_cvt_scalef32_pk_fp4_f32(w, y2, y3, 1.0f, 1);
            st[g] = w & 0xffffu;
            if (g < 3) { const f32x2_t q01 = __builtin_amdgcn_cvt_scalef32_pk_f32_fp4(w, 1.0f, 0), q23 = __builtin_amdgcn_cvt_scalef32_pk_f32_fp4(w, 1.0f, 1);
                y0 = (y0 - q01.x) * rs_; y1 = (y1 - q01.y) * rs_; y2 = (y2 - q23.x) * rs_; y3 = (y3 - q23.y) * rs_; } }
        const size_t t = (size_t)(p >> 5); const int kb2 = (p & 31) * 2;
#pragma unroll
        for (int g = 0; g < 4; ++g) *(unsigned short*)(ACT4 + t * 256 + 64 * g + kb2) = (unsigned short)st[g];
        if ((p & 31) == 0) ASC[t] = m * (1.f / 6.f);
    }
    __syncthreads();
}
typedef int v8i_t __attribute__((ext_vector_type(8)));
__device__ __forceinline__ v8i_t ld_a4(const unsigned char* p) { const v4u w = *(const v4u*)p; return (v8i_t){(int)w.x, (int)w.y, (int)w.z, (int)w.w, 0, 0, 0, 0}; }
__device__ __forceinline__ v2i_t lds_tr4(LAS unsigned char* p) { return __builtin_amdgcn_ds_read_tr4_b64_v2i32((LAS v2i_t*)p); }
__device__ __forceinline__ float row_sum_dpp(float v) { v += dpp_f<DPP_X1>(v); v += dpp_f<DPP_X2>(v); v += dpp_f<DPP_HM>(v); v += dpp_f<0x140>(v); return v; }
#define PEER_V_STAGE(W) do { _Pragma("unroll") for (int i = 0; i < 16; ++i) { \
            if ((i & 1) == 0) *(LAS v4u*)(wimg + 128 * i + 8 * ((2 * j) ^ i)) = W[i]; \
            else { *(LAS v2u*)(wimg + 128 * i + 8 * ((2 * j) ^ i)) = (v2u){W[i].x, W[i].y}; *(LAS v2u*)(wimg + 128 * i + 8 * ((2 * j + 1) ^ i)) = (v2u){W[i].z, W[i].w}; } } \
        asm volatile("" ::: "memory"); } while (0)
#define PEER_V_COMPUTE(TOK, AOP, ASCV, X0R, X1R) do { const size_t t_ = (TOK); \
        const v4u x0_ = (X0R), x1_ = (X1R); \
        const float as_ = (ASCV); const unsigned xw_[8] = {x0_.x, x0_.y, x0_.z, x0_.w, x1_.x, x1_.y, x1_.z, x1_.w}; unsigned ow_[8]; float ss = 0.f; \
        _Pragma("unroll") for (int q = 0; q < 8; ++q) { float v2_[2]; \
            _Pragma("unroll") for (int h_ = 0; h_ < 2; ++h_) { const int cb = 2 * q + h_; \
                const v2i_t t0_ = lds_tr4(rimg + 8 * (cb ^ r15)), t1_ = lds_tr4(rimg + 2048 + 8 * (cb ^ r15)); \
                const int b0_ = t0_.x, b1_ = t0_.y, b2_ = t1_.x, b3_ = t1_.y; const v8i_t bb_ = {b0_, b1_, b2_, b3_, 0, 0, 0, 0}; \
                const f32x4_t c_ = __builtin_amdgcn_mfma_scale_f32_16x16x128_f8f6f4(AOP, bb_, (f32x4_t){0.f, 0.f, 0.f, 0.f}, 4, 4, 0, 0x7f7f7f7f, 0, 0x7f7f7f7f); \
                v2_[h_] = (c_[0] + c_[1] * 0.25f) + (c_[2] * 0.03125f + c_[3] * 0.00390625f); } \
            ow_[q] = cvtpk(fmaf(v2_[0], as_, bflo(xw_[q])), fmaf(v2_[1], as_, bfhi(xw_[q]))); const float r0 = bflo(ow_[q]), r1 = bfhi(ow_[q]); ss += r0 * r0 + r1 * r1; } \
        asm volatile("" ::: "memory"); \
        ss = row_sum_dpp(ss); \
        if (lane < 16) { bf16_t* dst = X3B + t_ * 1024 + 256 * x + 16 * lane; *(v4u*)dst = (v4u){ow_[0], ow_[1], ow_[2], ow_[3]}; *(v4u*)(dst + 8) = (v4u){ow_[4], ow_[5], ow_[6], ow_[7]}; if (lane == 0) SS3[t_ * 4 + x] = ss; } } while (0)
__device__ __forceinline__ void peer_v_phase(Frame& F, gu32* ctl, const int* EIDX, const unsigned char* ACT8, const float* ASC, const unsigned char* V8, const bf16_t* X2B, bf16_t* X3B, float* SS3) {
    const int lane = F.lane, g = lane >> 3, j = lane & 7, r15 = lane & 15; const unsigned lo16 = 16u * (unsigned)j;
    LAS unsigned char* wimg = F.lds + F.wave * 16384 + 2048 * g;
    LAS unsigned char* rimg = F.lds + F.wave * 16384 + 4096 * (lane >> 4) + 128 * (lane & 15);
    const int x0 = (int)(xb_xcc_id() & 7u);
    for (int s = 0; s < 4; ++s) {
        const int x = (((x0 & 1) | ((x0 >> 2) << 1)) + s) & 3;
        const unsigned char* Vx = V8 + (size_t)x * 16384 * 128;
        const bf16_t* Xx = X2B + 256 * x + 16 * (lane < 16 ? lane : 0);
        const unsigned char* Ax = ACT8 + 64 * ((lane & 15) < 4 ? (lane & 3) : 0) + 16 * (lane >> 4);
        for (;;) {
            int c = 0; if (lane == 0) c = (int)__hip_atomic_fetch_add(ctl + CW_PEERV + 64 * x, 1u, __ATOMIC_RELAXED, __HIP_MEMORY_SCOPE_AGENT);
            c = __builtin_amdgcn_readfirstlane(c);
            if (c >= T / PEER_CH) break;
            const size_t tc = (size_t)c * PEER_CH, tl = tc + PEER_CH - 1;
            int en[16]; v4u wa[16], wb[16];
            v2i_t era = PEER_LDIDX(tc), erb = PEER_LDIDX(tc + 1);
            v8i_t aa = ld_a4(Ax + tc * 256), ab; float sa = ASC[tc], sb; v4u xa0 = *(const v4u*)(Xx + tc * 1024), xa1 = *(const v4u*)(Xx + tc * 1024 + 8), xb0, xb1;
            PEER_SHUF(en, era);
            PEER_GATHER(wa, en, Vx);
            era = PEER_LDIDX(tc + 2);
            PEER_SHUF(en, erb);
            PEER_GATHER(wb, en, Vx);
            for (int tt = 0; tt < PEER_CH; tt += 2) {
                const size_t t = tc + tt, t2 = (t + 2 < tl) ? t + 2 : tl, t3 = (t + 3 < tl) ? t + 3 : tl, t4 = (t + 4 < tl) ? t + 4 : tl;
                erb = PEER_LDIDX(t3);
                ab = ld_a4(Ax + (t + 1) * 256); sb = ASC[t + 1]; xb0 = *(const v4u*)(Xx + (t + 1) * 1024); xb1 = *(const v4u*)(Xx + (t + 1) * 1024 + 8);
                PEER_V_STAGE(wa);
                PEER_SHUF(en, era);
                PEER_GATHER(wa, en, Vx);
                PEER_V_COMPUTE(t, aa, sa, xa0, xa1);
                era = PEER_LDIDX(t4);
                aa = ld_a4(Ax + t2 * 256); sa = ASC[t2]; xa0 = *(const v4u*)(Xx + t2 * 1024); xa1 = *(const v4u*)(Xx + t2 * 1024 + 8);
                PEER_V_STAGE(wb);
                PEER_SHUF(en, erb);
                PEER_GATHER(wb, en, Vx);
                PEER_V_COMPUTE(t + 1, ab, sb, xb0, xb1);
            }
        }
    }
}
__device__ __forceinline__ void peer_norm_phase(Frame& F, const Args& a, const float* SS3, const bf16_t* X3B, float* out) {
    const int gt = F.vcu * NWAVES * 64 + F.tid, ngt = F.G * NWAVES * 64;
    for (int p = gt; p < T * 128; p += ngt) {
        const size_t t = (size_t)(p >> 7); const int c = (p & 127) * 8;
        const f32x4_t s0 = *(const f32x4_t*)(SS3 + t * 4);
        const float r3 = rsqrtf(((s0[0] + s0[1]) + (s0[2] + s0[3])) * (1.f / D) + EPS);
        const v4u w = *(const v4u*)(X3B + t * 1024 + c);
        const f32x4_t g0 = *(const f32x4_t*)(a.g_final + c), g1 = *(const f32x4_t*)(a.g_final + c + 4);
        *(f32x4_t*)(out + t * 1024 + c) = (f32x4_t){bflo(w.x), bfhi(w.x), bflo(w.y), bfhi(w.y)} * g0 * r3;
        *(f32x4_t*)(out + t * 1024 + c + 4) = (f32x4_t){bflo(w.z), bfhi(w.z), bflo(w.w), bfhi(w.w)} * g1 * r3;
    }
}
#ifndef TOPK_HD
#define TOPK_HD __device__ __forceinline__
#endif
TOPK_HD void ce_desc(unsigned& a, unsigned& b) { const unsigned hi = a > b ? a : b, lo = a > b ? b : a; a = hi; b = lo; }
TOPK_HD void sort16_desc(unsigned (&v)[16]) {
    constexpr int NET[63][2] = {{0,1},{2,3},{0,2},{1,3},{1,2},{4,5},{6,7},{4,6},{5,7},{5,6},{0,4},{2,6},{2,4},{1,5},{3,7},{3,5},{1,2},{3,4},{5,6},{8,9},{10,11},{8,10},{9,11},{9,10},{12,13},{14,15},{12,14},{13,15},{13,14},{8,12},{10,14},{10,12},{9,13},{11,15},{11,13},{9,10},{11,12},{13,14},{0,8},{4,12},{4,8},{2,10},{6,14},{6,10},{2,4},{6,8},{10,12},{1,9},{5,13},{5,9},{3,11},{7,15},{7,11},{3,5},{7,9},{11,13},{1,2},{3,4},{5,6},{7,8},{9,10},{11,12},{13,14}};
#pragma unroll
    for (int c = 0; c < 63; ++c) ce_desc(v[NET[c][0]], v[NET[c][1]]);
}
TOPK_HD void bitonic_merge16_desc(unsigned (&v)[16]) {
#pragma unroll
    for (int j = 8; j >= 1; j >>= 1)
#pragma unroll
        for (int i = 0; i < 16; ++i) { const int l = i ^ j; if (l > i) ce_desc(v[i], v[l]); }
}
TOPK_HD void top16_merge(unsigned (&a)[16], const unsigned (&b)[16]) {
#pragma unroll
    for (int i = 0; i < 16; ++i) a[i] = a[i] > b[15 - i] ? a[i] : b[15 - i];
    bitonic_merge16_desc(a);
}
TOPK_HD unsigned f2ord(float f) { const unsigned u = __builtin_bit_cast(unsigned, f); return u ^ ((unsigned)((int)u >> 31) | 0x80000000u); }
TOPK_HD float ord2f(unsigned o) { const unsigned u = (o & 0x80000000u) ? (o & 0x7fffffffu) : ~o; return __builtin_bit_cast(float, u); }

__device__ __forceinline__ void peer_route_task(Frame& F, const bf16_t* PQ, const bf16_t* SK16, int* EIDX, float* EGATE, int tt, int h) {
    constexpr int CI[50] = {0,0,0,0,0,0,0,0,0,0,0,0,0,0,0,0,1,1,1,1,1,1,1,1,2,2,2,2,2,3,3,3,3,4,4,4,5,5,6,6,7,7,8,9,10,11,12,13,14,15};
    constexpr int CJ[50] = {0,1,2,3,4,5,6,7,8,9,10,11,12,13,14,15,0,1,2,3,4,5,6,7,0,1,2,3,4,0,1,2,3,0,1,2,0,1,0,1,0,1,0,0,0,0,0,0,0,0};
    int lane = F.lane; asm volatile("" : "+v"(lane));
    const int t = lane & 31, hi = lane >> 5;
    LAS unsigned* wl = (LAS unsigned*)(F.lds + 65536 + F.wave * 8192) + lane;
    {
        const size_t row = (size_t)tt * 32 + t;
        unsigned L[2][16];
#pragma unroll
        for (int p = 0; p < 2; ++p) {
            const int hp = h * 2 + p;
            bf16x8_t Bf[8];
#pragma unroll
            for (int ks = 0; ks < 8; ++ks) Bf[ks] = *(const bf16x8_t*)(PQ + row * 2048 + hp * 128 + 16 * ks + 8 * hi);
#pragma unroll
            for (int i = 0; i < 16; ++i) L[p][i] = 0u;
#pragma unroll 1
            for (int nt = 0; nt < 4; ++nt) {
                const int srow = p * 128 + 32 * nt + t;
                bf16x8_t Ac[8];
#pragma unroll
                for (int ks = 0; ks < 8; ++ks) Ac[ks] = *(const LAS bf16x8_t*)(F.lds + srow * 256 + (((2 * ks + hi) ^ (srow & 15)) << 4));
                f32x16_t acc = {};
#pragma unroll
                for (int ks = 0; ks < 8; ++ks) acc = __builtin_amdgcn_mfma_f32_32x32x16_bf16(Ac[ks], Bf[ks], acc, 0, 0, 0);
                unsigned k[16];
#pragma unroll
                for (int r = 0; r < 16; ++r) { const int n = 32 * nt + (r & 3) + 8 * (r >> 2) + 4 * hi; k[r] = (f2ord(acc[r]) & ~127u) | (unsigned)(127 - n); }
                sort16_desc(k);
                top16_merge(L[p], k);
            }
            unsigned pb[16];
#pragma unroll
            for (int i = 0; i < 16; ++i) pb[i] = __shfl_xor(L[p][i], 32);
            top16_merge(L[p], pb);
        }
        float sa[16], sb[16];
#pragma unroll
        for (int i = 0; i < 16; ++i) { sa[i] = ord2f(L[0][i] & ~127u); sb[i] = ord2f(L[1][i] & ~127u); wl[i * 64] = 127u - (L[0][i] & 127u); wl[(16 + i) * 64] = 127u - (L[1][i] & 127u); }
        unsigned c0[16], c1[16];
#pragma unroll
        for (int s = 0; s < 32; ++s) {
            unsigned key = 0u;
            if (s < 25) { const float v = hi ? sa[CI[25 + s]] + sb[CJ[25 + s]] : sa[CI[s]] + sb[CJ[s]]; const int pos = hi ? CI[25 + s] * 16 + CJ[25 + s] : CI[s] * 16 + CJ[s];
                key = (f2ord(v) & ~255u) | (unsigned)(255 - pos); }
            if (s < 16) c0[s] = key; else c1[s - 16] = key;
        }
        sort16_desc(c0); sort16_desc(c1); top16_merge(c0, c1);
        unsigned pb[16];
#pragma unroll
        for (int i = 0; i < 16; ++i) pb[i] = __shfl_xor(c0[i], 32);
        top16_merge(c0, pb);
        float e[16]; const float m = ord2f(c0[0] & ~255u); float l = 0.f;
#pragma unroll
        for (int r = 0; r < 16; ++r) { e[r] = __expf(ord2f(c0[r] & ~255u) - m); l += e[r]; }
        const float il = 1.f / l;
        int ex[8]; float gt[8];
#pragma unroll
        for (int q = 0; q < 8; ++q) { const unsigned kk = hi ? c0[8 + q] : c0[q]; const int pos = 255 - (int)(kk & 255u); ex[q] = (int)(wl[(pos >> 4) * 64] * 128u + wl[(16 + (pos & 15)) * 64]); gt[q] = (hi ? e[8 + q] : e[q]) * il; }
        int* ep = EIDX + row * 128 + h * 16 + hi * 8; float* gp = EGATE + row * 128 + h * 16 + hi * 8;
        *(int4*)ep = make_int4(ex[0], ex[1], ex[2], ex[3]); *(int4*)(ep + 4) = make_int4(ex[4], ex[5], ex[6], ex[7]);
        *(f32x4_t*)gp = (f32x4_t){gt[0], gt[1], gt[2], gt[3]}; *(f32x4_t*)(gp + 4) = (f32x4_t){gt[4], gt[5], gt[6], gt[7]};
    }
}
__device__ __forceinline__ void cross_item(Frame& F, const bf16_t* QC, const bf16_t* KC, const bf16_t* VC, bf16_t* OC, int bh, int qb) {
    int tid = F.tid; asm volatile("" : "+v"(tid));
    const int lane = tid & 63, wave = F.wave, q = lane & 31, hi = lane >> 5;
    LAS unsigned char* L = F.lds;
    const int g4 = lane >> 4, qq = (lane >> 2) & 3, p4 = lane & 3;
    {
        const int b = bh >> 2, h = bh & 3;
#pragma unroll
        for (int i = 0; i < 16; ++i) { const int cid = tid + 512 * i, r = cid >> 5, c = cid & 31;
            *(LAS v4u*)(L + r * 512 + ((c ^ (r & 15)) << 4)) = *(const v4u*)(KC + (size_t)(b * 256 + r) * 1024 + h * 256 + c * 8); }
        const size_t qrow0 = (size_t)b * SEQ + qb * 256 + wave * 32;
        const bf16_t* Qp = QC + (qrow0 + q) * 1024 + h * 256 + 8 * hi;
        __syncthreads();
        f32x16_t st[8];
#pragma unroll
        for (int kt = 0; kt < 8; ++kt) st[kt] = (f32x16_t){};
#pragma unroll 2
        for (int ks = 0; ks < 16; ++ks) { const bf16x8_t qf = *(const bf16x8_t*)(Qp + 16 * ks);
#pragma unroll
            for (int kt = 0; kt < 8; ++kt) { const int row = 32 * kt + q;
                st[kt] = __builtin_amdgcn_mfma_f32_32x32x16_bf16(*(const LAS bf16x8_t*)(L + row * 512 + (((2 * ks + hi) ^ (row & 15)) << 4)), qf, st[kt], 0, 0, 0); } }
        float m = -INFINITY;
#pragma unroll
        for (int kt = 0; kt < 8; ++kt)
#pragma unroll
            for (int r = 0; r < 16; ++r) { st[kt][r] *= 0.0625f; m = fmaxf(m, st[kt][r]); }
        m = xor32_max(m);
        float l = 0.f;
#pragma unroll
        for (int kt = 0; kt < 8; ++kt)
#pragma unroll
            for (int r = 0; r < 16; ++r) { st[kt][r] = __expf(st[kt][r] - m); l += st[kt][r]; }
        l = xor32_sum(l);
        const float il = 1.f / l;
        bf16x8_t pa[8][2];
#pragma unroll
        for (int kt = 0; kt < 8; ++kt)
#pragma unroll
            for (int s = 0; s < 2; ++s) pa[kt][s] = __builtin_bit_cast(bf16x8_t, (v4u){cvtpk(st[kt][8 * s] * il, st[kt][8 * s + 1] * il), cvtpk(st[kt][8 * s + 2] * il, st[kt][8 * s + 3] * il),
                                                                                        cvtpk(st[kt][8 * s + 4] * il, st[kt][8 * s + 5] * il), cvtpk(st[kt][8 * s + 6] * il, st[kt][8 * s + 7] * il)});
        __syncthreads();
#pragma unroll
        for (int i = 0; i < 16; ++i) { const int cid = tid + 512 * i, r = cid >> 5, c = cid & 31;
            *(LAS v4u*)(L + r * 512 + ((c ^ (4 * (r & 3))) << 4)) = *(const v4u*)(VC + (size_t)(b * 256 + r) * 1024 + h * 256 + c * 8); }
        __syncthreads();
        bf16_t* Op = OC + qrow0 * 1024 + h * 256 + q;
#pragma unroll 1
        for (int dt = 0; dt < 8; ++dt) {
            f32x16_t o = {};
            LAS unsigned char* vb = L + (4 * (g4 >> 1) + qq) * 512 + (((dt * 64) ^ (qq << 6)) + (g4 & 1) * 32 + p4 * 8);
#pragma unroll
            for (int kt = 0; kt < 8; ++kt)
#pragma unroll
                for (int s = 0; s < 2; ++s) { const v4i16_t a0 = lds_tr16(vb + (32 * kt + 16 * s) * 512), a1 = lds_tr16(vb + (32 * kt + 16 * s + 8) * 512);
                    const bf16x8_t vf = {a0[0], a0[1], a0[2], a0[3], a1[0], a1[1], a1[2], a1[3]};
                    o = __builtin_amdgcn_mfma_f32_32x32x16_bf16(pa[kt][s], vf, o, 0, 0, 0); }
#pragma unroll
            for (int r = 0; r < 16; ++r) { const int row = (r & 3) + 8 * (r >> 2) + 4 * hi; Op[(size_t)row * 1024 + dt * 32] = f2bf(o[r]); }
        }
        __syncthreads();
    }
}
template <bool REMAP>
__device__ __forceinline__ void transpose_tile(const float* W, int K, int N, const float* gain, bf16_t* WT, LAS float* tile, int item, int tid) {
    const int nblk = (N + 255) / 256, kb = item / nblk, nb = item % nblk, k0 = 64 * kb, n0 = 256 * nb;
    const int c4 = (tid & 63) * 4, kr = tid >> 6;
    f32x4 v[8];
#pragma unroll
    for (int i = 0; i < 8; ++i) { const int k = kr + 8 * i; v[i] = (n0 + c4 < N) ? *(const GAS f32x4*)(W + (size_t)(k0 + k) * N + n0 + c4) : (f32x4){0.f, 0.f, 0.f, 0.f}; }
#pragma unroll
    for (int i = 0; i < 8; ++i) { const int k = kr + 8 * i; LAS float* d = tile + k * 257 + c4; d[0] = v[i].x; d[1] = v[i].y; d[2] = v[i].z; d[3] = v[i].w; }
    __syncthreads();
#pragma unroll
    for (int i = 0; i < 4; ++i) { const int p = tid + 512 * i, n = p >> 3, c = p & 7; const LAS float* sp = tile + (8 * c) * 257 + n;
        float g[8];
#pragma unroll
        for (int q = 0; q < 8; ++q) g[q] = gain ? gain[k0 + 8 * c + q] : 1.f;
        v4u o; o.x = pk2(sp[0 * 257] * g[0], sp[1 * 257] * g[1]); o.y = pk2(sp[2 * 257] * g[2], sp[3 * 257] * g[3]); o.z = pk2(sp[4 * 257] * g[4], sp[5 * 257] * g[5]); o.w = pk2(sp[6 * 257] * g[6], sp[7 * 257] * g[7]);
        int ng = n0 + n; bool ok = ng < N;
        if (REMAP) { if (ng >= 3584 && ng < 3592) ok = false; else if (ng >= 3592) ng -= 8; }
        if (ok) *(GAS v4u*)(WT + (size_t)ng * K + k0 + 8 * c) = o; }
    __syncthreads();
}

__device__ __forceinline__ void p0_prologue(Frame& F, const Args& a) {
    unsigned char* ws = a.ws;
    LAS float* tile = (LAS float*)F.lds;
    const int gw = F.vcu * NWAVES + F.wave, NGW = F.G * NWAVES;
    constexpr int I_IN = 16 * 23;
    for (int it = F.vcu; it < I_IN; it += F.G) transpose_tile<true>(a.w_in, 1024, IN_COLS, a.g_mix, (bf16_t*)(ws + WS_WIN), tile, it, F.tid);
    __syncthreads();
    LAS float* wsm = (LAS float*)F.lds;
    for (int i = F.tid; i < 8192; i += NWAVES * 64) { const int j = i >> 10, k = i & 1023; wsm[i] = a.w_in[(size_t)k * IN_COLS + 3584 + j] * a.g_mix[k]; }
    __syncthreads();
    bf16_t* XB = (bf16_t*)(ws + WS_A0); float* rstd0 = (float*)(ws + WS_RSTD0); float* GB = (float*)(ws + WS_GB); float* GA = GB + T * 4;
    for (int row0 = gw * 4; row0 < T; row0 += NGW * 4) {
        f32x4 v[4][4];
#pragma unroll
        for (int r = 0; r < 4; ++r)
#pragma unroll
            for (int j = 0; j < 4; ++j) v[r][j] = *((const GAS f32x4*)(a.x + (size_t)(row0 + r) * D) + F.lane + 64 * j);
        float dja[4][8];
#pragma unroll
        for (int jj = 0; jj < 8; ++jj) { float d4[4] = {0.f, 0.f, 0.f, 0.f};
#pragma unroll
            for (int j = 0; j < 4; ++j) { const f32x4 w = *(const LAS f32x4*)(wsm + jj * 1024 + (F.lane + 64 * j) * 4);
#pragma unroll
                for (int r = 0; r < 4; ++r) d4[r] += (v[r][j].x * w.x + v[r][j].y * w.y) + (v[r][j].z * w.z + v[r][j].w * w.w); }
#pragma unroll
            for (int r = 0; r < 4; ++r) dja[r][jj] = d4[r]; }
#pragma unroll
        for (int r = 0; r < 4; ++r) { const int row = row0 + r; float s = 0.f;
#pragma unroll
            for (int j = 0; j < 4; ++j) s += (v[r][j].x * v[r][j].x + v[r][j].y * v[r][j].y) + (v[r][j].z * v[r][j].z + v[r][j].w * v[r][j].w);
            const float rstd = rsqrtf(wave_sum(s) * (1.f / D) + EPS);
            GAS unsigned long long* o8 = (GAS unsigned long long*)(XB + (size_t)row * D) + F.lane;
#pragma unroll
            for (int j = 0; j < 4; ++j) o8[64 * j] = (unsigned long long)pk2(v[r][j].x, v[r][j].y) | ((unsigned long long)pk2(v[r][j].z, v[r][j].w) << 32);
            float dj[8];
#pragma unroll
            for (int jj = 0; jj < 8; ++jj) dj[jj] = dja[r][jj];
            { const bool u4 = (F.lane & 4) != 0, u2 = (F.lane & 2) != 0, u1 = (F.lane & 1) != 0;
#pragma unroll
              for (int i = 0; i < 4; ++i) { const float lo = dj[i], hi = dj[i + 4]; dj[i] = (u4 ? hi : lo) + dpp_f<DPP_HM>(u4 ? lo : hi); }
#pragma unroll
              for (int i = 0; i < 2; ++i) { const float lo = dj[i], hi = dj[i + 2]; dj[i] = (u2 ? hi : lo) + dpp_f<DPP_X2>(u2 ? lo : hi); }
              { const float lo = dj[0], hi = dj[1]; dj[0] = (u1 ? hi : lo) + dpp_f<DPP_X1>(u1 ? lo : hi); } }
            float d0 = dj[0]; d0 += dpp_f<0x128>(d0); d0 = xor32_sum(xor16_sum(d0));
            if (F.lane == 0) rstd0[row] = rstd;
            if (F.lane < 4) GB[(size_t)row * 4 + F.lane] = d0 * rstd; else if (F.lane < 8) GA[(size_t)row * 4 + F.lane - 4] = d0 * rstd; }
    }
}
__device__ __forceinline__ void late_prologue(Frame& F, const Args& a, int wgi, int nwg) {
    unsigned char* ws = a.ws;
    LAS float* tile = (LAS float*)F.lds;
    const int gw = wgi * NWAVES + F.wave, NGW = nwg * NWAVES;
    constexpr int I_S = 8 * 4, I_M = 16 * 4, I_L = 16 * 8;
    constexpr int NITEMS = 2 * I_S + 3 * I_M + 2 * I_L;
    for (int it = wgi; it < NITEMS; it += nwg) {
        int r = it;
        if (r < I_S) { transpose_tile<false>(a.w_sb_up, 512, 1024, nullptr, (bf16_t*)(ws + WS_WSB), tile, r, F.tid); continue; } r -= I_S;
        if (r < I_S) { transpose_tile<false>(a.w_gdn_up, 512, 1024, nullptr, (bf16_t*)(ws + WS_WGDN), tile, r, F.tid); continue; } r -= I_S;
        if (r < I_M) { transpose_tile<false>(a.w_mix_out, 1024, 1024, nullptr, (bf16_t*)(ws + WS_WMIX), tile, r, F.tid); continue; } r -= I_M;
        if (r < I_M) { transpose_tile<false>(a.w_cq, 1024, 1024, a.g_cross, (bf16_t*)(ws + WS_WCQ), tile, r, F.tid); continue; } r -= I_M;
        if (r < I_M) { transpose_tile<false>(a.w_co, 1024, 1024, nullptr, (bf16_t*)(ws + WS_WCO), tile, r, F.tid); continue; } r -= I_M;
        if (r < I_L) { transpose_tile<false>(a.w_ckv, 1024, 2048, nullptr, (bf16_t*)(ws + WS_WCKV), tile, r, F.tid); continue; } r -= I_L;
        transpose_tile<false>(a.w_pq, 1024, 2048, a.g_peer, (bf16_t*)(ws + WS_WPQ), tile, r, F.tid);
    }
    __syncthreads();
    {
        float* SUV = (float*)(ws + WS_SUV);
        f32x4 gq[4];
#pragma unroll
        for (int q = 0; q < 4; ++q) gq[q] = *(const GAS f32x4*)(a.g_peer + 16 * F.lane + 4 * q);
        for (int row0 = gw * 4; row0 < 2 * 16384; row0 += NGW * 4) {
            f32x4 v[4][4];
#pragma unroll
            for (int r = 0; r < 4; ++r) { const int row = row0 + r, tb = row >> 14, e = row & 16383; const float* src = (tb ? a.peer_v : a.peer_u) + (size_t)e * 1024 + 16 * F.lane;
#pragma unroll
                for (int q = 0; q < 4; ++q) { v[r][q] = *(const GAS f32x4*)(src + 4 * q); if (!tb) v[r][q] *= gq[q]; } }
#pragma unroll
            for (int r = 0; r < 4; ++r) { const int row = row0 + r, tb = row >> 14, e = row & 16383; float am = 0.f;
#pragma unroll
                for (int q = 0; q < 4; ++q) am = fmaxf(am, fmaxf(fmaxf(fabsf(v[r][q].x), fabsf(v[r][q].y)), fmaxf(fabsf(v[r][q].z), fabsf(v[r][q].w))));
                am = wave_max(am);
                if (!tb) {
                    float sq = 0.f;
#pragma unroll
                    for (int q = 0; q < 4; ++q) sq += (v[r][q].x * v[r][q].x + v[r][q].y * v[r][q].y) + (v[r][q].z * v[r][q].z + v[r][q].w * v[r][q].w);
                    sq = wave_sum(sq);
                    const float cl = fminf(am, 2.6f * sqrtf(sq * (1.f / 1024.f))), sc4 = cl > 0.f ? 7.f / cl : 0.f; v2u o4;
#pragma unroll
                    for (int h2 = 0; h2 < 2; ++h2) { const float lo4[4] = {v[r][2 * h2].x, v[r][2 * h2].y, v[r][2 * h2].z, v[r][2 * h2].w}, hi4[4] = {v[r][2 * h2 + 1].x, v[r][2 * h2 + 1].y, v[r][2 * h2 + 1].z, v[r][2 * h2 + 1].w}; unsigned wd = 0u;
#pragma unroll
                        for (int k = 0; k < 4; ++k) { const int nl = (int)fminf(fmaxf(rintf(lo4[k] * sc4), -7.f), 7.f), nh = (int)fminf(fmaxf(rintf(hi4[k] * sc4), -7.f), 7.f);
                            wd |= ((unsigned)(nl + 8) | (((unsigned)nh & 15u) << 4)) << (8 * k); }
                        o4[h2] = wd; }
                    *(GAS v2u*)(ws + WS_U8 + ((size_t)(F.lane >> 4) * 16384 + e) * 128 + 8 * (F.lane & 15)) = o4;
                    if (F.lane == 0) SUV[row] = cl * (1.f / 7.f);
                    continue; }
                const float sc = am > 0.f ? 6.f / am : 0.f, inv = am * (1.f / 6.f);
                {   LAS unsigned char* vrow = F.lds + F.wave * 2048 + r * 512 + (F.lane >> 4) * 128 + ((F.lane & 15) >> 1);
#pragma unroll
                    for (int q = 0; q < 4; ++q) {
#pragma unroll
                        for (int c = 0; c < 4; ++c) { const float vv = v[r][q][c] * sc, pv = dpp_f<DPP_X1>(vv);
                            const unsigned byte = __builtin_amdgcn_cvt_scalef32_pk_fp4_f32(0u, vv, pv, 1.0f, 0);
                            if (!(F.lane & 1)) vrow[8 * (4 * q + c)] = (unsigned char)(byte & 0xffu); } } }
                if (F.lane == 0) SUV[row] = inv; }
            if (row0 >> 14) {
                asm volatile("" ::: "memory");
#pragma unroll
                for (int h = 0; h < 2; ++h) { const int idx = F.lane + 64 * h, rr = idx >> 5, ci = idx & 31, e2 = (row0 + rr) & 16383;
                    const v4u w = *(const LAS v4u*)(F.lds + F.wave * 2048 + rr * 512 + ci * 16);
                    *(GAS v4u*)(ws + WS_V8 + ((size_t)(ci >> 3) * 16384 + e2) * 128 + 16 * (ci & 7)) = w; }
                asm volatile("" ::: "memory"); }
        }
    }
    {
        const int gt = gw * 64 + F.lane, ngt = NGW * 64;
        for (int p = gt; p < 262144 / 8; p += ngt) { const float* src = a.subkeys + (size_t)p * 8; const f32x4 v0 = *(const GAS f32x4*)src, v1 = *(const GAS f32x4*)(src + 4);
            v4u o; o.x = pk2(v0.x, v0.y); o.y = pk2(v0.z, v0.w); o.z = pk2(v1.x, v1.y); o.w = pk2(v1.z, v1.w); *(GAS v4u*)((bf16_t*)(ws + WS_SKB) + (size_t)p * 8) = o; }
    }
    bf16_t* MN = (bf16_t*)(ws + WS_MN);
    for (int row = gw; row < 1024; row += NGW) {
        const GAS f32x4* xr = (const GAS f32x4*)(a.mem + (size_t)row * D) + F.lane;
        f32x4 v[4]; float s = 0.f;
#pragma unroll
        for (int j = 0; j < 4; ++j) { v[j] = xr[64 * j]; s += (v[j].x * v[j].x + v[j].y * v[j].y) + (v[j].z * v[j].z + v[j].w * v[j].w); }
        const float rstd = rsqrtf(wave_sum(s) * (1.f / D) + EPS);
        GAS unsigned long long* o8 = (GAS unsigned long long*)(MN + (size_t)row * D) + F.lane;
#pragma unroll
        for (int j = 0; j < 4; ++j) { const f32x4 g = *((const f32x4*)a.g_mem + F.lane + 64 * j); const f32x4 o = v[j] * g * rstd;
            o8[64 * j] = (unsigned long long)pk2(o.x, o.y) | ((unsigned long long)pk2(o.z, o.w) << 32); }
    }
}
__device__ __forceinline__ void rstd_rows_for_units(Frame& F, int N, const float* SS, float* rstd) {
    pg8::StaticOrder S2; S2.init(T, N, F.G, (int)blockIdx.x); pg8::Unit u;
    for (int i = 0; S2.next(i, u); ++i) if (F.tid < 256) { const int row = u.pm * 256 + F.tid; const f32x4* sp = (const f32x4*)(SS + (size_t)row * 16);
        const f32x4 a = (sp[0] + sp[1]) + (sp[2] + sp[3]); rstd[row] = rsqrtf(((a.x + a.y) + (a.z + a.w)) * (1.f / 1024.f) + EPS); }
    asm volatile("s_waitcnt vmcnt(0)" ::: "memory"); __syncthreads();
}

__device__ __forceinline__ void sub_barrier(gu32* cnt, unsigned n, gu32* tmo) {
    asm volatile("s_waitcnt vmcnt(0)" ::: "memory");
    __syncthreads();
    if (threadIdx.x == 0) {
        __builtin_amdgcn_fence(__ATOMIC_RELEASE, "agent");
        asm volatile("s_waitcnt vmcnt(0)" ::: "memory");
        __hip_atomic_fetch_add(cnt, 1u, __ATOMIC_RELAXED, __HIP_MEMORY_SCOPE_AGENT);
        unsigned sp = 0;
        while (__hip_atomic_load(cnt, __ATOMIC_RELAXED, __HIP_MEMORY_SCOPE_AGENT) < n) { __builtin_amdgcn_s_sleep(2); if (++sp > (1u << 22)) { __hip_atomic_store(tmo, 1u, __ATOMIC_RELAXED, __HIP_MEMORY_SCOPE_AGENT); break; } }
        __builtin_amdgcn_fence(__ATOMIC_ACQUIRE, "agent");
        asm volatile("s_waitcnt vmcnt(0)" ::: "memory");
    }
    __syncthreads();
}

__global__ void __launch_bounds__(NWAVES * 64, 2) mk_fwd(Args args) {
    extern __shared__ __attribute__((aligned(16))) unsigned char lds_raw[];
    Frame F;
    F.lds = (LAS unsigned char*)lds_raw;
    F.tid = threadIdx.x; F.lane = F.tid & 63; F.wave = __builtin_amdgcn_readfirstlane(F.tid >> 6);
    F.G = gridDim.x; { const int bx = blockIdx.x; F.vcu = (F.G % 8 == 0) ? (bx % 8) * (F.G / 8) + bx / 8 : bx; }
    unsigned char* ws = args.ws;
    gu32* ctl = (gu32*)(ws + WS_CTL);
    volatile LAS unsigned* MISC = (volatile LAS unsigned*)(F.lds + MISC_OFF);
    for (int u = F.tid; u < (LDS_BYTES - LDSCTL_OFF) / 4; u += NWAVES * 64) ((LAS unsigned*)(F.lds + LDSCTL_OFF))[u] = 0u;
    __syncthreads();
    XcdBarrier bar = xcd_barrier_post((unsigned*)(ctl + CW_BAR) + args.bar_region * XCD_BAR_WORDS, MISC + 8);
    const int lo = args.ph_lo, hi = args.ph_hi;
#define IN(k) (lo <= (k) && (k) < hi)
#ifndef PROBE_PH
#define PROBE_PH (-1)
#endif
    unsigned long long pb_t = (PROBE_PH >= 0) ? __builtin_amdgcn_s_memrealtime() : 0ull;
#define PB_STRETCH() do { const unsigned long long e_ = __builtin_amdgcn_s_memrealtime(), d_ = e_ - pb_t; while (__builtin_amdgcn_s_memrealtime() - e_ < d_) __builtin_amdgcn_s_sleep(4); } while (0)
#define SEAM(k) do { if (PROBE_PH == (k)) PB_STRETCH(); if (IN(k) && IN((k) + 1)) xcd_barrier(bar); if ((k) < PROBE_PH) pb_t = __builtin_amdgcn_s_memrealtime(); } while (0)
    bf16_t* A0 = (bf16_t*)(ws + WS_A0); bf16_t* A1 = (bf16_t*)(ws + WS_A1);
    bf16_t* MG = (bf16_t*)args.out;
    bf16_t* SBQ = (bf16_t*)args.out; bf16_t* SBK = SBQ + (size_t)T * 512; bf16_t* SBV = SBK + (size_t)T * 512; bf16_t* OSB = SBV + (size_t)T * 512;

    GdnBufs Gb{(bf16_t*)(ws + WS_NW), (bf16_t*)(ws + WS_QD), (bf16_t*)(ws + WS_KDT), (bf16_t*)(ws + WS_QK), (bf16_t*)(ws + WS_UT), (float*)(ws + WS_CD), (bf16_t*)(ws + WS_ORAW), (float*)(ws + WS_OSS)};
    if (IN(0)) { p0_prologue(F, args);}
    SEAM(0);
    if (IN(1)) {
        { pg8::Gemm g{A0, (const bf16_t*)(ws + WS_WIN), T, NPROJ, 1024}; pg8::StaticOrder S; S.init(T, NPROJ, F.G, (int)blockIdx.x);
          pg8::EpiProj E{(const float*)(ws + WS_RSTD0), SBQ, SBK, SBV, A1, (bf16_t*)(ws + WS_GZ), (bf16_t*)(ws + WS_GSB), (bf16_t*)(ws + WS_GGDN)};
          pg8::gemm_phase<pg8::EpiProj, pg8::StaticOrder, true, true>(F.lds, g, S, E); }
    }
    SEAM(1);
    if (IN(2)) { gdn_prep_phase(F, args, A1, (const float*)(ws + WS_GB), (const float*)(ws + WS_GB) + T * 4, Gb); }
    SEAM(2);
    if (IN(3)) {
        const int nscan = F.G > 64 ? 64 : F.G, sb0 = F.G > 64 ? 64 : 0;
        if ((int)blockIdx.x < nscan) for (int s0 = blockIdx.x; s0 < 64; s0 += nscan) { const int s = (nscan == 64) ? ((s0 & 7) + 8 * (s0 >> 5)) * 4 + ((s0 >> 3) & 3) : s0; gdn_scan_unit(F, s, Gb); __syncthreads(); }
        if ((int)blockIdx.x >= sb0) { late_prologue(F, args, (int)blockIdx.x - sb0, F.G - sb0); __syncthreads(); }
        if ((int)blockIdx.x >= sb0) sb_phase(F.lds + F.wave * 8192, SBQ, SBK, SBV, OSB, ((int)blockIdx.x - sb0) * NWAVES + F.wave, (F.G - sb0) * NWAVES, F.lane);
        __syncthreads();
        if (sb0 > 0 && (int)blockIdx.x >= sb0) {
            sub_barrier(ctl + CW_SUB, (unsigned)(F.G - sb0), ctl + CW_SUB + 64);
            pg8::Gemm g{OSB, (const bf16_t*)(ws + WS_WSB), T, 1024, 512}; pg8::StaticOrder S; S.init(T, 1024, F.G - sb0, (int)blockIdx.x - sb0);
            pg8::EpiMerge<false> E{(const bf16_t*)(ws + WS_GSB), MG};
            pg8::gemm_phase<pg8::EpiMerge<false>, pg8::StaticOrder, true, true>(F.lds, g, S, E);
            const int wgi = (int)blockIdx.x - sb0;
            if (F.G - sb0 >= 160 && wgi >= 128 && wgi < 160) { pg8::Gemm g2{(const bf16_t*)(ws + WS_MN), (const bf16_t*)(ws + WS_WCKV), 1024, 2048, 1024}; pg8::StaticOrder S2; S2.init(1024, 2048, 32, wgi - 128);
                pg8::EpiSplit E2{(bf16_t*)(ws + WS_KC), (bf16_t*)(ws + WS_VC), 1024, 4};
                pg8::gemm_phase<pg8::EpiSplit, pg8::StaticOrder, true, true>(F.lds, g2, S2, E2); }
        }
    }
    SEAM(3);
    if (IN(4)) {
        if (!(F.G > 64 && F.G - 64 >= 160)) { pg8::Gemm g{(const bf16_t*)(ws + WS_MN), (const bf16_t*)(ws + WS_WCKV), 1024, 2048, 1024}; pg8::StaticOrder S; S.init(1024, 2048, F.G, (int)blockIdx.x);
          pg8::EpiSplit E{(bf16_t*)(ws + WS_KC), (bf16_t*)(ws + WS_VC), 1024, 4};
          pg8::gemm_phase<pg8::EpiSplit, pg8::StaticOrder, true, true>(F.lds, g, S, E); }
        gdn_finish_phase(F, args, Gb, (const bf16_t*)(ws + WS_GZ), (bf16_t*)(ws + WS_OG)); }
    SEAM(4);
    if (IN(5)) {
        if (!(F.G > 64)) { pg8::Gemm g{OSB, (const bf16_t*)(ws + WS_WSB), T, 1024, 512}; pg8::StaticOrder S; S.init(T, 1024, F.G, (int)blockIdx.x);
          pg8::EpiMerge<false> E{(const bf16_t*)(ws + WS_GSB), MG};
          pg8::gemm_phase<pg8::EpiMerge<false>, pg8::StaticOrder, true, true>(F.lds, g, S, E);
          xcd_barrier(bar); }
        { pg8::Gemm g{(const bf16_t*)(ws + WS_OG), (const bf16_t*)(ws + WS_WGDN), T, 1024, 512}; pg8::StaticOrder S; S.init(T, 1024, F.G, (int)blockIdx.x);
          pg8::EpiMerge<true> E{(const bf16_t*)(ws + WS_GGDN), MG};
          pg8::gemm_phase<pg8::EpiMerge<true>, pg8::StaticOrder, true, true>(F.lds, g, S, E); }
    }
    SEAM(5);
    if (IN(6)) {
        pg8::Gemm g{MG, (const bf16_t*)(ws + WS_WMIX), T, 1024, 1024}; pg8::StaticOrder S; S.init(T, 1024, F.G, (int)blockIdx.x);
        pg8::EpiRes<true> E{args.x, nullptr, A1, (float*)(ws + WS_SS)};
        pg8::gemm_phase<pg8::EpiRes<true>, pg8::StaticOrder, true, true>(F.lds, g, S, E);
    }
    SEAM(6);
    if (IN(7)) {
        rstd_rows_for_units(F, 1024, (const float*)(ws + WS_SS), (float*)(ws + WS_RSTD0));
        pg8::Gemm g{A1, (const bf16_t*)(ws + WS_WCQ), T, 1024, 1024}; pg8::StaticOrder S; S.init(T, 1024, F.G, (int)blockIdx.x);
        pg8::EpiScale E{(const float*)(ws + WS_RSTD0), (bf16_t*)(ws + WS_GSB), 1024};
        pg8::gemm_phase<pg8::EpiScale, pg8::StaticOrder, true, true>(F.lds, g, S, E);
        asm volatile("s_waitcnt vmcnt(0)" ::: "memory"); __syncthreads();
        pg8::StaticOrder S2; S2.init(T, 1024, F.G, (int)blockIdx.x); pg8::Unit u;
        for (int i = 0; S2.next(i, u); ++i) cross_item(F, (const bf16_t*)(ws + WS_GSB), (const bf16_t*)(ws + WS_KC), (const bf16_t*)(ws + WS_VC), (bf16_t*)(ws + WS_GGDN), (u.pm >> 5) * 4 + u.pn, u.pm & 31);
    }
    SEAM(7);
    if (IN(9)) {
        pg8::Gemm g{(const bf16_t*)(ws + WS_GGDN), (const bf16_t*)(ws + WS_WCO), T, 1024, 1024}; pg8::StaticOrder S; S.init(T, 1024, F.G, (int)blockIdx.x);
        pg8::EpiRes<false> E{nullptr, A1, A0, (float*)(ws + WS_SS)};
        pg8::gemm_phase<pg8::EpiRes<false>, pg8::StaticOrder, true, true>(F.lds, g, S, E);
    }
    SEAM(9);
    if (IN(10)) {
        rstd_rows_for_units(F, 2048, (const float*)(ws + WS_SS), (float*)(ws + WS_RSTD2));
        pg8::Gemm g{A0, (const bf16_t*)(ws + WS_WPQ), T, 2048, 1024}; pg8::StaticOrder S; S.init(T, 2048, F.G, (int)blockIdx.x);
        pg8::EpiScale E{(const float*)(ws + WS_RSTD2), A1, 2048};
        pg8::gemm_phase<pg8::EpiScale, pg8::StaticOrder, true, true>(F.lds, g, S, E);
        asm volatile("s_waitcnt vmcnt(0)" ::: "memory"); __syncthreads();
        pg8::StaticOrder S2; S2.init(T, 2048, F.G, (int)blockIdx.x); pg8::Unit u;
        int hst = -1;
        for (int i = 0; S2.next(i, u); ++i) {
            if (u.pn != hst) { hst = u.pn; __syncthreads();
#pragma unroll
                for (int q = 0; q < 8; ++q) { const int cid = F.tid + 512 * q, r = cid >> 4, c = cid & 15;
                    *(LAS v4u*)(F.lds + r * 256 + ((c ^ (r & 15)) << 4)) = *(const v4u*)((const bf16_t*)(ws + WS_SKB) + ((size_t)u.pn * 256 + r) * 128 + c * 8); }
                __syncthreads(); }
            peer_route_task(F, A1, (const bf16_t*)(ws + WS_SKB), (int*)(ws + 296 * MiB), (float*)(ws + 312 * MiB), u.pm * 8 + F.wave, u.pn);
        }
        __syncthreads();
    }
    SEAM(10);
    if (IN(12)) { peer_u_phase(F, args, ctl, A0, (const float*)(ws + WS_RSTD2), (const int*)(ws + 296 * MiB), (const unsigned char*)(ws + WS_U8), (bf16_t*)(ws + WS_PART)); }
    SEAM(12);
    if (IN(13)) { peer_combine_phase(F, (const bf16_t*)(ws + WS_PART), (const int*)(ws + 296 * MiB), (const float*)(ws + 312 * MiB), (const float*)(ws + WS_SUV), (const float*)(ws + WS_SUV) + 16384, ws + 328 * MiB, (float*)(ws + 336 * MiB)); }
    SEAM(13);
    if (IN(14)) { peer_v_phase(F, ctl, (const int*)(ws + 296 * MiB), ws + 328 * MiB, (const float*)(ws + 336 * MiB), (const unsigned char*)(ws + WS_V8), A0, A1, (float*)(ws + WS_SS)); }
    SEAM(14);
    if (IN(15)) { peer_norm_phase(F, args, (const float*)(ws + WS_SS), A1, args.out); }
    if (PROBE_PH == 15) PB_STRETCH();
#undef IN
#undef SEAM
#undef PB_STRETCH
}
extern "C" void kernel_launch(void* const* d_in, const int* in_sizes, int n_in, void* d_out, int out_size, void* d_ws, size_t ws_size, hipStream_t stream) {
    static int grid = 0;
    if (grid == 0) {
        if (n_in != 22 || ws_size < WS_END || out_size != T * D) { fprintf(stderr, "kernel_launch: unexpected n_in %d / ws %zu / out %d\n", n_in, ws_size, out_size); grid = -1; return; }
        int dev = 0, cus = 0, per_cu = 0;
        if (hipGetDevice(&dev) != hipSuccess || hipDeviceGetAttribute(&cus, hipDeviceAttributeMultiprocessorCount, dev) != hipSuccess) { grid = -1; return; }
        if (hipFuncSetAttribute((const void*)mk_fwd, hipFuncAttributeMaxDynamicSharedMemorySize, LDS_BYTES) != hipSuccess) { fprintf(stderr, "kernel_launch: hipFuncSetAttribute failed\n"); grid = -1; return; }
        if (hipOccupancyMaxActiveBlocksPerMultiprocessor(&per_cu, (const void*)mk_fwd, NWAVES * 64, LDS_BYTES) != hipSuccess || per_cu < 1) { fprintf(stderr, "kernel_launch: occupancy query says %d\n", per_cu); per_cu = 1; }
        (void)hipGetLastError();
        grid = cus;
    }
    if (grid < 0) return;
    hipMemsetAsync((char*)d_ws + WS_CTL, 0, CTL_ZERO_BYTES, stream);
    Args a{};
    const float** ap = (const float**)&a;
    for (int i = 0; i < 22; ++i) ap[i] = (const float*)d_in[i];
    a.out = (float*)d_out; a.ws = (unsigned char*)d_ws;
    char* ws = (char*)d_ws; float* out = (float*)d_out;
    float* rstd2 = (float*)(ws + WS_RSTD2);
    bf16_t* KC = (bf16_t*)(ws + WS_KC); bf16_t* VC = (bf16_t*)(ws + WS_VC);
    bf16_t* PQ = (bf16_t*)(ws + WS_A1); bf16_t* QC = (bf16_t*)(ws + WS_GSB); bf16_t* OC = (bf16_t*)(ws + WS_GGDN);
    int* EIDX = (int*)(ws + 296 * MiB); float* EGATE = (float*)(ws + 312 * MiB);
#define MK(lo, hi, reg) do { a.ph_lo = (lo); a.ph_hi = (hi); a.bar_region = (reg); hipLaunchKernelGGL(mk_fwd, dim3(grid), dim3(NWAVES * 64), LDS_BYTES, stream, a); } while (0)
    MK(0, 16, 0);
#undef MK
}
```
